# Optimizing an MI355X kernel written in HIP

```python
import math
import jax, jax.numpy as jnp
from jax import lax
import numpy as np

D_MODEL = 2048
BATCH = 8
SEQ = 2048
DEPTH = 1

D_MIX = D_MODEL
SB_HEADS = 8
SB_HEAD_DIM = 128
SB_WIDTH = SB_HEADS * SB_HEAD_DIM
DF_HEADS = 8
DF_QK_DIM = 64
DF_V_DIM = 2 * DF_QK_DIM
DF_WIDTH = DF_HEADS * DF_V_DIM
ROPE_DIM = DF_QK_DIM // 4
ROPE_THETA = 500000.0
PLE_DIM = 256
Q_BLOCK = 128
NORM_EPS = 1e-6
SUBLN_EPS = 1e-5
LAMBDA_STD = 0.1
IN_SIZES = (SB_WIDTH, SB_WIDTH, SB_WIDTH, SB_WIDTH,
            DF_HEADS * 2 * DF_QK_DIM, DF_HEADS * 2 * DF_QK_DIM,
            DF_WIDTH, DF_WIDTH)
IN_COLS = sum(IN_SIZES)

kernel_name = "hybrid_stickbreak_diffattn_ple"


def rmsnorm(x, g, eps=NORM_EPS):
    xf = x.astype(jnp.float32)
    y = xf * lax.rsqrt(jnp.mean(xf * xf, axis=-1, keepdims=True) + eps)
    return (y * g.astype(jnp.float32)).astype(x.dtype)


def partial_rope(x, pos):
    half = ROPE_DIM // 2
    inv_freq = ROPE_THETA ** (-jnp.arange(0, ROPE_DIM, 2, dtype=jnp.float32) / ROPE_DIM)
    ang = pos.astype(jnp.float32)[:, None] * inv_freq[None, :]
    cos = jnp.cos(ang)[:, None, None, :].astype(x.dtype)
    sin = jnp.sin(ang)[:, None, None, :].astype(x.dtype)
    x1 = x[..., :half]
    x2 = x[..., half:ROPE_DIM]
    rot = jnp.concatenate([x1 * cos - x2 * sin, x2 * cos + x1 * sin], axis=-1)
    return jnp.concatenate([rot, x[..., ROPE_DIM:]], axis=-1)


def stick_breaking_attention(q, k, v):
    B, S, H, Dh = q.shape
    nb = S // Q_BLOCK
    scale = Dh ** -0.5
    kpos = jnp.arange(S)
    qb = q.reshape(B, nb, Q_BLOCK, H, Dh).transpose(1, 0, 2, 3, 4)

    def block(args):
        qi, bi = args
        z = jnp.einsum('bqhd,bkhd->bhqk', qi, k).astype(jnp.float32) * scale
        qpos = bi * Q_BLOCK + jnp.arange(Q_BLOCK)
        mask = kpos[None, :] < qpos[:, None]
        log_not_beta = jnp.where(mask, -jax.nn.softplus(z), 0.0)
        later = lax.cumsum(log_not_beta, axis=3, reverse=True) - log_not_beta
        w = jnp.where(mask, jnp.exp(jax.nn.log_sigmoid(z) + later), 0.0)
        return jnp.einsum('bhqk,bkhd->bqhd', w.astype(v.dtype), v)

    out = lax.map(block, (qb, jnp.arange(nb)))
    return out.transpose(1, 0, 2, 3, 4).reshape(B, S, H, Dh)


def differential_attention(q, k, v, lam):
    B, S, H, _, dq = q.shape
    nb = S // Q_BLOCK
    scale = dq ** -0.5
    kpos = jnp.arange(S)
    qb = q.reshape(B, nb, Q_BLOCK, H, 2, dq).transpose(1, 0, 2, 3, 4, 5)

    def block(args):
        qi, bi = args
        s = jnp.einsum('bqhcd,bkhcd->bhcqk', qi, k).astype(jnp.float32) * scale
        qpos = bi * Q_BLOCK + jnp.arange(Q_BLOCK)
        mask = kpos[None, :] <= qpos[:, None]
        pr = jax.nn.softmax(jnp.where(mask, s, -jnp.inf), axis=-1)
        a = pr[:, :, 0] - lam * pr[:, :, 1]
        return jnp.einsum('bhqk,bkhd->bqhd', a.astype(v.dtype), v)

    out = lax.map(block, (qb, jnp.arange(nb)))
    return out.transpose(1, 0, 2, 3, 4).reshape(B, S, H, v.shape[-1])


def setup_inputs(seed: int = 0) -> dict:
    key = jax.random.key(seed)
    ks = jax.random.split(key, 16)
    f32 = jnp.float32
    nrm = lambda k, shape, scale: jax.random.normal(k, shape, f32) * scale
    return {
        "x": nrm(ks[0], (BATCH, SEQ, D_MODEL), 1.0),
        "p": nrm(ks[1], (DEPTH, BATCH, SEQ, PLE_DIM), 1.0),
        "norm_mix_g": 1.0 + nrm(ks[2], (DEPTH, D_MODEL), 0.02),
        "w_in": nrm(ks[3], (DEPTH, D_MODEL, IN_COLS), D_MODEL ** -0.5),
        "lambda_q1": nrm(ks[4], (DEPTH, DF_QK_DIM), LAMBDA_STD),
        "lambda_k1": nrm(ks[5], (DEPTH, DF_QK_DIM), LAMBDA_STD),
        "lambda_q2": nrm(ks[6], (DEPTH, DF_QK_DIM), LAMBDA_STD),
        "lambda_k2": nrm(ks[7], (DEPTH, DF_QK_DIM), LAMBDA_STD),
        "subln_g": 1.0 + nrm(ks[8], (DEPTH, DF_V_DIM), 0.02),
        "w_out": nrm(ks[9], (DEPTH, D_MIX, D_MODEL), D_MIX ** -0.5),
        "norm_ple_g": 1.0 + nrm(ks[10], (DEPTH, D_MODEL), 0.02),
        "w_ple_gate": nrm(ks[11], (DEPTH, D_MODEL, D_MODEL), D_MODEL ** -0.5),
        "w_ple_proj": nrm(ks[12], (DEPTH, PLE_DIM, D_MODEL), PLE_DIM ** -0.5),
        "norm_final_g": 1.0 + nrm(ks[13], (D_MODEL,), 0.02),
    }


def reference(x, p, norm_mix_g, w_in, lambda_q1, lambda_k1, lambda_q2, lambda_k2, subln_g,
              w_out, norm_ple_g, w_ple_gate, w_ple_proj, norm_final_g):
    B, S, _ = x.shape
    pos = jnp.arange(S)
    split_at = [int(v) for v in np.cumsum(IN_SIZES)[:-1]]
    h = x
    for i in range(DEPTH):
        lambda_init = 0.8 - 0.6 * math.exp(-0.3 * i)
        hn = rmsnorm(h, norm_mix_g[i])
        proj = hn @ w_in[i]
        sb_q, sb_k, sb_v, sb_g, df_q, df_k, df_v, df_g = jnp.split(proj, split_at, axis=-1)

        sb_shape = (B, S, SB_HEADS, SB_HEAD_DIM)
        sb_out = stick_breaking_attention(sb_q.reshape(sb_shape), sb_k.reshape(sb_shape),
                                          sb_v.reshape(sb_shape)).reshape(B, S, SB_WIDTH)

        qk_shape = (B, S, DF_HEADS, 2, DF_QK_DIM)
        dq = partial_rope(df_q.reshape(qk_shape), pos)
        dk = partial_rope(df_k.reshape(qk_shape), pos)
        lam = (jnp.exp(jnp.sum(lambda_q1[i] * lambda_k1[i]).astype(jnp.float32))
               - jnp.exp(jnp.sum(lambda_q2[i] * lambda_k2[i]).astype(jnp.float32))
               + lambda_init)
        df_out = differential_attention(dq, dk, df_v.reshape(B, S, DF_HEADS, DF_V_DIM), lam)
        df_out = rmsnorm(df_out, subln_g[i], SUBLN_EPS) * (1.0 - lambda_init)
        df_out = df_out.reshape(B, S, DF_WIDTH)

        mixed = jnp.concatenate([sb_out * jax.nn.silu(sb_g), df_out * jax.nn.silu(df_g)], axis=-1)
        h = h + mixed @ w_out[i]

        gate = jax.nn.sigmoid(rmsnorm(h, norm_ple_g[i]) @ w_ple_gate[i])
        h = h + gate * (p[i] @ w_ple_proj[i])
    return rmsnorm(h, norm_final_g)
```

```cpp
#include <hip/hip_runtime.h>
#include <hip/hip_cooperative_groups.h>
#include <cstdio>
#include <cstdint>
namespace cg = cooperative_groups;
namespace pg8 {
#define PG8_LAS __attribute__((address_space(3)))
typedef unsigned short bf16_t;
typedef short bf16x8 __attribute__((ext_vector_type(8)));
typedef float f32x4 __attribute__((ext_vector_type(4)));
typedef unsigned u32x4 __attribute__((ext_vector_type(4)));
constexpr int BM = 256, BK = 64, HALF = 128, HTB = HALF * BK * 2  , STAGE_BYTES = 8 * HTB, NXCD = 8, WGM = 8;

__host__ __device__ __forceinline__ int lds_byte(int r, int c) { const int st = (r >> 4) * 2 + (c >> 5), rr = r & 15, cc = c & 31, ob = rr * 64 + cc * 2; return st * 1024 + (ob ^ (((ob >> 9) & 1) << 5)); }
__host__ __device__ __forceinline__ void stage_rc(int b, int& R, int& C) { const int st = b / 1024, sb = b % 1024, swz = sb ^ (((sb >> 9) & 1) << 5); R = (st >> 1) * 16 + swz / 64; C = (st & 1) * 32 + (swz % 64) / 2; }
__host__ __device__ __forceinline__ int perm32(int rho) { const int n = rho >> 4, i = rho & 15; return 8 * (i >> 2) + 4 * n + (i & 3); }

struct Unit { int pm, pn; };
struct Gemm { const bf16_t* A; const bf16_t* Bt; int M, N, K; };

struct StaticOrder {
    int nM, nN, nwg, G, c;
    __host__ __device__ void init(int M, int N, int G_, int c_) { nM = M / BM; nN = N / BM; nwg = nM * nN; G = G_; c = c_; }
    __host__ __device__ bool next(int i, Unit& u) const {
        const long L = (long)i * G + c; if (L >= nwg) return false;
        int wgid = (int)L; { const int q = nwg / NXCD, r = nwg % NXCD, xcd = wgid % NXCD, off = wgid / NXCD; wgid = (xcd < r ? xcd * (q + 1) : r * (q + 1) + (xcd - r) * q) + off; }
        const int nig = WGM * nN, gid = wgid / nig, fm = gid * WGM, gsz = (nM - fm) < WGM ? (nM - fm) : WGM;
        u.pm = fm + ((wgid % nig) % gsz); u.pn = (wgid % nig) / gsz; return true;
    }
    __device__ __forceinline__ void a_ready(const Unit&) const {}
    __device__ __forceinline__ void done(const Unit&) const {}
};

__device__ __forceinline__ unsigned cvt_pk_bf16(float lo, float hi) { unsigned r; asm volatile("v_cvt_pk_bf16_f32 %0, %1, %2" : "=v"(r) : "v"(lo), "v"(hi)); return r; }
typedef float f32x2 __attribute__((ext_vector_type(2)));
template <class Epi, class Sched, bool ALIGN_EPI = false, bool SP2 = false>
__device__ __forceinline__ void gemm_phase(PG8_LAS unsigned char* lds, const Gemm g, const Sched& S, const Epi& E) {
    const int tid = threadIdx.x, wid = __builtin_amdgcn_readfirstlane(tid >> 6), lane = tid & 63, wr = wid >> 2, wc = wid & 3, fr = lane & 15, fq = lane >> 4;
    const int K = g.K, nt = K / BK;
    unsigned voffA[2], voffB[2];
#pragma unroll
    for (int i = 0; i < 2; ++i) { int R, C; stage_rc(tid * 16 + i * 8192, R, C); const int Rb = Epi::PERM ? ((R & ~31) + perm32(R & 31)) : R;
        voffA[i] = (unsigned)(R * K + C) * 2u; voffB[i] = (unsigned)(Rb * K + C) * 2u; }
    const size_t kstep = (size_t)(BK * 2);
    const size_t hstep = (size_t)HALF * K * 2;
    const size_t tstep = 2 * hstep;
    const unsigned ldsw = (unsigned)wid * 1024u;
    const int aoff = lds_byte(wr * 64 + fr, fq * 8), boff = lds_byte(wc * 32 + fr, fq * 8);
#define PG8_SA(b, h) (((b) * 2 + (h)) * HTB)
#define PG8_SB(b, h) ((4 + (b) * 2 + (h)) * HTB)
#define PG8_STAGE(bufoff, gbase, voff) do { _Pragma("unroll") for (int _i = 0; _i < 2; ++_i) \
        __builtin_amdgcn_global_load_lds((const unsigned*)((const char*)(gbase) + (voff)[_i]), (PG8_LAS unsigned*)(lds + (bufoff) + ldsw + _i * 8192), 16, 0, 0); } while (0)
#define PG8_LDA(dst, b, h) do { _Pragma("unroll") for (int m = 0; m < 4; ++m) _Pragma("unroll") for (int k = 0; k < 2; ++k) dst[m][k] = *(const PG8_LAS bf16x8*)(lds + PG8_SA(b, h) + aoff + m * 2048 + k * 1024); } while (0)
#define PG8_LDB(dst, b, h) do { _Pragma("unroll") for (int n = 0; n < 2; ++n) _Pragma("unroll") for (int k = 0; k < 2; ++k) dst[n][k] = *(const PG8_LAS bf16x8*)(lds + PG8_SB(b, h) + boff + n * 2048 + k * 1024); } while (0)
#define PG8_MMA(ai, bj, At, Bt) do { __builtin_amdgcn_s_setprio(1); _Pragma("unroll") for (int m = 0; m < 4; ++m) _Pragma("unroll") for (int n = 0; n < 2; ++n) _Pragma("unroll") for (int k = 0; k < 2; ++k) \
        acc[ai][bj][m][n] = __builtin_amdgcn_mfma_f32_16x16x32_bf16(Bt[n][k], At[m][k], acc[ai][bj][m][n], 0, 0, 0); __builtin_amdgcn_s_setprio(0); } while (0)
#define PG8_WAIT_V(n) asm volatile("s_waitcnt vmcnt(" #n ")" ::: "memory")
#define PG8_WAIT_L(n) asm volatile("s_waitcnt lgkmcnt(" #n ")" ::: "memory")
#define PG8_BAR __builtin_amdgcn_s_barrier()
#define PG8_SCHED __builtin_amdgcn_sched_barrier(0)
    Unit cur, nxt; int ui = 0;
    if (!S.next(0, cur)) return;
    f32x4 acc[2][2][4][2];
#pragma unroll
    for (int a = 0; a < 2; ++a)
#pragma unroll
        for (int b = 0; b < 2; ++b)
#pragma unroll
            for (int m = 0; m < 4; ++m)
#pragma unroll
                for (int n = 0; n < 2; ++n) acc[a][b][m][n] = (f32x4){0.f, 0.f, 0.f, 0.f};
    bf16x8 At[4][2], B0[2][2], B1[2][2];
    const char* cA = (const char*)g.A + (size_t)cur.pm * tstep; const char* cB = (const char*)g.Bt + (size_t)cur.pn * tstep;
    S.a_ready(cur);
    if constexpr (SP2) {
        PG8_STAGE(PG8_SB(0, 0), cB, voffB); PG8_STAGE(PG8_SB(0, 1), cB + hstep, voffB); PG8_STAGE(PG8_SA(0, 0), cA, voffA); PG8_STAGE(PG8_SA(0, 1), cA + hstep, voffA);
        if (wr == 1) PG8_BAR;
        PG8_WAIT_V(2); PG8_BAR;
        PG8_STAGE(PG8_SB(1, 0), cB + kstep, voffB); PG8_STAGE(PG8_SA(1, 0), cA + kstep, voffA); PG8_STAGE(PG8_SB(1, 1), cB + hstep + kstep, voffB);
        PG8_WAIT_V(6); PG8_BAR;
    } else {
        PG8_STAGE(PG8_SB(0, 0), cB, voffB); PG8_STAGE(PG8_SA(0, 0), cA, voffA); PG8_STAGE(PG8_SB(0, 1), cB + hstep, voffB); PG8_STAGE(PG8_SA(0, 1), cA + hstep, voffA);
        if (wr == 1) PG8_BAR;
        PG8_WAIT_V(4); PG8_BAR;
        PG8_STAGE(PG8_SB(1, 0), cB + kstep, voffB); PG8_STAGE(PG8_SA(1, 0), cA + kstep, voffA); PG8_STAGE(PG8_SB(1, 1), cB + hstep + kstep, voffB);
        PG8_WAIT_V(6); PG8_BAR;
    }
    for (;;) {
        const bool has_next = S.next(ui + 1, nxt);
        const char* nA = has_next ? (const char*)g.A + (size_t)nxt.pm * tstep : cA; const char* nB = has_next ? (const char*)g.Bt + (size_t)nxt.pn * tstep : cB;
        for (int t = 0; t < nt; t += 2) {
            const bool last = (t == nt - 2);
            const char* a1 = cA + (size_t)(t + 1) * kstep;
            const char* a2 = last ? nA : cA + (size_t)(t + 2) * kstep; const char* b2 = last ? nB : cB + (size_t)(t + 2) * kstep;
            const char* a3 = a2 + kstep; const char* b3 = b2 + kstep;
            if (last && has_next) S.a_ready(nxt);
            if constexpr (SP2) {
            PG8_LDB(B0, 0, 0); PG8_LDB(B1, 0, 1); PG8_SCHED; PG8_LDA(At, 0, 0); PG8_STAGE(PG8_SA(1, 1), a1 + hstep, voffA);
            PG8_WAIT_V(8); PG8_WAIT_L(0); PG8_BAR; PG8_MMA(0, 0, At, B0); PG8_MMA(0, 1, At, B1); PG8_BAR; PG8_SCHED;
            PG8_LDA(At, 0, 1); PG8_STAGE(PG8_SB(0, 0), b2, voffB); PG8_STAGE(PG8_SB(0, 1), b2 + hstep, voffB); PG8_STAGE(PG8_SA(0, 0), a2, voffA);
            PG8_WAIT_V(8); PG8_WAIT_L(0); PG8_BAR; PG8_MMA(1, 0, At, B0); PG8_MMA(1, 1, At, B1); PG8_BAR; PG8_SCHED;
            PG8_LDB(B0, 1, 0); PG8_LDB(B1, 1, 1); PG8_SCHED; PG8_LDA(At, 1, 0); PG8_STAGE(PG8_SA(0, 1), a2 + hstep, voffA);
            PG8_WAIT_V(8); PG8_WAIT_L(0); PG8_BAR; PG8_MMA(0, 0, At, B0); PG8_MMA(0, 1, At, B1); PG8_BAR; PG8_SCHED;
            PG8_LDA(At, 1, 1); PG8_STAGE(PG8_SB(1, 0), b3, voffB); PG8_STAGE(PG8_SB(1, 1), b3 + hstep, voffB); PG8_STAGE(PG8_SA(1, 0), a3, voffA);
            PG8_WAIT_V(8); PG8_WAIT_L(0); PG8_BAR; PG8_MMA(1, 0, At, B0); PG8_MMA(1, 1, At, B1); PG8_BAR; PG8_SCHED;
            } else {
            PG8_LDB(B0, 0, 0); PG8_SCHED; PG8_LDA(At, 0, 0); PG8_STAGE(PG8_SA(1, 1), a1 + hstep, voffA);
            PG8_WAIT_L(8); PG8_BAR; PG8_WAIT_L(0); PG8_MMA(0, 0, At, B0); PG8_BAR; PG8_SCHED;
            PG8_LDB(B1, 0, 1); PG8_STAGE(PG8_SB(0, 0), b2, voffB);
            PG8_BAR; PG8_WAIT_L(0); PG8_MMA(0, 1, At, B1); PG8_BAR;
            PG8_LDA(At, 0, 1); PG8_STAGE(PG8_SA(0, 0), a2, voffA);
            PG8_BAR; PG8_WAIT_L(0); PG8_MMA(1, 0, At, B0); PG8_BAR; PG8_SCHED;
            PG8_STAGE(PG8_SB(0, 1), b2 + hstep, voffB);
            PG8_WAIT_V(6); PG8_BAR; PG8_MMA(1, 1, At, B1); PG8_BAR;
            PG8_LDB(B0, 1, 0); PG8_SCHED; PG8_LDA(At, 1, 0); PG8_STAGE(PG8_SA(0, 1), a2 + hstep, voffA);
            PG8_WAIT_L(8); PG8_BAR; PG8_WAIT_L(0); PG8_MMA(0, 0, At, B0); PG8_BAR; PG8_SCHED;
            PG8_LDB(B1, 1, 1); PG8_STAGE(PG8_SB(1, 0), b3, voffB);
            PG8_BAR; PG8_WAIT_L(0); PG8_MMA(0, 1, At, B1); PG8_BAR;
            PG8_LDA(At, 1, 1); PG8_STAGE(PG8_SA(1, 0), a3, voffA);
            PG8_BAR; PG8_WAIT_L(0); PG8_MMA(1, 0, At, B0); PG8_BAR; PG8_SCHED;
            PG8_STAGE(PG8_SB(1, 1), b3 + hstep, voffB);
            PG8_WAIT_V(6); PG8_BAR; PG8_MMA(1, 1, At, B1); PG8_BAR;
            }
        }
        if constexpr (ALIGN_EPI) { if (wr == 0) PG8_BAR; }
        if constexpr (!Epi::AFTER_DRAIN) { E(acc, cur, wr, wc, fr, fq); S.done(cur); }
        if (!has_next) break;
#pragma unroll
        for (int a = 0; a < 2; ++a)
#pragma unroll
            for (int b = 0; b < 2; ++b)
#pragma unroll
                for (int m = 0; m < 4; ++m)
#pragma unroll
                    for (int n = 0; n < 2; ++n) acc[a][b][m][n] = (f32x4){0.f, 0.f, 0.f, 0.f};
        cur = nxt; cA = nA; cB = nB; ++ui;
        if constexpr (ALIGN_EPI) { if (wr == 1) PG8_BAR; }
    }
    PG8_WAIT_V(0);
    if constexpr (!ALIGN_EPI) { if (wr == 0) PG8_BAR; }
    PG8_BAR;
    if constexpr (Epi::AFTER_DRAIN) { E.fused(acc, cur, wr, wc, fr, fq, lds, wid, lane); S.done(cur); }
#undef PG8_SA
#undef PG8_SB
#undef PG8_STAGE
#undef PG8_LDA
#undef PG8_LDB
#undef PG8_MMA
#undef PG8_WAIT_V
#undef PG8_WAIT_L
#undef PG8_BAR
#undef PG8_SCHED
}
}
#define LAS __attribute__((address_space(3)))
typedef unsigned short bf16_t;
typedef short bf16x8 __attribute__((ext_vector_type(8)));
typedef float f32x4 __attribute__((ext_vector_type(4)));
typedef float f32x2 __attribute__((ext_vector_type(2)));
typedef float f32x16 __attribute__((ext_vector_type(16)));
typedef unsigned u32x4 __attribute__((ext_vector_type(4)));
typedef unsigned u32x2 __attribute__((ext_vector_type(2)));

constexpr int NTOK = 16384, DM = 2048, SEQ = 2048, NBATCH = 8, PLE = 256;
constexpr int NPROJ = 6144;
constexpr int PQ_SB = 0, PK_SB = 1024, PG_SB = 2048, PQ_DF = 3072, PK_DF = 4096, PG_DF = 5120;
constexpr float LOG2E = 1.4426950408889634f;
constexpr float SBQ_SCALE = 0.08838834764831845f * LOG2E;
constexpr float DFQ_SCALE = 0.125f * LOG2E;
constexpr float NORM_EPS = 1e-6f, SUBLN_EPS = 1e-5f;
constexpr float LAMBDA_INIT = 0.2f;

constexpr size_t MiB = 1u << 20;
constexpr size_t WS_CTL = 0;
constexpr size_t CTL_SS2 = 0, CTL_SS3 = 65536, CTL_LAM = 131072, CTL_ROPE = 262144;
constexpr size_t WS_WIN = 2 * MiB, WS_WOUT = 34 * MiB, WS_WGATE = 42 * MiB, WS_WPROJ = 50 * MiB, WS_PB = 52 * MiB;
constexpr size_t WS_XN = 64 * MiB, WS_MIXED = 64 * MiB;
constexpr size_t WS_PROJ = 128 * MiB, WS_VT = 320 * MiB, WS_END = 384 * MiB;
constexpr size_t WS_HB = 128 * MiB, WS_PLE = 192 * MiB;

constexpr int LDS_BYTES = 131072 + 1024;

__device__ __forceinline__ unsigned cvt_pk(float lo, float hi) { unsigned r; asm volatile("v_cvt_pk_bf16_f32 %0, %1, %2" : "=v"(r) : "v"(lo), "v"(hi)); return r; }
__device__ __forceinline__ float bf_lo(unsigned w) { return __uint_as_float(w << 16); }
__device__ __forceinline__ float bf_hi(unsigned w) { return __uint_as_float(w & 0xffff0000u); }
__device__ __forceinline__ float wave_sum(float v) {
#pragma unroll
    for (int o = 1; o < 64; o <<= 1) v += __shfl_xor(v, o);
    return v;
}
__device__ __forceinline__ float fast_exp2(float x) { return __builtin_amdgcn_exp2f(x); }
__device__ __forceinline__ float fast_log2(float x) { return __builtin_amdgcn_logf(x); }
__device__ __forceinline__ float silu_f(float x) { return x * __builtin_amdgcn_rcpf(1.f + fast_exp2(-x * LOG2E)); }
__device__ __forceinline__ float sigmoid_f(float x) { return __builtin_amdgcn_rcpf(1.f + fast_exp2(-x * LOG2E)); }

namespace pg8 {
struct EpiBf16 {
    static constexpr bool PERM = true, AFTER_DRAIN = false;
    bf16_t* O; int ldc;
    __device__ __forceinline__ void operator()(const f32x4 (&acc)[2][2][4][2], const Unit& u, int wr, int wc, int fr, int fq) const {
        const int row0 = u.pm * BM + wr * 64 + fr; const int col0 = u.pn * BM + wc * 32 + 8 * fq;
#pragma unroll
        for (int ai = 0; ai < 2; ++ai)
#pragma unroll
            for (int m = 0; m < 4; ++m) { bf16_t* rowp = O + (size_t)(row0 + ai * HALF + m * 16) * ldc + col0;
#pragma unroll
                for (int bj = 0; bj < 2; ++bj) { const f32x4 v0 = acc[ai][bj][m][0], v1 = acc[ai][bj][m][1];
                    u32x4 w; w.x = cvt_pk_bf16(v0[0], v0[1]); w.y = cvt_pk_bf16(v0[2], v0[3]); w.z = cvt_pk_bf16(v1[0], v1[1]); w.w = cvt_pk_bf16(v1[2], v1[3]);
                    *(u32x4*)(rowp + bj * HALF) = w; } }
    }
};
struct EpiProj {
    static constexpr bool PERM = true, AFTER_DRAIN = false;
    bf16_t* O; const float* rope;
    __device__ __forceinline__ void operator()(const f32x4 (&acc)[2][2][4][2], const Unit& u, int wr, int wc, int fr, int fq) const {
        const int row0 = u.pm * BM + wr * 64 + fr; const int col0 = u.pn * BM + wc * 32 + 8 * fq;
        const int kind = u.pn >> 2;
        const bool dorope = (kind == 3 || kind == 4) && ((wc & 1) == 0) && (fq < 2);
        const float sc = kind == 0 ? SBQ_SCALE : (kind == 3 ? DFQ_SCALE : 1.f);
        const bool dosilu = (kind == 2 || kind == 5);
#pragma unroll
        for (int ai = 0; ai < 2; ++ai)
#pragma unroll
            for (int m = 0; m < 4; ++m) { const int row = row0 + ai * HALF + m * 16; bf16_t* rowp = O + (size_t)row * NPROJ + col0;
                f32x4 cs0 = {1.f, 0.f, 1.f, 0.f}, cs1 = {1.f, 0.f, 1.f, 0.f};
                if (dorope) { const f32x4* rp = (const f32x4*)(rope + ((size_t)(row & (SEQ - 1)) * 8 + 4 * fq) * 2); cs0 = rp[0]; cs1 = rp[1]; }
#pragma unroll
                for (int bj = 0; bj < 2; ++bj) { f32x4 v0 = acc[ai][bj][m][0], v1 = acc[ai][bj][m][1];
                    if (dorope) {
                        f32x4 a, b;
                        a[0] = v0[0] * cs0[0] - v0[1] * cs0[1]; a[1] = v0[1] * cs0[0] + v0[0] * cs0[1];
                        a[2] = v0[2] * cs0[2] - v0[3] * cs0[3]; a[3] = v0[3] * cs0[2] + v0[2] * cs0[3];
                        b[0] = v1[0] * cs1[0] - v1[1] * cs1[1]; b[1] = v1[1] * cs1[0] + v1[0] * cs1[1];
                        b[2] = v1[2] * cs1[2] - v1[3] * cs1[3]; b[3] = v1[3] * cs1[2] + v1[2] * cs1[3];
                        v0 = a; v1 = b; }
                    if (dosilu) {
#pragma unroll
                        for (int j = 0; j < 4; ++j) { v0[j] = silu_f(v0[j]); v1[j] = silu_f(v1[j]); } }
                    v0 = v0 * sc; v1 = v1 * sc;
                    u32x4 w; w.x = cvt_pk_bf16(v0[0], v0[1]); w.y = cvt_pk_bf16(v0[2], v0[3]); w.z = cvt_pk_bf16(v1[0], v1[1]); w.w = cvt_pk_bf16(v1[2], v1[3]);
                    *(u32x4*)(rowp + bj * HALF) = w; } }
    }
};
struct EpiRes {
    static constexpr bool PERM = false, AFTER_DRAIN = false;
    const float* x; float* out; bf16_t* hb; float* ss;
    __device__ __forceinline__ void operator()(const f32x4 (&acc)[2][2][4][2], const Unit& u, int wr, int wc, int fr, int fq) const {
        const int row0 = u.pm * BM + wr * 64 + fr; const int col0 = u.pn * BM + wc * 32 + 4 * fq;
#pragma unroll
        for (int ai = 0; ai < 2; ++ai)
#pragma unroll
            for (int m = 0; m < 4; ++m) { const int row = row0 + ai * HALF + m * 16; const size_t off = (size_t)row * DM + col0; float q = 0.f;
#pragma unroll
                for (int bj = 0; bj < 2; ++bj)
#pragma unroll
                    for (int n = 0; n < 2; ++n) { const size_t o2 = off + bj * HALF + n * 16; const f32x4 hv = *(const f32x4*)(x + o2) + acc[ai][bj][m][n];
                        *(f32x4*)(out + o2) = hv; u32x2 w; w.x = cvt_pk_bf16(hv[0], hv[1]); w.y = cvt_pk_bf16(hv[2], hv[3]); *(u32x2*)(hb + o2) = w;
                        q += (hv[0] * hv[0] + hv[1] * hv[1]) + (hv[2] * hv[2] + hv[3] * hv[3]); }
                q += __shfl_xor(q, 16); q += __shfl_xor(q, 32);
                if (fq == 0) atomicAdd(ss + row, q); }
    }
};
struct EpiGate {
    static constexpr bool PERM = false, AFTER_DRAIN = false;
    float* out; const bf16_t* ple; const float* ss2; float* ss3;
    __device__ __forceinline__ void operator()(const f32x4 (&acc)[2][2][4][2], const Unit& u, int wr, int wc, int fr, int fq) const {
        const int row0 = u.pm * BM + wr * 64 + fr; const int col0 = u.pn * BM + wc * 32 + 4 * fq;
#pragma unroll
        for (int ai = 0; ai < 2; ++ai)
#pragma unroll
            for (int m = 0; m < 4; ++m) { const int row = row0 + ai * HALF + m * 16; const size_t off = (size_t)row * DM + col0; float q = 0.f;
                const float rstd = rsqrtf(ss2[row] * (1.f / DM) + NORM_EPS);
#pragma unroll
                for (int bj = 0; bj < 2; ++bj)
#pragma unroll
                    for (int n = 0; n < 2; ++n) { const size_t o2 = off + bj * HALF + n * 16; const f32x4 hv = *(const f32x4*)(out + o2); const u32x2 pw = *(const u32x2*)(ple + o2);
                        const f32x4 a = acc[ai][bj][m][n] * rstd; f32x4 h2;
                        h2[0] = hv[0] + sigmoid_f(a[0]) * bf_lo(pw.x); h2[1] = hv[1] + sigmoid_f(a[1]) * bf_hi(pw.x);
                        h2[2] = hv[2] + sigmoid_f(a[2]) * bf_lo(pw.y); h2[3] = hv[3] + sigmoid_f(a[3]) * bf_hi(pw.y);
                        *(f32x4*)(out + o2) = h2;
                        q += (h2[0] * h2[0] + h2[1] * h2[1]) + (h2[2] * h2[2] + h2[3] * h2[3]); }
                q += __shfl_xor(q, 16); q += __shfl_xor(q, 32);
                if (fq == 0) atomicAdd(ss3 + row, q); }
    }
};
}
namespace att {
constexpr int KP = 272, VP = 144, KT_BYTES = 64 * KP, VT_BYTES = 128 * VP, BUF_BYTES = KT_BYTES + VT_BYTES;
constexpr int FLAG_OFF = 2 * BUF_BYTES;
constexpr int XP = 132;
constexpr float R_DONE = 152.0f;

template <int MODE>
__device__ __forceinline__ void attn_unit(LAS unsigned char* lds, const bf16_t* __restrict__ PROJ, const bf16_t* __restrict__ VT, bf16_t* __restrict__ MIXED,
                                          int b, int hh, int qblk, float lam, const float* __restrict__ subln_g) {
    constexpr int QB = MODE == 0 ? 256 : 128;
    constexpr int NKS = MODE == 0 ? 8 : 4;
    const int tid = threadIdx.x, lane = tid & 63, r = lane & 31, h = lane >> 5;
    const int wid = __builtin_amdgcn_readfirstlane(tid >> 6);
    const int qg = MODE == 0 ? wid : (wid & 3), role = MODE == 0 ? 0 : (wid >> 2);
    const int Q0 = qblk * QB, q0w = Q0 + 32 * qg, tq = q0w + r;
    const size_t tokbase = (size_t)b * SEQ;
    const bf16_t* Kg = PROJ + tokbase * NPROJ + (MODE == 0 ? PK_SB : PK_DF) + hh * 128;
    const bf16_t* Vg = VT + (size_t)((MODE == 0 ? 0 : 1024) + hh * 128) * NTOK + tokbase;
    bf16x8 qf[NKS];
    { const bf16_t* qp = PROJ + (tokbase + tq) * NPROJ + (MODE == 0 ? PQ_SB + hh * 128 : PQ_DF + hh * 128 + role * 64) + 8 * h;
#pragma unroll
      for (int ks = 0; ks < NKS; ++ks) qf[ks] = *(const bf16x8*)(qp + 16 * ks); }
    f32x16 o[4];
#pragma unroll
    for (int d = 0; d < 4; ++d)
#pragma unroll
        for (int i = 0; i < 16; ++i) o[d][i] = 0.f;
    float R = 0.f, m_run = -1e30f, l_run = 0.f;
    const int kr0 = tid >> 4, kc = tid & 15, vr0 = tid >> 3, vc = tid & 7;
    const int vpos0 = 16 * (vc >> 1) + ((vc & 1) ? 4 : 0), vpos1 = 16 * (vc >> 1) + ((vc & 1) ? 12 : 8);
    const int kst = kr0 * KP + kc * 16, vst0 = KT_BYTES + vr0 * VP + vpos0 * 2, vst1 = KT_BYTES + vr0 * VP + vpos1 * 2;
    const bf16_t* kgl = Kg + (size_t)kr0 * NPROJ + kc * 8;
    const bf16_t* vgl = Vg + (size_t)vr0 * NTOK + vc * 8;
    u32x4 kreg[2], vreg[2];
#define ATT_LOAD(t) do { _Pragma("unroll") for (int i_ = 0; i_ < 2; ++i_) { \
        kreg[i_] = *(const u32x4*)(kgl + (size_t)((t) * 64 + 32 * i_) * NPROJ); \
        vreg[i_] = *(const u32x4*)(vgl + (size_t)(64 * i_) * NTOK + (t) * 64); } } while (0)
#define ATT_STORE(bo) do { _Pragma("unroll") for (int i_ = 0; i_ < 2; ++i_) { \
        *(LAS u32x4*)(lds + (bo) + kst + i_ * 32 * KP) = kreg[i_]; \
        *(LAS u32x2*)(lds + (bo) + vst0 + i_ * 64 * VP) = (u32x2){vreg[i_].x, vreg[i_].y}; \
        *(LAS u32x2*)(lds + (bo) + vst1 + i_ * 64 * VP) = (u32x2){vreg[i_].z, vreg[i_].w}; } } while (0)
    const int tl = (Q0 + QB - 1) >> 6;
    const int kfrag = r * KP + (role * 64 + 8 * h) * 2;
    const int vfrag = KT_BYTES + r * VP + (8 * h) * 2;
    volatile LAS int* flags = (volatile LAS int*)(lds + FLAG_OFF);
    __syncthreads();
    ATT_LOAD(tl); ATT_STORE(0);
    __syncthreads();
    int cur = 0, it = 0;
    bool wdone = false;
    for (int t = tl;; --t, ++it) {
        if (t > 0) ATT_LOAD(t - 1);
        const int k0 = 64 * t;
        const bool active = (MODE == 0) ? (!wdone && k0 <= q0w + 30) : (k0 <= q0w + 31);
        if (active) {
            const int bo = cur * BUF_BYTES;
            f32x16 s[2];
#pragma unroll
            for (int kb = 0; kb < 2; ++kb) {
#pragma unroll
                for (int i = 0; i < 16; ++i) s[kb][i] = 0.f;
#pragma unroll
                for (int ks = 0; ks < NKS; ++ks) {
                    const bf16x8 a = *(const LAS bf16x8*)(lds + bo + kfrag + kb * 32 * KP + ks * 32);
                    s[kb] = __builtin_amdgcn_mfma_f32_32x32x16_bf16(a, qf[ks], s[kb], 0, 0, 0);
                }
            }
            bf16x8 pf[2][2];
            if (MODE == 0) {
#pragma unroll
                for (int kbi = 0; kbi < 2; ++kbi) {
                    const int kb = 1 - kbi;
                    const int kbase = k0 + 32 * kb + 4 * h;
                    float c[16]; bool ok[16];
#pragma unroll
                    for (int i = 0; i < 16; ++i) {
                        const int key = kbase + 8 * (i >> 2) + (i & 3);
                        ok[i] = key < tq;
                        const float z = s[kb][i];
                        const float spv = fmaxf(z, 0.f) + fast_log2(1.f + fast_exp2(-fabsf(z)));
                        c[i] = ok[i] ? spv : 0.f;
                    }
                    float T[4], OT[4], pr[4], suf[4];
#pragma unroll
                    for (int g = 0; g < 4; ++g) { c[4 * g + 2] += c[4 * g + 3]; c[4 * g + 1] += c[4 * g + 2]; c[4 * g] += c[4 * g + 1]; T[g] = c[4 * g]; }
#pragma unroll
                    for (int g = 0; g < 4; ++g) { OT[g] = __shfl_xor(T[g], 32); pr[g] = T[g] + OT[g]; }
                    suf[3] = 0.f; suf[2] = pr[3]; suf[1] = suf[2] + pr[2]; suf[0] = suf[1] + pr[1];
                    float w[16];
#pragma unroll
                    for (int g = 0; g < 4; ++g) { const float off = R + suf[g] + (h == 0 ? OT[g] : 0.f);
#pragma unroll
                        for (int j = 0; j < 4; ++j) { const int i = 4 * g + j; const float e = fast_exp2(s[kb][i] - (off + c[i])); w[i] = ok[i] ? e : 0.f; } }
                    R += suf[0] + pr[0];
#pragma unroll
                    for (int sp = 0; sp < 2; ++sp) { u32x4 p; p.x = cvt_pk(w[8 * sp], w[8 * sp + 1]); p.y = cvt_pk(w[8 * sp + 2], w[8 * sp + 3]); p.z = cvt_pk(w[8 * sp + 4], w[8 * sp + 5]); p.w = cvt_pk(w[8 * sp + 6], w[8 * sp + 7]);
                        pf[kb][sp] = __builtin_bit_cast(bf16x8, p); }
                }
                wdone = __all(R >= R_DONE);
            } else {
                float mx = -1e30f;
#pragma unroll
                for (int kb = 0; kb < 2; ++kb) { const int kbase = k0 + 32 * kb + 4 * h;
#pragma unroll
                    for (int i = 0; i < 16; ++i) { const int key = kbase + 8 * (i >> 2) + (i & 3); const float v = (key <= tq) ? s[kb][i] : -1e30f; s[kb][i] = v; mx = fmaxf(mx, v); } }
                mx = fmaxf(mx, __shfl_xor(mx, 32));
                const float m_new = fmaxf(m_run, mx), alpha = fast_exp2(m_run - m_new);
                m_run = m_new;
                float ls = 0.f;
#pragma unroll
                for (int kb = 0; kb < 2; ++kb) {
#pragma unroll
                    for (int i = 0; i < 16; ++i) { const float p = fast_exp2(s[kb][i] - m_new); s[kb][i] = p; ls += p; }
#pragma unroll
                    for (int sp = 0; sp < 2; ++sp) { u32x4 p; p.x = cvt_pk(s[kb][8 * sp], s[kb][8 * sp + 1]); p.y = cvt_pk(s[kb][8 * sp + 2], s[kb][8 * sp + 3]); p.z = cvt_pk(s[kb][8 * sp + 4], s[kb][8 * sp + 5]); p.w = cvt_pk(s[kb][8 * sp + 6], s[kb][8 * sp + 7]);
                        pf[kb][sp] = __builtin_bit_cast(bf16x8, p); }
                }
                l_run = l_run * alpha + ls;
#pragma unroll
                for (int d = 0; d < 4; ++d)
#pragma unroll
                    for (int i = 0; i < 16; ++i) o[d][i] *= alpha;
            }
#pragma unroll
            for (int d = 0; d < 4; ++d)
#pragma unroll
                for (int kb = 0; kb < 2; ++kb)
#pragma unroll
                    for (int sp = 0; sp < 2; ++sp) {
                        const bf16x8 a = *(const LAS bf16x8*)(lds + bo + vfrag + d * 32 * VP + (32 * kb + 16 * sp) * 2);
                        o[d] = __builtin_amdgcn_mfma_f32_32x32x16_bf16(a, pf[kb][sp], o[d], 0, 0, 0);
                    }
        }
        if (t > 0) ATT_STORE((cur ^ 1) * BUF_BYTES);
        if (MODE == 0) { if (lane == 0) flags[(it & 1) * 8 + wid] = wdone ? 1 : 0; }
        __syncthreads();
        if (t == 0) break;
        if (MODE == 0) { int alld = 1;
#pragma unroll
            for (int w2 = 0; w2 < 8; ++w2) alld &= flags[(it & 1) * 8 + w2];
            if (alld) break; }
        cur ^= 1;
    }
#undef ATT_LOAD
#undef ATT_STORE
    const size_t tok = tokbase + tq;
    if (MODE == 0) {
        const bf16_t* gp = PROJ + tok * NPROJ + PG_SB + hh * 128 + 4 * h;
        bf16_t* op = MIXED + tok * DM + hh * 128 + 4 * h;
#pragma unroll
        for (int d = 0; d < 4; ++d)
#pragma unroll
            for (int g = 0; g < 4; ++g) { const u32x2 gw = *(const u32x2*)(gp + 32 * d + 8 * g);
                u32x2 ow; ow.x = cvt_pk(o[d][4 * g] * bf_lo(gw.x), o[d][4 * g + 1] * bf_hi(gw.x)); ow.y = cvt_pk(o[d][4 * g + 2] * bf_lo(gw.y), o[d][4 * g + 3] * bf_hi(gw.y));
                *(u32x2*)(op + 32 * d + 8 * g) = ow; }
    } else {
        const float lt = l_run + __shfl_xor(l_run, 32);
        const float inv = 1.f / lt;
        LAS float* xq = (LAS float*)lds + (qg * 32 + r) * XP + 4 * h;
        if (role == 1) {
            const float f = inv * lam;
#pragma unroll
            for (int d = 0; d < 4; ++d)
#pragma unroll
                for (int g = 0; g < 4; ++g) *(LAS f32x4*)(xq + 32 * d + 8 * g) = (f32x4){o[d][4 * g] * f, o[d][4 * g + 1] * f, o[d][4 * g + 2] * f, o[d][4 * g + 3] * f};
        }
        __syncthreads();
        if (role == 0) {
            float q = 0.f;
#pragma unroll
            for (int d = 0; d < 4; ++d)
#pragma unroll
                for (int g = 0; g < 4; ++g) { const f32x4 x2 = *(const LAS f32x4*)(xq + 32 * d + 8 * g);
#pragma unroll
                    for (int j = 0; j < 4; ++j) { const float v = o[d][4 * g + j] * inv - x2[j]; o[d][4 * g + j] = v; q += v * v; } }
            q += __shfl_xor(q, 32);
            const float rs = rsqrtf(q * (1.f / 128.f) + SUBLN_EPS) * (1.f - LAMBDA_INIT);
            const bf16_t* gp = PROJ + tok * NPROJ + PG_DF + hh * 128 + 4 * h;
            bf16_t* op = MIXED + tok * DM + 1024 + hh * 128 + 4 * h;
            const float* sg = subln_g + 4 * h;
#pragma unroll
            for (int d = 0; d < 4; ++d)
#pragma unroll
                for (int g = 0; g < 4; ++g) { const u32x2 gw = *(const u32x2*)(gp + 32 * d + 8 * g); const f32x4 sv = *(const f32x4*)(sg + 32 * d + 8 * g);
                    u32x2 ow; ow.x = cvt_pk(o[d][4 * g] * rs * sv[0] * bf_lo(gw.x), o[d][4 * g + 1] * rs * sv[1] * bf_hi(gw.x));
                    ow.y = cvt_pk(o[d][4 * g + 2] * rs * sv[2] * bf_lo(gw.y), o[d][4 * g + 3] * rs * sv[3] * bf_hi(gw.y));
                    *(u32x2*)(op + 32 * d + 8 * g) = ow; }
        }
    }
}
}
__device__ __forceinline__ int win_dst_row(int c) {
    const int seg = c >> 10, w = c & 1023, d6 = w & 63;
    const int wp = d6 < 16 ? (w & ~63) + (d6 < 8 ? 2 * d6 : 2 * (d6 - 8) + 1) : w;
    switch (seg) { case 0: return w; case 1: return 1024 + w; case 2: return 6144 + w; case 3: return 2048 + w;
                   case 4: return 3072 + wp; case 5: return 4096 + wp; case 6: return 7168 + w; default: return 5120 + w; }
}
template <bool WIN>
__device__ __forceinline__ void p0_transpose_item(const float* __restrict__ W, int K, int N, bf16_t* __restrict__ WT, const float* __restrict__ kscale, LAS float* scr, int item, int lane) {
    const int nblk = N / 32, kb = item / nblk, nb = item % nblk, k0 = 64 * kb, n0 = 32 * nb;
#pragma unroll 8
    for (int i = 0; i < 32; ++i) { const int kk = 2 * i + (lane >> 5); float v = W[(size_t)(k0 + kk) * N + n0 + (lane & 31)]; if (kscale) v *= kscale[k0 + kk]; scr[kk * 33 + (lane & 31)] = v; }
    asm volatile("s_waitcnt lgkmcnt(0)" ::: "memory");
    const int c = lane & 7;
#pragma unroll
    for (int j = 0; j < 4; ++j) { const int n = (lane >> 3) + 8 * j; const LAS float* s = scr + (8 * c) * 33 + n;
        u32x4 o; o.x = cvt_pk(s[0 * 33], s[1 * 33]); o.y = cvt_pk(s[2 * 33], s[3 * 33]); o.z = cvt_pk(s[4 * 33], s[5 * 33]); o.w = cvt_pk(s[6 * 33], s[7 * 33]);
        const int dn = WIN ? win_dst_row(n0 + n) : (n0 + n);
        *(u32x4*)(WT + (size_t)dn * K + k0 + 8 * c) = o; }
    asm volatile("s_waitcnt lgkmcnt(0)" ::: "memory");
}
__device__ __forceinline__ void rms_row_to_bf16(const float* __restrict__ xrow, const float* __restrict__ g, bf16_t* __restrict__ orow, int lane) {
    const f32x4* xr = (const f32x4*)xrow + lane; f32x4 v[8]; float s = 0.f;
#pragma unroll
    for (int j = 0; j < 8; ++j) { v[j] = xr[64 * j]; s += (v[j][0] * v[j][0] + v[j][1] * v[j][1]) + (v[j][2] * v[j][2] + v[j][3] * v[j][3]); }
    const float rstd = rsqrtf(wave_sum(s) * (1.f / DM) + NORM_EPS);
    const f32x4* gr = (const f32x4*)g + lane; u32x2* o8 = (u32x2*)orow + lane;
#pragma unroll
    for (int j = 0; j < 8; ++j) { const f32x4 gv = gr[64 * j]; u32x2 w; w.x = cvt_pk(v[j][0] * rstd * gv[0], v[j][1] * rstd * gv[1]); w.y = cvt_pk(v[j][2] * rstd * gv[2], v[j][3] * rstd * gv[3]); o8[64 * j] = w; }
}

struct Args { const float* in[14]; float* out; unsigned char* ws; };

__global__ void __launch_bounds__(512, 2) fwd_megakernel(Args a) {
    extern __shared__ __attribute__((aligned(16))) unsigned char lds_raw[];
    LAS unsigned char* lds = (LAS unsigned char*)lds_raw;
    cg::grid_group grid = cg::this_grid();
    const int tid = threadIdx.x, lane = tid & 63, wave = __builtin_amdgcn_readfirstlane(tid >> 6);
    const int G = gridDim.x, bx = blockIdx.x;
    const int vcu = (G % 8 == 0) ? (bx % 8) * (G / 8) + bx / 8 : bx;
    unsigned char* ws = a.ws;
    float* ss2 = (float*)(ws + WS_CTL + CTL_SS2); float* ss3 = (float*)(ws + WS_CTL + CTL_SS3); float* lamp = (float*)(ws + WS_CTL + CTL_LAM); float* rope = (float*)(ws + WS_CTL + CTL_ROPE);
    bf16_t* WIN = (bf16_t*)(ws + WS_WIN); bf16_t* WOUT = (bf16_t*)(ws + WS_WOUT); bf16_t* WGATE = (bf16_t*)(ws + WS_WGATE); bf16_t* WPROJ = (bf16_t*)(ws + WS_WPROJ);
    bf16_t* PB = (bf16_t*)(ws + WS_PB); bf16_t* XN = (bf16_t*)(ws + WS_XN); bf16_t* MIXED = (bf16_t*)(ws + WS_MIXED); bf16_t* PROJ = (bf16_t*)(ws + WS_PROJ);
    bf16_t* VT = (bf16_t*)(ws + WS_VT); bf16_t* HB = (bf16_t*)(ws + WS_HB); bf16_t* PLEB = (bf16_t*)(ws + WS_PLE);
    const float* x = a.in[0]; float* out = a.out;

    {
        const int gw = bx * 8 + wave, NGW = G * 8; const int gt = bx * 512 + tid, NGT = G * 512;
        for (int i = gt; i < 2 * NTOK; i += NGT) ss2[i] = 0.f;
        if (gt == 0) { float s1 = 0.f, s2 = 0.f; for (int i = 0; i < 64; ++i) { s1 += a.in[4][i] * a.in[5][i]; s2 += a.in[6][i] * a.in[7][i]; } lamp[0] = expf(s1) - expf(s2) + LAMBDA_INIT; }
        for (int i = gt; i < SEQ * 8; i += NGT) { const int pos = i >> 3, f = i & 7;
            const float invf = (float)exp2(-(double)f * 0.125 * 18.931568569324174);
            const float angf = (float)pos * invf;
            const double tw = 6.283185307179586476925; double ang = (double)angf; ang -= tw * rint(ang / tw);
            rope[2 * i] = (float)cos(ang); rope[2 * i + 1] = (float)sin(ang); }
        LAS float* scr = (LAS float*)(lds + wave * 16384);
        constexpr int I_IN = (DM / 64) * (8192 / 32), I_SQ = (DM / 64) * (DM / 32), I_PR = (PLE / 64) * (DM / 32);
        for (int it = gw; it < I_IN + 2 * I_SQ + I_PR; it += NGW) {
            int rr = it;
            if (rr < I_IN) { p0_transpose_item<true>(a.in[3], DM, 8192, WIN, nullptr, scr, rr, lane); continue; } rr -= I_IN;
            if (rr < I_SQ) { p0_transpose_item<false>(a.in[9], DM, DM, WOUT, nullptr, scr, rr, lane); continue; } rr -= I_SQ;
            if (rr < I_SQ) { p0_transpose_item<false>(a.in[11], DM, DM, WGATE, a.in[10], scr, rr, lane); continue; } rr -= I_SQ;
            p0_transpose_item<false>(a.in[12], PLE, DM, WPROJ, nullptr, scr, rr, lane);
        }
        for (int m = gw; m < NTOK; m += NGW) rms_row_to_bf16(x + (size_t)m * DM, a.in[2], XN + (size_t)m * DM, lane);
        for (int i = gt; i < NTOK * PLE / 8; i += NGT) { const f32x4 v0 = ((const f32x4*)a.in[1])[2 * i], v1 = ((const f32x4*)a.in[1])[2 * i + 1];
            u32x4 w; w.x = cvt_pk(v0[0], v0[1]); w.y = cvt_pk(v0[2], v0[3]); w.z = cvt_pk(v1[0], v1[1]); w.w = cvt_pk(v1[2], v1[3]); ((u32x4*)PB)[i] = w; }
    }
    grid.sync();
    {
        { pg8::Gemm g{XN, WIN, NTOK, NPROJ, DM}; pg8::StaticOrder S; S.init(NTOK, NPROJ, G, bx); pg8::EpiProj E{PROJ, rope};
          pg8::gemm_phase<pg8::EpiProj, pg8::StaticOrder, true, true>(lds, g, S, E); }
        __syncthreads();
        { pg8::Gemm g{WIN + (size_t)NPROJ * DM, XN, 2048, NTOK, DM}; pg8::StaticOrder S; S.init(2048, NTOK, G, bx); pg8::EpiBf16 E{VT, NTOK};
          pg8::gemm_phase<pg8::EpiBf16, pg8::StaticOrder, true, true>(lds, g, S, E); }
    }
    grid.sync();
    {
        const float lam = lamp[0];
        for (int su = vcu; su < 256; su += G) {
            const int bh = su >> 2, s = su & 3;
#pragma unroll 1
            for (int k = 0; k < 4; ++k) { const int qb = (k == 0) ? s : (k == 1) ? 7 - s : (k == 2) ? 8 + s : 15 - s;
                att::attn_unit<1>(lds, PROJ, VT, MIXED, bh >> 3, bh & 7, qb, lam, a.in[8]); }
        }
#pragma unroll 1
        for (int u = vcu; u < 512; u += G) att::attn_unit<0>(lds, PROJ, VT, MIXED, (u >> 3) >> 3, (u >> 3) & 7, u & 7, lam, a.in[8]);
    }
    grid.sync();
    {
        __syncthreads();
        { pg8::Gemm g{MIXED, WOUT, NTOK, DM, DM}; pg8::StaticOrder S; S.init(NTOK, DM, G, bx); pg8::EpiRes E{x, out, HB, ss2};
          pg8::gemm_phase<pg8::EpiRes, pg8::StaticOrder, true, true>(lds, g, S, E); }
        __syncthreads();
        { pg8::Gemm g{PB, WPROJ, NTOK, DM, PLE}; pg8::StaticOrder S; S.init(NTOK, DM, G, bx); pg8::EpiBf16 E{PLEB, DM};
          pg8::gemm_phase<pg8::EpiBf16, pg8::StaticOrder, true, true>(lds, g, S, E); }
    }
    grid.sync();
    {
        pg8::Gemm g{HB, WGATE, NTOK, DM, DM}; pg8::StaticOrder S; S.init(NTOK, DM, G, bx); pg8::EpiGate E{out, PLEB, ss2, ss3};
        pg8::gemm_phase<pg8::EpiGate, pg8::StaticOrder, true, true>(lds, g, S, E);
    }
    grid.sync();
    {
        const int gw = bx * 8 + wave, NGW = G * 8; const f32x4* gr = (const f32x4*)a.in[13] + lane;
        for (int m = gw; m < NTOK; m += NGW) { const float rstd = rsqrtf(ss3[m] * (1.f / DM) + NORM_EPS); f32x4* orow = (f32x4*)(out + (size_t)m * DM) + lane;
#pragma unroll
            for (int j = 0; j < 8; ++j) { const f32x4 v = orow[64 * j], gv = gr[64 * j]; orow[64 * j] = v * rstd * gv; } }
    }
}

extern "C" void kernel_launch(void* const* d_in, const int* in_sizes, int n_in, void* d_out, int out_size, void* d_ws, size_t ws_size, hipStream_t stream) {
    static int grid = 0;
    if (grid == 0) {
        if (n_in != 14 || out_size != NTOK * DM || ws_size < WS_END) { fprintf(stderr, "kernel_launch: unexpected shapes (n_in %d out %d ws %zu)\n", n_in, out_size, ws_size); grid = -1; return; }
        int dev = 0, cus = 0, per_cu = 0;
        (void)hipGetDevice(&dev); (void)hipDeviceGetAttribute(&cus, hipDeviceAttributeMultiprocessorCount, dev);
        (void)hipFuncSetAttribute((const void*)fwd_megakernel, hipFuncAttributeMaxDynamicSharedMemorySize, LDS_BYTES);
        (void)hipOccupancyMaxActiveBlocksPerMultiprocessor(&per_cu, (const void*)fwd_megakernel, 512, LDS_BYTES);
        if (per_cu < 1) { fprintf(stderr, "kernel_launch: occupancy query says %d blocks/CU\n", per_cu); per_cu = 1; }
        grid = cus * per_cu;
    }
    if (grid < 0) return;
    Args a{};
    for (int i = 0; i < 14; ++i) a.in[i] = (const float*)d_in[i];
    a.out = (float*)d_out; a.ws = (unsigned char*)d_ws;
    void* args[] = {&a};
    hipError_t e = hipLaunchCooperativeKernel((void*)fwd_megakernel, dim3(grid), dim3(512), args, LDS_BYTES, stream);
    if (e != hipSuccess) fprintf(stderr, "cooperative launch failed: %s (grid %d)\n", hipGetErrorString(e), grid);
}
```

```cpp
#include <hip/hip_runtime.h>
#include <hip/hip_cooperative_groups.h>
#include <cstdio>
#include <cstdint>
namespace cg = cooperative_groups;
#ifndef PROBE_DUP
#define PROBE_DUP 0
#endif
namespace pg8 {
#define PG8_LAS __attribute__((address_space(3)))
typedef unsigned short bf16_t;
typedef short bf16x8 __attribute__((ext_vector_type(8)));
typedef float f32x4 __attribute__((ext_vector_type(4)));
typedef unsigned u32x4 __attribute__((ext_vector_type(4)));
constexpr int BM = 256, BK = 64, HALF = 128, HTB = HALF * BK * 2  , STAGE_BYTES = 8 * HTB, NXCD = 8, WGM = 8;

__host__ __device__ __forceinline__ int lds_byte(int r, int c) { const int st = (r >> 4) * 2 + (c >> 5), rr = r & 15, cc = c & 31, ob = rr * 64 + cc * 2; return st * 1024 + (ob ^ (((ob >> 9) & 1) << 5)); }
__host__ __device__ __forceinline__ void stage_rc(int b, int& R, int& C) { const int st = b / 1024, sb = b % 1024, swz = sb ^ (((sb >> 9) & 1) << 5); R = (st >> 1) * 16 + swz / 64; C = (st & 1) * 32 + (swz % 64) / 2; }
__host__ __device__ __forceinline__ int perm32(int rho) { const int n = rho >> 4, i = rho & 15; return 8 * (i >> 2) + 4 * n + (i & 3); }

struct Unit { int pm, pn; };
struct Gemm { const bf16_t* A; const bf16_t* Bt; int M, N, K; };

struct StaticOrder {
    int nM, nN, nwg, G, c;
    __host__ __device__ void init(int M, int N, int G_, int c_) { nM = M / BM; nN = N / BM; nwg = nM * nN; G = G_; c = c_; }
    __host__ __device__ bool next(int i, Unit& u) const {
        const long L = (long)i * G + c; if (L >= nwg) return false;
        int wgid = (int)L; { const int q = nwg / NXCD, r = nwg % NXCD, xcd = wgid % NXCD, off = wgid / NXCD; wgid = (xcd < r ? xcd * (q + 1) : r * (q + 1) + (xcd - r) * q) + off; }
        const int nig = WGM * nN, gid = wgid / nig, fm = gid * WGM, gsz = (nM - fm) < WGM ? (nM - fm) : WGM;
        u.pm = fm + ((wgid % nig) % gsz); u.pn = (wgid % nig) / gsz; return true;
    }
    __device__ __forceinline__ void a_ready(const Unit&) const {}
    __device__ __forceinline__ void done(const Unit&) const {}
};

__device__ __forceinline__ unsigned cvt_pk_bf16(float lo, float hi) { unsigned r; asm volatile("v_cvt_pk_bf16_f32 %0, %1, %2" : "=v"(r) : "v"(lo), "v"(hi)); return r; }
typedef float f32x2 __attribute__((ext_vector_type(2)));
template <class Epi, class Sched, bool ALIGN_EPI = false, bool SP2 = false>
__device__ __forceinline__ void gemm_phase(PG8_LAS unsigned char* lds, const Gemm g, const Sched& S, const Epi& E) {
    const int tid = threadIdx.x, wid = __builtin_amdgcn_readfirstlane(tid >> 6), lane = tid & 63, wr = wid >> 2, wc = wid & 3, fr = lane & 15, fq = lane >> 4;
    const int K = g.K, nt = K / BK;
    unsigned voffA[2], voffB[2];
#pragma unroll
    for (int i = 0; i < 2; ++i) { int R, C; stage_rc(tid * 16 + i * 8192, R, C); const int Rb = Epi::PERM ? ((R & ~31) + perm32(R & 31)) : R;
        voffA[i] = (unsigned)(R * K + C) * 2u; voffB[i] = (unsigned)(Rb * K + C) * 2u; }
    const size_t kstep = (size_t)(BK * 2);
    const size_t hstep = (size_t)HALF * K * 2;
    const size_t tstep = 2 * hstep;
    const unsigned ldsw = (unsigned)wid * 1024u;
    const int aoff = lds_byte(wr * 64 + fr, fq * 8), boff = lds_byte(wc * 32 + fr, fq * 8);
#define PG8_SA(b, h) (((b) * 2 + (h)) * HTB)
#define PG8_SB(b, h) ((4 + (b) * 2 + (h)) * HTB)
#define PG8_STAGE(bufoff, gbase, voff) do { _Pragma("unroll") for (int _i = 0; _i < 2; ++_i) \
        __builtin_amdgcn_global_load_lds((const unsigned*)((const char*)(gbase) + (voff)[_i]), (PG8_LAS unsigned*)(lds + (bufoff) + ldsw + _i * 8192), 16, 0, 0); } while (0)
#define PG8_LDA(dst, b, h) do { _Pragma("unroll") for (int m = 0; m < 4; ++m) _Pragma("unroll") for (int k = 0; k < 2; ++k) dst[m][k] = *(const PG8_LAS bf16x8*)(lds + PG8_SA(b, h) + aoff + m * 2048 + k * 1024); } while (0)
#define PG8_LDB(dst, b, h) do { _Pragma("unroll") for (int n = 0; n < 2; ++n) _Pragma("unroll") for (int k = 0; k < 2; ++k) dst[n][k] = *(const PG8_LAS bf16x8*)(lds + PG8_SB(b, h) + boff + n * 2048 + k * 1024); } while (0)
#define PG8_MMA(ai, bj, At, Bt) do { __builtin_amdgcn_s_setprio(1); _Pragma("unroll") for (int m = 0; m < 4; ++m) _Pragma("unroll") for (int n = 0; n < 2; ++n) _Pragma("unroll") for (int k = 0; k < 2; ++k) \
        acc[ai][bj][m][n] = __builtin_amdgcn_mfma_f32_16x16x32_bf16(Bt[n][k], At[m][k], acc[ai][bj][m][n], 0, 0, 0); __builtin_amdgcn_s_setprio(0); } while (0)
#define PG8_WAIT_V(n) asm volatile("s_waitcnt vmcnt(" #n ")" ::: "memory")
#define PG8_WAIT_L(n) asm volatile("s_waitcnt lgkmcnt(" #n ")" ::: "memory")
#define PG8_BAR __builtin_amdgcn_s_barrier()
#define PG8_SCHED __builtin_amdgcn_sched_barrier(0)
    Unit cur, nxt; int ui = 0;
    if (!S.next(0, cur)) return;
    f32x4 acc[2][2][4][2];
#pragma unroll
    for (int a = 0; a < 2; ++a)
#pragma unroll
        for (int b = 0; b < 2; ++b)
#pragma unroll
            for (int m = 0; m < 4; ++m)
#pragma unroll
                for (int n = 0; n < 2; ++n) acc[a][b][m][n] = (f32x4){0.f, 0.f, 0.f, 0.f};
    bf16x8 At[4][2], B0[2][2], B1[2][2];
    const char* cA = (const char*)g.A + (size_t)cur.pm * tstep; const char* cB = (const char*)g.Bt + (size_t)cur.pn * tstep;
    S.a_ready(cur);
    if constexpr (SP2) {
        PG8_STAGE(PG8_SB(0, 0), cB, voffB); PG8_STAGE(PG8_SB(0, 1), cB + hstep, voffB); PG8_STAGE(PG8_SA(0, 0), cA, voffA); PG8_STAGE(PG8_SA(0, 1), cA + hstep, voffA);
        if (wr == 1) PG8_BAR;
        PG8_WAIT_V(2); PG8_BAR;
        PG8_STAGE(PG8_SB(1, 0), cB + kstep, voffB); PG8_STAGE(PG8_SA(1, 0), cA + kstep, voffA); PG8_STAGE(PG8_SB(1, 1), cB + hstep + kstep, voffB);
        PG8_WAIT_V(6); PG8_BAR;
    } else {
        PG8_STAGE(PG8_SB(0, 0), cB, voffB); PG8_STAGE(PG8_SA(0, 0), cA, voffA); PG8_STAGE(PG8_SB(0, 1), cB + hstep, voffB); PG8_STAGE(PG8_SA(0, 1), cA + hstep, voffA);
        if (wr == 1) PG8_BAR;
        PG8_WAIT_V(4); PG8_BAR;
        PG8_STAGE(PG8_SB(1, 0), cB + kstep, voffB); PG8_STAGE(PG8_SA(1, 0), cA + kstep, voffA); PG8_STAGE(PG8_SB(1, 1), cB + hstep + kstep, voffB);
        PG8_WAIT_V(6); PG8_BAR;
    }
    for (;;) {
        const bool has_next = S.next(ui + 1, nxt);
        const char* nA = has_next ? (const char*)g.A + (size_t)nxt.pm * tstep : cA; const char* nB = has_next ? (const char*)g.Bt + (size_t)nxt.pn * tstep : cB;
        for (int t = 0; t < nt; t += 2) {
            const bool last = (t == nt - 2);
            const char* a1 = cA + (size_t)(t + 1) * kstep;
            const char* a2 = last ? nA : cA + (size_t)(t + 2) * kstep; const char* b2 = last ? nB : cB + (size_t)(t + 2) * kstep;
            const char* a3 = a2 + kstep; const char* b3 = b2 + kstep;
            if (last && has_next) S.a_ready(nxt);
            if constexpr (SP2) {
            PG8_LDB(B0, 0, 0); PG8_LDB(B1, 0, 1); PG8_SCHED; PG8_LDA(At, 0, 0); PG8_STAGE(PG8_SA(1, 1), a1 + hstep, voffA);
            PG8_WAIT_V(8); PG8_WAIT_L(0); PG8_BAR; PG8_MMA(0, 0, At, B0); PG8_MMA(0, 1, At, B1); PG8_BAR; PG8_SCHED;
            PG8_LDA(At, 0, 1); PG8_STAGE(PG8_SB(0, 0), b2, voffB); PG8_STAGE(PG8_SB(0, 1), b2 + hstep, voffB); PG8_STAGE(PG8_SA(0, 0), a2, voffA);
            PG8_WAIT_V(8); PG8_WAIT_L(0); PG8_BAR; PG8_MMA(1, 0, At, B0); PG8_MMA(1, 1, At, B1); PG8_BAR; PG8_SCHED;
            PG8_LDB(B0, 1, 0); PG8_LDB(B1, 1, 1); PG8_SCHED; PG8_LDA(At, 1, 0); PG8_STAGE(PG8_SA(0, 1), a2 + hstep, voffA);
            PG8_WAIT_V(8); PG8_WAIT_L(0); PG8_BAR; PG8_MMA(0, 0, At, B0); PG8_MMA(0, 1, At, B1); PG8_BAR; PG8_SCHED;
            PG8_LDA(At, 1, 1); PG8_STAGE(PG8_SB(1, 0), b3, voffB); PG8_STAGE(PG8_SB(1, 1), b3 + hstep, voffB); PG8_STAGE(PG8_SA(1, 0), a3, voffA);
            PG8_WAIT_V(8); PG8_WAIT_L(0); PG8_BAR; PG8_MMA(1, 0, At, B0); PG8_MMA(1, 1, At, B1); PG8_BAR; PG8_SCHED;
            } else {
            PG8_LDB(B0, 0, 0); PG8_SCHED; PG8_LDA(At, 0, 0); PG8_STAGE(PG8_SA(1, 1), a1 + hstep, voffA);
            PG8_WAIT_L(8); PG8_BAR; PG8_WAIT_L(0); PG8_MMA(0, 0, At, B0); PG8_BAR; PG8_SCHED;
            PG8_LDB(B1, 0, 1); PG8_STAGE(PG8_SB(0, 0), b2, voffB);
            PG8_BAR; PG8_WAIT_L(0); PG8_MMA(0, 1, At, B1); PG8_BAR;
            PG8_LDA(At, 0, 1); PG8_STAGE(PG8_SA(0, 0), a2, voffA);
            PG8_BAR; PG8_WAIT_L(0); PG8_MMA(1, 0, At, B0); PG8_BAR; PG8_SCHED;
            PG8_STAGE(PG8_SB(0, 1), b2 + hstep, voffB);
            PG8_WAIT_V(6); PG8_BAR; PG8_MMA(1, 1, At, B1); PG8_BAR;
            PG8_LDB(B0, 1, 0); PG8_SCHED; PG8_LDA(At, 1, 0); PG8_STAGE(PG8_SA(0, 1), a2 + hstep, voffA);
            PG8_WAIT_L(8); PG8_BAR; PG8_WAIT_L(0); PG8_MMA(0, 0, At, B0); PG8_BAR; PG8_SCHED;
            PG8_LDB(B1, 1, 1); PG8_STAGE(PG8_SB(1, 0), b3, voffB);
            PG8_BAR; PG8_WAIT_L(0); PG8_MMA(0, 1, At, B1); PG8_BAR;
            PG8_LDA(At, 1, 1); PG8_STAGE(PG8_SA(1, 0), a3, voffA);
            PG8_BAR; PG8_WAIT_L(0); PG8_MMA(1, 0, At, B0); PG8_BAR; PG8_SCHED;
            PG8_STAGE(PG8_SB(1, 1), b3 + hstep, voffB);
            PG8_WAIT_V(6); PG8_BAR; PG8_MMA(1, 1, At, B1); PG8_BAR;
            }
        }
        if constexpr (ALIGN_EPI) { if (wr == 0) PG8_BAR; }
        if constexpr (!Epi::AFTER_DRAIN) { E(acc, cur, wr, wc, fr, fq); S.done(cur); }
        if (!has_next) break;
#pragma unroll
        for (int a = 0; a < 2; ++a)
#pragma unroll
            for (int b = 0; b < 2; ++b)
#pragma unroll
                for (int m = 0; m < 4; ++m)
#pragma unroll
                    for (int n = 0; n < 2; ++n) acc[a][b][m][n] = (f32x4){0.f, 0.f, 0.f, 0.f};
        cur = nxt; cA = nA; cB = nB; ++ui;
        if constexpr (ALIGN_EPI) { if (wr == 1) PG8_BAR; }
    }
    PG8_WAIT_V(0);
    if constexpr (!ALIGN_EPI) { if (wr == 0) PG8_BAR; }
    PG8_BAR;
    if constexpr (Epi::AFTER_DRAIN) { E.fused(acc, cur, wr, wc, fr, fq, lds, wid, lane); S.done(cur); }
#undef PG8_SA
#undef PG8_SB
#undef PG8_STAGE
#undef PG8_LDA
#undef PG8_LDB
#undef PG8_MMA
#undef PG8_WAIT_V
#undef PG8_WAIT_L
#undef PG8_BAR
#undef PG8_SCHED
}
}
#define LAS __attribute__((address_space(3)))
typedef unsigned short bf16_t;
typedef short bf16x8 __attribute__((ext_vector_type(8)));
typedef float f32x4 __attribute__((ext_vector_type(4)));
typedef float f32x2 __attribute__((ext_vector_type(2)));
typedef float f32x16 __attribute__((ext_vector_type(16)));
typedef unsigned u32x4 __attribute__((ext_vector_type(4)));
typedef unsigned u32x2 __attribute__((ext_vector_type(2)));

constexpr int NTOK = 16384, DM = 2048, SEQ = 2048, NBATCH = 8, PLE = 256;
constexpr int NPROJ = 6144;
constexpr int PQ_SB = 0, PK_SB = 1024, PG_SB = 2048, PQ_DF = 3072, PK_DF = 4096, PG_DF = 5120;
constexpr float LOG2E = 1.4426950408889634f;
constexpr float SBQ_SCALE = 0.08838834764831845f * LOG2E;
constexpr float DFQ_SCALE = 0.125f * LOG2E;
constexpr float NORM_EPS = 1e-6f, SUBLN_EPS = 1e-5f;
constexpr float LAMBDA_INIT = 0.2f;

constexpr size_t MiB = 1u << 20;
constexpr size_t WS_CTL = 0;
constexpr size_t CTL_SS2 = 0, CTL_SS3 = 65536, CTL_LAM = 131072, CTL_ROPE = 262144;
constexpr size_t WS_WIN = 2 * MiB, WS_WOUT = 34 * MiB, WS_WGATE = 42 * MiB, WS_WPROJ = 50 * MiB, WS_PB = 52 * MiB;
constexpr size_t WS_XN = 64 * MiB, WS_MIXED = 64 * MiB;
constexpr size_t WS_PROJ = 128 * MiB, WS_VT = 320 * MiB, WS_END = 384 * MiB;
constexpr size_t WS_HB = 128 * MiB, WS_PLE = 192 * MiB;
constexpr size_t WS_H2B = 64 * MiB;

constexpr int LDS_BYTES = 131072 + 1024;

__device__ __forceinline__ unsigned cvt_pk(float lo, float hi) { unsigned r; asm volatile("v_cvt_pk_bf16_f32 %0, %1, %2" : "=v"(r) : "v"(lo), "v"(hi)); return r; }
__device__ __forceinline__ float bf_lo(unsigned w) { return __uint_as_float(w << 16); }
__device__ __forceinline__ float bf_hi(unsigned w) { return __uint_as_float(w & 0xffff0000u); }
__device__ __forceinline__ float wave_sum(float v) {
#pragma unroll
    for (int o = 1; o < 64; o <<= 1) v += __shfl_xor(v, o);
    return v;
}
__device__ __forceinline__ float fast_exp2(float x) { return __builtin_amdgcn_exp2f(x); }
__device__ __forceinline__ float fast_log2(float x) { return __builtin_amdgcn_logf(x); }
__device__ __forceinline__ float silu_f(float x) { return x * __builtin_amdgcn_rcpf(1.f + fast_exp2(-x * LOG2E)); }
__device__ __forceinline__ float sigmoid_f(float x) { return __builtin_amdgcn_rcpf(1.f + fast_exp2(-x * LOG2E)); }

namespace pg8 {
struct EpiBf16 {
    static constexpr bool PERM = true, AFTER_DRAIN = false;
    bf16_t* O; int ldc;
    __device__ __forceinline__ void operator()(const f32x4 (&acc)[2][2][4][2], const Unit& u, int wr, int wc, int fr, int fq) const {
        const int row0 = u.pm * BM + wr * 64 + fr; const int col0 = u.pn * BM + wc * 32 + 8 * fq;
#pragma unroll
        for (int ai = 0; ai < 2; ++ai)
#pragma unroll
            for (int m = 0; m < 4; ++m) { bf16_t* rowp = O + (size_t)(row0 + ai * HALF + m * 16) * ldc + col0;
#pragma unroll
                for (int bj = 0; bj < 2; ++bj) { const f32x4 v0 = acc[ai][bj][m][0], v1 = acc[ai][bj][m][1];
                    u32x4 w; w.x = cvt_pk_bf16(v0[0], v0[1]); w.y = cvt_pk_bf16(v0[2], v0[3]); w.z = cvt_pk_bf16(v1[0], v1[1]); w.w = cvt_pk_bf16(v1[2], v1[3]);
                    *(u32x4*)(rowp + bj * HALF) = w; } }
    }
};
struct EpiProj {
    static constexpr bool PERM = true, AFTER_DRAIN = false;
    bf16_t* O; const float* rope;
    __device__ __forceinline__ void operator()(const f32x4 (&acc)[2][2][4][2], const Unit& u, int wr, int wc, int fr, int fq) const {
        const int row0 = u.pm * BM + wr * 64 + fr; const int col0 = u.pn * BM + wc * 32 + 8 * fq;
        const int kind = u.pn >> 2;
        const bool dorope = (kind == 3 || kind == 4) && ((wc & 1) == 0) && (fq < 2);
        const float sc = kind == 0 ? SBQ_SCALE : (kind == 3 ? DFQ_SCALE : 1.f);
        const bool dosilu = (kind == 2 || kind == 5);
#pragma unroll
        for (int ai = 0; ai < 2; ++ai)
#pragma unroll
            for (int m = 0; m < 4; ++m) { const int row = row0 + ai * HALF + m * 16; bf16_t* rowp = O + (size_t)row * NPROJ + col0;
                f32x4 cs0 = {1.f, 0.f, 1.f, 0.f}, cs1 = {1.f, 0.f, 1.f, 0.f};
                if (dorope) { const f32x4* rp = (const f32x4*)(rope + ((size_t)(row & (SEQ - 1)) * 8 + 4 * fq) * 2); cs0 = rp[0]; cs1 = rp[1]; }
#pragma unroll
                for (int bj = 0; bj < 2; ++bj) { f32x4 v0 = acc[ai][bj][m][0], v1 = acc[ai][bj][m][1];
                    if (dorope) {
                        f32x4 a, b;
                        a[0] = v0[0] * cs0[0] - v0[1] * cs0[1]; a[1] = v0[1] * cs0[0] + v0[0] * cs0[1];
                        a[2] = v0[2] * cs0[2] - v0[3] * cs0[3]; a[3] = v0[3] * cs0[2] + v0[2] * cs0[3];
                        b[0] = v1[0] * cs1[0] - v1[1] * cs1[1]; b[1] = v1[1] * cs1[0] + v1[0] * cs1[1];
                        b[2] = v1[2] * cs1[2] - v1[3] * cs1[3]; b[3] = v1[3] * cs1[2] + v1[2] * cs1[3];
                        v0 = a; v1 = b; }
                    if (dosilu) {
#pragma unroll
                        for (int j = 0; j < 4; ++j) { v0[j] = silu_f(v0[j]); v1[j] = silu_f(v1[j]); } }
                    v0 = v0 * sc; v1 = v1 * sc;
                    u32x4 w; w.x = cvt_pk_bf16(v0[0], v0[1]); w.y = cvt_pk_bf16(v0[2], v0[3]); w.z = cvt_pk_bf16(v1[0], v1[1]); w.w = cvt_pk_bf16(v1[2], v1[3]);
                    *(u32x4*)(rowp + bj * HALF) = w; } }
    }
};
struct EpiRes {
    static constexpr bool PERM = false, AFTER_DRAIN = false;
    const float* x; bf16_t* hb; float* ss;
    __device__ __forceinline__ void operator()(const f32x4 (&acc)[2][2][4][2], const Unit& u, int wr, int wc, int fr, int fq) const {
        const int row0 = u.pm * BM + wr * 64 + fr; const int col0 = u.pn * BM + wc * 32 + 4 * fq;
#pragma unroll
        for (int ai = 0; ai < 2; ++ai)
#pragma unroll
            for (int m = 0; m < 4; ++m) { const int row = row0 + ai * HALF + m * 16; const size_t off = (size_t)row * DM + col0; float q = 0.f;
#pragma unroll
                for (int bj = 0; bj < 2; ++bj)
#pragma unroll
                    for (int n = 0; n < 2; ++n) { const size_t o2 = off + bj * HALF + n * 16; const f32x4 hv = *(const f32x4*)(x + o2) + acc[ai][bj][m][n];
                        u32x2 w; w.x = cvt_pk_bf16(hv[0], hv[1]); w.y = cvt_pk_bf16(hv[2], hv[3]); *(u32x2*)(hb + o2) = w;
                        q += (hv[0] * hv[0] + hv[1] * hv[1]) + (hv[2] * hv[2] + hv[3] * hv[3]); }
                q += __shfl_xor(q, 16); q += __shfl_xor(q, 32);
                if (fq == 0) atomicAdd(ss + row, q); }
    }
};
struct EpiGate {
    static constexpr bool PERM = false, AFTER_DRAIN = false;
    const bf16_t* hb; bf16_t* h2b; const bf16_t* ple; const float* ss2; float* ss3;
    __device__ __forceinline__ void operator()(const f32x4 (&acc)[2][2][4][2], const Unit& u, int wr, int wc, int fr, int fq) const {
        const int row0 = u.pm * BM + wr * 64 + fr; const int col0 = u.pn * BM + wc * 32 + 4 * fq;
#pragma unroll
        for (int ai = 0; ai < 2; ++ai)
#pragma unroll
            for (int m = 0; m < 4; ++m) { const int row = row0 + ai * HALF + m * 16; const size_t off = (size_t)row * DM + col0; float q = 0.f;
                const float rstd = rsqrtf(ss2[row] * (1.f / DM) + NORM_EPS);
#pragma unroll
                for (int bj = 0; bj < 2; ++bj)
#pragma unroll
                    for (int n = 0; n < 2; ++n) { const size_t o2 = off + bj * HALF + n * 16; const u32x2 hw = *(const u32x2*)(hb + o2); const f32x4 hv = {bf_lo(hw.x), bf_hi(hw.x), bf_lo(hw.y), bf_hi(hw.y)}; const u32x2 pw = *(const u32x2*)(ple + o2);
                        const f32x4 a = acc[ai][bj][m][n] * rstd; f32x4 h2;
                        h2[0] = hv[0] + sigmoid_f(a[0]) * bf_lo(pw.x); h2[1] = hv[1] + sigmoid_f(a[1]) * bf_hi(pw.x);
                        h2[2] = hv[2] + sigmoid_f(a[2]) * bf_lo(pw.y); h2[3] = hv[3] + sigmoid_f(a[3]) * bf_hi(pw.y);
                        u32x2 w2; w2.x = cvt_pk_bf16(h2[0], h2[1]); w2.y = cvt_pk_bf16(h2[2], h2[3]); *(u32x2*)(h2b + o2) = w2;
                        q += (h2[0] * h2[0] + h2[1] * h2[1]) + (h2[2] * h2[2] + h2[3] * h2[3]); }
                q += __shfl_xor(q, 16); q += __shfl_xor(q, 32);
                if (fq == 0) atomicAdd(ss3 + row, q); }
    }
};
}
namespace att {
constexpr int KP = 272, VP = 144, KT_BYTES = 64 * KP, VT_BYTES = 128 * VP, BUF_BYTES = KT_BYTES + VT_BYTES;
constexpr int FLAG_OFF = 2 * BUF_BYTES;
constexpr int XP = 132;
constexpr float R_DONE = 152.0f;

template <int MODE>
__device__ __forceinline__ void attn_unit(LAS unsigned char* lds, const bf16_t* __restrict__ PROJ, const bf16_t* __restrict__ VT, bf16_t* __restrict__ MIXED,
                                          int b, int hh, int qblk, float lam, const float* __restrict__ subln_g) {
    constexpr int QB = MODE == 0 ? 256 : 128;
    constexpr int NKS = MODE == 0 ? 8 : 4;
    const int tid = threadIdx.x, lane = tid & 63, r = lane & 31, h = lane >> 5;
    const int wid = __builtin_amdgcn_readfirstlane(tid >> 6);
    const int qg = MODE == 0 ? wid : (wid & 3), role = MODE == 0 ? 0 : (wid >> 2);
    const int Q0 = qblk * QB, q0w = Q0 + 32 * qg, tq = q0w + r;
    const size_t tokbase = (size_t)b * SEQ;
    const bf16_t* Kg = PROJ + tokbase * NPROJ + (MODE == 0 ? PK_SB : PK_DF) + hh * 128;
    const bf16_t* Vg = VT + (size_t)((MODE == 0 ? 0 : 1024) + hh * 128) * NTOK + tokbase;
    bf16x8 qf[NKS];
    { const bf16_t* qp = PROJ + (tokbase + tq) * NPROJ + (MODE == 0 ? PQ_SB + hh * 128 : PQ_DF + hh * 128 + role * 64) + 8 * h;
#pragma unroll
      for (int ks = 0; ks < NKS; ++ks) qf[ks] = *(const bf16x8*)(qp + 16 * ks); }
    f32x16 o[4];
#pragma unroll
    for (int d = 0; d < 4; ++d)
#pragma unroll
        for (int i = 0; i < 16; ++i) o[d][i] = 0.f;
    float R = 0.f, m_run = -1e30f, l_run = 0.f;
    const int kr0 = tid >> 4, kc = tid & 15, vr0 = tid >> 3, vc = tid & 7;
    const int vpos0 = 16 * (vc >> 1) + ((vc & 1) ? 4 : 0), vpos1 = 16 * (vc >> 1) + ((vc & 1) ? 12 : 8);
    const int kst = kr0 * KP + kc * 16, vst0 = KT_BYTES + vr0 * VP + vpos0 * 2, vst1 = KT_BYTES + vr0 * VP + vpos1 * 2;
    const bf16_t* kgl = Kg + (size_t)kr0 * NPROJ + kc * 8;
    const bf16_t* vgl = Vg + (size_t)vr0 * NTOK + vc * 8;
    u32x4 kreg[2], vreg[2];
#define ATT_LOAD(t) do { _Pragma("unroll") for (int i_ = 0; i_ < 2; ++i_) { \
        kreg[i_] = *(const u32x4*)(kgl + (size_t)((t) * 64 + 32 * i_) * NPROJ); \
        vreg[i_] = *(const u32x4*)(vgl + (size_t)(64 * i_) * NTOK + (t) * 64); } } while (0)
#define ATT_STORE(bo) do { _Pragma("unroll") for (int i_ = 0; i_ < 2; ++i_) { \
        *(LAS u32x4*)(lds + (bo) + kst + i_ * 32 * KP) = kreg[i_]; \
        *(LAS u32x2*)(lds + (bo) + vst0 + i_ * 64 * VP) = (u32x2){vreg[i_].x, vreg[i_].y}; \
        *(LAS u32x2*)(lds + (bo) + vst1 + i_ * 64 * VP) = (u32x2){vreg[i_].z, vreg[i_].w}; } } while (0)
    const int tl = (Q0 + QB - 1) >> 6;
    const int kfrag = r * KP + (role * 64 + 8 * h) * 2;
    const int vfrag = KT_BYTES + r * VP + (8 * h) * 2;
    volatile LAS int* flags = (volatile LAS int*)(lds + FLAG_OFF);
    __syncthreads();
    ATT_LOAD(tl); ATT_STORE(0);
    __syncthreads();
    int cur = 0, it = 0;
    bool wdone = false;
    for (int t = tl;; --t, ++it) {
        if (t > 0) ATT_LOAD(t - 1);
        const int k0 = 64 * t;
        const bool active = (MODE == 0) ? (!wdone && k0 <= q0w + 30) : (k0 <= q0w + 31);
        if (active) {
            const int bo = cur * BUF_BYTES;
            f32x16 s[2];
#pragma unroll
            for (int kb = 0; kb < 2; ++kb) {
#pragma unroll
                for (int i = 0; i < 16; ++i) s[kb][i] = 0.f;
#pragma unroll
                for (int ks = 0; ks < NKS; ++ks) {
                    const bf16x8 a = *(const LAS bf16x8*)(lds + bo + kfrag + kb * 32 * KP + ks * 32);
                    s[kb] = __builtin_amdgcn_mfma_f32_32x32x16_bf16(a, qf[ks], s[kb], 0, 0, 0);
                }
            }
            bf16x8 pf[2][2];
            if (MODE == 0) {
#pragma unroll
                for (int kbi = 0; kbi < 2; ++kbi) {
                    const int kb = 1 - kbi;
                    const int kbase = k0 + 32 * kb + 4 * h;
                    float c[16]; bool ok[16];
#pragma unroll
                    for (int i = 0; i < 16; ++i) {
                        const int key = kbase + 8 * (i >> 2) + (i & 3);
                        ok[i] = key < tq;
                        const float z = s[kb][i];
                        const float spv = fmaxf(z, 0.f) + fast_log2(1.f + fast_exp2(-fabsf(z)));
                        c[i] = ok[i] ? spv : 0.f;
                    }
                    float T[4], OT[4], pr[4], suf[4];
#pragma unroll
                    for (int g = 0; g < 4; ++g) { c[4 * g + 2] += c[4 * g + 3]; c[4 * g + 1] += c[4 * g + 2]; c[4 * g] += c[4 * g + 1]; T[g] = c[4 * g]; }
#pragma unroll
                    for (int g = 0; g < 4; ++g) { OT[g] = __shfl_xor(T[g], 32); pr[g] = T[g] + OT[g]; }
                    suf[3] = 0.f; suf[2] = pr[3]; suf[1] = suf[2] + pr[2]; suf[0] = suf[1] + pr[1];
                    float w[16];
#pragma unroll
                    for (int g = 0; g < 4; ++g) { const float off = R + suf[g] + (h == 0 ? OT[g] : 0.f);
#pragma unroll
                        for (int j = 0; j < 4; ++j) { const int i = 4 * g + j; const float e = fast_exp2(s[kb][i] - (off + c[i])); w[i] = ok[i] ? e : 0.f; } }
                    R += suf[0] + pr[0];
#pragma unroll
                    for (int sp = 0; sp < 2; ++sp) { u32x4 p; p.x = cvt_pk(w[8 * sp], w[8 * sp + 1]); p.y = cvt_pk(w[8 * sp + 2], w[8 * sp + 3]); p.z = cvt_pk(w[8 * sp + 4], w[8 * sp + 5]); p.w = cvt_pk(w[8 * sp + 6], w[8 * sp + 7]);
                        pf[kb][sp] = __builtin_bit_cast(bf16x8, p); }
                }
                wdone = __all(R >= R_DONE);
            } else {
                float mx = -1e30f;
#pragma unroll
                for (int kb = 0; kb < 2; ++kb) { const int kbase = k0 + 32 * kb + 4 * h;
#pragma unroll
                    for (int i = 0; i < 16; ++i) { const int key = kbase + 8 * (i >> 2) + (i & 3); const float v = (key <= tq) ? s[kb][i] : -1e30f; s[kb][i] = v; mx = fmaxf(mx, v); } }
                mx = fmaxf(mx, __shfl_xor(mx, 32));
                const float m_new = fmaxf(m_run, mx), alpha = fast_exp2(m_run - m_new);
                m_run = m_new;
                float ls = 0.f;
#pragma unroll
                for (int kb = 0; kb < 2; ++kb) {
#pragma unroll
                    for (int i = 0; i < 16; ++i) { const float p = fast_exp2(s[kb][i] - m_new); s[kb][i] = p; ls += p; }
#pragma unroll
                    for (int sp = 0; sp < 2; ++sp) { u32x4 p; p.x = cvt_pk(s[kb][8 * sp], s[kb][8 * sp + 1]); p.y = cvt_pk(s[kb][8 * sp + 2], s[kb][8 * sp + 3]); p.z = cvt_pk(s[kb][8 * sp + 4], s[kb][8 * sp + 5]); p.w = cvt_pk(s[kb][8 * sp + 6], s[kb][8 * sp + 7]);
                        pf[kb][sp] = __builtin_bit_cast(bf16x8, p); }
                }
                l_run = l_run * alpha + ls;
#pragma unroll
                for (int d = 0; d < 4; ++d)
#pragma unroll
                    for (int i = 0; i < 16; ++i) o[d][i] *= alpha;
            }
#pragma unroll
            for (int d = 0; d < 4; ++d)
#pragma unroll
                for (int kb = 0; kb < 2; ++kb)
#pragma unroll
                    for (int sp = 0; sp < 2; ++sp) {
                        const bf16x8 a = *(const LAS bf16x8*)(lds + bo + vfrag + d * 32 * VP + (32 * kb + 16 * sp) * 2);
                        o[d] = __builtin_amdgcn_mfma_f32_32x32x16_bf16(a, pf[kb][sp], o[d], 0, 0, 0);
                    }
        }
        if (t > 0) ATT_STORE((cur ^ 1) * BUF_BYTES);
        if (MODE == 0) { if (lane == 0) flags[(it & 1) * 8 + wid] = wdone ? 1 : 0; }
        __syncthreads();
        if (t == 0) break;
        if (MODE == 0) { int alld = 1;
#pragma unroll
            for (int w2 = 0; w2 < 8; ++w2) alld &= flags[(it & 1) * 8 + w2];
            if (alld) break; }
        cur ^= 1;
    }
#undef ATT_LOAD
#undef ATT_STORE
    const size_t tok = tokbase + tq;
    if (MODE == 0) {
        const bf16_t* gp = PROJ + tok * NPROJ + PG_SB + hh * 128 + 4 * h;
        bf16_t* op = MIXED + tok * DM + hh * 128 + 4 * h;
#pragma unroll
        for (int d = 0; d < 4; ++d)
#pragma unroll
            for (int g = 0; g < 4; ++g) { const u32x2 gw = *(const u32x2*)(gp + 32 * d + 8 * g);
                u32x2 ow; ow.x = cvt_pk(o[d][4 * g] * bf_lo(gw.x), o[d][4 * g + 1] * bf_hi(gw.x)); ow.y = cvt_pk(o[d][4 * g + 2] * bf_lo(gw.y), o[d][4 * g + 3] * bf_hi(gw.y));
                *(u32x2*)(op + 32 * d + 8 * g) = ow; }
    } else {
        const float lt = l_run + __shfl_xor(l_run, 32);
        const float inv = 1.f / lt;
        LAS float* xq = (LAS float*)lds + (qg * 32 + r) * XP + 4 * h;
        if (role == 1) {
            const float f = inv * lam;
#pragma unroll
            for (int d = 0; d < 4; ++d)
#pragma unroll
                for (int g = 0; g < 4; ++g) *(LAS f32x4*)(xq + 32 * d + 8 * g) = (f32x4){o[d][4 * g] * f, o[d][4 * g + 1] * f, o[d][4 * g + 2] * f, o[d][4 * g + 3] * f};
        }
        __syncthreads();
        if (role == 0) {
            float q = 0.f;
#pragma unroll
            for (int d = 0; d < 4; ++d)
#pragma unroll
                for (int g = 0; g < 4; ++g) { const f32x4 x2 = *(const LAS f32x4*)(xq + 32 * d + 8 * g);
#pragma unroll
                    for (int j = 0; j < 4; ++j) { const float v = o[d][4 * g + j] * inv - x2[j]; o[d][4 * g + j] = v; q += v * v; } }
            q += __shfl_xor(q, 32);
            const float rs = rsqrtf(q * (1.f / 128.f) + SUBLN_EPS) * (1.f - LAMBDA_INIT);
            const bf16_t* gp = PROJ + tok * NPROJ + PG_DF + hh * 128 + 4 * h;
            bf16_t* op = MIXED + tok * DM + 1024 + hh * 128 + 4 * h;
            const float* sg = subln_g + 4 * h;
#pragma unroll
            for (int d = 0; d < 4; ++d)
#pragma unroll
                for (int g = 0; g < 4; ++g) { const u32x2 gw = *(const u32x2*)(gp + 32 * d + 8 * g); const f32x4 sv = *(const f32x4*)(sg + 32 * d + 8 * g);
                    u32x2 ow; ow.x = cvt_pk(o[d][4 * g] * rs * sv[0] * bf_lo(gw.x), o[d][4 * g + 1] * rs * sv[1] * bf_hi(gw.x));
                    ow.y = cvt_pk(o[d][4 * g + 2] * rs * sv[2] * bf_lo(gw.y), o[d][4 * g + 3] * rs * sv[3] * bf_hi(gw.y));
                    *(u32x2*)(op + 32 * d + 8 * g) = ow; }
        }
    }
}
}
__device__ __forceinline__ int win_dst_row(int c) {
    const int seg = c >> 10, w = c & 1023, d6 = w & 63;
    const int wp = d6 < 16 ? (w & ~63) + (d6 < 8 ? 2 * d6 : 2 * (d6 - 8) + 1) : w;
    switch (seg) { case 0: return w; case 1: return 1024 + w; case 2: return 6144 + w; case 3: return 2048 + w;
                   case 4: return 3072 + wp; case 5: return 4096 + wp; case 6: return 7168 + w; default: return 5120 + w; }
}
template <bool WIN>
__device__ __forceinline__ void p0_transpose_item(const float* __restrict__ W, int K, int N, bf16_t* __restrict__ WT, const float* __restrict__ kscale, LAS float* scr, int item, int lane) {
    const int nblk = N / 32, kb = item / nblk, nb = item % nblk, k0 = 64 * kb, n0 = 32 * nb;
#pragma unroll
    for (int i = 0; i < 32; ++i) { const int kk = 2 * i + (lane >> 5); float v = W[(size_t)(k0 + kk) * N + n0 + (lane & 31)]; if (kscale) v *= kscale[k0 + kk]; scr[kk * 33 + (lane & 31)] = v; }
    asm volatile("s_waitcnt lgkmcnt(0)" ::: "memory");
    const int c = lane & 7;
#pragma unroll
    for (int j = 0; j < 4; ++j) { const int n = (lane >> 3) + 8 * j; const LAS float* s = scr + (8 * c) * 33 + n;
        u32x4 o; o.x = cvt_pk(s[0 * 33], s[1 * 33]); o.y = cvt_pk(s[2 * 33], s[3 * 33]); o.z = cvt_pk(s[4 * 33], s[5 * 33]); o.w = cvt_pk(s[6 * 33], s[7 * 33]);
        const int dn = WIN ? win_dst_row(n0 + n) : (n0 + n);
        *(u32x4*)(WT + (size_t)dn * K + k0 + 8 * c) = o; }
    asm volatile("s_waitcnt lgkmcnt(0)" ::: "memory");
}
__device__ __forceinline__ void rms_row_to_bf16(const float* __restrict__ xrow, const float* __restrict__ g, bf16_t* __restrict__ orow, int lane) {
    const f32x4* xr = (const f32x4*)xrow + lane; f32x4 v[8]; float s = 0.f;
#pragma unroll
    for (int j = 0; j < 8; ++j) { v[j] = xr[64 * j]; s += (v[j][0] * v[j][0] + v[j][1] * v[j][1]) + (v[j][2] * v[j][2] + v[j][3] * v[j][3]); }
    const float rstd = rsqrtf(wave_sum(s) * (1.f / DM) + NORM_EPS);
    const f32x4* gr = (const f32x4*)g + lane; u32x2* o8 = (u32x2*)orow + lane;
#pragma unroll
    for (int j = 0; j < 8; ++j) { const f32x4 gv = gr[64 * j]; u32x2 w; w.x = cvt_pk(v[j][0] * rstd * gv[0], v[j][1] * rstd * gv[1]); w.y = cvt_pk(v[j][2] * rstd * gv[2], v[j][3] * rstd * gv[3]); o8[64 * j] = w; }
}

struct Args { const float* in[14]; float* out; unsigned char* ws; };

__global__ void __launch_bounds__(512, 2) fwd_megakernel(Args a) {
    extern __shared__ __attribute__((aligned(16))) unsigned char lds_raw[];
    LAS unsigned char* lds = (LAS unsigned char*)lds_raw;
    cg::grid_group grid = cg::this_grid();
    const int tid = threadIdx.x, lane = tid & 63, wave = __builtin_amdgcn_readfirstlane(tid >> 6);
    const int G = gridDim.x, bx = blockIdx.x;
    const int vcu = (G % 8 == 0) ? (bx % 8) * (G / 8) + bx / 8 : bx;
    unsigned char* ws = a.ws;
    float* ss2 = (float*)(ws + WS_CTL + CTL_SS2); float* ss3 = (float*)(ws + WS_CTL + CTL_SS3); float* lamp = (float*)(ws + WS_CTL + CTL_LAM); float* rope = (float*)(ws + WS_CTL + CTL_ROPE);
    bf16_t* WIN = (bf16_t*)(ws + WS_WIN); bf16_t* WOUT = (bf16_t*)(ws + WS_WOUT); bf16_t* WGATE = (bf16_t*)(ws + WS_WGATE); bf16_t* WPROJ = (bf16_t*)(ws + WS_WPROJ);
    bf16_t* PB = (bf16_t*)(ws + WS_PB); bf16_t* XN = (bf16_t*)(ws + WS_XN); bf16_t* MIXED = (bf16_t*)(ws + WS_MIXED); bf16_t* PROJ = (bf16_t*)(ws + WS_PROJ);
    bf16_t* VT = (bf16_t*)(ws + WS_VT); bf16_t* HB = (bf16_t*)(ws + WS_HB); bf16_t* PLEB = (bf16_t*)(ws + WS_PLE); bf16_t* H2B = (bf16_t*)(ws + WS_H2B);
    const float* x = a.in[0]; float* out = a.out;

    for (int rep_ = 0; rep_ < ((PROBE_DUP & 1) ? 2 : 1); ++rep_) {
        if (rep_) __syncthreads();
        const int gw = bx * 8 + wave, NGW = G * 8; const int gt = bx * 512 + tid, NGT = G * 512;
        for (int i = gt; i < 2 * NTOK; i += NGT) ss2[i] = 0.f;
        if (gt == 0) { float s1 = 0.f, s2 = 0.f; for (int i = 0; i < 64; ++i) { s1 += a.in[4][i] * a.in[5][i]; s2 += a.in[6][i] * a.in[7][i]; } lamp[0] = expf(s1) - expf(s2) + LAMBDA_INIT; }
        for (int i = gt; i < SEQ * 8; i += NGT) { const int pos = i >> 3, f = i & 7;
            const float invf = (float)exp2(-(double)f * 0.125 * 18.931568569324174);
            const float angf = (float)pos * invf;
            const double tw = 6.283185307179586476925; double ang = (double)angf; ang -= tw * rint(ang / tw);
            rope[2 * i] = (float)cos(ang); rope[2 * i + 1] = (float)sin(ang); }
        LAS float* scr = (LAS float*)(lds + wave * 16384);
        constexpr int I_IN = (DM / 64) * (8192 / 32), I_SQ = (DM / 64) * (DM / 32), I_PR = (PLE / 64) * (DM / 32);
        for (int it = gw; it < I_IN + 2 * I_SQ + I_PR; it += NGW) {
            int rr = it;
            if (rr < I_IN) { p0_transpose_item<true>(a.in[3], DM, 8192, WIN, nullptr, scr, rr, lane); continue; } rr -= I_IN;
            if (rr < I_SQ) { p0_transpose_item<false>(a.in[9], DM, DM, WOUT, nullptr, scr, rr, lane); continue; } rr -= I_SQ;
            if (rr < I_SQ) { p0_transpose_item<false>(a.in[11], DM, DM, WGATE, a.in[10], scr, rr, lane); continue; } rr -= I_SQ;
            p0_transpose_item<false>(a.in[12], PLE, DM, WPROJ, nullptr, scr, rr, lane);
        }
        for (int m = gw; m < NTOK; m += NGW) rms_row_to_bf16(x + (size_t)m * DM, a.in[2], XN + (size_t)m * DM, lane);
        for (int i = gt; i < NTOK * PLE / 8; i += NGT) { const f32x4 v0 = ((const f32x4*)a.in[1])[2 * i], v1 = ((const f32x4*)a.in[1])[2 * i + 1];
            u32x4 w; w.x = cvt_pk(v0[0], v0[1]); w.y = cvt_pk(v0[2], v0[3]); w.z = cvt_pk(v1[0], v1[1]); w.w = cvt_pk(v1[2], v1[3]); ((u32x4*)PB)[i] = w; }
    }
    grid.sync();
    for (int rep_ = 0; rep_ < ((PROBE_DUP & 2) ? 2 : 1); ++rep_) {
        if (rep_) __syncthreads();
        { pg8::Gemm g{XN, WIN, NTOK, NPROJ, DM}; pg8::StaticOrder S; S.init(NTOK, NPROJ, G, bx); pg8::EpiProj E{PROJ, rope};
          pg8::gemm_phase<pg8::EpiProj, pg8::StaticOrder, true, true>(lds, g, S, E); }
        __syncthreads();
        { pg8::Gemm g{WIN + (size_t)NPROJ * DM, XN, 2048, NTOK, DM}; pg8::StaticOrder S; S.init(2048, NTOK, G, bx); pg8::EpiBf16 E{VT, NTOK};
          pg8::gemm_phase<pg8::EpiBf16, pg8::StaticOrder, true, true>(lds, g, S, E); }
    }
    grid.sync();
    for (int rep_ = 0; rep_ < ((PROBE_DUP & 4) ? 2 : 1); ++rep_) {
        const float lam = lamp[0];
        for (int su = vcu; su < 256; su += G) {
            const int bh = su >> 2, s = su & 3;
#pragma unroll 1
            for (int k = 0; k < 4; ++k) { const int qb = (k == 0) ? s : (k == 1) ? 7 - s : (k == 2) ? 8 + s : 15 - s;
                att::attn_unit<1>(lds, PROJ, VT, MIXED, bh >> 3, bh & 7, qb, lam, a.in[8]); }
        }
#pragma unroll 1
        for (int u = vcu; u < 512; u += G) att::attn_unit<0>(lds, PROJ, VT, MIXED, (u >> 3) >> 3, (u >> 3) & 7, u & 7, lam, a.in[8]);
    }
    grid.sync();
    {
        __syncthreads();
        { pg8::Gemm g{MIXED, WOUT, NTOK, DM, DM}; pg8::StaticOrder S; S.init(NTOK, DM, G, bx); pg8::EpiRes E{x, HB, ss2};
          pg8::gemm_phase<pg8::EpiRes, pg8::StaticOrder, true, true>(lds, g, S, E); }
        __syncthreads();
        { pg8::Gemm g{PB, WPROJ, NTOK, DM, PLE}; pg8::StaticOrder S; S.init(NTOK, DM, G, bx); pg8::EpiBf16 E{PLEB, DM};
          pg8::gemm_phase<pg8::EpiBf16, pg8::StaticOrder, true, true>(lds, g, S, E); }
    }
    grid.sync();
    {
        pg8::Gemm g{HB, WGATE, NTOK, DM, DM}; pg8::StaticOrder S; S.init(NTOK, DM, G, bx); pg8::EpiGate E{HB, H2B, PLEB, ss2, ss3};
        pg8::gemm_phase<pg8::EpiGate, pg8::StaticOrder, true, true>(lds, g, S, E);
    }
    grid.sync();
    {
        const int gw = bx * 8 + wave, NGW = G * 8; const f32x4* gr = (const f32x4*)a.in[13];
        for (int m = gw; m < NTOK; m += NGW) { const float rstd = rsqrtf(ss3[m] * (1.f / DM) + NORM_EPS); f32x4* orow = (f32x4*)(out + (size_t)m * DM); const u32x4* hrow = (const u32x4*)(H2B + (size_t)m * DM);
#pragma unroll
            for (int j = 0; j < 4; ++j) { const int c = lane + 64 * j; const u32x4 hw = hrow[c]; const f32x4 g0 = gr[2 * c], g1 = gr[2 * c + 1];
                orow[2 * c] = (f32x4){bf_lo(hw.x) * rstd * g0[0], bf_hi(hw.x) * rstd * g0[1], bf_lo(hw.y) * rstd * g0[2], bf_hi(hw.y) * rstd * g0[3]};
                orow[2 * c + 1] = (f32x4){bf_lo(hw.z) * rstd * g1[0], bf_hi(hw.z) * rstd * g1[1], bf_lo(hw.w) * rstd * g1[2], bf_hi(hw.w) * rstd * g1[3]}; } }
    }
}

extern "C" void kernel_launch(void* const* d_in, const int* in_sizes, int n_in, void* d_out, int out_size, void* d_ws, size_t ws_size, hipStream_t stream) {
    static int grid = 0;
    if (grid == 0) {
        if (n_in != 14 || out_size != NTOK * DM || ws_size < WS_END) { fprintf(stderr, "kernel_launch: unexpected shapes (n_in %d out %d ws %zu)\n", n_in, out_size, ws_size); grid = -1; return; }
        int dev = 0, cus = 0, per_cu = 0;
        (void)hipGetDevice(&dev); (void)hipDeviceGetAttribute(&cus, hipDeviceAttributeMultiprocessorCount, dev);
        (void)hipFuncSetAttribute((const void*)fwd_megakernel, hipFuncAttributeMaxDynamicSharedMemorySize, LDS_BYTES);
        (void)hipOccupancyMaxActiveBlocksPerMultiprocessor(&per_cu, (const void*)fwd_megakernel, 512, LDS_BYTES);
        if (per_cu < 1) { fprintf(stderr, "kernel_launch: occupancy query says %d blocks/CU\n", per_cu); per_cu = 1; }
        grid = cus * per_cu;
    }
    if (grid < 0) return;
    Args a{};
    for (int i = 0; i < 14; ++i) a.in[i] = (const float*)d_in[i];
    a.out = (float*)d_out; a.ws = (unsigned char*)d_ws;
    void* args[] = {&a};
    hipError_t e = hipLaunchCooperativeKernel((void*)fwd_megakernel, dim3(grid), dim3(512), args, LDS_BYTES, stream);
    if (e != hipSuccess) fprintf(stderr, "cooperative launch failed: %s (grid %d)\n", hipGetErrorString(e), grid);
}
```

```cpp
#include <hip/hip_runtime.h>
#include <hip/hip_cooperative_groups.h>
#include <cstdio>
#include <cstdint>
namespace cg = cooperative_groups;
__device__ __forceinline__ int opaque_tid() { int t = (int)threadIdx.x; asm volatile("" : "+v"(t)); return t; }
#ifndef PROBE_DUP
#define PROBE_DUP 0
#endif
namespace pg8 {
#define PG8_LAS __attribute__((address_space(3)))
typedef unsigned short bf16_t;
typedef short bf16x8 __attribute__((ext_vector_type(8)));
typedef float f32x4 __attribute__((ext_vector_type(4)));
typedef unsigned u32x4 __attribute__((ext_vector_type(4)));
constexpr int BM = 256, BK = 64, HALF = 128, HTB = HALF * BK * 2  , STAGE_BYTES = 8 * HTB, NXCD = 8, WGM = 8;

__host__ __device__ __forceinline__ int lds_byte(int r, int c) { const int st = (r >> 4) * 2 + (c >> 5), rr = r & 15, cc = c & 31, ob = rr * 64 + cc * 2; return st * 1024 + (ob ^ (((ob >> 9) & 1) << 5)); }
__host__ __device__ __forceinline__ void stage_rc(int b, int& R, int& C) { const int st = b / 1024, sb = b % 1024, swz = sb ^ (((sb >> 9) & 1) << 5); R = (st >> 1) * 16 + swz / 64; C = (st & 1) * 32 + (swz % 64) / 2; }
__host__ __device__ __forceinline__ int perm32(int rho) { const int n = rho >> 4, i = rho & 15; return 8 * (i >> 2) + 4 * n + (i & 3); }

struct Unit { int pm, pn; };
struct Gemm { const bf16_t* A; const bf16_t* Bt; int M, N, K; };

struct StaticOrder {
    int nM, nN, nwg, G, c;
    __host__ __device__ void init(int M, int N, int G_, int c_) { nM = M / BM; nN = N / BM; nwg = nM * nN; G = G_; c = c_; }
    __host__ __device__ bool next(int i, Unit& u) const {
        const long L = (long)i * G + c; if (L >= nwg) return false;
        int wgid = (int)L; { const int q = nwg / NXCD, r = nwg % NXCD, xcd = wgid % NXCD, off = wgid / NXCD; wgid = (xcd < r ? xcd * (q + 1) : r * (q + 1) + (xcd - r) * q) + off; }
        const int nig = WGM * nN, gid = wgid / nig, fm = gid * WGM, gsz = (nM - fm) < WGM ? (nM - fm) : WGM;
        u.pm = fm + ((wgid % nig) % gsz); u.pn = (wgid % nig) / gsz; return true;
    }
    __device__ __forceinline__ void a_ready(const Unit&) const {}
    __device__ __forceinline__ void done(const Unit&) const {}
};

__device__ __forceinline__ unsigned cvt_pk_bf16(float lo, float hi) { unsigned r; asm volatile("v_cvt_pk_bf16_f32 %0, %1, %2" : "=v"(r) : "v"(lo), "v"(hi)); return r; }
typedef float f32x2 __attribute__((ext_vector_type(2)));
template <class Epi, class Sched, bool ALIGN_EPI = false, bool SP2 = false>
__device__ __forceinline__ void gemm_phase(PG8_LAS unsigned char* lds, const Gemm g, const Sched& S, const Epi& E) {
    const int tid = opaque_tid(), wid = __builtin_amdgcn_readfirstlane(tid >> 6), lane = tid & 63, wr = wid >> 2, wc = wid & 3, fr = lane & 15, fq = lane >> 4;
    const int K = g.K, nt = K / BK;
    unsigned voffA[2], voffB[2];
#pragma unroll
    for (int i = 0; i < 2; ++i) { int R, C; stage_rc(tid * 16 + i * 8192, R, C); const int Rb = Epi::PERM ? ((R & ~31) + perm32(R & 31)) : R;
        voffA[i] = (unsigned)(R * K + C) * 2u; voffB[i] = (unsigned)(Rb * K + C) * 2u; }
    const size_t kstep = (size_t)(BK * 2);
    const size_t hstep = (size_t)HALF * K * 2;
    const size_t tstep = 2 * hstep;
    const unsigned ldsw = (unsigned)wid * 1024u;
    const int aoff = lds_byte(wr * 64 + fr, fq * 8), boff = lds_byte(wc * 32 + fr, fq * 8);
#define PG8_SA(b, h) (((b) * 2 + (h)) * HTB)
#define PG8_SB(b, h) ((4 + (b) * 2 + (h)) * HTB)
#define PG8_STAGE(bufoff, gbase, voff) do { _Pragma("unroll") for (int _i = 0; _i < 2; ++_i) \
        __builtin_amdgcn_global_load_lds((const unsigned*)((const char*)(gbase) + (voff)[_i]), (PG8_LAS unsigned*)(lds + (bufoff) + ldsw + _i * 8192), 16, 0, 0); } while (0)
#define PG8_LDA(dst, b, h) do { _Pragma("unroll") for (int m = 0; m < 4; ++m) _Pragma("unroll") for (int k = 0; k < 2; ++k) dst[m][k] = *(const PG8_LAS bf16x8*)(lds + PG8_SA(b, h) + aoff + m * 2048 + k * 1024); } while (0)
#define PG8_LDB(dst, b, h) do { _Pragma("unroll") for (int n = 0; n < 2; ++n) _Pragma("unroll") for (int k = 0; k < 2; ++k) dst[n][k] = *(const PG8_LAS bf16x8*)(lds + PG8_SB(b, h) + boff + n * 2048 + k * 1024); } while (0)
#define PG8_MMA(ai, bj, At, Bt) do { __builtin_amdgcn_s_setprio(1); _Pragma("unroll") for (int m = 0; m < 4; ++m) _Pragma("unroll") for (int n = 0; n < 2; ++n) _Pragma("unroll") for (int k = 0; k < 2; ++k) \
        acc[ai][bj][m][n] = __builtin_amdgcn_mfma_f32_16x16x32_bf16(Bt[n][k], At[m][k], acc[ai][bj][m][n], 0, 0, 0); __builtin_amdgcn_s_setprio(0); } while (0)
#define PG8_WAIT_V(n) asm volatile("s_waitcnt vmcnt(" #n ")" ::: "memory")
#define PG8_WAIT_L(n) asm volatile("s_waitcnt lgkmcnt(" #n ")" ::: "memory")
#define PG8_BAR __builtin_amdgcn_s_barrier()
#define PG8_SCHED __builtin_amdgcn_sched_barrier(0)
    Unit cur, nxt; int ui = 0;
    if (!S.next(0, cur)) return;
    f32x4 acc[2][2][4][2];
#pragma unroll
    for (int a = 0; a < 2; ++a)
#pragma unroll
        for (int b = 0; b < 2; ++b)
#pragma unroll
            for (int m = 0; m < 4; ++m)
#pragma unroll
                for (int n = 0; n < 2; ++n) acc[a][b][m][n] = (f32x4){0.f, 0.f, 0.f, 0.f};
    bf16x8 At[4][2], B0[2][2], B1[2][2];
    const char* cA = (const char*)g.A + (size_t)cur.pm * tstep; const char* cB = (const char*)g.Bt + (size_t)cur.pn * tstep;
    S.a_ready(cur);
    if constexpr (SP2) {
        PG8_STAGE(PG8_SB(0, 0), cB, voffB); PG8_STAGE(PG8_SB(0, 1), cB + hstep, voffB); PG8_STAGE(PG8_SA(0, 0), cA, voffA); PG8_STAGE(PG8_SA(0, 1), cA + hstep, voffA);
        if (wr == 1) PG8_BAR;
        PG8_WAIT_V(2); PG8_BAR;
        PG8_STAGE(PG8_SB(1, 0), cB + kstep, voffB); PG8_STAGE(PG8_SA(1, 0), cA + kstep, voffA); PG8_STAGE(PG8_SB(1, 1), cB + hstep + kstep, voffB);
        PG8_WAIT_V(6); PG8_BAR;
    } else {
        PG8_STAGE(PG8_SB(0, 0), cB, voffB); PG8_STAGE(PG8_SA(0, 0), cA, voffA); PG8_STAGE(PG8_SB(0, 1), cB + hstep, voffB); PG8_STAGE(PG8_SA(0, 1), cA + hstep, voffA);
        if (wr == 1) PG8_BAR;
        PG8_WAIT_V(4); PG8_BAR;
        PG8_STAGE(PG8_SB(1, 0), cB + kstep, voffB); PG8_STAGE(PG8_SA(1, 0), cA + kstep, voffA); PG8_STAGE(PG8_SB(1, 1), cB + hstep + kstep, voffB);
        PG8_WAIT_V(6); PG8_BAR;
    }
    for (;;) {
        const bool has_next = S.next(ui + 1, nxt);
        const char* nA = has_next ? (const char*)g.A + (size_t)nxt.pm * tstep : cA; const char* nB = has_next ? (const char*)g.Bt + (size_t)nxt.pn * tstep : cB;
        for (int t = 0; t < nt; t += 2) {
            const bool last = (t == nt - 2);
            const char* a1 = cA + (size_t)(t + 1) * kstep;
            const char* a2 = last ? nA : cA + (size_t)(t + 2) * kstep; const char* b2 = last ? nB : cB + (size_t)(t + 2) * kstep;
            const char* a3 = a2 + kstep; const char* b3 = b2 + kstep;
            if (last && has_next) S.a_ready(nxt);
            if constexpr (SP2) {
            PG8_LDB(B0, 0, 0); PG8_LDB(B1, 0, 1); PG8_SCHED; PG8_LDA(At, 0, 0); PG8_STAGE(PG8_SA(1, 1), a1 + hstep, voffA);
            PG8_WAIT_V(8); PG8_WAIT_L(0); PG8_BAR; PG8_MMA(0, 0, At, B0); PG8_MMA(0, 1, At, B1); PG8_BAR; PG8_SCHED;
            PG8_LDA(At, 0, 1); PG8_STAGE(PG8_SB(0, 0), b2, voffB); PG8_STAGE(PG8_SB(0, 1), b2 + hstep, voffB); PG8_STAGE(PG8_SA(0, 0), a2, voffA);
            PG8_WAIT_V(8); PG8_WAIT_L(0); PG8_BAR; PG8_MMA(1, 0, At, B0); PG8_MMA(1, 1, At, B1); PG8_BAR; PG8_SCHED;
            PG8_LDB(B0, 1, 0); PG8_LDB(B1, 1, 1); PG8_SCHED; PG8_LDA(At, 1, 0); PG8_STAGE(PG8_SA(0, 1), a2 + hstep, voffA);
            PG8_WAIT_V(8); PG8_WAIT_L(0); PG8_BAR; PG8_MMA(0, 0, At, B0); PG8_MMA(0, 1, At, B1); PG8_BAR; PG8_SCHED;
            PG8_LDA(At, 1, 1); PG8_STAGE(PG8_SB(1, 0), b3, voffB); PG8_STAGE(PG8_SB(1, 1), b3 + hstep, voffB); PG8_STAGE(PG8_SA(1, 0), a3, voffA);
            PG8_WAIT_V(8); PG8_WAIT_L(0); PG8_BAR; PG8_MMA(1, 0, At, B0); PG8_MMA(1, 1, At, B1); PG8_BAR; PG8_SCHED;
            } else {
            PG8_LDB(B0, 0, 0); PG8_SCHED; PG8_LDA(At, 0, 0); PG8_STAGE(PG8_SA(1, 1), a1 + hstep, voffA);
            PG8_WAIT_L(8); PG8_BAR; PG8_WAIT_L(0); PG8_MMA(0, 0, At, B0); PG8_BAR; PG8_SCHED;
            PG8_LDB(B1, 0, 1); PG8_STAGE(PG8_SB(0, 0), b2, voffB);
            PG8_BAR; PG8_WAIT_L(0); PG8_MMA(0, 1, At, B1); PG8_BAR;
            PG8_LDA(At, 0, 1); PG8_STAGE(PG8_SA(0, 0), a2, voffA);
            PG8_BAR; PG8_WAIT_L(0); PG8_MMA(1, 0, At, B0); PG8_BAR; PG8_SCHED;
            PG8_STAGE(PG8_SB(0, 1), b2 + hstep, voffB);
            PG8_WAIT_V(6); PG8_BAR; PG8_MMA(1, 1, At, B1); PG8_BAR;
            PG8_LDB(B0, 1, 0); PG8_SCHED; PG8_LDA(At, 1, 0); PG8_STAGE(PG8_SA(0, 1), a2 + hstep, voffA);
            PG8_WAIT_L(8); PG8_BAR; PG8_WAIT_L(0); PG8_MMA(0, 0, At, B0); PG8_BAR; PG8_SCHED;
            PG8_LDB(B1, 1, 1); PG8_STAGE(PG8_SB(1, 0), b3, voffB);
            PG8_BAR; PG8_WAIT_L(0); PG8_MMA(0, 1, At, B1); PG8_BAR;
            PG8_LDA(At, 1, 1); PG8_STAGE(PG8_SA(1, 0), a3, voffA);
            PG8_BAR; PG8_WAIT_L(0); PG8_MMA(1, 0, At, B0); PG8_BAR; PG8_SCHED;
            PG8_STAGE(PG8_SB(1, 1), b3 + hstep, voffB);
            PG8_WAIT_V(6); PG8_BAR; PG8_MMA(1, 1, At, B1); PG8_BAR;
            }
        }
        if constexpr (ALIGN_EPI) { if (wr == 0) PG8_BAR; }
        if constexpr (!Epi::AFTER_DRAIN) { E(acc, cur, wr, wc, fr, fq); S.done(cur); }
        if (!has_next) break;
#pragma unroll
        for (int a = 0; a < 2; ++a)
#pragma unroll
            for (int b = 0; b < 2; ++b)
#pragma unroll
                for (int m = 0; m < 4; ++m)
#pragma unroll
                    for (int n = 0; n < 2; ++n) acc[a][b][m][n] = (f32x4){0.f, 0.f, 0.f, 0.f};
        cur = nxt; cA = nA; cB = nB; ++ui;
        if constexpr (ALIGN_EPI) { if (wr == 1) PG8_BAR; }
    }
    PG8_WAIT_V(0);
    if constexpr (!ALIGN_EPI) { if (wr == 0) PG8_BAR; }
    PG8_BAR;
    if constexpr (Epi::AFTER_DRAIN) { E.fused(acc, cur, wr, wc, fr, fq, lds, wid, lane); S.done(cur); }
#undef PG8_SA
#undef PG8_SB
#undef PG8_STAGE
#undef PG8_LDA
#undef PG8_LDB
#undef PG8_MMA
#undef PG8_WAIT_V
#undef PG8_WAIT_L
#undef PG8_BAR
#undef PG8_SCHED
}
}
#define LAS __attribute__((address_space(3)))
typedef unsigned short bf16_t;
typedef short bf16x8 __attribute__((ext_vector_type(8)));
typedef float f32x4 __attribute__((ext_vector_type(4)));
typedef float f32x2 __attribute__((ext_vector_type(2)));
typedef float f32x16 __attribute__((ext_vector_type(16)));
typedef unsigned u32x4 __attribute__((ext_vector_type(4)));
typedef unsigned u32x2 __attribute__((ext_vector_type(2)));

constexpr int NTOK = 16384, DM = 2048, SEQ = 2048, NBATCH = 8, PLE = 256;
constexpr int NPROJ = 6144;
constexpr int PQ_SB = 0, PK_SB = 1024, PG_SB = 2048, PQ_DF = 3072, PK_DF = 4096, PG_DF = 5120;
constexpr float LOG2E = 1.4426950408889634f;
constexpr float SBQ_SCALE = 0.08838834764831845f * LOG2E;
constexpr float DFQ_SCALE = 0.125f * LOG2E;
constexpr float NORM_EPS = 1e-6f, SUBLN_EPS = 1e-5f;
constexpr float LAMBDA_INIT = 0.2f;

constexpr size_t MiB = 1u << 20;
constexpr size_t WS_CTL = 0;
constexpr size_t CTL_SS2 = 0, CTL_SS3 = 65536, CTL_LAM = 131072, CTL_ROPE = 262144;
constexpr size_t WS_WIN = 2 * MiB, WS_WOUT = 34 * MiB, WS_WGATE = 42 * MiB, WS_WPROJ = 50 * MiB, WS_PB = 52 * MiB;
constexpr size_t WS_XN = 64 * MiB, WS_MIXED = 64 * MiB;
constexpr size_t WS_PROJ = 128 * MiB, WS_VT = 320 * MiB, WS_KIMG = 384 * MiB, WS_END = 448 * MiB;
constexpr size_t WS_HB = 128 * MiB, WS_PLE = 192 * MiB;
constexpr size_t WS_H2B = 64 * MiB;

constexpr int LDS_BYTES = 131072 + 1024;

__device__ __forceinline__ unsigned cvt_pk(float lo, float hi) { unsigned r; asm volatile("v_cvt_pk_bf16_f32 %0, %1, %2" : "=v"(r) : "v"(lo), "v"(hi)); return r; }
__device__ __forceinline__ float bf_lo(unsigned w) { return __uint_as_float(w << 16); }
__device__ __forceinline__ float bf_hi(unsigned w) { return __uint_as_float(w & 0xffff0000u); }
__device__ __forceinline__ float wave_sum(float v) {
#pragma unroll
    for (int o = 1; o < 64; o <<= 1) v += __shfl_xor(v, o);
    return v;
}
__device__ __forceinline__ float fast_exp2(float x) { return __builtin_amdgcn_exp2f(x); }
__device__ __forceinline__ float fast_log2(float x) { return __builtin_amdgcn_logf(x); }
__device__ __forceinline__ float silu_f(float x) { return x * __builtin_amdgcn_rcpf(1.f + fast_exp2(-x * LOG2E)); }
__device__ __forceinline__ float sigmoid_f(float x) { return __builtin_amdgcn_rcpf(1.f + fast_exp2(-x * LOG2E)); }

namespace pg8 {
struct EpiBf16 {
    static constexpr bool PERM = true, AFTER_DRAIN = false;
    bf16_t* O; int ldc;
    __device__ __forceinline__ void operator()(const f32x4 (&acc)[2][2][4][2], const Unit& u, int wr, int wc, int fr, int fq) const {
        const int row0 = u.pm * BM + wr * 64 + fr; const int col0 = u.pn * BM + wc * 32 + 8 * fq;
#pragma unroll
        for (int ai = 0; ai < 2; ++ai)
#pragma unroll
            for (int m = 0; m < 4; ++m) { bf16_t* rowp = O + (size_t)(row0 + ai * HALF + m * 16) * ldc + col0;
#pragma unroll
                for (int bj = 0; bj < 2; ++bj) { const f32x4 v0 = acc[ai][bj][m][0], v1 = acc[ai][bj][m][1];
                    u32x4 w; w.x = cvt_pk_bf16(v0[0], v0[1]); w.y = cvt_pk_bf16(v0[2], v0[3]); w.z = cvt_pk_bf16(v1[0], v1[1]); w.w = cvt_pk_bf16(v1[2], v1[3]);
                    *(u32x4*)(rowp + bj * HALF) = w; } }
    }
};
struct EpiProj {
    static constexpr bool PERM = true, AFTER_DRAIN = false;
    bf16_t* O; const float* rope; bf16_t* KI;
    __device__ __forceinline__ void operator()(const f32x4 (&acc)[2][2][4][2], const Unit& u, int wr, int wc, int fr, int fq) const {
        const int row0 = u.pm * BM + wr * 64 + fr; const int col0 = u.pn * BM + wc * 32 + 8 * fq;
        const int kind = u.pn >> 2;
        const bool dorope = (kind == 3 || kind == 4) && ((wc & 1) == 0) && (fq < 2);
        const float sc = kind == 0 ? SBQ_SCALE : (kind == 3 ? DFQ_SCALE : 1.f);
        const bool dosilu = (kind == 2 || kind == 5);
#pragma unroll
        for (int ai = 0; ai < 2; ++ai)
#pragma unroll
            for (int m = 0; m < 4; ++m) { const int row = row0 + ai * HALF + m * 16; bf16_t* rowp = O + (size_t)row * NPROJ + col0;
                if (kind == 1 || kind == 4) {
                    const int cw = col0 & 1023; rowp = KI + ((size_t)(((kind == 4 ? 8 : 0) + (row >> 11)) * 8 + (cw >> 7)) * SEQ + (row & (SEQ - 1))) * 128 + (cw & 127); }
                f32x4 cs0 = {1.f, 0.f, 1.f, 0.f}, cs1 = {1.f, 0.f, 1.f, 0.f};
                if (dorope) { const f32x4* rp = (const f32x4*)(rope + ((size_t)(row & (SEQ - 1)) * 8 + 4 * fq) * 2); cs0 = rp[0]; cs1 = rp[1]; }
#pragma unroll
                for (int bj = 0; bj < 2; ++bj) { f32x4 v0 = acc[ai][bj][m][0], v1 = acc[ai][bj][m][1];
                    if (dorope) {
                        f32x4 a, b;
                        a[0] = v0[0] * cs0[0] - v0[1] * cs0[1]; a[1] = v0[1] * cs0[0] + v0[0] * cs0[1];
                        a[2] = v0[2] * cs0[2] - v0[3] * cs0[3]; a[3] = v0[3] * cs0[2] + v0[2] * cs0[3];
                        b[0] = v1[0] * cs1[0] - v1[1] * cs1[1]; b[1] = v1[1] * cs1[0] + v1[0] * cs1[1];
                        b[2] = v1[2] * cs1[2] - v1[3] * cs1[3]; b[3] = v1[3] * cs1[2] + v1[2] * cs1[3];
                        v0 = a; v1 = b; }
                    if (dosilu) {
#pragma unroll
                        for (int j = 0; j < 4; ++j) { v0[j] = silu_f(v0[j]); v1[j] = silu_f(v1[j]); } }
                    v0 = v0 * sc; v1 = v1 * sc;
                    u32x4 w; w.x = cvt_pk_bf16(v0[0], v0[1]); w.y = cvt_pk_bf16(v0[2], v0[3]); w.z = cvt_pk_bf16(v1[0], v1[1]); w.w = cvt_pk_bf16(v1[2], v1[3]);
                    *(u32x4*)(rowp + ((kind == 1 || kind == 4) ? bj * SEQ * 128 : bj * HALF)) = w; } }
    }
};
struct EpiVt {
    static constexpr bool PERM = true, AFTER_DRAIN = false;
    bf16_t* O;
    __device__ __forceinline__ void operator()(const f32x4 (&acc)[2][2][4][2], const Unit& u, int wr, int wc, int fr, int fq) const {
        const int row0 = u.pm * BM + wr * 64 + fr; const int col0 = u.pn * BM + wc * 32 + 8 * fq;
        const int p0 = (fq & 1) ? 4 : 0, p1 = (fq & 1) ? 12 : 8;
#pragma unroll
        for (int ai = 0; ai < 2; ++ai)
#pragma unroll
            for (int m = 0; m < 4; ++m) { const int row = row0 + ai * HALF + m * 16; const int gh = row >> 7, d = row & 127;
#pragma unroll
                for (int bj = 0; bj < 2; ++bj) { const int col = col0 + bj * HALF; const int b = col >> 11, sq = col & (SEQ - 1);
                    bf16_t* tp = O + ((size_t)((((gh >> 3) * 8 + b) * 8 + (gh & 7)) * 32 + (sq >> 6)) * 128 + d) * 64 + (sq & 48);
                    const f32x4 v0 = acc[ai][bj][m][0], v1 = acc[ai][bj][m][1];
                    u32x2 w0, w1; w0.x = cvt_pk_bf16(v0[0], v0[1]); w0.y = cvt_pk_bf16(v0[2], v0[3]); w1.x = cvt_pk_bf16(v1[0], v1[1]); w1.y = cvt_pk_bf16(v1[2], v1[3]);
                    *(u32x2*)(tp + p0) = w0; *(u32x2*)(tp + p1) = w1; } }
    }
};
struct EpiRes {
    static constexpr bool PERM = false, AFTER_DRAIN = false;
    const float* x; bf16_t* hb; float* ss;
    __device__ __forceinline__ void operator()(const f32x4 (&acc)[2][2][4][2], const Unit& u, int wr, int wc, int fr, int fq) const {
        const int row0 = u.pm * BM + wr * 64 + fr; const int col0 = u.pn * BM + wc * 32 + 4 * fq;
#pragma unroll
        for (int ai = 0; ai < 2; ++ai)
#pragma unroll
            for (int m = 0; m < 4; ++m) { const int row = row0 + ai * HALF + m * 16; const size_t off = (size_t)row * DM + col0; float q = 0.f;
#pragma unroll
                for (int bj = 0; bj < 2; ++bj)
#pragma unroll
                    for (int n = 0; n < 2; ++n) { const size_t o2 = off + bj * HALF + n * 16; const f32x4 hv = *(const f32x4*)(x + o2) + acc[ai][bj][m][n];
                        u32x2 w; w.x = cvt_pk_bf16(hv[0], hv[1]); w.y = cvt_pk_bf16(hv[2], hv[3]); *(u32x2*)(hb + o2) = w;
                        q += (hv[0] * hv[0] + hv[1] * hv[1]) + (hv[2] * hv[2] + hv[3] * hv[3]); }
                q += __shfl_xor(q, 16); q += __shfl_xor(q, 32);
                if (fq == 0) atomicAdd(ss + row, q); }
    }
};
struct EpiGate {
    static constexpr bool PERM = false, AFTER_DRAIN = false;
    const bf16_t* hb; bf16_t* h2b; const bf16_t* ple; const float* ss2; float* ss3;
    __device__ __forceinline__ void operator()(const f32x4 (&acc)[2][2][4][2], const Unit& u, int wr, int wc, int fr, int fq) const {
        const int row0 = u.pm * BM + wr * 64 + fr; const int col0 = u.pn * BM + wc * 32 + 4 * fq;
#pragma unroll
        for (int ai = 0; ai < 2; ++ai)
#pragma unroll
            for (int m = 0; m < 4; ++m) { const int row = row0 + ai * HALF + m * 16; const size_t off = (size_t)row * DM + col0; float q = 0.f;
                const float rstd = rsqrtf(ss2[row] * (1.f / DM) + NORM_EPS);
#pragma unroll
                for (int bj = 0; bj < 2; ++bj)
#pragma unroll
                    for (int n = 0; n < 2; ++n) { const size_t o2 = off + bj * HALF + n * 16; const u32x2 hw = *(const u32x2*)(hb + o2); const f32x4 hv = {bf_lo(hw.x), bf_hi(hw.x), bf_lo(hw.y), bf_hi(hw.y)}; const u32x2 pw = *(const u32x2*)(ple + o2);
                        const f32x4 a = acc[ai][bj][m][n] * rstd; f32x4 h2;
                        h2[0] = hv[0] + sigmoid_f(a[0]) * bf_lo(pw.x); h2[1] = hv[1] + sigmoid_f(a[1]) * bf_hi(pw.x);
                        h2[2] = hv[2] + sigmoid_f(a[2]) * bf_lo(pw.y); h2[3] = hv[3] + sigmoid_f(a[3]) * bf_hi(pw.y);
                        u32x2 w2; w2.x = cvt_pk_bf16(h2[0], h2[1]); w2.y = cvt_pk_bf16(h2[2], h2[3]); *(u32x2*)(h2b + o2) = w2;
                        q += (h2[0] * h2[0] + h2[1] * h2[1]) + (h2[2] * h2[2] + h2[3] * h2[3]); }
                q += __shfl_xor(q, 16); q += __shfl_xor(q, 32);
                if (fq == 0) atomicAdd(ss3 + row, q); }
    }
};
}
namespace att {
constexpr int KP = 272, VP = 144, KT_BYTES = 64 * KP, VT_BYTES = 128 * VP, BUF_BYTES = KT_BYTES + VT_BYTES;
constexpr int FLAG_OFF = 2 * BUF_BYTES;
constexpr int XP = 132;
constexpr float R_DONE = 152.0f;

template <bool MASK>
__device__ __forceinline__ void sb_block(const f32x16& sv, int kbase, int tq, int h, float& R, bf16x8 (&pf)[2]) {
    float c[16];
#pragma unroll
    for (int i = 0; i < 16; ++i) {
        const float z = sv[i];
        const float spv = fmaxf(z, 0.f) + fast_log2(1.f + fast_exp2(-fabsf(z)));
        c[i] = (!MASK || (kbase + 8 * (i >> 2) + (i & 3) < tq)) ? spv : 0.f;
    }
    float T[4], OT[4], pr[4], suf[4];
#pragma unroll
    for (int g = 0; g < 4; ++g) { c[4 * g + 2] += c[4 * g + 3]; c[4 * g + 1] += c[4 * g + 2]; c[4 * g] += c[4 * g + 1]; T[g] = c[4 * g]; }
#pragma unroll
    for (int g = 0; g < 4; ++g) { OT[g] = __shfl_xor(T[g], 32); pr[g] = T[g] + OT[g]; }
    suf[3] = 0.f; suf[2] = pr[3]; suf[1] = suf[2] + pr[2]; suf[0] = suf[1] + pr[1];
    float w[16];
#pragma unroll
    for (int g = 0; g < 4; ++g) { const float off = R + suf[g] + (h == 0 ? OT[g] : 0.f);
#pragma unroll
        for (int j = 0; j < 4; ++j) { const int i = 4 * g + j; const float e = fast_exp2(sv[i] - (off + c[i])); w[i] = (!MASK || (kbase + 8 * (i >> 2) + (i & 3) < tq)) ? e : 0.f; } }
    R += suf[0] + pr[0];
#pragma unroll
    for (int sp = 0; sp < 2; ++sp) { u32x4 p; p.x = cvt_pk(w[8 * sp], w[8 * sp + 1]); p.y = cvt_pk(w[8 * sp + 2], w[8 * sp + 3]); p.z = cvt_pk(w[8 * sp + 4], w[8 * sp + 5]); p.w = cvt_pk(w[8 * sp + 6], w[8 * sp + 7]);
        pf[sp] = __builtin_bit_cast(bf16x8, p); }
}

template <int MODE>
__device__ __forceinline__ void attn_unit(LAS unsigned char* lds, const bf16_t* __restrict__ PROJ, const bf16_t* __restrict__ KIMG, const bf16_t* __restrict__ VT, bf16_t* __restrict__ MIXED,
                                          int b, int hh, int qblk, float lam, const float* __restrict__ subln_g) {
    constexpr int QB = MODE == 0 ? 256 : 128;
    constexpr int NKS = MODE == 0 ? 8 : 4;
    const int tid = opaque_tid(), lane = tid & 63, r = lane & 31, h = lane >> 5;
    const int wid = __builtin_amdgcn_readfirstlane(tid >> 6);
    const int qg = MODE == 0 ? wid : (wid & 3), role = MODE == 0 ? 0 : (wid >> 2);
    const int Q0 = qblk * QB, q0w = Q0 + 32 * qg, tq = q0w + r;
    const size_t tokbase = (size_t)b * SEQ;
    const int gbh = ((MODE == 0 ? 0 : 8) + b) * 8 + hh;
    const bf16_t* Kg = KIMG + (size_t)gbh * SEQ * 128;
    const bf16_t* Vg = VT + (size_t)gbh * 32 * 8192;
    bf16x8 qf[NKS];
    { const bf16_t* qp = PROJ + (tokbase + tq) * NPROJ + (MODE == 0 ? PQ_SB + hh * 128 : PQ_DF + hh * 128 + role * 64) + 8 * h;
#pragma unroll
      for (int ks = 0; ks < NKS; ++ks) qf[ks] = *(const bf16x8*)(qp + 16 * ks); }
    f32x16 o[4];
#pragma unroll
    for (int d = 0; d < 4; ++d)
#pragma unroll
        for (int i = 0; i < 16; ++i) o[d][i] = 0.f;
    float R = 0.f, m_run = -1e30f, l_run = 0.f;
    const int kr0 = tid >> 4, kc = tid & 15, vr0 = tid >> 3, vc = tid & 7;
    const int kst = kr0 * KP + kc * 16, vst = KT_BYTES + vr0 * VP + vc * 16;
    const bf16_t* kgl = Kg + tid * 8;
    const bf16_t* vgl = Vg + tid * 8;
    u32x4 kreg[2], vreg[2];
#define ATT_LOAD(t) do { _Pragma("unroll") for (int i_ = 0; i_ < 2; ++i_) { \
        kreg[i_] = *(const u32x4*)(kgl + (size_t)(t) * 8192 + i_ * 4096); \
        vreg[i_] = *(const u32x4*)(vgl + (size_t)(t) * 8192 + i_ * 4096); } } while (0)
#define ATT_STORE(bo) do { _Pragma("unroll") for (int i_ = 0; i_ < 2; ++i_) { \
        *(LAS u32x4*)(lds + (bo) + kst + i_ * 32 * KP) = kreg[i_]; \
        *(LAS u32x4*)(lds + (bo) + vst + i_ * 64 * VP) = vreg[i_]; } } while (0)
    const int tl = (Q0 + QB - 1) >> 6;
    const int kfrag = r * KP + (role * 64 + 8 * h) * 2;
    const int vfrag = KT_BYTES + r * VP + (8 * h) * 2;
    volatile LAS int* flags = (volatile LAS int*)(lds + FLAG_OFF);
    __syncthreads();
    ATT_LOAD(tl); ATT_STORE(0);
    __syncthreads();
    int cur = 0, it = 0;
    bool wdone = false;
    for (int t = tl;; --t, ++it) {
        if (t > 0) ATT_LOAD(t - 1);
        const int k0 = 64 * t;
        const bool active = (MODE == 0) ? (!wdone && k0 <= q0w + 30) : (k0 <= q0w + 31);
        if (active) {
            const int bo = cur * BUF_BYTES;
            f32x16 s[2];
            bf16x8 vf[4][2][2];
            if (MODE == 1) {
                bf16x8 kf[2][NKS];
#pragma unroll
                for (int kb = 0; kb < 2; ++kb)
#pragma unroll
                    for (int ks = 0; ks < NKS; ++ks) kf[kb][ks] = *(const LAS bf16x8*)(lds + bo + kfrag + kb * 32 * KP + ks * 32);
                __builtin_amdgcn_sched_barrier(0);
#pragma unroll
                for (int kb = 0; kb < 2; ++kb) {
#pragma unroll
                    for (int i = 0; i < 16; ++i) s[kb][i] = 0.f;
#pragma unroll
                    for (int ks = 0; ks < NKS; ++ks) s[kb] = __builtin_amdgcn_mfma_f32_32x32x16_bf16(kf[kb][ks], qf[ks], s[kb], 0, 0, 0);
                }
                __builtin_amdgcn_sched_barrier(0);
#pragma unroll
                for (int d = 0; d < 2; ++d)
#pragma unroll
                    for (int kb = 0; kb < 2; ++kb)
#pragma unroll
                        for (int sp = 0; sp < 2; ++sp) vf[d][kb][sp] = *(const LAS bf16x8*)(lds + bo + vfrag + d * 32 * VP + (32 * kb + 16 * sp) * 2);
                __builtin_amdgcn_sched_barrier(0);
            } else {
#pragma unroll
                for (int kb = 0; kb < 2; ++kb) {
#pragma unroll
                    for (int i = 0; i < 16; ++i) s[kb][i] = 0.f;
#pragma unroll
                    for (int ks = 0; ks < NKS; ++ks) {
                        const bf16x8 a = *(const LAS bf16x8*)(lds + bo + kfrag + kb * 32 * KP + ks * 32);
                        s[kb] = __builtin_amdgcn_mfma_f32_32x32x16_bf16(a, qf[ks], s[kb], 0, 0, 0);
                    }
                }
            }
            bf16x8 pf[2][2];
            if (MODE == 0) {
                { sb_block<true>(s[1], k0 + 32 + 4 * h, tq, h, R, pf[1]); sb_block<true>(s[0], k0 + 4 * h, tq, h, R, pf[0]); }
                wdone = __all(R >= R_DONE);
            } else {
                float mx = -1e30f;
                if (k0 + 63 > q0w) {
#pragma unroll
                    for (int kb = 0; kb < 2; ++kb) { const int kbase = k0 + 32 * kb + 4 * h;
#pragma unroll
                        for (int i = 0; i < 16; ++i) { const int key = kbase + 8 * (i >> 2) + (i & 3); const float v = (key <= tq) ? s[kb][i] : -1e30f; s[kb][i] = v; mx = fmaxf(mx, v); } }
                } else {
#pragma unroll
                    for (int kb = 0; kb < 2; ++kb)
#pragma unroll
                        for (int i = 0; i < 16; ++i) mx = fmaxf(mx, s[kb][i]);
                }
                mx = fmaxf(mx, __shfl_xor(mx, 32));
                const float m_new = fmaxf(m_run, mx), alpha = fast_exp2(m_run - m_new);
                m_run = m_new;
                float ls = 0.f;
#pragma unroll
                for (int kb = 0; kb < 2; ++kb) {
#pragma unroll
                    for (int i = 0; i < 16; ++i) { const float p = fast_exp2(s[kb][i] - m_new); s[kb][i] = p; ls += p; }
#pragma unroll
                    for (int sp = 0; sp < 2; ++sp) { u32x4 p; p.x = cvt_pk(s[kb][8 * sp], s[kb][8 * sp + 1]); p.y = cvt_pk(s[kb][8 * sp + 2], s[kb][8 * sp + 3]); p.z = cvt_pk(s[kb][8 * sp + 4], s[kb][8 * sp + 5]); p.w = cvt_pk(s[kb][8 * sp + 6], s[kb][8 * sp + 7]);
                        pf[kb][sp] = __builtin_bit_cast(bf16x8, p); }
                }
                l_run = l_run * alpha + ls;
                if (!__all(alpha == 1.f)) {
#pragma unroll
                    for (int d = 0; d < 4; ++d)
#pragma unroll
                        for (int i = 0; i < 16; ++i) o[d][i] *= alpha;
                }
            }
            if (MODE == 1) {
                __builtin_amdgcn_sched_barrier(0);
#pragma unroll
                for (int d = 2; d < 4; ++d)
#pragma unroll
                    for (int kb = 0; kb < 2; ++kb)
#pragma unroll
                        for (int sp = 0; sp < 2; ++sp) vf[d][kb][sp] = *(const LAS bf16x8*)(lds + bo + vfrag + d * 32 * VP + (32 * kb + 16 * sp) * 2);
                __builtin_amdgcn_sched_barrier(0);
            }
#pragma unroll
            for (int d = 0; d < 4; ++d)
#pragma unroll
                for (int kb = 0; kb < 2; ++kb)
#pragma unroll
                    for (int sp = 0; sp < 2; ++sp) {
                        const bf16x8 a = (MODE == 1) ? vf[d][kb][sp] : *(const LAS bf16x8*)(lds + bo + vfrag + d * 32 * VP + (32 * kb + 16 * sp) * 2);
                        o[d] = __builtin_amdgcn_mfma_f32_32x32x16_bf16(a, pf[kb][sp], o[d], 0, 0, 0);
                    }
        }
        if (t > 0) ATT_STORE((cur ^ 1) * BUF_BYTES);
        if (MODE == 0) { if (lane == 0) flags[(it & 1) * 8 + wid] = wdone ? 1 : 0; }
        __syncthreads();
        if (t == 0) break;
        if (MODE == 0) { int alld = 1;
#pragma unroll
            for (int w2 = 0; w2 < 8; ++w2) alld &= flags[(it & 1) * 8 + w2];
            if (alld) break; }
        cur ^= 1;
    }
#undef ATT_LOAD
#undef ATT_STORE
    const size_t tok = tokbase + tq;
    if (MODE == 0) {
        const bf16_t* gp = PROJ + tok * NPROJ + PG_SB + hh * 128 + 4 * h;
        bf16_t* op = MIXED + tok * DM + hh * 128 + 4 * h;
#pragma unroll
        for (int d = 0; d < 4; ++d)
#pragma unroll
            for (int g = 0; g < 4; ++g) { const u32x2 gw = *(const u32x2*)(gp + 32 * d + 8 * g);
                u32x2 ow; ow.x = cvt_pk(o[d][4 * g] * bf_lo(gw.x), o[d][4 * g + 1] * bf_hi(gw.x)); ow.y = cvt_pk(o[d][4 * g + 2] * bf_lo(gw.y), o[d][4 * g + 3] * bf_hi(gw.y));
                *(u32x2*)(op + 32 * d + 8 * g) = ow; }
    } else {
        const float lt = l_run + __shfl_xor(l_run, 32);
        const float inv = 1.f / lt;
        LAS float* xq = (LAS float*)lds + (qg * 32 + r) * XP + 4 * h;
        if (role == 1) {
            const float f = inv * lam;
#pragma unroll
            for (int d = 0; d < 4; ++d)
#pragma unroll
                for (int g = 0; g < 4; ++g) *(LAS f32x4*)(xq + 32 * d + 8 * g) = (f32x4){o[d][4 * g] * f, o[d][4 * g + 1] * f, o[d][4 * g + 2] * f, o[d][4 * g + 3] * f};
        }
        __syncthreads();
        if (role == 0) {
            float q = 0.f;
#pragma unroll
            for (int d = 0; d < 4; ++d)
#pragma unroll
                for (int g = 0; g < 4; ++g) { const f32x4 x2 = *(const LAS f32x4*)(xq + 32 * d + 8 * g);
#pragma unroll
                    for (int j = 0; j < 4; ++j) { const float v = o[d][4 * g + j] * inv - x2[j]; o[d][4 * g + j] = v; q += v * v; } }
            q += __shfl_xor(q, 32);
            const float rs = rsqrtf(q * (1.f / 128.f) + SUBLN_EPS) * (1.f - LAMBDA_INIT);
            const bf16_t* gp = PROJ + tok * NPROJ + PG_DF + hh * 128 + 4 * h;
            bf16_t* op = MIXED + tok * DM + 1024 + hh * 128 + 4 * h;
            const float* sg = subln_g + 4 * h;
#pragma unroll
            for (int d = 0; d < 4; ++d)
#pragma unroll
                for (int g = 0; g < 4; ++g) { const u32x2 gw = *(const u32x2*)(gp + 32 * d + 8 * g); const f32x4 sv = *(const f32x4*)(sg + 32 * d + 8 * g);
                    u32x2 ow; ow.x = cvt_pk(o[d][4 * g] * rs * sv[0] * bf_lo(gw.x), o[d][4 * g + 1] * rs * sv[1] * bf_hi(gw.x));
                    ow.y = cvt_pk(o[d][4 * g + 2] * rs * sv[2] * bf_lo(gw.y), o[d][4 * g + 3] * rs * sv[3] * bf_hi(gw.y));
                    *(u32x2*)(op + 32 * d + 8 * g) = ow; }
        }
    }
}
}
__device__ __forceinline__ int win_dst_row(int c) {
    const int seg = c >> 10, w = c & 1023, d6 = w & 63;
    const int wp = d6 < 16 ? (w & ~63) + (d6 < 8 ? 2 * d6 : 2 * (d6 - 8) + 1) : w;
    switch (seg) { case 0: return w; case 1: return 1024 + w; case 2: return 6144 + w; case 3: return 2048 + w;
                   case 4: return 3072 + wp; case 5: return 4096 + wp; case 6: return 7168 + w; default: return 5120 + w; }
}
template <bool WIN>
__device__ __forceinline__ void p0_transpose_item(const float* __restrict__ W, int K, int N, bf16_t* __restrict__ WT, const float* __restrict__ kscale, LAS float* scr, int item, int lane) {
    const int nblk = N / 32, kb = item / nblk, nb = item % nblk, k0 = 64 * kb, n0 = 32 * nb;
#pragma unroll
    for (int i = 0; i < 32; ++i) { const int kk = 2 * i + (lane >> 5); float v = W[(size_t)(k0 + kk) * N + n0 + (lane & 31)]; if (kscale) v *= kscale[k0 + kk]; scr[kk * 33 + (lane & 31)] = v; }
    asm volatile("s_waitcnt lgkmcnt(0)" ::: "memory");
    const int c = lane & 7;
#pragma unroll
    for (int j = 0; j < 4; ++j) { const int n = (lane >> 3) + 8 * j; const LAS float* s = scr + (8 * c) * 33 + n;
        u32x4 o; o.x = cvt_pk(s[0 * 33], s[1 * 33]); o.y = cvt_pk(s[2 * 33], s[3 * 33]); o.z = cvt_pk(s[4 * 33], s[5 * 33]); o.w = cvt_pk(s[6 * 33], s[7 * 33]);
        const int dn = WIN ? win_dst_row(n0 + n) : (n0 + n);
        *(u32x4*)(WT + (size_t)dn * K + k0 + 8 * c) = o; }
    asm volatile("s_waitcnt lgkmcnt(0)" ::: "memory");
}
__device__ __forceinline__ void rms_row_to_bf16(const float* __restrict__ xrow, const float* __restrict__ g, bf16_t* __restrict__ orow, int lane) {
    const f32x4* xr = (const f32x4*)xrow + lane; f32x4 v[8]; float s = 0.f;
#pragma unroll
    for (int j = 0; j < 8; ++j) { v[j] = xr[64 * j]; s += (v[j][0] * v[j][0] + v[j][1] * v[j][1]) + (v[j][2] * v[j][2] + v[j][3] * v[j][3]); }
    const float rstd = rsqrtf(wave_sum(s) * (1.f / DM) + NORM_EPS);
    const f32x4* gr = (const f32x4*)g + lane; u32x2* o8 = (u32x2*)orow + lane;
#pragma unroll
    for (int j = 0; j < 8; ++j) { const f32x4 gv = gr[64 * j]; u32x2 w; w.x = cvt_pk(v[j][0] * rstd * gv[0], v[j][1] * rstd * gv[1]); w.y = cvt_pk(v[j][2] * rstd * gv[2], v[j][3] * rstd * gv[3]); o8[64 * j] = w; }
}

struct Args { const float* in[14]; float* out; unsigned char* ws; };

__global__ void __launch_bounds__(512, 2) fwd_megakernel(Args a) {
    extern __shared__ __attribute__((aligned(16))) unsigned char lds_raw[];
    LAS unsigned char* lds = (LAS unsigned char*)lds_raw;
    cg::grid_group grid = cg::this_grid();
    const int tid = threadIdx.x, lane = tid & 63, wave = __builtin_amdgcn_readfirstlane(tid >> 6);
    const int G = gridDim.x, bx = blockIdx.x;
    const int vcu = (G % 8 == 0) ? (bx % 8) * (G / 8) + bx / 8 : bx;
    unsigned char* ws = a.ws;
    float* ss2 = (float*)(ws + WS_CTL + CTL_SS2); float* ss3 = (float*)(ws + WS_CTL + CTL_SS3); float* lamp = (float*)(ws + WS_CTL + CTL_LAM); float* rope = (float*)(ws + WS_CTL + CTL_ROPE);
    bf16_t* WIN = (bf16_t*)(ws + WS_WIN); bf16_t* WOUT = (bf16_t*)(ws + WS_WOUT); bf16_t* WGATE = (bf16_t*)(ws + WS_WGATE); bf16_t* WPROJ = (bf16_t*)(ws + WS_WPROJ);
    bf16_t* PB = (bf16_t*)(ws + WS_PB); bf16_t* XN = (bf16_t*)(ws + WS_XN); bf16_t* MIXED = (bf16_t*)(ws + WS_MIXED); bf16_t* PROJ = (bf16_t*)(ws + WS_PROJ);
    bf16_t* VT = (bf16_t*)(ws + WS_VT); bf16_t* KIMG = (bf16_t*)(ws + WS_KIMG); bf16_t* HB = (bf16_t*)(ws + WS_HB); bf16_t* PLEB = (bf16_t*)(ws + WS_PLE); bf16_t* H2B = (bf16_t*)(ws + WS_H2B);
    const float* x = a.in[0]; float* out = a.out;

    for (int rep_ = 0; rep_ < ((PROBE_DUP & 1) ? 2 : 1); ++rep_) {
        if (rep_) __syncthreads();
        const int gw = bx * 8 + wave, NGW = G * 8; const int gt = bx * 512 + tid, NGT = G * 512;
        for (int i = gt; i < 2 * NTOK; i += NGT) ss2[i] = 0.f;
        if (gt == 0) { float s1 = 0.f, s2 = 0.f; for (int i = 0; i < 64; ++i) { s1 += a.in[4][i] * a.in[5][i]; s2 += a.in[6][i] * a.in[7][i]; } lamp[0] = expf(s1) - expf(s2) + LAMBDA_INIT; }
        for (int i = gt; i < SEQ * 8; i += NGT) { const int pos = i >> 3, f = i & 7;
            const float invf = (float)exp2(-(double)f * 0.125 * 18.931568569324174);
            const float angf = (float)pos * invf;
            const double tw = 6.283185307179586476925; double ang = (double)angf; ang -= tw * rint(ang / tw);
            rope[2 * i] = (float)cos(ang); rope[2 * i + 1] = (float)sin(ang); }
        LAS float* scr = (LAS float*)(lds + wave * 16384);
        constexpr int I_IN = (DM / 64) * (8192 / 32), I_SQ = (DM / 64) * (DM / 32), I_PR = (PLE / 64) * (DM / 32);
        for (int it = gw; it < I_IN + 2 * I_SQ + I_PR; it += NGW) {
            int rr = it;
            if (rr < I_IN) { p0_transpose_item<true>(a.in[3], DM, 8192, WIN, nullptr, scr, rr, lane); continue; } rr -= I_IN;
            if (rr < I_SQ) { p0_transpose_item<false>(a.in[9], DM, DM, WOUT, nullptr, scr, rr, lane); continue; } rr -= I_SQ;
            if (rr < I_SQ) { p0_transpose_item<false>(a.in[11], DM, DM, WGATE, a.in[10], scr, rr, lane); continue; } rr -= I_SQ;
            p0_transpose_item<false>(a.in[12], PLE, DM, WPROJ, nullptr, scr, rr, lane);
        }
        for (int m = gw; m < NTOK; m += NGW) rms_row_to_bf16(x + (size_t)m * DM, a.in[2], XN + (size_t)m * DM, lane);
        for (int i = gt; i < NTOK * PLE / 8; i += NGT) { const f32x4 v0 = ((const f32x4*)a.in[1])[2 * i], v1 = ((const f32x4*)a.in[1])[2 * i + 1];
            u32x4 w; w.x = cvt_pk(v0[0], v0[1]); w.y = cvt_pk(v0[2], v0[3]); w.z = cvt_pk(v1[0], v1[1]); w.w = cvt_pk(v1[2], v1[3]); ((u32x4*)PB)[i] = w; }
    }
    grid.sync();
    for (int rep_ = 0; rep_ < ((PROBE_DUP & 2) ? 2 : 1); ++rep_) {
        if (rep_) __syncthreads();
        { pg8::Gemm g{XN, WIN, NTOK, NPROJ, DM}; pg8::StaticOrder S; S.init(NTOK, NPROJ, G, bx); pg8::EpiProj E{PROJ, rope, KIMG};
          pg8::gemm_phase<pg8::EpiProj, pg8::StaticOrder, true, true>(lds, g, S, E); }
        __syncthreads();
        { pg8::Gemm g{WIN + (size_t)NPROJ * DM, XN, 2048, NTOK, DM}; pg8::StaticOrder S; S.init(2048, NTOK, G, bx); pg8::EpiVt E{VT};
          pg8::gemm_phase<pg8::EpiVt, pg8::StaticOrder, true, true>(lds, g, S, E); }
    }
    grid.sync();
    for (int rep_ = 0; rep_ < ((PROBE_DUP & 4) ? 2 : 1); ++rep_) {
        const float lam = lamp[0];
        for (int su = vcu; su < 256; su += G) {
            const int grp = su >> 4, j = su & 15;
#pragma unroll 1
            for (int k = 0; k < 4; ++k) { const int bh = 4 * grp + k; const int qb = (k & 1) ? 15 - j : j;
                att::attn_unit<1>(lds, PROJ, KIMG, VT, MIXED, bh >> 3, bh & 7, qb, lam, a.in[8]); }
        }
#pragma unroll 1
        for (int u = vcu; u < 512; u += G) att::attn_unit<0>(lds, PROJ, KIMG, VT, MIXED, (u >> 3) >> 3, (u >> 3) & 7, u & 7, lam, a.in[8]);
    }
    grid.sync();
    {
        __syncthreads();
        { pg8::Gemm g{MIXED, WOUT, NTOK, DM, DM}; pg8::StaticOrder S; S.init(NTOK, DM, G, bx); pg8::EpiRes E{x, HB, ss2};
          pg8::gemm_phase<pg8::EpiRes, pg8::StaticOrder, true, true>(lds, g, S, E); }
        __syncthreads();
        { pg8::Gemm g{PB, WPROJ, NTOK, DM, PLE}; pg8::StaticOrder S; S.init(NTOK, DM, G, bx); pg8::EpiBf16 E{PLEB, DM};
          pg8::gemm_phase<pg8::EpiBf16, pg8::StaticOrder, true, true>(lds, g, S, E); }
    }
    grid.sync();
    {
        pg8::Gemm g{HB, WGATE, NTOK, DM, DM}; pg8::StaticOrder S; S.init(NTOK, DM, G, bx); pg8::EpiGate E{HB, H2B, PLEB, ss2, ss3};
        pg8::gemm_phase<pg8::EpiGate, pg8::StaticOrder, true, true>(lds, g, S, E);
    }
    grid.sync();
    {
        const int tid5 = opaque_tid(), lane = tid5 & 63, wave = __builtin_amdgcn_readfirstlane(tid5 >> 6);
        const int gw = bx * 8 + wave, NGW = G * 8; const f32x4* gr = (const f32x4*)a.in[13];
        for (int m = gw; m < NTOK; m += NGW) { const float rstd = rsqrtf(ss3[m] * (1.f / DM) + NORM_EPS); f32x4* orow = (f32x4*)(out + (size_t)m * DM); const u32x4* hrow = (const u32x4*)(H2B + (size_t)m * DM);
#pragma unroll
            for (int j = 0; j < 4; ++j) { const int c = lane + 64 * j; const u32x4 hw = hrow[c]; const f32x4 g0 = gr[2 * c], g1 = gr[2 * c + 1];
                orow[2 * c] = (f32x4){bf_lo(hw.x) * rstd * g0[0], bf_hi(hw.x) * rstd * g0[1], bf_lo(hw.y) * rstd * g0[2], bf_hi(hw.y) * rstd * g0[3]};
                orow[2 * c + 1] = (f32x4){bf_lo(hw.z) * rstd * g1[0], bf_hi(hw.z) * rstd * g1[1], bf_lo(hw.w) * rstd * g1[2], bf_hi(hw.w) * rstd * g1[3]}; } }
    }
}

extern "C" void kernel_launch(void* const* d_in, const int* in_sizes, int n_in, void* d_out, int out_size, void* d_ws, size_t ws_size, hipStream_t stream) {
    static int grid = 0;
    if (grid == 0) {
        if (n_in != 14 || out_size != NTOK * DM || ws_size < WS_END) { fprintf(stderr, "kernel_launch: unexpected shapes (n_in %d out %d ws %zu)\n", n_in, out_size, ws_size); grid = -1; return; }
        int dev = 0, cus = 0, per_cu = 0;
        (void)hipGetDevice(&dev); (void)hipDeviceGetAttribute(&cus, hipDeviceAttributeMultiprocessorCount, dev);
        (void)hipFuncSetAttribute((const void*)fwd_megakernel, hipFuncAttributeMaxDynamicSharedMemorySize, LDS_BYTES);
        (void)hipOccupancyMaxActiveBlocksPerMultiprocessor(&per_cu, (const void*)fwd_megakernel, 512, LDS_BYTES);
        if (per_cu < 1) { fprintf(stderr, "kernel_launch: occupancy query says %d blocks/CU\n", per_cu); per_cu = 1; }
        grid = cus * per_cu;
    }
    if (grid < 0) return;
    Args a{};
    for (int i = 0; i < 14; ++i) a.in[i] = (const float*)d_in[i];
    a.out = (float*)d_out; a.ws = (unsigned char*)d_ws;
    void* args[] = {&a};
    hipError_t e = hipLaunchCooperativeKernel((void*)fwd_megakernel, dim3(grid), dim3(512), args, LDS_BYTES, stream);
    if (e != hipSuccess) fprintf(stderr, "cooperative launch failed: %s (grid %d)\n", hipGetErrorString(e), grid);
}
```

```cpp
#include <hip/hip_runtime.h>
#include <hip/hip_cooperative_groups.h>
#include <cstdio>
#include <cstdint>
namespace cg = cooperative_groups;
__device__ __forceinline__ int opaque_tid() { int t = (int)threadIdx.x; asm volatile("" : "+v"(t)); return t; }
#ifndef PROBE_DUP
#define PROBE_DUP 0
#endif
namespace pg8 {
#define PG8_LAS __attribute__((address_space(3)))
typedef unsigned short bf16_t;
typedef short bf16x8 __attribute__((ext_vector_type(8)));
typedef float f32x4 __attribute__((ext_vector_type(4)));
typedef unsigned u32x4 __attribute__((ext_vector_type(4)));
constexpr int BM = 256, BK = 64, HALF = 128, HTB = HALF * BK * 2  , STAGE_BYTES = 8 * HTB, NXCD = 8, WGM = 8;

__host__ __device__ __forceinline__ int lds_byte(int r, int c) { const int st = (r >> 4) * 2 + (c >> 5), rr = r & 15, cc = c & 31, ob = rr * 64 + cc * 2; return st * 1024 + (ob ^ (((ob >> 9) & 1) << 5)); }
__host__ __device__ __forceinline__ void stage_rc(int b, int& R, int& C) { const int st = b / 1024, sb = b % 1024, swz = sb ^ (((sb >> 9) & 1) << 5); R = (st >> 1) * 16 + swz / 64; C = (st & 1) * 32 + (swz % 64) / 2; }
__host__ __device__ __forceinline__ int perm32(int rho) { const int n = rho >> 4, i = rho & 15; return 8 * (i >> 2) + 4 * n + (i & 3); }

struct Unit { int pm, pn; };
struct Gemm { const bf16_t* A; const bf16_t* Bt; int M, N, K; };

struct StaticOrder {
    int nM, nN, nwg, G, c;
    __host__ __device__ void init(int M, int N, int G_, int c_) { nM = M / BM; nN = N / BM; nwg = nM * nN; G = G_; c = c_; }
    __host__ __device__ bool next(int i, Unit& u) const {
        const long L = (long)i * G + c; if (L >= nwg) return false;
        int wgid = (int)L; { const int q = nwg / NXCD, r = nwg % NXCD, xcd = wgid % NXCD, off = wgid / NXCD; wgid = (xcd < r ? xcd * (q + 1) : r * (q + 1) + (xcd - r) * q) + off; }
        const int nig = WGM * nN, gid = wgid / nig, fm = gid * WGM, gsz = (nM - fm) < WGM ? (nM - fm) : WGM;
        u.pm = fm + ((wgid % nig) % gsz); u.pn = (wgid % nig) / gsz; return true;
    }
    __device__ __forceinline__ void a_ready(const Unit&) const {}
    __device__ __forceinline__ void done(const Unit&) const {}
};

__device__ __forceinline__ unsigned cvt_pk_bf16(float lo, float hi) { unsigned r; asm volatile("v_cvt_pk_bf16_f32 %0, %1, %2" : "=v"(r) : "v"(lo), "v"(hi)); return r; }
typedef float f32x2 __attribute__((ext_vector_type(2)));
template <class Epi, class Sched, bool ALIGN_EPI = false, bool SP2 = false>
__device__ __forceinline__ void gemm_phase(PG8_LAS unsigned char* lds, const Gemm g, const Sched& S, const Epi& E) {
    const int tid = opaque_tid(), wid = __builtin_amdgcn_readfirstlane(tid >> 6), lane = tid & 63, wr = wid >> 2, wc = wid & 3, fr = lane & 15, fq = lane >> 4;
    const int K = g.K, nt = K / BK;
    unsigned voffA[2], voffB[2];
#pragma unroll
    for (int i = 0; i < 2; ++i) { int R, C; stage_rc(tid * 16 + i * 8192, R, C); const int Rb = Epi::PERM ? ((R & ~31) + perm32(R & 31)) : R;
        voffA[i] = (unsigned)(R * K + C) * 2u; voffB[i] = (unsigned)(Rb * K + C) * 2u; }
    const size_t kstep = (size_t)(BK * 2);
    const size_t hstep = (size_t)HALF * K * 2;
    const size_t tstep = 2 * hstep;
    const unsigned ldsw = (unsigned)wid * 1024u;
    const int aoff = lds_byte(wr * 64 + fr, fq * 8), boff = lds_byte(wc * 32 + fr, fq * 8);
#define PG8_SA(b, h) (((b) * 2 + (h)) * HTB)
#define PG8_SB(b, h) ((4 + (b) * 2 + (h)) * HTB)
#define PG8_STAGE(bufoff, gbase, voff) do { _Pragma("unroll") for (int _i = 0; _i < 2; ++_i) \
        __builtin_amdgcn_global_load_lds((const unsigned*)((const char*)(gbase) + (voff)[_i]), (PG8_LAS unsigned*)(lds + (bufoff) + ldsw + _i * 8192), 16, 0, 0); } while (0)
#define PG8_LDA(dst, b, h) do { _Pragma("unroll") for (int m = 0; m < 4; ++m) _Pragma("unroll") for (int k = 0; k < 2; ++k) dst[m][k] = *(const PG8_LAS bf16x8*)(lds + PG8_SA(b, h) + aoff + m * 2048 + k * 1024); } while (0)
#define PG8_LDB(dst, b, h) do { _Pragma("unroll") for (int n = 0; n < 2; ++n) _Pragma("unroll") for (int k = 0; k < 2; ++k) dst[n][k] = *(const PG8_LAS bf16x8*)(lds + PG8_SB(b, h) + boff + n * 2048 + k * 1024); } while (0)
#define PG8_MMA(ai, bj, At, Bt) do { __builtin_amdgcn_s_setprio(1); _Pragma("unroll") for (int m = 0; m < 4; ++m) _Pragma("unroll") for (int n = 0; n < 2; ++n) _Pragma("unroll") for (int k = 0; k < 2; ++k) \
        acc[ai][bj][m][n] = __builtin_amdgcn_mfma_f32_16x16x32_bf16(Bt[n][k], At[m][k], acc[ai][bj][m][n], 0, 0, 0); __builtin_amdgcn_s_setprio(0); } while (0)
#define PG8_WAIT_V(n) asm volatile("s_waitcnt vmcnt(" #n ")" ::: "memory")
#define PG8_WAIT_L(n) asm volatile("s_waitcnt lgkmcnt(" #n ")" ::: "memory")
#define PG8_BAR __builtin_amdgcn_s_barrier()
#define PG8_SCHED __builtin_amdgcn_sched_barrier(0)
    Unit cur, nxt; int ui = 0;
    if (!S.next(0, cur)) return;
    f32x4 acc[2][2][4][2];
#pragma unroll
    for (int a = 0; a < 2; ++a)
#pragma unroll
        for (int b = 0; b < 2; ++b)
#pragma unroll
            for (int m = 0; m < 4; ++m)
#pragma unroll
                for (int n = 0; n < 2; ++n) acc[a][b][m][n] = (f32x4){0.f, 0.f, 0.f, 0.f};
    bf16x8 At[4][2], B0[2][2], B1[2][2];
    const char* cA = (const char*)g.A + (size_t)cur.pm * tstep; const char* cB = (const char*)g.Bt + (size_t)cur.pn * tstep;
    S.a_ready(cur);
    if constexpr (SP2) {
        PG8_STAGE(PG8_SB(0, 0), cB, voffB); PG8_STAGE(PG8_SB(0, 1), cB + hstep, voffB); PG8_STAGE(PG8_SA(0, 0), cA, voffA); PG8_STAGE(PG8_SA(0, 1), cA + hstep, voffA);
        if (wr == 1) PG8_BAR;
        PG8_WAIT_V(2); PG8_BAR;
        PG8_STAGE(PG8_SB(1, 0), cB + kstep, voffB); PG8_STAGE(PG8_SA(1, 0), cA + kstep, voffA); PG8_STAGE(PG8_SB(1, 1), cB + hstep + kstep, voffB);
        PG8_WAIT_V(6); PG8_BAR;
    } else {
        PG8_STAGE(PG8_SB(0, 0), cB, voffB); PG8_STAGE(PG8_SA(0, 0), cA, voffA); PG8_STAGE(PG8_SB(0, 1), cB + hstep, voffB); PG8_STAGE(PG8_SA(0, 1), cA + hstep, voffA);
        if (wr == 1) PG8_BAR;
        PG8_WAIT_V(4); PG8_BAR;
        PG8_STAGE(PG8_SB(1, 0), cB + kstep, voffB); PG8_STAGE(PG8_SA(1, 0), cA + kstep, voffA); PG8_STAGE(PG8_SB(1, 1), cB + hstep + kstep, voffB);
        PG8_WAIT_V(6); PG8_BAR;
    }
    for (;;) {
        const bool has_next = S.next(ui + 1, nxt);
        const char* nA = has_next ? (const char*)g.A + (size_t)nxt.pm * tstep : cA; const char* nB = has_next ? (const char*)g.Bt + (size_t)nxt.pn * tstep : cB;
        for (int t = 0; t < nt; t += 2) {
            const bool last = (t == nt - 2);
            const char* a1 = cA + (size_t)(t + 1) * kstep;
            const char* a2 = last ? nA : cA + (size_t)(t + 2) * kstep; const char* b2 = last ? nB : cB + (size_t)(t + 2) * kstep;
            const char* a3 = a2 + kstep; const char* b3 = b2 + kstep;
            if (last && has_next) S.a_ready(nxt);
            if constexpr (SP2) {
            PG8_LDB(B0, 0, 0); PG8_LDB(B1, 0, 1); PG8_SCHED; PG8_LDA(At, 0, 0); PG8_STAGE(PG8_SA(1, 1), a1 + hstep, voffA);
            PG8_WAIT_V(8); PG8_WAIT_L(0); PG8_BAR; PG8_MMA(0, 0, At, B0); PG8_MMA(0, 1, At, B1); PG8_BAR; PG8_SCHED;
            PG8_LDA(At, 0, 1); PG8_STAGE(PG8_SB(0, 0), b2, voffB); PG8_STAGE(PG8_SB(0, 1), b2 + hstep, voffB); PG8_STAGE(PG8_SA(0, 0), a2, voffA);
            PG8_WAIT_V(8); PG8_WAIT_L(0); PG8_BAR; PG8_MMA(1, 0, At, B0); PG8_MMA(1, 1, At, B1); PG8_BAR; PG8_SCHED;
            PG8_LDB(B0, 1, 0); PG8_LDB(B1, 1, 1); PG8_SCHED; PG8_LDA(At, 1, 0); PG8_STAGE(PG8_SA(0, 1), a2 + hstep, voffA);
            PG8_WAIT_V(8); PG8_WAIT_L(0); PG8_BAR; PG8_MMA(0, 0, At, B0); PG8_MMA(0, 1, At, B1); PG8_BAR; PG8_SCHED;
            PG8_LDA(At, 1, 1); PG8_STAGE(PG8_SB(1, 0), b3, voffB); PG8_STAGE(PG8_SB(1, 1), b3 + hstep, voffB); PG8_STAGE(PG8_SA(1, 0), a3, voffA);
            PG8_WAIT_V(8); PG8_WAIT_L(0); PG8_BAR; PG8_MMA(1, 0, At, B0); PG8_MMA(1, 1, At, B1); PG8_BAR; PG8_SCHED;
            } else {
            PG8_LDB(B0, 0, 0); PG8_SCHED; PG8_LDA(At, 0, 0); PG8_STAGE(PG8_SA(1, 1), a1 + hstep, voffA);
            PG8_WAIT_L(8); PG8_BAR; PG8_WAIT_L(0); PG8_MMA(0, 0, At, B0); PG8_BAR; PG8_SCHED;
            PG8_LDB(B1, 0, 1); PG8_STAGE(PG8_SB(0, 0), b2, voffB);
            PG8_BAR; PG8_WAIT_L(0); PG8_MMA(0, 1, At, B1); PG8_BAR;
            PG8_LDA(At, 0, 1); PG8_STAGE(PG8_SA(0, 0), a2, voffA);
            PG8_BAR; PG8_WAIT_L(0); PG8_MMA(1, 0, At, B0); PG8_BAR; PG8_SCHED;
            PG8_STAGE(PG8_SB(0, 1), b2 + hstep, voffB);
            PG8_WAIT_V(6); PG8_BAR; PG8_MMA(1, 1, At, B1); PG8_BAR;
            PG8_LDB(B0, 1, 0); PG8_SCHED; PG8_LDA(At, 1, 0); PG8_STAGE(PG8_SA(0, 1), a2 + hstep, voffA);
            PG8_WAIT_L(8); PG8_BAR; PG8_WAIT_L(0); PG8_MMA(0, 0, At, B0); PG8_BAR; PG8_SCHED;
            PG8_LDB(B1, 1, 1); PG8_STAGE(PG8_SB(1, 0), b3, voffB);
            PG8_BAR; PG8_WAIT_L(0); PG8_MMA(0, 1, At, B1); PG8_BAR;
            PG8_LDA(At, 1, 1); PG8_STAGE(PG8_SA(1, 0), a3, voffA);
            PG8_BAR; PG8_WAIT_L(0); PG8_MMA(1, 0, At, B0); PG8_BAR; PG8_SCHED;
            PG8_STAGE(PG8_SB(1, 1), b3 + hstep, voffB);
            PG8_WAIT_V(6); PG8_BAR; PG8_MMA(1, 1, At, B1); PG8_BAR;
            }
        }
        if constexpr (ALIGN_EPI) { if (wr == 0) PG8_BAR; }
        if constexpr (!Epi::AFTER_DRAIN) { E(acc, cur, wr, wc, fr, fq); S.done(cur); }
        if (!has_next) break;
#pragma unroll
        for (int a = 0; a < 2; ++a)
#pragma unroll
            for (int b = 0; b < 2; ++b)
#pragma unroll
                for (int m = 0; m < 4; ++m)
#pragma unroll
                    for (int n = 0; n < 2; ++n) acc[a][b][m][n] = (f32x4){0.f, 0.f, 0.f, 0.f};
        cur = nxt; cA = nA; cB = nB; ++ui;
        if constexpr (ALIGN_EPI) { if (wr == 1) PG8_BAR; }
    }
    PG8_WAIT_V(0);
    if constexpr (!ALIGN_EPI) { if (wr == 0) PG8_BAR; }
    PG8_BAR;
    if constexpr (Epi::AFTER_DRAIN) { E.fused(acc, cur, wr, wc, fr, fq, lds, wid, lane); S.done(cur); }
#undef PG8_SA
#undef PG8_SB
#undef PG8_STAGE
#undef PG8_LDA
#undef PG8_LDB
#undef PG8_MMA
#undef PG8_WAIT_V
#undef PG8_WAIT_L
#undef PG8_BAR
#undef PG8_SCHED
}
}
#define LAS __attribute__((address_space(3)))
typedef unsigned short bf16_t;
typedef short bf16x8 __attribute__((ext_vector_type(8)));
typedef float f32x4 __attribute__((ext_vector_type(4)));
typedef float f32x2 __attribute__((ext_vector_type(2)));
typedef float f32x16 __attribute__((ext_vector_type(16)));
typedef unsigned u32x4 __attribute__((ext_vector_type(4)));
typedef unsigned u32x2 __attribute__((ext_vector_type(2)));

constexpr int NTOK = 16384, DM = 2048, SEQ = 2048, NBATCH = 8, PLE = 256;
constexpr int NPROJ = 6144;
constexpr int PQ_SB = 0, PK_SB = 1024, PG_SB = 2048, PQ_DF = 3072, PK_DF = 4096, PG_DF = 5120;
constexpr float LOG2E = 1.4426950408889634f;
constexpr float SBQ_SCALE = 0.08838834764831845f * LOG2E;
constexpr float DFQ_SCALE = 0.125f * LOG2E;
constexpr float NORM_EPS = 1e-6f, SUBLN_EPS = 1e-5f;
constexpr float LAMBDA_INIT = 0.2f;

constexpr size_t MiB = 1u << 20;
constexpr size_t WS_CTL = 0;
constexpr size_t CTL_SS2 = 0, CTL_SS3 = 65536, CTL_LAM = 131072, CTL_ROPE = 262144, CTL_BAR = 524288, CTL_BAR_BYTES = 16384;
constexpr size_t WS_WIN = 2 * MiB, WS_WOUT = 34 * MiB, WS_WGATE = 42 * MiB, WS_WPROJ = 50 * MiB, WS_PB = 52 * MiB;
constexpr size_t WS_XN = 64 * MiB, WS_MIXED = 64 * MiB;
constexpr size_t WS_PROJ = 128 * MiB, WS_VT = 320 * MiB, WS_KIMG = 384 * MiB, WS_END = 448 * MiB;
constexpr size_t WS_HB = 128 * MiB, WS_PLE = 192 * MiB;
constexpr size_t WS_H2B = 64 * MiB;

constexpr int LDS_BYTES = 131072 + 1024;

__device__ __forceinline__ unsigned cvt_pk(float lo, float hi) { unsigned r; asm volatile("v_cvt_pk_bf16_f32 %0, %1, %2" : "=v"(r) : "v"(lo), "v"(hi)); return r; }
__device__ __forceinline__ float bf_lo(unsigned w) { return __uint_as_float(w << 16); }
__device__ __forceinline__ float bf_hi(unsigned w) { return __uint_as_float(w & 0xffff0000u); }
__device__ __forceinline__ float wave_sum(float v) {
#pragma unroll
    for (int o = 1; o < 64; o <<= 1) v += __shfl_xor(v, o);
    return v;
}
__device__ __forceinline__ float fast_exp2(float x) { return __builtin_amdgcn_exp2f(x); }
__device__ __forceinline__ float fast_log2(float x) { return __builtin_amdgcn_logf(x); }
__device__ __forceinline__ float silu_f(float x) { return x * __builtin_amdgcn_rcpf(1.f + fast_exp2(-x * LOG2E)); }
__device__ __forceinline__ float sigmoid_f(float x) { return __builtin_amdgcn_rcpf(1.f + fast_exp2(-x * LOG2E)); }

namespace pg8 {
struct EpiBf16 {
    static constexpr bool PERM = true, AFTER_DRAIN = false;
    bf16_t* O; int ldc;
    __device__ __forceinline__ void operator()(const f32x4 (&acc)[2][2][4][2], const Unit& u, int wr, int wc, int fr, int fq) const {
        const int row0 = u.pm * BM + wr * 64 + fr; const int col0 = u.pn * BM + wc * 32 + 8 * fq;
#pragma unroll
        for (int ai = 0; ai < 2; ++ai)
#pragma unroll
            for (int m = 0; m < 4; ++m) { bf16_t* rowp = O + (size_t)(row0 + ai * HALF + m * 16) * ldc + col0;
#pragma unroll
                for (int bj = 0; bj < 2; ++bj) { const f32x4 v0 = acc[ai][bj][m][0], v1 = acc[ai][bj][m][1];
                    u32x4 w; w.x = cvt_pk_bf16(v0[0], v0[1]); w.y = cvt_pk_bf16(v0[2], v0[3]); w.z = cvt_pk_bf16(v1[0], v1[1]); w.w = cvt_pk_bf16(v1[2], v1[3]);
                    *(u32x4*)(rowp + bj * HALF) = w; } }
    }
};
struct EpiProj {
    static constexpr bool PERM = true, AFTER_DRAIN = false;
    bf16_t* O; const float* rope; bf16_t* KI;
    __device__ __forceinline__ void operator()(const f32x4 (&acc)[2][2][4][2], const Unit& u, int wr, int wc, int fr, int fq) const {
        const int row0 = u.pm * BM + wr * 64 + fr; const int col0 = u.pn * BM + wc * 32 + 8 * fq;
        const int kind = u.pn >> 2;
        const bool dorope = (kind == 3 || kind == 4) && ((wc & 1) == 0) && (fq < 2);
        const float sc = kind == 0 ? SBQ_SCALE : (kind == 3 ? DFQ_SCALE : 1.f);
        const bool dosilu = (kind == 2 || kind == 5);
#pragma unroll
        for (int ai = 0; ai < 2; ++ai)
#pragma unroll
            for (int m = 0; m < 4; ++m) { const int row = row0 + ai * HALF + m * 16; bf16_t* rowp = O + (size_t)row * NPROJ + col0;
                if (kind == 1 || kind == 4) {
                    const int cw = col0 & 1023; rowp = KI + ((size_t)(((kind == 4 ? 8 : 0) + (row >> 11)) * 8 + (cw >> 7)) * SEQ + (row & (SEQ - 1))) * 128 + (cw & 127); }
                f32x4 cs0 = {1.f, 0.f, 1.f, 0.f}, cs1 = {1.f, 0.f, 1.f, 0.f};
                if (dorope) { const f32x4* rp = (const f32x4*)(rope + ((size_t)(row & (SEQ - 1)) * 8 + 4 * fq) * 2); cs0 = rp[0]; cs1 = rp[1]; }
#pragma unroll
                for (int bj = 0; bj < 2; ++bj) { f32x4 v0 = acc[ai][bj][m][0], v1 = acc[ai][bj][m][1];
                    if (dorope) {
                        f32x4 a, b;
                        a[0] = v0[0] * cs0[0] - v0[1] * cs0[1]; a[1] = v0[1] * cs0[0] + v0[0] * cs0[1];
                        a[2] = v0[2] * cs0[2] - v0[3] * cs0[3]; a[3] = v0[3] * cs0[2] + v0[2] * cs0[3];
                        b[0] = v1[0] * cs1[0] - v1[1] * cs1[1]; b[1] = v1[1] * cs1[0] + v1[0] * cs1[1];
                        b[2] = v1[2] * cs1[2] - v1[3] * cs1[3]; b[3] = v1[3] * cs1[2] + v1[2] * cs1[3];
                        v0 = a; v1 = b; }
                    if (dosilu) {
#pragma unroll
                        for (int j = 0; j < 4; ++j) { v0[j] = silu_f(v0[j]); v1[j] = silu_f(v1[j]); } }
                    v0 = v0 * sc; v1 = v1 * sc;
                    u32x4 w; w.x = cvt_pk_bf16(v0[0], v0[1]); w.y = cvt_pk_bf16(v0[2], v0[3]); w.z = cvt_pk_bf16(v1[0], v1[1]); w.w = cvt_pk_bf16(v1[2], v1[3]);
                    *(u32x4*)(rowp + ((kind == 1 || kind == 4) ? bj * SEQ * 128 : bj * HALF)) = w; } }
    }
};
struct EpiVt {
    static constexpr bool PERM = true, AFTER_DRAIN = false;
    bf16_t* O;
    __device__ __forceinline__ void operator()(const f32x4 (&acc)[2][2][4][2], const Unit& u, int wr, int wc, int fr, int fq) const {
        const int row0 = u.pm * BM + wr * 64 + fr; const int col0 = u.pn * BM + wc * 32 + 8 * fq;
        const int p0 = (fq & 1) ? 4 : 0, p1 = (fq & 1) ? 12 : 8;
#pragma unroll
        for (int ai = 0; ai < 2; ++ai)
#pragma unroll
            for (int m = 0; m < 4; ++m) { const int row = row0 + ai * HALF + m * 16; const int gh = row >> 7, d = row & 127;
#pragma unroll
                for (int bj = 0; bj < 2; ++bj) { const int col = col0 + bj * HALF; const int b = col >> 11, sq = col & (SEQ - 1);
                    bf16_t* tp = O + ((size_t)((((gh >> 3) * 8 + b) * 8 + (gh & 7)) * 32 + (sq >> 6)) * 128 + d) * 64 + (sq & 48);
                    const f32x4 v0 = acc[ai][bj][m][0], v1 = acc[ai][bj][m][1];
                    u32x2 w0, w1; w0.x = cvt_pk_bf16(v0[0], v0[1]); w0.y = cvt_pk_bf16(v0[2], v0[3]); w1.x = cvt_pk_bf16(v1[0], v1[1]); w1.y = cvt_pk_bf16(v1[2], v1[3]);
                    *(u32x2*)(tp + p0) = w0; *(u32x2*)(tp + p1) = w1; } }
    }
};
struct EpiRes {
    static constexpr bool PERM = false, AFTER_DRAIN = false;
    const float* x; bf16_t* hb; float* ss;
    __device__ __forceinline__ void operator()(const f32x4 (&acc)[2][2][4][2], const Unit& u, int wr, int wc, int fr, int fq) const {
        const int row0 = u.pm * BM + wr * 64 + fr; const int col0 = u.pn * BM + wc * 32 + 4 * fq;
#pragma unroll
        for (int ai = 0; ai < 2; ++ai)
#pragma unroll
            for (int m = 0; m < 4; ++m) { const int row = row0 + ai * HALF + m * 16; const size_t off = (size_t)row * DM + col0; float q = 0.f;
#pragma unroll
                for (int bj = 0; bj < 2; ++bj)
#pragma unroll
                    for (int n = 0; n < 2; ++n) { const size_t o2 = off + bj * HALF + n * 16; const f32x4 hv = *(const f32x4*)(x + o2) + acc[ai][bj][m][n];
                        u32x2 w; w.x = cvt_pk_bf16(hv[0], hv[1]); w.y = cvt_pk_bf16(hv[2], hv[3]); *(u32x2*)(hb + o2) = w;
                        q += (hv[0] * hv[0] + hv[1] * hv[1]) + (hv[2] * hv[2] + hv[3] * hv[3]); }
                q += __shfl_xor(q, 16); q += __shfl_xor(q, 32);
                if (fq == 0) atomicAdd(ss + row, q); }
    }
};
struct EpiGate {
    static constexpr bool PERM = false, AFTER_DRAIN = false;
    const bf16_t* hb; bf16_t* h2b; const bf16_t* ple; const float* ss2; float* ss3;
    __device__ __forceinline__ void operator()(const f32x4 (&acc)[2][2][4][2], const Unit& u, int wr, int wc, int fr, int fq) const {
        const int row0 = u.pm * BM + wr * 64 + fr; const int col0 = u.pn * BM + wc * 32 + 4 * fq;
#pragma unroll
        for (int ai = 0; ai < 2; ++ai)
#pragma unroll
            for (int m = 0; m < 4; ++m) { const int row = row0 + ai * HALF + m * 16; const size_t off = (size_t)row * DM + col0; float q = 0.f;
                const float rstd = rsqrtf(ss2[row] * (1.f / DM) + NORM_EPS);
#pragma unroll
                for (int bj = 0; bj < 2; ++bj)
#pragma unroll
                    for (int n = 0; n < 2; ++n) { const size_t o2 = off + bj * HALF + n * 16; const u32x2 hw = *(const u32x2*)(hb + o2); const f32x4 hv = {bf_lo(hw.x), bf_hi(hw.x), bf_lo(hw.y), bf_hi(hw.y)}; const u32x2 pw = *(const u32x2*)(ple + o2);
                        const f32x4 a = acc[ai][bj][m][n] * rstd; f32x4 h2;
                        h2[0] = hv[0] + sigmoid_f(a[0]) * bf_lo(pw.x); h2[1] = hv[1] + sigmoid_f(a[1]) * bf_hi(pw.x);
                        h2[2] = hv[2] + sigmoid_f(a[2]) * bf_lo(pw.y); h2[3] = hv[3] + sigmoid_f(a[3]) * bf_hi(pw.y);
                        u32x2 w2; w2.x = cvt_pk_bf16(h2[0], h2[1]); w2.y = cvt_pk_bf16(h2[2], h2[3]); *(u32x2*)(h2b + o2) = w2;
                        q += (h2[0] * h2[0] + h2[1] * h2[1]) + (h2[2] * h2[2] + h2[3] * h2[3]); }
                q += __shfl_xor(q, 16); q += __shfl_xor(q, 32);
                if (fq == 0) atomicAdd(ss3 + row, q); }
    }
};
}
namespace att {
constexpr int KP = 272, VP = 144, KT_BYTES = 64 * KP, VT_BYTES = 128 * VP, BUF_BYTES = KT_BYTES + VT_BYTES;
constexpr int FLAG_OFF = 2 * BUF_BYTES;
constexpr int XP = 132;
constexpr float R_DONE = 152.0f;

template <bool MASK>
__device__ __forceinline__ void sb_block(const f32x16& sv, int kbase, int tq, int h, float& R, bf16x8 (&pf)[2]) {
    float c[16];
#pragma unroll
    for (int i = 0; i < 16; ++i) {
        const float z = sv[i];
        const float spv = fmaxf(z, 0.f) + fast_log2(1.f + fast_exp2(-fabsf(z)));
        c[i] = (!MASK || (kbase + 8 * (i >> 2) + (i & 3) < tq)) ? spv : 0.f;
    }
    float T[4], OT[4], pr[4], suf[4];
#pragma unroll
    for (int g = 0; g < 4; ++g) { c[4 * g + 2] += c[4 * g + 3]; c[4 * g + 1] += c[4 * g + 2]; c[4 * g] += c[4 * g + 1]; T[g] = c[4 * g]; }
#pragma unroll
    for (int g = 0; g < 4; ++g) { OT[g] = __shfl_xor(T[g], 32); pr[g] = T[g] + OT[g]; }
    suf[3] = 0.f; suf[2] = pr[3]; suf[1] = suf[2] + pr[2]; suf[0] = suf[1] + pr[1];
    float w[16];
#pragma unroll
    for (int g = 0; g < 4; ++g) { const float off = R + suf[g] + (h == 0 ? OT[g] : 0.f);
#pragma unroll
        for (int j = 0; j < 4; ++j) { const int i = 4 * g + j; const float e = fast_exp2(sv[i] - (off + c[i])); w[i] = (!MASK || (kbase + 8 * (i >> 2) + (i & 3) < tq)) ? e : 0.f; } }
    R += suf[0] + pr[0];
#pragma unroll
    for (int sp = 0; sp < 2; ++sp) { u32x4 p; p.x = cvt_pk(w[8 * sp], w[8 * sp + 1]); p.y = cvt_pk(w[8 * sp + 2], w[8 * sp + 3]); p.z = cvt_pk(w[8 * sp + 4], w[8 * sp + 5]); p.w = cvt_pk(w[8 * sp + 6], w[8 * sp + 7]);
        pf[sp] = __builtin_bit_cast(bf16x8, p); }
}

template <int MODE>
__device__ __forceinline__ void attn_unit(LAS unsigned char* lds, const bf16_t* __restrict__ PROJ, const bf16_t* __restrict__ KIMG, const bf16_t* __restrict__ VT, bf16_t* __restrict__ MIXED,
                                          int b, int hh, int qblk, float lam, const float* __restrict__ subln_g) {
    constexpr int QB = MODE == 0 ? 256 : 128;
    constexpr int NKS = MODE == 0 ? 8 : 4;
    const int tid = opaque_tid(), lane = tid & 63, r = lane & 31, h = lane >> 5;
    const int wid = __builtin_amdgcn_readfirstlane(tid >> 6);
    const int qg = MODE == 0 ? wid : (wid & 3), role = MODE == 0 ? 0 : (wid >> 2);
    const int Q0 = qblk * QB, q0w = Q0 + 32 * qg, tq = q0w + r;
    const size_t tokbase = (size_t)b * SEQ;
    const int gbh = ((MODE == 0 ? 0 : 8) + b) * 8 + hh;
    const bf16_t* Kg = KIMG + (size_t)gbh * SEQ * 128;
    const bf16_t* Vg = VT + (size_t)gbh * 32 * 8192;
    bf16x8 qf[NKS];
    { const bf16_t* qp = PROJ + (tokbase + tq) * NPROJ + (MODE == 0 ? PQ_SB + hh * 128 : PQ_DF + hh * 128 + role * 64) + 8 * h;
#pragma unroll
      for (int ks = 0; ks < NKS; ++ks) qf[ks] = *(const bf16x8*)(qp + 16 * ks); }
    f32x16 o[4];
#pragma unroll
    for (int d = 0; d < 4; ++d)
#pragma unroll
        for (int i = 0; i < 16; ++i) o[d][i] = 0.f;
    float R = 0.f, m_run = -1e30f, l_run = 0.f;
    const int kr0 = tid >> 4, kc = tid & 15, vr0 = tid >> 3, vc = tid & 7;
    const int kst = kr0 * KP + kc * 16, vst = KT_BYTES + vr0 * VP + vc * 16;
    const bf16_t* kgl = Kg + tid * 8;
    const bf16_t* vgl = Vg + tid * 8;
    u32x4 kreg[2], vreg[2];
#define ATT_LOAD(t) do { _Pragma("unroll") for (int i_ = 0; i_ < 2; ++i_) { \
        kreg[i_] = *(const u32x4*)(kgl + (size_t)(t) * 8192 + i_ * 4096); \
        vreg[i_] = *(const u32x4*)(vgl + (size_t)(t) * 8192 + i_ * 4096); } } while (0)
#define ATT_STORE(bo) do { _Pragma("unroll") for (int i_ = 0; i_ < 2; ++i_) { \
        *(LAS u32x4*)(lds + (bo) + kst + i_ * 32 * KP) = kreg[i_]; \
        *(LAS u32x4*)(lds + (bo) + vst + i_ * 64 * VP) = vreg[i_]; } } while (0)
    const int tl = (Q0 + QB - 1) >> 6;
    const int kfrag = r * KP + (role * 64 + 8 * h) * 2;
    const int vfrag = KT_BYTES + r * VP + (8 * h) * 2;
    volatile LAS int* flags = (volatile LAS int*)(lds + FLAG_OFF);
    __syncthreads();
    ATT_LOAD(tl); ATT_STORE(0);
    __syncthreads();
    int cur = 0, it = 0;
    bool wdone = false;
    for (int t = tl;; --t, ++it) {
        if (t > 0) ATT_LOAD(t - 1);
        const int k0 = 64 * t;
        const bool active = (MODE == 0) ? (!wdone && k0 <= q0w + 30) : (k0 <= q0w + 31);
        if (active) {
            const int bo = cur * BUF_BYTES;
            f32x16 s[2];
            bf16x8 vf[4][2][2];
            if (MODE == 1) {
                bf16x8 kf[2][NKS];
#pragma unroll
                for (int kb = 0; kb < 2; ++kb)
#pragma unroll
                    for (int ks = 0; ks < NKS; ++ks) kf[kb][ks] = *(const LAS bf16x8*)(lds + bo + kfrag + kb * 32 * KP + ks * 32);
                __builtin_amdgcn_sched_barrier(0);
#pragma unroll
                for (int kb = 0; kb < 2; ++kb) {
#pragma unroll
                    for (int i = 0; i < 16; ++i) s[kb][i] = 0.f;
#pragma unroll
                    for (int ks = 0; ks < NKS; ++ks) s[kb] = __builtin_amdgcn_mfma_f32_32x32x16_bf16(kf[kb][ks], qf[ks], s[kb], 0, 0, 0);
                }
                __builtin_amdgcn_sched_barrier(0);
#pragma unroll
                for (int d = 0; d < 2; ++d)
#pragma unroll
                    for (int kb = 0; kb < 2; ++kb)
#pragma unroll
                        for (int sp = 0; sp < 2; ++sp) vf[d][kb][sp] = *(const LAS bf16x8*)(lds + bo + vfrag + d * 32 * VP + (32 * kb + 16 * sp) * 2);
                __builtin_amdgcn_sched_barrier(0);
            } else {
#pragma unroll
                for (int kb = 0; kb < 2; ++kb) {
#pragma unroll
                    for (int i = 0; i < 16; ++i) s[kb][i] = 0.f;
#pragma unroll
                    for (int ks = 0; ks < NKS; ++ks) {
                        const bf16x8 a = *(const LAS bf16x8*)(lds + bo + kfrag + kb * 32 * KP + ks * 32);
                        s[kb] = __builtin_amdgcn_mfma_f32_32x32x16_bf16(a, qf[ks], s[kb], 0, 0, 0);
                    }
                }
            }
            bf16x8 pf[2][2];
            if (MODE == 0) {
                { sb_block<true>(s[1], k0 + 32 + 4 * h, tq, h, R, pf[1]); sb_block<true>(s[0], k0 + 4 * h, tq, h, R, pf[0]); }
                wdone = __all(R >= R_DONE);
            } else {
                float mx = -1e30f;
                if (k0 + 63 > q0w) {
#pragma unroll
                    for (int kb = 0; kb < 2; ++kb) { const int kbase = k0 + 32 * kb + 4 * h;
#pragma unroll
                        for (int i = 0; i < 16; ++i) { const int key = kbase + 8 * (i >> 2) + (i & 3); const float v = (key <= tq) ? s[kb][i] : -1e30f; s[kb][i] = v; mx = fmaxf(mx, v); } }
                } else {
#pragma unroll
                    for (int kb = 0; kb < 2; ++kb)
#pragma unroll
                        for (int i = 0; i < 16; ++i) mx = fmaxf(mx, s[kb][i]);
                }
                mx = fmaxf(mx, __shfl_xor(mx, 32));
                const float m_new = fmaxf(m_run, mx), alpha = fast_exp2(m_run - m_new);
                m_run = m_new;
                float ls = 0.f;
#pragma unroll
                for (int kb = 0; kb < 2; ++kb) {
#pragma unroll
                    for (int i = 0; i < 16; ++i) { const float p = fast_exp2(s[kb][i] - m_new); s[kb][i] = p; ls += p; }
#pragma unroll
                    for (int sp = 0; sp < 2; ++sp) { u32x4 p; p.x = cvt_pk(s[kb][8 * sp], s[kb][8 * sp + 1]); p.y = cvt_pk(s[kb][8 * sp + 2], s[kb][8 * sp + 3]); p.z = cvt_pk(s[kb][8 * sp + 4], s[kb][8 * sp + 5]); p.w = cvt_pk(s[kb][8 * sp + 6], s[kb][8 * sp + 7]);
                        pf[kb][sp] = __builtin_bit_cast(bf16x8, p); }
                }
                l_run = l_run * alpha + ls;
                if (!__all(alpha == 1.f)) {
#pragma unroll
                    for (int d = 0; d < 4; ++d)
#pragma unroll
                        for (int i = 0; i < 16; ++i) o[d][i] *= alpha;
                }
            }
            if (MODE == 1) {
                __builtin_amdgcn_sched_barrier(0);
#pragma unroll
                for (int d = 2; d < 4; ++d)
#pragma unroll
                    for (int kb = 0; kb < 2; ++kb)
#pragma unroll
                        for (int sp = 0; sp < 2; ++sp) vf[d][kb][sp] = *(const LAS bf16x8*)(lds + bo + vfrag + d * 32 * VP + (32 * kb + 16 * sp) * 2);
                __builtin_amdgcn_sched_barrier(0);
            }
#pragma unroll
            for (int d = 0; d < 4; ++d)
#pragma unroll
                for (int kb = 0; kb < 2; ++kb)
#pragma unroll
                    for (int sp = 0; sp < 2; ++sp) {
                        const bf16x8 a = (MODE == 1) ? vf[d][kb][sp] : *(const LAS bf16x8*)(lds + bo + vfrag + d * 32 * VP + (32 * kb + 16 * sp) * 2);
                        o[d] = __builtin_amdgcn_mfma_f32_32x32x16_bf16(a, pf[kb][sp], o[d], 0, 0, 0);
                    }
        }
        if (t > 0) ATT_STORE((cur ^ 1) * BUF_BYTES);
        if (MODE == 0) { if (lane == 0) flags[(it & 1) * 8 + wid] = wdone ? 1 : 0; }
        __syncthreads();
        if (t == 0) break;
        if (MODE == 0) { int alld = 1;
#pragma unroll
            for (int w2 = 0; w2 < 8; ++w2) alld &= flags[(it & 1) * 8 + w2];
            if (alld) break; }
        cur ^= 1;
    }
#undef ATT_LOAD
#undef ATT_STORE
    const size_t tok = tokbase + tq;
    if (MODE == 0) {
        const bf16_t* gp = PROJ + tok * NPROJ + PG_SB + hh * 128 + 4 * h;
        bf16_t* op = MIXED + tok * DM + hh * 128 + 4 * h;
#pragma unroll
        for (int d = 0; d < 4; ++d)
#pragma unroll
            for (int g = 0; g < 4; ++g) { const u32x2 gw = *(const u32x2*)(gp + 32 * d + 8 * g);
                u32x2 ow; ow.x = cvt_pk(o[d][4 * g] * bf_lo(gw.x), o[d][4 * g + 1] * bf_hi(gw.x)); ow.y = cvt_pk(o[d][4 * g + 2] * bf_lo(gw.y), o[d][4 * g + 3] * bf_hi(gw.y));
                *(u32x2*)(op + 32 * d + 8 * g) = ow; }
    } else {
        const float lt = l_run + __shfl_xor(l_run, 32);
        const float inv = 1.f / lt;
        LAS float* xq = (LAS float*)lds + (qg * 32 + r) * XP + 4 * h;
        if (role == 1) {
            const float f = inv * lam;
#pragma unroll
            for (int d = 0; d < 4; ++d)
#pragma unroll
                for (int g = 0; g < 4; ++g) *(LAS f32x4*)(xq + 32 * d + 8 * g) = (f32x4){o[d][4 * g] * f, o[d][4 * g + 1] * f, o[d][4 * g + 2] * f, o[d][4 * g + 3] * f};
        }
        __syncthreads();
        if (role == 0) {
            float q = 0.f;
#pragma unroll
            for (int d = 0; d < 4; ++d)
#pragma unroll
                for (int g = 0; g < 4; ++g) { const f32x4 x2 = *(const LAS f32x4*)(xq + 32 * d + 8 * g);
#pragma unroll
                    for (int j = 0; j < 4; ++j) { const float v = o[d][4 * g + j] * inv - x2[j]; o[d][4 * g + j] = v; q += v * v; } }
            q += __shfl_xor(q, 32);
            const float rs = rsqrtf(q * (1.f / 128.f) + SUBLN_EPS) * (1.f - LAMBDA_INIT);
            const bf16_t* gp = PROJ + tok * NPROJ + PG_DF + hh * 128 + 4 * h;
            bf16_t* op = MIXED + tok * DM + 1024 + hh * 128 + 4 * h;
            const float* sg = subln_g + 4 * h;
#pragma unroll
            for (int d = 0; d < 4; ++d)
#pragma unroll
                for (int g = 0; g < 4; ++g) { const u32x2 gw = *(const u32x2*)(gp + 32 * d + 8 * g); const f32x4 sv = *(const f32x4*)(sg + 32 * d + 8 * g);
                    u32x2 ow; ow.x = cvt_pk(o[d][4 * g] * rs * sv[0] * bf_lo(gw.x), o[d][4 * g + 1] * rs * sv[1] * bf_hi(gw.x));
                    ow.y = cvt_pk(o[d][4 * g + 2] * rs * sv[2] * bf_lo(gw.y), o[d][4 * g + 3] * rs * sv[3] * bf_hi(gw.y));
                    *(u32x2*)(op + 32 * d + 8 * g) = ow; }
        }
    }
}
}
#define XB_TMO      128
#define XB_XCNT(j)  (256  + 64 * (j))
#define XB_XSUB(j)  (1280 + 64 * (j))
#define XB_XGEN(j)  (2304 + 64 * (j))
#define XB_TOP      3328
#define XB_TOPGEN   3392
#define XCD_BAR_WORDS 3456
#define XB_SPIN_CAP (1u << 18)

__device__ __forceinline__ unsigned xb_ld(unsigned* p)              { return __hip_atomic_load(p, __ATOMIC_RELAXED, __HIP_MEMORY_SCOPE_AGENT); }
__device__ __forceinline__ unsigned xb_add(unsigned* p, unsigned v) { return __hip_atomic_fetch_add(p, v, __ATOMIC_RELAXED, __HIP_MEMORY_SCOPE_AGENT); }
__device__ __forceinline__ unsigned xb_xcc_id() { return (unsigned)__builtin_amdgcn_s_getreg((3 << 11) | 20) & 0xFu; }
#define XB_SPIN(cond, bar) do { unsigned _sp = 0; while (cond) { __builtin_amdgcn_s_sleep(1); \
    if ((++_sp & 255u) == 0u) { if (xb_ld(&(bar)[XB_TMO])) break; if (_sp > XB_SPIN_CAP) { atomicAdd(&(bar)[XB_TMO], 1u); break; } } } } while (0)

struct XcdBarrier {
    unsigned* bar; unsigned x;
    volatile LAS unsigned* st;
};

__device__ __forceinline__ XcdBarrier xcd_barrier_post(unsigned* bar, volatile LAS unsigned* st) {
    XcdBarrier b; b.bar = bar; b.x = xb_xcc_id(); b.st = st;
    if (threadIdx.x == 0) (void)xb_add(&bar[XB_XCNT(b.x)], 1u);
    return b;
}
__device__ __forceinline__ void xcd_barrier_complete(unsigned* bar, unsigned x, unsigned& nloc, unsigned& nx) {
    const unsigned G = gridDim.x * gridDim.y * gridDim.z;
    unsigned sum, cnt, mine, sp = 0u;
    for (;;) {
        sum = 0u; cnt = 0u; mine = 0u;
#pragma unroll
        for (unsigned j = 0; j < 16; ++j) { const unsigned c = xb_ld(&bar[XB_XCNT(j)]); sum += c; cnt += (c > 0u) ? 1u : 0u; mine = (j == x) ? c : mine; }
        if (sum == G) break;
        __builtin_amdgcn_s_sleep(1);
        if ((++sp & 255u) == 0u) { if (xb_ld(&bar[XB_TMO])) break; if (sp > XB_SPIN_CAP) { atomicAdd(&bar[XB_TMO], 1u); break; } }
    }
    nloc = mine > 0u ? mine : 1u; nx = cnt > 0u ? cnt : 1u;
}

__device__ __forceinline__ void xcd_barrier(const XcdBarrier& b) {
    asm volatile("s_waitcnt vmcnt(0)" ::: "memory");
    __syncthreads();
    if (threadIdx.x == 0) {
        unsigned* bar = b.bar;
        __builtin_amdgcn_s_waitcnt(0);
        unsigned nloc = b.st[0], nx = b.st[1];
        if (nloc == 0u) { xcd_barrier_complete(bar, b.x, nloc, nx); b.st[0] = nloc; b.st[1] = nx; }
        const unsigned old = xb_add(&bar[XB_XSUB(b.x)], 1u);
        const unsigned gen = old / nloc;
        if (old + 1u == (gen + 1u) * nloc) {
            __builtin_amdgcn_fence(__ATOMIC_RELEASE, "agent");
            asm volatile("s_waitcnt vmcnt(0)" ::: "memory");
            const unsigned og = xb_add(&bar[XB_TOP], 1u);
            const unsigned tg = og / nx;
            if (og + 1u == (tg + 1u) * nx) xb_add(&bar[XB_TOPGEN], 1u);
            else XB_SPIN(xb_ld(&bar[XB_TOPGEN]) == tg, bar);
            __builtin_amdgcn_fence(__ATOMIC_ACQUIRE, "agent");
            xb_add(&bar[XB_XGEN(b.x)], 1u);
            asm volatile("s_waitcnt vmcnt(0)" ::: "memory");
        } else {
            XB_SPIN(xb_ld(&bar[XB_XGEN(b.x)]) == gen, bar);
            __builtin_amdgcn_fence(__ATOMIC_ACQUIRE, "agent");
            asm volatile("s_waitcnt vmcnt(0)" ::: "memory");
        }
    }
    __syncthreads();
}

__device__ __forceinline__ int win_dst_row(int c) {
    const int seg = c >> 10, w = c & 1023, d6 = w & 63;
    const int wp = d6 < 16 ? (w & ~63) + (d6 < 8 ? 2 * d6 : 2 * (d6 - 8) + 1) : w;
    switch (seg) { case 0: return w; case 1: return 1024 + w; case 2: return 6144 + w; case 3: return 2048 + w;
                   case 4: return 3072 + wp; case 5: return 4096 + wp; case 6: return 7168 + w; default: return 5120 + w; }
}
struct TItem { const float* W; bf16_t* WT; const float* ks; int K, N, win, item; };
__device__ __forceinline__ void tr_load(const TItem& t, float (&v)[32], int lane) {
    const int nblk = t.N / 32, kb = t.item / nblk, nb = t.item % nblk; const float* p = t.W + (size_t)(64 * kb + (lane >> 5)) * t.N + 32 * nb + (lane & 31);
#pragma unroll
    for (int i = 0; i < 32; ++i) v[i] = p[(size_t)(2 * i) * t.N];
}
__device__ __forceinline__ void tr_write(const float (&v)[32], LAS float* scr, int lane) {
#pragma unroll
    for (int i = 0; i < 32; ++i) scr[(2 * i + (lane >> 5)) * 33 + (lane & 31)] = v[i];
}
__device__ __forceinline__ void tr_store(const TItem& t, LAS float* scr, int lane) {
    const int nblk = t.N / 32, kb = t.item / nblk, nb = t.item % nblk, k0 = 64 * kb, n0 = 32 * nb, c = lane & 7;
    f32x4 s0 = {1.f, 1.f, 1.f, 1.f}, s1 = {1.f, 1.f, 1.f, 1.f};
    if (t.ks) { s0 = *(const f32x4*)(t.ks + k0 + 8 * c); s1 = *(const f32x4*)(t.ks + k0 + 8 * c + 4); }
#pragma unroll
    for (int j = 0; j < 4; ++j) { const int n = (lane >> 3) + 8 * j; const LAS float* s = scr + (8 * c) * 33 + n;
        u32x4 o; o.x = cvt_pk(s[0 * 33] * s0[0], s[1 * 33] * s0[1]); o.y = cvt_pk(s[2 * 33] * s0[2], s[3 * 33] * s0[3]); o.z = cvt_pk(s[4 * 33] * s1[0], s[5 * 33] * s1[1]); o.w = cvt_pk(s[6 * 33] * s1[2], s[7 * 33] * s1[3]);
        const int dn = t.win ? win_dst_row(n0 + n) : (n0 + n);
        *(u32x4*)(t.WT + (size_t)dn * t.K + k0 + 8 * c) = o; }
}
__device__ __forceinline__ void rms_load(const float* __restrict__ xrow, f32x4 (&v)[8], int lane) {
    const f32x4* xr = (const f32x4*)xrow + lane;
#pragma unroll
    for (int j = 0; j < 8; ++j) v[j] = xr[64 * j];
}
__device__ __forceinline__ void rms_finish(const f32x4 (&v)[8], const f32x4 (&gv)[8], bf16_t* __restrict__ orow, int lane) {
    float s = 0.f;
#pragma unroll
    for (int j = 0; j < 8; ++j) s += (v[j][0] * v[j][0] + v[j][1] * v[j][1]) + (v[j][2] * v[j][2] + v[j][3] * v[j][3]);
    const float rstd = rsqrtf(wave_sum(s) * (1.f / DM) + NORM_EPS);
    u32x2* o8 = (u32x2*)orow + lane;
#pragma unroll
    for (int j = 0; j < 8; ++j) { u32x2 w; w.x = cvt_pk(v[j][0] * rstd * gv[j][0], v[j][1] * rstd * gv[j][1]); w.y = cvt_pk(v[j][2] * rstd * gv[j][2], v[j][3] * rstd * gv[j][3]); o8[64 * j] = w; }
}

struct Args { const float* in[14]; float* out; unsigned char* ws; };

__global__ void __launch_bounds__(512, 2) fwd_megakernel(Args a) {
    extern __shared__ __attribute__((aligned(16))) unsigned char lds_raw[];
    LAS unsigned char* lds = (LAS unsigned char*)lds_raw;
    cg::grid_group grid = cg::this_grid();
    const int tid = threadIdx.x, lane = tid & 63, wave = __builtin_amdgcn_readfirstlane(tid >> 6);
    const int G = gridDim.x, bx = blockIdx.x;
    const int vcu = (G % 8 == 0) ? (bx % 8) * (G / 8) + bx / 8 : bx;
    unsigned char* ws = a.ws;
    float* ss2 = (float*)(ws + WS_CTL + CTL_SS2); float* ss3 = (float*)(ws + WS_CTL + CTL_SS3); float* lamp = (float*)(ws + WS_CTL + CTL_LAM); float* rope = (float*)(ws + WS_CTL + CTL_ROPE);
    bf16_t* WIN = (bf16_t*)(ws + WS_WIN); bf16_t* WOUT = (bf16_t*)(ws + WS_WOUT); bf16_t* WGATE = (bf16_t*)(ws + WS_WGATE); bf16_t* WPROJ = (bf16_t*)(ws + WS_WPROJ);
    bf16_t* PB = (bf16_t*)(ws + WS_PB); bf16_t* XN = (bf16_t*)(ws + WS_XN); bf16_t* MIXED = (bf16_t*)(ws + WS_MIXED); bf16_t* PROJ = (bf16_t*)(ws + WS_PROJ);
    bf16_t* VT = (bf16_t*)(ws + WS_VT); bf16_t* KIMG = (bf16_t*)(ws + WS_KIMG); bf16_t* HB = (bf16_t*)(ws + WS_HB); bf16_t* PLEB = (bf16_t*)(ws + WS_PLE); bf16_t* H2B = (bf16_t*)(ws + WS_H2B);
    const float* x = a.in[0]; float* out = a.out;
    volatile LAS unsigned* xst = (volatile LAS unsigned*)(lds + 131072);
    if (tid == 0) { xst[0] = 0u; xst[1] = 0u; }
    __syncthreads();
    const XcdBarrier xb = xcd_barrier_post((unsigned*)(ws + WS_CTL + CTL_BAR), xst);

    for (int rep_ = 0; rep_ < ((PROBE_DUP & 1) ? 2 : 1); ++rep_) {
        if (rep_) __syncthreads();
        const int gw = bx * 8 + wave, NGW = G * 8; const int gt = bx * 512 + tid, NGT = G * 512;
        for (int i = gt; i < 2 * NTOK; i += NGT) ss2[i] = 0.f;
        if (gt == 0) { float s1 = 0.f, s2 = 0.f; for (int i = 0; i < 64; ++i) { s1 += a.in[4][i] * a.in[5][i]; s2 += a.in[6][i] * a.in[7][i]; } lamp[0] = expf(s1) - expf(s2) + LAMBDA_INIT; }
        for (int i = gt; i < SEQ * 8; i += NGT) { const int pos = i >> 3, f = i & 7;
            const float invf = (float)exp2(-(double)f * 0.125 * 18.931568569324174);
            const float angf = (float)pos * invf;
            const double tw = 6.283185307179586476925; double ang = (double)angf; ang -= tw * rint(ang / tw);
            rope[2 * i] = (float)cos(ang); rope[2 * i + 1] = (float)sin(ang); }
        LAS float* scr = (LAS float*)(lds + wave * 16384);
        constexpr int I_IN = (DM / 64) * (8192 / 32), I_SQ = (DM / 64) * (DM / 32), I_PR = (PLE / 64) * (DM / 32), I_ALL = I_IN + 2 * I_SQ + I_PR;
#define P0_DECODE(T, it_) do { int rr_ = (it_); \
            if (rr_ < I_IN) { T = TItem{a.in[3], WIN, nullptr, DM, 8192, 1, rr_}; } \
            else if (rr_ < I_IN + I_SQ) { T = TItem{a.in[9], WOUT, nullptr, DM, DM, 0, rr_ - I_IN}; } \
            else if (rr_ < I_IN + 2 * I_SQ) { T = TItem{a.in[11], WGATE, a.in[10], DM, DM, 0, rr_ - I_IN - I_SQ}; } \
            else { T = TItem{a.in[12], WPROJ, nullptr, PLE, DM, 0, rr_ - I_IN - 2 * I_SQ}; } } while (0)
        {
            float tv[32]; TItem cur, nxt; int it = gw;
            if (it < I_ALL) { P0_DECODE(cur, it); tr_load(cur, tv, lane); }
            while (it < I_ALL) {
                tr_write(tv, scr, lane);
                const int itn = it + NGW;
                if (itn < I_ALL) { P0_DECODE(nxt, itn); tr_load(nxt, tv, lane); }
                asm volatile("s_waitcnt lgkmcnt(0)" ::: "memory");
                tr_store(cur, scr, lane);
                asm volatile("s_waitcnt lgkmcnt(0)" ::: "memory");
                cur = nxt; it = itn;
            }
        }
#undef P0_DECODE
        {
            f32x4 gv[8], va[8], vb[8];
            { const f32x4* gr = (const f32x4*)a.in[2] + lane;
#pragma unroll
              for (int j = 0; j < 8; ++j) gv[j] = gr[64 * j]; }
            int m = gw;
            if (m < NTOK) rms_load(x + (size_t)m * DM, va, lane);
            for (; m < NTOK; m += 2 * NGW) {
                const int m1 = m + NGW, m2 = m + 2 * NGW;
                if (m1 < NTOK) rms_load(x + (size_t)m1 * DM, vb, lane);
                rms_finish(va, gv, XN + (size_t)m * DM, lane);
                if (m2 < NTOK) rms_load(x + (size_t)m2 * DM, va, lane);
                if (m1 < NTOK) rms_finish(vb, gv, XN + (size_t)m1 * DM, lane);
            }
        }
        for (int i = gt; i < NTOK * PLE / 8; i += NGT) { const f32x4 v0 = ((const f32x4*)a.in[1])[2 * i], v1 = ((const f32x4*)a.in[1])[2 * i + 1];
            u32x4 w; w.x = cvt_pk(v0[0], v0[1]); w.y = cvt_pk(v0[2], v0[3]); w.z = cvt_pk(v1[0], v1[1]); w.w = cvt_pk(v1[2], v1[3]); ((u32x4*)PB)[i] = w; }
    }
    grid.sync();
    for (int rep_ = 0; rep_ < ((PROBE_DUP & 2) ? 2 : 1); ++rep_) {
        if (rep_) __syncthreads();
        { pg8::Gemm g{XN, WIN, NTOK, NPROJ, DM}; pg8::StaticOrder S; S.init(NTOK, NPROJ, G, bx); pg8::EpiProj E{PROJ, rope, KIMG};
          pg8::gemm_phase<pg8::EpiProj, pg8::StaticOrder, true, true>(lds, g, S, E); }
        __syncthreads();
        { pg8::Gemm g{WIN + (size_t)NPROJ * DM, XN, 2048, NTOK, DM}; pg8::StaticOrder S; S.init(2048, NTOK, G, bx); pg8::EpiVt E{VT};
          pg8::gemm_phase<pg8::EpiVt, pg8::StaticOrder, true, true>(lds, g, S, E); }
    }
    xcd_barrier(xb);
    for (int rep_ = 0; rep_ < ((PROBE_DUP & 4) ? 2 : 1); ++rep_) {
        const float lam = lamp[0];
        for (int su = vcu; su < 256; su += G) {
            const int grp = su >> 4, j = su & 15;
#pragma unroll 1
            for (int k = 0; k < 4; ++k) { const int bh = 4 * grp + k; const int qb = (k & 1) ? 15 - j : j;
                att::attn_unit<1>(lds, PROJ, KIMG, VT, MIXED, bh >> 3, bh & 7, qb, lam, a.in[8]); }
        }
#pragma unroll 1
        for (int u = vcu; u < 512; u += G) att::attn_unit<0>(lds, PROJ, KIMG, VT, MIXED, (u >> 3) >> 3, (u >> 3) & 7, u & 7, lam, a.in[8]);
    }
    xcd_barrier(xb);
    {
        __syncthreads();
        { pg8::Gemm g{MIXED, WOUT, NTOK, DM, DM}; pg8::StaticOrder S; S.init(NTOK, DM, G, bx); pg8::EpiRes E{x, HB, ss2};
          pg8::gemm_phase<pg8::EpiRes, pg8::StaticOrder, true, true>(lds, g, S, E); }
        __syncthreads();
        { pg8::Gemm g{PB, WPROJ, NTOK, DM, PLE}; pg8::StaticOrder S; S.init(NTOK, DM, G, bx); pg8::EpiBf16 E{PLEB, DM};
          pg8::gemm_phase<pg8::EpiBf16, pg8::StaticOrder, true, true>(lds, g, S, E); }
    }
    xcd_barrier(xb);
    {
        pg8::Gemm g{HB, WGATE, NTOK, DM, DM}; pg8::StaticOrder S; S.init(NTOK, DM, G, bx); pg8::EpiGate E{HB, H2B, PLEB, ss2, ss3};
        pg8::gemm_phase<pg8::EpiGate, pg8::StaticOrder, true, true>(lds, g, S, E);
    }
    xcd_barrier(xb);
    {
        const int tid5 = opaque_tid(), lane = tid5 & 63, wave = __builtin_amdgcn_readfirstlane(tid5 >> 6);
        const int gw = bx * 8 + wave, NGW = G * 8; const f32x4* gr = (const f32x4*)a.in[13];
        for (int m = gw; m < NTOK; m += NGW) { const float rstd = rsqrtf(ss3[m] * (1.f / DM) + NORM_EPS); f32x4* orow = (f32x4*)(out + (size_t)m * DM); const u32x4* hrow = (const u32x4*)(H2B + (size_t)m * DM);
#pragma unroll
            for (int j = 0; j < 4; ++j) { const int c = lane + 64 * j; const u32x4 hw = hrow[c]; const f32x4 g0 = gr[2 * c], g1 = gr[2 * c + 1];
                orow[2 * c] = (f32x4){bf_lo(hw.x) * rstd * g0[0], bf_hi(hw.x) * rstd * g0[1], bf_lo(hw.y) * rstd * g0[2], bf_hi(hw.y) * rstd * g0[3]};
                orow[2 * c + 1] = (f32x4){bf_lo(hw.z) * rstd * g1[0], bf_hi(hw.z) * rstd * g1[1], bf_lo(hw.w) * rstd * g1[2], bf_hi(hw.w) * rstd * g1[3]}; } }
    }
}

extern "C" void kernel_launch(void* const* d_in, const int* in_sizes, int n_in, void* d_out, int out_size, void* d_ws, size_t ws_size, hipStream_t stream) {
    static int grid = 0;
    if (grid == 0) {
        if (n_in != 14 || out_size != NTOK * DM || ws_size < WS_END) { fprintf(stderr, "kernel_launch: unexpected shapes (n_in %d out %d ws %zu)\n", n_in, out_size, ws_size); grid = -1; return; }
        int dev = 0, cus = 0, per_cu = 0;
        (void)hipGetDevice(&dev); (void)hipDeviceGetAttribute(&cus, hipDeviceAttributeMultiprocessorCount, dev);
        (void)hipFuncSetAttribute((const void*)fwd_megakernel, hipFuncAttributeMaxDynamicSharedMemorySize, LDS_BYTES);
        (void)hipOccupancyMaxActiveBlocksPerMultiprocessor(&per_cu, (const void*)fwd_megakernel, 512, LDS_BYTES);
        if (per_cu < 1) { fprintf(stderr, "kernel_launch: occupancy query says %d blocks/CU\n", per_cu); per_cu = 1; }
        grid = cus * per_cu;
    }
    if (grid < 0) return;
    Args a{};
    for (int i = 0; i < 14; ++i) a.in[i] = (const float*)d_in[i];
    a.out = (float*)d_out; a.ws = (unsigned char*)d_ws;
    (void)hipMemsetAsync((unsigned char*)d_ws + WS_CTL + CTL_BAR, 0, CTL_BAR_BYTES, stream);
    void* args[] = {&a};
    hipError_t e = hipLaunchCooperativeKernel((void*)fwd_megakernel, dim3(grid), dim3(512), args, LDS_BYTES, stream);
    if (e != hipSuccess) fprintf(stderr, "cooperative launch failed: %s (grid %d)\n", hipGetErrorString(e), grid);
}
```

```cpp
#include <hip/hip_runtime.h>
#include <hip/hip_cooperative_groups.h>
#include <cstdio>
#include <cstdint>
namespace cg = cooperative_groups;
__device__ __forceinline__ int opaque_tid() { int t = (int)threadIdx.x; asm volatile("" : "+v"(t)); return t; }
#ifndef PROBE_DUP
#define PROBE_DUP 0
#endif
namespace pg8 {
#define PG8_LAS __attribute__((address_space(3)))
typedef unsigned short bf16_t;
typedef short bf16x8 __attribute__((ext_vector_type(8)));
typedef float f32x4 __attribute__((ext_vector_type(4)));
typedef unsigned u32x4 __attribute__((ext_vector_type(4)));
constexpr int BM = 256, BK = 64, HALF = 128, HTB = HALF * BK * 2  , STAGE_BYTES = 8 * HTB, NXCD = 8, WGM = 8;

__host__ __device__ __forceinline__ int lds_byte(int r, int c) { const int st = (r >> 4) * 2 + (c >> 5), rr = r & 15, cc = c & 31, ob = rr * 64 + cc * 2; return st * 1024 + (ob ^ (((ob >> 9) & 1) << 5)); }
__host__ __device__ __forceinline__ void stage_rc(int b, int& R, int& C) { const int st = b / 1024, sb = b % 1024, swz = sb ^ (((sb >> 9) & 1) << 5); R = (st >> 1) * 16 + swz / 64; C = (st & 1) * 32 + (swz % 64) / 2; }
__host__ __device__ __forceinline__ int perm32(int rho) { const int n = rho >> 4, i = rho & 15; return 8 * (i >> 2) + 4 * n + (i & 3); }

struct Unit { int pm, pn; };
struct Gemm { const bf16_t* A; const bf16_t* Bt; int M, N, K; };

struct StaticOrder {
    int nM, nN, nwg, G, c;
    __host__ __device__ void init(int M, int N, int G_, int c_) { nM = M / BM; nN = N / BM; nwg = nM * nN; G = G_; c = c_; }
    __host__ __device__ bool next(int i, Unit& u) const {
        const long L = (long)i * G + c; if (L >= nwg) return false;
        int wgid = (int)L; { const int q = nwg / NXCD, r = nwg % NXCD, xcd = wgid % NXCD, off = wgid / NXCD; wgid = (xcd < r ? xcd * (q + 1) : r * (q + 1) + (xcd - r) * q) + off; }
        const int nig = WGM * nN, gid = wgid / nig, fm = gid * WGM, gsz = (nM - fm) < WGM ? (nM - fm) : WGM;
        u.pm = fm + ((wgid % nig) % gsz); u.pn = (wgid % nig) / gsz; return true;
    }
    __device__ __forceinline__ void a_ready(const Unit&) const {}
    __device__ __forceinline__ void done(const Unit&) const {}
};

__device__ __forceinline__ unsigned cvt_pk_bf16(float lo, float hi) { unsigned r; asm volatile("v_cvt_pk_bf16_f32 %0, %1, %2" : "=v"(r) : "v"(lo), "v"(hi)); return r; }
typedef float f32x2 __attribute__((ext_vector_type(2)));
template <class Epi, class Sched, bool ALIGN_EPI = false, bool SP2 = false>
__device__ __forceinline__ void gemm_phase(PG8_LAS unsigned char* lds, const Gemm g, const Sched& S, const Epi& E) {
    const int tid = opaque_tid(), wid = __builtin_amdgcn_readfirstlane(tid >> 6), lane = tid & 63, wr = wid >> 2, wc = wid & 3, fr = lane & 15, fq = lane >> 4;
    const int K = g.K, nt = K / BK;
    unsigned voffA[2], voffB[2];
#pragma unroll
    for (int i = 0; i < 2; ++i) { int R, C; stage_rc(tid * 16 + i * 8192, R, C); const int Rb = Epi::PERM ? ((R & ~31) + perm32(R & 31)) : R;
        voffA[i] = (unsigned)(R * K + C) * 2u; voffB[i] = (unsigned)(Rb * K + C) * 2u; }
    const size_t kstep = (size_t)(BK * 2);
    const size_t hstep = (size_t)HALF * K * 2;
    const size_t tstep = 2 * hstep;
    const unsigned ldsw = (unsigned)wid * 1024u;
    const int aoff = lds_byte(wr * 64 + fr, fq * 8), boff = lds_byte(wc * 32 + fr, fq * 8);
#define PG8_SA(b, h) (((b) * 2 + (h)) * HTB)
#define PG8_SB(b, h) ((4 + (b) * 2 + (h)) * HTB)
#define PG8_STAGE(bufoff, gbase, voff) do { _Pragma("unroll") for (int _i = 0; _i < 2; ++_i) \
        __builtin_amdgcn_global_load_lds((const unsigned*)((const char*)(gbase) + (voff)[_i]), (PG8_LAS unsigned*)(lds + (bufoff) + ldsw + _i * 8192), 16, 0, 0); } while (0)
#define PG8_LDA(dst, b, h) do { _Pragma("unroll") for (int m = 0; m < 4; ++m) _Pragma("unroll") for (int k = 0; k < 2; ++k) dst[m][k] = *(const PG8_LAS bf16x8*)(lds + PG8_SA(b, h) + aoff + m * 2048 + k * 1024); } while (0)
#define PG8_LDB(dst, b, h) do { _Pragma("unroll") for (int n = 0; n < 2; ++n) _Pragma("unroll") for (int k = 0; k < 2; ++k) dst[n][k] = *(const PG8_LAS bf16x8*)(lds + PG8_SB(b, h) + boff + n * 2048 + k * 1024); } while (0)
#define PG8_MMA(ai, bj, At, Bt) do { __builtin_amdgcn_s_setprio(1); _Pragma("unroll") for (int m = 0; m < 4; ++m) _Pragma("unroll") for (int n = 0; n < 2; ++n) _Pragma("unroll") for (int k = 0; k < 2; ++k) \
        acc[ai][bj][m][n] = __builtin_amdgcn_mfma_f32_16x16x32_bf16(Bt[n][k], At[m][k], acc[ai][bj][m][n], 0, 0, 0); __builtin_amdgcn_s_setprio(0); } while (0)
#define PG8_WAIT_V(n) asm volatile("s_waitcnt vmcnt(" #n ")" ::: "memory")
#define PG8_WAIT_L(n) asm volatile("s_waitcnt lgkmcnt(" #n ")" ::: "memory")
#define PG8_BAR __builtin_amdgcn_s_barrier()
#define PG8_SCHED __builtin_amdgcn_sched_barrier(0)
    Unit cur, nxt; int ui = 0;
    if (!S.next(0, cur)) return;
    f32x4 acc[2][2][4][2];
#pragma unroll
    for (int a = 0; a < 2; ++a)
#pragma unroll
        for (int b = 0; b < 2; ++b)
#pragma unroll
            for (int m = 0; m < 4; ++m)
#pragma unroll
                for (int n = 0; n < 2; ++n) acc[a][b][m][n] = (f32x4){0.f, 0.f, 0.f, 0.f};
    bf16x8 At[4][2], B0[2][2], B1[2][2];
    const char* cA = (const char*)g.A + (size_t)cur.pm * tstep; const char* cB = (const char*)g.Bt + (size_t)cur.pn * tstep;
    S.a_ready(cur);
    if constexpr (SP2) {
        PG8_STAGE(PG8_SB(0, 0), cB, voffB); PG8_STAGE(PG8_SB(0, 1), cB + hstep, voffB); PG8_STAGE(PG8_SA(0, 0), cA, voffA); PG8_STAGE(PG8_SA(0, 1), cA + hstep, voffA);
        if (wr == 1) PG8_BAR;
        PG8_WAIT_V(2); PG8_BAR;
        PG8_STAGE(PG8_SB(1, 0), cB + kstep, voffB); PG8_STAGE(PG8_SA(1, 0), cA + kstep, voffA); PG8_STAGE(PG8_SB(1, 1), cB + hstep + kstep, voffB);
        PG8_WAIT_V(6); PG8_BAR;
    } else {
        PG8_STAGE(PG8_SB(0, 0), cB, voffB); PG8_STAGE(PG8_SA(0, 0), cA, voffA); PG8_STAGE(PG8_SB(0, 1), cB + hstep, voffB); PG8_STAGE(PG8_SA(0, 1), cA + hstep, voffA);
        if (wr == 1) PG8_BAR;
        PG8_WAIT_V(4); PG8_BAR;
        PG8_STAGE(PG8_SB(1, 0), cB + kstep, voffB); PG8_STAGE(PG8_SA(1, 0), cA + kstep, voffA); PG8_STAGE(PG8_SB(1, 1), cB + hstep + kstep, voffB);
        PG8_WAIT_V(6); PG8_BAR;
    }
    for (;;) {
        const bool has_next = S.next(ui + 1, nxt);
        const char* nA = has_next ? (const char*)g.A + (size_t)nxt.pm * tstep : cA; const char* nB = has_next ? (const char*)g.Bt + (size_t)nxt.pn * tstep : cB;
        for (int t = 0; t < nt; t += 2) {
            const bool last = (t == nt - 2);
            const char* a1 = cA + (size_t)(t + 1) * kstep;
            const char* a2 = last ? nA : cA + (size_t)(t + 2) * kstep; const char* b2 = last ? nB : cB + (size_t)(t + 2) * kstep;
            const char* a3 = a2 + kstep; const char* b3 = b2 + kstep;
            if (last && has_next) S.a_ready(nxt);
            if constexpr (SP2) {
            PG8_LDB(B0, 0, 0); PG8_LDB(B1, 0, 1); PG8_SCHED; PG8_LDA(At, 0, 0); PG8_STAGE(PG8_SA(1, 1), a1 + hstep, voffA);
            PG8_WAIT_V(8); PG8_WAIT_L(0); PG8_BAR; PG8_MMA(0, 0, At, B0); PG8_MMA(0, 1, At, B1); PG8_BAR; PG8_SCHED;
            PG8_LDA(At, 0, 1); PG8_STAGE(PG8_SB(0, 0), b2, voffB); PG8_STAGE(PG8_SB(0, 1), b2 + hstep, voffB); PG8_STAGE(PG8_SA(0, 0), a2, voffA);
            PG8_WAIT_V(8); PG8_WAIT_L(0); PG8_BAR; PG8_MMA(1, 0, At, B0); PG8_MMA(1, 1, At, B1); PG8_BAR; PG8_SCHED;
            PG8_LDB(B0, 1, 0); PG8_LDB(B1, 1, 1); PG8_SCHED; PG8_LDA(At, 1, 0); PG8_STAGE(PG8_SA(0, 1), a2 + hstep, voffA);
            PG8_WAIT_V(8); PG8_WAIT_L(0); PG8_BAR; PG8_MMA(0, 0, At, B0); PG8_MMA(0, 1, At, B1); PG8_BAR; PG8_SCHED;
            PG8_LDA(At, 1, 1); PG8_STAGE(PG8_SB(1, 0), b3, voffB); PG8_STAGE(PG8_SB(1, 1), b3 + hstep, voffB); PG8_STAGE(PG8_SA(1, 0), a3, voffA);
            PG8_WAIT_V(8); PG8_WAIT_L(0); PG8_BAR; PG8_MMA(1, 0, At, B0); PG8_MMA(1, 1, At, B1); PG8_BAR; PG8_SCHED;
            } else {
            PG8_LDB(B0, 0, 0); PG8_SCHED; PG8_LDA(At, 0, 0); PG8_STAGE(PG8_SA(1, 1), a1 + hstep, voffA);
            PG8_WAIT_L(8); PG8_BAR; PG8_WAIT_L(0); PG8_MMA(0, 0, At, B0); PG8_BAR; PG8_SCHED;
            PG8_LDB(B1, 0, 1); PG8_STAGE(PG8_SB(0, 0), b2, voffB);
            PG8_BAR; PG8_WAIT_L(0); PG8_MMA(0, 1, At, B1); PG8_BAR;
            PG8_LDA(At, 0, 1); PG8_STAGE(PG8_SA(0, 0), a2, voffA);
            PG8_BAR; PG8_WAIT_L(0); PG8_MMA(1, 0, At, B0); PG8_BAR; PG8_SCHED;
            PG8_STAGE(PG8_SB(0, 1), b2 + hstep, voffB);
            PG8_WAIT_V(6); PG8_BAR; PG8_MMA(1, 1, At, B1); PG8_BAR;
            PG8_LDB(B0, 1, 0); PG8_SCHED; PG8_LDA(At, 1, 0); PG8_STAGE(PG8_SA(0, 1), a2 + hstep, voffA);
            PG8_WAIT_L(8); PG8_BAR; PG8_WAIT_L(0); PG8_MMA(0, 0, At, B0); PG8_BAR; PG8_SCHED;
            PG8_LDB(B1, 1, 1); PG8_STAGE(PG8_SB(1, 0), b3, voffB);
            PG8_BAR; PG8_WAIT_L(0); PG8_MMA(0, 1, At, B1); PG8_BAR;
            PG8_LDA(At, 1, 1); PG8_STAGE(PG8_SA(1, 0), a3, voffA);
            PG8_BAR; PG8_WAIT_L(0); PG8_MMA(1, 0, At, B0); PG8_BAR; PG8_SCHED;
            PG8_STAGE(PG8_SB(1, 1), b3 + hstep, voffB);
            PG8_WAIT_V(6); PG8_BAR; PG8_MMA(1, 1, At, B1); PG8_BAR;
            }
        }
        if constexpr (ALIGN_EPI) { if (wr == 0) PG8_BAR; }
        if constexpr (!Epi::AFTER_DRAIN) { E(acc, cur, wr, wc, fr, fq); S.done(cur); }
        if (!has_next) break;
#pragma unroll
        for (int a = 0; a < 2; ++a)
#pragma unroll
            for (int b = 0; b < 2; ++b)
#pragma unroll
                for (int m = 0; m < 4; ++m)
#pragma unroll
                    for (int n = 0; n < 2; ++n) acc[a][b][m][n] = (f32x4){0.f, 0.f, 0.f, 0.f};
        cur = nxt; cA = nA; cB = nB; ++ui;
        if constexpr (ALIGN_EPI) { if (wr == 1) PG8_BAR; }
    }
    PG8_WAIT_V(0);
    if constexpr (!ALIGN_EPI) { if (wr == 0) PG8_BAR; }
    PG8_BAR;
    if constexpr (Epi::AFTER_DRAIN) { E.fused(acc, cur, wr, wc, fr, fq, lds, wid, lane); S.done(cur); }
#undef PG8_SA
#undef PG8_SB
#undef PG8_STAGE
#undef PG8_LDA
#undef PG8_LDB
#undef PG8_MMA
#undef PG8_WAIT_V
#undef PG8_WAIT_L
#undef PG8_BAR
#undef PG8_SCHED
}
}
#define LAS __attribute__((address_space(3)))
typedef unsigned short bf16_t;
typedef short bf16x8 __attribute__((ext_vector_type(8)));
typedef float f32x4 __attribute__((ext_vector_type(4)));
typedef float f32x2 __attribute__((ext_vector_type(2)));
typedef float f32x16 __attribute__((ext_vector_type(16)));
typedef unsigned u32x4 __attribute__((ext_vector_type(4)));
typedef unsigned u32x2 __attribute__((ext_vector_type(2)));

constexpr int NTOK = 16384, DM = 2048, SEQ = 2048, NBATCH = 8, PLE = 256;
constexpr int NPROJ = 6144;
constexpr int PQ_SB = 0, PK_SB = 1024, PG_SB = 2048, PQ_DF = 3072, PK_DF = 4096, PG_DF = 5120;
constexpr float LOG2E = 1.4426950408889634f;
constexpr float SBQ_SCALE = 0.08838834764831845f * LOG2E;
constexpr float DFQ_SCALE = 0.125f * LOG2E;
constexpr float NORM_EPS = 1e-6f, SUBLN_EPS = 1e-5f;
constexpr float LAMBDA_INIT = 0.2f;

constexpr size_t MiB = 1u << 20;
constexpr size_t WS_CTL = 0;
constexpr size_t CTL_SS2 = 0, CTL_SS3 = 65536, CTL_LAM = 131072, CTL_ROPE = 262144, CTL_BAR = 524288, CTL_BAR_BYTES = 16384;
constexpr size_t WS_WIN = 2 * MiB, WS_WOUT = 34 * MiB, WS_WGATE = 42 * MiB, WS_WPROJ = 50 * MiB, WS_PB = 52 * MiB;
constexpr size_t WS_XN = 64 * MiB, WS_MIXED = 64 * MiB;
constexpr size_t WS_PROJ = 128 * MiB, WS_VT = 320 * MiB, WS_KIMG = 384 * MiB, WS_END = 448 * MiB;
constexpr size_t WS_HB = 128 * MiB, WS_PLE = 192 * MiB;
constexpr size_t WS_H2B = 64 * MiB;

constexpr int LDS_BYTES = 131072 + 1024;

__device__ __forceinline__ unsigned cvt_pk(float lo, float hi) { unsigned r; asm volatile("v_cvt_pk_bf16_f32 %0, %1, %2" : "=v"(r) : "v"(lo), "v"(hi)); return r; }
__device__ __forceinline__ float bf_lo(unsigned w) { return __uint_as_float(w << 16); }
__device__ __forceinline__ float bf_hi(unsigned w) { return __uint_as_float(w & 0xffff0000u); }
__device__ __forceinline__ float wave_sum(float v) {
#pragma unroll
    for (int o = 1; o < 64; o <<= 1) v += __shfl_xor(v, o);
    return v;
}
__device__ __forceinline__ float fast_exp2(float x) { return __builtin_amdgcn_exp2f(x); }
__device__ __forceinline__ float fast_log2(float x) { return __builtin_amdgcn_logf(x); }
__device__ __forceinline__ float silu_f(float x) { return x * __builtin_amdgcn_rcpf(1.f + fast_exp2(-x * LOG2E)); }
__device__ __forceinline__ float sigmoid_f(float x) { return __builtin_amdgcn_rcpf(1.f + fast_exp2(-x * LOG2E)); }

namespace pg8 {
struct EpiBf16 {
    static constexpr bool PERM = true, AFTER_DRAIN = false;
    bf16_t* O; int ldc;
    __device__ __forceinline__ void operator()(const f32x4 (&acc)[2][2][4][2], const Unit& u, int wr, int wc, int fr, int fq) const {
        const int row0 = u.pm * BM + wr * 64 + fr; const int col0 = u.pn * BM + wc * 32 + 8 * fq;
#pragma unroll
        for (int ai = 0; ai < 2; ++ai)
#pragma unroll
            for (int m = 0; m < 4; ++m) { bf16_t* rowp = O + (size_t)(row0 + ai * HALF + m * 16) * ldc + col0;
#pragma unroll
                for (int bj = 0; bj < 2; ++bj) { const f32x4 v0 = acc[ai][bj][m][0], v1 = acc[ai][bj][m][1];
                    u32x4 w; w.x = cvt_pk_bf16(v0[0], v0[1]); w.y = cvt_pk_bf16(v0[2], v0[3]); w.z = cvt_pk_bf16(v1[0], v1[1]); w.w = cvt_pk_bf16(v1[2], v1[3]);
                    *(u32x4*)(rowp + bj * HALF) = w; } }
    }
};
struct EpiProj {
    static constexpr bool PERM = true, AFTER_DRAIN = false;
    bf16_t* O; const float* rope; bf16_t* KI;
    __device__ __forceinline__ void operator()(const f32x4 (&acc)[2][2][4][2], const Unit& u, int wr, int wc, int fr, int fq) const {
        const int row0 = u.pm * BM + wr * 64 + fr; const int col0 = u.pn * BM + wc * 32 + 8 * fq;
        const int kind = u.pn >> 2;
        const bool dorope = (kind == 3 || kind == 4) && ((wc & 1) == 0) && (fq < 2);
        const float sc = kind == 0 ? SBQ_SCALE : (kind == 3 ? DFQ_SCALE : 1.f);
        const bool dosilu = (kind == 2 || kind == 5);
#pragma unroll
        for (int ai = 0; ai < 2; ++ai)
#pragma unroll
            for (int m = 0; m < 4; ++m) { const int row = row0 + ai * HALF + m * 16; bf16_t* rowp = O + (size_t)row * NPROJ + col0;
                if (kind == 1 || kind == 4) {
                    const int cw = col0 & 1023; rowp = KI + ((size_t)(((kind == 4 ? 8 : 0) + (row >> 11)) * 8 + (cw >> 7)) * SEQ + (row & (SEQ - 1))) * 128 + (cw & 127); }
                f32x4 cs0 = {1.f, 0.f, 1.f, 0.f}, cs1 = {1.f, 0.f, 1.f, 0.f};
                if (dorope) { const f32x4* rp = (const f32x4*)(rope + ((size_t)(row & (SEQ - 1)) * 8 + 4 * fq) * 2); cs0 = rp[0]; cs1 = rp[1]; }
#pragma unroll
                for (int bj = 0; bj < 2; ++bj) { f32x4 v0 = acc[ai][bj][m][0], v1 = acc[ai][bj][m][1];
                    if (dorope) {
                        f32x4 a, b;
                        a[0] = v0[0] * cs0[0] - v0[1] * cs0[1]; a[1] = v0[1] * cs0[0] + v0[0] * cs0[1];
                        a[2] = v0[2] * cs0[2] - v0[3] * cs0[3]; a[3] = v0[3] * cs0[2] + v0[2] * cs0[3];
                        b[0] = v1[0] * cs1[0] - v1[1] * cs1[1]; b[1] = v1[1] * cs1[0] + v1[0] * cs1[1];
                        b[2] = v1[2] * cs1[2] - v1[3] * cs1[3]; b[3] = v1[3] * cs1[2] + v1[2] * cs1[3];
                        v0 = a; v1 = b; }
                    if (dosilu) {
#pragma unroll
                        for (int j = 0; j < 4; ++j) { v0[j] = silu_f(v0[j]); v1[j] = silu_f(v1[j]); } }
                    v0 = v0 * sc; v1 = v1 * sc;
                    u32x4 w; w.x = cvt_pk_bf16(v0[0], v0[1]); w.y = cvt_pk_bf16(v0[2], v0[3]); w.z = cvt_pk_bf16(v1[0], v1[1]); w.w = cvt_pk_bf16(v1[2], v1[3]);
                    *(u32x4*)(rowp + ((kind == 1 || kind == 4) ? bj * SEQ * 128 : bj * HALF)) = w; } }
    }
};
struct EpiVt {
    static constexpr bool PERM = true, AFTER_DRAIN = false;
    bf16_t* O;
    __device__ __forceinline__ void operator()(const f32x4 (&acc)[2][2][4][2], const Unit& u, int wr, int wc, int fr, int fq) const {
        const int row0 = u.pm * BM + wr * 64 + fr; const int col0 = u.pn * BM + wc * 32 + 8 * fq;
        const int p0 = (fq & 1) ? 4 : 0, p1 = (fq & 1) ? 12 : 8;
#pragma unroll
        for (int ai = 0; ai < 2; ++ai)
#pragma unroll
            for (int m = 0; m < 4; ++m) { const int row = row0 + ai * HALF + m * 16; const int gh = row >> 7, d = row & 127;
#pragma unroll
                for (int bj = 0; bj < 2; ++bj) { const int col = col0 + bj * HALF; const int b = col >> 11, sq = col & (SEQ - 1);
                    bf16_t* tp = O + ((size_t)((((gh >> 3) * 8 + b) * 8 + (gh & 7)) * 32 + (sq >> 6)) * 128 + d) * 64 + (sq & 48);
                    const f32x4 v0 = acc[ai][bj][m][0], v1 = acc[ai][bj][m][1];
                    u32x2 w0, w1; w0.x = cvt_pk_bf16(v0[0], v0[1]); w0.y = cvt_pk_bf16(v0[2], v0[3]); w1.x = cvt_pk_bf16(v1[0], v1[1]); w1.y = cvt_pk_bf16(v1[2], v1[3]);
                    *(u32x2*)(tp + p0) = w0; *(u32x2*)(tp + p1) = w1; } }
    }
};
struct EpiRes {
    static constexpr bool PERM = false, AFTER_DRAIN = false;
    const float* x; bf16_t* hb; float* ss;
    __device__ __forceinline__ void operator()(const f32x4 (&acc)[2][2][4][2], const Unit& u, int wr, int wc, int fr, int fq) const {
        const int row0 = u.pm * BM + wr * 64 + fr; const int col0 = u.pn * BM + wc * 32 + 4 * fq;
#pragma unroll
        for (int ai = 0; ai < 2; ++ai)
#pragma unroll
            for (int m = 0; m < 4; ++m) { const int row = row0 + ai * HALF + m * 16; const size_t off = (size_t)row * DM + col0; float q = 0.f;
#pragma unroll
                for (int bj = 0; bj < 2; ++bj)
#pragma unroll
                    for (int n = 0; n < 2; ++n) { const size_t o2 = off + bj * HALF + n * 16; const f32x4 hv = *(const f32x4*)(x + o2) + acc[ai][bj][m][n];
                        u32x2 w; w.x = cvt_pk_bf16(hv[0], hv[1]); w.y = cvt_pk_bf16(hv[2], hv[3]); *(u32x2*)(hb + o2) = w;
                        q += (hv[0] * hv[0] + hv[1] * hv[1]) + (hv[2] * hv[2] + hv[3] * hv[3]); }
                q += __shfl_xor(q, 16); q += __shfl_xor(q, 32);
                if (fq == 0) atomicAdd(ss + row, q); }
    }
};
struct EpiGate {
    static constexpr bool PERM = false, AFTER_DRAIN = false;
    const bf16_t* hb; bf16_t* h2b; const bf16_t* ple; const float* ss2; float* ss3;
    __device__ __forceinline__ void operator()(const f32x4 (&acc)[2][2][4][2], const Unit& u, int wr, int wc, int fr, int fq) const {
        const int row0 = u.pm * BM + wr * 64 + fr; const int col0 = u.pn * BM + wc * 32 + 4 * fq;
#pragma unroll
        for (int ai = 0; ai < 2; ++ai)
#pragma unroll
            for (int m = 0; m < 4; ++m) { const int row = row0 + ai * HALF + m * 16; const size_t off = (size_t)row * DM + col0; float q = 0.f;
                const float rstd = rsqrtf(ss2[row] * (1.f / DM) + NORM_EPS);
#pragma unroll
                for (int bj = 0; bj < 2; ++bj)
#pragma unroll
                    for (int n = 0; n < 2; ++n) { const size_t o2 = off + bj * HALF + n * 16; const u32x2 hw = *(const u32x2*)(hb + o2); const f32x4 hv = {bf_lo(hw.x), bf_hi(hw.x), bf_lo(hw.y), bf_hi(hw.y)}; const u32x2 pw = *(const u32x2*)(ple + o2);
                        const f32x4 a = acc[ai][bj][m][n] * rstd; f32x4 h2;
                        h2[0] = hv[0] + sigmoid_f(a[0]) * bf_lo(pw.x); h2[1] = hv[1] + sigmoid_f(a[1]) * bf_hi(pw.x);
                        h2[2] = hv[2] + sigmoid_f(a[2]) * bf_lo(pw.y); h2[3] = hv[3] + sigmoid_f(a[3]) * bf_hi(pw.y);
                        u32x2 w2; w2.x = cvt_pk_bf16(h2[0], h2[1]); w2.y = cvt_pk_bf16(h2[2], h2[3]); *(u32x2*)(h2b + o2) = w2;
                        q += (h2[0] * h2[0] + h2[1] * h2[1]) + (h2[2] * h2[2] + h2[3] * h2[3]); }
                q += __shfl_xor(q, 16); q += __shfl_xor(q, 32);
                if (fq == 0) atomicAdd(ss3 + row, q); }
    }
};
}
namespace att {
constexpr int KP = 272, VP = 144, KT_BYTES = 64 * KP, VT_BYTES = 128 * VP, BUF_BYTES = KT_BYTES + VT_BYTES;
constexpr int FLAG_OFF = 2 * BUF_BYTES;
constexpr int XP = 132;
constexpr float R_DONE = 152.0f;

template <bool MASK>
__device__ __forceinline__ void sb_block(const f32x16& sv, int kbase, int tq, int h, float& R, bf16x8 (&pf)[2]) {
    float c[16];
#pragma unroll
    for (int i = 0; i < 16; ++i) {
        const float z = sv[i];
        const float spv = fmaxf(z, 0.f) + fast_log2(1.f + fast_exp2(-fabsf(z)));
        c[i] = (!MASK || (kbase + 8 * (i >> 2) + (i & 3) < tq)) ? spv : 0.f;
    }
    float T[4], OT[4], pr[4], suf[4];
#pragma unroll
    for (int g = 0; g < 4; ++g) { c[4 * g + 2] += c[4 * g + 3]; c[4 * g + 1] += c[4 * g + 2]; c[4 * g] += c[4 * g + 1]; T[g] = c[4 * g]; }
#pragma unroll
    for (int g = 0; g < 4; ++g) { OT[g] = __shfl_xor(T[g], 32); pr[g] = T[g] + OT[g]; }
    suf[3] = 0.f; suf[2] = pr[3]; suf[1] = suf[2] + pr[2]; suf[0] = suf[1] + pr[1];
    float w[16];
#pragma unroll
    for (int g = 0; g < 4; ++g) { const float off = R + suf[g] + (h == 0 ? OT[g] : 0.f);
#pragma unroll
        for (int j = 0; j < 4; ++j) { const int i = 4 * g + j; const float e = fast_exp2(sv[i] - (off + c[i])); w[i] = (!MASK || (kbase + 8 * (i >> 2) + (i & 3) < tq)) ? e : 0.f; } }
    R += suf[0] + pr[0];
#pragma unroll
    for (int sp = 0; sp < 2; ++sp) { u32x4 p; p.x = cvt_pk(w[8 * sp], w[8 * sp + 1]); p.y = cvt_pk(w[8 * sp + 2], w[8 * sp + 3]); p.z = cvt_pk(w[8 * sp + 4], w[8 * sp + 5]); p.w = cvt_pk(w[8 * sp + 6], w[8 * sp + 7]);
        pf[sp] = __builtin_bit_cast(bf16x8, p); }
}

template <int MODE>
__device__ __forceinline__ void attn_unit(LAS unsigned char* lds, const bf16_t* __restrict__ PROJ, const bf16_t* __restrict__ KIMG, const bf16_t* __restrict__ VT, bf16_t* __restrict__ MIXED,
                                          int b, int hh, int qblk, float lam, const float* __restrict__ subln_g) {
    constexpr int QB = MODE == 0 ? 256 : 128;
    constexpr int NKS = MODE == 0 ? 8 : 4;
    const int tid = opaque_tid(), lane = tid & 63, r = lane & 31, h = lane >> 5;
    const int wid = __builtin_amdgcn_readfirstlane(tid >> 6);
    const int qg = MODE == 0 ? wid : (wid & 3), role = MODE == 0 ? 0 : (wid >> 2);
    const int Q0 = qblk * QB, q0w = Q0 + 32 * qg, tq = q0w + r;
    const size_t tokbase = (size_t)b * SEQ;
    const int gbh = ((MODE == 0 ? 0 : 8) + b) * 8 + hh;
    const bf16_t* Kg = KIMG + (size_t)gbh * SEQ * 128;
    const bf16_t* Vg = VT + (size_t)gbh * 32 * 8192;
    bf16x8 qf[NKS];
    { const bf16_t* qp = PROJ + (tokbase + tq) * NPROJ + (MODE == 0 ? PQ_SB + hh * 128 : PQ_DF + hh * 128 + role * 64) + 8 * h;
#pragma unroll
      for (int ks = 0; ks < NKS; ++ks) qf[ks] = *(const bf16x8*)(qp + 16 * ks); }
    f32x16 o[4];
#pragma unroll
    for (int d = 0; d < 4; ++d)
#pragma unroll
        for (int i = 0; i < 16; ++i) o[d][i] = 0.f;
    float R = 0.f, m_run = -1e30f, l_run = 0.f;
    const int kr0 = tid >> 4, kc = tid & 15, vr0 = tid >> 3, vc = tid & 7;
    const int kst = kr0 * KP + kc * 16, vst = KT_BYTES + vr0 * VP + vc * 16;
    const bf16_t* kgl = Kg + tid * 8;
    const bf16_t* vgl = Vg + tid * 8;
    u32x4 kreg[2], vreg[2];
#define ATT_LOAD(t) do { _Pragma("unroll") for (int i_ = 0; i_ < 2; ++i_) { \
        kreg[i_] = *(const u32x4*)(kgl + (size_t)(t) * 8192 + i_ * 4096); \
        vreg[i_] = *(const u32x4*)(vgl + (size_t)(t) * 8192 + i_ * 4096); } } while (0)
#define ATT_STORE(bo) do { _Pragma("unroll") for (int i_ = 0; i_ < 2; ++i_) { \
        *(LAS u32x4*)(lds + (bo) + kst + i_ * 32 * KP) = kreg[i_]; \
        *(LAS u32x4*)(lds + (bo) + vst + i_ * 64 * VP) = vreg[i_]; } } while (0)
    const int tl = (Q0 + QB - 1) >> 6;
    const int kfrag = r * KP + (role * 64 + 8 * h) * 2;
    const int vfrag = KT_BYTES + r * VP + (8 * h) * 2;
    volatile LAS int* flags = (volatile LAS int*)(lds + FLAG_OFF);
    __syncthreads();
    ATT_LOAD(tl); ATT_STORE(0);
    __syncthreads();
    int cur = 0, it = 0;
    bool wdone = false;
    for (int t = tl;; --t, ++it) {
        if (t > 0) ATT_LOAD(t - 1);
        const int k0 = 64 * t;
        const bool active = (MODE == 0) ? (!wdone && k0 <= q0w + 30) : (k0 <= q0w + 31);
        if (active) {
            const int bo = cur * BUF_BYTES;
            f32x16 s[2];
            bf16x8 vf[4][2][2];
            if (MODE == 1) {
                bf16x8 kf[2][NKS];
#pragma unroll
                for (int kb = 0; kb < 2; ++kb)
#pragma unroll
                    for (int ks = 0; ks < NKS; ++ks) kf[kb][ks] = *(const LAS bf16x8*)(lds + bo + kfrag + kb * 32 * KP + ks * 32);
                __builtin_amdgcn_sched_barrier(0);
#pragma unroll
                for (int kb = 0; kb < 2; ++kb) {
#pragma unroll
                    for (int i = 0; i < 16; ++i) s[kb][i] = 0.f;
#pragma unroll
                    for (int ks = 0; ks < NKS; ++ks) s[kb] = __builtin_amdgcn_mfma_f32_32x32x16_bf16(kf[kb][ks], qf[ks], s[kb], 0, 0, 0);
                }
                __builtin_amdgcn_sched_barrier(0);
#pragma unroll
                for (int d = 0; d < 2; ++d)
#pragma unroll
                    for (int kb = 0; kb < 2; ++kb)
#pragma unroll
                        for (int sp = 0; sp < 2; ++sp) vf[d][kb][sp] = *(const LAS bf16x8*)(lds + bo + vfrag + d * 32 * VP + (32 * kb + 16 * sp) * 2);
                __builtin_amdgcn_sched_barrier(0);
            } else {
#pragma unroll
                for (int kb = 0; kb < 2; ++kb) {
#pragma unroll
                    for (int i = 0; i < 16; ++i) s[kb][i] = 0.f;
#pragma unroll
                    for (int ks = 0; ks < NKS; ++ks) {
                        const bf16x8 a = *(const LAS bf16x8*)(lds + bo + kfrag + kb * 32 * KP + ks * 32);
                        s[kb] = __builtin_amdgcn_mfma_f32_32x32x16_bf16(a, qf[ks], s[kb], 0, 0, 0);
                    }
                }
            }
            bf16x8 pf[2][2];
            if (MODE == 0) {
                { sb_block<true>(s[1], k0 + 32 + 4 * h, tq, h, R, pf[1]); sb_block<true>(s[0], k0 + 4 * h, tq, h, R, pf[0]); }
                wdone = __all(R >= R_DONE);
            } else {
                float mx = -1e30f;
                if (k0 + 63 > q0w) {
#pragma unroll
                    for (int kb = 0; kb < 2; ++kb) { const int kbase = k0 + 32 * kb + 4 * h;
#pragma unroll
                        for (int i = 0; i < 16; ++i) { const int key = kbase + 8 * (i >> 2) + (i & 3); const float v = (key <= tq) ? s[kb][i] : -1e30f; s[kb][i] = v; mx = fmaxf(mx, v); } }
                } else {
#pragma unroll
                    for (int kb = 0; kb < 2; ++kb)
#pragma unroll
                        for (int i = 0; i < 16; ++i) mx = fmaxf(mx, s[kb][i]);
                }
                mx = fmaxf(mx, __shfl_xor(mx, 32));
                const float m_new = fmaxf(m_run, mx), alpha = fast_exp2(m_run - m_new);
                m_run = m_new;
                float ls = 0.f;
#pragma unroll
                for (int kb = 0; kb < 2; ++kb) {
#pragma unroll
                    for (int i = 0; i < 16; ++i) { const float p = fast_exp2(s[kb][i] - m_new); s[kb][i] = p; ls += p; }
#pragma unroll
                    for (int sp = 0; sp < 2; ++sp) { u32x4 p; p.x = cvt_pk(s[kb][8 * sp], s[kb][8 * sp + 1]); p.y = cvt_pk(s[kb][8 * sp + 2], s[kb][8 * sp + 3]); p.z = cvt_pk(s[kb][8 * sp + 4], s[kb][8 * sp + 5]); p.w = cvt_pk(s[kb][8 * sp + 6], s[kb][8 * sp + 7]);
                        pf[kb][sp] = __builtin_bit_cast(bf16x8, p); }
                }
                l_run = l_run * alpha + ls;
                if (!__all(alpha == 1.f)) {
#pragma unroll
                    for (int d = 0; d < 4; ++d)
#pragma unroll
                        for (int i = 0; i < 16; ++i) o[d][i] *= alpha;
                }
            }
            if (MODE == 1) {
                __builtin_amdgcn_sched_barrier(0);
#pragma unroll
                for (int d = 2; d < 4; ++d)
#pragma unroll
                    for (int kb = 0; kb < 2; ++kb)
#pragma unroll
                        for (int sp = 0; sp < 2; ++sp) vf[d][kb][sp] = *(const LAS bf16x8*)(lds + bo + vfrag + d * 32 * VP + (32 * kb + 16 * sp) * 2);
                __builtin_amdgcn_sched_barrier(0);
            }
#pragma unroll
            for (int d = 0; d < 4; ++d)
#pragma unroll
                for (int kb = 0; kb < 2; ++kb)
#pragma unroll
                    for (int sp = 0; sp < 2; ++sp) {
                        const bf16x8 a = (MODE == 1) ? vf[d][kb][sp] : *(const LAS bf16x8*)(lds + bo + vfrag + d * 32 * VP + (32 * kb + 16 * sp) * 2);
                        o[d] = __builtin_amdgcn_mfma_f32_32x32x16_bf16(a, pf[kb][sp], o[d], 0, 0, 0);
                    }
        }
        if (t > 0) ATT_STORE((cur ^ 1) * BUF_BYTES);
        if (MODE == 0) { if (lane == 0) flags[(it & 1) * 8 + wid] = wdone ? 1 : 0; }
        __syncthreads();
        if (t == 0) break;
        if (MODE == 0) { int alld = 1;
#pragma unroll
            for (int w2 = 0; w2 < 8; ++w2) alld &= flags[(it & 1) * 8 + w2];
            if (alld) break; }
        cur ^= 1;
    }
#undef ATT_LOAD
#undef ATT_STORE
    const size_t tok = tokbase + tq;
    if (MODE == 0) {
        const bf16_t* gp = PROJ + tok * NPROJ + PG_SB + hh * 128 + 4 * h;
        bf16_t* op = MIXED + tok * DM + hh * 128 + 4 * h;
#pragma unroll
        for (int d = 0; d < 4; ++d)
#pragma unroll
            for (int g = 0; g < 4; ++g) { const u32x2 gw = *(const u32x2*)(gp + 32 * d + 8 * g);
                u32x2 ow; ow.x = cvt_pk(o[d][4 * g] * bf_lo(gw.x), o[d][4 * g + 1] * bf_hi(gw.x)); ow.y = cvt_pk(o[d][4 * g + 2] * bf_lo(gw.y), o[d][4 * g + 3] * bf_hi(gw.y));
                *(u32x2*)(op + 32 * d + 8 * g) = ow; }
    } else {
        const float lt = l_run + __shfl_xor(l_run, 32);
        const float inv = 1.f / lt;
        LAS float* xq = (LAS float*)lds + (qg * 32 + r) * XP + 4 * h;
        if (role == 1) {
            const float f = inv * lam;
#pragma unroll
            for (int d = 0; d < 4; ++d)
#pragma unroll
                for (int g = 0; g < 4; ++g) *(LAS f32x4*)(xq + 32 * d + 8 * g) = (f32x4){o[d][4 * g] * f, o[d][4 * g + 1] * f, o[d][4 * g + 2] * f, o[d][4 * g + 3] * f};
        }
        __syncthreads();
        if (role == 0) {
            float q = 0.f;
#pragma unroll
            for (int d = 0; d < 4; ++d)
#pragma unroll
                for (int g = 0; g < 4; ++g) { const f32x4 x2 = *(const LAS f32x4*)(xq + 32 * d + 8 * g);
#pragma unroll
                    for (int j = 0; j < 4; ++j) { const float v = o[d][4 * g + j] * inv - x2[j]; o[d][4 * g + j] = v; q += v * v; } }
            q += __shfl_xor(q, 32);
            const float rs = rsqrtf(q * (1.f / 128.f) + SUBLN_EPS) * (1.f - LAMBDA_INIT);
            const bf16_t* gp = PROJ + tok * NPROJ + PG_DF + hh * 128 + 4 * h;
            bf16_t* op = MIXED + tok * DM + 1024 + hh * 128 + 4 * h;
            const float* sg = subln_g + 4 * h;
#pragma unroll
            for (int d = 0; d < 4; ++d)
#pragma unroll
                for (int g = 0; g < 4; ++g) { const u32x2 gw = *(const u32x2*)(gp + 32 * d + 8 * g); const f32x4 sv = *(const f32x4*)(sg + 32 * d + 8 * g);
                    u32x2 ow; ow.x = cvt_pk(o[d][4 * g] * rs * sv[0] * bf_lo(gw.x), o[d][4 * g + 1] * rs * sv[1] * bf_hi(gw.x));
                    ow.y = cvt_pk(o[d][4 * g + 2] * rs * sv[2] * bf_lo(gw.y), o[d][4 * g + 3] * rs * sv[3] * bf_hi(gw.y));
                    *(u32x2*)(op + 32 * d + 8 * g) = ow; }
        }
    }
}
}
#define XB_TMO      128
#define XB_XCNT(j)  (256  + 64 * (j))
#define XB_XSUB(j)  (1280 + 64 * (j))
#define XB_XGEN(j)  (2304 + 64 * (j))
#define XB_TOP      3328
#define XB_TOPGEN   3392
#define XCD_BAR_WORDS 3456
#define XB_SPIN_CAP (1u << 18)

__device__ __forceinline__ unsigned xb_ld(unsigned* p)              { return __hip_atomic_load(p, __ATOMIC_RELAXED, __HIP_MEMORY_SCOPE_AGENT); }
__device__ __forceinline__ unsigned xb_add(unsigned* p, unsigned v) { return __hip_atomic_fetch_add(p, v, __ATOMIC_RELAXED, __HIP_MEMORY_SCOPE_AGENT); }
__device__ __forceinline__ unsigned xb_xcc_id() { return (unsigned)__builtin_amdgcn_s_getreg((3 << 11) | 20) & 0xFu; }
#define XB_SPIN(cond, bar) do { unsigned _sp = 0; while (cond) { __builtin_amdgcn_s_sleep(1); \
    if ((++_sp & 255u) == 0u) { if (xb_ld(&(bar)[XB_TMO])) break; if (_sp > XB_SPIN_CAP) { atomicAdd(&(bar)[XB_TMO], 1u); break; } } } } while (0)

struct XcdBarrier {
    unsigned* bar; unsigned x;
    volatile LAS unsigned* st;
};

__device__ __forceinline__ XcdBarrier xcd_barrier_post(unsigned* bar, volatile LAS unsigned* st) {
    XcdBarrier b; b.bar = bar; b.x = xb_xcc_id(); b.st = st;
    if (threadIdx.x == 0) (void)xb_add(&bar[XB_XCNT(b.x)], 1u);
    return b;
}
__device__ __forceinline__ void xcd_barrier_complete(unsigned* bar, unsigned x, unsigned& nloc, unsigned& nx) {
    const unsigned G = gridDim.x * gridDim.y * gridDim.z;
    unsigned sum, cnt, mine, sp = 0u;
    for (;;) {
        sum = 0u; cnt = 0u; mine = 0u;
#pragma unroll
        for (unsigned j = 0; j < 16; ++j) { const unsigned c = xb_ld(&bar[XB_XCNT(j)]); sum += c; cnt += (c > 0u) ? 1u : 0u; mine = (j == x) ? c : mine; }
        if (sum == G) break;
        __builtin_amdgcn_s_sleep(1);
        if ((++sp & 255u) == 0u) { if (xb_ld(&bar[XB_TMO])) break; if (sp > XB_SPIN_CAP) { atomicAdd(&bar[XB_TMO], 1u); break; } }
    }
    nloc = mine > 0u ? mine : 1u; nx = cnt > 0u ? cnt : 1u;
}

__device__ __forceinline__ void xcd_barrier(const XcdBarrier& b) {
    asm volatile("s_waitcnt vmcnt(0)" ::: "memory");
    __syncthreads();
    if (threadIdx.x == 0) {
        unsigned* bar = b.bar;
        __builtin_amdgcn_s_waitcnt(0);
        unsigned nloc = b.st[0], nx = b.st[1];
        if (nloc == 0u) { xcd_barrier_complete(bar, b.x, nloc, nx); b.st[0] = nloc; b.st[1] = nx; }
        const unsigned old = xb_add(&bar[XB_XSUB(b.x)], 1u);
        const unsigned gen = old / nloc;
        if (old + 1u == (gen + 1u) * nloc) {
            __builtin_amdgcn_fence(__ATOMIC_RELEASE, "agent");
            asm volatile("s_waitcnt vmcnt(0)" ::: "memory");
            const unsigned og = xb_add(&bar[XB_TOP], 1u);
            const unsigned tg = og / nx;
            if (og + 1u == (tg + 1u) * nx) xb_add(&bar[XB_TOPGEN], 1u);
            else XB_SPIN(xb_ld(&bar[XB_TOPGEN]) == tg, bar);
            __builtin_amdgcn_fence(__ATOMIC_ACQUIRE, "agent");
            xb_add(&bar[XB_XGEN(b.x)], 1u);
            asm volatile("s_waitcnt vmcnt(0)" ::: "memory");
        } else {
            XB_SPIN(xb_ld(&bar[XB_XGEN(b.x)]) == gen, bar);
            __builtin_amdgcn_fence(__ATOMIC_ACQUIRE, "agent");
            asm volatile("s_waitcnt vmcnt(0)" ::: "memory");
        }
    }
    __syncthreads();
}

__device__ __forceinline__ int win_dst_row(int c) {
    const int seg = c >> 10, w = c & 1023, d6 = w & 63;
    const int wp = d6 < 16 ? (w & ~63) + (d6 < 8 ? 2 * d6 : 2 * (d6 - 8) + 1) : w;
    switch (seg) { case 0: return w; case 1: return 1024 + w; case 2: return 6144 + w; case 3: return 2048 + w;
                   case 4: return 3072 + wp; case 5: return 4096 + wp; case 6: return 7168 + w; default: return 5120 + w; }
}
struct TItem { const float* W; bf16_t* WT; const float* ks; int K, N, win, item; };
__device__ __forceinline__ void tr_load(const TItem& t, float (&v)[32], int lane) {
    const int nblk = t.N / 32, kb = t.item / nblk, nb = t.item % nblk; const float* p = t.W + (size_t)(64 * kb + (lane >> 5)) * t.N + 32 * nb + (lane & 31);
#pragma unroll
    for (int i = 0; i < 32; ++i) v[i] = p[(size_t)(2 * i) * t.N];
}
__device__ __forceinline__ void tr_write(const float (&v)[32], LAS float* scr, int lane) {
#pragma unroll
    for (int i = 0; i < 32; ++i) scr[(2 * i + (lane >> 5)) * 33 + (lane & 31)] = v[i];
}
__device__ __forceinline__ void tr_store(const TItem& t, LAS float* scr, int lane) {
    const int nblk = t.N / 32, kb = t.item / nblk, nb = t.item % nblk, k0 = 64 * kb, n0 = 32 * nb, c = lane & 7;
    f32x4 s0 = {1.f, 1.f, 1.f, 1.f}, s1 = {1.f, 1.f, 1.f, 1.f};
    if (t.ks) { s0 = *(const f32x4*)(t.ks + k0 + 8 * c); s1 = *(const f32x4*)(t.ks + k0 + 8 * c + 4); }
#pragma unroll
    for (int j = 0; j < 4; ++j) { const int n = (lane >> 3) + 8 * j; const LAS float* s = scr + (8 * c) * 33 + n;
        u32x4 o; o.x = cvt_pk(s[0 * 33] * s0[0], s[1 * 33] * s0[1]); o.y = cvt_pk(s[2 * 33] * s0[2], s[3 * 33] * s0[3]); o.z = cvt_pk(s[4 * 33] * s1[0], s[5 * 33] * s1[1]); o.w = cvt_pk(s[6 * 33] * s1[2], s[7 * 33] * s1[3]);
        const int dn = t.win ? win_dst_row(n0 + n) : (n0 + n);
        *(u32x4*)(t.WT + (size_t)dn * t.K + k0 + 8 * c) = o; }
}
__device__ __forceinline__ void rms_load(const float* __restrict__ xrow, f32x4 (&v)[8], int lane) {
    const f32x4* xr = (const f32x4*)xrow + lane;
#pragma unroll
    for (int j = 0; j < 8; ++j) v[j] = xr[64 * j];
}
__device__ __forceinline__ void rms_finish(const f32x4 (&v)[8], const f32x4 (&gv)[8], bf16_t* __restrict__ orow, int lane) {
    float s = 0.f;
#pragma unroll
    for (int j = 0; j < 8; ++j) s += (v[j][0] * v[j][0] + v[j][1] * v[j][1]) + (v[j][2] * v[j][2] + v[j][3] * v[j][3]);
    const float rstd = rsqrtf(wave_sum(s) * (1.f / DM) + NORM_EPS);
    u32x2* o8 = (u32x2*)orow + lane;
#pragma unroll
    for (int j = 0; j < 8; ++j) { u32x2 w; w.x = cvt_pk(v[j][0] * rstd * gv[j][0], v[j][1] * rstd * gv[j][1]); w.y = cvt_pk(v[j][2] * rstd * gv[j][2], v[j][3] * rstd * gv[j][3]); o8[64 * j] = w; }
}

struct Args { const float* in[14]; float* out; unsigned char* ws; };

__global__ void __launch_bounds__(512, 2) fwd_megakernel(Args a) {
    extern __shared__ __attribute__((aligned(16))) unsigned char lds_raw[];
    LAS unsigned char* lds = (LAS unsigned char*)lds_raw;
    { cg::grid_group grid = cg::this_grid(); if (a.ws == nullptr) grid.sync(); }
    const int tid = threadIdx.x, lane = tid & 63, wave = __builtin_amdgcn_readfirstlane(tid >> 6);
    const int G = gridDim.x, bx = blockIdx.x;
    const int vcu = (G % 8 == 0) ? (bx % 8) * (G / 8) + bx / 8 : bx;
    unsigned char* ws = a.ws;
    float* ss2 = (float*)(ws + WS_CTL + CTL_SS2); float* ss3 = (float*)(ws + WS_CTL + CTL_SS3); float* lamp = (float*)(ws + WS_CTL + CTL_LAM); float* rope = (float*)(ws + WS_CTL + CTL_ROPE);
    bf16_t* WIN = (bf16_t*)(ws + WS_WIN); bf16_t* WOUT = (bf16_t*)(ws + WS_WOUT); bf16_t* WGATE = (bf16_t*)(ws + WS_WGATE); bf16_t* WPROJ = (bf16_t*)(ws + WS_WPROJ);
    bf16_t* PB = (bf16_t*)(ws + WS_PB); bf16_t* XN = (bf16_t*)(ws + WS_XN); bf16_t* MIXED = (bf16_t*)(ws + WS_MIXED); bf16_t* PROJ = (bf16_t*)(ws + WS_PROJ);
    bf16_t* VT = (bf16_t*)(ws + WS_VT); bf16_t* KIMG = (bf16_t*)(ws + WS_KIMG); bf16_t* HB = (bf16_t*)(ws + WS_HB); bf16_t* PLEB = (bf16_t*)(ws + WS_PLE); bf16_t* H2B = (bf16_t*)(ws + WS_H2B);
    const float* x = a.in[0]; float* out = a.out;
    volatile LAS unsigned* xst = (volatile LAS unsigned*)(lds + 131072);
    if (tid == 0) { xst[0] = 0u; xst[1] = 0u; }
    __syncthreads();
    const XcdBarrier xb = xcd_barrier_post((unsigned*)(ws + WS_CTL + CTL_BAR), xst);

    for (int rep_ = 0; rep_ < ((PROBE_DUP & 1) ? 2 : 1); ++rep_) {
        if (rep_) __syncthreads();
        const int gw = bx * 8 + wave, NGW = G * 8; const int gt = bx * 512 + tid, NGT = G * 512;
        for (int i = gt; i < 2 * NTOK; i += NGT) ss2[i] = 0.f;
        if (gt == 0) { float s1 = 0.f, s2 = 0.f; for (int i = 0; i < 64; ++i) { s1 += a.in[4][i] * a.in[5][i]; s2 += a.in[6][i] * a.in[7][i]; } lamp[0] = expf(s1) - expf(s2) + LAMBDA_INIT; }
        for (int i = gt; i < SEQ * 8; i += NGT) { const int pos = i >> 3, f = i & 7;
            const float invf = (float)exp2(-(double)f * 0.125 * 18.931568569324174);
            const float angf = (float)pos * invf;
            const double tw = 6.283185307179586476925; double ang = (double)angf; ang -= tw * rint(ang / tw);
            rope[2 * i] = (float)cos(ang); rope[2 * i + 1] = (float)sin(ang); }
        LAS float* scr = (LAS float*)(lds + wave * 16384);
        constexpr int I_IN = (DM / 64) * (8192 / 32), I_SQ = (DM / 64) * (DM / 32), I_PR = (PLE / 64) * (DM / 32), I_ALL = I_IN + 2 * I_SQ + I_PR;
#define P0_DECODE(T, it_) do { int rr_ = (it_); \
            if (rr_ < I_IN) { T = TItem{a.in[3], WIN, nullptr, DM, 8192, 1, rr_}; } \
            else if (rr_ < I_IN + I_SQ) { T = TItem{a.in[9], WOUT, nullptr, DM, DM, 0, rr_ - I_IN}; } \
            else if (rr_ < I_IN + 2 * I_SQ) { T = TItem{a.in[11], WGATE, a.in[10], DM, DM, 0, rr_ - I_IN - I_SQ}; } \
            else { T = TItem{a.in[12], WPROJ, nullptr, PLE, DM, 0, rr_ - I_IN - 2 * I_SQ}; } } while (0)
        {
            float tv[32]; TItem cur, nxt; int it = gw;
            if (it < I_ALL) { P0_DECODE(cur, it); tr_load(cur, tv, lane); }
            while (it < I_ALL) {
                tr_write(tv, scr, lane);
                const int itn = it + NGW;
                if (itn < I_ALL) { P0_DECODE(nxt, itn); tr_load(nxt, tv, lane); }
                asm volatile("s_waitcnt lgkmcnt(0)" ::: "memory");
                tr_store(cur, scr, lane);
                asm volatile("s_waitcnt lgkmcnt(0)" ::: "memory");
                cur = nxt; it = itn;
            }
        }
#undef P0_DECODE
        {
            f32x4 gv[8], va[8], vb[8];
            { const f32x4* gr = (const f32x4*)a.in[2] + lane;
#pragma unroll
              for (int j = 0; j < 8; ++j) gv[j] = gr[64 * j]; }
            int m = gw;
            if (m < NTOK) rms_load(x + (size_t)m * DM, va, lane);
            for (; m < NTOK; m += 2 * NGW) {
                const int m1 = m + NGW, m2 = m + 2 * NGW;
                if (m1 < NTOK) rms_load(x + (size_t)m1 * DM, vb, lane);
                rms_finish(va, gv, XN + (size_t)m * DM, lane);
                if (m2 < NTOK) rms_load(x + (size_t)m2 * DM, va, lane);
                if (m1 < NTOK) rms_finish(vb, gv, XN + (size_t)m1 * DM, lane);
            }
        }
        for (int i = gt; i < NTOK * PLE / 8; i += NGT) { const f32x4 v0 = ((const f32x4*)a.in[1])[2 * i], v1 = ((const f32x4*)a.in[1])[2 * i + 1];
            u32x4 w; w.x = cvt_pk(v0[0], v0[1]); w.y = cvt_pk(v0[2], v0[3]); w.z = cvt_pk(v1[0], v1[1]); w.w = cvt_pk(v1[2], v1[3]); ((u32x4*)PB)[i] = w; }
    }
    xcd_barrier(xb);
    for (int rep_ = 0; rep_ < ((PROBE_DUP & 2) ? 2 : 1); ++rep_) {
        if (rep_) __syncthreads();
        { pg8::Gemm g{XN, WIN, NTOK, NPROJ, DM}; pg8::StaticOrder S; S.init(NTOK, NPROJ, G, bx); pg8::EpiProj E{PROJ, rope, KIMG};
          pg8::gemm_phase<pg8::EpiProj, pg8::StaticOrder, true, true>(lds, g, S, E); }
        __syncthreads();
        { pg8::Gemm g{WIN + (size_t)NPROJ * DM, XN, 2048, NTOK, DM}; pg8::StaticOrder S; S.init(2048, NTOK, G, bx); pg8::EpiVt E{VT};
          pg8::gemm_phase<pg8::EpiVt, pg8::StaticOrder, true, true>(lds, g, S, E); }
    }
    xcd_barrier(xb);
    for (int rep_ = 0; rep_ < ((PROBE_DUP & 4) ? 2 : 1); ++rep_) {
        const float lam = lamp[0];
        for (int su = vcu; su < 256; su += G) {
            const int grp = su >> 4, j = su & 15;
#pragma unroll 1
            for (int k = 0; k < 4; ++k) { const int bh = 4 * grp + k; const int qb = (k & 1) ? 15 - j : j;
                att::attn_unit<1>(lds, PROJ, KIMG, VT, MIXED, bh >> 3, bh & 7, qb, lam, a.in[8]); }
        }
#pragma unroll 1
        for (int u = vcu; u < 512; u += G) att::attn_unit<0>(lds, PROJ, KIMG, VT, MIXED, (u >> 3) >> 3, (u >> 3) & 7, u & 7, lam, a.in[8]);
    }
    xcd_barrier(xb);
    {
        __syncthreads();
        { pg8::Gemm g{MIXED, WOUT, NTOK, DM, DM}; pg8::StaticOrder S; S.init(NTOK, DM, G, bx); pg8::EpiRes E{x, HB, ss2};
          pg8::gemm_phase<pg8::EpiRes, pg8::StaticOrder, true, true>(lds, g, S, E); }
        __syncthreads();
        { pg8::Gemm g{PB, WPROJ, NTOK, DM, PLE}; pg8::StaticOrder S; S.init(NTOK, DM, G, bx); pg8::EpiBf16 E{PLEB, DM};
          pg8::gemm_phase<pg8::EpiBf16, pg8::StaticOrder, true, true>(lds, g, S, E); }
    }
    xcd_barrier(xb);
    {
        pg8::Gemm g{HB, WGATE, NTOK, DM, DM}; pg8::StaticOrder S; S.init(NTOK, DM, G, bx); pg8::EpiGate E{HB, H2B, PLEB, ss2, ss3};
        pg8::gemm_phase<pg8::EpiGate, pg8::StaticOrder, true, true>(lds, g, S, E);
    }
    xcd_barrier(xb);
    {
        const int tid5 = opaque_tid(), lane = tid5 & 63, wave = __builtin_amdgcn_readfirstlane(tid5 >> 6);
        const int gw = bx * 8 + wave, NGW = G * 8; const f32x4* gr = (const f32x4*)a.in[13];
        for (int m = gw; m < NTOK; m += NGW) { const float rstd = rsqrtf(ss3[m] * (1.f / DM) + NORM_EPS); f32x4* orow = (f32x4*)(out + (size_t)m * DM); const u32x4* hrow = (const u32x4*)(H2B + (size_t)m * DM);
#pragma unroll
            for (int j = 0; j < 4; ++j) { const int c = lane + 64 * j; const u32x4 hw = hrow[c]; const f32x4 g0 = gr[2 * c], g1 = gr[2 * c + 1];
                orow[2 * c] = (f32x4){bf_lo(hw.x) * rstd * g0[0], bf_hi(hw.x) * rstd * g0[1], bf_lo(hw.y) * rstd * g0[2], bf_hi(hw.y) * rstd * g0[3]};
                orow[2 * c + 1] = (f32x4){bf_lo(hw.z) * rstd * g1[0], bf_hi(hw.z) * rstd * g1[1], bf_lo(hw.w) * rstd * g1[2], bf_hi(hw.w) * rstd * g1[3]}; } }
    }
}

extern "C" void kernel_launch(void* const* d_in, const int* in_sizes, int n_in, void* d_out, int out_size, void* d_ws, size_t ws_size, hipStream_t stream) {
    static int grid = 0;
    if (grid == 0) {
        if (n_in != 14 || out_size != NTOK * DM || ws_size < WS_END) { fprintf(stderr, "kernel_launch: unexpected shapes (n_in %d out %d ws %zu)\n", n_in, out_size, ws_size); grid = -1; return; }
        int dev = 0, cus = 0, per_cu = 0;
        (void)hipGetDevice(&dev); (void)hipDeviceGetAttribute(&cus, hipDeviceAttributeMultiprocessorCount, dev);
        (void)hipFuncSetAttribute((const void*)fwd_megakernel, hipFuncAttributeMaxDynamicSharedMemorySize, LDS_BYTES);
        (void)hipOccupancyMaxActiveBlocksPerMultiprocessor(&per_cu, (const void*)fwd_megakernel, 512, LDS_BYTES);
        if (per_cu < 1) { fprintf(stderr, "kernel_launch: occupancy query says %d blocks/CU\n", per_cu); per_cu = 1; }
        grid = cus * per_cu;
    }
    if (grid < 0) return;
    Args a{};
    for (int i = 0; i < 14; ++i) a.in[i] = (const float*)d_in[i];
    a.out = (float*)d_out; a.ws = (unsigned char*)d_ws;
    (void)hipMemsetAsync((unsigned char*)d_ws + WS_CTL + CTL_BAR, 0, CTL_BAR_BYTES, stream);
    void* args[] = {&a};
    hipError_t e = hipLaunchCooperativeKernel((void*)fwd_megakernel, dim3(grid), dim3(512), args, LDS_BYTES, stream);
    if (e != hipSuccess) fprintf(stderr, "cooperative launch failed: %s (grid %d)\n", hipGetErrorString(e), grid);
}
```

```cpp
#include <hip/hip_runtime.h>
#include <hip/hip_cooperative_groups.h>
#include <cstdio>
#include <cstdint>
namespace cg = cooperative_groups;
__device__ __forceinline__ int opaque_tid() { int t = (int)threadIdx.x; asm volatile("" : "+v"(t)); return t; }
#ifndef PROBE_DUP
#define PROBE_DUP 0
#endif
namespace pg8 {
#define PG8_LAS __attribute__((address_space(3)))
typedef unsigned short bf16_t;
typedef short bf16x8 __attribute__((ext_vector_type(8)));
typedef float f32x4 __attribute__((ext_vector_type(4)));
typedef unsigned u32x4 __attribute__((ext_vector_type(4)));
constexpr int BM = 256, BK = 64, HALF = 128, HTB = HALF * BK * 2  , STAGE_BYTES = 8 * HTB, NXCD = 8, WGM = 8;

__host__ __device__ __forceinline__ int lds_byte(int r, int c) { const int st = (r >> 4) * 2 + (c >> 5), rr = r & 15, cc = c & 31, ob = rr * 64 + cc * 2; return st * 1024 + (ob ^ (((ob >> 9) & 1) << 5)); }
__host__ __device__ __forceinline__ void stage_rc(int b, int& R, int& C) { const int st = b / 1024, sb = b % 1024, swz = sb ^ (((sb >> 9) & 1) << 5); R = (st >> 1) * 16 + swz / 64; C = (st & 1) * 32 + (swz % 64) / 2; }
__host__ __device__ __forceinline__ int perm32(int rho) { const int n = rho >> 4, i = rho & 15; return 8 * (i >> 2) + 4 * n + (i & 3); }

struct Unit { int pm, pn; };
struct Gemm { const bf16_t* A; const bf16_t* Bt; int M, N, K; };

struct StaticOrder {
    int nM, nN, nwg, G, c;
    __host__ __device__ void init(int M, int N, int G_, int c_) { nM = M / BM; nN = N / BM; nwg = nM * nN; G = G_; c = c_; }
    __host__ __device__ bool next(int i, Unit& u) const {
        const long L = (long)i * G + c; if (L >= nwg) return false;
        int wgid = (int)L; { const int q = nwg / NXCD, r = nwg % NXCD, xcd = wgid % NXCD, off = wgid / NXCD; wgid = (xcd < r ? xcd * (q + 1) : r * (q + 1) + (xcd - r) * q) + off; }
        const int nig = WGM * nN, gid = wgid / nig, fm = gid * WGM, gsz = (nM - fm) < WGM ? (nM - fm) : WGM;
        u.pm = fm + ((wgid % nig) % gsz); u.pn = (wgid % nig) / gsz; return true;
    }
    __device__ __forceinline__ void a_ready(const Unit&) const {}
    __device__ __forceinline__ void done(const Unit&) const {}
};

__device__ __forceinline__ unsigned cvt_pk_bf16(float lo, float hi) { unsigned r; asm volatile("v_cvt_pk_bf16_f32 %0, %1, %2" : "=v"(r) : "v"(lo), "v"(hi)); return r; }
typedef float f32x2 __attribute__((ext_vector_type(2)));
template <class Epi, class Sched, bool ALIGN_EPI = false, bool SP2 = false>
__device__ __forceinline__ void gemm_phase(PG8_LAS unsigned char* lds, const Gemm g, const Sched& S, const Epi& E) {
    const int tid = opaque_tid(), wid = __builtin_amdgcn_readfirstlane(tid >> 6), lane = tid & 63, wr = wid >> 2, wc = wid & 3, fr = lane & 15, fq = lane >> 4;
    const int K = g.K, nt = K / BK;
    unsigned voffA[2], voffB[2];
#pragma unroll
    for (int i = 0; i < 2; ++i) { int R, C; stage_rc(tid * 16 + i * 8192, R, C); const int Rb = Epi::PERM ? ((R & ~31) + perm32(R & 31)) : R;
        voffA[i] = (unsigned)(R * K + C) * 2u; voffB[i] = (unsigned)(Rb * K + C) * 2u; }
    const size_t kstep = (size_t)(BK * 2);
    const size_t hstep = (size_t)HALF * K * 2;
    const size_t tstep = 2 * hstep;
    const unsigned ldsw = (unsigned)wid * 1024u;
    const int aoff = lds_byte(wr * 64 + fr, fq * 8), boff = lds_byte(wc * 32 + fr, fq * 8);
#define PG8_SA(b, h) (((b) * 2 + (h)) * HTB)
#define PG8_SB(b, h) ((4 + (b) * 2 + (h)) * HTB)
#define PG8_STAGE(bufoff, gbase, voff) do { _Pragma("unroll") for (int _i = 0; _i < 2; ++_i) \
        __builtin_amdgcn_global_load_lds((const unsigned*)((const char*)(gbase) + (voff)[_i]), (PG8_LAS unsigned*)(lds + (bufoff) + ldsw + _i * 8192), 16, 0, 0); } while (0)
#define PG8_LDA(dst, b, h) do { _Pragma("unroll") for (int m = 0; m < 4; ++m) _Pragma("unroll") for (int k = 0; k < 2; ++k) dst[m][k] = *(const PG8_LAS bf16x8*)(lds + PG8_SA(b, h) + aoff + m * 2048 + k * 1024); } while (0)
#define PG8_LDB(dst, b, h) do { _Pragma("unroll") for (int n = 0; n < 2; ++n) _Pragma("unroll") for (int k = 0; k < 2; ++k) dst[n][k] = *(const PG8_LAS bf16x8*)(lds + PG8_SB(b, h) + boff + n * 2048 + k * 1024); } while (0)
#define PG8_MMA(ai, bj, At, Bt) do { __builtin_amdgcn_s_setprio(1); _Pragma("unroll") for (int m = 0; m < 4; ++m) _Pragma("unroll") for (int n = 0; n < 2; ++n) _Pragma("unroll") for (int k = 0; k < 2; ++k) \
        acc[ai][bj][m][n] = __builtin_amdgcn_mfma_f32_16x16x32_bf16(Bt[n][k], At[m][k], acc[ai][bj][m][n], 0, 0, 0); __builtin_amdgcn_s_setprio(0); } while (0)
#define PG8_WAIT_V(n) asm volatile("s_waitcnt vmcnt(" #n ")" ::: "memory")
#define PG8_WAIT_L(n) asm volatile("s_waitcnt lgkmcnt(" #n ")" ::: "memory")
#define PG8_BAR __builtin_amdgcn_s_barrier()
#define PG8_SCHED __builtin_amdgcn_sched_barrier(0)
    Unit cur, nxt; int ui = 0;
    if (!S.next(0, cur)) return;
    f32x4 acc[2][2][4][2];
#pragma unroll
    for (int a = 0; a < 2; ++a)
#pragma unroll
        for (int b = 0; b < 2; ++b)
#pragma unroll
            for (int m = 0; m < 4; ++m)
#pragma unroll
                for (int n = 0; n < 2; ++n) acc[a][b][m][n] = (f32x4){0.f, 0.f, 0.f, 0.f};
    bf16x8 At[4][2], B0[2][2], B1[2][2];
    const char* cA = (const char*)g.A + (size_t)cur.pm * tstep; const char* cB = (const char*)g.Bt + (size_t)cur.pn * tstep;
    S.a_ready(cur);
    if constexpr (SP2) {
        PG8_STAGE(PG8_SB(0, 0), cB, voffB); PG8_STAGE(PG8_SB(0, 1), cB + hstep, voffB); PG8_STAGE(PG8_SA(0, 0), cA, voffA); PG8_STAGE(PG8_SA(0, 1), cA + hstep, voffA);
        if (wr == 1) PG8_BAR;
        PG8_WAIT_V(2); PG8_BAR;
        PG8_STAGE(PG8_SB(1, 0), cB + kstep, voffB); PG8_STAGE(PG8_SA(1, 0), cA + kstep, voffA); PG8_STAGE(PG8_SB(1, 1), cB + hstep + kstep, voffB);
        PG8_WAIT_V(6); PG8_BAR;
    } else {
        PG8_STAGE(PG8_SB(0, 0), cB, voffB); PG8_STAGE(PG8_SA(0, 0), cA, voffA); PG8_STAGE(PG8_SB(0, 1), cB + hstep, voffB); PG8_STAGE(PG8_SA(0, 1), cA + hstep, voffA);
        if (wr == 1) PG8_BAR;
        PG8_WAIT_V(4); PG8_BAR;
        PG8_STAGE(PG8_SB(1, 0), cB + kstep, voffB); PG8_STAGE(PG8_SA(1, 0), cA + kstep, voffA); PG8_STAGE(PG8_SB(1, 1), cB + hstep + kstep, voffB);
        PG8_WAIT_V(6); PG8_BAR;
    }
    for (;;) {
        const bool has_next = S.next(ui + 1, nxt);
        const char* nA = has_next ? (const char*)g.A + (size_t)nxt.pm * tstep : cA; const char* nB = has_next ? (const char*)g.Bt + (size_t)nxt.pn * tstep : cB;
        for (int t = 0; t < nt; t += 2) {
            const bool last = (t == nt - 2);
            const char* a1 = cA + (size_t)(t + 1) * kstep;
            const char* a2 = last ? nA : cA + (size_t)(t + 2) * kstep; const char* b2 = last ? nB : cB + (size_t)(t + 2) * kstep;
            const char* a3 = a2 + kstep; const char* b3 = b2 + kstep;
            if (last && has_next) S.a_ready(nxt);
            if constexpr (SP2) {
            PG8_LDB(B0, 0, 0); PG8_LDB(B1, 0, 1); PG8_SCHED; PG8_LDA(At, 0, 0); PG8_STAGE(PG8_SA(1, 1), a1 + hstep, voffA);
            PG8_WAIT_V(8); PG8_WAIT_L(0); PG8_BAR; PG8_MMA(0, 0, At, B0); PG8_MMA(0, 1, At, B1); PG8_BAR; PG8_SCHED;
            PG8_LDA(At, 0, 1); PG8_STAGE(PG8_SB(0, 0), b2, voffB); PG8_STAGE(PG8_SB(0, 1), b2 + hstep, voffB); PG8_STAGE(PG8_SA(0, 0), a2, voffA);
            PG8_WAIT_V(8); PG8_WAIT_L(0); PG8_BAR; PG8_MMA(1, 0, At, B0); PG8_MMA(1, 1, At, B1); PG8_BAR; PG8_SCHED;
            PG8_LDB(B0, 1, 0); PG8_LDB(B1, 1, 1); PG8_SCHED; PG8_LDA(At, 1, 0); PG8_STAGE(PG8_SA(0, 1), a2 + hstep, voffA);
            PG8_WAIT_V(8); PG8_WAIT_L(0); PG8_BAR; PG8_MMA(0, 0, At, B0); PG8_MMA(0, 1, At, B1); PG8_BAR; PG8_SCHED;
            PG8_LDA(At, 1, 1); PG8_STAGE(PG8_SB(1, 0), b3, voffB); PG8_STAGE(PG8_SB(1, 1), b3 + hstep, voffB); PG8_STAGE(PG8_SA(1, 0), a3, voffA);
            PG8_WAIT_V(8); PG8_WAIT_L(0); PG8_BAR; PG8_MMA(1, 0, At, B0); PG8_MMA(1, 1, At, B1); PG8_BAR; PG8_SCHED;
            } else {
            PG8_LDB(B0, 0, 0); PG8_SCHED; PG8_LDA(At, 0, 0); PG8_STAGE(PG8_SA(1, 1), a1 + hstep, voffA);
            PG8_WAIT_L(8); PG8_BAR; PG8_WAIT_L(0); PG8_MMA(0, 0, At, B0); PG8_BAR; PG8_SCHED;
            PG8_LDB(B1, 0, 1); PG8_STAGE(PG8_SB(0, 0), b2, voffB);
            PG8_BAR; PG8_WAIT_L(0); PG8_MMA(0, 1, At, B1); PG8_BAR;
            PG8_LDA(At, 0, 1); PG8_STAGE(PG8_SA(0, 0), a2, voffA);
            PG8_BAR; PG8_WAIT_L(0); PG8_MMA(1, 0, At, B0); PG8_BAR; PG8_SCHED;
            PG8_STAGE(PG8_SB(0, 1), b2 + hstep, voffB);
            PG8_WAIT_V(6); PG8_BAR; PG8_MMA(1, 1, At, B1); PG8_BAR;
            PG8_LDB(B0, 1, 0); PG8_SCHED; PG8_LDA(At, 1, 0); PG8_STAGE(PG8_SA(0, 1), a2 + hstep, voffA);
            PG8_WAIT_L(8); PG8_BAR; PG8_WAIT_L(0); PG8_MMA(0, 0, At, B0); PG8_BAR; PG8_SCHED;
            PG8_LDB(B1, 1, 1); PG8_STAGE(PG8_SB(1, 0), b3, voffB);
            PG8_BAR; PG8_WAIT_L(0); PG8_MMA(0, 1, At, B1); PG8_BAR;
            PG8_LDA(At, 1, 1); PG8_STAGE(PG8_SA(1, 0), a3, voffA);
            PG8_BAR; PG8_WAIT_L(0); PG8_MMA(1, 0, At, B0); PG8_BAR; PG8_SCHED;
            PG8_STAGE(PG8_SB(1, 1), b3 + hstep, voffB);
            PG8_WAIT_V(6); PG8_BAR; PG8_MMA(1, 1, At, B1); PG8_BAR;
            }
        }
        if constexpr (ALIGN_EPI) { if (wr == 0) PG8_BAR; }
        if constexpr (!Epi::AFTER_DRAIN) { E(acc, cur, wr, wc, fr, fq); S.done(cur); }
        if (!has_next) break;
#pragma unroll
        for (int a = 0; a < 2; ++a)
#pragma unroll
            for (int b = 0; b < 2; ++b)
#pragma unroll
                for (int m = 0; m < 4; ++m)
#pragma unroll
                    for (int n = 0; n < 2; ++n) acc[a][b][m][n] = (f32x4){0.f, 0.f, 0.f, 0.f};
        cur = nxt; cA = nA; cB = nB; ++ui;
        if constexpr (ALIGN_EPI) { if (wr == 1) PG8_BAR; }
    }
    PG8_WAIT_V(0);
    if constexpr (!ALIGN_EPI) { if (wr == 0) PG8_BAR; }
    PG8_BAR;
    if constexpr (Epi::AFTER_DRAIN) { E.fused(acc, cur, wr, wc, fr, fq, lds, wid, lane); S.done(cur); }
#undef PG8_SA
#undef PG8_SB
#undef PG8_STAGE
#undef PG8_LDA
#undef PG8_LDB
#undef PG8_MMA
#undef PG8_WAIT_V
#undef PG8_WAIT_L
#undef PG8_BAR
#undef PG8_SCHED
}
}
#define LAS __attribute__((address_space(3)))
typedef unsigned short bf16_t;
typedef short bf16x8 __attribute__((ext_vector_type(8)));
typedef float f32x4 __attribute__((ext_vector_type(4)));
typedef float f32x2 __attribute__((ext_vector_type(2)));
typedef float f32x16 __attribute__((ext_vector_type(16)));
typedef unsigned u32x4 __attribute__((ext_vector_type(4)));
typedef unsigned u32x2 __attribute__((ext_vector_type(2)));

constexpr int NTOK = 16384, DM = 2048, SEQ = 2048, NBATCH = 8, PLE = 256;
constexpr int NPROJ = 6144;
constexpr int PQ_SB = 0, PK_SB = 1024, PG_SB = 2048, PQ_DF = 3072, PK_DF = 4096, PG_DF = 5120;
constexpr float LOG2E = 1.4426950408889634f;
constexpr float SBQ_SCALE = 0.08838834764831845f * LOG2E;
constexpr float DFQ_SCALE = 0.125f * LOG2E;
constexpr float NORM_EPS = 1e-6f, SUBLN_EPS = 1e-5f;
constexpr float LAMBDA_INIT = 0.2f;

constexpr size_t MiB = 1u << 20;
constexpr size_t WS_CTL = 0;
constexpr size_t CTL_SS2 = 0, CTL_SS3 = 65536, CTL_LAM = 131072, CTL_ROPE = 262144, CTL_BAR = 524288, CTL_BAR_BYTES = 16384;
constexpr size_t WS_WIN = 2 * MiB, WS_WOUT = 34 * MiB, WS_WGATE = 42 * MiB, WS_WPROJ = 50 * MiB, WS_PB = 52 * MiB;
constexpr size_t WS_XN = 64 * MiB, WS_MIXED = 64 * MiB;
constexpr size_t WS_PROJ = 128 * MiB, WS_VT = 320 * MiB, WS_KIMG = 384 * MiB, WS_END = 448 * MiB;
constexpr size_t WS_HB = 128 * MiB, WS_PLE = 192 * MiB;
constexpr size_t WS_H2B = 64 * MiB;

constexpr int LDS_BYTES = 131072 + 1024;

typedef __bf16 bf16x2_t __attribute__((ext_vector_type(2)));
__device__ __forceinline__ unsigned cvt_pk(float lo, float hi) { f32x2 v = {lo, hi}; bf16x2_t b = __builtin_convertvector(v, bf16x2_t); return __builtin_bit_cast(unsigned, b); }
__device__ __forceinline__ float bf_lo(unsigned w) { return __uint_as_float(w << 16); }
__device__ __forceinline__ float bf_hi(unsigned w) { return __uint_as_float(w & 0xffff0000u); }
__device__ __forceinline__ float wave_sum(float v) {
#pragma unroll
    for (int o = 1; o < 64; o <<= 1) v += __shfl_xor(v, o);
    return v;
}
__device__ __forceinline__ float fast_exp2(float x) { return __builtin_amdgcn_exp2f(x); }
__device__ __forceinline__ float fast_log2(float x) { return __builtin_amdgcn_logf(x); }
__device__ __forceinline__ float silu_f(float x) { return x * __builtin_amdgcn_rcpf(1.f + fast_exp2(-x * LOG2E)); }
__device__ __forceinline__ float sigmoid_f(float x) { return __builtin_amdgcn_rcpf(1.f + fast_exp2(-x * LOG2E)); }

namespace pg8 {
struct EpiBf16 {
    static constexpr bool PERM = true, AFTER_DRAIN = false;
    bf16_t* O; int ldc;
    __device__ __forceinline__ void operator()(const f32x4 (&acc)[2][2][4][2], const Unit& u, int wr, int wc, int fr, int fq) const {
        const int row0 = u.pm * BM + wr * 64 + fr; const int col0 = u.pn * BM + wc * 32 + 8 * fq;
#pragma unroll
        for (int ai = 0; ai < 2; ++ai)
#pragma unroll
            for (int m = 0; m < 4; ++m) { bf16_t* rowp = O + (size_t)(row0 + ai * HALF + m * 16) * ldc + col0;
#pragma unroll
                for (int bj = 0; bj < 2; ++bj) { const f32x4 v0 = acc[ai][bj][m][0], v1 = acc[ai][bj][m][1];
                    u32x4 w; w.x = cvt_pk_bf16(v0[0], v0[1]); w.y = cvt_pk_bf16(v0[2], v0[3]); w.z = cvt_pk_bf16(v1[0], v1[1]); w.w = cvt_pk_bf16(v1[2], v1[3]);
                    *(u32x4*)(rowp + bj * HALF) = w; } }
    }
};
struct EpiProj {
    static constexpr bool PERM = true, AFTER_DRAIN = false;
    bf16_t* O; const float* rope; bf16_t* KI;
    __device__ __forceinline__ void operator()(const f32x4 (&acc)[2][2][4][2], const Unit& u, int wr, int wc, int fr, int fq) const {
        const int row0 = u.pm * BM + wr * 64 + fr; const int col0 = u.pn * BM + wc * 32 + 8 * fq;
        const int kind = u.pn >> 2;
        const bool dorope = (kind == 3 || kind == 4) && ((wc & 1) == 0) && (fq < 2);
        const float sc = kind == 0 ? SBQ_SCALE : (kind == 3 ? DFQ_SCALE : 1.f);
        const bool dosilu = (kind == 2 || kind == 5);
#pragma unroll
        for (int ai = 0; ai < 2; ++ai)
#pragma unroll
            for (int m = 0; m < 4; ++m) { const int row = row0 + ai * HALF + m * 16; bf16_t* rowp = O + (size_t)row * NPROJ + col0;
                if (kind == 1 || kind == 4) {
                    const int cw = col0 & 1023; rowp = KI + ((size_t)(((kind == 4 ? 8 : 0) + (row >> 11)) * 8 + (cw >> 7)) * SEQ + (row & (SEQ - 1))) * 128 + (cw & 127); }
                f32x4 cs0 = {1.f, 0.f, 1.f, 0.f}, cs1 = {1.f, 0.f, 1.f, 0.f};
                if (dorope) { const f32x4* rp = (const f32x4*)(rope + ((size_t)(row & (SEQ - 1)) * 8 + 4 * fq) * 2); cs0 = rp[0]; cs1 = rp[1]; }
#pragma unroll
                for (int bj = 0; bj < 2; ++bj) { f32x4 v0 = acc[ai][bj][m][0], v1 = acc[ai][bj][m][1];
                    if (dorope) {
                        f32x4 a, b;
                        a[0] = v0[0] * cs0[0] - v0[1] * cs0[1]; a[1] = v0[1] * cs0[0] + v0[0] * cs0[1];
                        a[2] = v0[2] * cs0[2] - v0[3] * cs0[3]; a[3] = v0[3] * cs0[2] + v0[2] * cs0[3];
                        b[0] = v1[0] * cs1[0] - v1[1] * cs1[1]; b[1] = v1[1] * cs1[0] + v1[0] * cs1[1];
                        b[2] = v1[2] * cs1[2] - v1[3] * cs1[3]; b[3] = v1[3] * cs1[2] + v1[2] * cs1[3];
                        v0 = a; v1 = b; }
                    if (dosilu) {
#pragma unroll
                        for (int j = 0; j < 4; ++j) { v0[j] = silu_f(v0[j]); v1[j] = silu_f(v1[j]); } }
                    v0 = v0 * sc; v1 = v1 * sc;
                    u32x4 w; w.x = cvt_pk_bf16(v0[0], v0[1]); w.y = cvt_pk_bf16(v0[2], v0[3]); w.z = cvt_pk_bf16(v1[0], v1[1]); w.w = cvt_pk_bf16(v1[2], v1[3]);
                    *(u32x4*)(rowp + ((kind == 1 || kind == 4) ? bj * SEQ * 128 : bj * HALF)) = w; } }
    }
};
struct EpiVt {
    static constexpr bool PERM = true, AFTER_DRAIN = false;
    bf16_t* O;
    __device__ __forceinline__ void operator()(const f32x4 (&acc)[2][2][4][2], const Unit& u, int wr, int wc, int fr, int fq) const {
        const int row0 = u.pm * BM + wr * 64 + fr; const int col0 = u.pn * BM + wc * 32 + 8 * fq;
        const int p0 = (fq & 1) ? 4 : 0, p1 = (fq & 1) ? 12 : 8;
#pragma unroll
        for (int ai = 0; ai < 2; ++ai)
#pragma unroll
            for (int m = 0; m < 4; ++m) { const int row = row0 + ai * HALF + m * 16; const int gh = row >> 7, d = row & 127;
#pragma unroll
                for (int bj = 0; bj < 2; ++bj) { const int col = col0 + bj * HALF; const int b = col >> 11, sq = col & (SEQ - 1);
                    bf16_t* tp = O + ((size_t)((((gh >> 3) * 8 + b) * 8 + (gh & 7)) * 32 + (sq >> 6)) * 128 + d) * 64 + (sq & 48);
                    const f32x4 v0 = acc[ai][bj][m][0], v1 = acc[ai][bj][m][1];
                    u32x2 w0, w1; w0.x = cvt_pk_bf16(v0[0], v0[1]); w0.y = cvt_pk_bf16(v0[2], v0[3]); w1.x = cvt_pk_bf16(v1[0], v1[1]); w1.y = cvt_pk_bf16(v1[2], v1[3]);
                    *(u32x2*)(tp + p0) = w0; *(u32x2*)(tp + p1) = w1; } }
    }
};
struct EpiRes {
    static constexpr bool PERM = true, AFTER_DRAIN = false;
    const float* x; bf16_t* hb; float* ss;
    __device__ __forceinline__ void operator()(const f32x4 (&acc)[2][2][4][2], const Unit& u, int wr, int wc, int fr, int fq) const {
        const int row0 = u.pm * BM + wr * 64 + fr; const int col0 = u.pn * BM + wc * 32 + 8 * fq;
#pragma unroll
        for (int ai = 0; ai < 2; ++ai)
#pragma unroll
            for (int m = 0; m < 4; ++m) { const int row = row0 + ai * HALF + m * 16; const size_t off = (size_t)row * DM + col0; float q = 0.f;
#pragma unroll
                for (int bj = 0; bj < 2; ++bj) { const size_t o2 = off + bj * HALF;
                    const f32x4 h0 = *(const f32x4*)(x + o2) + acc[ai][bj][m][0], h1 = *(const f32x4*)(x + o2 + 4) + acc[ai][bj][m][1];
                    u32x4 w; w.x = cvt_pk_bf16(h0[0], h0[1]); w.y = cvt_pk_bf16(h0[2], h0[3]); w.z = cvt_pk_bf16(h1[0], h1[1]); w.w = cvt_pk_bf16(h1[2], h1[3]);
                    *(u32x4*)(hb + o2) = w;
                    q += ((h0[0] * h0[0] + h0[1] * h0[1]) + (h0[2] * h0[2] + h0[3] * h0[3])) + ((h1[0] * h1[0] + h1[1] * h1[1]) + (h1[2] * h1[2] + h1[3] * h1[3])); }
                q += __shfl_xor(q, 16); q += __shfl_xor(q, 32);
                if (fq == 0) atomicAdd(ss + row, q); }
    }
};
struct EpiGate {
    static constexpr bool PERM = true, AFTER_DRAIN = false;
    const bf16_t* hb; bf16_t* h2b; const bf16_t* ple; const float* ss2; float* ss3;
    __device__ __forceinline__ void operator()(const f32x4 (&acc)[2][2][4][2], const Unit& u, int wr, int wc, int fr, int fq) const {
        const int row0 = u.pm * BM + wr * 64 + fr; const int col0 = u.pn * BM + wc * 32 + 8 * fq;
#pragma unroll
        for (int ai = 0; ai < 2; ++ai)
#pragma unroll
            for (int m = 0; m < 4; ++m) { const int row = row0 + ai * HALF + m * 16; const size_t off = (size_t)row * DM + col0; float q = 0.f;
                const float rstd = rsqrtf(ss2[row] * (1.f / DM) + NORM_EPS);
#pragma unroll
                for (int bj = 0; bj < 2; ++bj) { const size_t o2 = off + bj * HALF; const u32x4 hw = *(const u32x4*)(hb + o2); const u32x4 pw = *(const u32x4*)(ple + o2);
                    const f32x4 a0 = acc[ai][bj][m][0] * rstd, a1 = acc[ai][bj][m][1] * rstd; f32x4 g0, g1;
                    g0[0] = bf_lo(hw.x) + sigmoid_f(a0[0]) * bf_lo(pw.x); g0[1] = bf_hi(hw.x) + sigmoid_f(a0[1]) * bf_hi(pw.x);
                    g0[2] = bf_lo(hw.y) + sigmoid_f(a0[2]) * bf_lo(pw.y); g0[3] = bf_hi(hw.y) + sigmoid_f(a0[3]) * bf_hi(pw.y);
                    g1[0] = bf_lo(hw.z) + sigmoid_f(a1[0]) * bf_lo(pw.z); g1[1] = bf_hi(hw.z) + sigmoid_f(a1[1]) * bf_hi(pw.z);
                    g1[2] = bf_lo(hw.w) + sigmoid_f(a1[2]) * bf_lo(pw.w); g1[3] = bf_hi(hw.w) + sigmoid_f(a1[3]) * bf_hi(pw.w);
                    u32x4 w2; w2.x = cvt_pk_bf16(g0[0], g0[1]); w2.y = cvt_pk_bf16(g0[2], g0[3]); w2.z = cvt_pk_bf16(g1[0], g1[1]); w2.w = cvt_pk_bf16(g1[2], g1[3]);
                    *(u32x4*)(h2b + o2) = w2;
                    q += ((g0[0] * g0[0] + g0[1] * g0[1]) + (g0[2] * g0[2] + g0[3] * g0[3])) + ((g1[0] * g1[0] + g1[1] * g1[1]) + (g1[2] * g1[2] + g1[3] * g1[3])); }
                q += __shfl_xor(q, 16); q += __shfl_xor(q, 32);
                if (fq == 0) atomicAdd(ss3 + row, q); }
    }
};
}
namespace att {
constexpr int KP = 272, VP = 144, KT_BYTES = 64 * KP, VT_BYTES = 128 * VP, BUF_BYTES = KT_BYTES + VT_BYTES;
constexpr int FLAG_OFF = 2 * BUF_BYTES;
constexpr int XP = 132;
constexpr float R_DONE = 152.0f;

template <bool MASK>
__device__ __forceinline__ void sb_block(const f32x16& sv, int kbase, int tq, int h, float& R, bf16x8 (&pf)[2]) {
    float c[16];
#pragma unroll
    for (int i = 0; i < 16; ++i) {
        const float z = sv[i];
        const float spv = fmaxf(z, 0.f) + fast_log2(1.f + fast_exp2(-fabsf(z)));
        c[i] = (!MASK || (kbase + 8 * (i >> 2) + (i & 3) < tq)) ? spv : 0.f;
    }
    float T[4], OT[4], pr[4], suf[4];
#pragma unroll
    for (int g = 0; g < 4; ++g) { c[4 * g + 2] += c[4 * g + 3]; c[4 * g + 1] += c[4 * g + 2]; c[4 * g] += c[4 * g + 1]; T[g] = c[4 * g]; }
#pragma unroll
    for (int g = 0; g < 4; ++g) { OT[g] = __shfl_xor(T[g], 32); pr[g] = T[g] + OT[g]; }
    suf[3] = 0.f; suf[2] = pr[3]; suf[1] = suf[2] + pr[2]; suf[0] = suf[1] + pr[1];
    float w[16];
#pragma unroll
    for (int g = 0; g < 4; ++g) { const float off = R + suf[g] + (h == 0 ? OT[g] : 0.f);
#pragma unroll
        for (int j = 0; j < 4; ++j) { const int i = 4 * g + j; const float e = fast_exp2(sv[i] - (off + c[i])); w[i] = (!MASK || (kbase + 8 * (i >> 2) + (i & 3) < tq)) ? e : 0.f; } }
    R += suf[0] + pr[0];
#pragma unroll
    for (int sp = 0; sp < 2; ++sp) { u32x4 p; p.x = cvt_pk(w[8 * sp], w[8 * sp + 1]); p.y = cvt_pk(w[8 * sp + 2], w[8 * sp + 3]); p.z = cvt_pk(w[8 * sp + 4], w[8 * sp + 5]); p.w = cvt_pk(w[8 * sp + 6], w[8 * sp + 7]);
        pf[sp] = __builtin_bit_cast(bf16x8, p); }
}

template <int MODE>
__device__ __forceinline__ void attn_unit(LAS unsigned char* lds, const bf16_t* __restrict__ PROJ, const bf16_t* __restrict__ KIMG, const bf16_t* __restrict__ VT, bf16_t* __restrict__ MIXED,
                                          int b, int hh, int qblk, float lam, const float* __restrict__ subln_g) {
    constexpr int QB = MODE == 0 ? 256 : 128;
    constexpr int NKS = MODE == 0 ? 8 : 4;
    const int tid = opaque_tid(), lane = tid & 63, r = lane & 31, h = lane >> 5;
    const int wid = __builtin_amdgcn_readfirstlane(tid >> 6);
    const int qg = MODE == 0 ? wid : (wid & 3), role = MODE == 0 ? 0 : (wid >> 2);
    const int Q0 = qblk * QB, q0w = Q0 + 32 * qg, tq = q0w + r;
    const size_t tokbase = (size_t)b * SEQ;
    const int gbh = ((MODE == 0 ? 0 : 8) + b) * 8 + hh;
    const bf16_t* Kg = KIMG + (size_t)gbh * SEQ * 128;
    const bf16_t* Vg = VT + (size_t)gbh * 32 * 8192;
    bf16x8 qf[NKS];
    { const bf16_t* qp = PROJ + (tokbase + tq) * NPROJ + (MODE == 0 ? PQ_SB + hh * 128 : PQ_DF + hh * 128 + role * 64) + 8 * h;
#pragma unroll
      for (int ks = 0; ks < NKS; ++ks) qf[ks] = *(const bf16x8*)(qp + 16 * ks); }
    f32x16 o[4];
#pragma unroll
    for (int d = 0; d < 4; ++d)
#pragma unroll
        for (int i = 0; i < 16; ++i) o[d][i] = 0.f;
    float R = 0.f, m_run = -1e30f, l_run = 0.f;
    const int kr0 = tid >> 4, kc = tid & 15, vr0 = tid >> 3, vc = tid & 7;
    const int kst = kr0 * KP + kc * 16, vst = KT_BYTES + vr0 * VP + vc * 16;
    const bf16_t* kgl = Kg + tid * 8;
    const bf16_t* vgl = Vg + tid * 8;
    u32x4 kreg[2], vreg[2];
#define ATT_LOAD(t) do { _Pragma("unroll") for (int i_ = 0; i_ < 2; ++i_) { \
        kreg[i_] = *(const u32x4*)(kgl + (size_t)(t) * 8192 + i_ * 4096); \
        vreg[i_] = *(const u32x4*)(vgl + (size_t)(t) * 8192 + i_ * 4096); } } while (0)
#define ATT_STORE(bo) do { _Pragma("unroll") for (int i_ = 0; i_ < 2; ++i_) { \
        *(LAS u32x4*)(lds + (bo) + kst + i_ * 32 * KP) = kreg[i_]; \
        *(LAS u32x4*)(lds + (bo) + vst + i_ * 64 * VP) = vreg[i_]; } } while (0)
    const int tl = (Q0 + QB - 1) >> 6;
    const int kfrag = r * KP + (role * 64 + 8 * h) * 2;
    const int vfrag = KT_BYTES + r * VP + (8 * h) * 2;
    volatile LAS int* flags = (volatile LAS int*)(lds + FLAG_OFF);
    __syncthreads();
    ATT_LOAD(tl); ATT_STORE(0);
    __syncthreads();
    int cur = 0, it = 0;
    bool wdone = false;
    for (int t = tl;; --t, ++it) {
        if (t > 0) ATT_LOAD(t - 1);
        const int k0 = 64 * t;
        const bool active = (MODE == 0) ? (!wdone && k0 <= q0w + 30) : (k0 <= q0w + 31);
        if (active) {
            const int bo = cur * BUF_BYTES;
            f32x16 s[2];
            bf16x8 vf[4][2][2];
            if (MODE == 1) {
                bf16x8 kf[2][NKS];
#pragma unroll
                for (int kb = 0; kb < 2; ++kb)
#pragma unroll
                    for (int ks = 0; ks < NKS; ++ks) kf[kb][ks] = *(const LAS bf16x8*)(lds + bo + kfrag + kb * 32 * KP + ks * 32);
                __builtin_amdgcn_sched_barrier(0);
#pragma unroll
                for (int kb = 0; kb < 2; ++kb) {
#pragma unroll
                    for (int i = 0; i < 16; ++i) s[kb][i] = 0.f;
#pragma unroll
                    for (int ks = 0; ks < NKS; ++ks) s[kb] = __builtin_amdgcn_mfma_f32_32x32x16_bf16(kf[kb][ks], qf[ks], s[kb], 0, 0, 0);
                }
                __builtin_amdgcn_sched_barrier(0);
#pragma unroll
                for (int d = 0; d < 2; ++d)
#pragma unroll
                    for (int kb = 0; kb < 2; ++kb)
#pragma unroll
                        for (int sp = 0; sp < 2; ++sp) vf[d][kb][sp] = *(const LAS bf16x8*)(lds + bo + vfrag + d * 32 * VP + (32 * kb + 16 * sp) * 2);
                __builtin_amdgcn_sched_barrier(0);
            } else {
#pragma unroll
                for (int kb = 0; kb < 2; ++kb) {
#pragma unroll
                    for (int i = 0; i < 16; ++i) s[kb][i] = 0.f;
#pragma unroll
                    for (int ks = 0; ks < NKS; ++ks) {
                        const bf16x8 a = *(const LAS bf16x8*)(lds + bo + kfrag + kb * 32 * KP + ks * 32);
                        s[kb] = __builtin_amdgcn_mfma_f32_32x32x16_bf16(a, qf[ks], s[kb], 0, 0, 0);
                    }
                }
            }
            bf16x8 pf[2][2];
            if (MODE == 0) {
                { sb_block<true>(s[1], k0 + 32 + 4 * h, tq, h, R, pf[1]); sb_block<true>(s[0], k0 + 4 * h, tq, h, R, pf[0]); }
                wdone = __all(R >= R_DONE);
            } else {
                float mx = -1e30f;
                if (k0 + 63 > q0w) {
#pragma unroll
                    for (int kb = 0; kb < 2; ++kb) { const int kbase = k0 + 32 * kb + 4 * h;
#pragma unroll
                        for (int i = 0; i < 16; ++i) { const int key = kbase + 8 * (i >> 2) + (i & 3); const float v = (key <= tq) ? s[kb][i] : -1e30f; s[kb][i] = v; mx = fmaxf(mx, v); } }
                } else {
#pragma unroll
                    for (int kb = 0; kb < 2; ++kb)
#pragma unroll
                        for (int i = 0; i < 16; ++i) mx = fmaxf(mx, s[kb][i]);
                }
                mx = fmaxf(mx, __shfl_xor(mx, 32));
                const float m_new = fmaxf(m_run, mx), alpha = fast_exp2(m_run - m_new);
                m_run = m_new;
                float ls = 0.f;
#pragma unroll
                for (int kb = 0; kb < 2; ++kb) {
#pragma unroll
                    for (int i = 0; i < 16; ++i) { const float p = fast_exp2(s[kb][i] - m_new); s[kb][i] = p; ls += p; }
#pragma unroll
                    for (int sp = 0; sp < 2; ++sp) { u32x4 p; p.x = cvt_pk(s[kb][8 * sp], s[kb][8 * sp + 1]); p.y = cvt_pk(s[kb][8 * sp + 2], s[kb][8 * sp + 3]); p.z = cvt_pk(s[kb][8 * sp + 4], s[kb][8 * sp + 5]); p.w = cvt_pk(s[kb][8 * sp + 6], s[kb][8 * sp + 7]);
                        pf[kb][sp] = __builtin_bit_cast(bf16x8, p); }
                }
                l_run = l_run * alpha + ls;
                if (!__all(alpha == 1.f)) {
#pragma unroll
                    for (int d = 0; d < 4; ++d)
#pragma unroll
                        for (int i = 0; i < 16; ++i) o[d][i] *= alpha;
                }
            }
            if (MODE == 1) {
                __builtin_amdgcn_sched_barrier(0);
#pragma unroll
                for (int d = 2; d < 4; ++d)
#pragma unroll
                    for (int kb = 0; kb < 2; ++kb)
#pragma unroll
                        for (int sp = 0; sp < 2; ++sp) vf[d][kb][sp] = *(const LAS bf16x8*)(lds + bo + vfrag + d * 32 * VP + (32 * kb + 16 * sp) * 2);
                __builtin_amdgcn_sched_barrier(0);
            }
#pragma unroll
            for (int d = 0; d < 4; ++d)
#pragma unroll
                for (int kb = 0; kb < 2; ++kb)
#pragma unroll
                    for (int sp = 0; sp < 2; ++sp) {
                        const bf16x8 a = (MODE == 1) ? vf[d][kb][sp] : *(const LAS bf16x8*)(lds + bo + vfrag + d * 32 * VP + (32 * kb + 16 * sp) * 2);
                        o[d] = __builtin_amdgcn_mfma_f32_32x32x16_bf16(a, pf[kb][sp], o[d], 0, 0, 0);
                    }
        }
        if (t > 0) ATT_STORE((cur ^ 1) * BUF_BYTES);
        if (MODE == 0) { if (lane == 0) flags[(it & 1) * 8 + wid] = wdone ? 1 : 0; }
        __syncthreads();
        if (t == 0) break;
        if (MODE == 0) { int alld = 1;
#pragma unroll
            for (int w2 = 0; w2 < 8; ++w2) alld &= flags[(it & 1) * 8 + w2];
            if (alld) break; }
        cur ^= 1;
    }
#undef ATT_LOAD
#undef ATT_STORE
    const int erow = lane >> 4, ech = lane & 15;
    const size_t tok0 = tokbase + q0w;
    if (MODE == 0 || role == 0) {
    }
    u32x4 gw[8];
    if (MODE == 0 || role == 0) {
        const bf16_t* gp = PROJ + (tok0 + erow) * NPROJ + (MODE == 0 ? PG_SB : PG_DF) + hh * 128 + ech * 8;
#pragma unroll
        for (int i = 0; i < 8; ++i) gw[i] = *(const u32x4*)(gp + (size_t)(4 * i) * NPROJ);
    }
    LAS unsigned char* stg = lds + (MODE == 0 ? wid * 8704 : 69632 + qg * 8704);
    if (MODE == 0) {
#pragma unroll
        for (int d = 0; d < 4; ++d)
#pragma unroll
            for (int g = 0; g < 4; ++g) { u32x2 w; w.x = cvt_pk(o[d][4 * g], o[d][4 * g + 1]); w.y = cvt_pk(o[d][4 * g + 2], o[d][4 * g + 3]);
                *(LAS u32x2*)(stg + r * 272 + (32 * d + 8 * g + 4 * h) * 2) = w; }
    } else {
        const float lt = l_run + __shfl_xor(l_run, 32);
        const float inv = 1.f / lt;
        LAS float* xq = (LAS float*)lds + (qg * 32 + r) * XP + 4 * h;
        if (role == 1) {
            const float f = inv * lam;
#pragma unroll
            for (int d = 0; d < 4; ++d)
#pragma unroll
                for (int g = 0; g < 4; ++g) *(LAS f32x4*)(xq + 32 * d + 8 * g) = (f32x4){o[d][4 * g] * f, o[d][4 * g + 1] * f, o[d][4 * g + 2] * f, o[d][4 * g + 3] * f};
        }
        __syncthreads();
        if (role == 0) {
            float q = 0.f;
#pragma unroll
            for (int d = 0; d < 4; ++d)
#pragma unroll
                for (int g = 0; g < 4; ++g) { const f32x4 x2 = *(const LAS f32x4*)(xq + 32 * d + 8 * g);
#pragma unroll
                    for (int j = 0; j < 4; ++j) { const float v = o[d][4 * g + j] * inv - x2[j]; o[d][4 * g + j] = v; q += v * v; } }
            q += __shfl_xor(q, 32);
            const float rs = rsqrtf(q * (1.f / 128.f) + SUBLN_EPS) * (1.f - LAMBDA_INIT);
            const float* sg = subln_g + 4 * h;
#pragma unroll
            for (int d = 0; d < 4; ++d)
#pragma unroll
                for (int g = 0; g < 4; ++g) { const f32x4 sv = *(const f32x4*)(sg + 32 * d + 8 * g);
                    u32x2 w; w.x = cvt_pk(o[d][4 * g] * rs * sv[0], o[d][4 * g + 1] * rs * sv[1]); w.y = cvt_pk(o[d][4 * g + 2] * rs * sv[2], o[d][4 * g + 3] * rs * sv[3]);
                    *(LAS u32x2*)(stg + r * 272 + (32 * d + 8 * g + 4 * h) * 2) = w; }
        }
    }
    if (MODE == 0 || role == 0) {
        asm volatile("s_waitcnt lgkmcnt(0)" ::: "memory");
        bf16_t* op = MIXED + (tok0 + erow) * DM + (MODE == 0 ? 0 : 1024) + hh * 128 + ech * 8;
#pragma unroll
        for (int i = 0; i < 8; ++i) { const u32x4 ov = *(const LAS u32x4*)(stg + (4 * i + erow) * 272 + ech * 16); const u32x4 g4 = gw[i];
            u32x4 w; w.x = cvt_pk(bf_lo(ov.x) * bf_lo(g4.x), bf_hi(ov.x) * bf_hi(g4.x)); w.y = cvt_pk(bf_lo(ov.y) * bf_lo(g4.y), bf_hi(ov.y) * bf_hi(g4.y));
            w.z = cvt_pk(bf_lo(ov.z) * bf_lo(g4.z), bf_hi(ov.z) * bf_hi(g4.z)); w.w = cvt_pk(bf_lo(ov.w) * bf_lo(g4.w), bf_hi(ov.w) * bf_hi(g4.w));
            *(u32x4*)(op + (size_t)(4 * i) * DM) = w; }
    }
}

__device__ __forceinline__ void attn_unit_df(LAS unsigned char* lds, const bf16_t* __restrict__ PROJ, const bf16_t* __restrict__ KIMG, const bf16_t* __restrict__ VT, bf16_t* __restrict__ MIXED,
                                             int b, int hh, int qblk, float lam, const float* __restrict__ subln_g) {
    constexpr int VB0 = 2 * KT_BYTES;
    const int tid = opaque_tid(), lane = tid & 63, r = lane & 31, h = lane >> 5;
    const int wid = __builtin_amdgcn_readfirstlane(tid >> 6);
    const int qg = wid & 3, role = wid >> 2;
    const int Q0 = qblk * 128, q0w = Q0 + 32 * qg, tq = q0w + r;
    const size_t tokbase = (size_t)b * SEQ;
    const int gbh = (8 + b) * 8 + hh;
    const bf16_t* Kg = KIMG + (size_t)gbh * SEQ * 128;
    const bf16_t* Vg = VT + (size_t)gbh * 32 * 8192;
    bf16x8 qf[4];
    { const bf16_t* qp = PROJ + (tokbase + tq) * NPROJ + PQ_DF + hh * 128 + role * 64 + 8 * h;
#pragma unroll
      for (int ks = 0; ks < 4; ++ks) qf[ks] = *(const bf16x8*)(qp + 16 * ks); }
    f32x16 o[4];
#pragma unroll
    for (int d = 0; d < 4; ++d)
#pragma unroll
        for (int i = 0; i < 16; ++i) o[d][i] = 0.f;
    float m_run = -1e30f, l_run = 0.f, alpha = 1.f;
    const int kr0 = tid >> 4, kc = tid & 15, vr0 = tid >> 3, vc = tid & 7;
    const int kst = kr0 * KP + kc * 16, vst = vr0 * VP + vc * 16;
    const bf16_t* kgl = Kg + tid * 8;
    const bf16_t* vgl = Vg + tid * 8;
    u32x4 kreg[2], vreg[2];
#define DF_LOAD(t) do { _Pragma("unroll") for (int i_ = 0; i_ < 2; ++i_) { \
        kreg[i_] = *(const u32x4*)(kgl + (size_t)(t) * 8192 + i_ * 4096); \
        vreg[i_] = *(const u32x4*)(vgl + (size_t)(t) * 8192 + i_ * 4096); } } while (0)
#define DF_STORE(ko, vo) do { _Pragma("unroll") for (int i_ = 0; i_ < 2; ++i_) { \
        *(LAS u32x4*)(lds + (ko) + kst + i_ * 32 * KP) = kreg[i_]; \
        *(LAS u32x4*)(lds + (vo) + vst + i_ * 64 * VP) = vreg[i_]; } } while (0)
#define DF_VLOAD(vo) do { _Pragma("unroll") for (int d_ = 0; d_ < 4; ++d_) _Pragma("unroll") for (int kb_ = 0; kb_ < 2; ++kb_) _Pragma("unroll") for (int sp_ = 0; sp_ < 2; ++sp_) \
        vf[d_][kb_][sp_] = *(const LAS bf16x8*)(lds + (vo) + vfrag + d_ * 32 * VP + (32 * kb_ + 16 * sp_) * 2); } while (0)
#define DF_PV() do { _Pragma("unroll") for (int d_ = 0; d_ < 4; ++d_) _Pragma("unroll") for (int kb_ = 0; kb_ < 2; ++kb_) _Pragma("unroll") for (int sp_ = 0; sp_ < 2; ++sp_) \
        o[d_] = __builtin_amdgcn_mfma_f32_32x32x16_bf16(vf[d_][kb_][sp_], pf[kb_][sp_], o[d_], 0, 0, 0); } while (0)
#define DF_RESCALE() do { if (!__all(alpha == 1.f)) { _Pragma("unroll") for (int d_ = 0; d_ < 4; ++d_) _Pragma("unroll") for (int i_ = 0; i_ < 16; ++i_) o[d_][i_] *= alpha; } } while (0)
    const int tl = (Q0 + 127) >> 6, NT = tl + 1;
    const int kfrag = r * KP + (role * 64 + 8 * h) * 2;
    const int vfrag = r * VP + (8 * h) * 2;
    __syncthreads();
    DF_LOAD(tl); DF_STORE(0, VB0);
    __syncthreads();
    bool have_p = false;
    bf16x8 pf[2][2];
    for (int i = 0; i < NT; ++i) {
        const int t = tl - i, k0 = 64 * t;
        if (t > 0) DF_LOAD(t - 1);
        if (k0 <= q0w + 31) {
            const int ko = (i & 1) * KT_BYTES;
            bf16x8 kf[2][4];
#pragma unroll
            for (int kb = 0; kb < 2; ++kb)
#pragma unroll
                for (int ks = 0; ks < 4; ++ks) kf[kb][ks] = *(const LAS bf16x8*)(lds + ko + kfrag + kb * 32 * KP + ks * 32);
            f32x16 s[2];
#pragma unroll
            for (int kb = 0; kb < 2; ++kb) {
#pragma unroll
                for (int j = 0; j < 16; ++j) s[kb][j] = 0.f;
#pragma unroll
                for (int ks = 0; ks < 4; ++ks) s[kb] = __builtin_amdgcn_mfma_f32_32x32x16_bf16(kf[kb][ks], qf[ks], s[kb], 0, 0, 0);
            }
            if (!have_p) {
                float mx = -1e30f;
#pragma unroll
                for (int kb = 0; kb < 2; ++kb) { const int kbase = k0 + 32 * kb + 4 * h;
#pragma unroll
                    for (int j = 0; j < 16; ++j) { const int key = kbase + 8 * (j >> 2) + (j & 3); const float v = (key <= tq) ? s[kb][j] : -1e30f; s[kb][j] = v; mx = fmaxf(mx, v); } }
                mx = fmaxf(mx, __shfl_xor(mx, 32));
                m_run = mx; alpha = 1.f;
                float ls = 0.f;
#pragma unroll
                for (int kb = 0; kb < 2; ++kb) {
#pragma unroll
                    for (int j = 0; j < 16; ++j) { const float p = fast_exp2(s[kb][j] - mx); s[kb][j] = p; ls += p; }
#pragma unroll
                    for (int sp = 0; sp < 2; ++sp) { u32x4 p; p.x = cvt_pk(s[kb][8 * sp], s[kb][8 * sp + 1]); p.y = cvt_pk(s[kb][8 * sp + 2], s[kb][8 * sp + 3]); p.z = cvt_pk(s[kb][8 * sp + 4], s[kb][8 * sp + 5]); p.w = cvt_pk(s[kb][8 * sp + 6], s[kb][8 * sp + 7]);
                        pf[kb][sp] = __builtin_bit_cast(bf16x8, p); }
                }
                l_run = ls;
                have_p = true;
            } else {
                DF_RESCALE();
                const int vo = VB0 + ((i + 2) % 3) * VT_BYTES;
                bf16x8 vf[2][2][2];
                bf16x8 pn[2][2]; u32x4 pw[2][2];
                float mx = -1e30f, ls = 0.f, m_new = 0.f;
#define DF_VL(g) do { _Pragma("unroll") for (int kb_ = 0; kb_ < 2; ++kb_) _Pragma("unroll") for (int sp_ = 0; sp_ < 2; ++sp_) \
        vf[(g) & 1][kb_][sp_] = *(const LAS bf16x8*)(lds + vo + vfrag + (g) * 32 * VP + (32 * kb_ + 16 * sp_) * 2); } while (0)
#define DF_MF(k) o[(k) >> 2] = __builtin_amdgcn_mfma_f32_32x32x16_bf16(vf[((k) >> 2) & 1][((k) >> 1) & 1][(k) & 1], pf[((k) >> 1) & 1][(k) & 1], o[(k) >> 2], 0, 0, 0)
#define DF_S(e) s[(e) >> 4][(e) & 15]
                DF_VL(0); DF_VL(1);
                __builtin_amdgcn_sched_barrier(0);
                DF_MF(0);
                mx = fmaxf(fmaxf(mx, DF_S(0)), DF_S(1));
                mx = fmaxf(fmaxf(mx, DF_S(2)), DF_S(3));
                mx = fmaxf(fmaxf(mx, DF_S(4)), DF_S(5));
                mx = fmaxf(fmaxf(mx, DF_S(6)), DF_S(7));
                __builtin_amdgcn_sched_barrier(0);
                DF_MF(1);
                mx = fmaxf(fmaxf(mx, DF_S(8)), DF_S(9));
                mx = fmaxf(fmaxf(mx, DF_S(10)), DF_S(11));
                mx = fmaxf(fmaxf(mx, DF_S(12)), DF_S(13));
                mx = fmaxf(fmaxf(mx, DF_S(14)), DF_S(15));
                __builtin_amdgcn_sched_barrier(0);
                DF_MF(2);
                mx = fmaxf(fmaxf(mx, DF_S(16)), DF_S(17));
                mx = fmaxf(fmaxf(mx, DF_S(18)), DF_S(19));
                mx = fmaxf(fmaxf(mx, DF_S(20)), DF_S(21));
                mx = fmaxf(fmaxf(mx, DF_S(22)), DF_S(23));
                __builtin_amdgcn_sched_barrier(0);
                DF_MF(3);
                mx = fmaxf(fmaxf(mx, DF_S(24)), DF_S(25));
                mx = fmaxf(fmaxf(mx, DF_S(26)), DF_S(27));
                mx = fmaxf(fmaxf(mx, DF_S(28)), DF_S(29));
                mx = fmaxf(fmaxf(mx, DF_S(30)), DF_S(31));
                { auto rr = __builtin_amdgcn_permlane32_swap(__float_as_uint(mx), __float_as_uint(mx), false, false); mx = fmaxf(__uint_as_float(rr[0]), __uint_as_float(rr[1])); }
                m_new = fmaxf(m_run, mx); alpha = fast_exp2(m_run - m_new); m_run = m_new;
                __builtin_amdgcn_sched_barrier(0);
                DF_VL(2);
                DF_MF(4);
                { const float p = fast_exp2(DF_S(0) - m_new); DF_S(0) = p; ls += p; }
                { const float p = fast_exp2(DF_S(1) - m_new); DF_S(1) = p; ls += p; }
                pw[0][0][0] = cvt_pk(DF_S(0), DF_S(1));
                { const float p = fast_exp2(DF_S(2) - m_new); DF_S(2) = p; ls += p; }
                __builtin_amdgcn_sched_barrier(0);
                DF_MF(5);
                { const float p = fast_exp2(DF_S(3) - m_new); DF_S(3) = p; ls += p; }
                pw[0][0][1] = cvt_pk(DF_S(2), DF_S(3));
                { const float p = fast_exp2(DF_S(4) - m_new); DF_S(4) = p; ls += p; }
                { const float p = fast_exp2(DF_S(5) - m_new); DF_S(5) = p; ls += p; }
                pw[0][0][2] = cvt_pk(DF_S(4), DF_S(5));
                __builtin_amdgcn_sched_barrier(0);
                DF_MF(6);
                { const float p = fast_exp2(DF_S(6) - m_new); DF_S(6) = p; ls += p; }
                { const float p = fast_exp2(DF_S(7) - m_new); DF_S(7) = p; ls += p; }
                pw[0][0][3] = cvt_pk(DF_S(6), DF_S(7));
                { const float p = fast_exp2(DF_S(8) - m_new); DF_S(8) = p; ls += p; }
                __builtin_amdgcn_sched_barrier(0);
                DF_MF(7);
                { const float p = fast_exp2(DF_S(9) - m_new); DF_S(9) = p; ls += p; }
                pw[0][1][0] = cvt_pk(DF_S(8), DF_S(9));
                { const float p = fast_exp2(DF_S(10) - m_new); DF_S(10) = p; ls += p; }
                { const float p = fast_exp2(DF_S(11) - m_new); DF_S(11) = p; ls += p; }
                pw[0][1][1] = cvt_pk(DF_S(10), DF_S(11));
                __builtin_amdgcn_sched_barrier(0);
                DF_VL(3);
                DF_MF(8);
                { const float p = fast_exp2(DF_S(12) - m_new); DF_S(12) = p; ls += p; }
                { const float p = fast_exp2(DF_S(13) - m_new); DF_S(13) = p; ls += p; }
                pw[0][1][2] = cvt_pk(DF_S(12), DF_S(13));
                { const float p = fast_exp2(DF_S(14) - m_new); DF_S(14) = p; ls += p; }
                __builtin_amdgcn_sched_barrier(0);
                DF_MF(9);
                { const float p = fast_exp2(DF_S(15) - m_new); DF_S(15) = p; ls += p; }
                pw[0][1][3] = cvt_pk(DF_S(14), DF_S(15));
                { const float p = fast_exp2(DF_S(16) - m_new); DF_S(16) = p; ls += p; }
                { const float p = fast_exp2(DF_S(17) - m_new); DF_S(17) = p; ls += p; }
                pw[1][0][0] = cvt_pk(DF_S(16), DF_S(17));
                __builtin_amdgcn_sched_barrier(0);
                DF_MF(10);
                { const float p = fast_exp2(DF_S(18) - m_new); DF_S(18) = p; ls += p; }
                { const float p = fast_exp2(DF_S(19) - m_new); DF_S(19) = p; ls += p; }
                pw[1][0][1] = cvt_pk(DF_S(18), DF_S(19));
                { const float p = fast_exp2(DF_S(20) - m_new); DF_S(20) = p; ls += p; }
                __builtin_amdgcn_sched_barrier(0);
                DF_MF(11);
                { const float p = fast_exp2(DF_S(21) - m_new); DF_S(21) = p; ls += p; }
                pw[1][0][2] = cvt_pk(DF_S(20), DF_S(21));
                { const float p = fast_exp2(DF_S(22) - m_new); DF_S(22) = p; ls += p; }
                { const float p = fast_exp2(DF_S(23) - m_new); DF_S(23) = p; ls += p; }
                pw[1][0][3] = cvt_pk(DF_S(22), DF_S(23));
                __builtin_amdgcn_sched_barrier(0);
                DF_MF(12);
                { const float p = fast_exp2(DF_S(24) - m_new); DF_S(24) = p; ls += p; }
                { const float p = fast_exp2(DF_S(25) - m_new); DF_S(25) = p; ls += p; }
                pw[1][1][0] = cvt_pk(DF_S(24), DF_S(25));
                __builtin_amdgcn_sched_barrier(0);
                DF_MF(13);
                { const float p = fast_exp2(DF_S(26) - m_new); DF_S(26) = p; ls += p; }
                { const float p = fast_exp2(DF_S(27) - m_new); DF_S(27) = p; ls += p; }
                pw[1][1][1] = cvt_pk(DF_S(26), DF_S(27));
                __builtin_amdgcn_sched_barrier(0);
                DF_MF(14);
                { const float p = fast_exp2(DF_S(28) - m_new); DF_S(28) = p; ls += p; }
                { const float p = fast_exp2(DF_S(29) - m_new); DF_S(29) = p; ls += p; }
                pw[1][1][2] = cvt_pk(DF_S(28), DF_S(29));
                __builtin_amdgcn_sched_barrier(0);
                DF_MF(15);
                { const float p = fast_exp2(DF_S(30) - m_new); DF_S(30) = p; ls += p; }
                { const float p = fast_exp2(DF_S(31) - m_new); DF_S(31) = p; ls += p; }
                pw[1][1][3] = cvt_pk(DF_S(30), DF_S(31));
                __builtin_amdgcn_sched_barrier(0);
                l_run = l_run * alpha + ls;
#pragma unroll
                for (int kb = 0; kb < 2; ++kb)
#pragma unroll
                    for (int sp = 0; sp < 2; ++sp) pf[kb][sp] = __builtin_bit_cast(bf16x8, pw[kb][sp]);
#undef DF_VL
#undef DF_MF
#undef DF_S
            }
        }
        if (t > 0) DF_STORE(((i + 1) & 1) * KT_BYTES, VB0 + ((i + 1) % 3) * VT_BYTES);
        __syncthreads();
    }
    if (have_p) {
        DF_RESCALE();
        bf16x8 vf[4][2][2];
        DF_VLOAD(VB0 + ((NT - 1) % 3) * VT_BYTES);
        DF_PV();
    }
    __syncthreads();
#undef DF_LOAD
#undef DF_STORE
#undef DF_VLOAD
#undef DF_PV
#undef DF_RESCALE
    const int erow = lane >> 4, ech = lane & 15;
    const size_t tok0 = tokbase + q0w;
    u32x4 gw[8];
    if (role == 0) {
        const bf16_t* gp = PROJ + (tok0 + erow) * NPROJ + PG_DF + hh * 128 + ech * 8;
#pragma unroll
        for (int i = 0; i < 8; ++i) gw[i] = *(const u32x4*)(gp + (size_t)(4 * i) * NPROJ);
    }
    LAS unsigned char* stg = lds + 69632 + qg * 8704;
    {
        const float lt = l_run + __shfl_xor(l_run, 32);
        const float inv = 1.f / lt;
        LAS float* xq = (LAS float*)lds + (qg * 32 + r) * XP + 4 * h;
        if (role == 1) {
            const float f = inv * lam;
#pragma unroll
            for (int d = 0; d < 4; ++d)
#pragma unroll
                for (int g = 0; g < 4; ++g) *(LAS f32x4*)(xq + 32 * d + 8 * g) = (f32x4){o[d][4 * g] * f, o[d][4 * g + 1] * f, o[d][4 * g + 2] * f, o[d][4 * g + 3] * f};
        }
        __syncthreads();
        if (role == 0) {
            float q = 0.f;
#pragma unroll
            for (int d = 0; d < 4; ++d)
#pragma unroll
                for (int g = 0; g < 4; ++g) { const f32x4 x2 = *(const LAS f32x4*)(xq + 32 * d + 8 * g);
#pragma unroll
                    for (int j = 0; j < 4; ++j) { const float v = o[d][4 * g + j] * inv - x2[j]; o[d][4 * g + j] = v; q += v * v; } }
            q += __shfl_xor(q, 32);
            const float rs = rsqrtf(q * (1.f / 128.f) + SUBLN_EPS) * (1.f - LAMBDA_INIT);
            const float* sg = subln_g + 4 * h;
#pragma unroll
            for (int d = 0; d < 4; ++d)
#pragma unroll
                for (int g = 0; g < 4; ++g) { const f32x4 sv = *(const f32x4*)(sg + 32 * d + 8 * g);
                    u32x2 w; w.x = cvt_pk(o[d][4 * g] * rs * sv[0], o[d][4 * g + 1] * rs * sv[1]); w.y = cvt_pk(o[d][4 * g + 2] * rs * sv[2], o[d][4 * g + 3] * rs * sv[3]);
                    *(LAS u32x2*)(stg + r * 272 + (32 * d + 8 * g + 4 * h) * 2) = w; }
            asm volatile("s_waitcnt lgkmcnt(0)" ::: "memory");
            bf16_t* op = MIXED + (tok0 + erow) * DM + 1024 + hh * 128 + ech * 8;
#pragma unroll
            for (int i = 0; i < 8; ++i) { const u32x4 ov = *(const LAS u32x4*)(stg + (4 * i + erow) * 272 + ech * 16); const u32x4 g4 = gw[i];
                u32x4 w; w.x = cvt_pk(bf_lo(ov.x) * bf_lo(g4.x), bf_hi(ov.x) * bf_hi(g4.x)); w.y = cvt_pk(bf_lo(ov.y) * bf_lo(g4.y), bf_hi(ov.y) * bf_hi(g4.y));
                w.z = cvt_pk(bf_lo(ov.z) * bf_lo(g4.z), bf_hi(ov.z) * bf_hi(g4.z)); w.w = cvt_pk(bf_lo(ov.w) * bf_lo(g4.w), bf_hi(ov.w) * bf_hi(g4.w));
                *(u32x4*)(op + (size_t)(4 * i) * DM) = w; }
        }
    }
}
}
#define XB_TMO      128
#define XB_XCNT(j)  (256  + 64 * (j))
#define XB_XSUB(j)  (1280 + 64 * (j))
#define XB_XGEN(j)  (2304 + 64 * (j))
#define XB_TOP      3328
#define XB_TOPGEN   3392
#define XCD_BAR_WORDS 3456
#define XB_SPIN_CAP (1u << 18)

__device__ __forceinline__ unsigned xb_ld(unsigned* p)              { return __hip_atomic_load(p, __ATOMIC_RELAXED, __HIP_MEMORY_SCOPE_AGENT); }
__device__ __forceinline__ unsigned xb_add(unsigned* p, unsigned v) { return __hip_atomic_fetch_add(p, v, __ATOMIC_RELAXED, __HIP_MEMORY_SCOPE_AGENT); }
__device__ __forceinline__ unsigned xb_xcc_id() { return (unsigned)__builtin_amdgcn_s_getreg((3 << 11) | 20) & 0xFu; }
#define XB_SPIN(cond, bar) do { unsigned _sp = 0; while (cond) { __builtin_amdgcn_s_sleep(1); \
    if ((++_sp & 255u) == 0u) { if (xb_ld(&(bar)[XB_TMO])) break; if (_sp > XB_SPIN_CAP) { atomicAdd(&(bar)[XB_TMO], 1u); break; } } } } while (0)

struct XcdBarrier {
    unsigned* bar; unsigned x;
    volatile LAS unsigned* st;
};

__device__ __forceinline__ XcdBarrier xcd_barrier_post(unsigned* bar, volatile LAS unsigned* st) {
    XcdBarrier b; b.bar = bar; b.x = xb_xcc_id(); b.st = st;
    if (threadIdx.x == 0) (void)xb_add(&bar[XB_XCNT(b.x)], 1u);
    return b;
}
__device__ __forceinline__ void xcd_barrier_complete(unsigned* bar, unsigned x, unsigned& nloc, unsigned& nx) {
    const unsigned G = gridDim.x * gridDim.y * gridDim.z;
    unsigned sum, cnt, mine, sp = 0u;
    for (;;) {
        sum = 0u; cnt = 0u; mine = 0u;
#pragma unroll
        for (unsigned j = 0; j < 16; ++j) { const unsigned c = xb_ld(&bar[XB_XCNT(j)]); sum += c; cnt += (c > 0u) ? 1u : 0u; mine = (j == x) ? c : mine; }
        if (sum == G) break;
        __builtin_amdgcn_s_sleep(1);
        if ((++sp & 255u) == 0u) { if (xb_ld(&bar[XB_TMO])) break; if (sp > XB_SPIN_CAP) { atomicAdd(&bar[XB_TMO], 1u); break; } }
    }
    nloc = mine > 0u ? mine : 1u; nx = cnt > 0u ? cnt : 1u;
}

__device__ __forceinline__ void xcd_barrier(const XcdBarrier& b) {
    asm volatile("s_waitcnt vmcnt(0)" ::: "memory");
    __syncthreads();
    if (threadIdx.x == 0) {
        unsigned* bar = b.bar;
        __builtin_amdgcn_s_waitcnt(0);
        unsigned nloc = b.st[0], nx = b.st[1];
        if (nloc == 0u) { xcd_barrier_complete(bar, b.x, nloc, nx); b.st[0] = nloc; b.st[1] = nx; }
        const unsigned old = xb_add(&bar[XB_XSUB(b.x)], 1u);
        const unsigned gen = old / nloc;
        if (old + 1u == (gen + 1u) * nloc) {
            __builtin_amdgcn_fence(__ATOMIC_RELEASE, "agent");
            asm volatile("s_waitcnt vmcnt(0)" ::: "memory");
            const unsigned og = xb_add(&bar[XB_TOP], 1u);
            const unsigned tg = og / nx;
            if (og + 1u == (tg + 1u) * nx) xb_add(&bar[XB_TOPGEN], 1u);
            else XB_SPIN(xb_ld(&bar[XB_TOPGEN]) == tg, bar);
            __builtin_amdgcn_fence(__ATOMIC_ACQUIRE, "agent");
            xb_add(&bar[XB_XGEN(b.x)], 1u);
            asm volatile("s_waitcnt vmcnt(0)" ::: "memory");
        } else {
            XB_SPIN(xb_ld(&bar[XB_XGEN(b.x)]) == gen, bar);
            __builtin_amdgcn_fence(__ATOMIC_ACQUIRE, "agent");
            asm volatile("s_waitcnt vmcnt(0)" ::: "memory");
        }
    }
    __syncthreads();
}

__device__ __forceinline__ int win_dst_row(int c) {
    const int seg = c >> 10, w = c & 1023, d6 = w & 63;
    const int wp = d6 < 16 ? (w & ~63) + (d6 < 8 ? 2 * d6 : 2 * (d6 - 8) + 1) : w;
    switch (seg) { case 0: return w; case 1: return 1024 + w; case 2: return 6144 + w; case 3: return 2048 + w;
                   case 4: return 3072 + wp; case 5: return 4096 + wp; case 6: return 7168 + w; default: return 5120 + w; }
}
struct TItem { const float* W; bf16_t* WT; const float* ks; int K, N, win, item; };
__device__ __forceinline__ void tr_load(const TItem& t, float (&v)[32], int lane) {
    const int nblk = t.N / 32, kb = t.item / nblk, nb = t.item % nblk; const float* p = t.W + (size_t)(64 * kb + (lane >> 5)) * t.N + 32 * nb + (lane & 31);
#pragma unroll
    for (int i = 0; i < 32; ++i) v[i] = p[(size_t)(2 * i) * t.N];
}
__device__ __forceinline__ void tr_write(const float (&v)[32], LAS float* scr, int lane) {
#pragma unroll
    for (int i = 0; i < 32; ++i) scr[(2 * i + (lane >> 5)) * 33 + (lane & 31)] = v[i];
}
__device__ __forceinline__ void tr_store(const TItem& t, LAS float* scr, int lane) {
    const int nblk = t.N / 32, kb = t.item / nblk, nb = t.item % nblk, k0 = 64 * kb, n0 = 32 * nb, c = lane & 7;
    f32x4 s0 = {1.f, 1.f, 1.f, 1.f}, s1 = {1.f, 1.f, 1.f, 1.f};
    if (t.ks) { s0 = *(const f32x4*)(t.ks + k0 + 8 * c); s1 = *(const f32x4*)(t.ks + k0 + 8 * c + 4); }
#pragma unroll
    for (int j = 0; j < 4; ++j) { const int n = (lane >> 3) + 8 * j; const LAS float* s = scr + (8 * c) * 33 + n;
        u32x4 o; o.x = cvt_pk(s[0 * 33] * s0[0], s[1 * 33] * s0[1]); o.y = cvt_pk(s[2 * 33] * s0[2], s[3 * 33] * s0[3]); o.z = cvt_pk(s[4 * 33] * s1[0], s[5 * 33] * s1[1]); o.w = cvt_pk(s[6 * 33] * s1[2], s[7 * 33] * s1[3]);
        const int dn = t.win ? win_dst_row(n0 + n) : (n0 + n);
        *(u32x4*)(t.WT + (size_t)dn * t.K + k0 + 8 * c) = o; }
}
__device__ __forceinline__ void rms_load(const float* __restrict__ xrow, f32x4 (&v)[8], int lane) {
    const f32x4* xr = (const f32x4*)xrow + lane;
#pragma unroll
    for (int j = 0; j < 8; ++j) v[j] = xr[64 * j];
}
__device__ __forceinline__ void rms_finish(const f32x4 (&v)[8], const f32x4 (&gv)[8], bf16_t* __restrict__ orow, int lane) {
    float s = 0.f;
#pragma unroll
    for (int j = 0; j < 8; ++j) s += (v[j][0] * v[j][0] + v[j][1] * v[j][1]) + (v[j][2] * v[j][2] + v[j][3] * v[j][3]);
    const float rstd = rsqrtf(wave_sum(s) * (1.f / DM) + NORM_EPS);
    u32x2* o8 = (u32x2*)orow + lane;
#pragma unroll
    for (int j = 0; j < 8; ++j) { u32x2 w; w.x = cvt_pk(v[j][0] * rstd * gv[j][0], v[j][1] * rstd * gv[j][1]); w.y = cvt_pk(v[j][2] * rstd * gv[j][2], v[j][3] * rstd * gv[j][3]); o8[64 * j] = w; }
}

struct Args { const float* in[14]; float* out; unsigned char* ws; };

__global__ void __launch_bounds__(512, 2) fwd_megakernel(Args a) {
    extern __shared__ __attribute__((aligned(16))) unsigned char lds_raw[];
    LAS unsigned char* lds = (LAS unsigned char*)lds_raw;
    { cg::grid_group grid = cg::this_grid(); if (a.ws == nullptr) grid.sync(); }
    const int tid = threadIdx.x, lane = tid & 63, wave = __builtin_amdgcn_readfirstlane(tid >> 6);
    const int G = gridDim.x, bx = blockIdx.x;
    const int vcu = (G % 8 == 0) ? (bx % 8) * (G / 8) + bx / 8 : bx;
    unsigned char* ws = a.ws;
    float* ss2 = (float*)(ws + WS_CTL + CTL_SS2); float* ss3 = (float*)(ws + WS_CTL + CTL_SS3); float* lamp = (float*)(ws + WS_CTL + CTL_LAM); float* rope = (float*)(ws + WS_CTL + CTL_ROPE);
    bf16_t* WIN = (bf16_t*)(ws + WS_WIN); bf16_t* WOUT = (bf16_t*)(ws + WS_WOUT); bf16_t* WGATE = (bf16_t*)(ws + WS_WGATE); bf16_t* WPROJ = (bf16_t*)(ws + WS_WPROJ);
    bf16_t* PB = (bf16_t*)(ws + WS_PB); bf16_t* XN = (bf16_t*)(ws + WS_XN); bf16_t* MIXED = (bf16_t*)(ws + WS_MIXED); bf16_t* PROJ = (bf16_t*)(ws + WS_PROJ);
    bf16_t* VT = (bf16_t*)(ws + WS_VT); bf16_t* KIMG = (bf16_t*)(ws + WS_KIMG); bf16_t* HB = (bf16_t*)(ws + WS_HB); bf16_t* PLEB = (bf16_t*)(ws + WS_PLE); bf16_t* H2B = (bf16_t*)(ws + WS_H2B);
    const float* x = a.in[0]; float* out = a.out;
    volatile LAS unsigned* xst = (volatile LAS unsigned*)(lds + 131072);
    if (tid == 0) { xst[0] = 0u; xst[1] = 0u; }
    __syncthreads();
    const XcdBarrier xb = xcd_barrier_post((unsigned*)(ws + WS_CTL + CTL_BAR), xst);

    for (int rep_ = 0; rep_ < ((PROBE_DUP & 1) ? 2 : 1); ++rep_) {
        if (rep_) __syncthreads();
        const int gw = bx * 8 + wave, NGW = G * 8; const int gt = bx * 512 + tid, NGT = G * 512;
        for (int i = gt; i < 2 * NTOK; i += NGT) ss2[i] = 0.f;
        if (gt == 0) { float s1 = 0.f, s2 = 0.f; for (int i = 0; i < 64; ++i) { s1 += a.in[4][i] * a.in[5][i]; s2 += a.in[6][i] * a.in[7][i]; } lamp[0] = expf(s1) - expf(s2) + LAMBDA_INIT; }
        for (int i = gt; i < SEQ * 8; i += NGT) { const int pos = i >> 3, f = i & 7;
            const float invf = (float)exp2(-(double)f * 0.125 * 18.931568569324174);
            const float angf = (float)pos * invf;
            const double tw = 6.283185307179586476925; double ang = (double)angf; ang -= tw * rint(ang / tw);
            rope[2 * i] = (float)cos(ang); rope[2 * i + 1] = (float)sin(ang); }
        LAS float* scr = (LAS float*)(lds + wave * 16384);
        constexpr int I_IN = (DM / 64) * (8192 / 32), I_SQ = (DM / 64) * (DM / 32), I_PR = (PLE / 64) * (DM / 32), I_ALL = I_IN + 2 * I_SQ + I_PR;
#define P0_DECODE(T, it_) do { int rr_ = (it_); \
            if (rr_ < I_IN) { T = TItem{a.in[3], WIN, nullptr, DM, 8192, 1, rr_}; } \
            else if (rr_ < I_IN + I_SQ) { T = TItem{a.in[9], WOUT, nullptr, DM, DM, 0, rr_ - I_IN}; } \
            else if (rr_ < I_IN + 2 * I_SQ) { T = TItem{a.in[11], WGATE, a.in[10], DM, DM, 0, rr_ - I_IN - I_SQ}; } \
            else { T = TItem{a.in[12], WPROJ, nullptr, PLE, DM, 0, rr_ - I_IN - 2 * I_SQ}; } } while (0)
        {
            float tv[32]; TItem cur, nxt; int it = gw;
            if (it < I_ALL) { P0_DECODE(cur, it); tr_load(cur, tv, lane); }
            while (it < I_ALL) {
                tr_write(tv, scr, lane);
                const int itn = it + NGW;
                if (itn < I_ALL) { P0_DECODE(nxt, itn); tr_load(nxt, tv, lane); }
                asm volatile("s_waitcnt lgkmcnt(0)" ::: "memory");
                tr_store(cur, scr, lane);
                asm volatile("s_waitcnt lgkmcnt(0)" ::: "memory");
                cur = nxt; it = itn;
            }
        }
#undef P0_DECODE
        {
            f32x4 gv[8], va[8], vb[8];
            { const f32x4* gr = (const f32x4*)a.in[2] + lane;
#pragma unroll
              for (int j = 0; j < 8; ++j) gv[j] = gr[64 * j]; }
            int m = gw;
            if (m < NTOK) rms_load(x + (size_t)m * DM, va, lane);
            for (; m < NTOK; m += 2 * NGW) {
                const int m1 = m + NGW, m2 = m + 2 * NGW;
                if (m1 < NTOK) rms_load(x + (size_t)m1 * DM, vb, lane);
                rms_finish(va, gv, XN + (size_t)m * DM, lane);
                if (m2 < NTOK) rms_load(x + (size_t)m2 * DM, va, lane);
                if (m1 < NTOK) rms_finish(vb, gv, XN + (size_t)m1 * DM, lane);
            }
        }
        for (int i = gt; i < NTOK * PLE / 8; i += NGT) { const f32x4 v0 = ((const f32x4*)a.in[1])[2 * i], v1 = ((const f32x4*)a.in[1])[2 * i + 1];
            u32x4 w; w.x = cvt_pk(v0[0], v0[1]); w.y = cvt_pk(v0[2], v0[3]); w.z = cvt_pk(v1[0], v1[1]); w.w = cvt_pk(v1[2], v1[3]); ((u32x4*)PB)[i] = w; }
    }
    xcd_barrier(xb);
    for (int rep_ = 0; rep_ < ((PROBE_DUP & 2) ? 2 : 1); ++rep_) {
        if (rep_) __syncthreads();
        { pg8::Gemm g{XN, WIN, NTOK, NPROJ, DM}; pg8::StaticOrder S; S.init(NTOK, NPROJ, G, bx); pg8::EpiProj E{PROJ, rope, KIMG};
          pg8::gemm_phase<pg8::EpiProj, pg8::StaticOrder, true, true>(lds, g, S, E); }
        __syncthreads();
        { pg8::Gemm g{WIN + (size_t)NPROJ * DM, XN, 2048, NTOK, DM}; pg8::StaticOrder S; S.init(2048, NTOK, G, bx); pg8::EpiVt E{VT};
          pg8::gemm_phase<pg8::EpiVt, pg8::StaticOrder, true, true>(lds, g, S, E); }
    }
    xcd_barrier(xb);
    for (int rep_ = 0; rep_ < ((PROBE_DUP & 4) ? 2 : 1); ++rep_) {
        const float lam = lamp[0];
        for (int su = vcu; su < 256; su += G) {
            const int grp = su >> 4, j = su & 15;
#pragma unroll 1
            for (int k = 0; k < 4; ++k) { const int bh = 4 * grp + k; const int qb = (k & 1) ? 15 - j : j;
                att::attn_unit_df(lds, PROJ, KIMG, VT, MIXED, bh >> 3, bh & 7, qb, lam, a.in[8]); }
        }
#pragma unroll 1
        for (int u = vcu; u < 512; u += G) att::attn_unit<0>(lds, PROJ, KIMG, VT, MIXED, (u >> 3) >> 3, (u >> 3) & 7, u & 7, lam, a.in[8]);
    }
    xcd_barrier(xb);
    {
        __syncthreads();
        { pg8::Gemm g{MIXED, WOUT, NTOK, DM, DM}; pg8::StaticOrder S; S.init(NTOK, DM, G, bx); pg8::EpiRes E{x, HB, ss2};
          pg8::gemm_phase<pg8::EpiRes, pg8::StaticOrder, true, true>(lds, g, S, E); }
        __syncthreads();
        { pg8::Gemm g{PB, WPROJ, NTOK, DM, PLE}; pg8::StaticOrder S; S.init(NTOK, DM, G, bx); pg8::EpiBf16 E{PLEB, DM};
          pg8::gemm_phase<pg8::EpiBf16, pg8::StaticOrder, true, true>(lds, g, S, E); }
    }
    xcd_barrier(xb);
    {
        pg8::Gemm g{HB, WGATE, NTOK, DM, DM}; pg8::StaticOrder S; S.init(NTOK, DM, G, bx); pg8::EpiGate E{HB, H2B, PLEB, ss2, ss3};
        pg8::gemm_phase<pg8::EpiGate, pg8::StaticOrder, true, true>(lds, g, S, E);
    }
    xcd_barrier(xb);
    {
        const int tid5 = opaque_tid(), lane = tid5 & 63, wave = __builtin_amdgcn_readfirstlane(tid5 >> 6);
        const int gw = bx * 8 + wave, NGW = G * 8; const f32x4* gr = (const f32x4*)a.in[13];
        for (int m = gw; m < NTOK; m += NGW) { const float rstd = rsqrtf(ss3[m] * (1.f / DM) + NORM_EPS); f32x4* orow = (f32x4*)(out + (size_t)m * DM); const u32x4* hrow = (const u32x4*)(H2B + (size_t)m * DM);
#pragma unroll
            for (int j = 0; j < 4; ++j) { const int c = lane + 64 * j; const u32x4 hw = hrow[c]; const f32x4 g0 = gr[2 * c], g1 = gr[2 * c + 1];
                orow[2 * c] = (f32x4){bf_lo(hw.x) * rstd * g0[0], bf_hi(hw.x) * rstd * g0[1], bf_lo(hw.y) * rstd * g0[2], bf_hi(hw.y) * rstd * g0[3]};
                orow[2 * c + 1] = (f32x4){bf_lo(hw.z) * rstd * g1[0], bf_hi(hw.z) * rstd * g1[1], bf_lo(hw.w) * rstd * g1[2], bf_hi(hw.w) * rstd * g1[3]}; } }
    }
}

extern "C" void kernel_launch(void* const* d_in, const int* in_sizes, int n_in, void* d_out, int out_size, void* d_ws, size_t ws_size, hipStream_t stream) {
    static int grid = 0;
    if (grid == 0) {
        if (n_in != 14 || out_size != NTOK * DM || ws_size < WS_END) { fprintf(stderr, "kernel_launch: unexpected shapes (n_in %d out %d ws %zu)\n", n_in, out_size, ws_size); grid = -1; return; }
        int dev = 0, cus = 0, per_cu = 0;
        (void)hipGetDevice(&dev); (void)hipDeviceGetAttribute(&cus, hipDeviceAttributeMultiprocessorCount, dev);
        (void)hipFuncSetAttribute((const void*)fwd_megakernel, hipFuncAttributeMaxDynamicSharedMemorySize, LDS_BYTES);
        (void)hipOccupancyMaxActiveBlocksPerMultiprocessor(&per_cu, (const void*)fwd_megakernel, 512, LDS_BYTES);
        if (per_cu < 1) { fprintf(stderr, "kernel_launch: occupancy query says %d blocks/CU\n", per_cu); per_cu = 1; }
        grid = cus * per_cu;
    }
    if (grid < 0) return;
    Args a{};
    for (int i = 0; i < 14; ++i) a.in[i] = (const float*)d_in[i];
    a.out = (float*)d_out; a.ws = (unsigned char*)d_ws;
    (void)hipMemsetAsync((unsigned char*)d_ws + WS_CTL + CTL_BAR, 0, CTL_BAR_BYTES, stream);
    void* args[] = {&a};
    hipError_t e = hipLaunchCooperativeKernel((void*)fwd_megakernel, dim3(grid), dim3(512), args, LDS_BYTES, stream);
    if (e != hipSuccess) fprintf(stderr, "cooperative launch failed: %s (grid %d)\n", hipGetErrorString(e), grid);
}
```

```cpp
#include <hip/hip_runtime.h>
#include <hip/hip_cooperative_groups.h>
#include <cstdio>
#include <cstdint>
namespace cg = cooperative_groups;
__device__ __forceinline__ int opaque_tid() { int t = (int)threadIdx.x; asm volatile("" : "+v"(t)); return t; }
#ifndef PROBE_DUP
#define PROBE_DUP 0
#endif
namespace pg8 {
#define PG8_LAS __attribute__((address_space(3)))
typedef unsigned short bf16_t;
typedef short bf16x8 __attribute__((ext_vector_type(8)));
typedef float f32x4 __attribute__((ext_vector_type(4)));
typedef unsigned u32x4 __attribute__((ext_vector_type(4)));
constexpr int BM = 256, BK = 64, HALF = 128, HTB = HALF * BK * 2  , STAGE_BYTES = 8 * HTB, NXCD = 8, WGM = 8;

__host__ __device__ __forceinline__ int lds_byte(int r, int c) { const int st = (r >> 4) * 2 + (c >> 5), rr = r & 15, cc = c & 31, ob = rr * 64 + cc * 2; return st * 1024 + (ob ^ (((ob >> 9) & 1) << 5)); }
__host__ __device__ __forceinline__ void stage_rc(int b, int& R, int& C) { const int st = b / 1024, sb = b % 1024, swz = sb ^ (((sb >> 9) & 1) << 5); R = (st >> 1) * 16 + swz / 64; C = (st & 1) * 32 + (swz % 64) / 2; }
__host__ __device__ __forceinline__ int perm32(int rho) { const int n = rho >> 4, i = rho & 15; return 8 * (i >> 2) + 4 * n + (i & 3); }

struct Unit { int pm, pn; };
struct Gemm { const bf16_t* A; const bf16_t* Bt; int M, N, K; };

struct StaticOrder {
    int nM, nN, nwg, G, c;
    __host__ __device__ void init(int M, int N, int G_, int c_) { nM = M / BM; nN = N / BM; nwg = nM * nN; G = G_; c = c_; }
    __host__ __device__ bool next(int i, Unit& u) const {
        const long L = (long)i * G + c; if (L >= nwg) return false;
        int wgid = (int)L; { const int q = nwg / NXCD, r = nwg % NXCD, xcd = wgid % NXCD, off = wgid / NXCD; wgid = (xcd < r ? xcd * (q + 1) : r * (q + 1) + (xcd - r) * q) + off; }
        const int nig = WGM * nN, gid = wgid / nig, fm = gid * WGM, gsz = (nM - fm) < WGM ? (nM - fm) : WGM;
        u.pm = fm + ((wgid % nig) % gsz); u.pn = (wgid % nig) / gsz; return true;
    }
    __device__ __forceinline__ void a_ready(const Unit&) const {}
    __device__ __forceinline__ void done(const Unit&) const {}
};

__device__ __forceinline__ unsigned cvt_pk_bf16(float lo, float hi) { unsigned r; asm volatile("v_cvt_pk_bf16_f32 %0, %1, %2" : "=v"(r) : "v"(lo), "v"(hi)); return r; }
typedef float f32x2 __attribute__((ext_vector_type(2)));
template <class Epi, class Sched, bool ALIGN_EPI = false, bool SP2 = false>
__device__ __forceinline__ void gemm_phase(PG8_LAS unsigned char* lds, const Gemm g, const Sched& S, const Epi& E) {
    const int tid = opaque_tid(), wid = __builtin_amdgcn_readfirstlane(tid >> 6), lane = tid & 63, wr = wid >> 2, wc = wid & 3, fr = lane & 15, fq = lane >> 4;
    const int K = g.K, nt = K / BK;
    unsigned voffA[2], voffB[2];
#pragma unroll
    for (int i = 0; i < 2; ++i) { int R, C; stage_rc(tid * 16 + i * 8192, R, C); const int Rb = Epi::PERM ? ((R & ~31) + perm32(R & 31)) : R;
        voffA[i] = (unsigned)(R * K + C) * 2u; voffB[i] = (unsigned)(Rb * K + C) * 2u; }
    const size_t kstep = (size_t)(BK * 2);
    const size_t hstep = (size_t)HALF * K * 2;
    const size_t tstep = 2 * hstep;
    const unsigned ldsw = (unsigned)wid * 1024u;
    const int aoff = lds_byte(wr * 64 + fr, fq * 8), boff = lds_byte(wc * 32 + fr, fq * 8);
#define PG8_SA(b, h) (((b) * 2 + (h)) * HTB)
#define PG8_SB(b, h) ((4 + (b) * 2 + (h)) * HTB)
#define PG8_STAGE(bufoff, gbase, voff) do { _Pragma("unroll") for (int _i = 0; _i < 2; ++_i) \
        __builtin_amdgcn_global_load_lds((const unsigned*)((const char*)(gbase) + (voff)[_i]), (PG8_LAS unsigned*)(lds + (bufoff) + ldsw + _i * 8192), 16, 0, 0); } while (0)
#define PG8_LDA(dst, b, h) do { _Pragma("unroll") for (int m = 0; m < 4; ++m) _Pragma("unroll") for (int k = 0; k < 2; ++k) dst[m][k] = *(const PG8_LAS bf16x8*)(lds + PG8_SA(b, h) + aoff + m * 2048 + k * 1024); } while (0)
#define PG8_LDB(dst, b, h) do { _Pragma("unroll") for (int n = 0; n < 2; ++n) _Pragma("unroll") for (int k = 0; k < 2; ++k) dst[n][k] = *(const PG8_LAS bf16x8*)(lds + PG8_SB(b, h) + boff + n * 2048 + k * 1024); } while (0)
#define PG8_MMA(ai, bj, At, Bt) do { __builtin_amdgcn_s_setprio(1); _Pragma("unroll") for (int m = 0; m < 4; ++m) _Pragma("unroll") for (int n = 0; n < 2; ++n) _Pragma("unroll") for (int k = 0; k < 2; ++k) \
        acc[ai][bj][m][n] = __builtin_amdgcn_mfma_f32_16x16x32_bf16(Bt[n][k], At[m][k], acc[ai][bj][m][n], 0, 0, 0); __builtin_amdgcn_s_setprio(0); } while (0)
#define PG8_WAIT_V(n) asm volatile("s_waitcnt vmcnt(" #n ")" ::: "memory")
#define PG8_WAIT_L(n) asm volatile("s_waitcnt lgkmcnt(" #n ")" ::: "memory")
#define PG8_BAR __builtin_amdgcn_s_barrier()
#define PG8_SCHED __builtin_amdgcn_sched_barrier(0)
    Unit cur, nxt; int ui = 0;
    if (!S.next(0, cur)) return;
    f32x4 acc[2][2][4][2];
#pragma unroll
    for (int a = 0; a < 2; ++a)
#pragma unroll
        for (int b = 0; b < 2; ++b)
#pragma unroll
            for (int m = 0; m < 4; ++m)
#pragma unroll
                for (int n = 0; n < 2; ++n) acc[a][b][m][n] = (f32x4){0.f, 0.f, 0.f, 0.f};
    bf16x8 At[4][2], B0[2][2], B1[2][2];
    const char* cA = (const char*)g.A + (size_t)cur.pm * tstep; const char* cB = (const char*)g.Bt + (size_t)cur.pn * tstep;
    S.a_ready(cur);
    if constexpr (SP2) {
        PG8_STAGE(PG8_SB(0, 0), cB, voffB); PG8_STAGE(PG8_SB(0, 1), cB + hstep, voffB); PG8_STAGE(PG8_SA(0, 0), cA, voffA); PG8_STAGE(PG8_SA(0, 1), cA + hstep, voffA);
        if (wr == 1) PG8_BAR;
        PG8_WAIT_V(2); PG8_BAR;
        PG8_STAGE(PG8_SB(1, 0), cB + kstep, voffB); PG8_STAGE(PG8_SA(1, 0), cA + kstep, voffA); PG8_STAGE(PG8_SB(1, 1), cB + hstep + kstep, voffB);
        PG8_WAIT_V(6); PG8_BAR;
    } else {
        PG8_STAGE(PG8_SB(0, 0), cB, voffB); PG8_STAGE(PG8_SA(0, 0), cA, voffA); PG8_STAGE(PG8_SB(0, 1), cB + hstep, voffB); PG8_STAGE(PG8_SA(0, 1), cA + hstep, voffA);
        if (wr == 1) PG8_BAR;
        PG8_WAIT_V(4); PG8_BAR;
        PG8_STAGE(PG8_SB(1, 0), cB + kstep, voffB); PG8_STAGE(PG8_SA(1, 0), cA + kstep, voffA); PG8_STAGE(PG8_SB(1, 1), cB + hstep + kstep, voffB);
        PG8_WAIT_V(6); PG8_BAR;
    }
    for (;;) {
        const bool has_next = S.next(ui + 1, nxt);
        const char* nA = has_next ? (const char*)g.A + (size_t)nxt.pm * tstep : cA; const char* nB = has_next ? (const char*)g.Bt + (size_t)nxt.pn * tstep : cB;
        for (int t = 0; t < nt; t += 2) {
            const bool last = (t == nt - 2);
            const char* a1 = cA + (size_t)(t + 1) * kstep;
            const char* a2 = last ? nA : cA + (size_t)(t + 2) * kstep; const char* b2 = last ? nB : cB + (size_t)(t + 2) * kstep;
            const char* a3 = a2 + kstep; const char* b3 = b2 + kstep;
            if (last && has_next) S.a_ready(nxt);
            if constexpr (SP2) {
            PG8_LDB(B0, 0, 0); PG8_LDB(B1, 0, 1); PG8_SCHED; PG8_LDA(At, 0, 0); PG8_STAGE(PG8_SA(1, 1), a1 + hstep, voffA);
            PG8_WAIT_V(8); PG8_WAIT_L(0); PG8_BAR; PG8_MMA(0, 0, At, B0); PG8_MMA(0, 1, At, B1); PG8_BAR; PG8_SCHED;
            PG8_LDA(At, 0, 1); PG8_STAGE(PG8_SB(0, 0), b2, voffB); PG8_STAGE(PG8_SB(0, 1), b2 + hstep, voffB); PG8_STAGE(PG8_SA(0, 0), a2, voffA);
            PG8_WAIT_V(8); PG8_WAIT_L(0); PG8_BAR; PG8_MMA(1, 0, At, B0); PG8_MMA(1, 1, At, B1); PG8_BAR; PG8_SCHED;
            PG8_LDB(B0, 1, 0); PG8_LDB(B1, 1, 1); PG8_SCHED; PG8_LDA(At, 1, 0); PG8_STAGE(PG8_SA(0, 1), a2 + hstep, voffA);
            PG8_WAIT_V(8); PG8_WAIT_L(0); PG8_BAR; PG8_MMA(0, 0, At, B0); PG8_MMA(0, 1, At, B1); PG8_BAR; PG8_SCHED;
            PG8_LDA(At, 1, 1); PG8_STAGE(PG8_SB(1, 0), b3, voffB); PG8_STAGE(PG8_SB(1, 1), b3 + hstep, voffB); PG8_STAGE(PG8_SA(1, 0), a3, voffA);
            PG8_WAIT_V(8); PG8_WAIT_L(0); PG8_BAR; PG8_MMA(1, 0, At, B0); PG8_MMA(1, 1, At, B1); PG8_BAR; PG8_SCHED;
            } else {
            PG8_LDB(B0, 0, 0); PG8_SCHED; PG8_LDA(At, 0, 0); PG8_STAGE(PG8_SA(1, 1), a1 + hstep, voffA);
            PG8_WAIT_L(8); PG8_BAR; PG8_WAIT_L(0); PG8_MMA(0, 0, At, B0); PG8_BAR; PG8_SCHED;
            PG8_LDB(B1, 0, 1); PG8_STAGE(PG8_SB(0, 0), b2, voffB);
            PG8_BAR; PG8_WAIT_L(0); PG8_MMA(0, 1, At, B1); PG8_BAR;
            PG8_LDA(At, 0, 1); PG8_STAGE(PG8_SA(0, 0), a2, voffA);
            PG8_BAR; PG8_WAIT_L(0); PG8_MMA(1, 0, At, B0); PG8_BAR; PG8_SCHED;
            PG8_STAGE(PG8_SB(0, 1), b2 + hstep, voffB);
            PG8_WAIT_V(6); PG8_BAR; PG8_MMA(1, 1, At, B1); PG8_BAR;
            PG8_LDB(B0, 1, 0); PG8_SCHED; PG8_LDA(At, 1, 0); PG8_STAGE(PG8_SA(0, 1), a2 + hstep, voffA);
            PG8_WAIT_L(8); PG8_BAR; PG8_WAIT_L(0); PG8_MMA(0, 0, At, B0); PG8_BAR; PG8_SCHED;
            PG8_LDB(B1, 1, 1); PG8_STAGE(PG8_SB(1, 0), b3, voffB);
            PG8_BAR; PG8_WAIT_L(0); PG8_MMA(0, 1, At, B1); PG8_BAR;
            PG8_LDA(At, 1, 1); PG8_STAGE(PG8_SA(1, 0), a3, voffA);
            PG8_BAR; PG8_WAIT_L(0); PG8_MMA(1, 0, At, B0); PG8_BAR; PG8_SCHED;
            PG8_STAGE(PG8_SB(1, 1), b3 + hstep, voffB);
            PG8_WAIT_V(6); PG8_BAR; PG8_MMA(1, 1, At, B1); PG8_BAR;
            }
        }
        if constexpr (ALIGN_EPI) { if (wr == 0) PG8_BAR; }
        if constexpr (!Epi::AFTER_DRAIN) { E(acc, cur, wr, wc, fr, fq); S.done(cur); }
        if (!has_next) break;
#pragma unroll
        for (int a = 0; a < 2; ++a)
#pragma unroll
            for (int b = 0; b < 2; ++b)
#pragma unroll
                for (int m = 0; m < 4; ++m)
#pragma unroll
                    for (int n = 0; n < 2; ++n) acc[a][b][m][n] = (f32x4){0.f, 0.f, 0.f, 0.f};
        cur = nxt; cA = nA; cB = nB; ++ui;
        if constexpr (ALIGN_EPI) { if (wr == 1) PG8_BAR; }
    }
    PG8_WAIT_V(0);
    if constexpr (!ALIGN_EPI) { if (wr == 0) PG8_BAR; }
    PG8_BAR;
    if constexpr (Epi::AFTER_DRAIN) { E.fused(acc, cur, wr, wc, fr, fq, lds, wid, lane); S.done(cur); }
#undef PG8_SA
#undef PG8_SB
#undef PG8_STAGE
#undef PG8_LDA
#undef PG8_LDB
#undef PG8_MMA
#undef PG8_WAIT_V
#undef PG8_WAIT_L
#undef PG8_BAR
#undef PG8_SCHED
}
}
#define LAS __attribute__((address_space(3)))
typedef unsigned short bf16_t;
typedef short bf16x8 __attribute__((ext_vector_type(8)));
typedef float f32x4 __attribute__((ext_vector_type(4)));
typedef float f32x2 __attribute__((ext_vector_type(2)));
typedef float f32x16 __attribute__((ext_vector_type(16)));
typedef unsigned u32x4 __attribute__((ext_vector_type(4)));
typedef unsigned u32x2 __attribute__((ext_vector_type(2)));

constexpr int NTOK = 16384, DM = 2048, SEQ = 2048, NBATCH = 8, PLE = 256;
constexpr int NPROJ = 6144;
constexpr int PQ_SB = 0, PK_SB = 1024, PG_SB = 2048, PQ_DF = 3072, PK_DF = 4096, PG_DF = 5120;
constexpr float LOG2E = 1.4426950408889634f;
constexpr float SBQ_SCALE = 0.08838834764831845f * LOG2E;
constexpr float DFQ_SCALE = 0.125f * LOG2E;
constexpr float NORM_EPS = 1e-6f, SUBLN_EPS = 1e-5f;
constexpr float LAMBDA_INIT = 0.2f;

constexpr size_t MiB = 1u << 20;
constexpr size_t WS_CTL = 0;
constexpr size_t CTL_SS2 = 0, CTL_SS3 = 65536, CTL_LAM = 131072, CTL_ROPE = 262144, CTL_BAR = 524288, CTL_BAR_BYTES = 16384;
constexpr size_t WS_WIN = 2 * MiB, WS_WOUT = 34 * MiB, WS_WGATE = 42 * MiB, WS_WPROJ = 50 * MiB, WS_PB = 52 * MiB;
constexpr size_t WS_XN = 64 * MiB, WS_MIXED = 64 * MiB;
constexpr size_t WS_PROJ = 128 * MiB, WS_VT = 320 * MiB, WS_KIMG = 384 * MiB, WS_END = 448 * MiB;
constexpr size_t WS_HB = 128 * MiB, WS_PLE = 192 * MiB;
constexpr size_t WS_H2B = 64 * MiB;

constexpr int LDS_BYTES = 131072 + 1024;

typedef __bf16 bf16x2_t __attribute__((ext_vector_type(2)));
__device__ __forceinline__ unsigned cvt_pk(float lo, float hi) { f32x2 v = {lo, hi}; bf16x2_t b = __builtin_convertvector(v, bf16x2_t); return __builtin_bit_cast(unsigned, b); }
__device__ __forceinline__ float bf_lo(unsigned w) { return __uint_as_float(w << 16); }
__device__ __forceinline__ float bf_hi(unsigned w) { return __uint_as_float(w & 0xffff0000u); }
__device__ __forceinline__ float wave_sum(float v) {
#pragma unroll
    for (int o = 1; o < 64; o <<= 1) v += __shfl_xor(v, o);
    return v;
}
__device__ __forceinline__ float fast_exp2(float x) { return __builtin_amdgcn_exp2f(x); }
__device__ __forceinline__ float fast_log2(float x) { return __builtin_amdgcn_logf(x); }
__device__ __forceinline__ float silu_f(float x) { return x * __builtin_amdgcn_rcpf(1.f + fast_exp2(-x * LOG2E)); }
__device__ __forceinline__ float sigmoid_f(float x) { return __builtin_amdgcn_rcpf(1.f + fast_exp2(-x * LOG2E)); }

namespace pg8 {
struct EpiBf16 {
    static constexpr bool PERM = true, AFTER_DRAIN = false;
    bf16_t* O; int ldc;
    __device__ __forceinline__ void operator()(const f32x4 (&acc)[2][2][4][2], const Unit& u, int wr, int wc, int fr, int fq) const {
        const int row0 = u.pm * BM + wr * 64 + fr; const int col0 = u.pn * BM + wc * 32 + 8 * fq;
#pragma unroll
        for (int ai = 0; ai < 2; ++ai)
#pragma unroll
            for (int m = 0; m < 4; ++m) { bf16_t* rowp = O + (size_t)(row0 + ai * HALF + m * 16) * ldc + col0;
#pragma unroll
                for (int bj = 0; bj < 2; ++bj) { const f32x4 v0 = acc[ai][bj][m][0], v1 = acc[ai][bj][m][1];
                    u32x4 w; w.x = cvt_pk_bf16(v0[0], v0[1]); w.y = cvt_pk_bf16(v0[2], v0[3]); w.z = cvt_pk_bf16(v1[0], v1[1]); w.w = cvt_pk_bf16(v1[2], v1[3]);
                    *(u32x4*)(rowp + bj * HALF) = w; } }
    }
};
struct EpiProj {
    static constexpr bool PERM = true, AFTER_DRAIN = false;
    bf16_t* O; const float* rope; bf16_t* KI;
    __device__ __forceinline__ void operator()(const f32x4 (&acc)[2][2][4][2], const Unit& u, int wr, int wc, int fr, int fq) const {
        const int row0 = u.pm * BM + wr * 64 + fr; const int col0 = u.pn * BM + wc * 32 + 8 * fq;
        const int kind = u.pn >> 2;
        const bool dorope = (kind == 3 || kind == 4) && ((wc & 1) == 0) && (fq < 2);
        const float sc = kind == 0 ? SBQ_SCALE : (kind == 3 ? DFQ_SCALE : 1.f);
        const bool dosilu = (kind == 2 || kind == 5);
#pragma unroll
        for (int ai = 0; ai < 2; ++ai)
#pragma unroll
            for (int m = 0; m < 4; ++m) { const int row = row0 + ai * HALF + m * 16; bf16_t* rowp = O + (size_t)row * NPROJ + col0;
                if (kind == 1 || kind == 4) {
                    const int cw = col0 & 1023; rowp = KI + ((size_t)(((kind == 4 ? 8 : 0) + (row >> 11)) * 8 + (cw >> 7)) * SEQ + (row & (SEQ - 1))) * 128 + (cw & 127); }
                f32x4 cs0 = {1.f, 0.f, 1.f, 0.f}, cs1 = {1.f, 0.f, 1.f, 0.f};
                if (dorope) { const f32x4* rp = (const f32x4*)(rope + ((size_t)(row & (SEQ - 1)) * 8 + 4 * fq) * 2); cs0 = rp[0]; cs1 = rp[1]; }
#pragma unroll
                for (int bj = 0; bj < 2; ++bj) { f32x4 v0 = acc[ai][bj][m][0], v1 = acc[ai][bj][m][1];
                    if (dorope) {
                        f32x4 a, b;
                        a[0] = v0[0] * cs0[0] - v0[1] * cs0[1]; a[1] = v0[1] * cs0[0] + v0[0] * cs0[1];
                        a[2] = v0[2] * cs0[2] - v0[3] * cs0[3]; a[3] = v0[3] * cs0[2] + v0[2] * cs0[3];
                        b[0] = v1[0] * cs1[0] - v1[1] * cs1[1]; b[1] = v1[1] * cs1[0] + v1[0] * cs1[1];
                        b[2] = v1[2] * cs1[2] - v1[3] * cs1[3]; b[3] = v1[3] * cs1[2] + v1[2] * cs1[3];
                        v0 = a; v1 = b; }
                    if (dosilu) {
#pragma unroll
                        for (int j = 0; j < 4; ++j) { v0[j] = silu_f(v0[j]); v1[j] = silu_f(v1[j]); } }
                    v0 = v0 * sc; v1 = v1 * sc;
                    u32x4 w; w.x = cvt_pk_bf16(v0[0], v0[1]); w.y = cvt_pk_bf16(v0[2], v0[3]); w.z = cvt_pk_bf16(v1[0], v1[1]); w.w = cvt_pk_bf16(v1[2], v1[3]);
                    *(u32x4*)(rowp + ((kind == 1 || kind == 4) ? bj * SEQ * 128 : bj * HALF)) = w; } }
    }
};
struct EpiVt {
    static constexpr bool PERM = true, AFTER_DRAIN = false;
    bf16_t* O;
    __device__ __forceinline__ void operator()(const f32x4 (&acc)[2][2][4][2], const Unit& u, int wr, int wc, int fr, int fq) const {
        const int row0 = u.pm * BM + wr * 64 + fr; const int col0 = u.pn * BM + wc * 32 + 8 * fq;
        const int p0 = (fq & 1) ? 4 : 0, p1 = (fq & 1) ? 12 : 8;
#pragma unroll
        for (int ai = 0; ai < 2; ++ai)
#pragma unroll
            for (int m = 0; m < 4; ++m) { const int row = row0 + ai * HALF + m * 16; const int gh = row >> 7, d = row & 127;
#pragma unroll
                for (int bj = 0; bj < 2; ++bj) { const int col = col0 + bj * HALF; const int b = col >> 11, sq = col & (SEQ - 1);
                    bf16_t* tp = O + ((size_t)((((gh >> 3) * 8 + b) * 8 + (gh & 7)) * 32 + (sq >> 6)) * 128 + d) * 64 + (sq & 48);
                    const f32x4 v0 = acc[ai][bj][m][0], v1 = acc[ai][bj][m][1];
                    u32x2 w0, w1; w0.x = cvt_pk_bf16(v0[0], v0[1]); w0.y = cvt_pk_bf16(v0[2], v0[3]); w1.x = cvt_pk_bf16(v1[0], v1[1]); w1.y = cvt_pk_bf16(v1[2], v1[3]);
                    *(u32x2*)(tp + p0) = w0; *(u32x2*)(tp + p1) = w1; } }
    }
};
struct EpiRes {
    static constexpr bool PERM = true, AFTER_DRAIN = false;
    const float* x; bf16_t* hb; float* ss;
    __device__ __forceinline__ void operator()(const f32x4 (&acc)[2][2][4][2], const Unit& u, int wr, int wc, int fr, int fq) const {
        const int row0 = u.pm * BM + wr * 64 + fr; const int col0 = u.pn * BM + wc * 32 + 8 * fq;
#pragma unroll
        for (int ai = 0; ai < 2; ++ai)
#pragma unroll
            for (int m = 0; m < 4; ++m) { const int row = row0 + ai * HALF + m * 16; const size_t off = (size_t)row * DM + col0; float q = 0.f;
#pragma unroll
                for (int bj = 0; bj < 2; ++bj) { const size_t o2 = off + bj * HALF;
                    const f32x4 h0 = *(const f32x4*)(x + o2) + acc[ai][bj][m][0], h1 = *(const f32x4*)(x + o2 + 4) + acc[ai][bj][m][1];
                    u32x4 w; w.x = cvt_pk_bf16(h0[0], h0[1]); w.y = cvt_pk_bf16(h0[2], h0[3]); w.z = cvt_pk_bf16(h1[0], h1[1]); w.w = cvt_pk_bf16(h1[2], h1[3]);
                    *(u32x4*)(hb + o2) = w;
                    q += ((h0[0] * h0[0] + h0[1] * h0[1]) + (h0[2] * h0[2] + h0[3] * h0[3])) + ((h1[0] * h1[0] + h1[1] * h1[1]) + (h1[2] * h1[2] + h1[3] * h1[3])); }
                q += __shfl_xor(q, 16); q += __shfl_xor(q, 32);
                if (fq == 0) atomicAdd(ss + row, q); }
    }
};
struct EpiGate {
    static constexpr bool PERM = true, AFTER_DRAIN = false;
    const bf16_t* hb; bf16_t* h2b; const bf16_t* ple; const float* ss2; float* ss3;
    __device__ __forceinline__ void operator()(const f32x4 (&acc)[2][2][4][2], const Unit& u, int wr, int wc, int fr, int fq) const {
        const int row0 = u.pm * BM + wr * 64 + fr; const int col0 = u.pn * BM + wc * 32 + 8 * fq;
#pragma unroll
        for (int ai = 0; ai < 2; ++ai)
#pragma unroll
            for (int m = 0; m < 4; ++m) { const int row = row0 + ai * HALF + m * 16; const size_t off = (size_t)row * DM + col0; float q = 0.f;
                const float rstd = rsqrtf(ss2[row] * (1.f / DM) + NORM_EPS);
#pragma unroll
                for (int bj = 0; bj < 2; ++bj) { const size_t o2 = off + bj * HALF; const u32x4 hw = *(const u32x4*)(hb + o2); const u32x4 pw = *(const u32x4*)(ple + o2);
                    const f32x4 a0 = acc[ai][bj][m][0] * rstd, a1 = acc[ai][bj][m][1] * rstd; f32x4 g0, g1;
                    g0[0] = bf_lo(hw.x) + sigmoid_f(a0[0]) * bf_lo(pw.x); g0[1] = bf_hi(hw.x) + sigmoid_f(a0[1]) * bf_hi(pw.x);
                    g0[2] = bf_lo(hw.y) + sigmoid_f(a0[2]) * bf_lo(pw.y); g0[3] = bf_hi(hw.y) + sigmoid_f(a0[3]) * bf_hi(pw.y);
                    g1[0] = bf_lo(hw.z) + sigmoid_f(a1[0]) * bf_lo(pw.z); g1[1] = bf_hi(hw.z) + sigmoid_f(a1[1]) * bf_hi(pw.z);
                    g1[2] = bf_lo(hw.w) + sigmoid_f(a1[2]) * bf_lo(pw.w); g1[3] = bf_hi(hw.w) + sigmoid_f(a1[3]) * bf_hi(pw.w);
                    u32x4 w2; w2.x = cvt_pk_bf16(g0[0], g0[1]); w2.y = cvt_pk_bf16(g0[2], g0[3]); w2.z = cvt_pk_bf16(g1[0], g1[1]); w2.w = cvt_pk_bf16(g1[2], g1[3]);
                    *(u32x4*)(h2b + o2) = w2;
                    q += ((g0[0] * g0[0] + g0[1] * g0[1]) + (g0[2] * g0[2] + g0[3] * g0[3])) + ((g1[0] * g1[0] + g1[1] * g1[1]) + (g1[2] * g1[2] + g1[3] * g1[3])); }
                q += __shfl_xor(q, 16); q += __shfl_xor(q, 32);
                if (fq == 0) atomicAdd(ss3 + row, q); }
    }
};
}
namespace att {
constexpr int KP = 272, VP = 144, KT_BYTES = 64 * KP, VT_BYTES = 128 * VP, BUF_BYTES = KT_BYTES + VT_BYTES;
constexpr int FLAG_OFF = 2 * BUF_BYTES;
constexpr int XP = 132;
constexpr float R_DONE = 152.0f;

template <bool MASK>
__device__ __forceinline__ void sb_block(const f32x16& sv, int kbase, int tq, int h, float& R, bf16x8 (&pf)[2]) {
    float c[16];
#pragma unroll
    for (int i = 0; i < 16; ++i) {
        const float z = sv[i];
        const float spv = fmaxf(z, 0.f) + fast_log2(1.f + fast_exp2(-fabsf(z)));
        c[i] = (!MASK || (kbase + 8 * (i >> 2) + (i & 3) < tq)) ? spv : 0.f;
    }
    float T[4], OT[4], pr[4], suf[4];
#pragma unroll
    for (int g = 0; g < 4; ++g) { c[4 * g + 2] += c[4 * g + 3]; c[4 * g + 1] += c[4 * g + 2]; c[4 * g] += c[4 * g + 1]; T[g] = c[4 * g]; }
#pragma unroll
    for (int g = 0; g < 4; ++g) { OT[g] = __shfl_xor(T[g], 32); pr[g] = T[g] + OT[g]; }
    suf[3] = 0.f; suf[2] = pr[3]; suf[1] = suf[2] + pr[2]; suf[0] = suf[1] + pr[1];
    float w[16];
#pragma unroll
    for (int g = 0; g < 4; ++g) { const float off = R + suf[g] + (h == 0 ? OT[g] : 0.f);
#pragma unroll
        for (int j = 0; j < 4; ++j) { const int i = 4 * g + j; const float e = fast_exp2(sv[i] - (off + c[i])); w[i] = (!MASK || (kbase + 8 * (i >> 2) + (i & 3) < tq)) ? e : 0.f; } }
    R += suf[0] + pr[0];
#pragma unroll
    for (int sp = 0; sp < 2; ++sp) { u32x4 p; p.x = cvt_pk(w[8 * sp], w[8 * sp + 1]); p.y = cvt_pk(w[8 * sp + 2], w[8 * sp + 3]); p.z = cvt_pk(w[8 * sp + 4], w[8 * sp + 5]); p.w = cvt_pk(w[8 * sp + 6], w[8 * sp + 7]);
        pf[sp] = __builtin_bit_cast(bf16x8, p); }
}

template <int MODE>
__device__ __forceinline__ void attn_unit(LAS unsigned char* lds, const bf16_t* __restrict__ PROJ, const bf16_t* __restrict__ KIMG, const bf16_t* __restrict__ VT, bf16_t* __restrict__ MIXED,
                                          int b, int hh, int qblk, float lam, const float* __restrict__ subln_g) {
    constexpr int QB = MODE == 0 ? 256 : 128;
    constexpr int NKS = MODE == 0 ? 8 : 4;
    const int tid = opaque_tid(), lane = tid & 63, r = lane & 31, h = lane >> 5;
    const int wid = __builtin_amdgcn_readfirstlane(tid >> 6);
    const int qg = MODE == 0 ? wid : (wid & 3), role = MODE == 0 ? 0 : (wid >> 2);
    const int Q0 = qblk * QB, q0w = Q0 + 32 * qg, tq = q0w + r;
    const size_t tokbase = (size_t)b * SEQ;
    const int gbh = ((MODE == 0 ? 0 : 8) + b) * 8 + hh;
    const bf16_t* Kg = KIMG + (size_t)gbh * SEQ * 128;
    const bf16_t* Vg = VT + (size_t)gbh * 32 * 8192;
    bf16x8 qf[NKS];
    { const bf16_t* qp = PROJ + (tokbase + tq) * NPROJ + (MODE == 0 ? PQ_SB + hh * 128 : PQ_DF + hh * 128 + role * 64) + 8 * h;
#pragma unroll
      for (int ks = 0; ks < NKS; ++ks) qf[ks] = *(const bf16x8*)(qp + 16 * ks); }
    f32x16 o[4];
#pragma unroll
    for (int d = 0; d < 4; ++d)
#pragma unroll
        for (int i = 0; i < 16; ++i) o[d][i] = 0.f;
    float R = 0.f, m_run = -1e30f, l_run = 0.f;
    const int kr0 = tid >> 4, kc = tid & 15, vr0 = tid >> 3, vc = tid & 7;
    const int kst = kr0 * KP + kc * 16, vst = KT_BYTES + vr0 * VP + vc * 16;
    const bf16_t* kgl = Kg + tid * 8;
    const bf16_t* vgl = Vg + tid * 8;
    u32x4 kreg[2], vreg[2];
#define ATT_LOAD(t) do { _Pragma("unroll") for (int i_ = 0; i_ < 2; ++i_) { \
        kreg[i_] = *(const u32x4*)(kgl + (size_t)(t) * 8192 + i_ * 4096); \
        vreg[i_] = *(const u32x4*)(vgl + (size_t)(t) * 8192 + i_ * 4096); } } while (0)
#define ATT_STORE(bo) do { _Pragma("unroll") for (int i_ = 0; i_ < 2; ++i_) { \
        *(LAS u32x4*)(lds + (bo) + kst + i_ * 32 * KP) = kreg[i_]; \
        *(LAS u32x4*)(lds + (bo) + vst + i_ * 64 * VP) = vreg[i_]; } } while (0)
    const int tl = (Q0 + QB - 1) >> 6;
    const int kfrag = r * KP + (role * 64 + 8 * h) * 2;
    const int vfrag = KT_BYTES + r * VP + (8 * h) * 2;
    volatile LAS int* flags = (volatile LAS int*)(lds + FLAG_OFF);
    __syncthreads();
    ATT_LOAD(tl); ATT_STORE(0);
    __syncthreads();
    int cur = 0, it = 0;
    bool wdone = false;
    for (int t = tl;; --t, ++it) {
        if (t > 0) ATT_LOAD(t - 1);
        const int k0 = 64 * t;
        const bool active = (MODE == 0) ? (!wdone && k0 <= q0w + 30) : (k0 <= q0w + 31);
        if (active) {
            const int bo = cur * BUF_BYTES;
            f32x16 s[2];
            bf16x8 vf[4][2][2];
            if (MODE == 1) {
                bf16x8 kf[2][NKS];
#pragma unroll
                for (int kb = 0; kb < 2; ++kb)
#pragma unroll
                    for (int ks = 0; ks < NKS; ++ks) kf[kb][ks] = *(const LAS bf16x8*)(lds + bo + kfrag + kb * 32 * KP + ks * 32);
                __builtin_amdgcn_sched_barrier(0);
#pragma unroll
                for (int kb = 0; kb < 2; ++kb) {
#pragma unroll
                    for (int i = 0; i < 16; ++i) s[kb][i] = 0.f;
#pragma unroll
                    for (int ks = 0; ks < NKS; ++ks) s[kb] = __builtin_amdgcn_mfma_f32_32x32x16_bf16(kf[kb][ks], qf[ks], s[kb], 0, 0, 0);
                }
                __builtin_amdgcn_sched_barrier(0);
#pragma unroll
                for (int d = 0; d < 2; ++d)
#pragma unroll
                    for (int kb = 0; kb < 2; ++kb)
#pragma unroll
                        for (int sp = 0; sp < 2; ++sp) vf[d][kb][sp] = *(const LAS bf16x8*)(lds + bo + vfrag + d * 32 * VP + (32 * kb + 16 * sp) * 2);
                __builtin_amdgcn_sched_barrier(0);
            } else {
#pragma unroll
                for (int kb = 0; kb < 2; ++kb) {
#pragma unroll
                    for (int i = 0; i < 16; ++i) s[kb][i] = 0.f;
#pragma unroll
                    for (int ks = 0; ks < NKS; ++ks) {
                        const bf16x8 a = *(const LAS bf16x8*)(lds + bo + kfrag + kb * 32 * KP + ks * 32);
                        s[kb] = __builtin_amdgcn_mfma_f32_32x32x16_bf16(a, qf[ks], s[kb], 0, 0, 0);
                    }
                }
            }
            bf16x8 pf[2][2];
            if (MODE == 0) {
                { sb_block<true>(s[1], k0 + 32 + 4 * h, tq, h, R, pf[1]); sb_block<true>(s[0], k0 + 4 * h, tq, h, R, pf[0]); }
                wdone = __all(R >= R_DONE);
            } else {
                float mx = -1e30f;
                if (k0 + 63 > q0w) {
#pragma unroll
                    for (int kb = 0; kb < 2; ++kb) { const int kbase = k0 + 32 * kb + 4 * h;
#pragma unroll
                        for (int i = 0; i < 16; ++i) { const int key = kbase + 8 * (i >> 2) + (i & 3); const float v = (key <= tq) ? s[kb][i] : -1e30f; s[kb][i] = v; mx = fmaxf(mx, v); } }
                } else {
#pragma unroll
                    for (int kb = 0; kb < 2; ++kb)
#pragma unroll
                        for (int i = 0; i < 16; ++i) mx = fmaxf(mx, s[kb][i]);
                }
                mx = fmaxf(mx, __shfl_xor(mx, 32));
                const float m_new = fmaxf(m_run, mx), alpha = fast_exp2(m_run - m_new);
                m_run = m_new;
                float ls = 0.f;
#pragma unroll
                for (int kb = 0; kb < 2; ++kb) {
#pragma unroll
                    for (int i = 0; i < 16; ++i) { const float p = fast_exp2(s[kb][i] - m_new); s[kb][i] = p; ls += p; }
#pragma unroll
                    for (int sp = 0; sp < 2; ++sp) { u32x4 p; p.x = cvt_pk(s[kb][8 * sp], s[kb][8 * sp + 1]); p.y = cvt_pk(s[kb][8 * sp + 2], s[kb][8 * sp + 3]); p.z = cvt_pk(s[kb][8 * sp + 4], s[kb][8 * sp + 5]); p.w = cvt_pk(s[kb][8 * sp + 6], s[kb][8 * sp + 7]);
                        pf[kb][sp] = __builtin_bit_cast(bf16x8, p); }
                }
                l_run = l_run * alpha + ls;
                if (!__all(alpha == 1.f)) {
#pragma unroll
                    for (int d = 0; d < 4; ++d)
#pragma unroll
                        for (int i = 0; i < 16; ++i) o[d][i] *= alpha;
                }
            }
            if (MODE == 1) {
                __builtin_amdgcn_sched_barrier(0);
#pragma unroll
                for (int d = 2; d < 4; ++d)
#pragma unroll
                    for (int kb = 0; kb < 2; ++kb)
#pragma unroll
                        for (int sp = 0; sp < 2; ++sp) vf[d][kb][sp] = *(const LAS bf16x8*)(lds + bo + vfrag + d * 32 * VP + (32 * kb + 16 * sp) * 2);
                __builtin_amdgcn_sched_barrier(0);
            }
#pragma unroll
            for (int d = 0; d < 4; ++d)
#pragma unroll
                for (int kb = 0; kb < 2; ++kb)
#pragma unroll
                    for (int sp = 0; sp < 2; ++sp) {
                        const bf16x8 a = (MODE == 1) ? vf[d][kb][sp] : *(const LAS bf16x8*)(lds + bo + vfrag + d * 32 * VP + (32 * kb + 16 * sp) * 2);
                        o[d] = __builtin_amdgcn_mfma_f32_32x32x16_bf16(a, pf[kb][sp], o[d], 0, 0, 0);
                    }
        }
        if (t > 0) ATT_STORE((cur ^ 1) * BUF_BYTES);
        if (MODE == 0) { if (lane == 0) flags[(it & 1) * 8 + wid] = wdone ? 1 : 0; }
        __syncthreads();
        if (t == 0) break;
        if (MODE == 0) { int alld = 1;
#pragma unroll
            for (int w2 = 0; w2 < 8; ++w2) alld &= flags[(it & 1) * 8 + w2];
            if (alld) break; }
        cur ^= 1;
    }
#undef ATT_LOAD
#undef ATT_STORE
    const int erow = lane >> 4, ech = lane & 15;
    const size_t tok0 = tokbase + q0w;
    if (MODE == 0 || role == 0) {
    }
    u32x4 gw[8];
    if (MODE == 0 || role == 0) {
        const bf16_t* gp = PROJ + (tok0 + erow) * NPROJ + (MODE == 0 ? PG_SB : PG_DF) + hh * 128 + ech * 8;
#pragma unroll
        for (int i = 0; i < 8; ++i) gw[i] = *(const u32x4*)(gp + (size_t)(4 * i) * NPROJ);
    }
    LAS unsigned char* stg = lds + (MODE == 0 ? wid * 8704 : 69632 + qg * 8704);
    if (MODE == 0) {
#pragma unroll
        for (int d = 0; d < 4; ++d)
#pragma unroll
            for (int g = 0; g < 4; ++g) { u32x2 w; w.x = cvt_pk(o[d][4 * g], o[d][4 * g + 1]); w.y = cvt_pk(o[d][4 * g + 2], o[d][4 * g + 3]);
                *(LAS u32x2*)(stg + r * 272 + (32 * d + 8 * g + 4 * h) * 2) = w; }
    } else {
        const float lt = l_run + __shfl_xor(l_run, 32);
        const float inv = 1.f / lt;
        LAS float* xq = (LAS float*)lds + (qg * 32 + r) * XP + 4 * h;
        if (role == 1) {
            const float f = inv * lam;
#pragma unroll
            for (int d = 0; d < 4; ++d)
#pragma unroll
                for (int g = 0; g < 4; ++g) *(LAS f32x4*)(xq + 32 * d + 8 * g) = (f32x4){o[d][4 * g] * f, o[d][4 * g + 1] * f, o[d][4 * g + 2] * f, o[d][4 * g + 3] * f};
        }
        __syncthreads();
        if (role == 0) {
            float q = 0.f;
#pragma unroll
            for (int d = 0; d < 4; ++d)
#pragma unroll
                for (int g = 0; g < 4; ++g) { const f32x4 x2 = *(const LAS f32x4*)(xq + 32 * d + 8 * g);
#pragma unroll
                    for (int j = 0; j < 4; ++j) { const float v = o[d][4 * g + j] * inv - x2[j]; o[d][4 * g + j] = v; q += v * v; } }
            q += __shfl_xor(q, 32);
            const float rs = rsqrtf(q * (1.f / 128.f) + SUBLN_EPS) * (1.f - LAMBDA_INIT);
            const float* sg = subln_g + 4 * h;
#pragma unroll
            for (int d = 0; d < 4; ++d)
#pragma unroll
                for (int g = 0; g < 4; ++g) { const f32x4 sv = *(const f32x4*)(sg + 32 * d + 8 * g);
                    u32x2 w; w.x = cvt_pk(o[d][4 * g] * rs * sv[0], o[d][4 * g + 1] * rs * sv[1]); w.y = cvt_pk(o[d][4 * g + 2] * rs * sv[2], o[d][4 * g + 3] * rs * sv[3]);
                    *(LAS u32x2*)(stg + r * 272 + (32 * d + 8 * g + 4 * h) * 2) = w; }
        }
    }
    if (MODE == 0 || role == 0) {
        asm volatile("s_waitcnt lgkmcnt(0)" ::: "memory");
        bf16_t* op = MIXED + (tok0 + erow) * DM + (MODE == 0 ? 0 : 1024) + hh * 128 + ech * 8;
#pragma unroll
        for (int i = 0; i < 8; ++i) { const u32x4 ov = *(const LAS u32x4*)(stg + (4 * i + erow) * 272 + ech * 16); const u32x4 g4 = gw[i];
            u32x4 w; w.x = cvt_pk(bf_lo(ov.x) * bf_lo(g4.x), bf_hi(ov.x) * bf_hi(g4.x)); w.y = cvt_pk(bf_lo(ov.y) * bf_lo(g4.y), bf_hi(ov.y) * bf_hi(g4.y));
            w.z = cvt_pk(bf_lo(ov.z) * bf_lo(g4.z), bf_hi(ov.z) * bf_hi(g4.z)); w.w = cvt_pk(bf_lo(ov.w) * bf_lo(g4.w), bf_hi(ov.w) * bf_hi(g4.w));
            *(u32x4*)(op + (size_t)(4 * i) * DM) = w; }
    }
}

__device__ __forceinline__ void attn_unit_df(LAS unsigned char* lds, const bf16_t* __restrict__ PROJ, const bf16_t* __restrict__ KIMG, const bf16_t* __restrict__ VT, bf16_t* __restrict__ MIXED,
                                             int b, int hh, int qblk, float lam, const float* __restrict__ subln_g) {
    constexpr int VB0 = 2 * KT_BYTES;
    const int tid = opaque_tid(), lane = tid & 63, r = lane & 31, h = lane >> 5;
    const int wid = __builtin_amdgcn_readfirstlane(tid >> 6);
    const int qg = wid & 3, role = wid >> 2;
    const int Q0 = qblk * 128, q0w = Q0 + 32 * qg, tq = q0w + r;
    const size_t tokbase = (size_t)b * SEQ;
    const int gbh = (8 + b) * 8 + hh;
    const bf16_t* Kg = KIMG + (size_t)gbh * SEQ * 128;
    const bf16_t* Vg = VT + (size_t)gbh * 32 * 8192;
    bf16x8 qf[4];
    { const bf16_t* qp = PROJ + (tokbase + tq) * NPROJ + PQ_DF + hh * 128 + role * 64 + 8 * h;
#pragma unroll
      for (int ks = 0; ks < 4; ++ks) qf[ks] = *(const bf16x8*)(qp + 16 * ks); }
    f32x16 o[4];
#pragma unroll
    for (int d = 0; d < 4; ++d)
#pragma unroll
        for (int i = 0; i < 16; ++i) o[d][i] = 0.f;
    float m_run = -1e30f, l_run = 0.f, alpha = 1.f;
    const int kr0 = tid >> 4, kc = tid & 15, vr0 = tid >> 3, vc = tid & 7;
    const int kst = kr0 * KP + kc * 16, vst = vr0 * VP + vc * 16;
    const bf16_t* kgl = Kg + tid * 8;
    const bf16_t* vgl = Vg + tid * 8;
    u32x4 kreg[2], vreg[2];
#define DF_LOAD(t) do { _Pragma("unroll") for (int i_ = 0; i_ < 2; ++i_) { \
        kreg[i_] = *(const u32x4*)(kgl + (size_t)(t) * 8192 + i_ * 4096); \
        vreg[i_] = *(const u32x4*)(vgl + (size_t)(t) * 8192 + i_ * 4096); } } while (0)
#define DF_STORE(ko, vo) do { _Pragma("unroll") for (int i_ = 0; i_ < 2; ++i_) { \
        *(LAS u32x4*)(lds + (ko) + kst + i_ * 32 * KP) = kreg[i_]; \
        *(LAS u32x4*)(lds + (vo) + vst + i_ * 64 * VP) = vreg[i_]; } } while (0)
#define DF_VLOAD(vo) do { _Pragma("unroll") for (int d_ = 0; d_ < 4; ++d_) _Pragma("unroll") for (int kb_ = 0; kb_ < 2; ++kb_) _Pragma("unroll") for (int sp_ = 0; sp_ < 2; ++sp_) \
        vf[d_][kb_][sp_] = *(const LAS bf16x8*)(lds + (vo) + vfrag + d_ * 32 * VP + (32 * kb_ + 16 * sp_) * 2); } while (0)
#define DF_PV() do { _Pragma("unroll") for (int d_ = 0; d_ < 4; ++d_) _Pragma("unroll") for (int kb_ = 0; kb_ < 2; ++kb_) _Pragma("unroll") for (int sp_ = 0; sp_ < 2; ++sp_) \
        o[d_] = __builtin_amdgcn_mfma_f32_32x32x16_bf16(vf[d_][kb_][sp_], pf[kb_][sp_], o[d_], 0, 0, 0); } while (0)
#define DF_RESCALE() do { if (!__all(alpha == 1.f)) { _Pragma("unroll") for (int d_ = 0; d_ < 4; ++d_) _Pragma("unroll") for (int i_ = 0; i_ < 16; ++i_) o[d_][i_] *= alpha; } } while (0)
    const int tl = (Q0 + 127) >> 6, NT = tl + 1;
    const int kfrag = r * KP + (role * 64 + 8 * h) * 2;
    const int vfrag = r * VP + (8 * h) * 2;
    __syncthreads();
    DF_LOAD(tl); DF_STORE(0, VB0);
    __syncthreads();
    bool have_p = false;
    bf16x8 pf[2][2];
    for (int i = 0; i < NT; ++i) {
        const int t = tl - i, k0 = 64 * t;
        if (t > 0) DF_LOAD(t - 1);
        if (k0 <= q0w + 31) {
            const int ko = (i & 1) * KT_BYTES;
            bf16x8 kf[2][4];
#pragma unroll
            for (int kb = 0; kb < 2; ++kb)
#pragma unroll
                for (int ks = 0; ks < 4; ++ks) kf[kb][ks] = *(const LAS bf16x8*)(lds + ko + kfrag + kb * 32 * KP + ks * 32);
            f32x16 s[2];
#pragma unroll
            for (int kb = 0; kb < 2; ++kb) {
#pragma unroll
                for (int j = 0; j < 16; ++j) s[kb][j] = 0.f;
#pragma unroll
                for (int ks = 0; ks < 4; ++ks) s[kb] = __builtin_amdgcn_mfma_f32_32x32x16_bf16(kf[kb][ks], qf[ks], s[kb], 0, 0, 0);
            }
            if (!have_p) {
                float mx = -1e30f;
#pragma unroll
                for (int kb = 0; kb < 2; ++kb) { const int kbase = k0 + 32 * kb + 4 * h;
#pragma unroll
                    for (int j = 0; j < 16; ++j) { const int key = kbase + 8 * (j >> 2) + (j & 3); const float v = (key <= tq) ? s[kb][j] : -1e30f; s[kb][j] = v; mx = fmaxf(mx, v); } }
                mx = fmaxf(mx, __shfl_xor(mx, 32));
                m_run = mx; alpha = 1.f;
                float ls = 0.f;
#pragma unroll
                for (int kb = 0; kb < 2; ++kb) {
#pragma unroll
                    for (int j = 0; j < 16; ++j) { const float p = fast_exp2(s[kb][j] - mx); s[kb][j] = p; ls += p; }
#pragma unroll
                    for (int sp = 0; sp < 2; ++sp) { u32x4 p; p.x = cvt_pk(s[kb][8 * sp], s[kb][8 * sp + 1]); p.y = cvt_pk(s[kb][8 * sp + 2], s[kb][8 * sp + 3]); p.z = cvt_pk(s[kb][8 * sp + 4], s[kb][8 * sp + 5]); p.w = cvt_pk(s[kb][8 * sp + 6], s[kb][8 * sp + 7]);
                        pf[kb][sp] = __builtin_bit_cast(bf16x8, p); }
                }
                l_run = ls;
                have_p = true;
            } else {
                DF_RESCALE();
                const int vo = VB0 + ((i + 2) % 3) * VT_BYTES;
                bf16x8 vf[2][2][2];
                bf16x8 pn[2][2]; u32x4 pw[2][2];
                float mx = -1e30f, ls = 0.f, m_new = 0.f;
#define DF_VL(g) do { _Pragma("unroll") for (int kb_ = 0; kb_ < 2; ++kb_) _Pragma("unroll") for (int sp_ = 0; sp_ < 2; ++sp_) \
        vf[(g) & 1][kb_][sp_] = *(const LAS bf16x8*)(lds + vo + vfrag + (g) * 32 * VP + (32 * kb_ + 16 * sp_) * 2); } while (0)
#define DF_MF(k) o[(k) >> 2] = __builtin_amdgcn_mfma_f32_32x32x16_bf16(vf[((k) >> 2) & 1][((k) >> 1) & 1][(k) & 1], pf[((k) >> 1) & 1][(k) & 1], o[(k) >> 2], 0, 0, 0)
#define DF_S(e) s[(e) >> 4][(e) & 15]
                DF_VL(0); DF_VL(1);
                __builtin_amdgcn_sched_barrier(0);
                DF_MF(0);
                mx = fmaxf(fmaxf(mx, DF_S(0)), DF_S(1));
                mx = fmaxf(fmaxf(mx, DF_S(2)), DF_S(3));
                mx = fmaxf(fmaxf(mx, DF_S(4)), DF_S(5));
                mx = fmaxf(fmaxf(mx, DF_S(6)), DF_S(7));
                __builtin_amdgcn_sched_barrier(0);
                DF_MF(1);
                mx = fmaxf(fmaxf(mx, DF_S(8)), DF_S(9));
                mx = fmaxf(fmaxf(mx, DF_S(10)), DF_S(11));
                mx = fmaxf(fmaxf(mx, DF_S(12)), DF_S(13));
                mx = fmaxf(fmaxf(mx, DF_S(14)), DF_S(15));
                __builtin_amdgcn_sched_barrier(0);
                DF_MF(2);
                mx = fmaxf(fmaxf(mx, DF_S(16)), DF_S(17));
                mx = fmaxf(fmaxf(mx, DF_S(18)), DF_S(19));
                mx = fmaxf(fmaxf(mx, DF_S(20)), DF_S(21));
                mx = fmaxf(fmaxf(mx, DF_S(22)), DF_S(23));
                __builtin_amdgcn_sched_barrier(0);
                DF_MF(3);
                mx = fmaxf(fmaxf(mx, DF_S(24)), DF_S(25));
                mx = fmaxf(fmaxf(mx, DF_S(26)), DF_S(27));
                mx = fmaxf(fmaxf(mx, DF_S(28)), DF_S(29));
                mx = fmaxf(fmaxf(mx, DF_S(30)), DF_S(31));
                { auto rr = __builtin_amdgcn_permlane32_swap(__float_as_uint(mx), __float_as_uint(mx), false, false); mx = fmaxf(__uint_as_float(rr[0]), __uint_as_float(rr[1])); }
                m_new = fmaxf(m_run, mx); alpha = fast_exp2(m_run - m_new); m_run = m_new;
                __builtin_amdgcn_sched_barrier(0);
                DF_VL(2);
                DF_MF(4);
                { const float p = fast_exp2(DF_S(0) - m_new); DF_S(0) = p; ls += p; }
                { const float p = fast_exp2(DF_S(1) - m_new); DF_S(1) = p; ls += p; }
                pw[0][0][0] = cvt_pk(DF_S(0), DF_S(1));
                { const float p = fast_exp2(DF_S(2) - m_new); DF_S(2) = p; ls += p; }
                __builtin_amdgcn_sched_barrier(0);
                DF_MF(5);
                { const float p = fast_exp2(DF_S(3) - m_new); DF_S(3) = p; ls += p; }
                pw[0][0][1] = cvt_pk(DF_S(2), DF_S(3));
                { const float p = fast_exp2(DF_S(4) - m_new); DF_S(4) = p; ls += p; }
                { const float p = fast_exp2(DF_S(5) - m_new); DF_S(5) = p; ls += p; }
                pw[0][0][2] = cvt_pk(DF_S(4), DF_S(5));
                __builtin_amdgcn_sched_barrier(0);
                DF_MF(6);
                { const float p = fast_exp2(DF_S(6) - m_new); DF_S(6) = p; ls += p; }
                { const float p = fast_exp2(DF_S(7) - m_new); DF_S(7) = p; ls += p; }
                pw[0][0][3] = cvt_pk(DF_S(6), DF_S(7));
                { const float p = fast_exp2(DF_S(8) - m_new); DF_S(8) = p; ls += p; }
                __builtin_amdgcn_sched_barrier(0);
                DF_MF(7);
                { const float p = fast_exp2(DF_S(9) - m_new); DF_S(9) = p; ls += p; }
                pw[0][1][0] = cvt_pk(DF_S(8), DF_S(9));
                { const float p = fast_exp2(DF_S(10) - m_new); DF_S(10) = p; ls += p; }
                { const float p = fast_exp2(DF_S(11) - m_new); DF_S(11) = p; ls += p; }
                pw[0][1][1] = cvt_pk(DF_S(10), DF_S(11));
                __builtin_amdgcn_sched_barrier(0);
                DF_VL(3);
                DF_MF(8);
                { const float p = fast_exp2(DF_S(12) - m_new); DF_S(12) = p; ls += p; }
                { const float p = fast_exp2(DF_S(13) - m_new); DF_S(13) = p; ls += p; }
                pw[0][1][2] = cvt_pk(DF_S(12), DF_S(13));
                { const float p = fast_exp2(DF_S(14) - m_new); DF_S(14) = p; ls += p; }
                __builtin_amdgcn_sched_barrier(0);
                DF_MF(9);
                { const float p = fast_exp2(DF_S(15) - m_new); DF_S(15) = p; ls += p; }
                pw[0][1][3] = cvt_pk(DF_S(14), DF_S(15));
                { const float p = fast_exp2(DF_S(16) - m_new); DF_S(16) = p; ls += p; }
                { const float p = fast_exp2(DF_S(17) - m_new); DF_S(17) = p; ls += p; }
                pw[1][0][0] = cvt_pk(DF_S(16), DF_S(17));
                __builtin_amdgcn_sched_barrier(0);
                DF_MF(10);
                { const float p = fast_exp2(DF_S(18) - m_new); DF_S(18) = p; ls += p; }
                { const float p = fast_exp2(DF_S(19) - m_new); DF_S(19) = p; ls += p; }
                pw[1][0][1] = cvt_pk(DF_S(18), DF_S(19));
                { const float p = fast_exp2(DF_S(20) - m_new); DF_S(20) = p; ls += p; }
                __builtin_amdgcn_sched_barrier(0);
                DF_MF(11);
                { const float p = fast_exp2(DF_S(21) - m_new); DF_S(21) = p; ls += p; }
                pw[1][0][2] = cvt_pk(DF_S(20), DF_S(21));
                { const float p = fast_exp2(DF_S(22) - m_new); DF_S(22) = p; ls += p; }
                { const float p = fast_exp2(DF_S(23) - m_new); DF_S(23) = p; ls += p; }
                pw[1][0][3] = cvt_pk(DF_S(22), DF_S(23));
                __builtin_amdgcn_sched_barrier(0);
                DF_MF(12);
                { const float p = fast_exp2(DF_S(24) - m_new); DF_S(24) = p; ls += p; }
                { const float p = fast_exp2(DF_S(25) - m_new); DF_S(25) = p; ls += p; }
                pw[1][1][0] = cvt_pk(DF_S(24), DF_S(25));
                __builtin_amdgcn_sched_barrier(0);
                DF_MF(13);
                { const float p = fast_exp2(DF_S(26) - m_new); DF_S(26) = p; ls += p; }
                { const float p = fast_exp2(DF_S(27) - m_new); DF_S(27) = p; ls += p; }
                pw[1][1][1] = cvt_pk(DF_S(26), DF_S(27));
                __builtin_amdgcn_sched_barrier(0);
                DF_MF(14);
                { const float p = fast_exp2(DF_S(28) - m_new); DF_S(28) = p; ls += p; }
                { const float p = fast_exp2(DF_S(29) - m_new); DF_S(29) = p; ls += p; }
                pw[1][1][2] = cvt_pk(DF_S(28), DF_S(29));
                __builtin_amdgcn_sched_barrier(0);
                DF_MF(15);
                { const float p = fast_exp2(DF_S(30) - m_new); DF_S(30) = p; ls += p; }
                { const float p = fast_exp2(DF_S(31) - m_new); DF_S(31) = p; ls += p; }
                pw[1][1][3] = cvt_pk(DF_S(30), DF_S(31));
                __builtin_amdgcn_sched_barrier(0);
                l_run = l_run * alpha + ls;
#pragma unroll
                for (int kb = 0; kb < 2; ++kb)
#pragma unroll
                    for (int sp = 0; sp < 2; ++sp) pf[kb][sp] = __builtin_bit_cast(bf16x8, pw[kb][sp]);
#undef DF_VL
#undef DF_MF
#undef DF_S
            }
        }
        if (t > 0) DF_STORE(((i + 1) & 1) * KT_BYTES, VB0 + ((i + 1) % 3) * VT_BYTES);
        __syncthreads();
    }
    if (have_p) {
        DF_RESCALE();
        bf16x8 vf[4][2][2];
        DF_VLOAD(VB0 + ((NT - 1) % 3) * VT_BYTES);
        DF_PV();
    }
    __syncthreads();
#undef DF_LOAD
#undef DF_STORE
#undef DF_VLOAD
#undef DF_PV
#undef DF_RESCALE
    const int erow = lane >> 4, ech = lane & 15;
    const size_t tok0 = tokbase + q0w;
    u32x4 gw[8];
    if (role == 0) {
        const bf16_t* gp = PROJ + (tok0 + erow) * NPROJ + PG_DF + hh * 128 + ech * 8;
#pragma unroll
        for (int i = 0; i < 8; ++i) gw[i] = *(const u32x4*)(gp + (size_t)(4 * i) * NPROJ);
    }
    LAS unsigned char* stg = lds + 69632 + qg * 8704;
    {
        const float lt = l_run + __shfl_xor(l_run, 32);
        const float inv = 1.f / lt;
        LAS float* xq = (LAS float*)lds + (qg * 32 + r) * XP + 4 * h;
        if (role == 1) {
            const float f = inv * lam;
#pragma unroll
            for (int d = 0; d < 4; ++d)
#pragma unroll
                for (int g = 0; g < 4; ++g) *(LAS f32x4*)(xq + 32 * d + 8 * g) = (f32x4){o[d][4 * g] * f, o[d][4 * g + 1] * f, o[d][4 * g + 2] * f, o[d][4 * g + 3] * f};
        }
        __syncthreads();
        if (role == 0) {
            float q = 0.f;
#pragma unroll
            for (int d = 0; d < 4; ++d)
#pragma unroll
                for (int g = 0; g < 4; ++g) { const f32x4 x2 = *(const LAS f32x4*)(xq + 32 * d + 8 * g);
#pragma unroll
                    for (int j = 0; j < 4; ++j) { const float v = o[d][4 * g + j] * inv - x2[j]; o[d][4 * g + j] = v; q += v * v; } }
            q += __shfl_xor(q, 32);
            const float rs = rsqrtf(q * (1.f / 128.f) + SUBLN_EPS) * (1.f - LAMBDA_INIT);
            const float* sg = subln_g + 4 * h;
#pragma unroll
            for (int d = 0; d < 4; ++d)
#pragma unroll
                for (int g = 0; g < 4; ++g) { const f32x4 sv = *(const f32x4*)(sg + 32 * d + 8 * g);
                    u32x2 w; w.x = cvt_pk(o[d][4 * g] * rs * sv[0], o[d][4 * g + 1] * rs * sv[1]); w.y = cvt_pk(o[d][4 * g + 2] * rs * sv[2], o[d][4 * g + 3] * rs * sv[3]);
                    *(LAS u32x2*)(stg + r * 272 + (32 * d + 8 * g + 4 * h) * 2) = w; }
            asm volatile("s_waitcnt lgkmcnt(0)" ::: "memory");
            bf16_t* op = MIXED + (tok0 + erow) * DM + 1024 + hh * 128 + ech * 8;
#pragma unroll
            for (int i = 0; i < 8; ++i) { const u32x4 ov = *(const LAS u32x4*)(stg + (4 * i + erow) * 272 + ech * 16); const u32x4 g4 = gw[i];
                u32x4 w; w.x = cvt_pk(bf_lo(ov.x) * bf_lo(g4.x), bf_hi(ov.x) * bf_hi(g4.x)); w.y = cvt_pk(bf_lo(ov.y) * bf_lo(g4.y), bf_hi(ov.y) * bf_hi(g4.y));
                w.z = cvt_pk(bf_lo(ov.z) * bf_lo(g4.z), bf_hi(ov.z) * bf_hi(g4.z)); w.w = cvt_pk(bf_lo(ov.w) * bf_lo(g4.w), bf_hi(ov.w) * bf_hi(g4.w));
                *(u32x4*)(op + (size_t)(4 * i) * DM) = w; }
        }
    }
}
}
#define XB_TMO      128
#define XB_XCNT(j)  (256  + 64 * (j))
#define XB_XSUB(j)  (1280 + 64 * (j))
#define XB_XGEN(j)  (2304 + 64 * (j))
#define XB_TOP      3328
#define XB_TOPGEN   3392
#define XCD_BAR_WORDS 3456
#define XB_SPIN_CAP (1u << 18)

__device__ __forceinline__ unsigned xb_ld(unsigned* p)              { return __hip_atomic_load(p, __ATOMIC_RELAXED, __HIP_MEMORY_SCOPE_AGENT); }
__device__ __forceinline__ unsigned xb_add(unsigned* p, unsigned v) { return __hip_atomic_fetch_add(p, v, __ATOMIC_RELAXED, __HIP_MEMORY_SCOPE_AGENT); }
__device__ __forceinline__ unsigned xb_xcc_id() { return (unsigned)__builtin_amdgcn_s_getreg((3 << 11) | 20) & 0xFu; }
#define XB_SPIN(cond, bar) do { unsigned _sp = 0; while (cond) { __builtin_amdgcn_s_sleep(1); \
    if ((++_sp & 255u) == 0u) { if (xb_ld(&(bar)[XB_TMO])) break; if (_sp > XB_SPIN_CAP) { atomicAdd(&(bar)[XB_TMO], 1u); break; } } } } while (0)

struct XcdBarrier {
    unsigned* bar; unsigned x;
    volatile LAS unsigned* st;
};

__device__ __forceinline__ XcdBarrier xcd_barrier_post(unsigned* bar, volatile LAS unsigned* st) {
    XcdBarrier b; b.bar = bar; b.x = xb_xcc_id(); b.st = st;
    if (threadIdx.x == 0) (void)xb_add(&bar[XB_XCNT(b.x)], 1u);
    return b;
}
__device__ __forceinline__ void xcd_barrier_complete(unsigned* bar, unsigned x, unsigned& nloc, unsigned& nx) {
    const unsigned G = gridDim.x * gridDim.y * gridDim.z;
    unsigned sum, cnt, mine, sp = 0u;
    for (;;) {
        sum = 0u; cnt = 0u; mine = 0u;
#pragma unroll
        for (unsigned j = 0; j < 16; ++j) { const unsigned c = xb_ld(&bar[XB_XCNT(j)]); sum += c; cnt += (c > 0u) ? 1u : 0u; mine = (j == x) ? c : mine; }
        if (sum == G) break;
        __builtin_amdgcn_s_sleep(1);
        if ((++sp & 255u) == 0u) { if (xb_ld(&bar[XB_TMO])) break; if (sp > XB_SPIN_CAP) { atomicAdd(&bar[XB_TMO], 1u); break; } }
    }
    nloc = mine > 0u ? mine : 1u; nx = cnt > 0u ? cnt : 1u;
}

__device__ __forceinline__ void xcd_barrier(const XcdBarrier& b) {
    asm volatile("s_waitcnt vmcnt(0)" ::: "memory");
    __syncthreads();
    if (threadIdx.x == 0) {
        unsigned* bar = b.bar;
        __builtin_amdgcn_s_waitcnt(0);
        unsigned nloc = b.st[0], nx = b.st[1];
        if (nloc == 0u) { xcd_barrier_complete(bar, b.x, nloc, nx); b.st[0] = nloc; b.st[1] = nx; }
        const unsigned old = xb_add(&bar[XB_XSUB(b.x)], 1u);
        const unsigned gen = old / nloc;
        if (old + 1u == (gen + 1u) * nloc) {
            __builtin_amdgcn_fence(__ATOMIC_RELEASE, "agent");
            asm volatile("s_waitcnt vmcnt(0)" ::: "memory");
            const unsigned og = xb_add(&bar[XB_TOP], 1u);
            const unsigned tg = og / nx;
            if (og + 1u == (tg + 1u) * nx) xb_add(&bar[XB_TOPGEN], 1u);
            else XB_SPIN(xb_ld(&bar[XB_TOPGEN]) == tg, bar);
            __builtin_amdgcn_fence(__ATOMIC_ACQUIRE, "agent");
            xb_add(&bar[XB_XGEN(b.x)], 1u);
            asm volatile("s_waitcnt vmcnt(0)" ::: "memory");
        } else {
            XB_SPIN(xb_ld(&bar[XB_XGEN(b.x)]) == gen, bar);
            __builtin_amdgcn_fence(__ATOMIC_ACQUIRE, "agent");
            asm volatile("s_waitcnt vmcnt(0)" ::: "memory");
        }
    }
    __syncthreads();
}

__device__ __forceinline__ int win_dst_row(int c) {
    const int seg = c >> 10, w = c & 1023, d6 = w & 63;
    const int wp = d6 < 16 ? (w & ~63) + (d6 < 8 ? 2 * d6 : 2 * (d6 - 8) + 1) : w;
    switch (seg) { case 0: return w; case 1: return 1024 + w; case 2: return 6144 + w; case 3: return 2048 + w;
                   case 4: return 3072 + wp; case 5: return 4096 + wp; case 6: return 7168 + w; default: return 5120 + w; }
}
struct TItem { const float* W; bf16_t* WT; const float* ks; int K, N, win, item; };
__device__ __forceinline__ void tr_load(const TItem& t, float (&v)[32], int lane) {
    const int nblk = t.N / 32, kb = t.item / nblk, nb = t.item % nblk; const float* p = t.W + (size_t)(64 * kb + (lane >> 5)) * t.N + 32 * nb + (lane & 31);
#pragma unroll
    for (int i = 0; i < 32; ++i) v[i] = p[(size_t)(2 * i) * t.N];
}
__device__ __forceinline__ void tr_write(const float (&v)[32], LAS float* scr, int lane) {
#pragma unroll
    for (int i = 0; i < 32; ++i) scr[(2 * i + (lane >> 5)) * 33 + (lane & 31)] = v[i];
}
__device__ __forceinline__ void tr_store(const TItem& t, LAS float* scr, int lane) {
    const int nblk = t.N / 32, kb = t.item / nblk, nb = t.item % nblk, k0 = 64 * kb, n0 = 32 * nb, c = lane & 7;
    f32x4 s0 = {1.f, 1.f, 1.f, 1.f}, s1 = {1.f, 1.f, 1.f, 1.f};
    if (t.ks) { s0 = *(const f32x4*)(t.ks + k0 + 8 * c); s1 = *(const f32x4*)(t.ks + k0 + 8 * c + 4); }
#pragma unroll
    for (int j = 0; j < 4; ++j) { const int n = (lane >> 3) + 8 * j; const LAS float* s = scr + (8 * c) * 33 + n;
        u32x4 o; o.x = cvt_pk(s[0 * 33] * s0[0], s[1 * 33] * s0[1]); o.y = cvt_pk(s[2 * 33] * s0[2], s[3 * 33] * s0[3]); o.z = cvt_pk(s[4 * 33] * s1[0], s[5 * 33] * s1[1]); o.w = cvt_pk(s[6 * 33] * s1[2], s[7 * 33] * s1[3]);
        const int dn = t.win ? win_dst_row(n0 + n) : (n0 + n);
        *(u32x4*)(t.WT + (size_t)dn * t.K + k0 + 8 * c) = o; }
}
__device__ __forceinline__ void rms_load(const float* __restrict__ xrow, f32x4 (&v)[8], int lane) {
    const f32x4* xr = (const f32x4*)xrow + lane;
#pragma unroll
    for (int j = 0; j < 8; ++j) v[j] = xr[64 * j];
}
__device__ __forceinline__ void rms_finish(const f32x4 (&v)[8], const f32x4 (&gv)[8], bf16_t* __restrict__ orow, int lane) {
    float s = 0.f;
#pragma unroll
    for (int j = 0; j < 8; ++j) s += (v[j][0] * v[j][0] + v[j][1] * v[j][1]) + (v[j][2] * v[j][2] + v[j][3] * v[j][3]);
    const float rstd = rsqrtf(wave_sum(s) * (1.f / DM) + NORM_EPS);
    u32x2* o8 = (u32x2*)orow + lane;
#pragma unroll
    for (int j = 0; j < 8; ++j) { u32x2 w; w.x = cvt_pk(v[j][0] * rstd * gv[j][0], v[j][1] * rstd * gv[j][1]); w.y = cvt_pk(v[j][2] * rstd * gv[j][2], v[j][3] * rstd * gv[j][3]); o8[64 * j] = w; }
}

struct Args { const float* in[14]; float* out; unsigned char* ws; };

__global__ void __launch_bounds__(512, 2) fwd_megakernel(Args a) {
    extern __shared__ __attribute__((aligned(16))) unsigned char lds_raw[];
    LAS unsigned char* lds = (LAS unsigned char*)lds_raw;
    { cg::grid_group grid = cg::this_grid(); if (a.ws == nullptr) grid.sync(); }
    const int tid = threadIdx.x, lane = tid & 63, wave = __builtin_amdgcn_readfirstlane(tid >> 6);
    const int G = gridDim.x, bx = blockIdx.x;
    const int vcu = (G % 8 == 0) ? (bx % 8) * (G / 8) + bx / 8 : bx;
    unsigned char* ws = a.ws;
    float* ss2 = (float*)(ws + WS_CTL + CTL_SS2); float* ss3 = (float*)(ws + WS_CTL + CTL_SS3); float* lamp = (float*)(ws + WS_CTL + CTL_LAM); float* rope = (float*)(ws + WS_CTL + CTL_ROPE);
    bf16_t* WIN = (bf16_t*)(ws + WS_WIN); bf16_t* WOUT = (bf16_t*)(ws + WS_WOUT); bf16_t* WGATE = (bf16_t*)(ws + WS_WGATE); bf16_t* WPROJ = (bf16_t*)(ws + WS_WPROJ);
    bf16_t* PB = (bf16_t*)(ws + WS_PB); bf16_t* XN = (bf16_t*)(ws + WS_XN); bf16_t* MIXED = (bf16_t*)(ws + WS_MIXED); bf16_t* PROJ = (bf16_t*)(ws + WS_PROJ);
    bf16_t* VT = (bf16_t*)(ws + WS_VT); bf16_t* KIMG = (bf16_t*)(ws + WS_KIMG); bf16_t* HB = (bf16_t*)(ws + WS_HB); bf16_t* PLEB = (bf16_t*)(ws + WS_PLE); bf16_t* H2B = (bf16_t*)(ws + WS_H2B);
    const float* x = a.in[0]; float* out = a.out;
    volatile LAS unsigned* xst = (volatile LAS unsigned*)(lds + 131072);
    if (tid == 0) { xst[0] = 0u; xst[1] = 0u; }
    __syncthreads();
    const XcdBarrier xb = xcd_barrier_post((unsigned*)(ws + WS_CTL + CTL_BAR), xst);

    for (int rep_ = 0; rep_ < ((PROBE_DUP & 1) ? 2 : 1); ++rep_) {
        if (rep_) __syncthreads();
        const int gw = bx * 8 + wave, NGW = G * 8; const int gt = bx * 512 + tid, NGT = G * 512;
        for (int i = gt; i < 2 * NTOK; i += NGT) ss2[i] = 0.f;
        if (gt == 0) { float s1 = 0.f, s2 = 0.f; for (int i = 0; i < 64; ++i) { s1 += a.in[4][i] * a.in[5][i]; s2 += a.in[6][i] * a.in[7][i]; } lamp[0] = expf(s1) - expf(s2) + LAMBDA_INIT; }
        for (int i = gt; i < SEQ * 8; i += NGT) { const int pos = i >> 3, f = i & 7;
            const float invf = (float)exp2(-(double)f * 0.125 * 18.931568569324174);
            const float angf = (float)pos * invf;
            const double tw = 6.283185307179586476925; double ang = (double)angf; ang -= tw * rint(ang / tw);
            rope[2 * i] = (float)cos(ang); rope[2 * i + 1] = (float)sin(ang); }
        LAS float* scr = (LAS float*)(lds + wave * 16384);
        constexpr int I_IN = (DM / 64) * (8192 / 32), I_SQ = (DM / 64) * (DM / 32), I_PR = (PLE / 64) * (DM / 32), I_ALL = I_IN + 2 * I_SQ + I_PR;
#define P0_DECODE(T, it_) do { int rr_ = (it_); \
            if (rr_ < I_IN) { T = TItem{a.in[3], WIN, nullptr, DM, 8192, 1, rr_}; } \
            else if (rr_ < I_IN + I_SQ) { T = TItem{a.in[9], WOUT, nullptr, DM, DM, 0, rr_ - I_IN}; } \
            else if (rr_ < I_IN + 2 * I_SQ) { T = TItem{a.in[11], WGATE, a.in[10], DM, DM, 0, rr_ - I_IN - I_SQ}; } \
            else { T = TItem{a.in[12], WPROJ, nullptr, PLE, DM, 0, rr_ - I_IN - 2 * I_SQ}; } } while (0)
        {
            float tv[32]; TItem cur, nxt; int it = gw;
            if (it < I_ALL) { P0_DECODE(cur, it); tr_load(cur, tv, lane); }
            while (it < I_ALL) {
                tr_write(tv, scr, lane);
                const int itn = it + NGW;
                if (itn < I_ALL) { P0_DECODE(nxt, itn); tr_load(nxt, tv, lane); }
                asm volatile("s_waitcnt lgkmcnt(0)" ::: "memory");
                tr_store(cur, scr, lane);
                asm volatile("s_waitcnt lgkmcnt(0)" ::: "memory");
                cur = nxt; it = itn;
            }
        }
#undef P0_DECODE
        {
            f32x4 gv[8], va[8], vb[8];
            { const f32x4* gr = (const f32x4*)a.in[2] + lane;
#pragma unroll
              for (int j = 0; j < 8; ++j) gv[j] = gr[64 * j]; }
            int m = gw;
            if (m < NTOK) rms_load(x + (size_t)m * DM, va, lane);
            for (; m < NTOK; m += 2 * NGW) {
                const int m1 = m + NGW, m2 = m + 2 * NGW;
                if (m1 < NTOK) rms_load(x + (size_t)m1 * DM, vb, lane);
                rms_finish(va, gv, XN + (size_t)m * DM, lane);
                if (m2 < NTOK) rms_load(x + (size_t)m2 * DM, va, lane);
                if (m1 < NTOK) rms_finish(vb, gv, XN + (size_t)m1 * DM, lane);
            }
        }
        for (int i = gt; i < NTOK * PLE / 8; i += NGT) { const f32x4 v0 = ((const f32x4*)a.in[1])[2 * i], v1 = ((const f32x4*)a.in[1])[2 * i + 1];
            u32x4 w; w.x = cvt_pk(v0[0], v0[1]); w.y = cvt_pk(v0[2], v0[3]); w.z = cvt_pk(v1[0], v1[1]); w.w = cvt_pk(v1[2], v1[3]); ((u32x4*)PB)[i] = w; }
    }
    xcd_barrier(xb);
    for (int rep_ = 0; rep_ < ((PROBE_DUP & 2) ? 2 : 1); ++rep_) {
        if (rep_) __syncthreads();
        { pg8::Gemm g{XN, WIN, NTOK, NPROJ, DM}; pg8::StaticOrder S; S.init(NTOK, NPROJ, G, bx); pg8::EpiProj E{PROJ, rope, KIMG};
          pg8::gemm_phase<pg8::EpiProj, pg8::StaticOrder, true, true>(lds, g, S, E); }
        __syncthreads();
        { pg8::Gemm g{WIN + (size_t)NPROJ * DM, XN, 2048, NTOK, DM}; pg8::StaticOrder S; S.init(2048, NTOK, G, bx); pg8::EpiVt E{VT};
          pg8::gemm_phase<pg8::EpiVt, pg8::StaticOrder, true, true>(lds, g, S, E); }
    }
    xcd_barrier(xb);
    for (int rep_ = 0; rep_ < ((PROBE_DUP & 4) ? 2 : 1); ++rep_) {
        const float lam = lamp[0];
        for (int su = vcu; su < 256; su += G) {
            const int grp = su >> 4, j = su & 15;
#pragma unroll 1
            for (int k = 0; k < 4; ++k) { const int bh = 4 * grp + k; const int qb = (k & 1) ? 15 - j : j;
                att::attn_unit_df(lds, PROJ, KIMG, VT, MIXED, bh >> 3, bh & 7, qb, lam, a.in[8]); }
        }
#pragma unroll 1
        for (int u = vcu; u < 512; u += G) att::attn_unit<0>(lds, PROJ, KIMG, VT, MIXED, (u >> 3) >> 3, (u >> 3) & 7, u & 7, lam, a.in[8]);
    }
    xcd_barrier(xb);
    {
        __syncthreads();
        { pg8::Gemm g{MIXED, WOUT, NTOK, DM, DM}; pg8::StaticOrder S; S.init(NTOK, DM, G, bx); pg8::EpiRes E{x, HB, ss2};
          pg8::gemm_phase<pg8::EpiRes, pg8::StaticOrder, true, true>(lds, g, S, E); }
        __syncthreads();
        { pg8::Gemm g{PB, WPROJ, NTOK, DM, PLE}; pg8::StaticOrder S; S.init(NTOK, DM, G, bx); pg8::EpiBf16 E{PLEB, DM};
          pg8::gemm_phase<pg8::EpiBf16, pg8::StaticOrder, true, true>(lds, g, S, E); }
    }
    xcd_barrier(xb);
    {
        pg8::Gemm g{HB, WGATE, NTOK, DM, DM}; pg8::StaticOrder S; S.init(NTOK, DM, G, bx); pg8::EpiGate E{HB, H2B, PLEB, ss2, ss3};
        pg8::gemm_phase<pg8::EpiGate, pg8::StaticOrder, true, true>(lds, g, S, E);
    }
    xcd_barrier(xb);
    {
        const int tid5 = opaque_tid(), lane = tid5 & 63, wave = __builtin_amdgcn_readfirstlane(tid5 >> 6);
        const int gw = bx * 8 + wave, NGW = G * 8; const f32x4* gr = (const f32x4*)a.in[13];
        f32x4 gv[8];
#pragma unroll
        for (int j = 0; j < 4; ++j) { gv[2 * j] = gr[2 * (lane + 64 * j)]; gv[2 * j + 1] = gr[2 * (lane + 64 * j) + 1]; }
#define P5_LOAD(H, S_, m_) do { const u32x4* hrow_ = (const u32x4*)(H2B + (size_t)(m_) * DM); S_ = ss3[m_]; _Pragma("unroll") for (int j_ = 0; j_ < 4; ++j_) H[j_] = hrow_[lane + 64 * j_]; } while (0)
#define P5_STORE(H, S_, m_) do { const float rstd_ = rsqrtf(S_ * (1.f / DM) + NORM_EPS); f32x4* orow_ = (f32x4*)(out + (size_t)(m_) * DM); \
            _Pragma("unroll") for (int j_ = 0; j_ < 4; ++j_) { const int c_ = lane + 64 * j_; const u32x4 hw_ = H[j_]; const f32x4 g0_ = gv[2 * j_], g1_ = gv[2 * j_ + 1]; \
                orow_[2 * c_] = (f32x4){bf_lo(hw_.x) * rstd_ * g0_[0], bf_hi(hw_.x) * rstd_ * g0_[1], bf_lo(hw_.y) * rstd_ * g0_[2], bf_hi(hw_.y) * rstd_ * g0_[3]}; \
                orow_[2 * c_ + 1] = (f32x4){bf_lo(hw_.z) * rstd_ * g1_[0], bf_hi(hw_.z) * rstd_ * g1_[1], bf_lo(hw_.w) * rstd_ * g1_[2], bf_hi(hw_.w) * rstd_ * g1_[3]}; } } while (0)
        u32x4 ha[4], hb4[4]; float sa = 0.f, sb = 0.f;
        int m = gw;
        if (m < NTOK) P5_LOAD(ha, sa, m);
        for (; m < NTOK; m += 2 * NGW) {
            const int m1 = m + NGW, m2 = m + 2 * NGW;
            if (m1 < NTOK) P5_LOAD(hb4, sb, m1);
            P5_STORE(ha, sa, m);
            if (m2 < NTOK) P5_LOAD(ha, sa, m2);
            if (m1 < NTOK) P5_STORE(hb4, sb, m1);
        }
#undef P5_LOAD
#undef P5_STORE
    }
}

extern "C" void kernel_launch(void* const* d_in, const int* in_sizes, int n_in, void* d_out, int out_size, void* d_ws, size_t ws_size, hipStream_t stream) {
    static int grid = 0;
    if (grid == 0) {
        if (n_in != 14 || out_size != NTOK * DM || ws_size < WS_END) { fprintf(stderr, "kernel_launch: unexpected shapes (n_in %d out %d ws %zu)\n", n_in, out_size, ws_size); grid = -1; return; }
        int dev = 0, cus = 0, per_cu = 0;
        (void)hipGetDevice(&dev); (void)hipDeviceGetAttribute(&cus, hipDeviceAttributeMultiprocessorCount, dev);
        (void)hipFuncSetAttribute((const void*)fwd_megakernel, hipFuncAttributeMaxDynamicSharedMemorySize, LDS_BYTES);
        (void)hipOccupancyMaxActiveBlocksPerMultiprocessor(&per_cu, (const void*)fwd_megakernel, 512, LDS_BYTES);
        if (per_cu < 1) { fprintf(stderr, "kernel_launch: occupancy query says %d blocks/CU\n", per_cu); per_cu = 1; }
        grid = cus * per_cu;
    }
    if (grid < 0) return;
    Args a{};
    for (int i = 0; i < 14; ++i) a.in[i] = (const float*)d_in[i];
    a.out = (float*)d_out; a.ws = (unsigned char*)d_ws;
    (void)hipMemsetAsync((unsigned char*)d_ws + WS_CTL + CTL_BAR, 0, CTL_BAR_BYTES, stream);
    void* args[] = {&a};
    hipError_t e = hipLaunchCooperativeKernel((void*)fwd_megakernel, dim3(grid), dim3(512), args, LDS_BYTES, stream);
    if (e != hipSuccess) fprintf(stderr, "cooperative launch failed: %s (grid %d)\n", hipGetErrorString(e), grid);
}
```

```cpp
#include <hip/hip_runtime.h>
#include <hip/hip_cooperative_groups.h>
#include <cstdio>
#include <cstdint>
namespace cg = cooperative_groups;
__device__ __forceinline__ int opaque_tid() { int t = (int)threadIdx.x; asm volatile("" : "+v"(t)); return t; }
#ifndef PROBE_DUP
#define PROBE_DUP 0
#endif
namespace pg8 {
#define PG8_LAS __attribute__((address_space(3)))
typedef unsigned short bf16_t;
typedef short bf16x8 __attribute__((ext_vector_type(8)));
typedef float f32x4 __attribute__((ext_vector_type(4)));
typedef unsigned u32x4 __attribute__((ext_vector_type(4)));
constexpr int BM = 256, BK = 64, HALF = 128, HTB = HALF * BK * 2  , STAGE_BYTES = 8 * HTB, NXCD = 8, WGM = 8;

__host__ __device__ __forceinline__ int lds_byte(int r, int c) { const int st = (r >> 4) * 2 + (c >> 5), rr = r & 15, cc = c & 31, ob = rr * 64 + cc * 2; return st * 1024 + (ob ^ (((ob >> 9) & 1) << 5)); }
__host__ __device__ __forceinline__ void stage_rc(int b, int& R, int& C) { const int st = b / 1024, sb = b % 1024, swz = sb ^ (((sb >> 9) & 1) << 5); R = (st >> 1) * 16 + swz / 64; C = (st & 1) * 32 + (swz % 64) / 2; }
__host__ __device__ __forceinline__ int perm32(int rho) { const int n = rho >> 4, i = rho & 15; return 8 * (i >> 2) + 4 * n + (i & 3); }

struct Unit { int pm, pn; };
struct Gemm { const bf16_t* A; const bf16_t* Bt; int M, N, K; };

struct StaticOrder {
    int nM, nN, nwg, G, c;
    __host__ __device__ void init(int M, int N, int G_, int c_) { nM = M / BM; nN = N / BM; nwg = nM * nN; G = G_; c = c_; }
    __host__ __device__ bool next(int i, Unit& u) const {
        const long L = (long)i * G + c; if (L >= nwg) return false;
        int wgid = (int)L; { const int q = nwg / NXCD, r = nwg % NXCD, xcd = wgid % NXCD, off = wgid / NXCD; wgid = (xcd < r ? xcd * (q + 1) : r * (q + 1) + (xcd - r) * q) + off; }
        const int nig = WGM * nN, gid = wgid / nig, fm = gid * WGM, gsz = (nM - fm) < WGM ? (nM - fm) : WGM;
        u.pm = fm + ((wgid % nig) % gsz); u.pn = (wgid % nig) / gsz; return true;
    }
    __device__ __forceinline__ void a_ready(const Unit&) const {}
    __device__ __forceinline__ void done(const Unit&) const {}
};

__device__ __forceinline__ unsigned cvt_pk_bf16(float lo, float hi) { unsigned r; asm volatile("v_cvt_pk_bf16_f32 %0, %1, %2" : "=v"(r) : "v"(lo), "v"(hi)); return r; }
typedef float f32x2 __attribute__((ext_vector_type(2)));
template <class Epi, class Sched, bool ALIGN_EPI = false, bool SP2 = false>
__device__ __forceinline__ void gemm_phase(PG8_LAS unsigned char* lds, const Gemm g, const Sched& S, const Epi& E) {
    const int tid = opaque_tid(), wid = __builtin_amdgcn_readfirstlane(tid >> 6), lane = tid & 63, wr = wid >> 2, wc = wid & 3, fr = lane & 15, fq = lane >> 4;
    const int K = g.K, nt = K / BK;
    unsigned voffA[2], voffB[2];
#pragma unroll
    for (int i = 0; i < 2; ++i) { int R, C; stage_rc(tid * 16 + i * 8192, R, C); const int Rb = Epi::PERM ? ((R & ~31) + perm32(R & 31)) : R;
        voffA[i] = (unsigned)(R * K + C) * 2u; voffB[i] = (unsigned)(Rb * K + C) * 2u; }
    const size_t kstep = (size_t)(BK * 2);
    const size_t hstep = (size_t)HALF * K * 2;
    const size_t tstep = 2 * hstep;
    const unsigned ldsw = (unsigned)wid * 1024u;
    const int aoff = lds_byte(wr * 64 + fr, fq * 8), boff = lds_byte(wc * 32 + fr, fq * 8);
#define PG8_SA(b, h) (((b) * 2 + (h)) * HTB)
#define PG8_SB(b, h) ((4 + (b) * 2 + (h)) * HTB)
#define PG8_STAGE(bufoff, gbase, voff) do { _Pragma("unroll") for (int _i = 0; _i < 2; ++_i) \
        __builtin_amdgcn_global_load_lds((const unsigned*)((const char*)(gbase) + (voff)[_i]), (PG8_LAS unsigned*)(lds + (bufoff) + ldsw + _i * 8192), 16, 0, 0); } while (0)
#define PG8_LDA(dst, b, h) do { _Pragma("unroll") for (int m = 0; m < 4; ++m) _Pragma("unroll") for (int k = 0; k < 2; ++k) dst[m][k] = *(const PG8_LAS bf16x8*)(lds + PG8_SA(b, h) + aoff + m * 2048 + k * 1024); } while (0)
#define PG8_LDB(dst, b, h) do { _Pragma("unroll") for (int n = 0; n < 2; ++n) _Pragma("unroll") for (int k = 0; k < 2; ++k) dst[n][k] = *(const PG8_LAS bf16x8*)(lds + PG8_SB(b, h) + boff + n * 2048 + k * 1024); } while (0)
#define PG8_MMA(ai, bj, At, Bt) do { __builtin_amdgcn_s_setprio(1); _Pragma("unroll") for (int m = 0; m < 4; ++m) _Pragma("unroll") for (int n = 0; n < 2; ++n) _Pragma("unroll") for (int k = 0; k < 2; ++k) \
        acc[ai][bj][m][n] = __builtin_amdgcn_mfma_f32_16x16x32_bf16(Bt[n][k], At[m][k], acc[ai][bj][m][n], 0, 0, 0); __builtin_amdgcn_s_setprio(0); } while (0)
#define PG8_WAIT_V(n) asm volatile("s_waitcnt vmcnt(" #n ")" ::: "memory")
#define PG8_WAIT_L(n) asm volatile("s_waitcnt lgkmcnt(" #n ")" ::: "memory")
#define PG8_BAR __builtin_amdgcn_s_barrier()
#define PG8_SCHED __builtin_amdgcn_sched_barrier(0)
    Unit cur, nxt; int ui = 0;
    if (!S.next(0, cur)) return;
    f32x4 acc[2][2][4][2];
#pragma unroll
    for (int a = 0; a < 2; ++a)
#pragma unroll
        for (int b = 0; b < 2; ++b)
#pragma unroll
            for (int m = 0; m < 4; ++m)
#pragma unroll
                for (int n = 0; n < 2; ++n) acc[a][b][m][n] = (f32x4){0.f, 0.f, 0.f, 0.f};
    bf16x8 At[4][2], B0[2][2], B1[2][2];
    const char* cA = (const char*)g.A + (size_t)cur.pm * tstep; const char* cB = (const char*)g.Bt + (size_t)cur.pn * tstep;
    S.a_ready(cur);
    if constexpr (SP2) {
        PG8_STAGE(PG8_SB(0, 0), cB, voffB); PG8_STAGE(PG8_SB(0, 1), cB + hstep, voffB); PG8_STAGE(PG8_SA(0, 0), cA, voffA); PG8_STAGE(PG8_SA(0, 1), cA + hstep, voffA);
        if (wr == 1) PG8_BAR;
        PG8_WAIT_V(2); PG8_BAR;
        PG8_STAGE(PG8_SB(1, 0), cB + kstep, voffB); PG8_STAGE(PG8_SA(1, 0), cA + kstep, voffA); PG8_STAGE(PG8_SB(1, 1), cB + hstep + kstep, voffB);
        PG8_WAIT_V(6); PG8_BAR;
    } else {
        PG8_STAGE(PG8_SB(0, 0), cB, voffB); PG8_STAGE(PG8_SA(0, 0), cA, voffA); PG8_STAGE(PG8_SB(0, 1), cB + hstep, voffB); PG8_STAGE(PG8_SA(0, 1), cA + hstep, voffA);
        if (wr == 1) PG8_BAR;
        PG8_WAIT_V(4); PG8_BAR;
        PG8_STAGE(PG8_SB(1, 0), cB + kstep, voffB); PG8_STAGE(PG8_SA(1, 0), cA + kstep, voffA); PG8_STAGE(PG8_SB(1, 1), cB + hstep + kstep, voffB);
        PG8_WAIT_V(6); PG8_BAR;
    }
    for (;;) {
        const bool has_next = S.next(ui + 1, nxt);
        const char* nA = has_next ? (const char*)g.A + (size_t)nxt.pm * tstep : cA; const char* nB = has_next ? (const char*)g.Bt + (size_t)nxt.pn * tstep : cB;
        for (int t = 0; t < nt; t += 2) {
            const bool last = (t == nt - 2);
            const char* a1 = cA + (size_t)(t + 1) * kstep;
            const char* a2 = last ? nA : cA + (size_t)(t + 2) * kstep; const char* b2 = last ? nB : cB + (size_t)(t + 2) * kstep;
            const char* a3 = a2 + kstep; const char* b3 = b2 + kstep;
            if (last && has_next) S.a_ready(nxt);
            if constexpr (SP2) {
            PG8_LDB(B0, 0, 0); PG8_LDB(B1, 0, 1); PG8_SCHED; PG8_LDA(At, 0, 0); PG8_STAGE(PG8_SA(1, 1), a1 + hstep, voffA);
            PG8_WAIT_V(8); PG8_WAIT_L(0); PG8_BAR; PG8_MMA(0, 0, At, B0); PG8_MMA(0, 1, At, B1); PG8_BAR; PG8_SCHED;
            PG8_LDA(At, 0, 1); PG8_STAGE(PG8_SB(0, 0), b2, voffB); PG8_STAGE(PG8_SB(0, 1), b2 + hstep, voffB); PG8_STAGE(PG8_SA(0, 0), a2, voffA);
            PG8_WAIT_V(8); PG8_WAIT_L(0); PG8_BAR; PG8_MMA(1, 0, At, B0); PG8_MMA(1, 1, At, B1); PG8_BAR; PG8_SCHED;
            PG8_LDB(B0, 1, 0); PG8_LDB(B1, 1, 1); PG8_SCHED; PG8_LDA(At, 1, 0); PG8_STAGE(PG8_SA(0, 1), a2 + hstep, voffA);
            PG8_WAIT_V(8); PG8_WAIT_L(0); PG8_BAR; PG8_MMA(0, 0, At, B0); PG8_MMA(0, 1, At, B1); PG8_BAR; PG8_SCHED;
            PG8_LDA(At, 1, 1); PG8_STAGE(PG8_SB(1, 0), b3, voffB); PG8_STAGE(PG8_SB(1, 1), b3 + hstep, voffB); PG8_STAGE(PG8_SA(1, 0), a3, voffA);
            PG8_WAIT_V(8); PG8_WAIT_L(0); PG8_BAR; PG8_MMA(1, 0, At, B0); PG8_MMA(1, 1, At, B1); PG8_BAR; PG8_SCHED;
            } else {
            PG8_LDB(B0, 0, 0); PG8_SCHED; PG8_LDA(At, 0, 0); PG8_STAGE(PG8_SA(1, 1), a1 + hstep, voffA);
            PG8_WAIT_L(8); PG8_BAR; PG8_WAIT_L(0); PG8_MMA(0, 0, At, B0); PG8_BAR; PG8_SCHED;
            PG8_LDB(B1, 0, 1); PG8_STAGE(PG8_SB(0, 0), b2, voffB);
            PG8_BAR; PG8_WAIT_L(0); PG8_MMA(0, 1, At, B1); PG8_BAR;
            PG8_LDA(At, 0, 1); PG8_STAGE(PG8_SA(0, 0), a2, voffA);
            PG8_BAR; PG8_WAIT_L(0); PG8_MMA(1, 0, At, B0); PG8_BAR; PG8_SCHED;
            PG8_STAGE(PG8_SB(0, 1), b2 + hstep, voffB);
            PG8_WAIT_V(6); PG8_BAR; PG8_MMA(1, 1, At, B1); PG8_BAR;
            PG8_LDB(B0, 1, 0); PG8_SCHED; PG8_LDA(At, 1, 0); PG8_STAGE(PG8_SA(0, 1), a2 + hstep, voffA);
            PG8_WAIT_L(8); PG8_BAR; PG8_WAIT_L(0); PG8_MMA(0, 0, At, B0); PG8_BAR; PG8_SCHED;
            PG8_LDB(B1, 1, 1); PG8_STAGE(PG8_SB(1, 0), b3, voffB);
            PG8_BAR; PG8_WAIT_L(0); PG8_MMA(0, 1, At, B1); PG8_BAR;
            PG8_LDA(At, 1, 1); PG8_STAGE(PG8_SA(1, 0), a3, voffA);
            PG8_BAR; PG8_WAIT_L(0); PG8_MMA(1, 0, At, B0); PG8_BAR; PG8_SCHED;
            PG8_STAGE(PG8_SB(1, 1), b3 + hstep, voffB);
            PG8_WAIT_V(6); PG8_BAR; PG8_MMA(1, 1, At, B1); PG8_BAR;
            }
        }
        if constexpr (ALIGN_EPI) { if (wr == 0) PG8_BAR; }
        if constexpr (!Epi::AFTER_DRAIN) { E(acc, cur, wr, wc, fr, fq); S.done(cur); }
        if (!has_next) break;
#pragma unroll
        for (int a = 0; a < 2; ++a)
#pragma unroll
            for (int b = 0; b < 2; ++b)
#pragma unroll
                for (int m = 0; m < 4; ++m)
#pragma unroll
                    for (int n = 0; n < 2; ++n) acc[a][b][m][n] = (f32x4){0.f, 0.f, 0.f, 0.f};
        cur = nxt; cA = nA; cB = nB; ++ui;
        if constexpr (ALIGN_EPI) { if (wr == 1) PG8_BAR; }
    }
    PG8_WAIT_V(0);
    if constexpr (!ALIGN_EPI) { if (wr == 0) PG8_BAR; }
    PG8_BAR;
    if constexpr (Epi::AFTER_DRAIN) { E.fused(acc, cur, wr, wc, fr, fq, lds, wid, lane); S.done(cur); }
#undef PG8_SA
#undef PG8_SB
#undef PG8_STAGE
#undef PG8_LDA
#undef PG8_LDB
#undef PG8_MMA
#undef PG8_WAIT_V
#undef PG8_WAIT_L
#undef PG8_BAR
#undef PG8_SCHED
}
}
#define LAS __attribute__((address_space(3)))
typedef unsigned short bf16_t;
typedef short bf16x8 __attribute__((ext_vector_type(8)));
typedef float f32x4 __attribute__((ext_vector_type(4)));
typedef float f32x2 __attribute__((ext_vector_type(2)));
typedef float f32x16 __attribute__((ext_vector_type(16)));
typedef unsigned u32x4 __attribute__((ext_vector_type(4)));
typedef unsigned u32x2 __attribute__((ext_vector_type(2)));

constexpr int NTOK = 16384, DM = 2048, SEQ = 2048, NBATCH = 8, PLE = 256;
constexpr int NPROJ = 6144;
constexpr int PQ_SB = 0, PK_SB = 1024, PG_SB = 2048, PQ_DF = 3072, PK_DF = 4096, PG_DF = 5120;
constexpr float LOG2E = 1.4426950408889634f;
constexpr float SBQ_SCALE = 0.08838834764831845f * LOG2E;
constexpr float DFQ_SCALE = 0.125f * LOG2E;
constexpr float NORM_EPS = 1e-6f, SUBLN_EPS = 1e-5f;
constexpr float LAMBDA_INIT = 0.2f;

constexpr size_t MiB = 1u << 20;
constexpr size_t WS_CTL = 0;
constexpr size_t CTL_SS2 = 0, CTL_SS3 = 65536, CTL_LAM = 131072, CTL_ROPE = 262144, CTL_BAR = 524288, CTL_BAR_BYTES = 16384;
constexpr size_t WS_WIN = 2 * MiB, WS_WOUT = 34 * MiB, WS_WGATE = 42 * MiB, WS_WPROJ = 50 * MiB, WS_PB = 52 * MiB;
constexpr size_t WS_XN = 64 * MiB, WS_MIXED = 64 * MiB;
constexpr size_t WS_PROJ = 128 * MiB, WS_VT = 320 * MiB, WS_KIMG = 384 * MiB, WS_END = 448 * MiB;
constexpr size_t WS_HB = 128 * MiB, WS_PLE = 192 * MiB;
constexpr size_t WS_H2B = 64 * MiB;

constexpr int LDS_BYTES = 131072 + 1024;

typedef __bf16 bf16x2_t __attribute__((ext_vector_type(2)));
__device__ __forceinline__ unsigned cvt_pk(float lo, float hi) { f32x2 v = {lo, hi}; bf16x2_t b = __builtin_convertvector(v, bf16x2_t); return __builtin_bit_cast(unsigned, b); }
__device__ __forceinline__ float bf_lo(unsigned w) { return __uint_as_float(w << 16); }
__device__ __forceinline__ float bf_hi(unsigned w) { return __uint_as_float(w & 0xffff0000u); }
__device__ __forceinline__ float wave_sum(float v) {
#pragma unroll
    for (int o = 1; o < 64; o <<= 1) v += __shfl_xor(v, o);
    return v;
}
__device__ __forceinline__ float fast_exp2(float x) { return __builtin_amdgcn_exp2f(x); }
__device__ __forceinline__ float fast_log2(float x) { return __builtin_amdgcn_logf(x); }
__device__ __forceinline__ float silu_f(float x) { return x * __builtin_amdgcn_rcpf(1.f + fast_exp2(-x * LOG2E)); }
__device__ __forceinline__ float sigmoid_f(float x) { return __builtin_amdgcn_rcpf(1.f + fast_exp2(-x * LOG2E)); }

namespace pg8 {
struct EpiBf16 {
    static constexpr bool PERM = true, AFTER_DRAIN = false;
    bf16_t* O; int ldc;
    __device__ __forceinline__ void operator()(const f32x4 (&acc)[2][2][4][2], const Unit& u, int wr, int wc, int fr, int fq) const {
        const int row0 = u.pm * BM + wr * 64 + fr; const int col0 = u.pn * BM + wc * 32 + 8 * fq;
#pragma unroll
        for (int ai = 0; ai < 2; ++ai)
#pragma unroll
            for (int m = 0; m < 4; ++m) { bf16_t* rowp = O + (size_t)(row0 + ai * HALF + m * 16) * ldc + col0;
#pragma unroll
                for (int bj = 0; bj < 2; ++bj) { const f32x4 v0 = acc[ai][bj][m][0], v1 = acc[ai][bj][m][1];
                    u32x4 w; w.x = cvt_pk_bf16(v0[0], v0[1]); w.y = cvt_pk_bf16(v0[2], v0[3]); w.z = cvt_pk_bf16(v1[0], v1[1]); w.w = cvt_pk_bf16(v1[2], v1[3]);
                    *(u32x4*)(rowp + bj * HALF) = w; } }
    }
};
struct EpiProj {
    static constexpr bool PERM = true, AFTER_DRAIN = false;
    bf16_t* O; const float* rope; bf16_t* KI;
    __device__ __forceinline__ void operator()(const f32x4 (&acc)[2][2][4][2], const Unit& u, int wr, int wc, int fr, int fq) const {
        const int row0 = u.pm * BM + wr * 64 + fr; const int col0 = u.pn * BM + wc * 32 + 8 * fq;
        const int kind = u.pn >> 2;
        const bool dorope = (kind == 3 || kind == 4) && ((wc & 1) == 0) && (fq < 2);
        const float sc = kind == 0 ? SBQ_SCALE : (kind == 3 ? DFQ_SCALE : 1.f);
        const bool dosilu = (kind == 2 || kind == 5);
#pragma unroll
        for (int ai = 0; ai < 2; ++ai)
#pragma unroll
            for (int m = 0; m < 4; ++m) { const int row = row0 + ai * HALF + m * 16; bf16_t* rowp = O + (size_t)row * NPROJ + col0;
                if (kind == 1 || kind == 4) {
                    const int cw = col0 & 1023; rowp = KI + ((size_t)(((kind == 4 ? 8 : 0) + (row >> 11)) * 8 + (cw >> 7)) * SEQ + (row & (SEQ - 1))) * 128 + (cw & 127); }
                f32x4 cs0 = {1.f, 0.f, 1.f, 0.f}, cs1 = {1.f, 0.f, 1.f, 0.f};
                if (dorope) { const f32x4* rp = (const f32x4*)(rope + ((size_t)(row & (SEQ - 1)) * 8 + 4 * fq) * 2); cs0 = rp[0]; cs1 = rp[1]; }
#pragma unroll
                for (int bj = 0; bj < 2; ++bj) { f32x4 v0 = acc[ai][bj][m][0], v1 = acc[ai][bj][m][1];
                    if (dorope) {
                        f32x4 a, b;
                        a[0] = v0[0] * cs0[0] - v0[1] * cs0[1]; a[1] = v0[1] * cs0[0] + v0[0] * cs0[1];
                        a[2] = v0[2] * cs0[2] - v0[3] * cs0[3]; a[3] = v0[3] * cs0[2] + v0[2] * cs0[3];
                        b[0] = v1[0] * cs1[0] - v1[1] * cs1[1]; b[1] = v1[1] * cs1[0] + v1[0] * cs1[1];
                        b[2] = v1[2] * cs1[2] - v1[3] * cs1[3]; b[3] = v1[3] * cs1[2] + v1[2] * cs1[3];
                        v0 = a; v1 = b; }
                    if (dosilu) {
#pragma unroll
                        for (int j = 0; j < 4; ++j) { v0[j] = silu_f(v0[j]); v1[j] = silu_f(v1[j]); } }
                    v0 = v0 * sc; v1 = v1 * sc;
                    u32x4 w; w.x = cvt_pk_bf16(v0[0], v0[1]); w.y = cvt_pk_bf16(v0[2], v0[3]); w.z = cvt_pk_bf16(v1[0], v1[1]); w.w = cvt_pk_bf16(v1[2], v1[3]);
                    *(u32x4*)(rowp + ((kind == 1 || kind == 4) ? bj * SEQ * 128 : bj * HALF)) = w; } }
    }
};
struct EpiVt {
    static constexpr bool PERM = true, AFTER_DRAIN = false;
    bf16_t* O;
    __device__ __forceinline__ void operator()(const f32x4 (&acc)[2][2][4][2], const Unit& u, int wr, int wc, int fr, int fq) const {
        const int row0 = u.pm * BM + wr * 64 + fr; const int col0 = u.pn * BM + wc * 32 + 8 * fq;
        const int p0 = (fq & 1) ? 4 : 0, p1 = (fq & 1) ? 12 : 8;
#pragma unroll
        for (int ai = 0; ai < 2; ++ai)
#pragma unroll
            for (int m = 0; m < 4; ++m) { const int row = row0 + ai * HALF + m * 16; const int gh = row >> 7, d = row & 127;
#pragma unroll
                for (int bj = 0; bj < 2; ++bj) { const int col = col0 + bj * HALF; const int b = col >> 11, sq = col & (SEQ - 1);
                    bf16_t* tp = O + ((size_t)((((gh >> 3) * 8 + b) * 8 + (gh & 7)) * 32 + (sq >> 6)) * 128 + d) * 64 + (sq & 48);
                    const f32x4 v0 = acc[ai][bj][m][0], v1 = acc[ai][bj][m][1];
                    u32x2 w0, w1; w0.x = cvt_pk_bf16(v0[0], v0[1]); w0.y = cvt_pk_bf16(v0[2], v0[3]); w1.x = cvt_pk_bf16(v1[0], v1[1]); w1.y = cvt_pk_bf16(v1[2], v1[3]);
                    *(u32x2*)(tp + p0) = w0; *(u32x2*)(tp + p1) = w1; } }
    }
};
struct EpiRes {
    static constexpr bool PERM = true, AFTER_DRAIN = false;
    const float* x; bf16_t* hb; float* ss;
    __device__ __forceinline__ void operator()(const f32x4 (&acc)[2][2][4][2], const Unit& u, int wr, int wc, int fr, int fq) const {
        const int row0 = u.pm * BM + wr * 64 + fr; const int col0 = u.pn * BM + wc * 32 + 8 * fq;
#pragma unroll
        for (int ai = 0; ai < 2; ++ai)
#pragma unroll
            for (int m = 0; m < 4; ++m) { const int row = row0 + ai * HALF + m * 16; const size_t off = (size_t)row * DM + col0; float q = 0.f;
#pragma unroll
                for (int bj = 0; bj < 2; ++bj) { const size_t o2 = off + bj * HALF;
                    const f32x4 h0 = *(const f32x4*)(x + o2) + acc[ai][bj][m][0], h1 = *(const f32x4*)(x + o2 + 4) + acc[ai][bj][m][1];
                    u32x4 w; w.x = cvt_pk_bf16(h0[0], h0[1]); w.y = cvt_pk_bf16(h0[2], h0[3]); w.z = cvt_pk_bf16(h1[0], h1[1]); w.w = cvt_pk_bf16(h1[2], h1[3]);
                    *(u32x4*)(hb + o2) = w;
                    q += ((h0[0] * h0[0] + h0[1] * h0[1]) + (h0[2] * h0[2] + h0[3] * h0[3])) + ((h1[0] * h1[0] + h1[1] * h1[1]) + (h1[2] * h1[2] + h1[3] * h1[3])); }
                q += __shfl_xor(q, 16); q += __shfl_xor(q, 32);
                if (fq == 0) atomicAdd(ss + row, q); }
    }
};
struct EpiGate {
    static constexpr bool PERM = true, AFTER_DRAIN = false;
    const bf16_t* hb; bf16_t* h2b; const bf16_t* ple; const float* ss2; float* ss3;
    __device__ __forceinline__ void operator()(const f32x4 (&acc)[2][2][4][2], const Unit& u, int wr, int wc, int fr, int fq) const {
        const int row0 = u.pm * BM + wr * 64 + fr; const int col0 = u.pn * BM + wc * 32 + 8 * fq;
#pragma unroll
        for (int ai = 0; ai < 2; ++ai)
#pragma unroll
            for (int m = 0; m < 4; ++m) { const int row = row0 + ai * HALF + m * 16; const size_t off = (size_t)row * DM + col0; float q = 0.f;
                const float rstd = rsqrtf(ss2[row] * (1.f / DM) + NORM_EPS);
#pragma unroll
                for (int bj = 0; bj < 2; ++bj) { const size_t o2 = off + bj * HALF; const u32x4 hw = *(const u32x4*)(hb + o2); const u32x4 pw = *(const u32x4*)(ple + o2);
                    const f32x4 a0 = acc[ai][bj][m][0] * rstd, a1 = acc[ai][bj][m][1] * rstd; f32x4 g0, g1;
                    g0[0] = bf_lo(hw.x) + sigmoid_f(a0[0]) * bf_lo(pw.x); g0[1] = bf_hi(hw.x) + sigmoid_f(a0[1]) * bf_hi(pw.x);
                    g0[2] = bf_lo(hw.y) + sigmoid_f(a0[2]) * bf_lo(pw.y); g0[3] = bf_hi(hw.y) + sigmoid_f(a0[3]) * bf_hi(pw.y);
                    g1[0] = bf_lo(hw.z) + sigmoid_f(a1[0]) * bf_lo(pw.z); g1[1] = bf_hi(hw.z) + sigmoid_f(a1[1]) * bf_hi(pw.z);
                    g1[2] = bf_lo(hw.w) + sigmoid_f(a1[2]) * bf_lo(pw.w); g1[3] = bf_hi(hw.w) + sigmoid_f(a1[3]) * bf_hi(pw.w);
                    u32x4 w2; w2.x = cvt_pk_bf16(g0[0], g0[1]); w2.y = cvt_pk_bf16(g0[2], g0[3]); w2.z = cvt_pk_bf16(g1[0], g1[1]); w2.w = cvt_pk_bf16(g1[2], g1[3]);
                    *(u32x4*)(h2b + o2) = w2;
                    q += ((g0[0] * g0[0] + g0[1] * g0[1]) + (g0[2] * g0[2] + g0[3] * g0[3])) + ((g1[0] * g1[0] + g1[1] * g1[1]) + (g1[2] * g1[2] + g1[3] * g1[3])); }
                q += __shfl_xor(q, 16); q += __shfl_xor(q, 32);
                if (fq == 0) atomicAdd(ss3 + row, q); }
    }
};
}
namespace att {
constexpr int KP = 272, VP = 144, KT_BYTES = 64 * KP, VT_BYTES = 128 * VP, BUF_BYTES = KT_BYTES + VT_BYTES;
constexpr int FLAG_OFF = 2 * BUF_BYTES;
constexpr int XP = 132;
constexpr float R_DONE = 152.0f;

template <bool MASK>
__device__ __forceinline__ void sb_block(const f32x16& sv, int kbase, int tq, int h, float& R, bf16x8 (&pf)[2]) {
    float c[16], z[16];
#pragma unroll
    for (int i = 0; i < 16; ++i) {
        z[i] = (!MASK || (kbase + 8 * (i >> 2) + (i & 3) < tq)) ? sv[i] : -1e30f;
        c[i] = fmaxf(z[i], 0.f) + fast_log2(1.f + fast_exp2(-fabsf(z[i])));
    }
    float T[4], OT[4], pr[4], suf[4];
#pragma unroll
    for (int g = 0; g < 4; ++g) { c[4 * g + 2] += c[4 * g + 3]; c[4 * g + 1] += c[4 * g + 2]; c[4 * g] += c[4 * g + 1]; T[g] = c[4 * g]; }
#pragma unroll
    for (int g = 0; g < 4; ++g) { OT[g] = __shfl_xor(T[g], 32); pr[g] = T[g] + OT[g]; }
    suf[3] = 0.f; suf[2] = pr[3]; suf[1] = suf[2] + pr[2]; suf[0] = suf[1] + pr[1];
    float w[16];
#pragma unroll
    for (int g = 0; g < 4; ++g) { const float off = R + suf[g] + (h == 0 ? OT[g] : 0.f);
#pragma unroll
        for (int j = 0; j < 4; ++j) { const int i = 4 * g + j; w[i] = fast_exp2(z[i] - (off + c[i])); } }
    R += suf[0] + pr[0];
#pragma unroll
    for (int sp = 0; sp < 2; ++sp) { u32x4 p; p.x = cvt_pk(w[8 * sp], w[8 * sp + 1]); p.y = cvt_pk(w[8 * sp + 2], w[8 * sp + 3]); p.z = cvt_pk(w[8 * sp + 4], w[8 * sp + 5]); p.w = cvt_pk(w[8 * sp + 6], w[8 * sp + 7]);
        pf[sp] = __builtin_bit_cast(bf16x8, p); }
}

template <int MODE>
__device__ __forceinline__ void attn_unit(LAS unsigned char* lds, const bf16_t* __restrict__ PROJ, const bf16_t* __restrict__ KIMG, const bf16_t* __restrict__ VT, bf16_t* __restrict__ MIXED,
                                          int b, int hh, int qblk, float lam, const float* __restrict__ subln_g) {
    constexpr int QB = MODE == 0 ? 256 : 128;
    constexpr int NKS = MODE == 0 ? 8 : 4;
    const int tid = opaque_tid(), lane = tid & 63, r = lane & 31, h = lane >> 5;
    const int wid = __builtin_amdgcn_readfirstlane(tid >> 6);
    const int qg = MODE == 0 ? wid : (wid & 3), role = MODE == 0 ? 0 : (wid >> 2);
    const int Q0 = qblk * QB, q0w = Q0 + 32 * qg, tq = q0w + r;
    const size_t tokbase = (size_t)b * SEQ;
    const int gbh = ((MODE == 0 ? 0 : 8) + b) * 8 + hh;
    const bf16_t* Kg = KIMG + (size_t)gbh * SEQ * 128;
    const bf16_t* Vg = VT + (size_t)gbh * 32 * 8192;
    bf16x8 qf[NKS];
    { const bf16_t* qp = PROJ + (tokbase + tq) * NPROJ + (MODE == 0 ? PQ_SB + hh * 128 : PQ_DF + hh * 128 + role * 64) + 8 * h;
#pragma unroll
      for (int ks = 0; ks < NKS; ++ks) qf[ks] = *(const bf16x8*)(qp + 16 * ks); }
    f32x16 o[4];
#pragma unroll
    for (int d = 0; d < 4; ++d)
#pragma unroll
        for (int i = 0; i < 16; ++i) o[d][i] = 0.f;
    float R = 0.f, m_run = -1e30f, l_run = 0.f;
    const int kr0 = tid >> 4, kc = tid & 15, vr0 = tid >> 3, vc = tid & 7;
    const int kst = kr0 * KP + kc * 16, vst = KT_BYTES + vr0 * VP + vc * 16;
    const bf16_t* kgl = Kg + tid * 8;
    const bf16_t* vgl = Vg + tid * 8;
    u32x4 kreg[2], vreg[2];
#define ATT_LOAD(t) do { _Pragma("unroll") for (int i_ = 0; i_ < 2; ++i_) { \
        kreg[i_] = *(const u32x4*)(kgl + (size_t)(t) * 8192 + i_ * 4096); \
        vreg[i_] = *(const u32x4*)(vgl + (size_t)(t) * 8192 + i_ * 4096); } } while (0)
#define ATT_STORE(bo) do { _Pragma("unroll") for (int i_ = 0; i_ < 2; ++i_) { \
        *(LAS u32x4*)(lds + (bo) + kst + i_ * 32 * KP) = kreg[i_]; \
        *(LAS u32x4*)(lds + (bo) + vst + i_ * 64 * VP) = vreg[i_]; } } while (0)
    const int tl = (Q0 + QB - 1) >> 6;
    const int kfrag = r * KP + (role * 64 + 8 * h) * 2;
    const int vfrag = KT_BYTES + r * VP + (8 * h) * 2;
    volatile LAS int* flags = (volatile LAS int*)(lds + FLAG_OFF);
    __syncthreads();
    ATT_LOAD(tl); ATT_STORE(0);
    __syncthreads();
    int cur = 0, it = 0;
    bool wdone = false;
    for (int t = tl;; --t, ++it) {
        if (t > 0) ATT_LOAD(t - 1);
        const int k0 = 64 * t;
        const bool active = (MODE == 0) ? (!wdone && k0 <= q0w + 30) : (k0 <= q0w + 31);
        if (active) {
            const int bo = cur * BUF_BYTES;
            f32x16 s[2];
            bf16x8 vf[4][2][2];
            if (MODE == 1) {
                bf16x8 kf[2][NKS];
#pragma unroll
                for (int kb = 0; kb < 2; ++kb)
#pragma unroll
                    for (int ks = 0; ks < NKS; ++ks) kf[kb][ks] = *(const LAS bf16x8*)(lds + bo + kfrag + kb * 32 * KP + ks * 32);
                __builtin_amdgcn_sched_barrier(0);
#pragma unroll
                for (int kb = 0; kb < 2; ++kb) {
#pragma unroll
                    for (int i = 0; i < 16; ++i) s[kb][i] = 0.f;
#pragma unroll
                    for (int ks = 0; ks < NKS; ++ks) s[kb] = __builtin_amdgcn_mfma_f32_32x32x16_bf16(kf[kb][ks], qf[ks], s[kb], 0, 0, 0);
                }
                __builtin_amdgcn_sched_barrier(0);
#pragma unroll
                for (int d = 0; d < 2; ++d)
#pragma unroll
                    for (int kb = 0; kb < 2; ++kb)
#pragma unroll
                        for (int sp = 0; sp < 2; ++sp) vf[d][kb][sp] = *(const LAS bf16x8*)(lds + bo + vfrag + d * 32 * VP + (32 * kb + 16 * sp) * 2);
                __builtin_amdgcn_sched_barrier(0);
            } else {
#pragma unroll
                for (int kb = 0; kb < 2; ++kb) {
#pragma unroll
                    for (int i = 0; i < 16; ++i) s[kb][i] = 0.f;
#pragma unroll
                    for (int ks = 0; ks < NKS; ++ks) {
                        const bf16x8 a = *(const LAS bf16x8*)(lds + bo + kfrag + kb * 32 * KP + ks * 32);
                        s[kb] = __builtin_amdgcn_mfma_f32_32x32x16_bf16(a, qf[ks], s[kb], 0, 0, 0);
                    }
                }
            }
            bf16x8 pf[2][2];
            if (MODE == 0) {
                sb_block<true>(s[1], k0 + 32 + 4 * h, tq, h, R, pf[1]);
                if (__all(R >= R_DONE)) {
#pragma unroll
                    for (int sp = 0; sp < 2; ++sp)
#pragma unroll
                        for (int j = 0; j < 8; ++j) pf[0][sp][j] = 0;
                } else sb_block<true>(s[0], k0 + 4 * h, tq, h, R, pf[0]);
                wdone = __all(R >= R_DONE);
            } else {
                float mx = -1e30f;
                if (k0 + 63 > q0w) {
#pragma unroll
                    for (int kb = 0; kb < 2; ++kb) { const int kbase = k0 + 32 * kb + 4 * h;
#pragma unroll
                        for (int i = 0; i < 16; ++i) { const int key = kbase + 8 * (i >> 2) + (i & 3); const float v = (key <= tq) ? s[kb][i] : -1e30f; s[kb][i] = v; mx = fmaxf(mx, v); } }
                } else {
#pragma unroll
                    for (int kb = 0; kb < 2; ++kb)
#pragma unroll
                        for (int i = 0; i < 16; ++i) mx = fmaxf(mx, s[kb][i]);
                }
                mx = fmaxf(mx, __shfl_xor(mx, 32));
                const float m_new = fmaxf(m_run, mx), alpha = fast_exp2(m_run - m_new);
                m_run = m_new;
                float ls = 0.f;
#pragma unroll
                for (int kb = 0; kb < 2; ++kb) {
#pragma unroll
                    for (int i = 0; i < 16; ++i) { const float p = fast_exp2(s[kb][i] - m_new); s[kb][i] = p; ls += p; }
#pragma unroll
                    for (int sp = 0; sp < 2; ++sp) { u32x4 p; p.x = cvt_pk(s[kb][8 * sp], s[kb][8 * sp + 1]); p.y = cvt_pk(s[kb][8 * sp + 2], s[kb][8 * sp + 3]); p.z = cvt_pk(s[kb][8 * sp + 4], s[kb][8 * sp + 5]); p.w = cvt_pk(s[kb][8 * sp + 6], s[kb][8 * sp + 7]);
                        pf[kb][sp] = __builtin_bit_cast(bf16x8, p); }
                }
                l_run = l_run * alpha + ls;
                if (!__all(alpha == 1.f)) {
#pragma unroll
                    for (int d = 0; d < 4; ++d)
#pragma unroll
                        for (int i = 0; i < 16; ++i) o[d][i] *= alpha;
                }
            }
            if (MODE == 1) {
                __builtin_amdgcn_sched_barrier(0);
#pragma unroll
                for (int d = 2; d < 4; ++d)
#pragma unroll
                    for (int kb = 0; kb < 2; ++kb)
#pragma unroll
                        for (int sp = 0; sp < 2; ++sp) vf[d][kb][sp] = *(const LAS bf16x8*)(lds + bo + vfrag + d * 32 * VP + (32 * kb + 16 * sp) * 2);
                __builtin_amdgcn_sched_barrier(0);
            }
#pragma unroll
            for (int d = 0; d < 4; ++d)
#pragma unroll
                for (int kb = 0; kb < 2; ++kb)
#pragma unroll
                    for (int sp = 0; sp < 2; ++sp) {
                        const bf16x8 a = (MODE == 1) ? vf[d][kb][sp] : *(const LAS bf16x8*)(lds + bo + vfrag + d * 32 * VP + (32 * kb + 16 * sp) * 2);
                        o[d] = __builtin_amdgcn_mfma_f32_32x32x16_bf16(a, pf[kb][sp], o[d], 0, 0, 0);
                    }
        }
        if (t > 0) ATT_STORE((cur ^ 1) * BUF_BYTES);
        if (MODE == 0) { if (lane == 0) flags[(it & 1) * 8 + wid] = wdone ? 1 : 0; }
        __syncthreads();
        if (t == 0) break;
        if (MODE == 0) { int alld = 1;
#pragma unroll
            for (int w2 = 0; w2 < 8; ++w2) alld &= flags[(it & 1) * 8 + w2];
            if (alld) break; }
        cur ^= 1;
    }
#undef ATT_LOAD
#undef ATT_STORE
    const int erow = lane >> 4, ech = lane & 15;
    const size_t tok0 = tokbase + q0w;
    if (MODE == 0 || role == 0) {
    }
    u32x4 gw[8];
    if (MODE == 0 || role == 0) {
        const bf16_t* gp = PROJ + (tok0 + erow) * NPROJ + (MODE == 0 ? PG_SB : PG_DF) + hh * 128 + ech * 8;
#pragma unroll
        for (int i = 0; i < 8; ++i) gw[i] = *(const u32x4*)(gp + (size_t)(4 * i) * NPROJ);
    }
    LAS unsigned char* stg = lds + (MODE == 0 ? wid * 8704 : 69632 + qg * 8704);
    if (MODE == 0) {
#pragma unroll
        for (int d = 0; d < 4; ++d)
#pragma unroll
            for (int g = 0; g < 4; ++g) { u32x2 w; w.x = cvt_pk(o[d][4 * g], o[d][4 * g + 1]); w.y = cvt_pk(o[d][4 * g + 2], o[d][4 * g + 3]);
                *(LAS u32x2*)(stg + r * 272 + (32 * d + 8 * g + 4 * h) * 2) = w; }
    } else {
        const float lt = l_run + __shfl_xor(l_run, 32);
        const float inv = 1.f / lt;
        LAS float* xq = (LAS float*)lds + (qg * 32 + r) * XP + 4 * h;
        if (role == 1) {
            const float f = inv * lam;
#pragma unroll
            for (int d = 0; d < 4; ++d)
#pragma unroll
                for (int g = 0; g < 4; ++g) *(LAS f32x4*)(xq + 32 * d + 8 * g) = (f32x4){o[d][4 * g] * f, o[d][4 * g + 1] * f, o[d][4 * g + 2] * f, o[d][4 * g + 3] * f};
        }
        __syncthreads();
        if (role == 0) {
            float q = 0.f;
#pragma unroll
            for (int d = 0; d < 4; ++d)
#pragma unroll
                for (int g = 0; g < 4; ++g) { const f32x4 x2 = *(const LAS f32x4*)(xq + 32 * d + 8 * g);
#pragma unroll
                    for (int j = 0; j < 4; ++j) { const float v = o[d][4 * g + j] * inv - x2[j]; o[d][4 * g + j] = v; q += v * v; } }
            q += __shfl_xor(q, 32);
            const float rs = rsqrtf(q * (1.f / 128.f) + SUBLN_EPS) * (1.f - LAMBDA_INIT);
            const float* sg = subln_g + 4 * h;
#pragma unroll
            for (int d = 0; d < 4; ++d)
#pragma unroll
                for (int g = 0; g < 4; ++g) { const f32x4 sv = *(const f32x4*)(sg + 32 * d + 8 * g);
                    u32x2 w; w.x = cvt_pk(o[d][4 * g] * rs * sv[0], o[d][4 * g + 1] * rs * sv[1]); w.y = cvt_pk(o[d][4 * g + 2] * rs * sv[2], o[d][4 * g + 3] * rs * sv[3]);
                    *(LAS u32x2*)(stg + r * 272 + (32 * d + 8 * g + 4 * h) * 2) = w; }
        }
    }
    if (MODE == 0 || role == 0) {
        asm volatile("s_waitcnt lgkmcnt(0)" ::: "memory");
        bf16_t* op = MIXED + (tok0 + erow) * DM + (MODE == 0 ? 0 : 1024) + hh * 128 + ech * 8;
#pragma unroll
        for (int i = 0; i < 8; ++i) { const u32x4 ov = *(const LAS u32x4*)(stg + (4 * i + erow) * 272 + ech * 16); const u32x4 g4 = gw[i];
            u32x4 w; w.x = cvt_pk(bf_lo(ov.x) * bf_lo(g4.x), bf_hi(ov.x) * bf_hi(g4.x)); w.y = cvt_pk(bf_lo(ov.y) * bf_lo(g4.y), bf_hi(ov.y) * bf_hi(g4.y));
            w.z = cvt_pk(bf_lo(ov.z) * bf_lo(g4.z), bf_hi(ov.z) * bf_hi(g4.z)); w.w = cvt_pk(bf_lo(ov.w) * bf_lo(g4.w), bf_hi(ov.w) * bf_hi(g4.w));
            *(u32x4*)(op + (size_t)(4 * i) * DM) = w; }
    }
}

__device__ __forceinline__ void attn_unit_df(LAS unsigned char* lds, const bf16_t* __restrict__ PROJ, const bf16_t* __restrict__ KIMG, const bf16_t* __restrict__ VT, bf16_t* __restrict__ MIXED,
                                             int b, int hh, int qblk, float lam, const float* __restrict__ subln_g) {
    constexpr int VB0 = 2 * KT_BYTES;
    const int tid = opaque_tid(), lane = tid & 63, r = lane & 31, h = lane >> 5;
    const int wid = __builtin_amdgcn_readfirstlane(tid >> 6);
    const int qg = wid & 3, role = wid >> 2;
    const int Q0 = qblk * 128, q0w = Q0 + 32 * qg, tq = q0w + r;
    const size_t tokbase = (size_t)b * SEQ;
    const int gbh = (8 + b) * 8 + hh;
    const bf16_t* Kg = KIMG + (size_t)gbh * SEQ * 128;
    const bf16_t* Vg = VT + (size_t)gbh * 32 * 8192;
    bf16x8 qf[4];
    { const bf16_t* qp = PROJ + (tokbase + tq) * NPROJ + PQ_DF + hh * 128 + role * 64 + 8 * h;
#pragma unroll
      for (int ks = 0; ks < 4; ++ks) qf[ks] = *(const bf16x8*)(qp + 16 * ks); }
    f32x16 o[4];
#pragma unroll
    for (int d = 0; d < 4; ++d)
#pragma unroll
        for (int i = 0; i < 16; ++i) o[d][i] = 0.f;
    float m_run = -1e30f, l_run = 0.f, alpha = 1.f;
    const int kr0 = tid >> 4, kc = tid & 15, vr0 = tid >> 3, vc = tid & 7;
    const int kst = kr0 * KP + kc * 16, vst = vr0 * VP + vc * 16;
    const bf16_t* kgl = Kg + tid * 8;
    const bf16_t* vgl = Vg + tid * 8;
    u32x4 kreg[2], vreg[2];
#define DF_LOAD(t) do { _Pragma("unroll") for (int i_ = 0; i_ < 2; ++i_) { \
        kreg[i_] = *(const u32x4*)(kgl + (size_t)(t) * 8192 + i_ * 4096); \
        vreg[i_] = *(const u32x4*)(vgl + (size_t)(t) * 8192 + i_ * 4096); } } while (0)
#define DF_STORE(ko, vo) do { _Pragma("unroll") for (int i_ = 0; i_ < 2; ++i_) { \
        *(LAS u32x4*)(lds + (ko) + kst + i_ * 32 * KP) = kreg[i_]; \
        *(LAS u32x4*)(lds + (vo) + vst + i_ * 64 * VP) = vreg[i_]; } } while (0)
#define DF_VLOAD(vo) do { _Pragma("unroll") for (int d_ = 0; d_ < 4; ++d_) _Pragma("unroll") for (int kb_ = 0; kb_ < 2; ++kb_) _Pragma("unroll") for (int sp_ = 0; sp_ < 2; ++sp_) \
        vf[d_][kb_][sp_] = *(const LAS bf16x8*)(lds + (vo) + vfrag + d_ * 32 * VP + (32 * kb_ + 16 * sp_) * 2); } while (0)
#define DF_PV() do { _Pragma("unroll") for (int d_ = 0; d_ < 4; ++d_) _Pragma("unroll") for (int kb_ = 0; kb_ < 2; ++kb_) _Pragma("unroll") for (int sp_ = 0; sp_ < 2; ++sp_) \
        o[d_] = __builtin_amdgcn_mfma_f32_32x32x16_bf16(vf[d_][kb_][sp_], pf[kb_][sp_], o[d_], 0, 0, 0); } while (0)
#define DF_RESCALE() do { if (!__all(alpha == 1.f)) { _Pragma("unroll") for (int d_ = 0; d_ < 4; ++d_) _Pragma("unroll") for (int i_ = 0; i_ < 16; ++i_) o[d_][i_] *= alpha; } } while (0)
    const int tl = (Q0 + 127) >> 6, NT = tl + 1;
    const int kfrag = r * KP + (role * 64 + 8 * h) * 2;
    const int vfrag = r * VP + (8 * h) * 2;
    __syncthreads();
    DF_LOAD(tl); DF_STORE(0, VB0);
    __syncthreads();
    bool have_p = false;
    bf16x8 pf[2][2];
    for (int i = 0; i < NT; ++i) {
        const int t = tl - i, k0 = 64 * t;
        if (t > 0) DF_LOAD(t - 1);
        if (k0 <= q0w + 31) {
            const int ko = (i & 1) * KT_BYTES;
            bf16x8 kf[2][4];
#pragma unroll
            for (int kb = 0; kb < 2; ++kb)
#pragma unroll
                for (int ks = 0; ks < 4; ++ks) kf[kb][ks] = *(const LAS bf16x8*)(lds + ko + kfrag + kb * 32 * KP + ks * 32);
            f32x16 s[2];
#pragma unroll
            for (int kb = 0; kb < 2; ++kb) {
#pragma unroll
                for (int j = 0; j < 16; ++j) s[kb][j] = 0.f;
#pragma unroll
                for (int ks = 0; ks < 4; ++ks) s[kb] = __builtin_amdgcn_mfma_f32_32x32x16_bf16(kf[kb][ks], qf[ks], s[kb], 0, 0, 0);
            }
            if (!have_p) {
                float mx = -1e30f;
#pragma unroll
                for (int kb = 0; kb < 2; ++kb) { const int kbase = k0 + 32 * kb + 4 * h;
#pragma unroll
                    for (int j = 0; j < 16; ++j) { const int key = kbase + 8 * (j >> 2) + (j & 3); const float v = (key <= tq) ? s[kb][j] : -1e30f; s[kb][j] = v; mx = fmaxf(mx, v); } }
                mx = fmaxf(mx, __shfl_xor(mx, 32));
                m_run = mx; alpha = 1.f;
                float ls = 0.f;
#pragma unroll
                for (int kb = 0; kb < 2; ++kb) {
#pragma unroll
                    for (int j = 0; j < 16; ++j) { const float p = fast_exp2(s[kb][j] - mx); s[kb][j] = p; ls += p; }
#pragma unroll
                    for (int sp = 0; sp < 2; ++sp) { u32x4 p; p.x = cvt_pk(s[kb][8 * sp], s[kb][8 * sp + 1]); p.y = cvt_pk(s[kb][8 * sp + 2], s[kb][8 * sp + 3]); p.z = cvt_pk(s[kb][8 * sp + 4], s[kb][8 * sp + 5]); p.w = cvt_pk(s[kb][8 * sp + 6], s[kb][8 * sp + 7]);
                        pf[kb][sp] = __builtin_bit_cast(bf16x8, p); }
                }
                l_run = ls;
                have_p = true;
            } else {
                DF_RESCALE();
                const int vo = VB0 + ((i + 2) % 3) * VT_BYTES;
                bf16x8 vf[2][2][2];
                bf16x8 pn[2][2]; u32x4 pw[2][2];
                float mx = -1e30f, ls = 0.f, m_new = 0.f;
#define DF_VL(g) do { _Pragma("unroll") for (int kb_ = 0; kb_ < 2; ++kb_) _Pragma("unroll") for (int sp_ = 0; sp_ < 2; ++sp_) \
        vf[(g) & 1][kb_][sp_] = *(const LAS bf16x8*)(lds + vo + vfrag + (g) * 32 * VP + (32 * kb_ + 16 * sp_) * 2); } while (0)
#define DF_MF(k) o[(k) >> 2] = __builtin_amdgcn_mfma_f32_32x32x16_bf16(vf[((k) >> 2) & 1][((k) >> 1) & 1][(k) & 1], pf[((k) >> 1) & 1][(k) & 1], o[(k) >> 2], 0, 0, 0)
#define DF_S(e) s[(e) >> 4][(e) & 15]
                DF_VL(0); DF_VL(1);
                __builtin_amdgcn_sched_barrier(0);
                DF_MF(0);
                mx = fmaxf(fmaxf(mx, DF_S(0)), DF_S(1));
                mx = fmaxf(fmaxf(mx, DF_S(2)), DF_S(3));
                mx = fmaxf(fmaxf(mx, DF_S(4)), DF_S(5));
                mx = fmaxf(fmaxf(mx, DF_S(6)), DF_S(7));
                __builtin_amdgcn_sched_barrier(0);
                DF_MF(1);
                mx = fmaxf(fmaxf(mx, DF_S(8)), DF_S(9));
                mx = fmaxf(fmaxf(mx, DF_S(10)), DF_S(11));
                mx = fmaxf(fmaxf(mx, DF_S(12)), DF_S(13));
                mx = fmaxf(fmaxf(mx, DF_S(14)), DF_S(15));
                __builtin_amdgcn_sched_barrier(0);
                DF_MF(2);
                mx = fmaxf(fmaxf(mx, DF_S(16)), DF_S(17));
                mx = fmaxf(fmaxf(mx, DF_S(18)), DF_S(19));
                mx = fmaxf(fmaxf(mx, DF_S(20)), DF_S(21));
                mx = fmaxf(fmaxf(mx, DF_S(22)), DF_S(23));
                __builtin_amdgcn_sched_barrier(0);
                DF_MF(3);
                mx = fmaxf(fmaxf(mx, DF_S(24)), DF_S(25));
                mx = fmaxf(fmaxf(mx, DF_S(26)), DF_S(27));
                mx = fmaxf(fmaxf(mx, DF_S(28)), DF_S(29));
                mx = fmaxf(fmaxf(mx, DF_S(30)), DF_S(31));
                { auto rr = __builtin_amdgcn_permlane32_swap(__float_as_uint(mx), __float_as_uint(mx), false, false); mx = fmaxf(__uint_as_float(rr[0]), __uint_as_float(rr[1])); }
                m_new = fmaxf(m_run, mx); alpha = fast_exp2(m_run - m_new); m_run = m_new;
                __builtin_amdgcn_sched_barrier(0);
                DF_VL(2);
                DF_MF(4);
                { const float p = fast_exp2(DF_S(0) - m_new); DF_S(0) = p; ls += p; }
                { const float p = fast_exp2(DF_S(1) - m_new); DF_S(1) = p; ls += p; }
                pw[0][0][0] = cvt_pk(DF_S(0), DF_S(1));
                { const float p = fast_exp2(DF_S(2) - m_new); DF_S(2) = p; ls += p; }
                __builtin_amdgcn_sched_barrier(0);
                DF_MF(5);
                { const float p = fast_exp2(DF_S(3) - m_new); DF_S(3) = p; ls += p; }
                pw[0][0][1] = cvt_pk(DF_S(2), DF_S(3));
                { const float p = fast_exp2(DF_S(4) - m_new); DF_S(4) = p; ls += p; }
                { const float p = fast_exp2(DF_S(5) - m_new); DF_S(5) = p; ls += p; }
                pw[0][0][2] = cvt_pk(DF_S(4), DF_S(5));
                __builtin_amdgcn_sched_barrier(0);
                DF_MF(6);
                { const float p = fast_exp2(DF_S(6) - m_new); DF_S(6) = p; ls += p; }
                { const float p = fast_exp2(DF_S(7) - m_new); DF_S(7) = p; ls += p; }
                pw[0][0][3] = cvt_pk(DF_S(6), DF_S(7));
                { const float p = fast_exp2(DF_S(8) - m_new); DF_S(8) = p; ls += p; }
                __builtin_amdgcn_sched_barrier(0);
                DF_MF(7);
                { const float p = fast_exp2(DF_S(9) - m_new); DF_S(9) = p; ls += p; }
                pw[0][1][0] = cvt_pk(DF_S(8), DF_S(9));
                { const float p = fast_exp2(DF_S(10) - m_new); DF_S(10) = p; ls += p; }
                { const float p = fast_exp2(DF_S(11) - m_new); DF_S(11) = p; ls += p; }
                pw[0][1][1] = cvt_pk(DF_S(10), DF_S(11));
                __builtin_amdgcn_sched_barrier(0);
                DF_VL(3);
                DF_MF(8);
                { const float p = fast_exp2(DF_S(12) - m_new); DF_S(12) = p; ls += p; }
                { const float p = fast_exp2(DF_S(13) - m_new); DF_S(13) = p; ls += p; }
                pw[0][1][2] = cvt_pk(DF_S(12), DF_S(13));
                { const float p = fast_exp2(DF_S(14) - m_new); DF_S(14) = p; ls += p; }
                __builtin_amdgcn_sched_barrier(0);
                DF_MF(9);
                { const float p = fast_exp2(DF_S(15) - m_new); DF_S(15) = p; ls += p; }
                pw[0][1][3] = cvt_pk(DF_S(14), DF_S(15));
                { const float p = fast_exp2(DF_S(16) - m_new); DF_S(16) = p; ls += p; }
                { const float p = fast_exp2(DF_S(17) - m_new); DF_S(17) = p; ls += p; }
                pw[1][0][0] = cvt_pk(DF_S(16), DF_S(17));
                __builtin_amdgcn_sched_barrier(0);
                DF_MF(10);
                { const float p = fast_exp2(DF_S(18) - m_new); DF_S(18) = p; ls += p; }
                { const float p = fast_exp2(DF_S(19) - m_new); DF_S(19) = p; ls += p; }
                pw[1][0][1] = cvt_pk(DF_S(18), DF_S(19));
                { const float p = fast_exp2(DF_S(20) - m_new); DF_S(20) = p; ls += p; }
                __builtin_amdgcn_sched_barrier(0);
                DF_MF(11);
                { const float p = fast_exp2(DF_S(21) - m_new); DF_S(21) = p; ls += p; }
                pw[1][0][2] = cvt_pk(DF_S(20), DF_S(21));
                { const float p = fast_exp2(DF_S(22) - m_new); DF_S(22) = p; ls += p; }
                { const float p = fast_exp2(DF_S(23) - m_new); DF_S(23) = p; ls += p; }
                pw[1][0][3] = cvt_pk(DF_S(22), DF_S(23));
                __builtin_amdgcn_sched_barrier(0);
                DF_MF(12);
                { const float p = fast_exp2(DF_S(24) - m_new); DF_S(24) = p; ls += p; }
                { const float p = fast_exp2(DF_S(25) - m_new); DF_S(25) = p; ls += p; }
                pw[1][1][0] = cvt_pk(DF_S(24), DF_S(25));
                __builtin_amdgcn_sched_barrier(0);
                DF_MF(13);
                { const float p = fast_exp2(DF_S(26) - m_new); DF_S(26) = p; ls += p; }
                { const float p = fast_exp2(DF_S(27) - m_new); DF_S(27) = p; ls += p; }
                pw[1][1][1] = cvt_pk(DF_S(26), DF_S(27));
                __builtin_amdgcn_sched_barrier(0);
                DF_MF(14);
                { const float p = fast_exp2(DF_S(28) - m_new); DF_S(28) = p; ls += p; }
                { const float p = fast_exp2(DF_S(29) - m_new); DF_S(29) = p; ls += p; }
                pw[1][1][2] = cvt_pk(DF_S(28), DF_S(29));
                __builtin_amdgcn_sched_barrier(0);
                DF_MF(15);
                { const float p = fast_exp2(DF_S(30) - m_new); DF_S(30) = p; ls += p; }
                { const float p = fast_exp2(DF_S(31) - m_new); DF_S(31) = p; ls += p; }
                pw[1][1][3] = cvt_pk(DF_S(30), DF_S(31));
                __builtin_amdgcn_sched_barrier(0);
                l_run = l_run * alpha + ls;
#pragma unroll
                for (int kb = 0; kb < 2; ++kb)
#pragma unroll
                    for (int sp = 0; sp < 2; ++sp) pf[kb][sp] = __builtin_bit_cast(bf16x8, pw[kb][sp]);
#undef DF_VL
#undef DF_MF
#undef DF_S
            }
        }
        if (t > 0) DF_STORE(((i + 1) & 1) * KT_BYTES, VB0 + ((i + 1) % 3) * VT_BYTES);
        __syncthreads();
    }
    if (have_p) {
        DF_RESCALE();
        bf16x8 vf[4][2][2];
        DF_VLOAD(VB0 + ((NT - 1) % 3) * VT_BYTES);
        DF_PV();
    }
    __syncthreads();
#undef DF_LOAD
#undef DF_STORE
#undef DF_VLOAD
#undef DF_PV
#undef DF_RESCALE
    const int erow = lane >> 4, ech = lane & 15;
    const size_t tok0 = tokbase + q0w;
    u32x4 gw[8];
    if (role == 0) {
        const bf16_t* gp = PROJ + (tok0 + erow) * NPROJ + PG_DF + hh * 128 + ech * 8;
#pragma unroll
        for (int i = 0; i < 8; ++i) gw[i] = *(const u32x4*)(gp + (size_t)(4 * i) * NPROJ);
    }
    LAS unsigned char* stg = lds + 69632 + qg * 8704;
    {
        const float lt = l_run + __shfl_xor(l_run, 32);
        const float inv = 1.f / lt;
        LAS float* xq = (LAS float*)lds + (qg * 32 + r) * XP + 4 * h;
        if (role == 1) {
            const float f = inv * lam;
#pragma unroll
            for (int d = 0; d < 4; ++d)
#pragma unroll
                for (int g = 0; g < 4; ++g) *(LAS f32x4*)(xq + 32 * d + 8 * g) = (f32x4){o[d][4 * g] * f, o[d][4 * g + 1] * f, o[d][4 * g + 2] * f, o[d][4 * g + 3] * f};
        }
        __syncthreads();
        if (role == 0) {
            float q = 0.f;
#pragma unroll
            for (int d = 0; d < 4; ++d)
#pragma unroll
                for (int g = 0; g < 4; ++g) { const f32x4 x2 = *(const LAS f32x4*)(xq + 32 * d + 8 * g);
#pragma unroll
                    for (int j = 0; j < 4; ++j) { const float v = o[d][4 * g + j] * inv - x2[j]; o[d][4 * g + j] = v; q += v * v; } }
            q += __shfl_xor(q, 32);
            const float rs = rsqrtf(q * (1.f / 128.f) + SUBLN_EPS) * (1.f - LAMBDA_INIT);
            const float* sg = subln_g + 4 * h;
#pragma unroll
            for (int d = 0; d < 4; ++d)
#pragma unroll
                for (int g = 0; g < 4; ++g) { const f32x4 sv = *(const f32x4*)(sg + 32 * d + 8 * g);
                    u32x2 w; w.x = cvt_pk(o[d][4 * g] * rs * sv[0], o[d][4 * g + 1] * rs * sv[1]); w.y = cvt_pk(o[d][4 * g + 2] * rs * sv[2], o[d][4 * g + 3] * rs * sv[3]);
                    *(LAS u32x2*)(stg + r * 272 + (32 * d + 8 * g + 4 * h) * 2) = w; }
            asm volatile("s_waitcnt lgkmcnt(0)" ::: "memory");
            bf16_t* op = MIXED + (tok0 + erow) * DM + 1024 + hh * 128 + ech * 8;
#pragma unroll
            for (int i = 0; i < 8; ++i) { const u32x4 ov = *(const LAS u32x4*)(stg + (4 * i + erow) * 272 + ech * 16); const u32x4 g4 = gw[i];
                u32x4 w; w.x = cvt_pk(bf_lo(ov.x) * bf_lo(g4.x), bf_hi(ov.x) * bf_hi(g4.x)); w.y = cvt_pk(bf_lo(ov.y) * bf_lo(g4.y), bf_hi(ov.y) * bf_hi(g4.y));
                w.z = cvt_pk(bf_lo(ov.z) * bf_lo(g4.z), bf_hi(ov.z) * bf_hi(g4.z)); w.w = cvt_pk(bf_lo(ov.w) * bf_lo(g4.w), bf_hi(ov.w) * bf_hi(g4.w));
                *(u32x4*)(op + (size_t)(4 * i) * DM) = w; }
        }
    }
}
}
#define XB_TMO      128
#define XB_XCNT(j)  (256  + 64 * (j))
#define XB_XSUB(j)  (1280 + 64 * (j))
#define XB_XGEN(j)  (2304 + 64 * (j))
#define XB_TOP      3328
#define XB_TOPGEN   3392
#define XCD_BAR_WORDS 3456
#define XB_SPIN_CAP (1u << 18)

__device__ __forceinline__ unsigned xb_ld(unsigned* p)              { return __hip_atomic_load(p, __ATOMIC_RELAXED, __HIP_MEMORY_SCOPE_AGENT); }
__device__ __forceinline__ unsigned xb_add(unsigned* p, unsigned v) { return __hip_atomic_fetch_add(p, v, __ATOMIC_RELAXED, __HIP_MEMORY_SCOPE_AGENT); }
__device__ __forceinline__ unsigned xb_xcc_id() { return (unsigned)__builtin_amdgcn_s_getreg((3 << 11) | 20) & 0xFu; }
#define XB_SPIN(cond, bar) do { unsigned _sp = 0; while (cond) { __builtin_amdgcn_s_sleep(1); \
    if ((++_sp & 255u) == 0u) { if (xb_ld(&(bar)[XB_TMO])) break; if (_sp > XB_SPIN_CAP) { atomicAdd(&(bar)[XB_TMO], 1u); break; } } } } while (0)

struct XcdBarrier {
    unsigned* bar; unsigned x;
    volatile LAS unsigned* st;
};

__device__ __forceinline__ XcdBarrier xcd_barrier_post(unsigned* bar, volatile LAS unsigned* st) {
    XcdBarrier b; b.bar = bar; b.x = xb_xcc_id(); b.st = st;
    if (threadIdx.x == 0) (void)xb_add(&bar[XB_XCNT(b.x)], 1u);
    return b;
}
__device__ __forceinline__ void xcd_barrier_complete(unsigned* bar, unsigned x, unsigned& nloc, unsigned& nx) {
    const unsigned G = gridDim.x * gridDim.y * gridDim.z;
    unsigned sum, cnt, mine, sp = 0u;
    for (;;) {
        sum = 0u; cnt = 0u; mine = 0u;
#pragma unroll
        for (unsigned j = 0; j < 16; ++j) { const unsigned c = xb_ld(&bar[XB_XCNT(j)]); sum += c; cnt += (c > 0u) ? 1u : 0u; mine = (j == x) ? c : mine; }
        if (sum == G) break;
        __builtin_amdgcn_s_sleep(1);
        if ((++sp & 255u) == 0u) { if (xb_ld(&bar[XB_TMO])) break; if (sp > XB_SPIN_CAP) { atomicAdd(&bar[XB_TMO], 1u); break; } }
    }
    nloc = mine > 0u ? mine : 1u; nx = cnt > 0u ? cnt : 1u;
}

__device__ __forceinline__ void xcd_barrier(const XcdBarrier& b) {
    asm volatile("s_waitcnt vmcnt(0)" ::: "memory");
    __syncthreads();
    if (threadIdx.x == 0) {
        unsigned* bar = b.bar;
        __builtin_amdgcn_s_waitcnt(0);
        unsigned nloc = b.st[0], nx = b.st[1];
        if (nloc == 0u) { xcd_barrier_complete(bar, b.x, nloc, nx); b.st[0] = nloc; b.st[1] = nx; }
        const unsigned old = xb_add(&bar[XB_XSUB(b.x)], 1u);
        const unsigned gen = old / nloc;
        if (old + 1u == (gen + 1u) * nloc) {
            __builtin_amdgcn_fence(__ATOMIC_RELEASE, "agent");
            asm volatile("s_waitcnt vmcnt(0)" ::: "memory");
            const unsigned og = xb_add(&bar[XB_TOP], 1u);
            const unsigned tg = og / nx;
            if (og + 1u == (tg + 1u) * nx) xb_add(&bar[XB_TOPGEN], 1u);
            else XB_SPIN(xb_ld(&bar[XB_TOPGEN]) == tg, bar);
            __builtin_amdgcn_fence(__ATOMIC_ACQUIRE, "agent");
            xb_add(&bar[XB_XGEN(b.x)], 1u);
            asm volatile("s_waitcnt vmcnt(0)" ::: "memory");
        } else {
            XB_SPIN(xb_ld(&bar[XB_XGEN(b.x)]) == gen, bar);
            __builtin_amdgcn_fence(__ATOMIC_ACQUIRE, "agent");
            asm volatile("s_waitcnt vmcnt(0)" ::: "memory");
        }
    }
    __syncthreads();
}

__device__ __forceinline__ int win_dst_row(int c) {
    const int seg = c >> 10, w = c & 1023, d6 = w & 63;
    const int wp = d6 < 16 ? (w & ~63) + (d6 < 8 ? 2 * d6 : 2 * (d6 - 8) + 1) : w;
    switch (seg) { case 0: return w; case 1: return 1024 + w; case 2: return 6144 + w; case 3: return 2048 + w;
                   case 4: return 3072 + wp; case 5: return 4096 + wp; case 6: return 7168 + w; default: return 5120 + w; }
}
struct TItem { const float* W; bf16_t* WT; const float* ks; int K, N, win, item; };
__device__ __forceinline__ void tr_load(const TItem& t, float (&v)[32], int lane) {
    const int nblk = t.N / 32, kb = t.item / nblk, nb = t.item % nblk; const float* p = t.W + (size_t)(64 * kb + (lane >> 5)) * t.N + 32 * nb + (lane & 31);
#pragma unroll
    for (int i = 0; i < 32; ++i) v[i] = p[(size_t)(2 * i) * t.N];
}
__device__ __forceinline__ void tr_write(const float (&v)[32], LAS float* scr, int lane) {
#pragma unroll
    for (int i = 0; i < 32; ++i) scr[(2 * i + (lane >> 5)) * 33 + (lane & 31)] = v[i];
}
__device__ __forceinline__ void tr_store(const TItem& t, LAS float* scr, int lane) {
    const int nblk = t.N / 32, kb = t.item / nblk, nb = t.item % nblk, k0 = 64 * kb, n0 = 32 * nb, c = lane & 7;
    f32x4 s0 = {1.f, 1.f, 1.f, 1.f}, s1 = {1.f, 1.f, 1.f, 1.f};
    if (t.ks) { s0 = *(const f32x4*)(t.ks + k0 + 8 * c); s1 = *(const f32x4*)(t.ks + k0 + 8 * c + 4); }
#pragma unroll
    for (int j = 0; j < 4; ++j) { const int n = (lane >> 3) + 8 * j; const LAS float* s = scr + (8 * c) * 33 + n;
        u32x4 o; o.x = cvt_pk(s[0 * 33] * s0[0], s[1 * 33] * s0[1]); o.y = cvt_pk(s[2 * 33] * s0[2], s[3 * 33] * s0[3]); o.z = cvt_pk(s[4 * 33] * s1[0], s[5 * 33] * s1[1]); o.w = cvt_pk(s[6 * 33] * s1[2], s[7 * 33] * s1[3]);
        const int dn = t.win ? win_dst_row(n0 + n) : (n0 + n);
        *(u32x4*)(t.WT + (size_t)dn * t.K + k0 + 8 * c) = o; }
}
__device__ __forceinline__ void rms_load(const float* __restrict__ xrow, f32x4 (&v)[8], int lane) {
    const f32x4* xr = (const f32x4*)xrow + lane;
#pragma unroll
    for (int j = 0; j < 8; ++j) v[j] = xr[64 * j];
}
__device__ __forceinline__ void rms_finish(const f32x4 (&v)[8], const f32x4 (&gv)[8], bf16_t* __restrict__ orow, int lane) {
    float s = 0.f;
#pragma unroll
    for (int j = 0; j < 8; ++j) s += (v[j][0] * v[j][0] + v[j][1] * v[j][1]) + (v[j][2] * v[j][2] + v[j][3] * v[j][3]);
    const float rstd = rsqrtf(wave_sum(s) * (1.f / DM) + NORM_EPS);
    u32x2* o8 = (u32x2*)orow + lane;
#pragma unroll
    for (int j = 0; j < 8; ++j) { u32x2 w; w.x = cvt_pk(v[j][0] * rstd * gv[j][0], v[j][1] * rstd * gv[j][1]); w.y = cvt_pk(v[j][2] * rstd * gv[j][2], v[j][3] * rstd * gv[j][3]); o8[64 * j] = w; }
}

struct Args { const float* in[14]; float* out; unsigned char* ws; };

__global__ void __launch_bounds__(512, 2) fwd_megakernel(Args a) {
    extern __shared__ __attribute__((aligned(16))) unsigned char lds_raw[];
    LAS unsigned char* lds = (LAS unsigned char*)lds_raw;
    { cg::grid_group grid = cg::this_grid(); if (a.ws == nullptr) grid.sync(); }
    const int tid = threadIdx.x, lane = tid & 63, wave = __builtin_amdgcn_readfirstlane(tid >> 6);
    const int G = gridDim.x, bx = blockIdx.x;
    const int vcu = (G % 8 == 0) ? (bx % 8) * (G / 8) + bx / 8 : bx;
    unsigned char* ws = a.ws;
    float* ss2 = (float*)(ws + WS_CTL + CTL_SS2); float* ss3 = (float*)(ws + WS_CTL + CTL_SS3); float* lamp = (float*)(ws + WS_CTL + CTL_LAM); float* rope = (float*)(ws + WS_CTL + CTL_ROPE);
    bf16_t* WIN = (bf16_t*)(ws + WS_WIN); bf16_t* WOUT = (bf16_t*)(ws + WS_WOUT); bf16_t* WGATE = (bf16_t*)(ws + WS_WGATE); bf16_t* WPROJ = (bf16_t*)(ws + WS_WPROJ);
    bf16_t* PB = (bf16_t*)(ws + WS_PB); bf16_t* XN = (bf16_t*)(ws + WS_XN); bf16_t* MIXED = (bf16_t*)(ws + WS_MIXED); bf16_t* PROJ = (bf16_t*)(ws + WS_PROJ);
    bf16_t* VT = (bf16_t*)(ws + WS_VT); bf16_t* KIMG = (bf16_t*)(ws + WS_KIMG); bf16_t* HB = (bf16_t*)(ws + WS_HB); bf16_t* PLEB = (bf16_t*)(ws + WS_PLE); bf16_t* H2B = (bf16_t*)(ws + WS_H2B);
    const float* x = a.in[0]; float* out = a.out;
    volatile LAS unsigned* xst = (volatile LAS unsigned*)(lds + 131072);
    if (tid == 0) { xst[0] = 0u; xst[1] = 0u; }
    __syncthreads();
    const XcdBarrier xb = xcd_barrier_post((unsigned*)(ws + WS_CTL + CTL_BAR), xst);

    for (int rep_ = 0; rep_ < ((PROBE_DUP & 1) ? 2 : 1); ++rep_) {
        if (rep_) __syncthreads();
        const int gw = bx * 8 + wave, NGW = G * 8; const int gt = bx * 512 + tid, NGT = G * 512;
        for (int i = gt; i < 2 * NTOK; i += NGT) ss2[i] = 0.f;
        if (gt == 0) { float s1 = 0.f, s2 = 0.f; for (int i = 0; i < 64; ++i) { s1 += a.in[4][i] * a.in[5][i]; s2 += a.in[6][i] * a.in[7][i]; } lamp[0] = expf(s1) - expf(s2) + LAMBDA_INIT; }
        for (int i = gt; i < SEQ * 8; i += NGT) { const int pos = i >> 3, f = i & 7;
            const float invf = (float)exp2(-(double)f * 0.125 * 18.931568569324174);
            const float angf = (float)pos * invf;
            const double tw = 6.283185307179586476925; double ang = (double)angf; ang -= tw * rint(ang / tw);
            rope[2 * i] = (float)cos(ang); rope[2 * i + 1] = (float)sin(ang); }
        LAS float* scr = (LAS float*)(lds + wave * 16384);
        constexpr int I_IN = (DM / 64) * (8192 / 32), I_SQ = (DM / 64) * (DM / 32), I_PR = (PLE / 64) * (DM / 32), I_ALL = I_IN + 2 * I_SQ + I_PR;
#define P0_DECODE(T, it_) do { int rr_ = (it_); \
            if (rr_ < I_IN) { T = TItem{a.in[3], WIN, nullptr, DM, 8192, 1, rr_}; } \
            else if (rr_ < I_IN + I_SQ) { T = TItem{a.in[9], WOUT, nullptr, DM, DM, 0, rr_ - I_IN}; } \
            else if (rr_ < I_IN + 2 * I_SQ) { T = TItem{a.in[11], WGATE, a.in[10], DM, DM, 0, rr_ - I_IN - I_SQ}; } \
            else { T = TItem{a.in[12], WPROJ, nullptr, PLE, DM, 0, rr_ - I_IN - 2 * I_SQ}; } } while (0)
        {
            float tv[32]; TItem cur, nxt; int it = gw;
            if (it < I_ALL) { P0_DECODE(cur, it); tr_load(cur, tv, lane); }
            while (it < I_ALL) {
                tr_write(tv, scr, lane);
                const int itn = it + NGW;
                if (itn < I_ALL) { P0_DECODE(nxt, itn); tr_load(nxt, tv, lane); }
                asm volatile("s_waitcnt lgkmcnt(0)" ::: "memory");
                tr_store(cur, scr, lane);
                asm volatile("s_waitcnt lgkmcnt(0)" ::: "memory");
                cur = nxt; it = itn;
            }
        }
#undef P0_DECODE
        {
            f32x4 gv[8], va[8], vb[8];
            { const f32x4* gr = (const f32x4*)a.in[2] + lane;
#pragma unroll
              for (int j = 0; j < 8; ++j) gv[j] = gr[64 * j]; }
            int m = gw;
            if (m < NTOK) rms_load(x + (size_t)m * DM, va, lane);
            for (; m < NTOK; m += 2 * NGW) {
                const int m1 = m + NGW, m2 = m + 2 * NGW;
                if (m1 < NTOK) rms_load(x + (size_t)m1 * DM, vb, lane);
                rms_finish(va, gv, XN + (size_t)m * DM, lane);
                if (m2 < NTOK) rms_load(x + (size_t)m2 * DM, va, lane);
                if (m1 < NTOK) rms_finish(vb, gv, XN + (size_t)m1 * DM, lane);
            }
        }
        for (int i = gt; i < NTOK * PLE / 8; i += NGT) { const f32x4 v0 = ((const f32x4*)a.in[1])[2 * i], v1 = ((const f32x4*)a.in[1])[2 * i + 1];
            u32x4 w; w.x = cvt_pk(v0[0], v0[1]); w.y = cvt_pk(v0[2], v0[3]); w.z = cvt_pk(v1[0], v1[1]); w.w = cvt_pk(v1[2], v1[3]); ((u32x4*)PB)[i] = w; }
    }
    xcd_barrier(xb);
    for (int rep_ = 0; rep_ < ((PROBE_DUP & 2) ? 2 : 1); ++rep_) {
        if (rep_) __syncthreads();
        { pg8::Gemm g{XN, WIN, NTOK, NPROJ, DM}; pg8::StaticOrder S; S.init(NTOK, NPROJ, G, bx); pg8::EpiProj E{PROJ, rope, KIMG};
          pg8::gemm_phase<pg8::EpiProj, pg8::StaticOrder, true, true>(lds, g, S, E); }
        __syncthreads();
        { pg8::Gemm g{WIN + (size_t)NPROJ * DM, XN, 2048, NTOK, DM}; pg8::StaticOrder S; S.init(2048, NTOK, G, bx); pg8::EpiVt E{VT};
          pg8::gemm_phase<pg8::EpiVt, pg8::StaticOrder, true, true>(lds, g, S, E); }
    }
    xcd_barrier(xb);
    for (int rep_ = 0; rep_ < ((PROBE_DUP & 4) ? 2 : 1); ++rep_) {
        const float lam = lamp[0];
        for (int su = vcu; su < 256; su += G) {
            const int grp = su >> 4, j = su & 15;
#pragma unroll 1
            for (int k = 0; k < 4; ++k) { const int bh = 4 * grp + k; const int qb = (k & 1) ? 15 - j : j;
                att::attn_unit_df(lds, PROJ, KIMG, VT, MIXED, bh >> 3, bh & 7, qb, lam, a.in[8]); }
        }
#pragma unroll 1
        for (int u = vcu; u < 512; u += G) att::attn_unit<0>(lds, PROJ, KIMG, VT, MIXED, (u >> 3) >> 3, (u >> 3) & 7, u & 7, lam, a.in[8]);
    }
    xcd_barrier(xb);
    {
        __syncthreads();
        { pg8::Gemm g{MIXED, WOUT, NTOK, DM, DM}; pg8::StaticOrder S; S.init(NTOK, DM, G, bx); pg8::EpiRes E{x, HB, ss2};
          pg8::gemm_phase<pg8::EpiRes, pg8::StaticOrder, true, true>(lds, g, S, E); }
        __syncthreads();
        { pg8::Gemm g{PB, WPROJ, NTOK, DM, PLE}; pg8::StaticOrder S; S.init(NTOK, DM, G, bx); pg8::EpiBf16 E{PLEB, DM};
          pg8::gemm_phase<pg8::EpiBf16, pg8::StaticOrder, true, true>(lds, g, S, E); }
    }
    xcd_barrier(xb);
    {
        pg8::Gemm g{HB, WGATE, NTOK, DM, DM}; pg8::StaticOrder S; S.init(NTOK, DM, G, bx); pg8::EpiGate E{HB, H2B, PLEB, ss2, ss3};
        pg8::gemm_phase<pg8::EpiGate, pg8::StaticOrder, true, true>(lds, g, S, E);
    }
    xcd_barrier(xb);
    {
        const int tid5 = opaque_tid(), lane = tid5 & 63, wave = __builtin_amdgcn_readfirstlane(tid5 >> 6);
        const int gw = bx * 8 + wave, NGW = G * 8; const f32x4* gr = (const f32x4*)a.in[13];
        f32x4 gv[8];
#pragma unroll
        for (int j = 0; j < 4; ++j) { gv[2 * j] = gr[2 * (lane + 64 * j)]; gv[2 * j + 1] = gr[2 * (lane + 64 * j) + 1]; }
#define P5_LOAD(H, S_, m_) do { const u32x4* hrow_ = (const u32x4*)(H2B + (size_t)(m_) * DM); S_ = ss3[m_]; _Pragma("unroll") for (int j_ = 0; j_ < 4; ++j_) H[j_] = hrow_[lane + 64 * j_]; } while (0)
#define P5_STORE(H, S_, m_) do { const float rstd_ = rsqrtf(S_ * (1.f / DM) + NORM_EPS); f32x4* orow_ = (f32x4*)(out + (size_t)(m_) * DM); \
            _Pragma("unroll") for (int j_ = 0; j_ < 4; ++j_) { const int c_ = lane + 64 * j_; const u32x4 hw_ = H[j_]; const f32x4 g0_ = gv[2 * j_], g1_ = gv[2 * j_ + 1]; \
                orow_[2 * c_] = (f32x4){bf_lo(hw_.x) * rstd_ * g0_[0], bf_hi(hw_.x) * rstd_ * g0_[1], bf_lo(hw_.y) * rstd_ * g0_[2], bf_hi(hw_.y) * rstd_ * g0_[3]}; \
                orow_[2 * c_ + 1] = (f32x4){bf_lo(hw_.z) * rstd_ * g1_[0], bf_hi(hw_.z) * rstd_ * g1_[1], bf_lo(hw_.w) * rstd_ * g1_[2], bf_hi(hw_.w) * rstd_ * g1_[3]}; } } while (0)
        u32x4 ha[4], hb4[4]; float sa = 0.f, sb = 0.f;
        int m = gw;
        if (m < NTOK) P5_LOAD(ha, sa, m);
        for (; m < NTOK; m += 2 * NGW) {
            const int m1 = m + NGW, m2 = m + 2 * NGW;
            if (m1 < NTOK) P5_LOAD(hb4, sb, m1);
            P5_STORE(ha, sa, m);
            if (m2 < NTOK) P5_LOAD(ha, sa, m2);
            if (m1 < NTOK) P5_STORE(hb4, sb, m1);
        }
#undef P5_LOAD
#undef P5_STORE
    }
}

extern "C" void kernel_launch(void* const* d_in, const int* in_sizes, int n_in, void* d_out, int out_size, void* d_ws, size_t ws_size, hipStream_t stream) {
    static int grid = 0;
    if (grid == 0) {
        if (n_in != 14 || out_size != NTOK * DM || ws_size < WS_END) { fprintf(stderr, "kernel_launch: unexpected shapes (n_in %d out %d ws %zu)\n", n_in, out_size, ws_size); grid = -1; return; }
        int dev = 0, cus = 0, per_cu = 0;
        (void)hipGetDevice(&dev); (void)hipDeviceGetAttribute(&cus, hipDeviceAttributeMultiprocessorCount, dev);
        (void)hipFuncSetAttribute((const void*)fwd_megakernel, hipFuncAttributeMaxDynamicSharedMemorySize, LDS_BYTES);
        (void)hipOccupancyMaxActiveBlocksPerMultiprocessor(&per_cu, (const void*)fwd_megakernel, 512, LDS_BYTES);
        if (per_cu < 1) { fprintf(stderr, "kernel_launch: occupancy query says %d blocks/CU\n", per_cu); per_cu = 1; }
        grid = cus * per_cu;
    }
    if (grid < 0) return;
    Args a{};
    for (int i = 0; i < 14; ++i) a.in[i] = (const float*)d_in[i];
    a.out = (float*)d_out; a.ws = (unsigned char*)d_ws;
    (void)hipMemsetAsync((unsigned char*)d_ws + WS_CTL + CTL_BAR, 0, CTL_BAR_BYTES, stream);
    void* args[] = {&a};
    hipError_t e = hipLaunchCooperativeKernel((void*)fwd_megakernel, dim3(grid), dim3(512), args, LDS_BYTES, stream);
    if (e != hipSuccess) fprintf(stderr, "cooperative launch failed: %s (grid %d)\n", hipGetErrorString(e), grid);
}
```

```cpp
#include <hip/hip_runtime.h>
#include <hip/hip_cooperative_groups.h>
#include <cstdio>
#include <cstdint>
namespace cg = cooperative_groups;
__device__ __forceinline__ int opaque_tid() { int t = (int)threadIdx.x; asm volatile("" : "+v"(t)); return t; }
#ifndef PROBE_DUP
#define PROBE_DUP 0
#endif
namespace pg8 {
#define PG8_LAS __attribute__((address_space(3)))
typedef unsigned short bf16_t;
typedef short bf16x8 __attribute__((ext_vector_type(8)));
typedef float f32x4 __attribute__((ext_vector_type(4)));
typedef unsigned u32x4 __attribute__((ext_vector_type(4)));
constexpr int BM = 256, BK = 64, HALF = 128, HTB = HALF * BK * 2  , STAGE_BYTES = 8 * HTB, NXCD = 8, WGM = 8;

__host__ __device__ __forceinline__ int lds_byte(int r, int c) { const int st = (r >> 4) * 2 + (c >> 5), rr = r & 15, cc = c & 31, ob = rr * 64 + cc * 2; return st * 1024 + (ob ^ (((ob >> 9) & 1) << 5)); }
__host__ __device__ __forceinline__ void stage_rc(int b, int& R, int& C) { const int st = b / 1024, sb = b % 1024, swz = sb ^ (((sb >> 9) & 1) << 5); R = (st >> 1) * 16 + swz / 64; C = (st & 1) * 32 + (swz % 64) / 2; }
__host__ __device__ __forceinline__ int perm32(int rho) { const int n = rho >> 4, i = rho & 15; return 8 * (i >> 2) + 4 * n + (i & 3); }

struct Unit { int pm, pn; };
struct Gemm { const bf16_t* A; const bf16_t* Bt; int M, N, K; };

struct StaticOrder {
    int nM, nN, nwg, G, c;
    __host__ __device__ void init(int M, int N, int G_, int c_) { nM = M / BM; nN = N / BM; nwg = nM * nN; G = G_; c = c_; }
    __host__ __device__ bool next(int i, Unit& u) const {
        const long L = (long)i * G + c; if (L >= nwg) return false;
        int wgid = (int)L; { const int q = nwg / NXCD, r = nwg % NXCD, xcd = wgid % NXCD, off = wgid / NXCD; wgid = (xcd < r ? xcd * (q + 1) : r * (q + 1) + (xcd - r) * q) + off; }
        const int nig = WGM * nN, gid = wgid / nig, fm = gid * WGM, gsz = (nM - fm) < WGM ? (nM - fm) : WGM;
        u.pm = fm + ((wgid % nig) % gsz); u.pn = (wgid % nig) / gsz; return true;
    }
    __device__ __forceinline__ void a_ready(const Unit&) const {}
    __device__ __forceinline__ void done(const Unit&) const {}
};

__device__ __forceinline__ unsigned cvt_pk_bf16(float lo, float hi) { unsigned r; asm volatile("v_cvt_pk_bf16_f32 %0, %1, %2" : "=v"(r) : "v"(lo), "v"(hi)); return r; }
typedef float f32x2 __attribute__((ext_vector_type(2)));
template <class Epi, class Sched, bool ALIGN_EPI = false, bool SP2 = false>
__device__ __forceinline__ void gemm_phase(PG8_LAS unsigned char* lds, const Gemm g, const Sched& S, const Epi& E) {
    const int tid = opaque_tid(), wid = __builtin_amdgcn_readfirstlane(tid >> 6), lane = tid & 63, wr = wid >> 2, wc = wid & 3, fr = lane & 15, fq = lane >> 4;
    const int K = g.K, nt = K / BK;
    unsigned voffA[2], voffB[2];
#pragma unroll
    for (int i = 0; i < 2; ++i) { int R, C; stage_rc(tid * 16 + i * 8192, R, C); const int Rb = Epi::PERM ? ((R & ~31) + perm32(R & 31)) : R;
        voffA[i] = (unsigned)(R * K + C) * 2u; voffB[i] = (unsigned)(Rb * K + C) * 2u; }
    const size_t kstep = (size_t)(BK * 2);
    const size_t hstep = (size_t)HALF * K * 2;
    const size_t tstep = 2 * hstep;
    const unsigned ldsw = (unsigned)wid * 1024u;
    const int aoff = lds_byte(wr * 64 + fr, fq * 8), boff = lds_byte(wc * 32 + fr, fq * 8);
#define PG8_SA(b, h) (((b) * 2 + (h)) * HTB)
#define PG8_SB(b, h) ((4 + (b) * 2 + (h)) * HTB)
#define PG8_STAGE(bufoff, gbase, voff) do { _Pragma("unroll") for (int _i = 0; _i < 2; ++_i) \
        __builtin_amdgcn_global_load_lds((const unsigned*)((const char*)(gbase) + (voff)[_i]), (PG8_LAS unsigned*)(lds + (bufoff) + ldsw + _i * 8192), 16, 0, 0); } while (0)
#define PG8_LDA(dst, b, h) do { _Pragma("unroll") for (int m = 0; m < 4; ++m) _Pragma("unroll") for (int k = 0; k < 2; ++k) dst[m][k] = *(const PG8_LAS bf16x8*)(lds + PG8_SA(b, h) + aoff + m * 2048 + k * 1024); } while (0)
#define PG8_LDB(dst, b, h) do { _Pragma("unroll") for (int n = 0; n < 2; ++n) _Pragma("unroll") for (int k = 0; k < 2; ++k) dst[n][k] = *(const PG8_LAS bf16x8*)(lds + PG8_SB(b, h) + boff + n * 2048 + k * 1024); } while (0)
#define PG8_MMA(ai, bj, At, Bt) do { __builtin_amdgcn_s_setprio(1); _Pragma("unroll") for (int m = 0; m < 4; ++m) _Pragma("unroll") for (int n = 0; n < 2; ++n) _Pragma("unroll") for (int k = 0; k < 2; ++k) \
        acc[ai][bj][m][n] = __builtin_amdgcn_mfma_f32_16x16x32_bf16(Bt[n][k], At[m][k], acc[ai][bj][m][n], 0, 0, 0); __builtin_amdgcn_s_setprio(0); } while (0)
#define PG8_WAIT_V(n) asm volatile("s_waitcnt vmcnt(" #n ")" ::: "memory")
#define PG8_WAIT_L(n) asm volatile("s_waitcnt lgkmcnt(" #n ")" ::: "memory")
#define PG8_BAR __builtin_amdgcn_s_barrier()
#define PG8_SCHED __builtin_amdgcn_sched_barrier(0)
    Unit cur, nxt; int ui = 0;
    if (!S.next(0, cur)) return;
    f32x4 acc[2][2][4][2];
#pragma unroll
    for (int a = 0; a < 2; ++a)
#pragma unroll
        for (int b = 0; b < 2; ++b)
#pragma unroll
            for (int m = 0; m < 4; ++m)
#pragma unroll
                for (int n = 0; n < 2; ++n) acc[a][b][m][n] = (f32x4){0.f, 0.f, 0.f, 0.f};
    bf16x8 At[4][2], B0[2][2], B1[2][2];
    const char* cA = (const char*)g.A + (size_t)cur.pm * tstep; const char* cB = (const char*)g.Bt + (size_t)cur.pn * tstep;
    S.a_ready(cur);
    if constexpr (SP2) {
        PG8_STAGE(PG8_SB(0, 0), cB, voffB); PG8_STAGE(PG8_SB(0, 1), cB + hstep, voffB); PG8_STAGE(PG8_SA(0, 0), cA, voffA); PG8_STAGE(PG8_SA(0, 1), cA + hstep, voffA);
        if (wr == 1) PG8_BAR;
        PG8_WAIT_V(2); PG8_BAR;
        PG8_STAGE(PG8_SB(1, 0), cB + kstep, voffB); PG8_STAGE(PG8_SA(1, 0), cA + kstep, voffA); PG8_STAGE(PG8_SB(1, 1), cB + hstep + kstep, voffB);
        PG8_WAIT_V(6); PG8_BAR;
    } else {
        PG8_STAGE(PG8_SB(0, 0), cB, voffB); PG8_STAGE(PG8_SA(0, 0), cA, voffA); PG8_STAGE(PG8_SB(0, 1), cB + hstep, voffB); PG8_STAGE(PG8_SA(0, 1), cA + hstep, voffA);
        if (wr == 1) PG8_BAR;
        PG8_WAIT_V(4); PG8_BAR;
        PG8_STAGE(PG8_SB(1, 0), cB + kstep, voffB); PG8_STAGE(PG8_SA(1, 0), cA + kstep, voffA); PG8_STAGE(PG8_SB(1, 1), cB + hstep + kstep, voffB);
        PG8_WAIT_V(6); PG8_BAR;
    }
    for (;;) {
        const bool has_next = S.next(ui + 1, nxt);
        const char* nA = has_next ? (const char*)g.A + (size_t)nxt.pm * tstep : cA; const char* nB = has_next ? (const char*)g.Bt + (size_t)nxt.pn * tstep : cB;
        for (int t = 0; t < nt; t += 2) {
            const bool last = (t == nt - 2);
            const char* a1 = cA + (size_t)(t + 1) * kstep;
            const char* a2 = last ? nA : cA + (size_t)(t + 2) * kstep; const char* b2 = last ? nB : cB + (size_t)(t + 2) * kstep;
            const char* a3 = a2 + kstep; const char* b3 = b2 + kstep;
            if (last && has_next) S.a_ready(nxt);
            if constexpr (SP2) {
            PG8_LDB(B0, 0, 0); PG8_LDB(B1, 0, 1); PG8_SCHED; PG8_LDA(At, 0, 0); PG8_STAGE(PG8_SA(1, 1), a1 + hstep, voffA);
            PG8_WAIT_V(8); PG8_WAIT_L(0); PG8_BAR; PG8_MMA(0, 0, At, B0); PG8_MMA(0, 1, At, B1); PG8_BAR; PG8_SCHED;
            PG8_LDA(At, 0, 1); PG8_STAGE(PG8_SB(0, 0), b2, voffB); PG8_STAGE(PG8_SB(0, 1), b2 + hstep, voffB); PG8_STAGE(PG8_SA(0, 0), a2, voffA);
            PG8_WAIT_V(8); PG8_WAIT_L(0); PG8_BAR; PG8_MMA(1, 0, At, B0); PG8_MMA(1, 1, At, B1); PG8_BAR; PG8_SCHED;
            PG8_LDB(B0, 1, 0); PG8_LDB(B1, 1, 1); PG8_SCHED; PG8_LDA(At, 1, 0); PG8_STAGE(PG8_SA(0, 1), a2 + hstep, voffA);
            PG8_WAIT_V(8); PG8_WAIT_L(0); PG8_BAR; PG8_MMA(0, 0, At, B0); PG8_MMA(0, 1, At, B1); PG8_BAR; PG8_SCHED;
            PG8_LDA(At, 1, 1); PG8_STAGE(PG8_SB(1, 0), b3, voffB); PG8_STAGE(PG8_SB(1, 1), b3 + hstep, voffB); PG8_STAGE(PG8_SA(1, 0), a3, voffA);
            PG8_WAIT_V(8); PG8_WAIT_L(0); PG8_BAR; PG8_MMA(1, 0, At, B0); PG8_MMA(1, 1, At, B1); PG8_BAR; PG8_SCHED;
            } else {
            PG8_LDB(B0, 0, 0); PG8_SCHED; PG8_LDA(At, 0, 0); PG8_STAGE(PG8_SA(1, 1), a1 + hstep, voffA);
            PG8_WAIT_L(8); PG8_BAR; PG8_WAIT_L(0); PG8_MMA(0, 0, At, B0); PG8_BAR; PG8_SCHED;
            PG8_LDB(B1, 0, 1); PG8_STAGE(PG8_SB(0, 0), b2, voffB);
            PG8_BAR; PG8_WAIT_L(0); PG8_MMA(0, 1, At, B1); PG8_BAR;
            PG8_LDA(At, 0, 1); PG8_STAGE(PG8_SA(0, 0), a2, voffA);
            PG8_BAR; PG8_WAIT_L(0); PG8_MMA(1, 0, At, B0); PG8_BAR; PG8_SCHED;
            PG8_STAGE(PG8_SB(0, 1), b2 + hstep, voffB);
            PG8_WAIT_V(6); PG8_BAR; PG8_MMA(1, 1, At, B1); PG8_BAR;
            PG8_LDB(B0, 1, 0); PG8_SCHED; PG8_LDA(At, 1, 0); PG8_STAGE(PG8_SA(0, 1), a2 + hstep, voffA);
            PG8_WAIT_L(8); PG8_BAR; PG8_WAIT_L(0); PG8_MMA(0, 0, At, B0); PG8_BAR; PG8_SCHED;
            PG8_LDB(B1, 1, 1); PG8_STAGE(PG8_SB(1, 0), b3, voffB);
            PG8_BAR; PG8_WAIT_L(0); PG8_MMA(0, 1, At, B1); PG8_BAR;
            PG8_LDA(At, 1, 1); PG8_STAGE(PG8_SA(1, 0), a3, voffA);
            PG8_BAR; PG8_WAIT_L(0); PG8_MMA(1, 0, At, B0); PG8_BAR; PG8_SCHED;
            PG8_STAGE(PG8_SB(1, 1), b3 + hstep, voffB);
            PG8_WAIT_V(6); PG8_BAR; PG8_MMA(1, 1, At, B1); PG8_BAR;
            }
        }
        if constexpr (ALIGN_EPI) { if (wr == 0) PG8_BAR; }
        if constexpr (!Epi::AFTER_DRAIN) { E(acc, cur, wr, wc, fr, fq); S.done(cur); }
        if (!has_next) break;
#pragma unroll
        for (int a = 0; a < 2; ++a)
#pragma unroll
            for (int b = 0; b < 2; ++b)
#pragma unroll
                for (int m = 0; m < 4; ++m)
#pragma unroll
                    for (int n = 0; n < 2; ++n) acc[a][b][m][n] = (f32x4){0.f, 0.f, 0.f, 0.f};
        cur = nxt; cA = nA; cB = nB; ++ui;
        if constexpr (ALIGN_EPI) { if (wr == 1) PG8_BAR; }
    }
    PG8_WAIT_V(0);
    if constexpr (!ALIGN_EPI) { if (wr == 0) PG8_BAR; }
    PG8_BAR;
    if constexpr (Epi::AFTER_DRAIN) { E.fused(acc, cur, wr, wc, fr, fq, lds, wid, lane); S.done(cur); }
#undef PG8_SA
#undef PG8_SB
#undef PG8_STAGE
#undef PG8_LDA
#undef PG8_LDB
#undef PG8_MMA
#undef PG8_WAIT_V
#undef PG8_WAIT_L
#undef PG8_BAR
#undef PG8_SCHED
}
}
#define LAS __attribute__((address_space(3)))
typedef unsigned short bf16_t;
typedef short bf16x8 __attribute__((ext_vector_type(8)));
typedef float f32x4 __attribute__((ext_vector_type(4)));
typedef float f32x2 __attribute__((ext_vector_type(2)));
typedef float f32x16 __attribute__((ext_vector_type(16)));
typedef unsigned u32x4 __attribute__((ext_vector_type(4)));
typedef unsigned u32x2 __attribute__((ext_vector_type(2)));

constexpr int NTOK = 16384, DM = 2048, SEQ = 2048, NBATCH = 8, PLE = 256;
constexpr int NPROJ = 6144;
constexpr int PQ_SB = 0, PK_SB = 1024, PG_SB = 2048, PQ_DF = 3072, PK_DF = 4096, PG_DF = 5120;
constexpr float LOG2E = 1.4426950408889634f;
constexpr float SBQ_SCALE = 0.08838834764831845f * LOG2E;
constexpr float DFQ_SCALE = 0.125f * LOG2E;
constexpr float NORM_EPS = 1e-6f, SUBLN_EPS = 1e-5f;
constexpr float LAMBDA_INIT = 0.2f;

constexpr size_t MiB = 1u << 20;
constexpr size_t WS_CTL = 0;
constexpr size_t CTL_SS2 = 0, CTL_SS3 = 65536, CTL_LAM = 131072, CTL_ROPE = 262144, CTL_BAR = 524288, CTL_BAR_BYTES = 16384;
constexpr size_t WS_WIN = 2 * MiB, WS_WOUT = 34 * MiB, WS_WGATE = 42 * MiB, WS_WPROJ = 50 * MiB, WS_PB = 52 * MiB;
constexpr size_t WS_XN = 64 * MiB, WS_MIXED = 64 * MiB;
constexpr size_t WS_PROJ = 128 * MiB, WS_VT = 320 * MiB, WS_KIMG = 384 * MiB, WS_END = 448 * MiB;
constexpr size_t WS_HB = 128 * MiB, WS_PLE = 192 * MiB;
constexpr size_t WS_H2B = 64 * MiB;

constexpr int LDS_BYTES = 131072 + 1024;

typedef __bf16 bf16x2_t __attribute__((ext_vector_type(2)));
__device__ __forceinline__ unsigned cvt_pk(float lo, float hi) { f32x2 v = {lo, hi}; bf16x2_t b = __builtin_convertvector(v, bf16x2_t); return __builtin_bit_cast(unsigned, b); }
__device__ __forceinline__ float bf_lo(unsigned w) { return __uint_as_float(w << 16); }
__device__ __forceinline__ float bf_hi(unsigned w) { return __uint_as_float(w & 0xffff0000u); }
__device__ __forceinline__ float wave_sum(float v) {
#pragma unroll
    for (int o = 1; o < 64; o <<= 1) v += __shfl_xor(v, o);
    return v;
}
__device__ __forceinline__ float fast_exp2(float x) { return __builtin_amdgcn_exp2f(x); }
__device__ __forceinline__ float fast_log2(float x) { return __builtin_amdgcn_logf(x); }
__device__ __forceinline__ float silu_f(float x) { return x * __builtin_amdgcn_rcpf(1.f + fast_exp2(-x * LOG2E)); }
__device__ __forceinline__ float sigmoid_f(float x) { return __builtin_amdgcn_rcpf(1.f + fast_exp2(-x * LOG2E)); }

namespace pg8 {
struct EpiBf16 {
    static constexpr bool PERM = true, AFTER_DRAIN = false;
    bf16_t* O; int ldc;
    __device__ __forceinline__ void operator()(const f32x4 (&acc)[2][2][4][2], const Unit& u, int wr, int wc, int fr, int fq) const {
        const int row0 = u.pm * BM + wr * 64 + fr; const int col0 = u.pn * BM + wc * 32 + 8 * fq;
#pragma unroll
        for (int ai = 0; ai < 2; ++ai)
#pragma unroll
            for (int m = 0; m < 4; ++m) { bf16_t* rowp = O + (size_t)(row0 + ai * HALF + m * 16) * ldc + col0;
#pragma unroll
                for (int bj = 0; bj < 2; ++bj) { const f32x4 v0 = acc[ai][bj][m][0], v1 = acc[ai][bj][m][1];
                    u32x4 w; w.x = cvt_pk_bf16(v0[0], v0[1]); w.y = cvt_pk_bf16(v0[2], v0[3]); w.z = cvt_pk_bf16(v1[0], v1[1]); w.w = cvt_pk_bf16(v1[2], v1[3]);
                    *(u32x4*)(rowp + bj * HALF) = w; } }
    }
};
struct EpiProj {
    static constexpr bool PERM = true, AFTER_DRAIN = false;
    bf16_t* O; const float* rope; bf16_t* KI;
    __device__ __forceinline__ void operator()(const f32x4 (&acc)[2][2][4][2], const Unit& u, int wr, int wc, int fr, int fq) const {
        const int row0 = u.pm * BM + wr * 64 + fr; const int col0 = u.pn * BM + wc * 32 + 8 * fq;
        const int kind = u.pn >> 2;
        const bool dorope = (kind == 3 || kind == 4) && ((wc & 1) == 0) && (fq < 2);
        const float sc = kind == 0 ? SBQ_SCALE : (kind == 3 ? DFQ_SCALE : 1.f);
        const bool dosilu = (kind == 2 || kind == 5);
#pragma unroll
        for (int ai = 0; ai < 2; ++ai)
#pragma unroll
            for (int m = 0; m < 4; ++m) { const int row = row0 + ai * HALF + m * 16; bf16_t* rowp = O + (size_t)row * NPROJ + col0;
                if (kind == 1 || kind == 4) {
                    const int cw = col0 & 1023; rowp = KI + ((size_t)(((kind == 4 ? 8 : 0) + (row >> 11)) * 8 + (cw >> 7)) * SEQ + (row & (SEQ - 1))) * 128 + (cw & 127); }
                f32x4 cs0 = {1.f, 0.f, 1.f, 0.f}, cs1 = {1.f, 0.f, 1.f, 0.f};
                if (dorope) { const f32x4* rp = (const f32x4*)(rope + ((size_t)(row & (SEQ - 1)) * 8 + 4 * fq) * 2); cs0 = rp[0]; cs1 = rp[1]; }
#pragma unroll
                for (int bj = 0; bj < 2; ++bj) { f32x4 v0 = acc[ai][bj][m][0], v1 = acc[ai][bj][m][1];
                    if (dorope) {
                        f32x4 a, b;
                        a[0] = v0[0] * cs0[0] - v0[1] * cs0[1]; a[1] = v0[1] * cs0[0] + v0[0] * cs0[1];
                        a[2] = v0[2] * cs0[2] - v0[3] * cs0[3]; a[3] = v0[3] * cs0[2] + v0[2] * cs0[3];
                        b[0] = v1[0] * cs1[0] - v1[1] * cs1[1]; b[1] = v1[1] * cs1[0] + v1[0] * cs1[1];
                        b[2] = v1[2] * cs1[2] - v1[3] * cs1[3]; b[3] = v1[3] * cs1[2] + v1[2] * cs1[3];
                        v0 = a; v1 = b; }
                    if (dosilu) {
#pragma unroll
                        for (int j = 0; j < 4; ++j) { v0[j] = silu_f(v0[j]); v1[j] = silu_f(v1[j]); } }
                    v0 = v0 * sc; v1 = v1 * sc;
                    u32x4 w; w.x = cvt_pk_bf16(v0[0], v0[1]); w.y = cvt_pk_bf16(v0[2], v0[3]); w.z = cvt_pk_bf16(v1[0], v1[1]); w.w = cvt_pk_bf16(v1[2], v1[3]);
                    *(u32x4*)(rowp + ((kind == 1 || kind == 4) ? bj * SEQ * 128 : bj * HALF)) = w; } }
    }
};
struct EpiVt {
    static constexpr bool PERM = true, AFTER_DRAIN = false;
    bf16_t* O;
    __device__ __forceinline__ void operator()(const f32x4 (&acc)[2][2][4][2], const Unit& u, int wr, int wc, int fr, int fq) const {
        const int row0 = u.pm * BM + wr * 64 + fr; const int col0 = u.pn * BM + wc * 32 + 8 * fq;
        const int p0 = (fq & 1) ? 4 : 0, p1 = (fq & 1) ? 12 : 8;
#pragma unroll
        for (int ai = 0; ai < 2; ++ai)
#pragma unroll
            for (int m = 0; m < 4; ++m) { const int row = row0 + ai * HALF + m * 16; const int gh = row >> 7, d = row & 127;
#pragma unroll
                for (int bj = 0; bj < 2; ++bj) { const int col = col0 + bj * HALF; const int b = col >> 11, sq = col & (SEQ - 1);
                    bf16_t* tp = O + ((size_t)((((gh >> 3) * 8 + b) * 8 + (gh & 7)) * 32 + (sq >> 6)) * 128 + d) * 64 + (sq & 48);
                    const f32x4 v0 = acc[ai][bj][m][0], v1 = acc[ai][bj][m][1];
                    u32x2 w0, w1; w0.x = cvt_pk_bf16(v0[0], v0[1]); w0.y = cvt_pk_bf16(v0[2], v0[3]); w1.x = cvt_pk_bf16(v1[0], v1[1]); w1.y = cvt_pk_bf16(v1[2], v1[3]);
                    *(u32x2*)(tp + p0) = w0; *(u32x2*)(tp + p1) = w1; } }
    }
};
struct EpiRes {
    static constexpr bool PERM = true, AFTER_DRAIN = false;
    const float* x; bf16_t* hb; float* ss;
    __device__ __forceinline__ void operator()(const f32x4 (&acc)[2][2][4][2], const Unit& u, int wr, int wc, int fr, int fq) const {
        const int row0 = u.pm * BM + wr * 64 + fr; const int col0 = u.pn * BM + wc * 32 + 8 * fq;
#pragma unroll
        for (int ai = 0; ai < 2; ++ai)
#pragma unroll
            for (int m = 0; m < 4; ++m) { const int row = row0 + ai * HALF + m * 16; const size_t off = (size_t)row * DM + col0; float q = 0.f;
#pragma unroll
                for (int bj = 0; bj < 2; ++bj) { const size_t o2 = off + bj * HALF;
                    const f32x4 h0 = *(const f32x4*)(x + o2) + acc[ai][bj][m][0], h1 = *(const f32x4*)(x + o2 + 4) + acc[ai][bj][m][1];
                    u32x4 w; w.x = cvt_pk_bf16(h0[0], h0[1]); w.y = cvt_pk_bf16(h0[2], h0[3]); w.z = cvt_pk_bf16(h1[0], h1[1]); w.w = cvt_pk_bf16(h1[2], h1[3]);
                    *(u32x4*)(hb + o2) = w;
                    q += ((h0[0] * h0[0] + h0[1] * h0[1]) + (h0[2] * h0[2] + h0[3] * h0[3])) + ((h1[0] * h1[0] + h1[1] * h1[1]) + (h1[2] * h1[2] + h1[3] * h1[3])); }
                q += __shfl_xor(q, 16); q += __shfl_xor(q, 32);
                if (fq == 0) atomicAdd(ss + row, q); }
    }
};
struct EpiGate {
    static constexpr bool PERM = true, AFTER_DRAIN = false;
    const bf16_t* hb; bf16_t* h2b; const bf16_t* ple; const float* ss2; float* ss3;
    __device__ __forceinline__ void operator()(const f32x4 (&acc)[2][2][4][2], const Unit& u, int wr, int wc, int fr, int fq) const {
        const int row0 = u.pm * BM + wr * 64 + fr; const int col0 = u.pn * BM + wc * 32 + 8 * fq;
#pragma unroll
        for (int ai = 0; ai < 2; ++ai)
#pragma unroll
            for (int m = 0; m < 4; ++m) { const int row = row0 + ai * HALF + m * 16; const size_t off = (size_t)row * DM + col0; float q = 0.f;
                const float rstd = rsqrtf(ss2[row] * (1.f / DM) + NORM_EPS);
#pragma unroll
                for (int bj = 0; bj < 2; ++bj) { const size_t o2 = off + bj * HALF; const u32x4 hw = *(const u32x4*)(hb + o2); const u32x4 pw = *(const u32x4*)(ple + o2);
                    const f32x4 a0 = acc[ai][bj][m][0] * rstd, a1 = acc[ai][bj][m][1] * rstd; f32x4 g0, g1;
                    g0[0] = bf_lo(hw.x) + sigmoid_f(a0[0]) * bf_lo(pw.x); g0[1] = bf_hi(hw.x) + sigmoid_f(a0[1]) * bf_hi(pw.x);
                    g0[2] = bf_lo(hw.y) + sigmoid_f(a0[2]) * bf_lo(pw.y); g0[3] = bf_hi(hw.y) + sigmoid_f(a0[3]) * bf_hi(pw.y);
                    g1[0] = bf_lo(hw.z) + sigmoid_f(a1[0]) * bf_lo(pw.z); g1[1] = bf_hi(hw.z) + sigmoid_f(a1[1]) * bf_hi(pw.z);
                    g1[2] = bf_lo(hw.w) + sigmoid_f(a1[2]) * bf_lo(pw.w); g1[3] = bf_hi(hw.w) + sigmoid_f(a1[3]) * bf_hi(pw.w);
                    u32x4 w2; w2.x = cvt_pk_bf16(g0[0], g0[1]); w2.y = cvt_pk_bf16(g0[2], g0[3]); w2.z = cvt_pk_bf16(g1[0], g1[1]); w2.w = cvt_pk_bf16(g1[2], g1[3]);
                    *(u32x4*)(h2b + o2) = w2;
                    q += ((g0[0] * g0[0] + g0[1] * g0[1]) + (g0[2] * g0[2] + g0[3] * g0[3])) + ((g1[0] * g1[0] + g1[1] * g1[1]) + (g1[2] * g1[2] + g1[3] * g1[3])); }
                q += __shfl_xor(q, 16); q += __shfl_xor(q, 32);
                if (fq == 0) atomicAdd(ss3 + row, q); }
    }
};
}
namespace att {
constexpr int KP = 272, VP = 144, KT_BYTES = 64 * KP, VT_BYTES = 128 * VP, BUF_BYTES = KT_BYTES + VT_BYTES;
constexpr int FLAG_OFF = 2 * BUF_BYTES;
constexpr int XP = 132;
constexpr float R_DONE = 152.0f;

template <bool MASK>
__device__ __forceinline__ void sb_block(const f32x16& sv, int kbase, int tq, int h, float& R, bf16x8 (&pf)[2]) {
    float c[16], z[16];
#pragma unroll
    for (int i = 0; i < 16; ++i) {
        z[i] = (!MASK || (kbase + 8 * (i >> 2) + (i & 3) < tq)) ? sv[i] : -1e30f;
        c[i] = fmaxf(z[i], 0.f) + fast_log2(1.f + fast_exp2(-fabsf(z[i])));
    }
    float T[4], OT[4], pr[4], suf[4];
#pragma unroll
    for (int g = 0; g < 4; ++g) { c[4 * g + 2] += c[4 * g + 3]; c[4 * g + 1] += c[4 * g + 2]; c[4 * g] += c[4 * g + 1]; T[g] = c[4 * g]; }
#pragma unroll
    for (int g = 0; g < 4; ++g) { OT[g] = __shfl_xor(T[g], 32); pr[g] = T[g] + OT[g]; }
    suf[3] = 0.f; suf[2] = pr[3]; suf[1] = suf[2] + pr[2]; suf[0] = suf[1] + pr[1];
    float w[16];
#pragma unroll
    for (int g = 0; g < 4; ++g) { const float off = R + suf[g] + (h == 0 ? OT[g] : 0.f);
#pragma unroll
        for (int j = 0; j < 4; ++j) { const int i = 4 * g + j; w[i] = fast_exp2(z[i] - (off + c[i])); } }
    R += suf[0] + pr[0];
#pragma unroll
    for (int sp = 0; sp < 2; ++sp) { u32x4 p; p.x = cvt_pk(w[8 * sp], w[8 * sp + 1]); p.y = cvt_pk(w[8 * sp + 2], w[8 * sp + 3]); p.z = cvt_pk(w[8 * sp + 4], w[8 * sp + 5]); p.w = cvt_pk(w[8 * sp + 6], w[8 * sp + 7]);
        pf[sp] = __builtin_bit_cast(bf16x8, p); }
}

template <int MODE>
__device__ __forceinline__ void attn_unit(LAS unsigned char* lds, const bf16_t* __restrict__ PROJ, const bf16_t* __restrict__ KIMG, const bf16_t* __restrict__ VT, bf16_t* __restrict__ MIXED,
                                          int b, int hh, int qblk, float lam, const float* __restrict__ subln_g) {
    constexpr int QB = MODE == 0 ? 256 : 128;
    constexpr int NKS = MODE == 0 ? 8 : 4;
    const int tid = opaque_tid(), lane = tid & 63, r = lane & 31, h = lane >> 5;
    const int wid = __builtin_amdgcn_readfirstlane(tid >> 6);
    const int qg = MODE == 0 ? wid : (wid & 3), role = MODE == 0 ? 0 : (wid >> 2);
    const int Q0 = qblk * QB, q0w = Q0 + 32 * qg, tq = q0w + r;
    const size_t tokbase = (size_t)b * SEQ;
    const int gbh = ((MODE == 0 ? 0 : 8) + b) * 8 + hh;
    const bf16_t* Kg = KIMG + (size_t)gbh * SEQ * 128;
    const bf16_t* Vg = VT + (size_t)gbh * 32 * 8192;
    bf16x8 qf[NKS];
    { const bf16_t* qp = PROJ + (tokbase + tq) * NPROJ + (MODE == 0 ? PQ_SB + hh * 128 : PQ_DF + hh * 128 + role * 64) + 8 * h;
#pragma unroll
      for (int ks = 0; ks < NKS; ++ks) qf[ks] = *(const bf16x8*)(qp + 16 * ks); }
    f32x16 o[4];
#pragma unroll
    for (int d = 0; d < 4; ++d)
#pragma unroll
        for (int i = 0; i < 16; ++i) o[d][i] = 0.f;
    float R = 0.f, m_run = -1e30f, l_run = 0.f;
    const int kr0 = tid >> 4, kc = tid & 15, vr0 = tid >> 3, vc = tid & 7;
    const int kst = kr0 * KP + kc * 16, vst = KT_BYTES + vr0 * VP + vc * 16;
    const bf16_t* kgl = Kg + tid * 8;
    const bf16_t* vgl = Vg + tid * 8;
    u32x4 kreg[2], vreg[2];
#define ATT_LOAD(t) do { _Pragma("unroll") for (int i_ = 0; i_ < 2; ++i_) { \
        kreg[i_] = *(const u32x4*)(kgl + (size_t)(t) * 8192 + i_ * 4096); \
        vreg[i_] = *(const u32x4*)(vgl + (size_t)(t) * 8192 + i_ * 4096); } } while (0)
#define ATT_STORE(bo) do { _Pragma("unroll") for (int i_ = 0; i_ < 2; ++i_) { \
        *(LAS u32x4*)(lds + (bo) + kst + i_ * 32 * KP) = kreg[i_]; \
        *(LAS u32x4*)(lds + (bo) + vst + i_ * 64 * VP) = vreg[i_]; } } while (0)
    const int tl = (Q0 + QB - 1) >> 6;
    const int kfrag = r * KP + (role * 64 + 8 * h) * 2;
    const int vfrag = KT_BYTES + r * VP + (8 * h) * 2;
    volatile LAS int* flags = (volatile LAS int*)(lds + FLAG_OFF);
    __syncthreads();
    ATT_LOAD(tl); ATT_STORE(0);
    __syncthreads();
    int cur = 0, it = 0;
    bool wdone = false;
    for (int t = tl;; --t, ++it) {
        if (t > 0) ATT_LOAD(t - 1);
        const int k0 = 64 * t;
        const bool active = (MODE == 0) ? (!wdone && k0 <= q0w + 30) : (k0 <= q0w + 31);
        if (active) {
            const int bo = cur * BUF_BYTES;
            f32x16 s[2];
            bf16x8 vf[4][2][2];
            if (MODE == 1) {
                bf16x8 kf[2][NKS];
#pragma unroll
                for (int kb = 0; kb < 2; ++kb)
#pragma unroll
                    for (int ks = 0; ks < NKS; ++ks) kf[kb][ks] = *(const LAS bf16x8*)(lds + bo + kfrag + kb * 32 * KP + ks * 32);
                __builtin_amdgcn_sched_barrier(0);
#pragma unroll
                for (int kb = 0; kb < 2; ++kb) {
#pragma unroll
                    for (int i = 0; i < 16; ++i) s[kb][i] = 0.f;
#pragma unroll
                    for (int ks = 0; ks < NKS; ++ks) s[kb] = __builtin_amdgcn_mfma_f32_32x32x16_bf16(kf[kb][ks], qf[ks], s[kb], 0, 0, 0);
                }
                __builtin_amdgcn_sched_barrier(0);
#pragma unroll
                for (int d = 0; d < 2; ++d)
#pragma unroll
                    for (int kb = 0; kb < 2; ++kb)
#pragma unroll
                        for (int sp = 0; sp < 2; ++sp) vf[d][kb][sp] = *(const LAS bf16x8*)(lds + bo + vfrag + d * 32 * VP + (32 * kb + 16 * sp) * 2);
                __builtin_amdgcn_sched_barrier(0);
            } else {
#pragma unroll
                for (int kb = 0; kb < 2; ++kb) {
#pragma unroll
                    for (int i = 0; i < 16; ++i) s[kb][i] = 0.f;
#pragma unroll
                    for (int ks = 0; ks < NKS; ++ks) {
                        const bf16x8 a = *(const LAS bf16x8*)(lds + bo + kfrag + kb * 32 * KP + ks * 32);
                        s[kb] = __builtin_amdgcn_mfma_f32_32x32x16_bf16(a, qf[ks], s[kb], 0, 0, 0);
                    }
                }
            }
            bf16x8 pf[2][2];
            if (MODE == 0) {
                sb_block<true>(s[1], k0 + 32 + 4 * h, tq, h, R, pf[1]);
                if (__all(R >= R_DONE)) {
#pragma unroll
                    for (int sp = 0; sp < 2; ++sp)
#pragma unroll
                        for (int j = 0; j < 8; ++j) pf[0][sp][j] = 0;
                } else sb_block<true>(s[0], k0 + 4 * h, tq, h, R, pf[0]);
                wdone = __all(R >= R_DONE);
            } else {
                float mx = -1e30f;
                if (k0 + 63 > q0w) {
#pragma unroll
                    for (int kb = 0; kb < 2; ++kb) { const int kbase = k0 + 32 * kb + 4 * h;
#pragma unroll
                        for (int i = 0; i < 16; ++i) { const int key = kbase + 8 * (i >> 2) + (i & 3); const float v = (key <= tq) ? s[kb][i] : -1e30f; s[kb][i] = v; mx = fmaxf(mx, v); } }
                } else {
#pragma unroll
                    for (int kb = 0; kb < 2; ++kb)
#pragma unroll
                        for (int i = 0; i < 16; ++i) mx = fmaxf(mx, s[kb][i]);
                }
                mx = fmaxf(mx, __shfl_xor(mx, 32));
                const float m_new = fmaxf(m_run, mx), alpha = fast_exp2(m_run - m_new);
                m_run = m_new;
                float ls = 0.f;
#pragma unroll
                for (int kb = 0; kb < 2; ++kb) {
#pragma unroll
                    for (int i = 0; i < 16; ++i) { const float p = fast_exp2(s[kb][i] - m_new); s[kb][i] = p; ls += p; }
#pragma unroll
                    for (int sp = 0; sp < 2; ++sp) { u32x4 p; p.x = cvt_pk(s[kb][8 * sp], s[kb][8 * sp + 1]); p.y = cvt_pk(s[kb][8 * sp + 2], s[kb][8 * sp + 3]); p.z = cvt_pk(s[kb][8 * sp + 4], s[kb][8 * sp + 5]); p.w = cvt_pk(s[kb][8 * sp + 6], s[kb][8 * sp + 7]);
                        pf[kb][sp] = __builtin_bit_cast(bf16x8, p); }
                }
                l_run = l_run * alpha + ls;
                if (!__all(alpha == 1.f)) {
#pragma unroll
                    for (int d = 0; d < 4; ++d)
#pragma unroll
                        for (int i = 0; i < 16; ++i) o[d][i] *= alpha;
                }
            }
            if (MODE == 1) {
                __builtin_amdgcn_sched_barrier(0);
#pragma unroll
                for (int d = 2; d < 4; ++d)
#pragma unroll
                    for (int kb = 0; kb < 2; ++kb)
#pragma unroll
                        for (int sp = 0; sp < 2; ++sp) vf[d][kb][sp] = *(const LAS bf16x8*)(lds + bo + vfrag + d * 32 * VP + (32 * kb + 16 * sp) * 2);
                __builtin_amdgcn_sched_barrier(0);
            }
#pragma unroll
            for (int d = 0; d < 4; ++d)
#pragma unroll
                for (int kb = 0; kb < 2; ++kb)
#pragma unroll
                    for (int sp = 0; sp < 2; ++sp) {
                        const bf16x8 a = (MODE == 1) ? vf[d][kb][sp] : *(const LAS bf16x8*)(lds + bo + vfrag + d * 32 * VP + (32 * kb + 16 * sp) * 2);
                        o[d] = __builtin_amdgcn_mfma_f32_32x32x16_bf16(a, pf[kb][sp], o[d], 0, 0, 0);
                    }
        }
        if (t > 0) ATT_STORE((cur ^ 1) * BUF_BYTES);
        if (MODE == 0) { if (lane == 0) flags[(it & 1) * 8 + wid] = wdone ? 1 : 0; }
        __syncthreads();
        if (t == 0) break;
        if (MODE == 0) { int alld = 1;
#pragma unroll
            for (int w2 = 0; w2 < 8; ++w2) alld &= flags[(it & 1) * 8 + w2];
            if (alld) break; }
        cur ^= 1;
    }
#undef ATT_LOAD
#undef ATT_STORE
    const int erow = lane >> 4, ech = lane & 15;
    const size_t tok0 = tokbase + q0w;
    if (MODE == 0 || role == 0) {
    }
    u32x4 gw[8];
    if (MODE == 0 || role == 0) {
        const bf16_t* gp = PROJ + (tok0 + erow) * NPROJ + (MODE == 0 ? PG_SB : PG_DF) + hh * 128 + ech * 8;
#pragma unroll
        for (int i = 0; i < 8; ++i) gw[i] = *(const u32x4*)(gp + (size_t)(4 * i) * NPROJ);
    }
    LAS unsigned char* stg = lds + (MODE == 0 ? wid * 8704 : 69632 + qg * 8704);
    if (MODE == 0) {
#pragma unroll
        for (int d = 0; d < 4; ++d)
#pragma unroll
            for (int g = 0; g < 4; ++g) { u32x2 w; w.x = cvt_pk(o[d][4 * g], o[d][4 * g + 1]); w.y = cvt_pk(o[d][4 * g + 2], o[d][4 * g + 3]);
                *(LAS u32x2*)(stg + r * 272 + (32 * d + 8 * g + 4 * h) * 2) = w; }
    } else {
        const float lt = l_run + __shfl_xor(l_run, 32);
        const float inv = 1.f / lt;
        LAS float* xq = (LAS float*)lds + (qg * 32 + r) * XP + 4 * h;
        if (role == 1) {
            const float f = inv * lam;
#pragma unroll
            for (int d = 0; d < 4; ++d)
#pragma unroll
                for (int g = 0; g < 4; ++g) *(LAS f32x4*)(xq + 32 * d + 8 * g) = (f32x4){o[d][4 * g] * f, o[d][4 * g + 1] * f, o[d][4 * g + 2] * f, o[d][4 * g + 3] * f};
        }
        __syncthreads();
        if (role == 0) {
            float q = 0.f;
#pragma unroll
            for (int d = 0; d < 4; ++d)
#pragma unroll
                for (int g = 0; g < 4; ++g) { const f32x4 x2 = *(const LAS f32x4*)(xq + 32 * d + 8 * g);
#pragma unroll
                    for (int j = 0; j < 4; ++j) { const float v = o[d][4 * g + j] * inv - x2[j]; o[d][4 * g + j] = v; q += v * v; } }
            q += __shfl_xor(q, 32);
            const float rs = rsqrtf(q * (1.f / 128.f) + SUBLN_EPS) * (1.f - LAMBDA_INIT);
            const float* sg = subln_g + 4 * h;
#pragma unroll
            for (int d = 0; d < 4; ++d)
#pragma unroll
                for (int g = 0; g < 4; ++g) { const f32x4 sv = *(const f32x4*)(sg + 32 * d + 8 * g);
                    u32x2 w; w.x = cvt_pk(o[d][4 * g] * rs * sv[0], o[d][4 * g + 1] * rs * sv[1]); w.y = cvt_pk(o[d][4 * g + 2] * rs * sv[2], o[d][4 * g + 3] * rs * sv[3]);
                    *(LAS u32x2*)(stg + r * 272 + (32 * d + 8 * g + 4 * h) * 2) = w; }
        }
    }
    if (MODE == 0 || role == 0) {
        asm volatile("s_waitcnt lgkmcnt(0)" ::: "memory");
        bf16_t* op = MIXED + (tok0 + erow) * DM + (MODE == 0 ? 0 : 1024) + hh * 128 + ech * 8;
#pragma unroll
        for (int i = 0; i < 8; ++i) { const u32x4 ov = *(const LAS u32x4*)(stg + (4 * i + erow) * 272 + ech * 16); const u32x4 g4 = gw[i];
            u32x4 w; w.x = cvt_pk(bf_lo(ov.x) * bf_lo(g4.x), bf_hi(ov.x) * bf_hi(g4.x)); w.y = cvt_pk(bf_lo(ov.y) * bf_lo(g4.y), bf_hi(ov.y) * bf_hi(g4.y));
            w.z = cvt_pk(bf_lo(ov.z) * bf_lo(g4.z), bf_hi(ov.z) * bf_hi(g4.z)); w.w = cvt_pk(bf_lo(ov.w) * bf_lo(g4.w), bf_hi(ov.w) * bf_hi(g4.w));
            *(u32x4*)(op + (size_t)(4 * i) * DM) = w; }
    }
}

__device__ __forceinline__ void attn_unit_df(LAS unsigned char* lds, const bf16_t* __restrict__ PROJ, const bf16_t* __restrict__ KIMG, const bf16_t* __restrict__ VT, bf16_t* __restrict__ MIXED,
                                             int b, int hh, int qblk, float lam, const float* __restrict__ subln_g) {
    constexpr int VB0 = 2 * KT_BYTES;
    const int tid = opaque_tid(), lane = tid & 63, r = lane & 31, h = lane >> 5;
    const int wid = __builtin_amdgcn_readfirstlane(tid >> 6);
    const int qg = wid & 3, role = wid >> 2;
    const int Q0 = qblk * 128, q0w = Q0 + 32 * qg, tq = q0w + r;
    const size_t tokbase = (size_t)b * SEQ;
    const int gbh = (8 + b) * 8 + hh;
    const bf16_t* Kg = KIMG + (size_t)gbh * SEQ * 128;
    const bf16_t* Vg = VT + (size_t)gbh * 32 * 8192;
    bf16x8 qf[4];
    { const bf16_t* qp = PROJ + (tokbase + tq) * NPROJ + PQ_DF + hh * 128 + role * 64 + 8 * h;
#pragma unroll
      for (int ks = 0; ks < 4; ++ks) qf[ks] = *(const bf16x8*)(qp + 16 * ks); }
    f32x16 o[4];
#pragma unroll
    for (int d = 0; d < 4; ++d)
#pragma unroll
        for (int i = 0; i < 16; ++i) o[d][i] = 0.f;
    float m_run = -1e30f, l_run = 0.f, alpha = 1.f;
    const int kr0 = tid >> 4, kc = tid & 15, vr0 = tid >> 3, vc = tid & 7;
    const int kst = kr0 * KP + kc * 16, vst = vr0 * VP + vc * 16;
    const bf16_t* kgl = Kg + tid * 8;
    const bf16_t* vgl = Vg + tid * 8;
    u32x4 kreg[2], vreg[2];
#define DF_LOAD(t) do { _Pragma("unroll") for (int i_ = 0; i_ < 2; ++i_) { \
        kreg[i_] = *(const u32x4*)(kgl + (size_t)(t) * 8192 + i_ * 4096); \
        vreg[i_] = *(const u32x4*)(vgl + (size_t)(t) * 8192 + i_ * 4096); } } while (0)
#define DF_STORE(ko, vo) do { _Pragma("unroll") for (int i_ = 0; i_ < 2; ++i_) { \
        *(LAS u32x4*)(lds + (ko) + kst + i_ * 32 * KP) = kreg[i_]; \
        *(LAS u32x4*)(lds + (vo) + vst + i_ * 64 * VP) = vreg[i_]; } } while (0)
#define DF_VLOAD(vo) do { _Pragma("unroll") for (int d_ = 0; d_ < 4; ++d_) _Pragma("unroll") for (int kb_ = 0; kb_ < 2; ++kb_) _Pragma("unroll") for (int sp_ = 0; sp_ < 2; ++sp_) \
        vf[d_][kb_][sp_] = *(const LAS bf16x8*)(lds + (vo) + vfrag + d_ * 32 * VP + (32 * kb_ + 16 * sp_) * 2); } while (0)
#define DF_PV() do { _Pragma("unroll") for (int d_ = 0; d_ < 4; ++d_) _Pragma("unroll") for (int kb_ = 0; kb_ < 2; ++kb_) _Pragma("unroll") for (int sp_ = 0; sp_ < 2; ++sp_) \
        o[d_] = __builtin_amdgcn_mfma_f32_32x32x16_bf16(vf[d_][kb_][sp_], pf[kb_][sp_], o[d_], 0, 0, 0); } while (0)
#define DF_RESCALE() do { if (!__all(alpha == 1.f)) { _Pragma("unroll") for (int d_ = 0; d_ < 4; ++d_) _Pragma("unroll") for (int i_ = 0; i_ < 16; ++i_) o[d_][i_] *= alpha; } } while (0)
    const int tl = (Q0 + 127) >> 6, NT = tl + 1;
    const int kfrag = r * KP + (role * 64 + 8 * h) * 2;
    const int vfrag = r * VP + (8 * h) * 2;
    __syncthreads();
    DF_LOAD(tl); DF_STORE(0, VB0);
    __syncthreads();
    bool have_p = false;
    bf16x8 pf[2][2];
    for (int i = 0; i < NT; ++i) {
        const int t = tl - i, k0 = 64 * t;
        if (t > 0) DF_LOAD(t - 1);
        if (k0 <= q0w + 31) {
            const int ko = (i & 1) * KT_BYTES;
            bf16x8 kf[2][4];
#pragma unroll
            for (int kb = 0; kb < 2; ++kb)
#pragma unroll
                for (int ks = 0; ks < 4; ++ks) kf[kb][ks] = *(const LAS bf16x8*)(lds + ko + kfrag + kb * 32 * KP + ks * 32);
            f32x16 s[2];
#pragma unroll
            for (int kb = 0; kb < 2; ++kb) {
#pragma unroll
                for (int j = 0; j < 16; ++j) s[kb][j] = 0.f;
#pragma unroll
                for (int ks = 0; ks < 4; ++ks) s[kb] = __builtin_amdgcn_mfma_f32_32x32x16_bf16(kf[kb][ks], qf[ks], s[kb], 0, 0, 0);
            }
            if (!have_p) {
                float mx = -1e30f;
#pragma unroll
                for (int kb = 0; kb < 2; ++kb) { const int kbase = k0 + 32 * kb + 4 * h;
#pragma unroll
                    for (int j = 0; j < 16; ++j) { const int key = kbase + 8 * (j >> 2) + (j & 3); const float v = (key <= tq) ? s[kb][j] : -1e30f; s[kb][j] = v; mx = fmaxf(mx, v); } }
                mx = fmaxf(mx, __shfl_xor(mx, 32));
                m_run = mx; alpha = 1.f;
                float ls = 0.f;
#pragma unroll
                for (int kb = 0; kb < 2; ++kb) {
#pragma unroll
                    for (int j = 0; j < 16; ++j) { const float p = fast_exp2(s[kb][j] - mx); s[kb][j] = p; ls += p; }
#pragma unroll
                    for (int sp = 0; sp < 2; ++sp) { u32x4 p; p.x = cvt_pk(s[kb][8 * sp], s[kb][8 * sp + 1]); p.y = cvt_pk(s[kb][8 * sp + 2], s[kb][8 * sp + 3]); p.z = cvt_pk(s[kb][8 * sp + 4], s[kb][8 * sp + 5]); p.w = cvt_pk(s[kb][8 * sp + 6], s[kb][8 * sp + 7]);
                        pf[kb][sp] = __builtin_bit_cast(bf16x8, p); }
                }
                l_run = ls;
                have_p = true;
            } else {
                DF_RESCALE();
                const int vo = VB0 + ((i + 2) % 3) * VT_BYTES;
                bf16x8 vf[2][2][2];
                bf16x8 pn[2][2]; u32x4 pw[2][2];
                float mx = -1e30f, ls = 0.f, m_new = 0.f;
#define DF_VL(g) do { _Pragma("unroll") for (int kb_ = 0; kb_ < 2; ++kb_) _Pragma("unroll") for (int sp_ = 0; sp_ < 2; ++sp_) \
        vf[(g) & 1][kb_][sp_] = *(const LAS bf16x8*)(lds + vo + vfrag + (g) * 32 * VP + (32 * kb_ + 16 * sp_) * 2); } while (0)
#define DF_MF(k) o[(k) >> 2] = __builtin_amdgcn_mfma_f32_32x32x16_bf16(vf[((k) >> 2) & 1][((k) >> 1) & 1][(k) & 1], pf[((k) >> 1) & 1][(k) & 1], o[(k) >> 2], 0, 0, 0)
#define DF_S(e) s[(e) >> 4][(e) & 15]
                DF_VL(0); DF_VL(1);
                __builtin_amdgcn_sched_barrier(0);
                DF_MF(0);
                mx = fmaxf(fmaxf(mx, DF_S(0)), DF_S(1));
                mx = fmaxf(fmaxf(mx, DF_S(2)), DF_S(3));
                mx = fmaxf(fmaxf(mx, DF_S(4)), DF_S(5));
                mx = fmaxf(fmaxf(mx, DF_S(6)), DF_S(7));
                __builtin_amdgcn_sched_barrier(0);
                DF_MF(1);
                mx = fmaxf(fmaxf(mx, DF_S(8)), DF_S(9));
                mx = fmaxf(fmaxf(mx, DF_S(10)), DF_S(11));
                mx = fmaxf(fmaxf(mx, DF_S(12)), DF_S(13));
                mx = fmaxf(fmaxf(mx, DF_S(14)), DF_S(15));
                __builtin_amdgcn_sched_barrier(0);
                DF_MF(2);
                mx = fmaxf(fmaxf(mx, DF_S(16)), DF_S(17));
                mx = fmaxf(fmaxf(mx, DF_S(18)), DF_S(19));
                mx = fmaxf(fmaxf(mx, DF_S(20)), DF_S(21));
                mx = fmaxf(fmaxf(mx, DF_S(22)), DF_S(23));
                __builtin_amdgcn_sched_barrier(0);
                DF_MF(3);
                mx = fmaxf(fmaxf(mx, DF_S(24)), DF_S(25));
                mx = fmaxf(fmaxf(mx, DF_S(26)), DF_S(27));
                mx = fmaxf(fmaxf(mx, DF_S(28)), DF_S(29));
                mx = fmaxf(fmaxf(mx, DF_S(30)), DF_S(31));
                { auto rr = __builtin_amdgcn_permlane32_swap(__float_as_uint(mx), __float_as_uint(mx), false, false); mx = fmaxf(__uint_as_float(rr[0]), __uint_as_float(rr[1])); }
                m_new = fmaxf(m_run, mx); alpha = fast_exp2(m_run - m_new); m_run = m_new;
                __builtin_amdgcn_sched_barrier(0);
                DF_VL(2);
                DF_MF(4);
                { const float p = fast_exp2(DF_S(0) - m_new); DF_S(0) = p; ls += p; }
                { const float p = fast_exp2(DF_S(1) - m_new); DF_S(1) = p; ls += p; }
                pw[0][0][0] = cvt_pk(DF_S(0), DF_S(1));
                { const float p = fast_exp2(DF_S(2) - m_new); DF_S(2) = p; ls += p; }
                __builtin_amdgcn_sched_barrier(0);
                DF_MF(5);
                { const float p = fast_exp2(DF_S(3) - m_new); DF_S(3) = p; ls += p; }
                pw[0][0][1] = cvt_pk(DF_S(2), DF_S(3));
                { const float p = fast_exp2(DF_S(4) - m_new); DF_S(4) = p; ls += p; }
                { const float p = fast_exp2(DF_S(5) - m_new); DF_S(5) = p; ls += p; }
                pw[0][0][2] = cvt_pk(DF_S(4), DF_S(5));
                __builtin_amdgcn_sched_barrier(0);
                DF_MF(6);
                { const float p = fast_exp2(DF_S(6) - m_new); DF_S(6) = p; ls += p; }
                { const float p = fast_exp2(DF_S(7) - m_new); DF_S(7) = p; ls += p; }
                pw[0][0][3] = cvt_pk(DF_S(6), DF_S(7));
                { const float p = fast_exp2(DF_S(8) - m_new); DF_S(8) = p; ls += p; }
                __builtin_amdgcn_sched_barrier(0);
                DF_MF(7);
                { const float p = fast_exp2(DF_S(9) - m_new); DF_S(9) = p; ls += p; }
                pw[0][1][0] = cvt_pk(DF_S(8), DF_S(9));
                { const float p = fast_exp2(DF_S(10) - m_new); DF_S(10) = p; ls += p; }
                { const float p = fast_exp2(DF_S(11) - m_new); DF_S(11) = p; ls += p; }
                pw[0][1][1] = cvt_pk(DF_S(10), DF_S(11));
                __builtin_amdgcn_sched_barrier(0);
                DF_VL(3);
                DF_MF(8);
                { const float p = fast_exp2(DF_S(12) - m_new); DF_S(12) = p; ls += p; }
                { const float p = fast_exp2(DF_S(13) - m_new); DF_S(13) = p; ls += p; }
                pw[0][1][2] = cvt_pk(DF_S(12), DF_S(13));
                { const float p = fast_exp2(DF_S(14) - m_new); DF_S(14) = p; ls += p; }
                __builtin_amdgcn_sched_barrier(0);
                DF_MF(9);
                { const float p = fast_exp2(DF_S(15) - m_new); DF_S(15) = p; ls += p; }
                pw[0][1][3] = cvt_pk(DF_S(14), DF_S(15));
                { const float p = fast_exp2(DF_S(16) - m_new); DF_S(16) = p; ls += p; }
                { const float p = fast_exp2(DF_S(17) - m_new); DF_S(17) = p; ls += p; }
                pw[1][0][0] = cvt_pk(DF_S(16), DF_S(17));
                __builtin_amdgcn_sched_barrier(0);
                DF_MF(10);
                { const float p = fast_exp2(DF_S(18) - m_new); DF_S(18) = p; ls += p; }
                { const float p = fast_exp2(DF_S(19) - m_new); DF_S(19) = p; ls += p; }
                pw[1][0][1] = cvt_pk(DF_S(18), DF_S(19));
                { const float p = fast_exp2(DF_S(20) - m_new); DF_S(20) = p; ls += p; }
                __builtin_amdgcn_sched_barrier(0);
                DF_MF(11);
                { const float p = fast_exp2(DF_S(21) - m_new); DF_S(21) = p; ls += p; }
                pw[1][0][2] = cvt_pk(DF_S(20), DF_S(21));
                { const float p = fast_exp2(DF_S(22) - m_new); DF_S(22) = p; ls += p; }
                { const float p = fast_exp2(DF_S(23) - m_new); DF_S(23) = p; ls += p; }
                pw[1][0][3] = cvt_pk(DF_S(22), DF_S(23));
                __builtin_amdgcn_sched_barrier(0);
                DF_MF(12);
                { const float p = fast_exp2(DF_S(24) - m_new); DF_S(24) = p; ls += p; }
                { const float p = fast_exp2(DF_S(25) - m_new); DF_S(25) = p; ls += p; }
                pw[1][1][0] = cvt_pk(DF_S(24), DF_S(25));
                __builtin_amdgcn_sched_barrier(0);
                DF_MF(13);
                { const float p = fast_exp2(DF_S(26) - m_new); DF_S(26) = p; ls += p; }
                { const float p = fast_exp2(DF_S(27) - m_new); DF_S(27) = p; ls += p; }
                pw[1][1][1] = cvt_pk(DF_S(26), DF_S(27));
                __builtin_amdgcn_sched_barrier(0);
                DF_MF(14);
                { const float p = fast_exp2(DF_S(28) - m_new); DF_S(28) = p; ls += p; }
                { const float p = fast_exp2(DF_S(29) - m_new); DF_S(29) = p; ls += p; }
                pw[1][1][2] = cvt_pk(DF_S(28), DF_S(29));
                __builtin_amdgcn_sched_barrier(0);
                DF_MF(15);
                { const float p = fast_exp2(DF_S(30) - m_new); DF_S(30) = p; ls += p; }
                { const float p = fast_exp2(DF_S(31) - m_new); DF_S(31) = p; ls += p; }
                pw[1][1][3] = cvt_pk(DF_S(30), DF_S(31));
                __builtin_amdgcn_sched_barrier(0);
                l_run = l_run * alpha + ls;
#pragma unroll
                for (int kb = 0; kb < 2; ++kb)
#pragma unroll
                    for (int sp = 0; sp < 2; ++sp) pf[kb][sp] = __builtin_bit_cast(bf16x8, pw[kb][sp]);
#undef DF_VL
#undef DF_MF
#undef DF_S
            }
        }
        if (t > 0) DF_STORE(((i + 1) & 1) * KT_BYTES, VB0 + ((i + 1) % 3) * VT_BYTES);
        __syncthreads();
    }
    if (have_p) {
        DF_RESCALE();
        bf16x8 vf[4][2][2];
        DF_VLOAD(VB0 + ((NT - 1) % 3) * VT_BYTES);
        DF_PV();
    }
    __syncthreads();
#undef DF_LOAD
#undef DF_STORE
#undef DF_VLOAD
#undef DF_PV
#undef DF_RESCALE
    const int erow = lane >> 4, ech = lane & 15;
    const size_t tok0 = tokbase + q0w;
    u32x4 gw[8];
    if (role == 0) {
        const bf16_t* gp = PROJ + (tok0 + erow) * NPROJ + PG_DF + hh * 128 + ech * 8;
#pragma unroll
        for (int i = 0; i < 8; ++i) gw[i] = *(const u32x4*)(gp + (size_t)(4 * i) * NPROJ);
    }
    LAS unsigned char* stg = lds + 69632 + qg * 8704;
    {
        const float lt = l_run + __shfl_xor(l_run, 32);
        const float inv = 1.f / lt;
        LAS float* xq = (LAS float*)lds + (qg * 32 + r) * XP + 4 * h;
        if (role == 1) {
            const float f = inv * lam;
#pragma unroll
            for (int d = 0; d < 4; ++d)
#pragma unroll
                for (int g = 0; g < 4; ++g) *(LAS f32x4*)(xq + 32 * d + 8 * g) = (f32x4){o[d][4 * g] * f, o[d][4 * g + 1] * f, o[d][4 * g + 2] * f, o[d][4 * g + 3] * f};
        }
        __syncthreads();
        if (role == 0) {
            float q = 0.f;
#pragma unroll
            for (int d = 0; d < 4; ++d)
#pragma unroll
                for (int g = 0; g < 4; ++g) { const f32x4 x2 = *(const LAS f32x4*)(xq + 32 * d + 8 * g);
#pragma unroll
                    for (int j = 0; j < 4; ++j) { const float v = o[d][4 * g + j] * inv - x2[j]; o[d][4 * g + j] = v; q += v * v; } }
            q += __shfl_xor(q, 32);
            const float rs = rsqrtf(q * (1.f / 128.f) + SUBLN_EPS) * (1.f - LAMBDA_INIT);
            const float* sg = subln_g + 4 * h;
#pragma unroll
            for (int d = 0; d < 4; ++d)
#pragma unroll
                for (int g = 0; g < 4; ++g) { const f32x4 sv = *(const f32x4*)(sg + 32 * d + 8 * g);
                    u32x2 w; w.x = cvt_pk(o[d][4 * g] * rs * sv[0], o[d][4 * g + 1] * rs * sv[1]); w.y = cvt_pk(o[d][4 * g + 2] * rs * sv[2], o[d][4 * g + 3] * rs * sv[3]);
                    *(LAS u32x2*)(stg + r * 272 + (32 * d + 8 * g + 4 * h) * 2) = w; }
            asm volatile("s_waitcnt lgkmcnt(0)" ::: "memory");
            bf16_t* op = MIXED + (tok0 + erow) * DM + 1024 + hh * 128 + ech * 8;
#pragma unroll
            for (int i = 0; i < 8; ++i) { const u32x4 ov = *(const LAS u32x4*)(stg + (4 * i + erow) * 272 + ech * 16); const u32x4 g4 = gw[i];
                u32x4 w; w.x = cvt_pk(bf_lo(ov.x) * bf_lo(g4.x), bf_hi(ov.x) * bf_hi(g4.x)); w.y = cvt_pk(bf_lo(ov.y) * bf_lo(g4.y), bf_hi(ov.y) * bf_hi(g4.y));
                w.z = cvt_pk(bf_lo(ov.z) * bf_lo(g4.z), bf_hi(ov.z) * bf_hi(g4.z)); w.w = cvt_pk(bf_lo(ov.w) * bf_lo(g4.w), bf_hi(ov.w) * bf_hi(g4.w));
                *(u32x4*)(op + (size_t)(4 * i) * DM) = w; }
        }
    }
}
}
#define XB_TMO      128
#define XB_XCNT(j)  (256  + 64 * (j))
#define XB_XSUB(j)  (1280 + 64 * (j))
#define XB_XGEN(j)  (2304 + 64 * (j))
#define XB_TOP      3328
#define XB_TOPGEN   3392
#define XCD_BAR_WORDS 3456
#define XB_SPIN_CAP (1u << 18)

__device__ __forceinline__ unsigned xb_ld(unsigned* p)              { return __hip_atomic_load(p, __ATOMIC_RELAXED, __HIP_MEMORY_SCOPE_AGENT); }
__device__ __forceinline__ unsigned xb_add(unsigned* p, unsigned v) { return __hip_atomic_fetch_add(p, v, __ATOMIC_RELAXED, __HIP_MEMORY_SCOPE_AGENT); }
__device__ __forceinline__ unsigned xb_xcc_id() { return (unsigned)__builtin_amdgcn_s_getreg((3 << 11) | 20) & 0xFu; }
#define XB_SPIN(cond, bar) do { unsigned _sp = 0; while (cond) { __builtin_amdgcn_s_sleep(1); \
    if ((++_sp & 255u) == 0u) { if (xb_ld(&(bar)[XB_TMO])) break; if (_sp > XB_SPIN_CAP) { atomicAdd(&(bar)[XB_TMO], 1u); break; } } } } while (0)

struct XcdBarrier {
    unsigned* bar; unsigned x;
    volatile LAS unsigned* st;
};

__device__ __forceinline__ XcdBarrier xcd_barrier_post(unsigned* bar, volatile LAS unsigned* st) {
    XcdBarrier b; b.bar = bar; b.x = xb_xcc_id(); b.st = st;
    if (threadIdx.x == 0) (void)xb_add(&bar[XB_XCNT(b.x)], 1u);
    return b;
}
__device__ __forceinline__ void xcd_barrier_complete(unsigned* bar, unsigned x, unsigned& nloc, unsigned& nx) {
    const unsigned G = gridDim.x * gridDim.y * gridDim.z;
    unsigned sum, cnt, mine, sp = 0u;
    for (;;) {
        sum = 0u; cnt = 0u; mine = 0u;
#pragma unroll
        for (unsigned j = 0; j < 16; ++j) { const unsigned c = xb_ld(&bar[XB_XCNT(j)]); sum += c; cnt += (c > 0u) ? 1u : 0u; mine = (j == x) ? c : mine; }
        if (sum == G) break;
        __builtin_amdgcn_s_sleep(1);
        if ((++sp & 255u) == 0u) { if (xb_ld(&bar[XB_TMO])) break; if (sp > XB_SPIN_CAP) { atomicAdd(&bar[XB_TMO], 1u); break; } }
    }
    nloc = mine > 0u ? mine : 1u; nx = cnt > 0u ? cnt : 1u;
}

__device__ __forceinline__ void xcd_barrier(const XcdBarrier& b) {
    asm volatile("s_waitcnt vmcnt(0)" ::: "memory");
    __syncthreads();
    if (threadIdx.x == 0) {
        unsigned* bar = b.bar;
        __builtin_amdgcn_s_waitcnt(0);
        unsigned nloc = b.st[0], nx = b.st[1];
        if (nloc == 0u) { xcd_barrier_complete(bar, b.x, nloc, nx); b.st[0] = nloc; b.st[1] = nx; }
        const unsigned old = xb_add(&bar[XB_XSUB(b.x)], 1u);
        const unsigned gen = old / nloc;
        if (old + 1u == (gen + 1u) * nloc) {
            __builtin_amdgcn_fence(__ATOMIC_RELEASE, "agent");
            asm volatile("s_waitcnt vmcnt(0)" ::: "memory");
            const unsigned og = xb_add(&bar[XB_TOP], 1u);
            const unsigned tg = og / nx;
            if (og + 1u == (tg + 1u) * nx) xb_add(&bar[XB_TOPGEN], 1u);
            else XB_SPIN(xb_ld(&bar[XB_TOPGEN]) == tg, bar);
            __builtin_amdgcn_fence(__ATOMIC_ACQUIRE, "agent");
            xb_add(&bar[XB_XGEN(b.x)], 1u);
            asm volatile("s_waitcnt vmcnt(0)" ::: "memory");
        } else {
            XB_SPIN(xb_ld(&bar[XB_XGEN(b.x)]) == gen, bar);
            __builtin_amdgcn_fence(__ATOMIC_ACQUIRE, "agent");
            asm volatile("s_waitcnt vmcnt(0)" ::: "memory");
        }
    }
    __syncthreads();
}

__device__ __forceinline__ int win_dst_row(int c) {
    const int seg = c >> 10, w = c & 1023, d6 = w & 63;
    const int wp = d6 < 16 ? (w & ~63) + (d6 < 8 ? 2 * d6 : 2 * (d6 - 8) + 1) : w;
    switch (seg) { case 0: return w; case 1: return 1024 + w; case 2: return 6144 + w; case 3: return 2048 + w;
                   case 4: return 3072 + wp; case 5: return 4096 + wp; case 6: return 7168 + w; default: return 5120 + w; }
}
struct TItem { const float* W; bf16_t* WT; const float* ks; int K, N, win, item; };
__device__ __forceinline__ void tr_load(const TItem& t, float (&v)[32], int lane) {
    const int nblk = t.N / 32, kb = t.item / nblk, nb = t.item % nblk; const float* p = t.W + (size_t)(64 * kb + (lane >> 5)) * t.N + 32 * nb + (lane & 31);
#pragma unroll
    for (int i = 0; i < 32; ++i) v[i] = __builtin_nontemporal_load(&p[(size_t)(2 * i) * t.N]);
}
__device__ __forceinline__ void tr_write(const float (&v)[32], LAS float* scr, int lane) {
#pragma unroll
    for (int i = 0; i < 32; ++i) scr[(2 * i + (lane >> 5)) * 33 + (lane & 31)] = v[i];
}
__device__ __forceinline__ void tr_store(const TItem& t, LAS float* scr, int lane) {
    const int nblk = t.N / 32, kb = t.item / nblk, nb = t.item % nblk, k0 = 64 * kb, n0 = 32 * nb, c = lane & 7;
    f32x4 s0 = {1.f, 1.f, 1.f, 1.f}, s1 = {1.f, 1.f, 1.f, 1.f};
    if (t.ks) { s0 = *(const f32x4*)(t.ks + k0 + 8 * c); s1 = *(const f32x4*)(t.ks + k0 + 8 * c + 4); }
#pragma unroll
    for (int j = 0; j < 4; ++j) { const int n = (lane >> 3) + 8 * j; const LAS float* s = scr + (8 * c) * 33 + n;
        u32x4 o; o.x = cvt_pk(s[0 * 33] * s0[0], s[1 * 33] * s0[1]); o.y = cvt_pk(s[2 * 33] * s0[2], s[3 * 33] * s0[3]); o.z = cvt_pk(s[4 * 33] * s1[0], s[5 * 33] * s1[1]); o.w = cvt_pk(s[6 * 33] * s1[2], s[7 * 33] * s1[3]);
        const int dn = t.win ? win_dst_row(n0 + n) : (n0 + n);
        *(u32x4*)(t.WT + (size_t)dn * t.K + k0 + 8 * c) = o; }
}
__device__ __forceinline__ void rms_load(const float* __restrict__ xrow, f32x4 (&v)[8], int lane) {
    const f32x4* xr = (const f32x4*)xrow + lane;
#pragma unroll
    for (int j = 0; j < 8; ++j) v[j] = __builtin_nontemporal_load(&xr[64 * j]);
}
__device__ __forceinline__ void rms_finish(const f32x4 (&v)[8], const f32x4 (&gv)[8], bf16_t* __restrict__ orow, int lane) {
    float s = 0.f;
#pragma unroll
    for (int j = 0; j < 8; ++j) s += (v[j][0] * v[j][0] + v[j][1] * v[j][1]) + (v[j][2] * v[j][2] + v[j][3] * v[j][3]);
    const float rstd = rsqrtf(wave_sum(s) * (1.f / DM) + NORM_EPS);
    u32x2* o8 = (u32x2*)orow + lane;
#pragma unroll
    for (int j = 0; j < 8; ++j) { u32x2 w; w.x = cvt_pk(v[j][0] * rstd * gv[j][0], v[j][1] * rstd * gv[j][1]); w.y = cvt_pk(v[j][2] * rstd * gv[j][2], v[j][3] * rstd * gv[j][3]); o8[64 * j] = w; }
}

struct Args { const float* in[14]; float* out; unsigned char* ws; };

__global__ void __launch_bounds__(512, 2) fwd_megakernel(Args a) {
    extern __shared__ __attribute__((aligned(16))) unsigned char lds_raw[];
    LAS unsigned char* lds = (LAS unsigned char*)lds_raw;
    { cg::grid_group grid = cg::this_grid(); if (a.ws == nullptr) grid.sync(); }
    const int tid = threadIdx.x, lane = tid & 63, wave = __builtin_amdgcn_readfirstlane(tid >> 6);
    const int G = gridDim.x, bx = blockIdx.x;
    const int vcu = (G % 8 == 0) ? (bx % 8) * (G / 8) + bx / 8 : bx;
    unsigned char* ws = a.ws;
    float* ss2 = (float*)(ws + WS_CTL + CTL_SS2); float* ss3 = (float*)(ws + WS_CTL + CTL_SS3); float* lamp = (float*)(ws + WS_CTL + CTL_LAM); float* rope = (float*)(ws + WS_CTL + CTL_ROPE);
    bf16_t* WIN = (bf16_t*)(ws + WS_WIN); bf16_t* WOUT = (bf16_t*)(ws + WS_WOUT); bf16_t* WGATE = (bf16_t*)(ws + WS_WGATE); bf16_t* WPROJ = (bf16_t*)(ws + WS_WPROJ);
    bf16_t* PB = (bf16_t*)(ws + WS_PB); bf16_t* XN = (bf16_t*)(ws + WS_XN); bf16_t* MIXED = (bf16_t*)(ws + WS_MIXED); bf16_t* PROJ = (bf16_t*)(ws + WS_PROJ);
    bf16_t* VT = (bf16_t*)(ws + WS_VT); bf16_t* KIMG = (bf16_t*)(ws + WS_KIMG); bf16_t* HB = (bf16_t*)(ws + WS_HB); bf16_t* PLEB = (bf16_t*)(ws + WS_PLE); bf16_t* H2B = (bf16_t*)(ws + WS_H2B);
    const float* x = a.in[0]; float* out = a.out;
    volatile LAS unsigned* xst = (volatile LAS unsigned*)(lds + 131072);
    if (tid == 0) { xst[0] = 0u; xst[1] = 0u; }
    __syncthreads();
    const XcdBarrier xb = xcd_barrier_post((unsigned*)(ws + WS_CTL + CTL_BAR), xst);

    for (int rep_ = 0; rep_ < ((PROBE_DUP & 1) ? 2 : 1); ++rep_) {
        if (rep_) __syncthreads();
        const int gw = bx * 8 + wave, NGW = G * 8; const int gt = bx * 512 + tid, NGT = G * 512;
        for (int i = gt; i < 2 * NTOK; i += NGT) ss2[i] = 0.f;
        if (gt == 0) { float s1 = 0.f, s2 = 0.f; for (int i = 0; i < 64; ++i) { s1 += a.in[4][i] * a.in[5][i]; s2 += a.in[6][i] * a.in[7][i]; } lamp[0] = expf(s1) - expf(s2) + LAMBDA_INIT; }
        for (int i = gt; i < SEQ * 8; i += NGT) { const int pos = i >> 3, f = i & 7;
            const float invf = (float)exp2(-(double)f * 0.125 * 18.931568569324174);
            const float angf = (float)pos * invf;
            const double tw = 6.283185307179586476925; double ang = (double)angf; ang -= tw * rint(ang / tw);
            rope[2 * i] = (float)cos(ang); rope[2 * i + 1] = (float)sin(ang); }
        LAS float* scr = (LAS float*)(lds + wave * 16384);
        constexpr int I_IN = (DM / 64) * (8192 / 32), I_SQ = (DM / 64) * (DM / 32), I_PR = (PLE / 64) * (DM / 32), I_ALL = I_IN + 2 * I_SQ + I_PR;
#define P0_DECODE(T, it_) do { int rr_ = (it_); \
            if (rr_ < I_IN) { T = TItem{a.in[3], WIN, nullptr, DM, 8192, 1, rr_}; } \
            else if (rr_ < I_IN + I_SQ) { T = TItem{a.in[9], WOUT, nullptr, DM, DM, 0, rr_ - I_IN}; } \
            else if (rr_ < I_IN + 2 * I_SQ) { T = TItem{a.in[11], WGATE, a.in[10], DM, DM, 0, rr_ - I_IN - I_SQ}; } \
            else { T = TItem{a.in[12], WPROJ, nullptr, PLE, DM, 0, rr_ - I_IN - 2 * I_SQ}; } } while (0)
        {
            float tv[32]; TItem cur, nxt; int it = gw;
            if (it < I_ALL) { P0_DECODE(cur, it); tr_load(cur, tv, lane); }
            while (it < I_ALL) {
                tr_write(tv, scr, lane);
                const int itn = it + NGW;
                if (itn < I_ALL) { P0_DECODE(nxt, itn); tr_load(nxt, tv, lane); }
                asm volatile("s_waitcnt lgkmcnt(0)" ::: "memory");
                tr_store(cur, scr, lane);
                asm volatile("s_waitcnt lgkmcnt(0)" ::: "memory");
                cur = nxt; it = itn;
            }
        }
#undef P0_DECODE
        {
            f32x4 gv[8], va[8], vb[8];
            { const f32x4* gr = (const f32x4*)a.in[2] + lane;
#pragma unroll
              for (int j = 0; j < 8; ++j) gv[j] = gr[64 * j]; }
            int m = gw;
            if (m < NTOK) rms_load(x + (size_t)m * DM, va, lane);
            for (; m < NTOK; m += 2 * NGW) {
                const int m1 = m + NGW, m2 = m + 2 * NGW;
                if (m1 < NTOK) rms_load(x + (size_t)m1 * DM, vb, lane);
                rms_finish(va, gv, XN + (size_t)m * DM, lane);
                if (m2 < NTOK) rms_load(x + (size_t)m2 * DM, va, lane);
                if (m1 < NTOK) rms_finish(vb, gv, XN + (size_t)m1 * DM, lane);
            }
        }
        for (int i = gt; i < NTOK * PLE / 8; i += NGT) { const f32x4 v0 = __builtin_nontemporal_load(&((const f32x4*)a.in[1])[2 * i]), v1 = __builtin_nontemporal_load(&((const f32x4*)a.in[1])[2 * i + 1]);
            u32x4 w; w.x = cvt_pk(v0[0], v0[1]); w.y = cvt_pk(v0[2], v0[3]); w.z = cvt_pk(v1[0], v1[1]); w.w = cvt_pk(v1[2], v1[3]); ((u32x4*)PB)[i] = w; }
    }
    xcd_barrier(xb);
    for (int rep_ = 0; rep_ < ((PROBE_DUP & 2) ? 2 : 1); ++rep_) {
        if (rep_) __syncthreads();
        { pg8::Gemm g{XN, WIN, NTOK, NPROJ, DM}; pg8::StaticOrder S; S.init(NTOK, NPROJ, G, bx); pg8::EpiProj E{PROJ, rope, KIMG};
          pg8::gemm_phase<pg8::EpiProj, pg8::StaticOrder, true, true>(lds, g, S, E); }
        __syncthreads();
        { pg8::Gemm g{WIN + (size_t)NPROJ * DM, XN, 2048, NTOK, DM}; pg8::StaticOrder S; S.init(2048, NTOK, G, bx); pg8::EpiVt E{VT};
          pg8::gemm_phase<pg8::EpiVt, pg8::StaticOrder, true, true>(lds, g, S, E); }
    }
    xcd_barrier(xb);
    for (int rep_ = 0; rep_ < ((PROBE_DUP & 4) ? 2 : 1); ++rep_) {
        const float lam = lamp[0];
        for (int su = vcu; su < 256; su += G) {
            const int grp = su >> 4, j = su & 15;
#pragma unroll 1
            for (int k = 0; k < 4; ++k) { const int bh = 4 * grp + k; const int qb = (k & 1) ? 15 - j : j;
                att::attn_unit_df(lds, PROJ, KIMG, VT, MIXED, bh >> 3, bh & 7, qb, lam, a.in[8]); }
        }
#pragma unroll 1
        for (int u = vcu; u < 512; u += G) att::attn_unit<0>(lds, PROJ, KIMG, VT, MIXED, (u >> 3) >> 3, (u >> 3) & 7, u & 7, lam, a.in[8]);
    }
    xcd_barrier(xb);
    {
        __syncthreads();
        { pg8::Gemm g{MIXED, WOUT, NTOK, DM, DM}; pg8::StaticOrder S; S.init(NTOK, DM, G, bx); pg8::EpiRes E{x, HB, ss2};
          pg8::gemm_phase<pg8::EpiRes, pg8::StaticOrder, true, true>(lds, g, S, E); }
        __syncthreads();
        { pg8::Gemm g{PB, WPROJ, NTOK, DM, PLE}; pg8::StaticOrder S; S.init(NTOK, DM, G, bx); pg8::EpiBf16 E{PLEB, DM};
          pg8::gemm_phase<pg8::EpiBf16, pg8::StaticOrder, true, true>(lds, g, S, E); }
    }
    xcd_barrier(xb);
    {
        pg8::Gemm g{HB, WGATE, NTOK, DM, DM}; pg8::StaticOrder S; S.init(NTOK, DM, G, bx); pg8::EpiGate E{HB, H2B, PLEB, ss2, ss3};
        pg8::gemm_phase<pg8::EpiGate, pg8::StaticOrder, true, true>(lds, g, S, E);
    }
    xcd_barrier(xb);
    {
        const int tid5 = opaque_tid(), lane = tid5 & 63, wave = __builtin_amdgcn_readfirstlane(tid5 >> 6);
        const int gw = bx * 8 + wave, NGW = G * 8; const f32x4* gr = (const f32x4*)a.in[13];
        f32x4 gv[8];
#pragma unroll
        for (int j = 0; j < 4; ++j) { gv[2 * j] = gr[2 * (lane + 64 * j)]; gv[2 * j + 1] = gr[2 * (lane + 64 * j) + 1]; }
#define P5_LOAD(H, S_, m_) do { const u32x4* hrow_ = (const u32x4*)(H2B + (size_t)(m_) * DM); S_ = ss3[m_]; _Pragma("unroll") for (int j_ = 0; j_ < 4; ++j_) H[j_] = hrow_[lane + 64 * j_]; } while (0)
#define P5_STORE(H, S_, m_) do { const float rstd_ = rsqrtf(S_ * (1.f / DM) + NORM_EPS); f32x4* orow_ = (f32x4*)(out + (size_t)(m_) * DM); \
            _Pragma("unroll") for (int j_ = 0; j_ < 4; ++j_) { const int c_ = lane + 64 * j_; const u32x4 hw_ = H[j_]; const f32x4 g0_ = gv[2 * j_], g1_ = gv[2 * j_ + 1]; \
                orow_[2 * c_] = (f32x4){bf_lo(hw_.x) * rstd_ * g0_[0], bf_hi(hw_.x) * rstd_ * g0_[1], bf_lo(hw_.y) * rstd_ * g0_[2], bf_hi(hw_.y) * rstd_ * g0_[3]}; \
                orow_[2 * c_ + 1] = (f32x4){bf_lo(hw_.z) * rstd_ * g1_[0], bf_hi(hw_.z) * rstd_ * g1_[1], bf_lo(hw_.w) * rstd_ * g1_[2], bf_hi(hw_.w) * rstd_ * g1_[3]}; } } while (0)
        u32x4 ha[4], hb4[4]; float sa = 0.f, sb = 0.f;
        int m = gw;
        if (m < NTOK) P5_LOAD(ha, sa, m);
        for (; m < NTOK; m += 2 * NGW) {
            const int m1 = m + NGW, m2 = m + 2 * NGW;
            if (m1 < NTOK) P5_LOAD(hb4, sb, m1);
            P5_STORE(ha, sa, m);
            if (m2 < NTOK) P5_LOAD(ha, sa, m2);
            if (m1 < NTOK) P5_STORE(hb4, sb, m1);
        }
#undef P5_LOAD
#undef P5_STORE
    }
}

extern "C" void kernel_launch(void* const* d_in, const int* in_sizes, int n_in, void* d_out, int out_size, void* d_ws, size_t ws_size, hipStream_t stream) {
    static int grid = 0;
    if (grid == 0) {
        if (n_in != 14 || out_size != NTOK * DM || ws_size < WS_END) { fprintf(stderr, "kernel_launch: unexpected shapes (n_in %d out %d ws %zu)\n", n_in, out_size, ws_size); grid = -1; return; }
        int dev = 0, cus = 0, per_cu = 0;
        (void)hipGetDevice(&dev); (void)hipDeviceGetAttribute(&cus, hipDeviceAttributeMultiprocessorCount, dev);
        (void)hipFuncSetAttribute((const void*)fwd_megakernel, hipFuncAttributeMaxDynamicSharedMemorySize, LDS_BYTES);
        (void)hipOccupancyMaxActiveBlocksPerMultiprocessor(&per_cu, (const void*)fwd_megakernel, 512, LDS_BYTES);
        if (per_cu < 1) { fprintf(stderr, "kernel_launch: occupancy query says %d blocks/CU\n", per_cu); per_cu = 1; }
        grid = cus * per_cu;
    }
    if (grid < 0) return;
    Args a{};
    for (int i = 0; i < 14; ++i) a.in[i] = (const float*)d_in[i];
    a.out = (float*)d_out; a.ws = (unsigned char*)d_ws;
    (void)hipMemsetAsync((unsigned char*)d_ws + WS_CTL + CTL_BAR, 0, CTL_BAR_BYTES, stream);
    void* args[] = {&a};
    hipError_t e = hipLaunchCooperativeKernel((void*)fwd_megakernel, dim3(grid), dim3(512), args, LDS_BYTES, stream);
    if (e != hipSuccess) fprintf(stderr, "cooperative launch failed: %s (grid %d)\n", hipGetErrorString(e), grid);
}
```

```cpp
#include <hip/hip_runtime.h>
#include <hip/hip_cooperative_groups.h>
#include <cstdio>
#include <cstdint>
namespace cg = cooperative_groups;
__device__ __forceinline__ int opaque_tid() { int t = (int)threadIdx.x; asm volatile("" : "+v"(t)); return t; }
#ifndef PROBE_DUP
#define PROBE_DUP 0
#endif
namespace pg8 {
#define PG8_LAS __attribute__((address_space(3)))
typedef unsigned short bf16_t;
typedef short bf16x8 __attribute__((ext_vector_type(8)));
typedef float f32x4 __attribute__((ext_vector_type(4)));
typedef unsigned u32x4 __attribute__((ext_vector_type(4)));
constexpr int BM = 256, BK = 64, HALF = 128, HTB = HALF * BK * 2  , STAGE_BYTES = 8 * HTB, NXCD = 8, WGM = 8;

__host__ __device__ __forceinline__ int lds_byte(int r, int c) { const int st = (r >> 4) * 2 + (c >> 5), rr = r & 15, cc = c & 31, ob = rr * 64 + cc * 2; return st * 1024 + (ob ^ (((ob >> 9) & 1) << 5)); }
__host__ __device__ __forceinline__ void stage_rc(int b, int& R, int& C) { const int st = b / 1024, sb = b % 1024, swz = sb ^ (((sb >> 9) & 1) << 5); R = (st >> 1) * 16 + swz / 64; C = (st & 1) * 32 + (swz % 64) / 2; }
__host__ __device__ __forceinline__ int perm32(int rho) { const int n = rho >> 4, i = rho & 15; return 8 * (i >> 2) + 4 * n + (i & 3); }

struct Unit { int pm, pn; };
struct Gemm { const bf16_t* A; const bf16_t* Bt; int M, N, K; };

struct StaticOrder {
    int nM, nN, nwg, G, c;
    __host__ __device__ void init(int M, int N, int G_, int c_) { nM = M / BM; nN = N / BM; nwg = nM * nN; G = G_; c = c_; }
    __host__ __device__ bool next(int i, Unit& u) const {
        const long L = (long)i * G + c; if (L >= nwg) return false;
        int wgid = (int)L; { const int q = nwg / NXCD, r = nwg % NXCD, xcd = wgid % NXCD, off = wgid / NXCD; wgid = (xcd < r ? xcd * (q + 1) : r * (q + 1) + (xcd - r) * q) + off; }
        const int nig = WGM * nN, gid = wgid / nig, fm = gid * WGM, gsz = (nM - fm) < WGM ? (nM - fm) : WGM;
        u.pm = fm + ((wgid % nig) % gsz); u.pn = (wgid % nig) / gsz; return true;
    }
    __device__ __forceinline__ void a_ready(const Unit&) const {}
    __device__ __forceinline__ void done(const Unit&) const {}
};

__device__ __forceinline__ unsigned cvt_pk_bf16(float lo, float hi) { unsigned r; asm volatile("v_cvt_pk_bf16_f32 %0, %1, %2" : "=v"(r) : "v"(lo), "v"(hi)); return r; }
typedef float f32x2 __attribute__((ext_vector_type(2)));
template <class Epi, class Sched, bool ALIGN_EPI = false, bool SP2 = false>
__device__ __forceinline__ void gemm_phase(PG8_LAS unsigned char* lds, const Gemm g, const Sched& S, const Epi& E) {
    const int tid = opaque_tid(), wid = __builtin_amdgcn_readfirstlane(tid >> 6), lane = tid & 63, wr = wid >> 2, wc = wid & 3, fr = lane & 15, fq = lane >> 4;
    const int K = g.K, nt = K / BK;
    unsigned voffA[2], voffB[2];
#pragma unroll
    for (int i = 0; i < 2; ++i) { int R, C; stage_rc(tid * 16 + i * 8192, R, C); const int Rb = Epi::PERM ? ((R & ~31) + perm32(R & 31)) : R;
        voffA[i] = (unsigned)(R * K + C) * 2u; voffB[i] = (unsigned)(Rb * K + C) * 2u; }
    const size_t kstep = (size_t)(BK * 2);
    const size_t hstep = (size_t)HALF * K * 2;
    const size_t tstep = 2 * hstep;
    const unsigned ldsw = (unsigned)wid * 1024u;
    const int aoff = lds_byte(wr * 64 + fr, fq * 8), boff = lds_byte(wc * 32 + fr, fq * 8);
#define PG8_SA(b, h) (((b) * 2 + (h)) * HTB)
#define PG8_SB(b, h) ((4 + (b) * 2 + (h)) * HTB)
#define PG8_STAGE(bufoff, gbase, voff) do { _Pragma("unroll") for (int _i = 0; _i < 2; ++_i) \
        __builtin_amdgcn_global_load_lds((const unsigned*)((const char*)(gbase) + (voff)[_i]), (PG8_LAS unsigned*)(lds + (bufoff) + ldsw + _i * 8192), 16, 0, 0); } while (0)
#define PG8_LDA(dst, b, h) do { _Pragma("unroll") for (int m = 0; m < 4; ++m) _Pragma("unroll") for (int k = 0; k < 2; ++k) dst[m][k] = *(const PG8_LAS bf16x8*)(lds + PG8_SA(b, h) + aoff + m * 2048 + k * 1024); } while (0)
#define PG8_LDB(dst, b, h) do { _Pragma("unroll") for (int n = 0; n < 2; ++n) _Pragma("unroll") for (int k = 0; k < 2; ++k) dst[n][k] = *(const PG8_LAS bf16x8*)(lds + PG8_SB(b, h) + boff + n * 2048 + k * 1024); } while (0)
#define PG8_MMA(ai, bj, At, Bt) do { __builtin_amdgcn_s_setprio(1); _Pragma("unroll") for (int m = 0; m < 4; ++m) _Pragma("unroll") for (int n = 0; n < 2; ++n) _Pragma("unroll") for (int k = 0; k < 2; ++k) \
        acc[ai][bj][m][n] = __builtin_amdgcn_mfma_f32_16x16x32_bf16(Bt[n][k], At[m][k], acc[ai][bj][m][n], 0, 0, 0); __builtin_amdgcn_s_setprio(0); } while (0)
#define PG8_WAIT_V(n) asm volatile("s_waitcnt vmcnt(" #n ")" ::: "memory")
#define PG8_WAIT_L(n) asm volatile("s_waitcnt lgkmcnt(" #n ")" ::: "memory")
#define PG8_BAR __builtin_amdgcn_s_barrier()
#define PG8_SCHED __builtin_amdgcn_sched_barrier(0)
    Unit cur, nxt; int ui = 0;
    if (!S.next(0, cur)) return;
    f32x4 acc[2][2][4][2];
#pragma unroll
    for (int a = 0; a < 2; ++a)
#pragma unroll
        for (int b = 0; b < 2; ++b)
#pragma unroll
            for (int m = 0; m < 4; ++m)
#pragma unroll
                for (int n = 0; n < 2; ++n) acc[a][b][m][n] = (f32x4){0.f, 0.f, 0.f, 0.f};
    bf16x8 At[4][2], B0[2][2], B1[2][2];
    const char* cA = (const char*)g.A + (size_t)cur.pm * tstep; const char* cB = (const char*)g.Bt + (size_t)cur.pn * tstep;
    S.a_ready(cur);
    if constexpr (SP2) {
        PG8_STAGE(PG8_SB(0, 0), cB, voffB); PG8_STAGE(PG8_SB(0, 1), cB + hstep, voffB); PG8_STAGE(PG8_SA(0, 0), cA, voffA); PG8_STAGE(PG8_SA(0, 1), cA + hstep, voffA);
        if (wr == 1) PG8_BAR;
        PG8_WAIT_V(2); PG8_BAR;
        PG8_STAGE(PG8_SB(1, 0), cB + kstep, voffB); PG8_STAGE(PG8_SA(1, 0), cA + kstep, voffA); PG8_STAGE(PG8_SB(1, 1), cB + hstep + kstep, voffB);
        PG8_WAIT_V(6); PG8_BAR;
    } else {
        PG8_STAGE(PG8_SB(0, 0), cB, voffB); PG8_STAGE(PG8_SA(0, 0), cA, voffA); PG8_STAGE(PG8_SB(0, 1), cB + hstep, voffB); PG8_STAGE(PG8_SA(0, 1), cA + hstep, voffA);
        if (wr == 1) PG8_BAR;
        PG8_WAIT_V(4); PG8_BAR;
        PG8_STAGE(PG8_SB(1, 0), cB + kstep, voffB); PG8_STAGE(PG8_SA(1, 0), cA + kstep, voffA); PG8_STAGE(PG8_SB(1, 1), cB + hstep + kstep, voffB);
        PG8_WAIT_V(6); PG8_BAR;
    }
    for (;;) {
        const bool has_next = S.next(ui + 1, nxt);
        const char* nA = has_next ? (const char*)g.A + (size_t)nxt.pm * tstep : cA; const char* nB = has_next ? (const char*)g.Bt + (size_t)nxt.pn * tstep : cB;
        for (int t = 0; t < nt; t += 2) {
            const bool last = (t == nt - 2);
            const char* a1 = cA + (size_t)(t + 1) * kstep;
            const char* a2 = last ? nA : cA + (size_t)(t + 2) * kstep; const char* b2 = last ? nB : cB + (size_t)(t + 2) * kstep;
            const char* a3 = a2 + kstep; const char* b3 = b2 + kstep;
            if (last && has_next) S.a_ready(nxt);
            if constexpr (SP2) {
            PG8_LDB(B0, 0, 0); PG8_LDB(B1, 0, 1); PG8_SCHED; PG8_LDA(At, 0, 0); PG8_STAGE(PG8_SA(1, 1), a1 + hstep, voffA);
            PG8_WAIT_V(8); PG8_WAIT_L(0); PG8_BAR; PG8_MMA(0, 0, At, B0); PG8_MMA(0, 1, At, B1); PG8_BAR; PG8_SCHED;
            PG8_LDA(At, 0, 1); PG8_STAGE(PG8_SB(0, 0), b2, voffB); PG8_STAGE(PG8_SB(0, 1), b2 + hstep, voffB); PG8_STAGE(PG8_SA(0, 0), a2, voffA);
            PG8_WAIT_V(8); PG8_WAIT_L(0); PG8_BAR; PG8_MMA(1, 0, At, B0); PG8_MMA(1, 1, At, B1); PG8_BAR; PG8_SCHED;
            PG8_LDB(B0, 1, 0); PG8_LDB(B1, 1, 1); PG8_SCHED; PG8_LDA(At, 1, 0); PG8_STAGE(PG8_SA(0, 1), a2 + hstep, voffA);
            PG8_WAIT_V(8); PG8_WAIT_L(0); PG8_BAR; PG8_MMA(0, 0, At, B0); PG8_MMA(0, 1, At, B1); PG8_BAR; PG8_SCHED;
            PG8_LDA(At, 1, 1); PG8_STAGE(PG8_SB(1, 0), b3, voffB); PG8_STAGE(PG8_SB(1, 1), b3 + hstep, voffB); PG8_STAGE(PG8_SA(1, 0), a3, voffA);
            PG8_WAIT_V(8); PG8_WAIT_L(0); PG8_BAR; PG8_MMA(1, 0, At, B0); PG8_MMA(1, 1, At, B1); PG8_BAR; PG8_SCHED;
            } else {
            PG8_LDB(B0, 0, 0); PG8_SCHED; PG8_LDA(At, 0, 0); PG8_STAGE(PG8_SA(1, 1), a1 + hstep, voffA);
            PG8_WAIT_L(8); PG8_BAR; PG8_WAIT_L(0); PG8_MMA(0, 0, At, B0); PG8_BAR; PG8_SCHED;
            PG8_LDB(B1, 0, 1); PG8_STAGE(PG8_SB(0, 0), b2, voffB);
            PG8_BAR; PG8_WAIT_L(0); PG8_MMA(0, 1, At, B1); PG8_BAR;
            PG8_LDA(At, 0, 1); PG8_STAGE(PG8_SA(0, 0), a2, voffA);
            PG8_BAR; PG8_WAIT_L(0); PG8_MMA(1, 0, At, B0); PG8_BAR; PG8_SCHED;
            PG8_STAGE(PG8_SB(0, 1), b2 + hstep, voffB);
            PG8_WAIT_V(6); PG8_BAR; PG8_MMA(1, 1, At, B1); PG8_BAR;
            PG8_LDB(B0, 1, 0); PG8_SCHED; PG8_LDA(At, 1, 0); PG8_STAGE(PG8_SA(0, 1), a2 + hstep, voffA);
            PG8_WAIT_L(8); PG8_BAR; PG8_WAIT_L(0); PG8_MMA(0, 0, At, B0); PG8_BAR; PG8_SCHED;
            PG8_LDB(B1, 1, 1); PG8_STAGE(PG8_SB(1, 0), b3, voffB);
            PG8_BAR; PG8_WAIT_L(0); PG8_MMA(0, 1, At, B1); PG8_BAR;
            PG8_LDA(At, 1, 1); PG8_STAGE(PG8_SA(1, 0), a3, voffA);
            PG8_BAR; PG8_WAIT_L(0); PG8_MMA(1, 0, At, B0); PG8_BAR; PG8_SCHED;
            PG8_STAGE(PG8_SB(1, 1), b3 + hstep, voffB);
            PG8_WAIT_V(6); PG8_BAR; PG8_MMA(1, 1, At, B1); PG8_BAR;
            }
        }
        if constexpr (ALIGN_EPI) { if (wr == 0) PG8_BAR; }
        if constexpr (!Epi::AFTER_DRAIN) { E(acc, cur, wr, wc, fr, fq); S.done(cur); }
        if (!has_next) break;
#pragma unroll
        for (int a = 0; a < 2; ++a)
#pragma unroll
            for (int b = 0; b < 2; ++b)
#pragma unroll
                for (int m = 0; m < 4; ++m)
#pragma unroll
                    for (int n = 0; n < 2; ++n) acc[a][b][m][n] = (f32x4){0.f, 0.f, 0.f, 0.f};
        cur = nxt; cA = nA; cB = nB; ++ui;
        if constexpr (ALIGN_EPI) { if (wr == 1) PG8_BAR; }
    }
    PG8_WAIT_V(0);
    if constexpr (!ALIGN_EPI) { if (wr == 0) PG8_BAR; }
    PG8_BAR;
    if constexpr (Epi::AFTER_DRAIN) { E.fused(acc, cur, wr, wc, fr, fq, lds, wid, lane); S.done(cur); }
#undef PG8_SA
#undef PG8_SB
#undef PG8_STAGE
#undef PG8_LDA
#undef PG8_LDB
#undef PG8_MMA
#undef PG8_WAIT_V
#undef PG8_WAIT_L
#undef PG8_BAR
#undef PG8_SCHED
}
}
#define LAS __attribute__((address_space(3)))
typedef unsigned short bf16_t;
typedef short bf16x8 __attribute__((ext_vector_type(8)));
typedef float f32x4 __attribute__((ext_vector_type(4)));
typedef float f32x2 __attribute__((ext_vector_type(2)));
typedef float f32x16 __attribute__((ext_vector_type(16)));
typedef unsigned u32x4 __attribute__((ext_vector_type(4)));
typedef unsigned u32x2 __attribute__((ext_vector_type(2)));

constexpr int NTOK = 16384, DM = 2048, SEQ = 2048, NBATCH = 8, PLE = 256;
constexpr int NPROJ = 6144;
constexpr int PQ_SB = 0, PK_SB = 1024, PG_SB = 2048, PQ_DF = 3072, PK_DF = 4096, PG_DF = 5120;
constexpr float LOG2E = 1.4426950408889634f;
constexpr float SBQ_SCALE = 0.08838834764831845f * LOG2E;
constexpr float DFQ_SCALE = 0.125f * LOG2E;
constexpr float NORM_EPS = 1e-6f, SUBLN_EPS = 1e-5f;
constexpr float LAMBDA_INIT = 0.2f;

constexpr size_t MiB = 1u << 20;
constexpr size_t WS_CTL = 0;
constexpr size_t CTL_SS2 = 0, CTL_SS3 = 65536, CTL_LAM = 131072, CTL_ROPE = 262144, CTL_BAR = 524288, CTL_BAR_BYTES = 16384;
constexpr size_t WS_WIN = 2 * MiB, WS_WOUT = 34 * MiB, WS_WGATE = 42 * MiB, WS_WPROJ = 50 * MiB, WS_PB = 52 * MiB;
constexpr size_t WS_XN = 64 * MiB, WS_MIXED = 64 * MiB;
constexpr size_t WS_PROJ = 128 * MiB, WS_VT = 320 * MiB, WS_KIMG = 384 * MiB, WS_END = 448 * MiB;
constexpr size_t WS_HB = 128 * MiB, WS_PLE = 192 * MiB;
constexpr size_t WS_H2B = 64 * MiB;

constexpr int LDS_BYTES = 131072 + 1024;

typedef __bf16 bf16x2_t __attribute__((ext_vector_type(2)));
__device__ __forceinline__ unsigned cvt_pk(float lo, float hi) { f32x2 v = {lo, hi}; bf16x2_t b = __builtin_convertvector(v, bf16x2_t); return __builtin_bit_cast(unsigned, b); }
__device__ __forceinline__ float bf_lo(unsigned w) { return __uint_as_float(w << 16); }
__device__ __forceinline__ float bf_hi(unsigned w) { return __uint_as_float(w & 0xffff0000u); }
__device__ __forceinline__ float wave_sum(float v) {
#pragma unroll
    for (int o = 1; o < 64; o <<= 1) v += __shfl_xor(v, o);
    return v;
}
__device__ __forceinline__ float fast_exp2(float x) { return __builtin_amdgcn_exp2f(x); }
__device__ __forceinline__ float fast_log2(float x) { return __builtin_amdgcn_logf(x); }
__device__ __forceinline__ float silu_f(float x) { return x * __builtin_amdgcn_rcpf(1.f + fast_exp2(-x * LOG2E)); }
__device__ __forceinline__ float sigmoid_f(float x) { return __builtin_amdgcn_rcpf(1.f + fast_exp2(-x * LOG2E)); }

namespace pg8 {
struct EpiBf16 {
    static constexpr bool PERM = true, AFTER_DRAIN = false;
    bf16_t* O; int ldc;
    __device__ __forceinline__ void operator()(const f32x4 (&acc)[2][2][4][2], const Unit& u, int wr, int wc, int fr, int fq) const {
        const int row0 = u.pm * BM + wr * 64 + fr; const int col0 = u.pn * BM + wc * 32 + 8 * fq;
#pragma unroll
        for (int ai = 0; ai < 2; ++ai)
#pragma unroll
            for (int m = 0; m < 4; ++m) { bf16_t* rowp = O + (size_t)(row0 + ai * HALF + m * 16) * ldc + col0;
#pragma unroll
                for (int bj = 0; bj < 2; ++bj) { const f32x4 v0 = acc[ai][bj][m][0], v1 = acc[ai][bj][m][1];
                    u32x4 w; w.x = cvt_pk_bf16(v0[0], v0[1]); w.y = cvt_pk_bf16(v0[2], v0[3]); w.z = cvt_pk_bf16(v1[0], v1[1]); w.w = cvt_pk_bf16(v1[2], v1[3]);
                    *(u32x4*)(rowp + bj * HALF) = w; } }
    }
};
struct EpiProj {
    static constexpr bool PERM = true, AFTER_DRAIN = false;
    bf16_t* O; const float* rope; bf16_t* KI;
    __device__ __forceinline__ void operator()(const f32x4 (&acc)[2][2][4][2], const Unit& u, int wr, int wc, int fr, int fq) const {
        const int row0 = u.pm * BM + wr * 64 + fr; const int col0 = u.pn * BM + wc * 32 + 8 * fq;
        const int kind = u.pn >> 2;
        const bool dorope = (kind == 3 || kind == 4) && ((wc & 1) == 0) && (fq < 2);
        const float sc = kind == 0 ? SBQ_SCALE : (kind == 3 ? DFQ_SCALE : 1.f);
        const bool dosilu = (kind == 2 || kind == 5);
#pragma unroll
        for (int ai = 0; ai < 2; ++ai)
#pragma unroll
            for (int m = 0; m < 4; ++m) { const int row = row0 + ai * HALF + m * 16; bf16_t* rowp = O + (size_t)row * NPROJ + col0;
                if (kind == 1 || kind == 4) {
                    const int cw = col0 & 1023; rowp = KI + ((size_t)(((kind == 4 ? 8 : 0) + (row >> 11)) * 8 + (cw >> 7)) * SEQ + (row & (SEQ - 1))) * 128 + (cw & 127); }
                f32x4 cs0 = {1.f, 0.f, 1.f, 0.f}, cs1 = {1.f, 0.f, 1.f, 0.f};
                if (dorope) { const f32x4* rp = (const f32x4*)(rope + ((size_t)(row & (SEQ - 1)) * 8 + 4 * fq) * 2); cs0 = rp[0]; cs1 = rp[1]; }
#pragma unroll
                for (int bj = 0; bj < 2; ++bj) { f32x4 v0 = acc[ai][bj][m][0], v1 = acc[ai][bj][m][1];
                    if (dorope) {
                        f32x4 a, b;
                        a[0] = v0[0] * cs0[0] - v0[1] * cs0[1]; a[1] = v0[1] * cs0[0] + v0[0] * cs0[1];
                        a[2] = v0[2] * cs0[2] - v0[3] * cs0[3]; a[3] = v0[3] * cs0[2] + v0[2] * cs0[3];
                        b[0] = v1[0] * cs1[0] - v1[1] * cs1[1]; b[1] = v1[1] * cs1[0] + v1[0] * cs1[1];
                        b[2] = v1[2] * cs1[2] - v1[3] * cs1[3]; b[3] = v1[3] * cs1[2] + v1[2] * cs1[3];
                        v0 = a; v1 = b; }
                    if (dosilu) {
#pragma unroll
                        for (int j = 0; j < 4; ++j) { v0[j] = silu_f(v0[j]); v1[j] = silu_f(v1[j]); } }
                    v0 = v0 * sc; v1 = v1 * sc;
                    u32x4 w; w.x = cvt_pk_bf16(v0[0], v0[1]); w.y = cvt_pk_bf16(v0[2], v0[3]); w.z = cvt_pk_bf16(v1[0], v1[1]); w.w = cvt_pk_bf16(v1[2], v1[3]);
                    *(u32x4*)(rowp + ((kind == 1 || kind == 4) ? bj * SEQ * 128 : bj * HALF)) = w; } }
    }
};
struct EpiVt {
    static constexpr bool PERM = true, AFTER_DRAIN = false;
    bf16_t* O;
    __device__ __forceinline__ void operator()(const f32x4 (&acc)[2][2][4][2], const Unit& u, int wr, int wc, int fr, int fq) const {
        const int row0 = u.pm * BM + wr * 64 + fr; const int col0 = u.pn * BM + wc * 32 + 8 * fq;
        const int p0 = (fq & 1) ? 4 : 0, p1 = (fq & 1) ? 12 : 8;
#pragma unroll
        for (int ai = 0; ai < 2; ++ai)
#pragma unroll
            for (int m = 0; m < 4; ++m) { const int row = row0 + ai * HALF + m * 16; const int gh = row >> 7, d = row & 127;
#pragma unroll
                for (int bj = 0; bj < 2; ++bj) { const int col = col0 + bj * HALF; const int b = col >> 11, sq = col & (SEQ - 1);
                    bf16_t* tp = O + ((size_t)((((gh >> 3) * 8 + b) * 8 + (gh & 7)) * 32 + (sq >> 6)) * 128 + d) * 64 + (sq & 48);
                    const f32x4 v0 = acc[ai][bj][m][0], v1 = acc[ai][bj][m][1];
                    u32x2 w0, w1; w0.x = cvt_pk_bf16(v0[0], v0[1]); w0.y = cvt_pk_bf16(v0[2], v0[3]); w1.x = cvt_pk_bf16(v1[0], v1[1]); w1.y = cvt_pk_bf16(v1[2], v1[3]);
                    *(u32x2*)(tp + p0) = w0; *(u32x2*)(tp + p1) = w1; } }
    }
};
struct EpiRes {
    static constexpr bool PERM = true, AFTER_DRAIN = false;
    const float* x; bf16_t* hb; float* ss;
    __device__ __forceinline__ void operator()(const f32x4 (&acc)[2][2][4][2], const Unit& u, int wr, int wc, int fr, int fq) const {
        const int row0 = u.pm * BM + wr * 64 + fr; const int col0 = u.pn * BM + wc * 32 + 8 * fq;
#pragma unroll
        for (int ai = 0; ai < 2; ++ai)
#pragma unroll
            for (int m = 0; m < 4; ++m) { const int row = row0 + ai * HALF + m * 16; const size_t off = (size_t)row * DM + col0; float q = 0.f;
#pragma unroll
                for (int bj = 0; bj < 2; ++bj) { const size_t o2 = off + bj * HALF;
                    const f32x4 h0 = __builtin_nontemporal_load((const f32x4*)(x + o2)) + acc[ai][bj][m][0], h1 = __builtin_nontemporal_load((const f32x4*)(x + o2 + 4)) + acc[ai][bj][m][1];
                    u32x4 w; w.x = cvt_pk_bf16(h0[0], h0[1]); w.y = cvt_pk_bf16(h0[2], h0[3]); w.z = cvt_pk_bf16(h1[0], h1[1]); w.w = cvt_pk_bf16(h1[2], h1[3]);
                    *(u32x4*)(hb + o2) = w;
                    q += ((h0[0] * h0[0] + h0[1] * h0[1]) + (h0[2] * h0[2] + h0[3] * h0[3])) + ((h1[0] * h1[0] + h1[1] * h1[1]) + (h1[2] * h1[2] + h1[3] * h1[3])); }
                q += __shfl_xor(q, 16); q += __shfl_xor(q, 32);
                if (fq == 0) atomicAdd(ss + row, q); }
    }
};
struct EpiGate {
    static constexpr bool PERM = true, AFTER_DRAIN = false;
    const bf16_t* hb; bf16_t* h2b; const bf16_t* ple; const float* ss2; float* ss3;
    __device__ __forceinline__ void operator()(const f32x4 (&acc)[2][2][4][2], const Unit& u, int wr, int wc, int fr, int fq) const {
        const int row0 = u.pm * BM + wr * 64 + fr; const int col0 = u.pn * BM + wc * 32 + 8 * fq;
#pragma unroll
        for (int ai = 0; ai < 2; ++ai)
#pragma unroll
            for (int m = 0; m < 4; ++m) { const int row = row0 + ai * HALF + m * 16; const size_t off = (size_t)row * DM + col0; float q = 0.f;
                const float rstd = rsqrtf(ss2[row] * (1.f / DM) + NORM_EPS);
#pragma unroll
                for (int bj = 0; bj < 2; ++bj) { const size_t o2 = off + bj * HALF; const u32x4 hw = *(const u32x4*)(hb + o2); const u32x4 pw = *(const u32x4*)(ple + o2);
                    const f32x4 a0 = acc[ai][bj][m][0] * rstd, a1 = acc[ai][bj][m][1] * rstd; f32x4 g0, g1;
                    g0[0] = bf_lo(hw.x) + sigmoid_f(a0[0]) * bf_lo(pw.x); g0[1] = bf_hi(hw.x) + sigmoid_f(a0[1]) * bf_hi(pw.x);
                    g0[2] = bf_lo(hw.y) + sigmoid_f(a0[2]) * bf_lo(pw.y); g0[3] = bf_hi(hw.y) + sigmoid_f(a0[3]) * bf_hi(pw.y);
                    g1[0] = bf_lo(hw.z) + sigmoid_f(a1[0]) * bf_lo(pw.z); g1[1] = bf_hi(hw.z) + sigmoid_f(a1[1]) * bf_hi(pw.z);
                    g1[2] = bf_lo(hw.w) + sigmoid_f(a1[2]) * bf_lo(pw.w); g1[3] = bf_hi(hw.w) + sigmoid_f(a1[3]) * bf_hi(pw.w);
                    u32x4 w2; w2.x = cvt_pk_bf16(g0[0], g0[1]); w2.y = cvt_pk_bf16(g0[2], g0[3]); w2.z = cvt_pk_bf16(g1[0], g1[1]); w2.w = cvt_pk_bf16(g1[2], g1[3]);
                    *(u32x4*)(h2b + o2) = w2;
                    q += ((g0[0] * g0[0] + g0[1] * g0[1]) + (g0[2] * g0[2] + g0[3] * g0[3])) + ((g1[0] * g1[0] + g1[1] * g1[1]) + (g1[2] * g1[2] + g1[3] * g1[3])); }
                q += __shfl_xor(q, 16); q += __shfl_xor(q, 32);
                if (fq == 0) atomicAdd(ss3 + row, q); }
    }
};
}
namespace att {
constexpr int KP = 272, VP = 144, KT_BYTES = 64 * KP, VT_BYTES = 128 * VP, BUF_BYTES = KT_BYTES + VT_BYTES;
constexpr int FLAG_OFF = 2 * BUF_BYTES;
constexpr int XP = 132;
constexpr float R_DONE = 152.0f;

template <bool MASK>
__device__ __forceinline__ void sb_block(const f32x16& sv, int kbase, int tq, int h, float& R, bf16x8 (&pf)[2]) {
    float c[16], z[16];
#pragma unroll
    for (int i = 0; i < 16; ++i) {
        z[i] = (!MASK || (kbase + 8 * (i >> 2) + (i & 3) < tq)) ? sv[i] : -1e30f;
        c[i] = fmaxf(z[i], 0.f) + fast_log2(1.f + fast_exp2(-fabsf(z[i])));
    }
    float T[4], OT[4], pr[4], suf[4];
#pragma unroll
    for (int g = 0; g < 4; ++g) { c[4 * g + 2] += c[4 * g + 3]; c[4 * g + 1] += c[4 * g + 2]; c[4 * g] += c[4 * g + 1]; T[g] = c[4 * g]; }
#pragma unroll
    for (int g = 0; g < 4; ++g) { OT[g] = __shfl_xor(T[g], 32); pr[g] = T[g] + OT[g]; }
    suf[3] = 0.f; suf[2] = pr[3]; suf[1] = suf[2] + pr[2]; suf[0] = suf[1] + pr[1];
    float w[16];
#pragma unroll
    for (int g = 0; g < 4; ++g) { const float off = R + suf[g] + (h == 0 ? OT[g] : 0.f);
#pragma unroll
        for (int j = 0; j < 4; ++j) { const int i = 4 * g + j; w[i] = fast_exp2(z[i] - (off + c[i])); } }
    R += suf[0] + pr[0];
#pragma unroll
    for (int sp = 0; sp < 2; ++sp) { u32x4 p; p.x = cvt_pk(w[8 * sp], w[8 * sp + 1]); p.y = cvt_pk(w[8 * sp + 2], w[8 * sp + 3]); p.z = cvt_pk(w[8 * sp + 4], w[8 * sp + 5]); p.w = cvt_pk(w[8 * sp + 6], w[8 * sp + 7]);
        pf[sp] = __builtin_bit_cast(bf16x8, p); }
}

template <int MODE>
__device__ __forceinline__ void attn_unit(LAS unsigned char* lds, const bf16_t* __restrict__ PROJ, const bf16_t* __restrict__ KIMG, const bf16_t* __restrict__ VT, bf16_t* __restrict__ MIXED,
                                          int b, int hh, int qblk, float lam, const float* __restrict__ subln_g) {
    constexpr int QB = MODE == 0 ? 256 : 128;
    constexpr int NKS = MODE == 0 ? 8 : 4;
    const int tid = opaque_tid(), lane = tid & 63, r = lane & 31, h = lane >> 5;
    const int wid = __builtin_amdgcn_readfirstlane(tid >> 6);
    const int qg = MODE == 0 ? wid : (wid & 3), role = MODE == 0 ? 0 : (wid >> 2);
    const int Q0 = qblk * QB, q0w = Q0 + 32 * qg, tq = q0w + r;
    const size_t tokbase = (size_t)b * SEQ;
    const int gbh = ((MODE == 0 ? 0 : 8) + b) * 8 + hh;
    const bf16_t* Kg = KIMG + (size_t)gbh * SEQ * 128;
    const bf16_t* Vg = VT + (size_t)gbh * 32 * 8192;
    bf16x8 qf[NKS];
    { const bf16_t* qp = PROJ + (tokbase + tq) * NPROJ + (MODE == 0 ? PQ_SB + hh * 128 : PQ_DF + hh * 128 + role * 64) + 8 * h;
#pragma unroll
      for (int ks = 0; ks < NKS; ++ks) qf[ks] = *(const bf16x8*)(qp + 16 * ks); }
    f32x16 o[4];
#pragma unroll
    for (int d = 0; d < 4; ++d)
#pragma unroll
        for (int i = 0; i < 16; ++i) o[d][i] = 0.f;
    float R = 0.f, m_run = -1e30f, l_run = 0.f;
    const int kr0 = tid >> 4, kc = tid & 15, vr0 = tid >> 3, vc = tid & 7;
    const int kst = kr0 * KP + kc * 16, vst = KT_BYTES + vr0 * VP + vc * 16;
    const bf16_t* kgl = Kg + tid * 8;
    const bf16_t* vgl = Vg + tid * 8;
    u32x4 kreg[2], vreg[2];
#define ATT_LOAD(t) do { _Pragma("unroll") for (int i_ = 0; i_ < 2; ++i_) { \
        kreg[i_] = *(const u32x4*)(kgl + (size_t)(t) * 8192 + i_ * 4096); \
        vreg[i_] = *(const u32x4*)(vgl + (size_t)(t) * 8192 + i_ * 4096); } } while (0)
#define ATT_STORE(bo) do { _Pragma("unroll") for (int i_ = 0; i_ < 2; ++i_) { \
        *(LAS u32x4*)(lds + (bo) + kst + i_ * 32 * KP) = kreg[i_]; \
        *(LAS u32x4*)(lds + (bo) + vst + i_ * 64 * VP) = vreg[i_]; } } while (0)
    const int tl = (Q0 + QB - 1) >> 6;
    const int kfrag = r * KP + (role * 64 + 8 * h) * 2;
    const int vfrag = KT_BYTES + r * VP + (8 * h) * 2;
    volatile LAS int* flags = (volatile LAS int*)(lds + FLAG_OFF);
    __syncthreads();
    ATT_LOAD(tl); ATT_STORE(0);
    __syncthreads();
    int cur = 0, it = 0;
    bool wdone = false;
    for (int t = tl;; --t, ++it) {
        if (t > 0) ATT_LOAD(t - 1);
        const int k0 = 64 * t;
        const bool active = (MODE == 0) ? (!wdone && k0 <= q0w + 30) : (k0 <= q0w + 31);
        if (active) {
            const int bo = cur * BUF_BYTES;
            f32x16 s[2];
            bf16x8 vf[4][2][2];
            if (MODE == 1) {
                bf16x8 kf[2][NKS];
#pragma unroll
                for (int kb = 0; kb < 2; ++kb)
#pragma unroll
                    for (int ks = 0; ks < NKS; ++ks) kf[kb][ks] = *(const LAS bf16x8*)(lds + bo + kfrag + kb * 32 * KP + ks * 32);
                __builtin_amdgcn_sched_barrier(0);
#pragma unroll
                for (int kb = 0; kb < 2; ++kb) {
#pragma unroll
                    for (int i = 0; i < 16; ++i) s[kb][i] = 0.f;
#pragma unroll
                    for (int ks = 0; ks < NKS; ++ks) s[kb] = __builtin_amdgcn_mfma_f32_32x32x16_bf16(kf[kb][ks], qf[ks], s[kb], 0, 0, 0);
                }
                __builtin_amdgcn_sched_barrier(0);
#pragma unroll
                for (int d = 0; d < 2; ++d)
#pragma unroll
                    for (int kb = 0; kb < 2; ++kb)
#pragma unroll
                        for (int sp = 0; sp < 2; ++sp) vf[d][kb][sp] = *(const LAS bf16x8*)(lds + bo + vfrag + d * 32 * VP + (32 * kb + 16 * sp) * 2);
                __builtin_amdgcn_sched_barrier(0);
            } else {
#pragma unroll
                for (int kb = 0; kb < 2; ++kb) {
#pragma unroll
                    for (int i = 0; i < 16; ++i) s[kb][i] = 0.f;
#pragma unroll
                    for (int ks = 0; ks < NKS; ++ks) {
                        const bf16x8 a = *(const LAS bf16x8*)(lds + bo + kfrag + kb * 32 * KP + ks * 32);
                        s[kb] = __builtin_amdgcn_mfma_f32_32x32x16_bf16(a, qf[ks], s[kb], 0, 0, 0);
                    }
                }
            }
            bf16x8 pf[2][2];
            if (MODE == 0) {
                sb_block<true>(s[1], k0 + 32 + 4 * h, tq, h, R, pf[1]);
                if (__all(R >= R_DONE)) {
#pragma unroll
                    for (int sp = 0; sp < 2; ++sp)
#pragma unroll
                        for (int j = 0; j < 8; ++j) pf[0][sp][j] = 0;
                } else sb_block<true>(s[0], k0 + 4 * h, tq, h, R, pf[0]);
                wdone = __all(R >= R_DONE);
            } else {
                float mx = -1e30f;
                if (k0 + 63 > q0w) {
#pragma unroll
                    for (int kb = 0; kb < 2; ++kb) { const int kbase = k0 + 32 * kb + 4 * h;
#pragma unroll
                        for (int i = 0; i < 16; ++i) { const int key = kbase + 8 * (i >> 2) + (i & 3); const float v = (key <= tq) ? s[kb][i] : -1e30f; s[kb][i] = v; mx = fmaxf(mx, v); } }
                } else {
#pragma unroll
                    for (int kb = 0; kb < 2; ++kb)
#pragma unroll
                        for (int i = 0; i < 16; ++i) mx = fmaxf(mx, s[kb][i]);
                }
                mx = fmaxf(mx, __shfl_xor(mx, 32));
                const float m_new = fmaxf(m_run, mx), alpha = fast_exp2(m_run - m_new);
                m_run = m_new;
                float ls = 0.f;
#pragma unroll
                for (int kb = 0; kb < 2; ++kb) {
#pragma unroll
                    for (int i = 0; i < 16; ++i) { const float p = fast_exp2(s[kb][i] - m_new); s[kb][i] = p; ls += p; }
#pragma unroll
                    for (int sp = 0; sp < 2; ++sp) { u32x4 p; p.x = cvt_pk(s[kb][8 * sp], s[kb][8 * sp + 1]); p.y = cvt_pk(s[kb][8 * sp + 2], s[kb][8 * sp + 3]); p.z = cvt_pk(s[kb][8 * sp + 4], s[kb][8 * sp + 5]); p.w = cvt_pk(s[kb][8 * sp + 6], s[kb][8 * sp + 7]);
                        pf[kb][sp] = __builtin_bit_cast(bf16x8, p); }
                }
                l_run = l_run * alpha + ls;
                if (!__all(alpha == 1.f)) {
#pragma unroll
                    for (int d = 0; d < 4; ++d)
#pragma unroll
                        for (int i = 0; i < 16; ++i) o[d][i] *= alpha;
                }
            }
            if (MODE == 1) {
                __builtin_amdgcn_sched_barrier(0);
#pragma unroll
                for (int d = 2; d < 4; ++d)
#pragma unroll
                    for (int kb = 0; kb < 2; ++kb)
#pragma unroll
                        for (int sp = 0; sp < 2; ++sp) vf[d][kb][sp] = *(const LAS bf16x8*)(lds + bo + vfrag + d * 32 * VP + (32 * kb + 16 * sp) * 2);
                __builtin_amdgcn_sched_barrier(0);
            }
#pragma unroll
            for (int d = 0; d < 4; ++d)
#pragma unroll
                for (int kb = 0; kb < 2; ++kb)
#pragma unroll
                    for (int sp = 0; sp < 2; ++sp) {
                        const bf16x8 a = (MODE == 1) ? vf[d][kb][sp] : *(const LAS bf16x8*)(lds + bo + vfrag + d * 32 * VP + (32 * kb + 16 * sp) * 2);
                        o[d] = __builtin_amdgcn_mfma_f32_32x32x16_bf16(a, pf[kb][sp], o[d], 0, 0, 0);
                    }
        }
        if (t > 0) ATT_STORE((cur ^ 1) * BUF_BYTES);
        if (MODE == 0) { if (lane == 0) flags[(it & 1) * 8 + wid] = wdone ? 1 : 0; }
        __syncthreads();
        if (t == 0) break;
        if (MODE == 0) { int alld = 1;
#pragma unroll
            for (int w2 = 0; w2 < 8; ++w2) alld &= flags[(it & 1) * 8 + w2];
            if (alld) break; }
        cur ^= 1;
    }
#undef ATT_LOAD
#undef ATT_STORE
    const int erow = lane >> 4, ech = lane & 15;
    const size_t tok0 = tokbase + q0w;
    if (MODE == 0 || role == 0) {
    }
    u32x4 gw[8];
    if (MODE == 0 || role == 0) {
        const bf16_t* gp = PROJ + (tok0 + erow) * NPROJ + (MODE == 0 ? PG_SB : PG_DF) + hh * 128 + ech * 8;
#pragma unroll
        for (int i = 0; i < 8; ++i) gw[i] = *(const u32x4*)(gp + (size_t)(4 * i) * NPROJ);
    }
    LAS unsigned char* stg = lds + (MODE == 0 ? wid * 8704 : 69632 + qg * 8704);
    if (MODE == 0) {
#pragma unroll
        for (int d = 0; d < 4; ++d)
#pragma unroll
            for (int g = 0; g < 4; ++g) { u32x2 w; w.x = cvt_pk(o[d][4 * g], o[d][4 * g + 1]); w.y = cvt_pk(o[d][4 * g + 2], o[d][4 * g + 3]);
                *(LAS u32x2*)(stg + r * 272 + (32 * d + 8 * g + 4 * h) * 2) = w; }
    } else {
        const float lt = l_run + __shfl_xor(l_run, 32);
        const float inv = 1.f / lt;
        LAS float* xq = (LAS float*)lds + (qg * 32 + r) * XP + 4 * h;
        if (role == 1) {
            const float f = inv * lam;
#pragma unroll
            for (int d = 0; d < 4; ++d)
#pragma unroll
                for (int g = 0; g < 4; ++g) *(LAS f32x4*)(xq + 32 * d + 8 * g) = (f32x4){o[d][4 * g] * f, o[d][4 * g + 1] * f, o[d][4 * g + 2] * f, o[d][4 * g + 3] * f};
        }
        __syncthreads();
        if (role == 0) {
            float q = 0.f;
#pragma unroll
            for (int d = 0; d < 4; ++d)
#pragma unroll
                for (int g = 0; g < 4; ++g) { const f32x4 x2 = *(const LAS f32x4*)(xq + 32 * d + 8 * g);
#pragma unroll
                    for (int j = 0; j < 4; ++j) { const float v = o[d][4 * g + j] * inv - x2[j]; o[d][4 * g + j] = v; q += v * v; } }
            q += __shfl_xor(q, 32);
            const float rs = rsqrtf(q * (1.f / 128.f) + SUBLN_EPS) * (1.f - LAMBDA_INIT);
            const float* sg = subln_g + 4 * h;
#pragma unroll
            for (int d = 0; d < 4; ++d)
#pragma unroll
                for (int g = 0; g < 4; ++g) { const f32x4 sv = *(const f32x4*)(sg + 32 * d + 8 * g);
                    u32x2 w; w.x = cvt_pk(o[d][4 * g] * rs * sv[0], o[d][4 * g + 1] * rs * sv[1]); w.y = cvt_pk(o[d][4 * g + 2] * rs * sv[2], o[d][4 * g + 3] * rs * sv[3]);
                    *(LAS u32x2*)(stg + r * 272 + (32 * d + 8 * g + 4 * h) * 2) = w; }
        }
    }
    if (MODE == 0 || role == 0) {
        asm volatile("s_waitcnt lgkmcnt(0)" ::: "memory");
        bf16_t* op = MIXED + (tok0 + erow) * DM + (MODE == 0 ? 0 : 1024) + hh * 128 + ech * 8;
#pragma unroll
        for (int i = 0; i < 8; ++i) { const u32x4 ov = *(const LAS u32x4*)(stg + (4 * i + erow) * 272 + ech * 16); const u32x4 g4 = gw[i];
            u32x4 w; w.x = cvt_pk(bf_lo(ov.x) * bf_lo(g4.x), bf_hi(ov.x) * bf_hi(g4.x)); w.y = cvt_pk(bf_lo(ov.y) * bf_lo(g4.y), bf_hi(ov.y) * bf_hi(g4.y));
            w.z = cvt_pk(bf_lo(ov.z) * bf_lo(g4.z), bf_hi(ov.z) * bf_hi(g4.z)); w.w = cvt_pk(bf_lo(ov.w) * bf_lo(g4.w), bf_hi(ov.w) * bf_hi(g4.w));
            *(u32x4*)(op + (size_t)(4 * i) * DM) = w; }
    }
}

__device__ __forceinline__ void attn_unit_df(LAS unsigned char* lds, const bf16_t* __restrict__ PROJ, const bf16_t* __restrict__ KIMG, const bf16_t* __restrict__ VT, bf16_t* __restrict__ MIXED,
                                             int b, int hh, int qblk, float lam, const float* __restrict__ subln_g) {
    constexpr int VB0 = 2 * KT_BYTES;
    const int tid = opaque_tid(), lane = tid & 63, r = lane & 31, h = lane >> 5;
    const int wid = __builtin_amdgcn_readfirstlane(tid >> 6);
    const int qg = wid & 3, role = wid >> 2;
    const int Q0 = qblk * 128, q0w = Q0 + 32 * qg, tq = q0w + r;
    const size_t tokbase = (size_t)b * SEQ;
    const int gbh = (8 + b) * 8 + hh;
    const bf16_t* Kg = KIMG + (size_t)gbh * SEQ * 128;
    const bf16_t* Vg = VT + (size_t)gbh * 32 * 8192;
    bf16x8 qf[4];
    { const bf16_t* qp = PROJ + (tokbase + tq) * NPROJ + PQ_DF + hh * 128 + role * 64 + 8 * h;
#pragma unroll
      for (int ks = 0; ks < 4; ++ks) qf[ks] = *(const bf16x8*)(qp + 16 * ks); }
    f32x16 o[4];
#pragma unroll
    for (int d = 0; d < 4; ++d)
#pragma unroll
        for (int i = 0; i < 16; ++i) o[d][i] = 0.f;
    float m_run = -1e30f, l_run = 0.f, alpha = 1.f;
    const int kr0 = tid >> 4, kc = tid & 15, vr0 = tid >> 3, vc = tid & 7;
    const int kst = kr0 * KP + kc * 16, vst = vr0 * VP + vc * 16;
    const bf16_t* kgl = Kg + tid * 8;
    const bf16_t* vgl = Vg + tid * 8;
    u32x4 kreg[2], vreg[2];
#define DF_LOAD(t) do { _Pragma("unroll") for (int i_ = 0; i_ < 2; ++i_) { \
        kreg[i_] = *(const u32x4*)(kgl + (size_t)(t) * 8192 + i_ * 4096); \
        vreg[i_] = *(const u32x4*)(vgl + (size_t)(t) * 8192 + i_ * 4096); } } while (0)
#define DF_STORE(ko, vo) do { _Pragma("unroll") for (int i_ = 0; i_ < 2; ++i_) { \
        *(LAS u32x4*)(lds + (ko) + kst + i_ * 32 * KP) = kreg[i_]; \
        *(LAS u32x4*)(lds + (vo) + vst + i_ * 64 * VP) = vreg[i_]; } } while (0)
#define DF_VLOAD(vo) do { _Pragma("unroll") for (int d_ = 0; d_ < 4; ++d_) _Pragma("unroll") for (int kb_ = 0; kb_ < 2; ++kb_) _Pragma("unroll") for (int sp_ = 0; sp_ < 2; ++sp_) \
        vf[d_][kb_][sp_] = *(const LAS bf16x8*)(lds + (vo) + vfrag + d_ * 32 * VP + (32 * kb_ + 16 * sp_) * 2); } while (0)
#define DF_PV() do { _Pragma("unroll") for (int d_ = 0; d_ < 4; ++d_) _Pragma("unroll") for (int kb_ = 0; kb_ < 2; ++kb_) _Pragma("unroll") for (int sp_ = 0; sp_ < 2; ++sp_) \
        o[d_] = __builtin_amdgcn_mfma_f32_32x32x16_bf16(vf[d_][kb_][sp_], pf[kb_][sp_], o[d_], 0, 0, 0); } while (0)
#define DF_RESCALE() do { if (!__all(alpha == 1.f)) { _Pragma("unroll") for (int d_ = 0; d_ < 4; ++d_) _Pragma("unroll") for (int i_ = 0; i_ < 16; ++i_) o[d_][i_] *= alpha; } } while (0)
    const int tl = (Q0 + 127) >> 6, NT = tl + 1;
    const int kfrag = r * KP + (role * 64 + 8 * h) * 2;
    const int vfrag = r * VP + (8 * h) * 2;
    __syncthreads();
    DF_LOAD(tl); DF_STORE(0, VB0);
    __syncthreads();
    bool have_p = false;
    bf16x8 pf[2][2];
    for (int i = 0; i < NT; ++i) {
        const int t = tl - i, k0 = 64 * t;
        if (t > 0) DF_LOAD(t - 1);
        if (k0 <= q0w + 31) {
            const int ko = (i & 1) * KT_BYTES;
            bf16x8 kf[2][4];
#pragma unroll
            for (int kb = 0; kb < 2; ++kb)
#pragma unroll
                for (int ks = 0; ks < 4; ++ks) kf[kb][ks] = *(const LAS bf16x8*)(lds + ko + kfrag + kb * 32 * KP + ks * 32);
            f32x16 s[2];
#pragma unroll
            for (int kb = 0; kb < 2; ++kb) {
#pragma unroll
                for (int j = 0; j < 16; ++j) s[kb][j] = 0.f;
#pragma unroll
                for (int ks = 0; ks < 4; ++ks) s[kb] = __builtin_amdgcn_mfma_f32_32x32x16_bf16(kf[kb][ks], qf[ks], s[kb], 0, 0, 0);
            }
            if (!have_p) {
                float mx = -1e30f;
#pragma unroll
                for (int kb = 0; kb < 2; ++kb) { const int kbase = k0 + 32 * kb + 4 * h;
#pragma unroll
                    for (int j = 0; j < 16; ++j) { const int key = kbase + 8 * (j >> 2) + (j & 3); const float v = (key <= tq) ? s[kb][j] : -1e30f; s[kb][j] = v; mx = fmaxf(mx, v); } }
                mx = fmaxf(mx, __shfl_xor(mx, 32));
                m_run = mx; alpha = 1.f;
                float ls = 0.f;
#pragma unroll
                for (int kb = 0; kb < 2; ++kb) {
#pragma unroll
                    for (int j = 0; j < 16; ++j) { const float p = fast_exp2(s[kb][j] - mx); s[kb][j] = p; ls += p; }
#pragma unroll
                    for (int sp = 0; sp < 2; ++sp) { u32x4 p; p.x = cvt_pk(s[kb][8 * sp], s[kb][8 * sp + 1]); p.y = cvt_pk(s[kb][8 * sp + 2], s[kb][8 * sp + 3]); p.z = cvt_pk(s[kb][8 * sp + 4], s[kb][8 * sp + 5]); p.w = cvt_pk(s[kb][8 * sp + 6], s[kb][8 * sp + 7]);
                        pf[kb][sp] = __builtin_bit_cast(bf16x8, p); }
                }
                l_run = ls;
                have_p = true;
            } else {
                DF_RESCALE();
                const int vo = VB0 + ((i + 2) % 3) * VT_BYTES;
                bf16x8 vf[2][2][2];
                bf16x8 pn[2][2]; u32x4 pw[2][2];
                float mx = -1e30f, ls = 0.f, m_new = 0.f;
#define DF_VL(g) do { _Pragma("unroll") for (int kb_ = 0; kb_ < 2; ++kb_) _Pragma("unroll") for (int sp_ = 0; sp_ < 2; ++sp_) \
        vf[(g) & 1][kb_][sp_] = *(const LAS bf16x8*)(lds + vo + vfrag + (g) * 32 * VP + (32 * kb_ + 16 * sp_) * 2); } while (0)
#define DF_MF(k) o[(k) >> 2] = __builtin_amdgcn_mfma_f32_32x32x16_bf16(vf[((k) >> 2) & 1][((k) >> 1) & 1][(k) & 1], pf[((k) >> 1) & 1][(k) & 1], o[(k) >> 2], 0, 0, 0)
#define DF_S(e) s[(e) >> 4][(e) & 15]
                DF_VL(0); DF_VL(1);
                __builtin_amdgcn_sched_barrier(0);
                DF_MF(0);
                mx = fmaxf(fmaxf(mx, DF_S(0)), DF_S(1));
                mx = fmaxf(fmaxf(mx, DF_S(2)), DF_S(3));
                mx = fmaxf(fmaxf(mx, DF_S(4)), DF_S(5));
                mx = fmaxf(fmaxf(mx, DF_S(6)), DF_S(7));
                __builtin_amdgcn_sched_barrier(0);
                DF_MF(1);
                mx = fmaxf(fmaxf(mx, DF_S(8)), DF_S(9));
                mx = fmaxf(fmaxf(mx, DF_S(10)), DF_S(11));
                mx = fmaxf(fmaxf(mx, DF_S(12)), DF_S(13));
                mx = fmaxf(fmaxf(mx, DF_S(14)), DF_S(15));
                __builtin_amdgcn_sched_barrier(0);
                DF_MF(2);
                mx = fmaxf(fmaxf(mx, DF_S(16)), DF_S(17));
                mx = fmaxf(fmaxf(mx, DF_S(18)), DF_S(19));
                mx = fmaxf(fmaxf(mx, DF_S(20)), DF_S(21));
                mx = fmaxf(fmaxf(mx, DF_S(22)), DF_S(23));
                __builtin_amdgcn_sched_barrier(0);
                DF_MF(3);
                mx = fmaxf(fmaxf(mx, DF_S(24)), DF_S(25));
                mx = fmaxf(fmaxf(mx, DF_S(26)), DF_S(27));
                mx = fmaxf(fmaxf(mx, DF_S(28)), DF_S(29));
                mx = fmaxf(fmaxf(mx, DF_S(30)), DF_S(31));
                { auto rr = __builtin_amdgcn_permlane32_swap(__float_as_uint(mx), __float_as_uint(mx), false, false); mx = fmaxf(__uint_as_float(rr[0]), __uint_as_float(rr[1])); }
                m_new = fmaxf(m_run, mx); alpha = fast_exp2(m_run - m_new); m_run = m_new;
                __builtin_amdgcn_sched_barrier(0);
                DF_VL(2);
                DF_MF(4);
                { const float p = fast_exp2(DF_S(0) - m_new); DF_S(0) = p; ls += p; }
                { const float p = fast_exp2(DF_S(1) - m_new); DF_S(1) = p; ls += p; }
                pw[0][0][0] = cvt_pk(DF_S(0), DF_S(1));
                { const float p = fast_exp2(DF_S(2) - m_new); DF_S(2) = p; ls += p; }
                __builtin_amdgcn_sched_barrier(0);
                DF_MF(5);
                { const float p = fast_exp2(DF_S(3) - m_new); DF_S(3) = p; ls += p; }
                pw[0][0][1] = cvt_pk(DF_S(2), DF_S(3));
                { const float p = fast_exp2(DF_S(4) - m_new); DF_S(4) = p; ls += p; }
                { const float p = fast_exp2(DF_S(5) - m_new); DF_S(5) = p; ls += p; }
                pw[0][0][2] = cvt_pk(DF_S(4), DF_S(5));
                __builtin_amdgcn_sched_barrier(0);
                DF_MF(6);
                { const float p = fast_exp2(DF_S(6) - m_new); DF_S(6) = p; ls += p; }
                { const float p = fast_exp2(DF_S(7) - m_new); DF_S(7) = p; ls += p; }
                pw[0][0][3] = cvt_pk(DF_S(6), DF_S(7));
                { const float p = fast_exp2(DF_S(8) - m_new); DF_S(8) = p; ls += p; }
                __builtin_amdgcn_sched_barrier(0);
                DF_MF(7);
                { const float p = fast_exp2(DF_S(9) - m_new); DF_S(9) = p; ls += p; }
                pw[0][1][0] = cvt_pk(DF_S(8), DF_S(9));
                { const float p = fast_exp2(DF_S(10) - m_new); DF_S(10) = p; ls += p; }
                { const float p = fast_exp2(DF_S(11) - m_new); DF_S(11) = p; ls += p; }
                pw[0][1][1] = cvt_pk(DF_S(10), DF_S(11));
                __builtin_amdgcn_sched_barrier(0);
                DF_VL(3);
                DF_MF(8);
                { const float p = fast_exp2(DF_S(12) - m_new); DF_S(12) = p; ls += p; }
                { const float p = fast_exp2(DF_S(13) - m_new); DF_S(13) = p; ls += p; }
                pw[0][1][2] = cvt_pk(DF_S(12), DF_S(13));
                { const float p = fast_exp2(DF_S(14) - m_new); DF_S(14) = p; ls += p; }
                __builtin_amdgcn_sched_barrier(0);
                DF_MF(9);
                { const float p = fast_exp2(DF_S(15) - m_new); DF_S(15) = p; ls += p; }
                pw[0][1][3] = cvt_pk(DF_S(14), DF_S(15));
                { const float p = fast_exp2(DF_S(16) - m_new); DF_S(16) = p; ls += p; }
                { const float p = fast_exp2(DF_S(17) - m_new); DF_S(17) = p; ls += p; }
                pw[1][0][0] = cvt_pk(DF_S(16), DF_S(17));
                __builtin_amdgcn_sched_barrier(0);
                DF_MF(10);
                { const float p = fast_exp2(DF_S(18) - m_new); DF_S(18) = p; ls += p; }
                { const float p = fast_exp2(DF_S(19) - m_new); DF_S(19) = p; ls += p; }
                pw[1][0][1] = cvt_pk(DF_S(18), DF_S(19));
                { const float p = fast_exp2(DF_S(20) - m_new); DF_S(20) = p; ls += p; }
                __builtin_amdgcn_sched_barrier(0);
                DF_MF(11);
                { const float p = fast_exp2(DF_S(21) - m_new); DF_S(21) = p; ls += p; }
                pw[1][0][2] = cvt_pk(DF_S(20), DF_S(21));
                { const float p = fast_exp2(DF_S(22) - m_new); DF_S(22) = p; ls += p; }
                { const float p = fast_exp2(DF_S(23) - m_new); DF_S(23) = p; ls += p; }
                pw[1][0][3] = cvt_pk(DF_S(22), DF_S(23));
                __builtin_amdgcn_sched_barrier(0);
                DF_MF(12);
                { const float p = fast_exp2(DF_S(24) - m_new); DF_S(24) = p; ls += p; }
                { const float p = fast_exp2(DF_S(25) - m_new); DF_S(25) = p; ls += p; }
                pw[1][1][0] = cvt_pk(DF_S(24), DF_S(25));
                __builtin_amdgcn_sched_barrier(0);
                DF_MF(13);
                { const float p = fast_exp2(DF_S(26) - m_new); DF_S(26) = p; ls += p; }
                { const float p = fast_exp2(DF_S(27) - m_new); DF_S(27) = p; ls += p; }
                pw[1][1][1] = cvt_pk(DF_S(26), DF_S(27));
                __builtin_amdgcn_sched_barrier(0);
                DF_MF(14);
                { const float p = fast_exp2(DF_S(28) - m_new); DF_S(28) = p; ls += p; }
                { const float p = fast_exp2(DF_S(29) - m_new); DF_S(29) = p; ls += p; }
                pw[1][1][2] = cvt_pk(DF_S(28), DF_S(29));
                __builtin_amdgcn_sched_barrier(0);
                DF_MF(15);
                { const float p = fast_exp2(DF_S(30) - m_new); DF_S(30) = p; ls += p; }
                { const float p = fast_exp2(DF_S(31) - m_new); DF_S(31) = p; ls += p; }
                pw[1][1][3] = cvt_pk(DF_S(30), DF_S(31));
                __builtin_amdgcn_sched_barrier(0);
                l_run = l_run * alpha + ls;
#pragma unroll
                for (int kb = 0; kb < 2; ++kb)
#pragma unroll
                    for (int sp = 0; sp < 2; ++sp) pf[kb][sp] = __builtin_bit_cast(bf16x8, pw[kb][sp]);
#undef DF_VL
#undef DF_MF
#undef DF_S
            }
        }
        if (t > 0) DF_STORE(((i + 1) & 1) * KT_BYTES, VB0 + ((i + 1) % 3) * VT_BYTES);
        __syncthreads();
    }
    if (have_p) {
        DF_RESCALE();
        bf16x8 vf[4][2][2];
        DF_VLOAD(VB0 + ((NT - 1) % 3) * VT_BYTES);
        DF_PV();
    }
    __syncthreads();
#undef DF_LOAD
#undef DF_STORE
#undef DF_VLOAD
#undef DF_PV
#undef DF_RESCALE
    const int erow = lane >> 4, ech = lane & 15;
    const size_t tok0 = tokbase + q0w;
    u32x4 gw[8];
    if (role == 0) {
        const bf16_t* gp = PROJ + (tok0 + erow) * NPROJ + PG_DF + hh * 128 + ech * 8;
#pragma unroll
        for (int i = 0; i < 8; ++i) gw[i] = *(const u32x4*)(gp + (size_t)(4 * i) * NPROJ);
    }
    LAS unsigned char* stg = lds + 69632 + qg * 8704;
    {
        const float lt = l_run + __shfl_xor(l_run, 32);
        const float inv = 1.f / lt;
        LAS float* xq = (LAS float*)lds + (qg * 32 + r) * XP + 4 * h;
        if (role == 1) {
            const float f = inv * lam;
#pragma unroll
            for (int d = 0; d < 4; ++d)
#pragma unroll
                for (int g = 0; g < 4; ++g) *(LAS f32x4*)(xq + 32 * d + 8 * g) = (f32x4){o[d][4 * g] * f, o[d][4 * g + 1] * f, o[d][4 * g + 2] * f, o[d][4 * g + 3] * f};
        }
        __syncthreads();
        if (role == 0) {
            float q = 0.f;
#pragma unroll
            for (int d = 0; d < 4; ++d)
#pragma unroll
                for (int g = 0; g < 4; ++g) { const f32x4 x2 = *(const LAS f32x4*)(xq + 32 * d + 8 * g);
#pragma unroll
                    for (int j = 0; j < 4; ++j) { const float v = o[d][4 * g + j] * inv - x2[j]; o[d][4 * g + j] = v; q += v * v; } }
            q += __shfl_xor(q, 32);
            const float rs = rsqrtf(q * (1.f / 128.f) + SUBLN_EPS) * (1.f - LAMBDA_INIT);
            const float* sg = subln_g + 4 * h;
#pragma unroll
            for (int d = 0; d < 4; ++d)
#pragma unroll
                for (int g = 0; g < 4; ++g) { const f32x4 sv = *(const f32x4*)(sg + 32 * d + 8 * g);
                    u32x2 w; w.x = cvt_pk(o[d][4 * g] * rs * sv[0], o[d][4 * g + 1] * rs * sv[1]); w.y = cvt_pk(o[d][4 * g + 2] * rs * sv[2], o[d][4 * g + 3] * rs * sv[3]);
                    *(LAS u32x2*)(stg + r * 272 + (32 * d + 8 * g + 4 * h) * 2) = w; }
            asm volatile("s_waitcnt lgkmcnt(0)" ::: "memory");
            bf16_t* op = MIXED + (tok0 + erow) * DM + 1024 + hh * 128 + ech * 8;
#pragma unroll
            for (int i = 0; i < 8; ++i) { const u32x4 ov = *(const LAS u32x4*)(stg + (4 * i + erow) * 272 + ech * 16); const u32x4 g4 = gw[i];
                u32x4 w; w.x = cvt_pk(bf_lo(ov.x) * bf_lo(g4.x), bf_hi(ov.x) * bf_hi(g4.x)); w.y = cvt_pk(bf_lo(ov.y) * bf_lo(g4.y), bf_hi(ov.y) * bf_hi(g4.y));
                w.z = cvt_pk(bf_lo(ov.z) * bf_lo(g4.z), bf_hi(ov.z) * bf_hi(g4.z)); w.w = cvt_pk(bf_lo(ov.w) * bf_lo(g4.w), bf_hi(ov.w) * bf_hi(g4.w));
                *(u32x4*)(op + (size_t)(4 * i) * DM) = w; }
        }
    }
}
}
#define XB_TMO      128
#define XB_XCNT(j)  (256  + 64 * (j))
#define XB_XSUB(j)  (1280 + 64 * (j))
#define XB_XGEN(j)  (2304 + 64 * (j))
#define XB_TOP      3328
#define XB_TOPGEN   3392
#define XCD_BAR_WORDS 3456
#define XB_SPIN_CAP (1u << 18)

__device__ __forceinline__ unsigned xb_ld(unsigned* p)              { return __hip_atomic_load(p, __ATOMIC_RELAXED, __HIP_MEMORY_SCOPE_AGENT); }
__device__ __forceinline__ unsigned xb_add(unsigned* p, unsigned v) { return __hip_atomic_fetch_add(p, v, __ATOMIC_RELAXED, __HIP_MEMORY_SCOPE_AGENT); }
__device__ __forceinline__ unsigned xb_xcc_id() { return (unsigned)__builtin_amdgcn_s_getreg((3 << 11) | 20) & 0xFu; }
#define XB_SPIN(cond, bar) do { unsigned _sp = 0; while (cond) { __builtin_amdgcn_s_sleep(1); \
    if ((++_sp & 255u) == 0u) { if (xb_ld(&(bar)[XB_TMO])) break; if (_sp > XB_SPIN_CAP) { atomicAdd(&(bar)[XB_TMO], 1u); break; } } } } while (0)

struct XcdBarrier {
    unsigned* bar; unsigned x;
    volatile LAS unsigned* st;
};

__device__ __forceinline__ XcdBarrier xcd_barrier_post(unsigned* bar, volatile LAS unsigned* st) {
    XcdBarrier b; b.bar = bar; b.x = xb_xcc_id(); b.st = st;
    if (threadIdx.x == 0) (void)xb_add(&bar[XB_XCNT(b.x)], 1u);
    return b;
}
__device__ __forceinline__ void xcd_barrier_complete(unsigned* bar, unsigned x, unsigned& nloc, unsigned& nx) {
    const unsigned G = gridDim.x * gridDim.y * gridDim.z;
    unsigned sum, cnt, mine, sp = 0u;
    for (;;) {
        sum = 0u; cnt = 0u; mine = 0u;
#pragma unroll
        for (unsigned j = 0; j < 16; ++j) { const unsigned c = xb_ld(&bar[XB_XCNT(j)]); sum += c; cnt += (c > 0u) ? 1u : 0u; mine = (j == x) ? c : mine; }
        if (sum == G) break;
        __builtin_amdgcn_s_sleep(1);
        if ((++sp & 255u) == 0u) { if (xb_ld(&bar[XB_TMO])) break; if (sp > XB_SPIN_CAP) { atomicAdd(&bar[XB_TMO], 1u); break; } }
    }
    nloc = mine > 0u ? mine : 1u; nx = cnt > 0u ? cnt : 1u;
}

__device__ __forceinline__ void xcd_barrier(const XcdBarrier& b) {
    asm volatile("s_waitcnt vmcnt(0)" ::: "memory");
    __syncthreads();
    if (threadIdx.x == 0) {
        unsigned* bar = b.bar;
        __builtin_amdgcn_s_waitcnt(0);
        unsigned nloc = b.st[0], nx = b.st[1];
        if (nloc == 0u) { xcd_barrier_complete(bar, b.x, nloc, nx); b.st[0] = nloc; b.st[1] = nx; }
        const unsigned old = xb_add(&bar[XB_XSUB(b.x)], 1u);
        const unsigned gen = old / nloc;
        if (old + 1u == (gen + 1u) * nloc) {
            __builtin_amdgcn_fence(__ATOMIC_RELEASE, "agent");
            asm volatile("s_waitcnt vmcnt(0)" ::: "memory");
            const unsigned og = xb_add(&bar[XB_TOP], 1u);
            const unsigned tg = og / nx;
            if (og + 1u == (tg + 1u) * nx) xb_add(&bar[XB_TOPGEN], 1u);
            else XB_SPIN(xb_ld(&bar[XB_TOPGEN]) == tg, bar);
            __builtin_amdgcn_fence(__ATOMIC_ACQUIRE, "agent");
            xb_add(&bar[XB_XGEN(b.x)], 1u);
            asm volatile("s_waitcnt vmcnt(0)" ::: "memory");
        } else {
            XB_SPIN(xb_ld(&bar[XB_XGEN(b.x)]) == gen, bar);
            __builtin_amdgcn_fence(__ATOMIC_ACQUIRE, "agent");
            asm volatile("s_waitcnt vmcnt(0)" ::: "memory");
        }
    }
    __syncthreads();
}

__device__ __forceinline__ int win_dst_row(int c) {
    const int seg = c >> 10, w = c & 1023, d6 = w & 63;
    const int wp = d6 < 16 ? (w & ~63) + (d6 < 8 ? 2 * d6 : 2 * (d6 - 8) + 1) : w;
    switch (seg) { case 0: return w; case 1: return 1024 + w; case 2: return 6144 + w; case 3: return 2048 + w;
                   case 4: return 3072 + wp; case 5: return 4096 + wp; case 6: return 7168 + w; default: return 5120 + w; }
}
struct TItem { const float* W; bf16_t* WT; const float* ks; int K, N, win, item; };
__device__ __forceinline__ void tr_load(const TItem& t, float (&v)[32], int lane) {
    const int nblk = t.N / 32, kb = t.item / nblk, nb = t.item % nblk; const float* p = t.W + (size_t)(64 * kb + (lane >> 5)) * t.N + 32 * nb + (lane & 31);
#pragma unroll
    for (int i = 0; i < 32; ++i) v[i] = __builtin_nontemporal_load(&p[(size_t)(2 * i) * t.N]);
}
__device__ __forceinline__ void tr_write(const float (&v)[32], LAS float* scr, int lane) {
#pragma unroll
    for (int i = 0; i < 32; ++i) scr[(2 * i + (lane >> 5)) * 33 + (lane & 31)] = v[i];
}
__device__ __forceinline__ void tr_store(const TItem& t, LAS float* scr, int lane) {
    const int nblk = t.N / 32, kb = t.item / nblk, nb = t.item % nblk, k0 = 64 * kb, n0 = 32 * nb, c = lane & 7;
    f32x4 s0 = {1.f, 1.f, 1.f, 1.f}, s1 = {1.f, 1.f, 1.f, 1.f};
    if (t.ks) { s0 = *(const f32x4*)(t.ks + k0 + 8 * c); s1 = *(const f32x4*)(t.ks + k0 + 8 * c + 4); }
#pragma unroll
    for (int j = 0; j < 4; ++j) { const int n = (lane >> 3) + 8 * j; const LAS float* s = scr + (8 * c) * 33 + n;
        u32x4 o; o.x = cvt_pk(s[0 * 33] * s0[0], s[1 * 33] * s0[1]); o.y = cvt_pk(s[2 * 33] * s0[2], s[3 * 33] * s0[3]); o.z = cvt_pk(s[4 * 33] * s1[0], s[5 * 33] * s1[1]); o.w = cvt_pk(s[6 * 33] * s1[2], s[7 * 33] * s1[3]);
        const int dn = t.win ? win_dst_row(n0 + n) : (n0 + n);
        *(u32x4*)(t.WT + (size_t)dn * t.K + k0 + 8 * c) = o; }
}
__device__ __forceinline__ void rms_load(const float* __restrict__ xrow, f32x4 (&v)[8], int lane) {
    const f32x4* xr = (const f32x4*)xrow + lane;
#pragma unroll
    for (int j = 0; j < 8; ++j) v[j] = __builtin_nontemporal_load(&xr[64 * j]);
}
__device__ __forceinline__ void rms_finish(const f32x4 (&v)[8], const f32x4 (&gv)[8], bf16_t* __restrict__ orow, int lane) {
    float s = 0.f;
#pragma unroll
    for (int j = 0; j < 8; ++j) s += (v[j][0] * v[j][0] + v[j][1] * v[j][1]) + (v[j][2] * v[j][2] + v[j][3] * v[j][3]);
    const float rstd = rsqrtf(wave_sum(s) * (1.f / DM) + NORM_EPS);
    u32x2* o8 = (u32x2*)orow + lane;
#pragma unroll
    for (int j = 0; j < 8; ++j) { u32x2 w; w.x = cvt_pk(v[j][0] * rstd * gv[j][0], v[j][1] * rstd * gv[j][1]); w.y = cvt_pk(v[j][2] * rstd * gv[j][2], v[j][3] * rstd * gv[j][3]); o8[64 * j] = w; }
}

struct Args { const float* in[14]; float* out; unsigned char* ws; };

__global__ void __launch_bounds__(512, 2) fwd_megakernel(Args a) {
    extern __shared__ __attribute__((aligned(16))) unsigned char lds_raw[];
    LAS unsigned char* lds = (LAS unsigned char*)lds_raw;
    { cg::grid_group grid = cg::this_grid(); if (a.ws == nullptr) grid.sync(); }
    const int tid = threadIdx.x, lane = tid & 63, wave = __builtin_amdgcn_readfirstlane(tid >> 6);
    const int G = gridDim.x, bx = blockIdx.x;
    const int vcu = (G % 8 == 0) ? (bx % 8) * (G / 8) + bx / 8 : bx;
    unsigned char* ws = a.ws;
    float* ss2 = (float*)(ws + WS_CTL + CTL_SS2); float* ss3 = (float*)(ws + WS_CTL + CTL_SS3); float* lamp = (float*)(ws + WS_CTL + CTL_LAM); float* rope = (float*)(ws + WS_CTL + CTL_ROPE);
    bf16_t* WIN = (bf16_t*)(ws + WS_WIN); bf16_t* WOUT = (bf16_t*)(ws + WS_WOUT); bf16_t* WGATE = (bf16_t*)(ws + WS_WGATE); bf16_t* WPROJ = (bf16_t*)(ws + WS_WPROJ);
    bf16_t* PB = (bf16_t*)(ws + WS_PB); bf16_t* XN = (bf16_t*)(ws + WS_XN); bf16_t* MIXED = (bf16_t*)(ws + WS_MIXED); bf16_t* PROJ = (bf16_t*)(ws + WS_PROJ);
    bf16_t* VT = (bf16_t*)(ws + WS_VT); bf16_t* KIMG = (bf16_t*)(ws + WS_KIMG); bf16_t* HB = (bf16_t*)(ws + WS_HB); bf16_t* PLEB = (bf16_t*)(ws + WS_PLE); bf16_t* H2B = (bf16_t*)(ws + WS_H2B);
    const float* x = a.in[0]; float* out = a.out;
    volatile LAS unsigned* xst = (volatile LAS unsigned*)(lds + 131072);
    if (tid == 0) { xst[0] = 0u; xst[1] = 0u; }
    __syncthreads();
    const XcdBarrier xb = xcd_barrier_post((unsigned*)(ws + WS_CTL + CTL_BAR), xst);

    for (int rep_ = 0; rep_ < ((PROBE_DUP & 1) ? 2 : 1); ++rep_) {
        if (rep_) __syncthreads();
        const int gw = bx * 8 + wave, NGW = G * 8; const int gt = bx * 512 + tid, NGT = G * 512;
        for (int i = gt; i < 2 * NTOK; i += NGT) ss2[i] = 0.f;
        if (gt == 0) { float s1 = 0.f, s2 = 0.f; for (int i = 0; i < 64; ++i) { s1 += a.in[4][i] * a.in[5][i]; s2 += a.in[6][i] * a.in[7][i]; } lamp[0] = expf(s1) - expf(s2) + LAMBDA_INIT; }
        for (int i = gt; i < SEQ * 8; i += NGT) { const int pos = i >> 3, f = i & 7;
            const float invf = (float)exp2(-(double)f * 0.125 * 18.931568569324174);
            const float angf = (float)pos * invf;
            const double tw = 6.283185307179586476925; double ang = (double)angf; ang -= tw * rint(ang / tw);
            rope[2 * i] = (float)cos(ang); rope[2 * i + 1] = (float)sin(ang); }
        LAS float* scr = (LAS float*)(lds + wave * 16384);
        constexpr int I_IN = (DM / 64) * (8192 / 32), I_SQ = (DM / 64) * (DM / 32), I_PR = (PLE / 64) * (DM / 32), I_ALL = I_IN + 2 * I_SQ + I_PR;
#define P0_DECODE(T, it_) do { int rr_ = (it_); \
            if (rr_ < I_IN) { T = TItem{a.in[3], WIN, nullptr, DM, 8192, 1, rr_}; } \
            else if (rr_ < I_IN + I_SQ) { T = TItem{a.in[9], WOUT, nullptr, DM, DM, 0, rr_ - I_IN}; } \
            else if (rr_ < I_IN + 2 * I_SQ) { T = TItem{a.in[11], WGATE, a.in[10], DM, DM, 0, rr_ - I_IN - I_SQ}; } \
            else { T = TItem{a.in[12], WPROJ, nullptr, PLE, DM, 0, rr_ - I_IN - 2 * I_SQ}; } } while (0)
        {
            float tv[32]; TItem cur, nxt; int it = gw;
            if (it < I_ALL) { P0_DECODE(cur, it); tr_load(cur, tv, lane); }
            while (it < I_ALL) {
                tr_write(tv, scr, lane);
                const int itn = it + NGW;
                if (itn < I_ALL) { P0_DECODE(nxt, itn); tr_load(nxt, tv, lane); }
                asm volatile("s_waitcnt lgkmcnt(0)" ::: "memory");
                tr_store(cur, scr, lane);
                asm volatile("s_waitcnt lgkmcnt(0)" ::: "memory");
                cur = nxt; it = itn;
            }
        }
#undef P0_DECODE
        {
            f32x4 gv[8], va[8], vb[8];
            { const f32x4* gr = (const f32x4*)a.in[2] + lane;
#pragma unroll
              for (int j = 0; j < 8; ++j) gv[j] = gr[64 * j]; }
            int m = gw;
            if (m < NTOK) rms_load(x + (size_t)m * DM, va, lane);
            for (; m < NTOK; m += 2 * NGW) {
                const int m1 = m + NGW, m2 = m + 2 * NGW;
                if (m1 < NTOK) rms_load(x + (size_t)m1 * DM, vb, lane);
                rms_finish(va, gv, XN + (size_t)m * DM, lane);
                if (m2 < NTOK) rms_load(x + (size_t)m2 * DM, va, lane);
                if (m1 < NTOK) rms_finish(vb, gv, XN + (size_t)m1 * DM, lane);
            }
        }
        for (int i = gt; i < NTOK * PLE / 8; i += NGT) { const f32x4 v0 = __builtin_nontemporal_load(&((const f32x4*)a.in[1])[2 * i]), v1 = __builtin_nontemporal_load(&((const f32x4*)a.in[1])[2 * i + 1]);
            u32x4 w; w.x = cvt_pk(v0[0], v0[1]); w.y = cvt_pk(v0[2], v0[3]); w.z = cvt_pk(v1[0], v1[1]); w.w = cvt_pk(v1[2], v1[3]); ((u32x4*)PB)[i] = w; }
    }
    xcd_barrier(xb);
    for (int rep_ = 0; rep_ < ((PROBE_DUP & 2) ? 2 : 1); ++rep_) {
        if (rep_) __syncthreads();
        { pg8::Gemm g{XN, WIN, NTOK, NPROJ, DM}; pg8::StaticOrder S; S.init(NTOK, NPROJ, G, bx); pg8::EpiProj E{PROJ, rope, KIMG};
          pg8::gemm_phase<pg8::EpiProj, pg8::StaticOrder, true, true>(lds, g, S, E); }
        __syncthreads();
        { pg8::Gemm g{WIN + (size_t)NPROJ * DM, XN, 2048, NTOK, DM}; pg8::StaticOrder S; S.init(2048, NTOK, G, bx); pg8::EpiVt E{VT};
          pg8::gemm_phase<pg8::EpiVt, pg8::StaticOrder, true, true>(lds, g, S, E); }
    }
    xcd_barrier(xb);
    for (int rep_ = 0; rep_ < ((PROBE_DUP & 4) ? 2 : 1); ++rep_) {
        const float lam = lamp[0];
        for (int su = vcu; su < 256; su += G) {
            const int grp = su >> 4, j = su & 15;
#pragma unroll 1
            for (int k = 0; k < 4; ++k) { const int bh = 4 * grp + k; const int qb = (k & 1) ? 15 - j : j;
                att::attn_unit_df(lds, PROJ, KIMG, VT, MIXED, bh >> 3, bh & 7, qb, lam, a.in[8]); }
        }
#pragma unroll 1
        for (int u = vcu; u < 512; u += G) att::attn_unit<0>(lds, PROJ, KIMG, VT, MIXED, (u >> 3) >> 3, (u >> 3) & 7, u & 7, lam, a.in[8]);
    }
    xcd_barrier(xb);
    {
        __syncthreads();
        { pg8::Gemm g{MIXED, WOUT, NTOK, DM, DM}; pg8::StaticOrder S; S.init(NTOK, DM, G, bx); pg8::EpiRes E{x, HB, ss2};
          pg8::gemm_phase<pg8::EpiRes, pg8::StaticOrder, true, true>(lds, g, S, E); }
        __syncthreads();
        { pg8::Gemm g{PB, WPROJ, NTOK, DM, PLE}; pg8::StaticOrder S; S.init(NTOK, DM, G, bx); pg8::EpiBf16 E{PLEB, DM};
          pg8::gemm_phase<pg8::EpiBf16, pg8::StaticOrder, true, true>(lds, g, S, E); }
    }
    xcd_barrier(xb);
    {
        pg8::Gemm g{HB, WGATE, NTOK, DM, DM}; pg8::StaticOrder S; S.init(NTOK, DM, G, bx); pg8::EpiGate E{HB, H2B, PLEB, ss2, ss3};
        pg8::gemm_phase<pg8::EpiGate, pg8::StaticOrder, true, true>(lds, g, S, E);
    }
    xcd_barrier(xb);
    {
        const int tid5 = opaque_tid(), lane = tid5 & 63, wave = __builtin_amdgcn_readfirstlane(tid5 >> 6);
        const int gw = bx * 8 + wave, NGW = G * 8; const f32x4* gr = (const f32x4*)a.in[13];
        f32x4 gv[8];
#pragma unroll
        for (int j = 0; j < 4; ++j) { gv[2 * j] = gr[2 * (lane + 64 * j)]; gv[2 * j + 1] = gr[2 * (lane + 64 * j) + 1]; }
#define P5_LOAD(H, S_, m_) do { const u32x4* hrow_ = (const u32x4*)(H2B + (size_t)(m_) * DM); S_ = ss3[m_]; _Pragma("unroll") for (int j_ = 0; j_ < 4; ++j_) H[j_] = __builtin_nontemporal_load(&hrow_[lane + 64 * j_]); } while (0)
#define P5_STORE(H, S_, m_) do { const float rstd_ = rsqrtf(S_ * (1.f / DM) + NORM_EPS); f32x4* orow_ = (f32x4*)(out + (size_t)(m_) * DM); \
            _Pragma("unroll") for (int j_ = 0; j_ < 4; ++j_) { const int c_ = lane + 64 * j_; const u32x4 hw_ = H[j_]; const f32x4 g0_ = gv[2 * j_], g1_ = gv[2 * j_ + 1]; \
                orow_[2 * c_] = (f32x4){bf_lo(hw_.x) * rstd_ * g0_[0], bf_hi(hw_.x) * rstd_ * g0_[1], bf_lo(hw_.y) * rstd_ * g0_[2], bf_hi(hw_.y) * rstd_ * g0_[3]}; \
                orow_[2 * c_ + 1] = (f32x4){bf_lo(hw_.z) * rstd_ * g1_[0], bf_hi(hw_.z) * rstd_ * g1_[1], bf_lo(hw_.w) * rstd_ * g1_[2], bf_hi(hw_.w) * rstd_ * g1_[3]}; } } while (0)
        u32x4 ha[4], hb4[4]; float sa = 0.f, sb = 0.f;
        int m = gw;
        if (m < NTOK) P5_LOAD(ha, sa, m);
        for (; m < NTOK; m += 2 * NGW) {
            const int m1 = m + NGW, m2 = m + 2 * NGW;
            if (m1 < NTOK) P5_LOAD(hb4, sb, m1);
            P5_STORE(ha, sa, m);
            if (m2 < NTOK) P5_LOAD(ha, sa, m2);
            if (m1 < NTOK) P5_STORE(hb4, sb, m1);
        }
#undef P5_LOAD
#undef P5_STORE
    }
}

extern "C" void kernel_launch(void* const* d_in, const int* in_sizes, int n_in, void* d_out, int out_size, void* d_ws, size_t ws_size, hipStream_t stream) {
    static int grid = 0;
    if (grid == 0) {
        if (n_in != 14 || out_size != NTOK * DM || ws_size < WS_END) { fprintf(stderr, "kernel_launch: unexpected shapes (n_in %d out %d ws %zu)\n", n_in, out_size, ws_size); grid = -1; return; }
        int dev = 0, cus = 0, per_cu = 0;
        (void)hipGetDevice(&dev); (void)hipDeviceGetAttribute(&cus, hipDeviceAttributeMultiprocessorCount, dev);
        (void)hipFuncSetAttribute((const void*)fwd_megakernel, hipFuncAttributeMaxDynamicSharedMemorySize, LDS_BYTES);
        (void)hipOccupancyMaxActiveBlocksPerMultiprocessor(&per_cu, (const void*)fwd_megakernel, 512, LDS_BYTES);
        if (per_cu < 1) { fprintf(stderr, "kernel_launch: occupancy query says %d blocks/CU\n", per_cu); per_cu = 1; }
        grid = cus * per_cu;
    }
    if (grid < 0) return;
    Args a{};
    for (int i = 0; i < 14; ++i) a.in[i] = (const float*)d_in[i];
    a.out = (float*)d_out; a.ws = (unsigned char*)d_ws;
    (void)hipMemsetAsync((unsigned char*)d_ws + WS_CTL + CTL_BAR, 0, CTL_BAR_BYTES, stream);
    void* args[] = {&a};
    hipError_t e = hipLaunchCooperativeKernel((void*)fwd_megakernel, dim3(grid), dim3(512), args, LDS_BYTES, stream);
    if (e != hipSuccess) fprintf(stderr, "cooperative launch failed: %s (grid %d)\n", hipGetErrorString(e), grid);
}
```

```cpp
#include <hip/hip_runtime.h>
#include <hip/hip_cooperative_groups.h>
#include <cstdio>
#include <cstdint>
namespace cg = cooperative_groups;
__device__ __forceinline__ int opaque_tid() { int t = (int)threadIdx.x; asm volatile("" : "+v"(t)); return t; }
#ifndef PROBE_DUP
#define PROBE_DUP 0
#endif
namespace pg8 {
#define PG8_LAS __attribute__((address_space(3)))
typedef unsigned short bf16_t;
typedef short bf16x8 __attribute__((ext_vector_type(8)));
typedef float f32x4 __attribute__((ext_vector_type(4)));
typedef unsigned u32x4 __attribute__((ext_vector_type(4)));
constexpr int BM = 256, BK = 64, HALF = 128, HTB = HALF * BK * 2  , STAGE_BYTES = 8 * HTB, NXCD = 8, WGM = 8;

__host__ __device__ __forceinline__ int lds_byte(int r, int c) { const int st = (r >> 4) * 2 + (c >> 5), rr = r & 15, cc = c & 31, ob = rr * 64 + cc * 2; return st * 1024 + (ob ^ (((ob >> 9) & 1) << 5)); }
__host__ __device__ __forceinline__ void stage_rc(int b, int& R, int& C) { const int st = b / 1024, sb = b % 1024, swz = sb ^ (((sb >> 9) & 1) << 5); R = (st >> 1) * 16 + swz / 64; C = (st & 1) * 32 + (swz % 64) / 2; }
__host__ __device__ __forceinline__ int perm32(int rho) { const int n = rho >> 4, i = rho & 15; return 8 * (i >> 2) + 4 * n + (i & 3); }

struct Unit { int pm, pn; };
struct Gemm { const bf16_t* A; const bf16_t* Bt; int M, N, K; };

struct StaticOrder {
    int nM, nN, nwg, G, c;
    __host__ __device__ void init(int M, int N, int G_, int c_) { nM = M / BM; nN = N / BM; nwg = nM * nN; G = G_; c = c_; }
    __host__ __device__ bool next(int i, Unit& u) const {
        const long L = (long)i * G + c; if (L >= nwg) return false;
        int wgid = (int)L; { const int q = nwg / NXCD, r = nwg % NXCD, xcd = wgid % NXCD, off = wgid / NXCD; wgid = (xcd < r ? xcd * (q + 1) : r * (q + 1) + (xcd - r) * q) + off; }
        const int nig = WGM * nN, gid = wgid / nig, fm = gid * WGM, gsz = (nM - fm) < WGM ? (nM - fm) : WGM;
        u.pm = fm + ((wgid % nig) % gsz); u.pn = (wgid % nig) / gsz; return true;
    }
    __device__ __forceinline__ void a_ready(const Unit&) const {}
    __device__ __forceinline__ void done(const Unit&) const {}
};

__device__ __forceinline__ unsigned cvt_pk_bf16(float lo, float hi) { unsigned r; asm volatile("v_cvt_pk_bf16_f32 %0, %1, %2" : "=v"(r) : "v"(lo), "v"(hi)); return r; }
typedef float f32x2 __attribute__((ext_vector_type(2)));
template <class Epi, class Sched, bool ALIGN_EPI = false, bool SP2 = false>
__device__ __forceinline__ void gemm_phase(PG8_LAS unsigned char* lds, const Gemm g, const Sched& S, const Epi& E) {
    const int tid = opaque_tid(), wid = __builtin_amdgcn_readfirstlane(tid >> 6), lane = tid & 63, wr = wid >> 2, wc = wid & 3, fr = lane & 15, fq = lane >> 4;
    const int K = g.K, nt = K / BK;
    unsigned voffA[2], voffB[2];
#pragma unroll
    for (int i = 0; i < 2; ++i) { int R, C; stage_rc(tid * 16 + i * 8192, R, C); const int Rb = Epi::PERM ? ((R & ~31) + perm32(R & 31)) : R;
        voffA[i] = (unsigned)(R * K + C) * 2u; voffB[i] = (unsigned)(Rb * K + C) * 2u; }
    const size_t kstep = (size_t)(BK * 2);
    const size_t hstep = (size_t)HALF * K * 2;
    const size_t tstep = 2 * hstep;
    const unsigned ldsw = (unsigned)wid * 1024u;
    const int aoff = lds_byte(wr * 64 + fr, fq * 8), boff = lds_byte(wc * 32 + fr, fq * 8);
#define PG8_SA(b, h) (((b) * 2 + (h)) * HTB)
#define PG8_SB(b, h) ((4 + (b) * 2 + (h)) * HTB)
#define PG8_STAGE(bufoff, gbase, voff) do { _Pragma("unroll") for (int _i = 0; _i < 2; ++_i) \
        __builtin_amdgcn_global_load_lds((const unsigned*)((const char*)(gbase) + (voff)[_i]), (PG8_LAS unsigned*)(lds + (bufoff) + ldsw + _i * 8192), 16, 0, 0); } while (0)
#define PG8_LDA(dst, b, h) do { _Pragma("unroll") for (int m = 0; m < 4; ++m) _Pragma("unroll") for (int k = 0; k < 2; ++k) dst[m][k] = *(const PG8_LAS bf16x8*)(lds + PG8_SA(b, h) + aoff + m * 2048 + k * 1024); } while (0)
#define PG8_LDB(dst, b, h) do { _Pragma("unroll") for (int n = 0; n < 2; ++n) _Pragma("unroll") for (int k = 0; k < 2; ++k) dst[n][k] = *(const PG8_LAS bf16x8*)(lds + PG8_SB(b, h) + boff + n * 2048 + k * 1024); } while (0)
#define PG8_MMA(ai, bj, At, Bt) do { __builtin_amdgcn_s_setprio(1); _Pragma("unroll") for (int m = 0; m < 4; ++m) _Pragma("unroll") for (int n = 0; n < 2; ++n) _Pragma("unroll") for (int k = 0; k < 2; ++k) \
        acc[ai][bj][m][n] = __builtin_amdgcn_mfma_f32_16x16x32_bf16(Bt[n][k], At[m][k], acc[ai][bj][m][n], 0, 0, 0); __builtin_amdgcn_s_setprio(0); } while (0)
#define PG8_WAIT_V(n) asm volatile("s_waitcnt vmcnt(" #n ")" ::: "memory")
#define PG8_WAIT_L(n) asm volatile("s_waitcnt lgkmcnt(" #n ")" ::: "memory")
#define PG8_BAR __builtin_amdgcn_s_barrier()
#define PG8_SCHED __builtin_amdgcn_sched_barrier(0)
    Unit cur, nxt; int ui = 0;
    if (!S.next(0, cur)) return;
    f32x4 acc[2][2][4][2];
#pragma unroll
    for (int a = 0; a < 2; ++a)
#pragma unroll
        for (int b = 0; b < 2; ++b)
#pragma unroll
            for (int m = 0; m < 4; ++m)
#pragma unroll
                for (int n = 0; n < 2; ++n) acc[a][b][m][n] = (f32x4){0.f, 0.f, 0.f, 0.f};
    bf16x8 At[4][2], B0[2][2], B1[2][2];
    const char* cA = (const char*)g.A + (size_t)cur.pm * tstep; const char* cB = (const char*)g.Bt + (size_t)cur.pn * tstep;
    S.a_ready(cur);
    if constexpr (SP2) {
        PG8_STAGE(PG8_SB(0, 0), cB, voffB); PG8_STAGE(PG8_SB(0, 1), cB + hstep, voffB); PG8_STAGE(PG8_SA(0, 0), cA, voffA); PG8_STAGE(PG8_SA(0, 1), cA + hstep, voffA);
        if (wr == 1) PG8_BAR;
        PG8_WAIT_V(2); PG8_BAR;
        PG8_STAGE(PG8_SB(1, 0), cB + kstep, voffB); PG8_STAGE(PG8_SA(1, 0), cA + kstep, voffA); PG8_STAGE(PG8_SB(1, 1), cB + hstep + kstep, voffB);
        PG8_WAIT_V(6); PG8_BAR;
    } else {
        PG8_STAGE(PG8_SB(0, 0), cB, voffB); PG8_STAGE(PG8_SA(0, 0), cA, voffA); PG8_STAGE(PG8_SB(0, 1), cB + hstep, voffB); PG8_STAGE(PG8_SA(0, 1), cA + hstep, voffA);
        if (wr == 1) PG8_BAR;
        PG8_WAIT_V(4); PG8_BAR;
        PG8_STAGE(PG8_SB(1, 0), cB + kstep, voffB); PG8_STAGE(PG8_SA(1, 0), cA + kstep, voffA); PG8_STAGE(PG8_SB(1, 1), cB + hstep + kstep, voffB);
        PG8_WAIT_V(6); PG8_BAR;
    }
    for (;;) {
        const bool has_next = S.next(ui + 1, nxt);
        const char* nA = has_next ? (const char*)g.A + (size_t)nxt.pm * tstep : cA; const char* nB = has_next ? (const char*)g.Bt + (size_t)nxt.pn * tstep : cB;
        for (int t = 0; t < nt; t += 2) {
            const bool last = (t == nt - 2);
            const char* a1 = cA + (size_t)(t + 1) * kstep;
            const char* a2 = last ? nA : cA + (size_t)(t + 2) * kstep; const char* b2 = last ? nB : cB + (size_t)(t + 2) * kstep;
            const char* a3 = a2 + kstep; const char* b3 = b2 + kstep;
            if (last && has_next) S.a_ready(nxt);
            if constexpr (SP2) {
            PG8_LDB(B0, 0, 0); PG8_LDB(B1, 0, 1); PG8_SCHED; PG8_LDA(At, 0, 0); PG8_STAGE(PG8_SA(1, 1), a1 + hstep, voffA);
            PG8_WAIT_V(8); PG8_WAIT_L(0); PG8_BAR; PG8_MMA(0, 0, At, B0); PG8_MMA(0, 1, At, B1); PG8_BAR; PG8_SCHED;
            PG8_LDA(At, 0, 1); PG8_STAGE(PG8_SB(0, 0), b2, voffB); PG8_STAGE(PG8_SB(0, 1), b2 + hstep, voffB); PG8_STAGE(PG8_SA(0, 0), a2, voffA);
            PG8_WAIT_V(8); PG8_WAIT_L(0); PG8_BAR; PG8_MMA(1, 0, At, B0); PG8_MMA(1, 1, At, B1); PG8_BAR; PG8_SCHED;
            PG8_LDB(B0, 1, 0); PG8_LDB(B1, 1, 1); PG8_SCHED; PG8_LDA(At, 1, 0); PG8_STAGE(PG8_SA(0, 1), a2 + hstep, voffA);
            PG8_WAIT_V(8); PG8_WAIT_L(0); PG8_BAR; PG8_MMA(0, 0, At, B0); PG8_MMA(0, 1, At, B1); PG8_BAR; PG8_SCHED;
            PG8_LDA(At, 1, 1); PG8_STAGE(PG8_SB(1, 0), b3, voffB); PG8_STAGE(PG8_SB(1, 1), b3 + hstep, voffB); PG8_STAGE(PG8_SA(1, 0), a3, voffA);
            PG8_WAIT_V(8); PG8_WAIT_L(0); PG8_BAR; PG8_MMA(1, 0, At, B0); PG8_MMA(1, 1, At, B1); PG8_BAR; PG8_SCHED;
            } else {
            PG8_LDB(B0, 0, 0); PG8_SCHED; PG8_LDA(At, 0, 0); PG8_STAGE(PG8_SA(1, 1), a1 + hstep, voffA);
            PG8_WAIT_L(8); PG8_BAR; PG8_WAIT_L(0); PG8_MMA(0, 0, At, B0); PG8_BAR; PG8_SCHED;
            PG8_LDB(B1, 0, 1); PG8_STAGE(PG8_SB(0, 0), b2, voffB);
            PG8_BAR; PG8_WAIT_L(0); PG8_MMA(0, 1, At, B1); PG8_BAR;
            PG8_LDA(At, 0, 1); PG8_STAGE(PG8_SA(0, 0), a2, voffA);
            PG8_BAR; PG8_WAIT_L(0); PG8_MMA(1, 0, At, B0); PG8_BAR; PG8_SCHED;
            PG8_STAGE(PG8_SB(0, 1), b2 + hstep, voffB);
            PG8_WAIT_V(6); PG8_BAR; PG8_MMA(1, 1, At, B1); PG8_BAR;
            PG8_LDB(B0, 1, 0); PG8_SCHED; PG8_LDA(At, 1, 0); PG8_STAGE(PG8_SA(0, 1), a2 + hstep, voffA);
            PG8_WAIT_L(8); PG8_BAR; PG8_WAIT_L(0); PG8_MMA(0, 0, At, B0); PG8_BAR; PG8_SCHED;
            PG8_LDB(B1, 1, 1); PG8_STAGE(PG8_SB(1, 0), b3, voffB);
            PG8_BAR; PG8_WAIT_L(0); PG8_MMA(0, 1, At, B1); PG8_BAR;
            PG8_LDA(At, 1, 1); PG8_STAGE(PG8_SA(1, 0), a3, voffA);
            PG8_BAR; PG8_WAIT_L(0); PG8_MMA(1, 0, At, B0); PG8_BAR; PG8_SCHED;
            PG8_STAGE(PG8_SB(1, 1), b3 + hstep, voffB);
            PG8_WAIT_V(6); PG8_BAR; PG8_MMA(1, 1, At, B1); PG8_BAR;
            }
        }
        if constexpr (ALIGN_EPI) { if (wr == 0) PG8_BAR; }
        if constexpr (!Epi::AFTER_DRAIN) { E(acc, cur, wr, wc, fr, fq); S.done(cur); }
        if (!has_next) break;
#pragma unroll
        for (int a = 0; a < 2; ++a)
#pragma unroll
            for (int b = 0; b < 2; ++b)
#pragma unroll
                for (int m = 0; m < 4; ++m)
#pragma unroll
                    for (int n = 0; n < 2; ++n) acc[a][b][m][n] = (f32x4){0.f, 0.f, 0.f, 0.f};
        cur = nxt; cA = nA; cB = nB; ++ui;
        if constexpr (ALIGN_EPI) { if (wr == 1) PG8_BAR; }
    }
    PG8_WAIT_V(0);
    if constexpr (!ALIGN_EPI) { if (wr == 0) PG8_BAR; }
    PG8_BAR;
    if constexpr (Epi::AFTER_DRAIN) { E.fused(acc, cur, wr, wc, fr, fq, lds, wid, lane); S.done(cur); }
#undef PG8_SA
#undef PG8_SB
#undef PG8_STAGE
#undef PG8_LDA
#undef PG8_LDB
#undef PG8_MMA
#undef PG8_WAIT_V
#undef PG8_WAIT_L
#undef PG8_BAR
#undef PG8_SCHED
}
}
#define LAS __attribute__((address_space(3)))
typedef unsigned short bf16_t;
typedef short bf16x8 __attribute__((ext_vector_type(8)));
typedef float f32x4 __attribute__((ext_vector_type(4)));
typedef float f32x2 __attribute__((ext_vector_type(2)));
typedef float f32x16 __attribute__((ext_vector_type(16)));
typedef unsigned u32x4 __attribute__((ext_vector_type(4)));
typedef unsigned u32x2 __attribute__((ext_vector_type(2)));

constexpr int NTOK = 16384, DM = 2048, SEQ = 2048, NBATCH = 8, PLE = 256;
constexpr int NPROJ = 6144;
constexpr int PQ_SB = 0, PK_SB = 1024, PG_SB = 2048, PQ_DF = 3072, PK_DF = 4096, PG_DF = 5120;
constexpr float LOG2E = 1.4426950408889634f;
constexpr float SBQ_SCALE = 0.08838834764831845f * LOG2E;
constexpr float DFQ_SCALE = 0.125f * LOG2E;
constexpr float NORM_EPS = 1e-6f, SUBLN_EPS = 1e-5f;
constexpr float LAMBDA_INIT = 0.2f;

constexpr size_t MiB = 1u << 20;
constexpr size_t WS_CTL = 0;
constexpr size_t CTL_SS2 = 0, CTL_SS3 = 65536, CTL_LAM = 131072, CTL_ROPE = 262144, CTL_BAR = 524288, CTL_BAR_BYTES = 16384;
constexpr size_t WS_WIN = 2 * MiB, WS_WOUT = 34 * MiB, WS_WGATE = 42 * MiB, WS_WPROJ = 50 * MiB, WS_PB = 52 * MiB;
constexpr size_t WS_XN = 64 * MiB, WS_MIXED = 64 * MiB;
constexpr size_t WS_PROJ = 128 * MiB, WS_VT = 320 * MiB, WS_KIMG = 384 * MiB, WS_END = 448 * MiB;
constexpr size_t WS_HB = 128 * MiB, WS_PLE = 192 * MiB;
constexpr size_t WS_H2B = 64 * MiB;

constexpr int LDS_BYTES = 131072 + 1024;

typedef __bf16 bf16x2_t __attribute__((ext_vector_type(2)));
__device__ __forceinline__ unsigned cvt_pk(float lo, float hi) { f32x2 v = {lo, hi}; bf16x2_t b = __builtin_convertvector(v, bf16x2_t); return __builtin_bit_cast(unsigned, b); }
__device__ __forceinline__ float bf_lo(unsigned w) { return __uint_as_float(w << 16); }
__device__ __forceinline__ float bf_hi(unsigned w) { return __uint_as_float(w & 0xffff0000u); }
__device__ __forceinline__ float wave_sum(float v) {
#pragma unroll
    for (int o = 1; o < 64; o <<= 1) v += __shfl_xor(v, o);
    return v;
}
__device__ __forceinline__ float fast_exp2(float x) { return __builtin_amdgcn_exp2f(x); }
__device__ __forceinline__ float fast_log2(float x) { return __builtin_amdgcn_logf(x); }
__device__ __forceinline__ float silu_f(float x) { return x * __builtin_amdgcn_rcpf(1.f + fast_exp2(-x * LOG2E)); }
__device__ __forceinline__ float sigmoid_f(float x) { return __builtin_amdgcn_rcpf(1.f + fast_exp2(-x * LOG2E)); }

namespace pg8 {
struct EpiBf16 {
    static constexpr bool PERM = true, AFTER_DRAIN = false;
    bf16_t* O; int ldc;
    __device__ __forceinline__ void operator()(const f32x4 (&acc)[2][2][4][2], const Unit& u, int wr, int wc, int fr, int fq) const {
        const int row0 = u.pm * BM + wr * 64 + fr; const int col0 = u.pn * BM + wc * 32 + 8 * fq;
#pragma unroll
        for (int ai = 0; ai < 2; ++ai)
#pragma unroll
            for (int m = 0; m < 4; ++m) { bf16_t* rowp = O + (size_t)(row0 + ai * HALF + m * 16) * ldc + col0;
#pragma unroll
                for (int bj = 0; bj < 2; ++bj) { const f32x4 v0 = acc[ai][bj][m][0], v1 = acc[ai][bj][m][1];
                    u32x4 w; w.x = cvt_pk_bf16(v0[0], v0[1]); w.y = cvt_pk_bf16(v0[2], v0[3]); w.z = cvt_pk_bf16(v1[0], v1[1]); w.w = cvt_pk_bf16(v1[2], v1[3]);
                    *(u32x4*)(rowp + bj * HALF) = w; } }
    }
};
struct EpiProj {
    static constexpr bool PERM = true, AFTER_DRAIN = false;
    bf16_t* O; const float* rope; bf16_t* KI;
    __device__ __forceinline__ void operator()(const f32x4 (&acc)[2][2][4][2], const Unit& u, int wr, int wc, int fr, int fq) const {
        const int row0 = u.pm * BM + wr * 64 + fr; const int col0 = u.pn * BM + wc * 32 + 8 * fq;
        const int kind = u.pn >> 2;
        const bool dorope = (kind == 3 || kind == 4) && ((wc & 1) == 0) && (fq < 2);
        const float sc = kind == 0 ? SBQ_SCALE : (kind == 3 ? DFQ_SCALE : 1.f);
        const bool dosilu = (kind == 2 || kind == 5);
#pragma unroll
        for (int ai = 0; ai < 2; ++ai)
#pragma unroll
            for (int m = 0; m < 4; ++m) { const int row = row0 + ai * HALF + m * 16; bf16_t* rowp = O + (size_t)row * NPROJ + col0;
                if (kind == 1 || kind == 4) {
                    const int cw = col0 & 1023; rowp = KI + ((size_t)(((kind == 4 ? 8 : 0) + (row >> 11)) * 8 + (cw >> 7)) * SEQ + (row & (SEQ - 1))) * 128 + (cw & 127); }
                f32x4 cs0 = {1.f, 0.f, 1.f, 0.f}, cs1 = {1.f, 0.f, 1.f, 0.f};
                if (dorope) { const f32x4* rp = (const f32x4*)(rope + ((size_t)(row & (SEQ - 1)) * 8 + 4 * fq) * 2); cs0 = rp[0]; cs1 = rp[1]; }
#pragma unroll
                for (int bj = 0; bj < 2; ++bj) { f32x4 v0 = acc[ai][bj][m][0], v1 = acc[ai][bj][m][1];
                    if (dorope) {
                        f32x4 a, b;
                        a[0] = v0[0] * cs0[0] - v0[1] * cs0[1]; a[1] = v0[1] * cs0[0] + v0[0] * cs0[1];
                        a[2] = v0[2] * cs0[2] - v0[3] * cs0[3]; a[3] = v0[3] * cs0[2] + v0[2] * cs0[3];
                        b[0] = v1[0] * cs1[0] - v1[1] * cs1[1]; b[1] = v1[1] * cs1[0] + v1[0] * cs1[1];
                        b[2] = v1[2] * cs1[2] - v1[3] * cs1[3]; b[3] = v1[3] * cs1[2] + v1[2] * cs1[3];
                        v0 = a; v1 = b; }
                    if (dosilu) {
#pragma unroll
                        for (int j = 0; j < 4; ++j) { v0[j] = silu_f(v0[j]); v1[j] = silu_f(v1[j]); } }
                    v0 = v0 * sc; v1 = v1 * sc;
                    u32x4 w; w.x = cvt_pk_bf16(v0[0], v0[1]); w.y = cvt_pk_bf16(v0[2], v0[3]); w.z = cvt_pk_bf16(v1[0], v1[1]); w.w = cvt_pk_bf16(v1[2], v1[3]);
                    *(u32x4*)(rowp + ((kind == 1 || kind == 4) ? bj * SEQ * 128 : bj * HALF)) = w; } }
    }
};
struct EpiVt {
    static constexpr bool PERM = true, AFTER_DRAIN = false;
    bf16_t* O;
    __device__ __forceinline__ void operator()(const f32x4 (&acc)[2][2][4][2], const Unit& u, int wr, int wc, int fr, int fq) const {
        const int row0 = u.pm * BM + wr * 64 + fr; const int col0 = u.pn * BM + wc * 32 + 8 * fq;
        const int p0 = (fq & 1) ? 4 : 0, p1 = (fq & 1) ? 12 : 8;
#pragma unroll
        for (int ai = 0; ai < 2; ++ai)
#pragma unroll
            for (int m = 0; m < 4; ++m) { const int row = row0 + ai * HALF + m * 16; const int gh = row >> 7, d = row & 127;
#pragma unroll
                for (int bj = 0; bj < 2; ++bj) { const int col = col0 + bj * HALF; const int b = col >> 11, sq = col & (SEQ - 1);
                    bf16_t* tp = O + ((size_t)((((gh >> 3) * 8 + b) * 8 + (gh & 7)) * 32 + (sq >> 6)) * 128 + d) * 64 + (sq & 48);
                    const f32x4 v0 = acc[ai][bj][m][0], v1 = acc[ai][bj][m][1];
                    u32x2 w0, w1; w0.x = cvt_pk_bf16(v0[0], v0[1]); w0.y = cvt_pk_bf16(v0[2], v0[3]); w1.x = cvt_pk_bf16(v1[0], v1[1]); w1.y = cvt_pk_bf16(v1[2], v1[3]);
                    *(u32x2*)(tp + p0) = w0; *(u32x2*)(tp + p1) = w1; } }
    }
};
struct EpiRes {
    static constexpr bool PERM = true, AFTER_DRAIN = false;
    const float* x; bf16_t* hb; float* ss;
    __device__ __forceinline__ void operator()(const f32x4 (&acc)[2][2][4][2], const Unit& u, int wr, int wc, int fr, int fq) const {
        const int row0 = u.pm * BM + wr * 64 + fr; const int col0 = u.pn * BM + wc * 32 + 8 * fq;
#pragma unroll
        for (int ai = 0; ai < 2; ++ai)
#pragma unroll
            for (int m = 0; m < 4; ++m) { const int row = row0 + ai * HALF + m * 16; const size_t off = (size_t)row * DM + col0; float q = 0.f;
#pragma unroll
                for (int bj = 0; bj < 2; ++bj) { const size_t o2 = off + bj * HALF;
                    const f32x4 h0 = __builtin_nontemporal_load((const f32x4*)(x + o2)) + acc[ai][bj][m][0], h1 = __builtin_nontemporal_load((const f32x4*)(x + o2 + 4)) + acc[ai][bj][m][1];
                    u32x4 w; w.x = cvt_pk_bf16(h0[0], h0[1]); w.y = cvt_pk_bf16(h0[2], h0[3]); w.z = cvt_pk_bf16(h1[0], h1[1]); w.w = cvt_pk_bf16(h1[2], h1[3]);
                    *(u32x4*)(hb + o2) = w;
                    q += ((h0[0] * h0[0] + h0[1] * h0[1]) + (h0[2] * h0[2] + h0[3] * h0[3])) + ((h1[0] * h1[0] + h1[1] * h1[1]) + (h1[2] * h1[2] + h1[3] * h1[3])); }
                q += __shfl_xor(q, 16); q += __shfl_xor(q, 32);
                if (fq == 0) atomicAdd(ss + row, q); }
    }
};
struct EpiGate {
    static constexpr bool PERM = true, AFTER_DRAIN = false;
    const bf16_t* hb; bf16_t* h2b; const bf16_t* ple; const float* ss2; float* ss3;
    __device__ __forceinline__ void operator()(const f32x4 (&acc)[2][2][4][2], const Unit& u, int wr, int wc, int fr, int fq) const {
        const int row0 = u.pm * BM + wr * 64 + fr; const int col0 = u.pn * BM + wc * 32 + 8 * fq;
#pragma unroll
        for (int ai = 0; ai < 2; ++ai)
#pragma unroll
            for (int m = 0; m < 4; ++m) { const int row = row0 + ai * HALF + m * 16; const size_t off = (size_t)row * DM + col0; float q = 0.f;
                const float rstd = rsqrtf(ss2[row] * (1.f / DM) + NORM_EPS);
#pragma unroll
                for (int bj = 0; bj < 2; ++bj) { const size_t o2 = off + bj * HALF; const u32x4 hw = *(const u32x4*)(hb + o2); const u32x4 pw = *(const u32x4*)(ple + o2);
                    const f32x4 a0 = acc[ai][bj][m][0] * rstd, a1 = acc[ai][bj][m][1] * rstd; f32x4 g0, g1;
                    g0[0] = bf_lo(hw.x) + sigmoid_f(a0[0]) * bf_lo(pw.x); g0[1] = bf_hi(hw.x) + sigmoid_f(a0[1]) * bf_hi(pw.x);
                    g0[2] = bf_lo(hw.y) + sigmoid_f(a0[2]) * bf_lo(pw.y); g0[3] = bf_hi(hw.y) + sigmoid_f(a0[3]) * bf_hi(pw.y);
                    g1[0] = bf_lo(hw.z) + sigmoid_f(a1[0]) * bf_lo(pw.z); g1[1] = bf_hi(hw.z) + sigmoid_f(a1[1]) * bf_hi(pw.z);
                    g1[2] = bf_lo(hw.w) + sigmoid_f(a1[2]) * bf_lo(pw.w); g1[3] = bf_hi(hw.w) + sigmoid_f(a1[3]) * bf_hi(pw.w);
                    u32x4 w2; w2.x = cvt_pk_bf16(g0[0], g0[1]); w2.y = cvt_pk_bf16(g0[2], g0[3]); w2.z = cvt_pk_bf16(g1[0], g1[1]); w2.w = cvt_pk_bf16(g1[2], g1[3]);
                    *(u32x4*)(h2b + o2) = w2;
                    q += ((g0[0] * g0[0] + g0[1] * g0[1]) + (g0[2] * g0[2] + g0[3] * g0[3])) + ((g1[0] * g1[0] + g1[1] * g1[1]) + (g1[2] * g1[2] + g1[3] * g1[3])); }
                q += __shfl_xor(q, 16); q += __shfl_xor(q, 32);
                if (fq == 0) atomicAdd(ss3 + row, q); }
    }
};
}
namespace att {
constexpr int KP = 272, VP = 144, KT_BYTES = 64 * KP, VT_BYTES = 128 * VP, BUF_BYTES = KT_BYTES + VT_BYTES;
constexpr int FLAG_OFF = 2 * BUF_BYTES;
constexpr int XP = 132;
constexpr float R_DONE = 152.0f;

template <bool MASK>
__device__ __forceinline__ void sb_block(const f32x16& sv, int kbase, int tq, int h, float& R, bf16x8 (&pf)[2]) {
    float c[16], z[16];
#pragma unroll
    for (int i = 0; i < 16; ++i) {
        z[i] = (!MASK || (kbase + 8 * (i >> 2) + (i & 3) < tq)) ? sv[i] : -1e30f;
        c[i] = fmaxf(z[i], 0.f) + fast_log2(1.f + fast_exp2(-fabsf(z[i])));
    }
    float T[4], OT[4], pr[4], suf[4];
#pragma unroll
    for (int g = 0; g < 4; ++g) { c[4 * g + 2] += c[4 * g + 3]; c[4 * g + 1] += c[4 * g + 2]; c[4 * g] += c[4 * g + 1]; T[g] = c[4 * g]; }
#pragma unroll
    for (int g = 0; g < 4; ++g) { OT[g] = __shfl_xor(T[g], 32); pr[g] = T[g] + OT[g]; }
    suf[3] = 0.f; suf[2] = pr[3]; suf[1] = suf[2] + pr[2]; suf[0] = suf[1] + pr[1];
    float w[16];
#pragma unroll
    for (int g = 0; g < 4; ++g) { const float off = R + suf[g] + (h == 0 ? OT[g] : 0.f);
#pragma unroll
        for (int j = 0; j < 4; ++j) { const int i = 4 * g + j; w[i] = fast_exp2(z[i] - (off + c[i])); } }
    R += suf[0] + pr[0];
#pragma unroll
    for (int sp = 0; sp < 2; ++sp) { u32x4 p; p.x = cvt_pk(w[8 * sp], w[8 * sp + 1]); p.y = cvt_pk(w[8 * sp + 2], w[8 * sp + 3]); p.z = cvt_pk(w[8 * sp + 4], w[8 * sp + 5]); p.w = cvt_pk(w[8 * sp + 6], w[8 * sp + 7]);
        pf[sp] = __builtin_bit_cast(bf16x8, p); }
}

template <int MODE>
__device__ __forceinline__ void attn_unit(LAS unsigned char* lds, const bf16_t* __restrict__ PROJ, const bf16_t* __restrict__ KIMG, const bf16_t* __restrict__ VT, bf16_t* __restrict__ MIXED,
                                          int b, int hh, int qblk, float lam, const float* __restrict__ subln_g) {
    constexpr int QB = MODE == 0 ? 256 : 128;
    constexpr int NKS = MODE == 0 ? 8 : 4;
    const int tid = opaque_tid(), lane = tid & 63, r = lane & 31, h = lane >> 5;
    const int wid = __builtin_amdgcn_readfirstlane(tid >> 6);
    const int qg = MODE == 0 ? wid : (wid & 3), role = MODE == 0 ? 0 : (wid >> 2);
    const int Q0 = qblk * QB, q0w = Q0 + 32 * qg, tq = q0w + r;
    const size_t tokbase = (size_t)b * SEQ;
    const int gbh = ((MODE == 0 ? 0 : 8) + b) * 8 + hh;
    const bf16_t* Kg = KIMG + (size_t)gbh * SEQ * 128;
    const bf16_t* Vg = VT + (size_t)gbh * 32 * 8192;
    bf16x8 qf[NKS];
    { const bf16_t* qp = PROJ + (tokbase + tq) * NPROJ + (MODE == 0 ? PQ_SB + hh * 128 : PQ_DF + hh * 128 + role * 64) + 8 * h;
#pragma unroll
      for (int ks = 0; ks < NKS; ++ks) qf[ks] = *(const bf16x8*)(qp + 16 * ks); }
    f32x16 o[4];
#pragma unroll
    for (int d = 0; d < 4; ++d)
#pragma unroll
        for (int i = 0; i < 16; ++i) o[d][i] = 0.f;
    float R = 0.f, m_run = -1e30f, l_run = 0.f;
    const int kr0 = tid >> 4, kc = tid & 15, vr0 = tid >> 3, vc = tid & 7;
    const int kst = kr0 * KP + kc * 16, vst = KT_BYTES + vr0 * VP + vc * 16;
    const bf16_t* kgl = Kg + tid * 8;
    const bf16_t* vgl = Vg + tid * 8;
    u32x4 kreg[2], vreg[2];
#define ATT_LOAD(t) do { _Pragma("unroll") for (int i_ = 0; i_ < 2; ++i_) { \
        kreg[i_] = *(const u32x4*)(kgl + (size_t)(t) * 8192 + i_ * 4096); \
        vreg[i_] = *(const u32x4*)(vgl + (size_t)(t) * 8192 + i_ * 4096); } } while (0)
#define ATT_STORE(bo) do { _Pragma("unroll") for (int i_ = 0; i_ < 2; ++i_) { \
        *(LAS u32x4*)(lds + (bo) + kst + i_ * 32 * KP) = kreg[i_]; \
        *(LAS u32x4*)(lds + (bo) + vst + i_ * 64 * VP) = vreg[i_]; } } while (0)
    const int tl = (Q0 + QB - 1) >> 6;
    const int kfrag = r * KP + (role * 64 + 8 * h) * 2;
    const int vfrag = KT_BYTES + r * VP + (8 * h) * 2;
    volatile LAS int* flags = (volatile LAS int*)(lds + FLAG_OFF);
    __syncthreads();
    ATT_LOAD(tl); ATT_STORE(0);
    __syncthreads();
    int cur = 0, it = 0;
    bool wdone = false;
    for (int t = tl;; --t, ++it) {
        if (t > 0) ATT_LOAD(t - 1);
        const int k0 = 64 * t;
        const bool active = (MODE == 0) ? (!wdone && k0 <= q0w + 30) : (k0 <= q0w + 31);
        if (active) {
            const int bo = cur * BUF_BYTES;
            f32x16 s[2];
            bf16x8 vf[4][2][2];
            if (MODE == 1) {
                bf16x8 kf[2][NKS];
#pragma unroll
                for (int kb = 0; kb < 2; ++kb)
#pragma unroll
                    for (int ks = 0; ks < NKS; ++ks) kf[kb][ks] = *(const LAS bf16x8*)(lds + bo + kfrag + kb * 32 * KP + ks * 32);
                __builtin_amdgcn_sched_barrier(0);
#pragma unroll
                for (int kb = 0; kb < 2; ++kb) {
#pragma unroll
                    for (int i = 0; i < 16; ++i) s[kb][i] = 0.f;
#pragma unroll
                    for (int ks = 0; ks < NKS; ++ks) s[kb] = __builtin_amdgcn_mfma_f32_32x32x16_bf16(kf[kb][ks], qf[ks], s[kb], 0, 0, 0);
                }
                __builtin_amdgcn_sched_barrier(0);
#pragma unroll
                for (int d = 0; d < 2; ++d)
#pragma unroll
                    for (int kb = 0; kb < 2; ++kb)
#pragma unroll
                        for (int sp = 0; sp < 2; ++sp) vf[d][kb][sp] = *(const LAS bf16x8*)(lds + bo + vfrag + d * 32 * VP + (32 * kb + 16 * sp) * 2);
                __builtin_amdgcn_sched_barrier(0);
            } else {
#pragma unroll
                for (int kb = 0; kb < 2; ++kb) {
#pragma unroll
                    for (int i = 0; i < 16; ++i) s[kb][i] = 0.f;
#pragma unroll
                    for (int ks = 0; ks < NKS; ++ks) {
                        const bf16x8 a = *(const LAS bf16x8*)(lds + bo + kfrag + kb * 32 * KP + ks * 32);
                        s[kb] = __builtin_amdgcn_mfma_f32_32x32x16_bf16(a, qf[ks], s[kb], 0, 0, 0);
                    }
                }
            }
            bf16x8 pf[2][2];
            if (MODE == 0) {
                sb_block<true>(s[1], k0 + 32 + 4 * h, tq, h, R, pf[1]);
                if (__all(R >= R_DONE)) {
#pragma unroll
                    for (int sp = 0; sp < 2; ++sp)
#pragma unroll
                        for (int j = 0; j < 8; ++j) pf[0][sp][j] = 0;
                } else sb_block<true>(s[0], k0 + 4 * h, tq, h, R, pf[0]);
                wdone = __all(R >= R_DONE);
            } else {
                float mx = -1e30f;
                if (k0 + 63 > q0w) {
#pragma unroll
                    for (int kb = 0; kb < 2; ++kb) { const int kbase = k0 + 32 * kb + 4 * h;
#pragma unroll
                        for (int i = 0; i < 16; ++i) { const int key = kbase + 8 * (i >> 2) + (i & 3); const float v = (key <= tq) ? s[kb][i] : -1e30f; s[kb][i] = v; mx = fmaxf(mx, v); } }
                } else {
#pragma unroll
                    for (int kb = 0; kb < 2; ++kb)
#pragma unroll
                        for (int i = 0; i < 16; ++i) mx = fmaxf(mx, s[kb][i]);
                }
                mx = fmaxf(mx, __shfl_xor(mx, 32));
                const float m_new = fmaxf(m_run, mx), alpha = fast_exp2(m_run - m_new);
                m_run = m_new;
                float ls = 0.f;
#pragma unroll
                for (int kb = 0; kb < 2; ++kb) {
#pragma unroll
                    for (int i = 0; i < 16; ++i) { const float p = fast_exp2(s[kb][i] - m_new); s[kb][i] = p; ls += p; }
#pragma unroll
                    for (int sp = 0; sp < 2; ++sp) { u32x4 p; p.x = cvt_pk(s[kb][8 * sp], s[kb][8 * sp + 1]); p.y = cvt_pk(s[kb][8 * sp + 2], s[kb][8 * sp + 3]); p.z = cvt_pk(s[kb][8 * sp + 4], s[kb][8 * sp + 5]); p.w = cvt_pk(s[kb][8 * sp + 6], s[kb][8 * sp + 7]);
                        pf[kb][sp] = __builtin_bit_cast(bf16x8, p); }
                }
                l_run = l_run * alpha + ls;
                if (!__all(alpha == 1.f)) {
#pragma unroll
                    for (int d = 0; d < 4; ++d)
#pragma unroll
                        for (int i = 0; i < 16; ++i) o[d][i] *= alpha;
                }
            }
            if (MODE == 1) {
                __builtin_amdgcn_sched_barrier(0);
#pragma unroll
                for (int d = 2; d < 4; ++d)
#pragma unroll
                    for (int kb = 0; kb < 2; ++kb)
#pragma unroll
                        for (int sp = 0; sp < 2; ++sp) vf[d][kb][sp] = *(const LAS bf16x8*)(lds + bo + vfrag + d * 32 * VP + (32 * kb + 16 * sp) * 2);
                __builtin_amdgcn_sched_barrier(0);
            }
#pragma unroll
            for (int d = 0; d < 4; ++d)
#pragma unroll
                for (int kb = 0; kb < 2; ++kb)
#pragma unroll
                    for (int sp = 0; sp < 2; ++sp) {
                        const bf16x8 a = (MODE == 1) ? vf[d][kb][sp] : *(const LAS bf16x8*)(lds + bo + vfrag + d * 32 * VP + (32 * kb + 16 * sp) * 2);
                        o[d] = __builtin_amdgcn_mfma_f32_32x32x16_bf16(a, pf[kb][sp], o[d], 0, 0, 0);
                    }
        }
        if (t > 0) ATT_STORE((cur ^ 1) * BUF_BYTES);
        if (MODE == 0) { if (lane == 0) flags[(it & 1) * 8 + wid] = wdone ? 1 : 0; }
        __syncthreads();
        if (t == 0) break;
        if (MODE == 0) { int alld = 1;
#pragma unroll
            for (int w2 = 0; w2 < 8; ++w2) alld &= flags[(it & 1) * 8 + w2];
            if (alld) break; }
        cur ^= 1;
    }
#undef ATT_LOAD
#undef ATT_STORE
    const int erow = lane >> 4, ech = lane & 15;
    const size_t tok0 = tokbase + q0w;
    if (MODE == 0 || role == 0) {
    }
    u32x4 gw[8];
    if (MODE == 0 || role == 0) {
        const bf16_t* gp = PROJ + (tok0 + erow) * NPROJ + (MODE == 0 ? PG_SB : PG_DF) + hh * 128 + ech * 8;
#pragma unroll
        for (int i = 0; i < 8; ++i) gw[i] = *(const u32x4*)(gp + (size_t)(4 * i) * NPROJ);
    }
    LAS unsigned char* stg = lds + (MODE == 0 ? wid * 8704 : 69632 + qg * 8704);
    if (MODE == 0) {
#pragma unroll
        for (int d = 0; d < 4; ++d)
#pragma unroll
            for (int g = 0; g < 4; ++g) { u32x2 w; w.x = cvt_pk(o[d][4 * g], o[d][4 * g + 1]); w.y = cvt_pk(o[d][4 * g + 2], o[d][4 * g + 3]);
                *(LAS u32x2*)(stg + r * 272 + (32 * d + 8 * g + 4 * h) * 2) = w; }
    } else {
        const float lt = l_run + __shfl_xor(l_run, 32);
        const float inv = 1.f / lt;
        LAS float* xq = (LAS float*)lds + (qg * 32 + r) * XP + 4 * h;
        if (role == 1) {
            const float f = inv * lam;
#pragma unroll
            for (int d = 0; d < 4; ++d)
#pragma unroll
                for (int g = 0; g < 4; ++g) *(LAS f32x4*)(xq + 32 * d + 8 * g) = (f32x4){o[d][4 * g] * f, o[d][4 * g + 1] * f, o[d][4 * g + 2] * f, o[d][4 * g + 3] * f};
        }
        __syncthreads();
        if (role == 0) {
            float q = 0.f;
#pragma unroll
            for (int d = 0; d < 4; ++d)
#pragma unroll
                for (int g = 0; g < 4; ++g) { const f32x4 x2 = *(const LAS f32x4*)(xq + 32 * d + 8 * g);
#pragma unroll
                    for (int j = 0; j < 4; ++j) { const float v = o[d][4 * g + j] * inv - x2[j]; o[d][4 * g + j] = v; q += v * v; } }
            q += __shfl_xor(q, 32);
            const float rs = rsqrtf(q * (1.f / 128.f) + SUBLN_EPS) * (1.f - LAMBDA_INIT);
            const float* sg = subln_g + 4 * h;
#pragma unroll
            for (int d = 0; d < 4; ++d)
#pragma unroll
                for (int g = 0; g < 4; ++g) { const f32x4 sv = *(const f32x4*)(sg + 32 * d + 8 * g);
                    u32x2 w; w.x = cvt_pk(o[d][4 * g] * rs * sv[0], o[d][4 * g + 1] * rs * sv[1]); w.y = cvt_pk(o[d][4 * g + 2] * rs * sv[2], o[d][4 * g + 3] * rs * sv[3]);
                    *(LAS u32x2*)(stg + r * 272 + (32 * d + 8 * g + 4 * h) * 2) = w; }
        }
    }
    if (MODE == 0 || role == 0) {
        asm volatile("s_waitcnt lgkmcnt(0)" ::: "memory");
        bf16_t* op = MIXED + (tok0 + erow) * DM + (MODE == 0 ? 0 : 1024) + hh * 128 + ech * 8;
#pragma unroll
        for (int i = 0; i < 8; ++i) { const u32x4 ov = *(const LAS u32x4*)(stg + (4 * i + erow) * 272 + ech * 16); const u32x4 g4 = gw[i];
            u32x4 w; w.x = cvt_pk(bf_lo(ov.x) * bf_lo(g4.x), bf_hi(ov.x) * bf_hi(g4.x)); w.y = cvt_pk(bf_lo(ov.y) * bf_lo(g4.y), bf_hi(ov.y) * bf_hi(g4.y));
            w.z = cvt_pk(bf_lo(ov.z) * bf_lo(g4.z), bf_hi(ov.z) * bf_hi(g4.z)); w.w = cvt_pk(bf_lo(ov.w) * bf_lo(g4.w), bf_hi(ov.w) * bf_hi(g4.w));
            *(u32x4*)(op + (size_t)(4 * i) * DM) = w; }
    }
}

__device__ __forceinline__ void attn_unit_df(LAS unsigned char* lds, const bf16_t* __restrict__ PROJ, const bf16_t* __restrict__ KIMG, const bf16_t* __restrict__ VT, bf16_t* __restrict__ MIXED,
                                             int b, int hh, int qblk, float lam, const float* __restrict__ subln_g) {
    constexpr int VB0 = 2 * KT_BYTES;
    const int tid = opaque_tid(), lane = tid & 63, r = lane & 31, h = lane >> 5;
    const int wid = __builtin_amdgcn_readfirstlane(tid >> 6);
    const int qg = wid & 3, role = wid >> 2;
    const int Q0 = qblk * 128, q0w = Q0 + 32 * qg, tq = q0w + r;
    const size_t tokbase = (size_t)b * SEQ;
    const int gbh = (8 + b) * 8 + hh;
    const bf16_t* Kg = KIMG + (size_t)gbh * SEQ * 128;
    const bf16_t* Vg = VT + (size_t)gbh * 32 * 8192;
    bf16x8 qf[4];
    { const bf16_t* qp = PROJ + (tokbase + tq) * NPROJ + PQ_DF + hh * 128 + role * 64 + 8 * h;
#pragma unroll
      for (int ks = 0; ks < 4; ++ks) qf[ks] = *(const bf16x8*)(qp + 16 * ks); }
    f32x16 o[4];
#pragma unroll
    for (int d = 0; d < 4; ++d)
#pragma unroll
        for (int i = 0; i < 16; ++i) o[d][i] = 0.f;
    float m_run = -1e30f, l_run = 0.f, alpha = 1.f;
    const int kr0 = tid >> 4, kc = tid & 15, vr0 = tid >> 3, vc = tid & 7;
    const int kst = kr0 * KP + kc * 16, vst = vr0 * VP + vc * 16;
    const bf16_t* kgl = Kg + tid * 8;
    const bf16_t* vgl = Vg + tid * 8;
    u32x4 kreg[2], vreg[2];
#define DF_LOAD(t) do { _Pragma("unroll") for (int i_ = 0; i_ < 2; ++i_) { \
        kreg[i_] = *(const u32x4*)(kgl + (size_t)(t) * 8192 + i_ * 4096); \
        vreg[i_] = *(const u32x4*)(vgl + (size_t)(t) * 8192 + i_ * 4096); } } while (0)
#define DF_STORE(ko, vo) do { _Pragma("unroll") for (int i_ = 0; i_ < 2; ++i_) { \
        *(LAS u32x4*)(lds + (ko) + kst + i_ * 32 * KP) = kreg[i_]; \
        *(LAS u32x4*)(lds + (vo) + vst + i_ * 64 * VP) = vreg[i_]; } } while (0)
#define DF_VLOAD(vo) do { _Pragma("unroll") for (int d_ = 0; d_ < 4; ++d_) _Pragma("unroll") for (int kb_ = 0; kb_ < 2; ++kb_) _Pragma("unroll") for (int sp_ = 0; sp_ < 2; ++sp_) \
        vf[d_][kb_][sp_] = *(const LAS bf16x8*)(lds + (vo) + vfrag + d_ * 32 * VP + (32 * kb_ + 16 * sp_) * 2); } while (0)
#define DF_PV() do { _Pragma("unroll") for (int d_ = 0; d_ < 4; ++d_) _Pragma("unroll") for (int kb_ = 0; kb_ < 2; ++kb_) _Pragma("unroll") for (int sp_ = 0; sp_ < 2; ++sp_) \
        o[d_] = __builtin_amdgcn_mfma_f32_32x32x16_bf16(vf[d_][kb_][sp_], pf[kb_][sp_], o[d_], 0, 0, 0); } while (0)
#define DF_RESCALE() do { if (!__all(alpha == 1.f)) { _Pragma("unroll") for (int d_ = 0; d_ < 4; ++d_) _Pragma("unroll") for (int i_ = 0; i_ < 16; ++i_) o[d_][i_] *= alpha; } } while (0)
    const int tl = (Q0 + 127) >> 6, NT = tl + 1;
    const int kfrag = r * KP + (role * 64 + 8 * h) * 2;
    const int vfrag = r * VP + (8 * h) * 2;
    __syncthreads();
    DF_LOAD(tl); DF_STORE(0, VB0);
    __syncthreads();
    bool have_p = false;
    bf16x8 pf[2][2];
    for (int i = 0; i < NT; ++i) {
        const int t = tl - i, k0 = 64 * t;
        if (t > 0) DF_LOAD(t - 1);
        if (k0 <= q0w + 31) {
            const int ko = (i & 1) * KT_BYTES;
            bf16x8 kf[2][4];
#pragma unroll
            for (int kb = 0; kb < 2; ++kb)
#pragma unroll
                for (int ks = 0; ks < 4; ++ks) kf[kb][ks] = *(const LAS bf16x8*)(lds + ko + kfrag + kb * 32 * KP + ks * 32);
            f32x16 s[2];
#pragma unroll
            for (int kb = 0; kb < 2; ++kb) {
#pragma unroll
                for (int j = 0; j < 16; ++j) s[kb][j] = 0.f;
#pragma unroll
                for (int ks = 0; ks < 4; ++ks) s[kb] = __builtin_amdgcn_mfma_f32_32x32x16_bf16(kf[kb][ks], qf[ks], s[kb], 0, 0, 0);
            }
            if (!have_p) {
                float mx = -1e30f;
#pragma unroll
                for (int kb = 0; kb < 2; ++kb) { const int kbase = k0 + 32 * kb + 4 * h;
#pragma unroll
                    for (int j = 0; j < 16; ++j) { const int key = kbase + 8 * (j >> 2) + (j & 3); const float v = (key <= tq) ? s[kb][j] : -1e30f; s[kb][j] = v; mx = fmaxf(mx, v); } }
                mx = fmaxf(mx, __shfl_xor(mx, 32));
                m_run = mx; alpha = 1.f;
                float ls = 0.f;
#pragma unroll
                for (int kb = 0; kb < 2; ++kb) {
#pragma unroll
                    for (int j = 0; j < 16; ++j) { const float p = fast_exp2(s[kb][j] - mx); s[kb][j] = p; ls += p; }
#pragma unroll
                    for (int sp = 0; sp < 2; ++sp) { u32x4 p; p.x = cvt_pk(s[kb][8 * sp], s[kb][8 * sp + 1]); p.y = cvt_pk(s[kb][8 * sp + 2], s[kb][8 * sp + 3]); p.z = cvt_pk(s[kb][8 * sp + 4], s[kb][8 * sp + 5]); p.w = cvt_pk(s[kb][8 * sp + 6], s[kb][8 * sp + 7]);
                        pf[kb][sp] = __builtin_bit_cast(bf16x8, p); }
                }
                l_run = ls;
                have_p = true;
            } else {
                DF_RESCALE();
                const int vo = VB0 + ((i + 2) % 3) * VT_BYTES;
                bf16x8 vf[2][2][2];
                bf16x8 pn[2][2]; u32x4 pw[2][2];
                float mx = -1e30f, ls = 0.f, m_new = 0.f;
#define DF_VL(g) do { _Pragma("unroll") for (int kb_ = 0; kb_ < 2; ++kb_) _Pragma("unroll") for (int sp_ = 0; sp_ < 2; ++sp_) \
        vf[(g) & 1][kb_][sp_] = *(const LAS bf16x8*)(lds + vo + vfrag + (g) * 32 * VP + (32 * kb_ + 16 * sp_) * 2); } while (0)
#define DF_MF(k) o[(k) >> 2] = __builtin_amdgcn_mfma_f32_32x32x16_bf16(vf[((k) >> 2) & 1][((k) >> 1) & 1][(k) & 1], pf[((k) >> 1) & 1][(k) & 1], o[(k) >> 2], 0, 0, 0)
#define DF_S(e) s[(e) >> 4][(e) & 15]
                DF_VL(0); DF_VL(1);
                __builtin_amdgcn_sched_barrier(0);
                DF_MF(0);
                mx = fmaxf(fmaxf(mx, DF_S(0)), DF_S(1));
                mx = fmaxf(fmaxf(mx, DF_S(2)), DF_S(3));
                mx = fmaxf(fmaxf(mx, DF_S(4)), DF_S(5));
                mx = fmaxf(fmaxf(mx, DF_S(6)), DF_S(7));
                __builtin_amdgcn_sched_barrier(0);
                DF_MF(1);
                mx = fmaxf(fmaxf(mx, DF_S(8)), DF_S(9));
                mx = fmaxf(fmaxf(mx, DF_S(10)), DF_S(11));
                mx = fmaxf(fmaxf(mx, DF_S(12)), DF_S(13));
                mx = fmaxf(fmaxf(mx, DF_S(14)), DF_S(15));
                __builtin_amdgcn_sched_barrier(0);
                DF_MF(2);
                mx = fmaxf(fmaxf(mx, DF_S(16)), DF_S(17));
                mx = fmaxf(fmaxf(mx, DF_S(18)), DF_S(19));
                mx = fmaxf(fmaxf(mx, DF_S(20)), DF_S(21));
                mx = fmaxf(fmaxf(mx, DF_S(22)), DF_S(23));
                __builtin_amdgcn_sched_barrier(0);
                DF_MF(3);
                mx = fmaxf(fmaxf(mx, DF_S(24)), DF_S(25));
                mx = fmaxf(fmaxf(mx, DF_S(26)), DF_S(27));
                mx = fmaxf(fmaxf(mx, DF_S(28)), DF_S(29));
                mx = fmaxf(fmaxf(mx, DF_S(30)), DF_S(31));
                { auto rr = __builtin_amdgcn_permlane32_swap(__float_as_uint(mx), __float_as_uint(mx), false, false); mx = fmaxf(__uint_as_float(rr[0]), __uint_as_float(rr[1])); }
                { const bool grow = !__all(mx - m_run <= 8.f); m_new = grow ? fmaxf(m_run, mx) : m_run; alpha = fast_exp2(m_run - m_new); m_run = m_new; }
                __builtin_amdgcn_sched_barrier(0);
                DF_VL(2);
                DF_MF(4);
                { const float p = fast_exp2(DF_S(0) - m_new); DF_S(0) = p; ls += p; }
                { const float p = fast_exp2(DF_S(1) - m_new); DF_S(1) = p; ls += p; }
                pw[0][0][0] = cvt_pk(DF_S(0), DF_S(1));
                { const float p = fast_exp2(DF_S(2) - m_new); DF_S(2) = p; ls += p; }
                __builtin_amdgcn_sched_barrier(0);
                DF_MF(5);
                { const float p = fast_exp2(DF_S(3) - m_new); DF_S(3) = p; ls += p; }
                pw[0][0][1] = cvt_pk(DF_S(2), DF_S(3));
                { const float p = fast_exp2(DF_S(4) - m_new); DF_S(4) = p; ls += p; }
                { const float p = fast_exp2(DF_S(5) - m_new); DF_S(5) = p; ls += p; }
                pw[0][0][2] = cvt_pk(DF_S(4), DF_S(5));
                __builtin_amdgcn_sched_barrier(0);
                DF_MF(6);
                { const float p = fast_exp2(DF_S(6) - m_new); DF_S(6) = p; ls += p; }
                { const float p = fast_exp2(DF_S(7) - m_new); DF_S(7) = p; ls += p; }
                pw[0][0][3] = cvt_pk(DF_S(6), DF_S(7));
                { const float p = fast_exp2(DF_S(8) - m_new); DF_S(8) = p; ls += p; }
                __builtin_amdgcn_sched_barrier(0);
                DF_MF(7);
                { const float p = fast_exp2(DF_S(9) - m_new); DF_S(9) = p; ls += p; }
                pw[0][1][0] = cvt_pk(DF_S(8), DF_S(9));
                { const float p = fast_exp2(DF_S(10) - m_new); DF_S(10) = p; ls += p; }
                { const float p = fast_exp2(DF_S(11) - m_new); DF_S(11) = p; ls += p; }
                pw[0][1][1] = cvt_pk(DF_S(10), DF_S(11));
                __builtin_amdgcn_sched_barrier(0);
                DF_VL(3);
                DF_MF(8);
                { const float p = fast_exp2(DF_S(12) - m_new); DF_S(12) = p; ls += p; }
                { const float p = fast_exp2(DF_S(13) - m_new); DF_S(13) = p; ls += p; }
                pw[0][1][2] = cvt_pk(DF_S(12), DF_S(13));
                { const float p = fast_exp2(DF_S(14) - m_new); DF_S(14) = p; ls += p; }
                __builtin_amdgcn_sched_barrier(0);
                DF_MF(9);
                { const float p = fast_exp2(DF_S(15) - m_new); DF_S(15) = p; ls += p; }
                pw[0][1][3] = cvt_pk(DF_S(14), DF_S(15));
                { const float p = fast_exp2(DF_S(16) - m_new); DF_S(16) = p; ls += p; }
                { const float p = fast_exp2(DF_S(17) - m_new); DF_S(17) = p; ls += p; }
                pw[1][0][0] = cvt_pk(DF_S(16), DF_S(17));
                __builtin_amdgcn_sched_barrier(0);
                DF_MF(10);
                { const float p = fast_exp2(DF_S(18) - m_new); DF_S(18) = p; ls += p; }
                { const float p = fast_exp2(DF_S(19) - m_new); DF_S(19) = p; ls += p; }
                pw[1][0][1] = cvt_pk(DF_S(18), DF_S(19));
                { const float p = fast_exp2(DF_S(20) - m_new); DF_S(20) = p; ls += p; }
                __builtin_amdgcn_sched_barrier(0);
                DF_MF(11);
                { const float p = fast_exp2(DF_S(21) - m_new); DF_S(21) = p; ls += p; }
                pw[1][0][2] = cvt_pk(DF_S(20), DF_S(21));
                { const float p = fast_exp2(DF_S(22) - m_new); DF_S(22) = p; ls += p; }
                { const float p = fast_exp2(DF_S(23) - m_new); DF_S(23) = p; ls += p; }
                pw[1][0][3] = cvt_pk(DF_S(22), DF_S(23));
                __builtin_amdgcn_sched_barrier(0);
                DF_MF(12);
                { const float p = fast_exp2(DF_S(24) - m_new); DF_S(24) = p; ls += p; }
                { const float p = fast_exp2(DF_S(25) - m_new); DF_S(25) = p; ls += p; }
                pw[1][1][0] = cvt_pk(DF_S(24), DF_S(25));
                __builtin_amdgcn_sched_barrier(0);
                DF_MF(13);
                { const float p = fast_exp2(DF_S(26) - m_new); DF_S(26) = p; ls += p; }
                { const float p = fast_exp2(DF_S(27) - m_new); DF_S(27) = p; ls += p; }
                pw[1][1][1] = cvt_pk(DF_S(26), DF_S(27));
                __builtin_amdgcn_sched_barrier(0);
                DF_MF(14);
                { const float p = fast_exp2(DF_S(28) - m_new); DF_S(28) = p; ls += p; }
                { const float p = fast_exp2(DF_S(29) - m_new); DF_S(29) = p; ls += p; }
                pw[1][1][2] = cvt_pk(DF_S(28), DF_S(29));
                __builtin_amdgcn_sched_barrier(0);
                DF_MF(15);
                { const float p = fast_exp2(DF_S(30) - m_new); DF_S(30) = p; ls += p; }
                { const float p = fast_exp2(DF_S(31) - m_new); DF_S(31) = p; ls += p; }
                pw[1][1][3] = cvt_pk(DF_S(30), DF_S(31));
                __builtin_amdgcn_sched_barrier(0);
                l_run = l_run * alpha + ls;
#pragma unroll
                for (int kb = 0; kb < 2; ++kb)
#pragma unroll
                    for (int sp = 0; sp < 2; ++sp) pf[kb][sp] = __builtin_bit_cast(bf16x8, pw[kb][sp]);
#undef DF_VL
#undef DF_MF
#undef DF_S
            }
        }
        if (t > 0) DF_STORE(((i + 1) & 1) * KT_BYTES, VB0 + ((i + 1) % 3) * VT_BYTES);
        __syncthreads();
    }
    if (have_p) {
        DF_RESCALE();
        bf16x8 vf[4][2][2];
        DF_VLOAD(VB0 + ((NT - 1) % 3) * VT_BYTES);
        DF_PV();
    }
    __syncthreads();
#undef DF_LOAD
#undef DF_STORE
#undef DF_VLOAD
#undef DF_PV
#undef DF_RESCALE
    const int erow = lane >> 4, ech = lane & 15;
    const size_t tok0 = tokbase + q0w;
    u32x4 gw[8];
    if (role == 0) {
        const bf16_t* gp = PROJ + (tok0 + erow) * NPROJ + PG_DF + hh * 128 + ech * 8;
#pragma unroll
        for (int i = 0; i < 8; ++i) gw[i] = *(const u32x4*)(gp + (size_t)(4 * i) * NPROJ);
    }
    LAS unsigned char* stg = lds + 69632 + qg * 8704;
    {
        const float lt = l_run + __shfl_xor(l_run, 32);
        const float inv = 1.f / lt;
        LAS float* xq = (LAS float*)lds + (qg * 32 + r) * XP + 4 * h;
        if (role == 1) {
            const float f = inv * lam;
#pragma unroll
            for (int d = 0; d < 4; ++d)
#pragma unroll
                for (int g = 0; g < 4; ++g) *(LAS f32x4*)(xq + 32 * d + 8 * g) = (f32x4){o[d][4 * g] * f, o[d][4 * g + 1] * f, o[d][4 * g + 2] * f, o[d][4 * g + 3] * f};
        }
        __syncthreads();
        if (role == 0) {
            float q = 0.f;
#pragma unroll
            for (int d = 0; d < 4; ++d)
#pragma unroll
                for (int g = 0; g < 4; ++g) { const f32x4 x2 = *(const LAS f32x4*)(xq + 32 * d + 8 * g);
#pragma unroll
                    for (int j = 0; j < 4; ++j) { const float v = o[d][4 * g + j] * inv - x2[j]; o[d][4 * g + j] = v; q += v * v; } }
            q += __shfl_xor(q, 32);
            const float rs = rsqrtf(q * (1.f / 128.f) + SUBLN_EPS) * (1.f - LAMBDA_INIT);
            const float* sg = subln_g + 4 * h;
#pragma unroll
            for (int d = 0; d < 4; ++d)
#pragma unroll
                for (int g = 0; g < 4; ++g) { const f32x4 sv = *(const f32x4*)(sg + 32 * d + 8 * g);
                    u32x2 w; w.x = cvt_pk(o[d][4 * g] * rs * sv[0], o[d][4 * g + 1] * rs * sv[1]); w.y = cvt_pk(o[d][4 * g + 2] * rs * sv[2], o[d][4 * g + 3] * rs * sv[3]);
                    *(LAS u32x2*)(stg + r * 272 + (32 * d + 8 * g + 4 * h) * 2) = w; }
            asm volatile("s_waitcnt lgkmcnt(0)" ::: "memory");
            bf16_t* op = MIXED + (tok0 + erow) * DM + 1024 + hh * 128 + ech * 8;
#pragma unroll
            for (int i = 0; i < 8; ++i) { const u32x4 ov = *(const LAS u32x4*)(stg + (4 * i + erow) * 272 + ech * 16); const u32x4 g4 = gw[i];
                u32x4 w; w.x = cvt_pk(bf_lo(ov.x) * bf_lo(g4.x), bf_hi(ov.x) * bf_hi(g4.x)); w.y = cvt_pk(bf_lo(ov.y) * bf_lo(g4.y), bf_hi(ov.y) * bf_hi(g4.y));
                w.z = cvt_pk(bf_lo(ov.z) * bf_lo(g4.z), bf_hi(ov.z) * bf_hi(g4.z)); w.w = cvt_pk(bf_lo(ov.w) * bf_lo(g4.w), bf_hi(ov.w) * bf_hi(g4.w));
                *(u32x4*)(op + (size_t)(4 * i) * DM) = w; }
        }
    }
}
}
#define XB_TMO      128
#define XB_XCNT(j)  (256  + 64 * (j))
#define XB_XSUB(j)  (1280 + 64 * (j))
#define XB_XGEN(j)  (2304 + 64 * (j))
#define XB_TOP      3328
#define XB_TOPGEN   3392
#define XCD_BAR_WORDS 3456
#define XB_SPIN_CAP (1u << 18)

__device__ __forceinline__ unsigned xb_ld(unsigned* p)              { return __hip_atomic_load(p, __ATOMIC_RELAXED, __HIP_MEMORY_SCOPE_AGENT); }
__device__ __forceinline__ unsigned xb_add(unsigned* p, unsigned v) { return __hip_atomic_fetch_add(p, v, __ATOMIC_RELAXED, __HIP_MEMORY_SCOPE_AGENT); }
__device__ __forceinline__ unsigned xb_xcc_id() { return (unsigned)__builtin_amdgcn_s_getreg((3 << 11) | 20) & 0xFu; }
#define XB_SPIN(cond, bar) do { unsigned _sp = 0; while (cond) { __builtin_amdgcn_s_sleep(1); \
    if ((++_sp & 255u) == 0u) { if (xb_ld(&(bar)[XB_TMO])) break; if (_sp > XB_SPIN_CAP) { atomicAdd(&(bar)[XB_TMO], 1u); break; } } } } while (0)

struct XcdBarrier {
    unsigned* bar; unsigned x;
    volatile LAS unsigned* st;
};

__device__ __forceinline__ XcdBarrier xcd_barrier_post(unsigned* bar, volatile LAS unsigned* st) {
    XcdBarrier b; b.bar = bar; b.x = xb_xcc_id(); b.st = st;
    if (threadIdx.x == 0) (void)xb_add(&bar[XB_XCNT(b.x)], 1u);
    return b;
}
__device__ __forceinline__ void xcd_barrier_complete(unsigned* bar, unsigned x, unsigned& nloc, unsigned& nx) {
    const unsigned G = gridDim.x * gridDim.y * gridDim.z;
    unsigned sum, cnt, mine, sp = 0u;
    for (;;) {
        sum = 0u; cnt = 0u; mine = 0u;
#pragma unroll
        for (unsigned j = 0; j < 16; ++j) { const unsigned c = xb_ld(&bar[XB_XCNT(j)]); sum += c; cnt += (c > 0u) ? 1u : 0u; mine = (j == x) ? c : mine; }
        if (sum == G) break;
        __builtin_amdgcn_s_sleep(1);
        if ((++sp & 255u) == 0u) { if (xb_ld(&bar[XB_TMO])) break; if (sp > XB_SPIN_CAP) { atomicAdd(&bar[XB_TMO], 1u); break; } }
    }
    nloc = mine > 0u ? mine : 1u; nx = cnt > 0u ? cnt : 1u;
}

__device__ __forceinline__ void xcd_barrier(const XcdBarrier& b) {
    asm volatile("s_waitcnt vmcnt(0)" ::: "memory");
    __syncthreads();
    if (threadIdx.x == 0) {
        unsigned* bar = b.bar;
        __builtin_amdgcn_s_waitcnt(0);
        unsigned nloc = b.st[0], nx = b.st[1];
        if (nloc == 0u) { xcd_barrier_complete(bar, b.x, nloc, nx); b.st[0] = nloc; b.st[1] = nx; }
        const unsigned old = xb_add(&bar[XB_XSUB(b.x)], 1u);
        const unsigned gen = old / nloc;
        if (old + 1u == (gen + 1u) * nloc) {
            __builtin_amdgcn_fence(__ATOMIC_RELEASE, "agent");
            asm volatile("s_waitcnt vmcnt(0)" ::: "memory");
            const unsigned og = xb_add(&bar[XB_TOP], 1u);
            const unsigned tg = og / nx;
            if (og + 1u == (tg + 1u) * nx) xb_add(&bar[XB_TOPGEN], 1u);
            else XB_SPIN(xb_ld(&bar[XB_TOPGEN]) == tg, bar);
            __builtin_amdgcn_fence(__ATOMIC_ACQUIRE, "agent");
            xb_add(&bar[XB_XGEN(b.x)], 1u);
            asm volatile("s_waitcnt vmcnt(0)" ::: "memory");
        } else {
            XB_SPIN(xb_ld(&bar[XB_XGEN(b.x)]) == gen, bar);
            __builtin_amdgcn_fence(__ATOMIC_ACQUIRE, "agent");
            asm volatile("s_waitcnt vmcnt(0)" ::: "memory");
        }
    }
    __syncthreads();
}

__device__ __forceinline__ int win_dst_row(int c) {
    const int seg = c >> 10, w = c & 1023, d6 = w & 63;
    const int wp = d6 < 16 ? (w & ~63) + (d6 < 8 ? 2 * d6 : 2 * (d6 - 8) + 1) : w;
    switch (seg) { case 0: return w; case 1: return 1024 + w; case 2: return 6144 + w; case 3: return 2048 + w;
                   case 4: return 3072 + wp; case 5: return 4096 + wp; case 6: return 7168 + w; default: return 5120 + w; }
}
struct TItem { const float* W; bf16_t* WT; const float* ks; int K, N, win, item; };
__device__ __forceinline__ void tr_load(const TItem& t, float (&v)[32], int lane) {
    const int nblk = t.N / 32, kb = t.item / nblk, nb = t.item % nblk; const float* p = t.W + (size_t)(64 * kb + (lane >> 5)) * t.N + 32 * nb + (lane & 31);
#pragma unroll
    for (int i = 0; i < 32; ++i) v[i] = __builtin_nontemporal_load(&p[(size_t)(2 * i) * t.N]);
}
__device__ __forceinline__ void tr_write(const float (&v)[32], LAS float* scr, int lane) {
#pragma unroll
    for (int i = 0; i < 32; ++i) scr[(2 * i + (lane >> 5)) * 33 + (lane & 31)] = v[i];
}
__device__ __forceinline__ void tr_store(const TItem& t, LAS float* scr, int lane) {
    const int nblk = t.N / 32, kb = t.item / nblk, nb = t.item % nblk, k0 = 64 * kb, n0 = 32 * nb, c = lane & 7;
    f32x4 s0 = {1.f, 1.f, 1.f, 1.f}, s1 = {1.f, 1.f, 1.f, 1.f};
    if (t.ks) { s0 = *(const f32x4*)(t.ks + k0 + 8 * c); s1 = *(const f32x4*)(t.ks + k0 + 8 * c + 4); }
#pragma unroll
    for (int j = 0; j < 4; ++j) { const int n = (lane >> 3) + 8 * j; const LAS float* s = scr + (8 * c) * 33 + n;
        u32x4 o; o.x = cvt_pk(s[0 * 33] * s0[0], s[1 * 33] * s0[1]); o.y = cvt_pk(s[2 * 33] * s0[2], s[3 * 33] * s0[3]); o.z = cvt_pk(s[4 * 33] * s1[0], s[5 * 33] * s1[1]); o.w = cvt_pk(s[6 * 33] * s1[2], s[7 * 33] * s1[3]);
        const int dn = t.win ? win_dst_row(n0 + n) : (n0 + n);
        *(u32x4*)(t.WT + (size_t)dn * t.K + k0 + 8 * c) = o; }
}
__device__ __forceinline__ void rms_load(const float* __restrict__ xrow, f32x4 (&v)[8], int lane) {
    const f32x4* xr = (const f32x4*)xrow + lane;
#pragma unroll
    for (int j = 0; j < 8; ++j) v[j] = __builtin_nontemporal_load(&xr[64 * j]);
}
__device__ __forceinline__ void rms_finish(const f32x4 (&v)[8], const f32x4 (&gv)[8], bf16_t* __restrict__ orow, int lane) {
    float s = 0.f;
#pragma unroll
    for (int j = 0; j < 8; ++j) s += (v[j][0] * v[j][0] + v[j][1] * v[j][1]) + (v[j][2] * v[j][2] + v[j][3] * v[j][3]);
    const float rstd = rsqrtf(wave_sum(s) * (1.f / DM) + NORM_EPS);
    u32x2* o8 = (u32x2*)orow + lane;
#pragma unroll
    for (int j = 0; j < 8; ++j) { u32x2 w; w.x = cvt_pk(v[j][0] * rstd * gv[j][0], v[j][1] * rstd * gv[j][1]); w.y = cvt_pk(v[j][2] * rstd * gv[j][2], v[j][3] * rstd * gv[j][3]); o8[64 * j] = w; }
}

struct Args { const float* in[14]; float* out; unsigned char* ws; };

__global__ void __launch_bounds__(512, 2) fwd_megakernel(Args a) {
    extern __shared__ __attribute__((aligned(16))) unsigned char lds_raw[];
    LAS unsigned char* lds = (LAS unsigned char*)lds_raw;
    { cg::grid_group grid = cg::this_grid(); if (a.ws == nullptr) grid.sync(); }
    const int tid = threadIdx.x, lane = tid & 63, wave = __builtin_amdgcn_readfirstlane(tid >> 6);
    const int G = gridDim.x, bx = blockIdx.x;
    const int vcu = (G % 8 == 0) ? (bx % 8) * (G / 8) + bx / 8 : bx;
    unsigned char* ws = a.ws;
    float* ss2 = (float*)(ws + WS_CTL + CTL_SS2); float* ss3 = (float*)(ws + WS_CTL + CTL_SS3); float* lamp = (float*)(ws + WS_CTL + CTL_LAM); float* rope = (float*)(ws + WS_CTL + CTL_ROPE);
    bf16_t* WIN = (bf16_t*)(ws + WS_WIN); bf16_t* WOUT = (bf16_t*)(ws + WS_WOUT); bf16_t* WGATE = (bf16_t*)(ws + WS_WGATE); bf16_t* WPROJ = (bf16_t*)(ws + WS_WPROJ);
    bf16_t* PB = (bf16_t*)(ws + WS_PB); bf16_t* XN = (bf16_t*)(ws + WS_XN); bf16_t* MIXED = (bf16_t*)(ws + WS_MIXED); bf16_t* PROJ = (bf16_t*)(ws + WS_PROJ);
    bf16_t* VT = (bf16_t*)(ws + WS_VT); bf16_t* KIMG = (bf16_t*)(ws + WS_KIMG); bf16_t* HB = (bf16_t*)(ws + WS_HB); bf16_t* PLEB = (bf16_t*)(ws + WS_PLE); bf16_t* H2B = (bf16_t*)(ws + WS_H2B);
    const float* x = a.in[0]; float* out = a.out;
    volatile LAS unsigned* xst = (volatile LAS unsigned*)(lds + 131072);
    if (tid == 0) { xst[0] = 0u; xst[1] = 0u; }
    __syncthreads();
    const XcdBarrier xb = xcd_barrier_post((unsigned*)(ws + WS_CTL + CTL_BAR), xst);

    for (int rep_ = 0; rep_ < ((PROBE_DUP & 1) ? 2 : 1); ++rep_) {
        if (rep_) __syncthreads();
        const int gw = bx * 8 + wave, NGW = G * 8; const int gt = bx * 512 + tid, NGT = G * 512;
        for (int i = gt; i < 2 * NTOK; i += NGT) ss2[i] = 0.f;
        if (gt == 0) { float s1 = 0.f, s2 = 0.f; for (int i = 0; i < 64; ++i) { s1 += a.in[4][i] * a.in[5][i]; s2 += a.in[6][i] * a.in[7][i]; } lamp[0] = expf(s1) - expf(s2) + LAMBDA_INIT; }
        for (int i = gt; i < SEQ * 8; i += NGT) { const int pos = i >> 3, f = i & 7;
            const float invf = (float)exp2(-(double)f * 0.125 * 18.931568569324174);
            const float angf = (float)pos * invf;
            const double tw = 6.283185307179586476925; double ang = (double)angf; ang -= tw * rint(ang / tw);
            rope[2 * i] = (float)cos(ang); rope[2 * i + 1] = (float)sin(ang); }
        LAS float* scr = (LAS float*)(lds + wave * 16384);
        constexpr int I_IN = (DM / 64) * (8192 / 32), I_SQ = (DM / 64) * (DM / 32), I_PR = (PLE / 64) * (DM / 32), I_ALL = I_IN + 2 * I_SQ + I_PR;
#define P0_DECODE(T, it_) do { int rr_ = (it_); \
            if (rr_ < I_IN) { T = TItem{a.in[3], WIN, nullptr, DM, 8192, 1, rr_}; } \
            else if (rr_ < I_IN + I_SQ) { T = TItem{a.in[9], WOUT, nullptr, DM, DM, 0, rr_ - I_IN}; } \
            else if (rr_ < I_IN + 2 * I_SQ) { T = TItem{a.in[11], WGATE, a.in[10], DM, DM, 0, rr_ - I_IN - I_SQ}; } \
            else { T = TItem{a.in[12], WPROJ, nullptr, PLE, DM, 0, rr_ - I_IN - 2 * I_SQ}; } } while (0)
        {
            float tv[32]; TItem cur, nxt; int it = gw;
            if (it < I_ALL) { P0_DECODE(cur, it); tr_load(cur, tv, lane); }
            while (it < I_ALL) {
                tr_write(tv, scr, lane);
                const int itn = it + NGW;
                if (itn < I_ALL) { P0_DECODE(nxt, itn); tr_load(nxt, tv, lane); }
                asm volatile("s_waitcnt lgkmcnt(0)" ::: "memory");
                tr_store(cur, scr, lane);
                asm volatile("s_waitcnt lgkmcnt(0)" ::: "memory");
                cur = nxt; it = itn;
            }
        }
#undef P0_DECODE
        {
            f32x4 gv[8], va[8], vb[8];
            { const f32x4* gr = (const f32x4*)a.in[2] + lane;
#pragma unroll
              for (int j = 0; j < 8; ++j) gv[j] = gr[64 * j]; }
            int m = gw;
            if (m < NTOK) rms_load(x + (size_t)m * DM, va, lane);
            for (; m < NTOK; m += 2 * NGW) {
                const int m1 = m + NGW, m2 = m + 2 * NGW;
                if (m1 < NTOK) rms_load(x + (size_t)m1 * DM, vb, lane);
                rms_finish(va, gv, XN + (size_t)m * DM, lane);
                if (m2 < NTOK) rms_load(x + (size_t)m2 * DM, va, lane);
                if (m1 < NTOK) rms_finish(vb, gv, XN + (size_t)m1 * DM, lane);
            }
        }
        for (int i = gt; i < NTOK * PLE / 8; i += NGT) { const f32x4 v0 = __builtin_nontemporal_load(&((const f32x4*)a.in[1])[2 * i]), v1 = __builtin_nontemporal_load(&((const f32x4*)a.in[1])[2 * i + 1]);
            u32x4 w; w.x = cvt_pk(v0[0], v0[1]); w.y = cvt_pk(v0[2], v0[3]); w.z = cvt_pk(v1[0], v1[1]); w.w = cvt_pk(v1[2], v1[3]); ((u32x4*)PB)[i] = w; }
    }
    xcd_barrier(xb);
    for (int rep_ = 0; rep_ < ((PROBE_DUP & 2) ? 2 : 1); ++rep_) {
        if (rep_) __syncthreads();
        { pg8::Gemm g{XN, WIN, NTOK, NPROJ, DM}; pg8::StaticOrder S; S.init(NTOK, NPROJ, G, bx); pg8::EpiProj E{PROJ, rope, KIMG};
          pg8::gemm_phase<pg8::EpiProj, pg8::StaticOrder, true, true>(lds, g, S, E); }
        __syncthreads();
        { pg8::Gemm g{WIN + (size_t)NPROJ * DM, XN, 2048, NTOK, DM}; pg8::StaticOrder S; S.init(2048, NTOK, G, bx); pg8::EpiVt E{VT};
          pg8::gemm_phase<pg8::EpiVt, pg8::StaticOrder, true, true>(lds, g, S, E); }
    }
    xcd_barrier(xb);
    for (int rep_ = 0; rep_ < ((PROBE_DUP & 4) ? 2 : 1); ++rep_) {
        const float lam = lamp[0];
        for (int su = vcu; su < 256; su += G) {
            const int grp = su >> 4, j = su & 15;
#pragma unroll 1
            for (int k = 0; k < 4; ++k) { const int bh = 4 * grp + k; const int qb = (k & 1) ? 15 - j : j;
                att::attn_unit_df(lds, PROJ, KIMG, VT, MIXED, bh >> 3, bh & 7, qb, lam, a.in[8]); }
        }
#pragma unroll 1
        for (int u = vcu; u < 512; u += G) att::attn_unit<0>(lds, PROJ, KIMG, VT, MIXED, (u >> 3) >> 3, (u >> 3) & 7, u & 7, lam, a.in[8]);
    }
    xcd_barrier(xb);
    {
        __syncthreads();
        { pg8::Gemm g{MIXED, WOUT, NTOK, DM, DM}; pg8::StaticOrder S; S.init(NTOK, DM, G, bx); pg8::EpiRes E{x, HB, ss2};
          pg8::gemm_phase<pg8::EpiRes, pg8::StaticOrder, true, true>(lds, g, S, E); }
        __syncthreads();
        { pg8::Gemm g{PB, WPROJ, NTOK, DM, PLE}; pg8::StaticOrder S; S.init(NTOK, DM, G, bx); pg8::EpiBf16 E{PLEB, DM};
          pg8::gemm_phase<pg8::EpiBf16, pg8::StaticOrder, true, true>(lds, g, S, E); }
    }
    xcd_barrier(xb);
    {
        pg8::Gemm g{HB, WGATE, NTOK, DM, DM}; pg8::StaticOrder S; S.init(NTOK, DM, G, bx); pg8::EpiGate E{HB, H2B, PLEB, ss2, ss3};
        pg8::gemm_phase<pg8::EpiGate, pg8::StaticOrder, true, true>(lds, g, S, E);
    }
    xcd_barrier(xb);
    {
        const int tid5 = opaque_tid(), lane = tid5 & 63, wave = __builtin_amdgcn_readfirstlane(tid5 >> 6);
        const int gw = bx * 8 + wave, NGW = G * 8; const f32x4* gr = (const f32x4*)a.in[13];
        f32x4 gv[8];
#pragma unroll
        for (int j = 0; j < 4; ++j) { gv[2 * j] = gr[2 * (lane + 64 * j)]; gv[2 * j + 1] = gr[2 * (lane + 64 * j) + 1]; }
#define P5_LOAD(H, S_, m_) do { const u32x4* hrow_ = (const u32x4*)(H2B + (size_t)(m_) * DM); S_ = ss3[m_]; _Pragma("unroll") for (int j_ = 0; j_ < 4; ++j_) H[j_] = __builtin_nontemporal_load(&hrow_[lane + 64 * j_]); } while (0)
#define P5_STORE(H, S_, m_) do { const float rstd_ = rsqrtf(S_ * (1.f / DM) + NORM_EPS); f32x4* orow_ = (f32x4*)(out + (size_t)(m_) * DM); \
            _Pragma("unroll") for (int j_ = 0; j_ < 4; ++j_) { const int c_ = lane + 64 * j_; const u32x4 hw_ = H[j_]; const f32x4 g0_ = gv[2 * j_], g1_ = gv[2 * j_ + 1]; \
                orow_[2 * c_] = (f32x4){bf_lo(hw_.x) * rstd_ * g0_[0], bf_hi(hw_.x) * rstd_ * g0_[1], bf_lo(hw_.y) * rstd_ * g0_[2], bf_hi(hw_.y) * rstd_ * g0_[3]}; \
                orow_[2 * c_ + 1] = (f32x4){bf_lo(hw_.z) * rstd_ * g1_[0], bf_hi(hw_.z) * rstd_ * g1_[1], bf_lo(hw_.w) * rstd_ * g1_[2], bf_hi(hw_.w) * rstd_ * g1_[3]}; } } while (0)
        u32x4 ha[4], hb4[4]; float sa = 0.f, sb = 0.f;
        int m = gw;
        if (m < NTOK) P5_LOAD(ha, sa, m);
        for (; m < NTOK; m += 2 * NGW) {
            const int m1 = m + NGW, m2 = m + 2 * NGW;
            if (m1 < NTOK) P5_LOAD(hb4, sb, m1);
            P5_STORE(ha, sa, m);
            if (m2 < NTOK) P5_LOAD(ha, sa, m2);
            if (m1 < NTOK) P5_STORE(hb4, sb, m1);
        }
#undef P5_LOAD
#undef P5_STORE
    }
}

extern "C" void kernel_launch(void* const* d_in, const int* in_sizes, int n_in, void* d_out, int out_size, void* d_ws, size_t ws_size, hipStream_t stream) {
    static int grid = 0;
    if (grid == 0) {
        if (n_in != 14 || out_size != NTOK * DM || ws_size < WS_END) { fprintf(stderr, "kernel_launch: unexpected shapes (n_in %d out %d ws %zu)\n", n_in, out_size, ws_size); grid = -1; return; }
        int dev = 0, cus = 0, per_cu = 0;
        (void)hipGetDevice(&dev); (void)hipDeviceGetAttribute(&cus, hipDeviceAttributeMultiprocessorCount, dev);
        (void)hipFuncSetAttribute((const void*)fwd_megakernel, hipFuncAttributeMaxDynamicSharedMemorySize, LDS_BYTES);
        (void)hipOccupancyMaxActiveBlocksPerMultiprocessor(&per_cu, (const void*)fwd_megakernel, 512, LDS_BYTES);
        if (per_cu < 1) { fprintf(stderr, "kernel_launch: occupancy query says %d blocks/CU\n", per_cu); per_cu = 1; }
        grid = cus * per_cu;
    }
    if (grid < 0) return;
    Args a{};
    for (int i = 0; i < 14; ++i) a.in[i] = (const float*)d_in[i];
    a.out = (float*)d_out; a.ws = (unsigned char*)d_ws;
    (void)hipMemsetAsync((unsigned char*)d_ws + WS_CTL + CTL_BAR, 0, CTL_BAR_BYTES, stream);
    void* args[] = {&a};
    hipError_t e = hipLaunchCooperativeKernel((void*)fwd_megakernel, dim3(grid), dim3(512), args, LDS_BYTES, stream);
    if (e != hipSuccess) fprintf(stderr, "cooperative launch failed: %s (grid %d)\n", hipGetErrorString(e), grid);
}
```

```cpp
#include <hip/hip_runtime.h>
#include <hip/hip_cooperative_groups.h>
#include <cstdio>
#include <cstdint>
namespace cg = cooperative_groups;
__device__ __forceinline__ int opaque_tid() { int t = (int)threadIdx.x; asm volatile("" : "+v"(t)); return t; }
namespace pg8 {
#define PG8_LAS __attribute__((address_space(3)))
typedef unsigned short bf16_t;
typedef short bf16x8 __attribute__((ext_vector_type(8)));
typedef float f32x4 __attribute__((ext_vector_type(4)));
typedef unsigned u32x4 __attribute__((ext_vector_type(4)));
constexpr int BM = 256, BK = 64, HALF = 128, HTB = HALF * BK * 2  , STAGE_BYTES = 8 * HTB, NXCD = 8, WGM = 8;

__host__ __device__ __forceinline__ int lds_byte(int r, int c) { const int st = (r >> 4) * 2 + (c >> 5), rr = r & 15, cc = c & 31, ob = rr * 64 + cc * 2; return st * 1024 + (ob ^ (((ob >> 9) & 1) << 5)); }
__host__ __device__ __forceinline__ void stage_rc(int b, int& R, int& C) { const int st = b / 1024, sb = b % 1024, swz = sb ^ (((sb >> 9) & 1) << 5); R = (st >> 1) * 16 + swz / 64; C = (st & 1) * 32 + (swz % 64) / 2; }
__host__ __device__ __forceinline__ int perm32(int rho) { const int n = rho >> 4, i = rho & 15; return 8 * (i >> 2) + 4 * n + (i & 3); }

struct Unit { int pm, pn; };
struct Gemm { const bf16_t* A; const bf16_t* Bt; int M, N, K; };

struct StaticOrder {
    int nM, nN, nwg, G, c;
    __host__ __device__ void init(int M, int N, int G_, int c_) { nM = M / BM; nN = N / BM; nwg = nM * nN; G = G_; c = c_; }
    __host__ __device__ bool next(int i, Unit& u) const {
        const long L = (long)i * G + c; if (L >= nwg) return false;
        int wgid = (int)L; { const int q = nwg / NXCD, r = nwg % NXCD, xcd = wgid % NXCD, off = wgid / NXCD; wgid = (xcd < r ? xcd * (q + 1) : r * (q + 1) + (xcd - r) * q) + off; }
        const int nig = WGM * nN, gid = wgid / nig, fm = gid * WGM, gsz = (nM - fm) < WGM ? (nM - fm) : WGM;
        u.pm = fm + ((wgid % nig) % gsz); u.pn = (wgid % nig) / gsz; return true;
    }
    __device__ __forceinline__ void a_ready(const Unit&) const {}
    __device__ __forceinline__ void done(const Unit&) const {}
};

__device__ __forceinline__ unsigned cvt_pk_bf16(float lo, float hi) { unsigned r; asm volatile("v_cvt_pk_bf16_f32 %0, %1, %2" : "=v"(r) : "v"(lo), "v"(hi)); return r; }
typedef float f32x2 __attribute__((ext_vector_type(2)));
template <class Epi, class Sched, bool ALIGN_EPI = false, bool SP2 = false>
__device__ __forceinline__ void gemm_phase(PG8_LAS unsigned char* lds, const Gemm g, const Sched& S, const Epi& E) {
    const int tid = opaque_tid(), wid = __builtin_amdgcn_readfirstlane(tid >> 6), lane = tid & 63, wr = wid >> 2, wc = wid & 3, fr = lane & 15, fq = lane >> 4;
    const int K = g.K, nt = K / BK;
    unsigned voffA[2], voffB[2];
#pragma unroll
    for (int i = 0; i < 2; ++i) { int R, C; stage_rc(tid * 16 + i * 8192, R, C); const int Rb = Epi::PERM ? ((R & ~31) + perm32(R & 31)) : R;
        voffA[i] = (unsigned)(R * K + C) * 2u; voffB[i] = (unsigned)(Rb * K + C) * 2u; }
    const size_t kstep = (size_t)(BK * 2);
    const size_t hstep = (size_t)HALF * K * 2;
    const size_t tstep = 2 * hstep;
    const unsigned ldsw = (unsigned)wid * 1024u;
    const int aoff = lds_byte(wr * 64 + fr, fq * 8), boff = lds_byte(wc * 32 + fr, fq * 8);
#define PG8_SA(b, h) (((b) * 2 + (h)) * HTB)
#define PG8_SB(b, h) ((4 + (b) * 2 + (h)) * HTB)
#define PG8_STAGE(bufoff, gbase, voff) do { _Pragma("unroll") for (int _i = 0; _i < 2; ++_i) \
        __builtin_amdgcn_global_load_lds((const unsigned*)((const char*)(gbase) + (voff)[_i]), (PG8_LAS unsigned*)(lds + (bufoff) + ldsw + _i * 8192), 16, 0, 0); } while (0)
#define PG8_LDA(dst, b, h) do { _Pragma("unroll") for (int m = 0; m < 4; ++m) _Pragma("unroll") for (int k = 0; k < 2; ++k) dst[m][k] = *(const PG8_LAS bf16x8*)(lds + PG8_SA(b, h) + aoff + m * 2048 + k * 1024); } while (0)
#define PG8_LDB(dst, b, h) do { _Pragma("unroll") for (int n = 0; n < 2; ++n) _Pragma("unroll") for (int k = 0; k < 2; ++k) dst[n][k] = *(const PG8_LAS bf16x8*)(lds + PG8_SB(b, h) + boff + n * 2048 + k * 1024); } while (0)
#define PG8_MMA(ai, bj, At, Bt) do { __builtin_amdgcn_s_setprio(1); _Pragma("unroll") for (int m = 0; m < 4; ++m) _Pragma("unroll") for (int n = 0; n < 2; ++n) _Pragma("unroll") for (int k = 0; k < 2; ++k) \
        acc[ai][bj][m][n] = __builtin_amdgcn_mfma_f32_16x16x32_bf16(Bt[n][k], At[m][k], acc[ai][bj][m][n], 0, 0, 0); __builtin_amdgcn_s_setprio(0); } while (0)
#define PG8_WAIT_V(n) asm volatile("s_waitcnt vmcnt(" #n ")" ::: "memory")
#define PG8_WAIT_L(n) asm volatile("s_waitcnt lgkmcnt(" #n ")" ::: "memory")
#define PG8_BAR __builtin_amdgcn_s_barrier()
#define PG8_SCHED __builtin_amdgcn_sched_barrier(0)
    Unit cur, nxt; int ui = 0;
    if (!S.next(0, cur)) return;
    f32x4 acc[2][2][4][2];
#pragma unroll
    for (int a = 0; a < 2; ++a)
#pragma unroll
        for (int b = 0; b < 2; ++b)
#pragma unroll
            for (int m = 0; m < 4; ++m)
#pragma unroll
                for (int n = 0; n < 2; ++n) acc[a][b][m][n] = (f32x4){0.f, 0.f, 0.f, 0.f};
    bf16x8 At[4][2], B0[2][2], B1[2][2];
    const char* cA = (const char*)g.A + (size_t)cur.pm * tstep; const char* cB = (const char*)g.Bt + (size_t)cur.pn * tstep;
    S.a_ready(cur);
    if constexpr (SP2) {
        PG8_STAGE(PG8_SB(0, 0), cB, voffB); PG8_STAGE(PG8_SB(0, 1), cB + hstep, voffB); PG8_STAGE(PG8_SA(0, 0), cA, voffA); PG8_STAGE(PG8_SA(0, 1), cA + hstep, voffA);
        if (wr == 1) PG8_BAR;
        PG8_WAIT_V(2); PG8_BAR;
        PG8_STAGE(PG8_SB(1, 0), cB + kstep, voffB); PG8_STAGE(PG8_SA(1, 0), cA + kstep, voffA); PG8_STAGE(PG8_SB(1, 1), cB + hstep + kstep, voffB);
        PG8_WAIT_V(6); PG8_BAR;
    } else {
        PG8_STAGE(PG8_SB(0, 0), cB, voffB); PG8_STAGE(PG8_SA(0, 0), cA, voffA); PG8_STAGE(PG8_SB(0, 1), cB + hstep, voffB); PG8_STAGE(PG8_SA(0, 1), cA + hstep, voffA);
        if (wr == 1) PG8_BAR;
        PG8_WAIT_V(4); PG8_BAR;
        PG8_STAGE(PG8_SB(1, 0), cB + kstep, voffB); PG8_STAGE(PG8_SA(1, 0), cA + kstep, voffA); PG8_STAGE(PG8_SB(1, 1), cB + hstep + kstep, voffB);
        PG8_WAIT_V(6); PG8_BAR;
    }
    for (;;) {
        const bool has_next = S.next(ui + 1, nxt);
        const char* nA = has_next ? (const char*)g.A + (size_t)nxt.pm * tstep : cA; const char* nB = has_next ? (const char*)g.Bt + (size_t)nxt.pn * tstep : cB;
        for (int t = 0; t < nt; t += 2) {
            const bool last = (t == nt - 2);
            const char* a1 = cA + (size_t)(t + 1) * kstep;
            const char* a2 = last ? nA : cA + (size_t)(t + 2) * kstep; const char* b2 = last ? nB : cB + (size_t)(t + 2) * kstep;
            const char* a3 = a2 + kstep; const char* b3 = b2 + kstep;
            if (last && has_next) S.a_ready(nxt);
            if constexpr (SP2) {
            PG8_LDB(B0, 0, 0); PG8_LDB(B1, 0, 1); PG8_SCHED; PG8_LDA(At, 0, 0); PG8_STAGE(PG8_SA(1, 1), a1 + hstep, voffA);
            PG8_WAIT_V(8); PG8_WAIT_L(0); PG8_BAR; PG8_MMA(0, 0, At, B0); PG8_MMA(0, 1, At, B1); PG8_BAR; PG8_SCHED;
            PG8_LDA(At, 0, 1); PG8_STAGE(PG8_SB(0, 0), b2, voffB); PG8_STAGE(PG8_SB(0, 1), b2 + hstep, voffB); PG8_STAGE(PG8_SA(0, 0), a2, voffA);
            PG8_WAIT_V(8); PG8_WAIT_L(0); PG8_BAR; PG8_MMA(1, 0, At, B0); PG8_MMA(1, 1, At, B1); PG8_BAR; PG8_SCHED;
            PG8_LDB(B0, 1, 0); PG8_LDB(B1, 1, 1); PG8_SCHED; PG8_LDA(At, 1, 0); PG8_STAGE(PG8_SA(0, 1), a2 + hstep, voffA);
            PG8_WAIT_V(8); PG8_WAIT_L(0); PG8_BAR; PG8_MMA(0, 0, At, B0); PG8_MMA(0, 1, At, B1); PG8_BAR; PG8_SCHED;
            PG8_LDA(At, 1, 1); PG8_STAGE(PG8_SB(1, 0), b3, voffB); PG8_STAGE(PG8_SB(1, 1), b3 + hstep, voffB); PG8_STAGE(PG8_SA(1, 0), a3, voffA);
            PG8_WAIT_V(8); PG8_WAIT_L(0); PG8_BAR; PG8_MMA(1, 0, At, B0); PG8_MMA(1, 1, At, B1); PG8_BAR; PG8_SCHED;
            } else {
            PG8_LDB(B0, 0, 0); PG8_SCHED; PG8_LDA(At, 0, 0); PG8_STAGE(PG8_SA(1, 1), a1 + hstep, voffA);
            PG8_WAIT_L(8); PG8_BAR; PG8_WAIT_L(0); PG8_MMA(0, 0, At, B0); PG8_BAR; PG8_SCHED;
            PG8_LDB(B1, 0, 1); PG8_STAGE(PG8_SB(0, 0), b2, voffB);
            PG8_BAR; PG8_WAIT_L(0); PG8_MMA(0, 1, At, B1); PG8_BAR;
            PG8_LDA(At, 0, 1); PG8_STAGE(PG8_SA(0, 0), a2, voffA);
            PG8_BAR; PG8_WAIT_L(0); PG8_MMA(1, 0, At, B0); PG8_BAR; PG8_SCHED;
            PG8_STAGE(PG8_SB(0, 1), b2 + hstep, voffB);
            PG8_WAIT_V(6); PG8_BAR; PG8_MMA(1, 1, At, B1); PG8_BAR;
            PG8_LDB(B0, 1, 0); PG8_SCHED; PG8_LDA(At, 1, 0); PG8_STAGE(PG8_SA(0, 1), a2 + hstep, voffA);
            PG8_WAIT_L(8); PG8_BAR; PG8_WAIT_L(0); PG8_MMA(0, 0, At, B0); PG8_BAR; PG8_SCHED;
            PG8_LDB(B1, 1, 1); PG8_STAGE(PG8_SB(1, 0), b3, voffB);
            PG8_BAR; PG8_WAIT_L(0); PG8_MMA(0, 1, At, B1); PG8_BAR;
            PG8_LDA(At, 1, 1); PG8_STAGE(PG8_SA(1, 0), a3, voffA);
            PG8_BAR; PG8_WAIT_L(0); PG8_MMA(1, 0, At, B0); PG8_BAR; PG8_SCHED;
            PG8_STAGE(PG8_SB(1, 1), b3 + hstep, voffB);
            PG8_WAIT_V(6); PG8_BAR; PG8_MMA(1, 1, At, B1); PG8_BAR;
            }
        }
        if constexpr (ALIGN_EPI) { if (wr == 0) PG8_BAR; }
        if constexpr (!Epi::AFTER_DRAIN) { E(acc, cur, wr, wc, fr, fq); S.done(cur); }
        if (!has_next) break;
#pragma unroll
        for (int a = 0; a < 2; ++a)
#pragma unroll
            for (int b = 0; b < 2; ++b)
#pragma unroll
                for (int m = 0; m < 4; ++m)
#pragma unroll
                    for (int n = 0; n < 2; ++n) acc[a][b][m][n] = (f32x4){0.f, 0.f, 0.f, 0.f};
        cur = nxt; cA = nA; cB = nB; ++ui;
        if constexpr (ALIGN_EPI) { if (wr == 1) PG8_BAR; }
    }
    PG8_WAIT_V(0);
    if constexpr (!ALIGN_EPI) { if (wr == 0) PG8_BAR; }
    PG8_BAR;
    if constexpr (Epi::AFTER_DRAIN) { E.fused(acc, cur, wr, wc, fr, fq, lds, wid, lane); S.done(cur); }
#undef PG8_SA
#undef PG8_SB
#undef PG8_STAGE
#undef PG8_LDA
#undef PG8_LDB
#undef PG8_MMA
#undef PG8_WAIT_V
#undef PG8_WAIT_L
#undef PG8_BAR
#undef PG8_SCHED
}
}
#define LAS __attribute__((address_space(3)))
typedef unsigned short bf16_t;
typedef short bf16x8 __attribute__((ext_vector_type(8)));
typedef float f32x4 __attribute__((ext_vector_type(4)));
typedef float f32x2 __attribute__((ext_vector_type(2)));
typedef float f32x16 __attribute__((ext_vector_type(16)));
typedef unsigned u32x4 __attribute__((ext_vector_type(4)));
typedef unsigned u32x2 __attribute__((ext_vector_type(2)));

constexpr int NTOK = 16384, DM = 2048, SEQ = 2048, NBATCH = 8, PLE = 256;
constexpr int NPROJ = 6144;
constexpr int PQ_SB = 0, PK_SB = 1024, PG_SB = 2048, PQ_DF = 3072, PK_DF = 4096, PG_DF = 5120;
constexpr float LOG2E = 1.4426950408889634f;
constexpr float SBQ_SCALE = 0.08838834764831845f * LOG2E;
constexpr float DFQ_SCALE = 0.125f * LOG2E;
constexpr float NORM_EPS = 1e-6f, SUBLN_EPS = 1e-5f;
constexpr float LAMBDA_INIT = 0.2f;

constexpr size_t MiB = 1u << 20;
constexpr size_t WS_CTL = 0;
constexpr size_t CTL_SS2 = 0, CTL_SS3 = 65536, CTL_LAM = 131072, CTL_ROPE = 262144, CTL_BAR = 524288, CTL_BAR_BYTES = 16384;
constexpr size_t WS_WIN = 2 * MiB, WS_WOUT = 34 * MiB, WS_WGATE = 42 * MiB, WS_WPROJ = 50 * MiB, WS_PB = 52 * MiB;
constexpr size_t WS_XN = 64 * MiB, WS_MIXED = 64 * MiB;
constexpr size_t WS_PROJ = 128 * MiB, WS_VT = 320 * MiB, WS_KIMG = 384 * MiB, WS_END = 448 * MiB;
constexpr size_t WS_HB = 128 * MiB, WS_PLE = 192 * MiB;
constexpr size_t WS_H2B = 64 * MiB;

constexpr int LDS_BYTES = 131072 + 1024;

typedef __bf16 bf16x2_t __attribute__((ext_vector_type(2)));
__device__ __forceinline__ unsigned cvt_pk(float lo, float hi) { f32x2 v = {lo, hi}; bf16x2_t b = __builtin_convertvector(v, bf16x2_t); return __builtin_bit_cast(unsigned, b); }
__device__ __forceinline__ float bf_lo(unsigned w) { return __uint_as_float(w << 16); }
__device__ __forceinline__ float bf_hi(unsigned w) { return __uint_as_float(w & 0xffff0000u); }
__device__ __forceinline__ float wave_sum(float v) {
#pragma unroll
    for (int o = 1; o < 64; o <<= 1) v += __shfl_xor(v, o);
    return v;
}
__device__ __forceinline__ float fast_exp2(float x) { return __builtin_amdgcn_exp2f(x); }
__device__ __forceinline__ float fast_log2(float x) { return __builtin_amdgcn_logf(x); }
__device__ __forceinline__ float silu_f(float x) { return x * __builtin_amdgcn_rcpf(1.f + fast_exp2(-x * LOG2E)); }
__device__ __forceinline__ float sigmoid_f(float x) { return __builtin_amdgcn_rcpf(1.f + fast_exp2(-x * LOG2E)); }

namespace pg8 {
struct EpiBf16 {
    static constexpr bool PERM = true, AFTER_DRAIN = false;
    bf16_t* O; int ldc;
    __device__ __forceinline__ void operator()(const f32x4 (&acc)[2][2][4][2], const Unit& u, int wr, int wc, int fr, int fq) const {
        const int row0 = u.pm * BM + wr * 64 + fr; const int col0 = u.pn * BM + wc * 32 + 8 * fq;
#pragma unroll
        for (int ai = 0; ai < 2; ++ai)
#pragma unroll
            for (int m = 0; m < 4; ++m) { bf16_t* rowp = O + (size_t)(row0 + ai * HALF + m * 16) * ldc + col0;
#pragma unroll
                for (int bj = 0; bj < 2; ++bj) { const f32x4 v0 = acc[ai][bj][m][0], v1 = acc[ai][bj][m][1];
                    u32x4 w; w.x = cvt_pk_bf16(v0[0], v0[1]); w.y = cvt_pk_bf16(v0[2], v0[3]); w.z = cvt_pk_bf16(v1[0], v1[1]); w.w = cvt_pk_bf16(v1[2], v1[3]);
                    *(u32x4*)(rowp + bj * HALF) = w; } }
    }
};
struct EpiProj {
    static constexpr bool PERM = true, AFTER_DRAIN = false;
    bf16_t* O; const float* rope; bf16_t* KI;
    __device__ __forceinline__ void operator()(const f32x4 (&acc)[2][2][4][2], const Unit& u, int wr, int wc, int fr, int fq) const {
        const int row0 = u.pm * BM + wr * 64 + fr; const int col0 = u.pn * BM + wc * 32 + 8 * fq;
        const int kind = u.pn >> 2;
        const bool dorope = (kind == 3 || kind == 4) && ((wc & 1) == 0) && (fq < 2);
        const float sc = kind == 0 ? SBQ_SCALE : (kind == 3 ? DFQ_SCALE : 1.f);
        const bool dosilu = (kind == 2 || kind == 5);
#pragma unroll
        for (int ai = 0; ai < 2; ++ai)
#pragma unroll
            for (int m = 0; m < 4; ++m) { const int row = row0 + ai * HALF + m * 16; bf16_t* rowp = O + (size_t)row * NPROJ + col0;
                if (kind == 1 || kind == 4) {
                    const int cw = col0 & 1023; rowp = KI + ((size_t)(((kind == 4 ? 8 : 0) + (row >> 11)) * 8 + (cw >> 7)) * SEQ + (row & (SEQ - 1))) * 128 + (cw & 127); }
                f32x4 cs0 = {1.f, 0.f, 1.f, 0.f}, cs1 = {1.f, 0.f, 1.f, 0.f};
                if (dorope) { const f32x4* rp = (const f32x4*)(rope + ((size_t)(row & (SEQ - 1)) * 8 + 4 * fq) * 2); cs0 = rp[0]; cs1 = rp[1]; }
#pragma unroll
                for (int bj = 0; bj < 2; ++bj) { f32x4 v0 = acc[ai][bj][m][0], v1 = acc[ai][bj][m][1];
                    if (dorope) {
                        f32x4 a, b;
                        a[0] = v0[0] * cs0[0] - v0[1] * cs0[1]; a[1] = v0[1] * cs0[0] + v0[0] * cs0[1];
                        a[2] = v0[2] * cs0[2] - v0[3] * cs0[3]; a[3] = v0[3] * cs0[2] + v0[2] * cs0[3];
                        b[0] = v1[0] * cs1[0] - v1[1] * cs1[1]; b[1] = v1[1] * cs1[0] + v1[0] * cs1[1];
                        b[2] = v1[2] * cs1[2] - v1[3] * cs1[3]; b[3] = v1[3] * cs1[2] + v1[2] * cs1[3];
                        v0 = a; v1 = b; }
                    if (dosilu) {
#pragma unroll
                        for (int j = 0; j < 4; ++j) { v0[j] = silu_f(v0[j]); v1[j] = silu_f(v1[j]); } }
                    v0 = v0 * sc; v1 = v1 * sc;
                    u32x4 w; w.x = cvt_pk_bf16(v0[0], v0[1]); w.y = cvt_pk_bf16(v0[2], v0[3]); w.z = cvt_pk_bf16(v1[0], v1[1]); w.w = cvt_pk_bf16(v1[2], v1[3]);
                    *(u32x4*)(rowp + ((kind == 1 || kind == 4) ? bj * SEQ * 128 : bj * HALF)) = w; } }
    }
};
struct EpiVt {
    static constexpr bool PERM = true, AFTER_DRAIN = false;
    bf16_t* O;
    __device__ __forceinline__ void operator()(const f32x4 (&acc)[2][2][4][2], const Unit& u, int wr, int wc, int fr, int fq) const {
        const int row0 = u.pm * BM + wr * 64 + fr; const int col0 = u.pn * BM + wc * 32 + 8 * fq;
        const int p0 = (fq & 1) ? 4 : 0, p1 = (fq & 1) ? 12 : 8;
#pragma unroll
        for (int ai = 0; ai < 2; ++ai)
#pragma unroll
            for (int m = 0; m < 4; ++m) { const int row = row0 + ai * HALF + m * 16; const int gh = row >> 7, d = row & 127;
#pragma unroll
                for (int bj = 0; bj < 2; ++bj) { const int col = col0 + bj * HALF; const int b = col >> 11, sq = col & (SEQ - 1);
                    bf16_t* tp = O + ((size_t)((((gh >> 3) * 8 + b) * 8 + (gh & 7)) * 32 + (sq >> 6)) * 128 + d) * 64 + (sq & 48);
                    const f32x4 v0 = acc[ai][bj][m][0], v1 = acc[ai][bj][m][1];
                    u32x2 w0, w1; w0.x = cvt_pk_bf16(v0[0], v0[1]); w0.y = cvt_pk_bf16(v0[2], v0[3]); w1.x = cvt_pk_bf16(v1[0], v1[1]); w1.y = cvt_pk_bf16(v1[2], v1[3]);
                    *(u32x2*)(tp + p0) = w0; *(u32x2*)(tp + p1) = w1; } }
    }
};
struct EpiRes {
    static constexpr bool PERM = true, AFTER_DRAIN = false;
    const float* x; bf16_t* hb; float* ss;
    __device__ __forceinline__ void operator()(const f32x4 (&acc)[2][2][4][2], const Unit& u, int wr, int wc, int fr, int fq) const {
        const int row0 = u.pm * BM + wr * 64 + fr; const int col0 = u.pn * BM + wc * 32 + 8 * fq;
#pragma unroll
        for (int ai = 0; ai < 2; ++ai)
#pragma unroll
            for (int m = 0; m < 4; ++m) { const int row = row0 + ai * HALF + m * 16; const size_t off = (size_t)row * DM + col0; float q = 0.f;
#pragma unroll
                for (int bj = 0; bj < 2; ++bj) { const size_t o2 = off + bj * HALF;
                    const f32x4 h0 = __builtin_nontemporal_load((const f32x4*)(x + o2)) + acc[ai][bj][m][0], h1 = __builtin_nontemporal_load((const f32x4*)(x + o2 + 4)) + acc[ai][bj][m][1];
                    u32x4 w; w.x = cvt_pk_bf16(h0[0], h0[1]); w.y = cvt_pk_bf16(h0[2], h0[3]); w.z = cvt_pk_bf16(h1[0], h1[1]); w.w = cvt_pk_bf16(h1[2], h1[3]);
                    *(u32x4*)(hb + o2) = w;
                    q += ((h0[0] * h0[0] + h0[1] * h0[1]) + (h0[2] * h0[2] + h0[3] * h0[3])) + ((h1[0] * h1[0] + h1[1] * h1[1]) + (h1[2] * h1[2] + h1[3] * h1[3])); }
                q += __shfl_xor(q, 16); q += __shfl_xor(q, 32);
                if (fq == 0) atomicAdd(ss + row, q); }
    }
};
struct EpiGate {
    static constexpr bool PERM = true, AFTER_DRAIN = false;
    const bf16_t* hb; bf16_t* h2b; const bf16_t* ple; const float* ss2; float* ss3;
    __device__ __forceinline__ void operator()(const f32x4 (&acc)[2][2][4][2], const Unit& u, int wr, int wc, int fr, int fq) const {
        const int row0 = u.pm * BM + wr * 64 + fr; const int col0 = u.pn * BM + wc * 32 + 8 * fq;
#pragma unroll
        for (int ai = 0; ai < 2; ++ai)
#pragma unroll
            for (int m = 0; m < 4; ++m) { const int row = row0 + ai * HALF + m * 16; const size_t off = (size_t)row * DM + col0; float q = 0.f;
                const float rstd = rsqrtf(ss2[row] * (1.f / DM) + NORM_EPS);
#pragma unroll
                for (int bj = 0; bj < 2; ++bj) { const size_t o2 = off + bj * HALF; const u32x4 hw = *(const u32x4*)(hb + o2); const u32x4 pw = *(const u32x4*)(ple + o2);
                    const f32x4 a0 = acc[ai][bj][m][0] * rstd, a1 = acc[ai][bj][m][1] * rstd; f32x4 g0, g1;
                    g0[0] = bf_lo(hw.x) + sigmoid_f(a0[0]) * bf_lo(pw.x); g0[1] = bf_hi(hw.x) + sigmoid_f(a0[1]) * bf_hi(pw.x);
                    g0[2] = bf_lo(hw.y) + sigmoid_f(a0[2]) * bf_lo(pw.y); g0[3] = bf_hi(hw.y) + sigmoid_f(a0[3]) * bf_hi(pw.y);
                    g1[0] = bf_lo(hw.z) + sigmoid_f(a1[0]) * bf_lo(pw.z); g1[1] = bf_hi(hw.z) + sigmoid_f(a1[1]) * bf_hi(pw.z);
                    g1[2] = bf_lo(hw.w) + sigmoid_f(a1[2]) * bf_lo(pw.w); g1[3] = bf_hi(hw.w) + sigmoid_f(a1[3]) * bf_hi(pw.w);
                    u32x4 w2; w2.x = cvt_pk_bf16(g0[0], g0[1]); w2.y = cvt_pk_bf16(g0[2], g0[3]); w2.z = cvt_pk_bf16(g1[0], g1[1]); w2.w = cvt_pk_bf16(g1[2], g1[3]);
                    *(u32x4*)(h2b + o2) = w2;
                    q += ((g0[0] * g0[0] + g0[1] * g0[1]) + (g0[2] * g0[2] + g0[3] * g0[3])) + ((g1[0] * g1[0] + g1[1] * g1[1]) + (g1[2] * g1[2] + g1[3] * g1[3])); }
                q += __shfl_xor(q, 16); q += __shfl_xor(q, 32);
                if (fq == 0) atomicAdd(ss3 + row, q); }
    }
};
}
namespace att {
constexpr int KP = 272, VP = 144, KT_BYTES = 64 * KP, VT_BYTES = 128 * VP, BUF_BYTES = KT_BYTES + VT_BYTES;
constexpr int FLAG_OFF = 2 * BUF_BYTES;
constexpr int XP = 132;
constexpr float R_DONE = 152.0f;

template <bool MASK>
__device__ __forceinline__ void sb_block(const f32x16& sv, int kbase, int tq, int h, float& R, bf16x8 (&pf)[2]) {
    float c[16], z[16];
#pragma unroll
    for (int i = 0; i < 16; ++i) {
        z[i] = (!MASK || (kbase + 8 * (i >> 2) + (i & 3) < tq)) ? sv[i] : -1e30f;
        c[i] = fmaxf(z[i], 0.f) + fast_log2(1.f + fast_exp2(-fabsf(z[i])));
    }
    float T[4], OT[4], pr[4], suf[4];
#pragma unroll
    for (int g = 0; g < 4; ++g) { c[4 * g + 2] += c[4 * g + 3]; c[4 * g + 1] += c[4 * g + 2]; c[4 * g] += c[4 * g + 1]; T[g] = c[4 * g]; }
#pragma unroll
    for (int g = 0; g < 4; ++g) { OT[g] = __shfl_xor(T[g], 32); pr[g] = T[g] + OT[g]; }
    suf[3] = 0.f; suf[2] = pr[3]; suf[1] = suf[2] + pr[2]; suf[0] = suf[1] + pr[1];
    float w[16];
#pragma unroll
    for (int g = 0; g < 4; ++g) { const float off = R + suf[g] + (h == 0 ? OT[g] : 0.f);
#pragma unroll
        for (int j = 0; j < 4; ++j) { const int i = 4 * g + j; w[i] = fast_exp2(z[i] - (off + c[i])); } }
    R += suf[0] + pr[0];
#pragma unroll
    for (int sp = 0; sp < 2; ++sp) { u32x4 p; p.x = cvt_pk(w[8 * sp], w[8 * sp + 1]); p.y = cvt_pk(w[8 * sp + 2], w[8 * sp + 3]); p.z = cvt_pk(w[8 * sp + 4], w[8 * sp + 5]); p.w = cvt_pk(w[8 * sp + 6], w[8 * sp + 7]);
        pf[sp] = __builtin_bit_cast(bf16x8, p); }
}

template <int MODE>
__device__ __forceinline__ void attn_unit(LAS unsigned char* lds, const bf16_t* __restrict__ PROJ, const bf16_t* __restrict__ KIMG, const bf16_t* __restrict__ VT, bf16_t* __restrict__ MIXED,
                                          int b, int hh, int qblk, float lam, const float* __restrict__ subln_g) {
    constexpr int QB = MODE == 0 ? 256 : 128;
    constexpr int NKS = MODE == 0 ? 8 : 4;
    const int tid = opaque_tid(), lane = tid & 63, r = lane & 31, h = lane >> 5;
    const int wid = __builtin_amdgcn_readfirstlane(tid >> 6);
    const int qg = MODE == 0 ? wid : (wid & 3), role = MODE == 0 ? 0 : (wid >> 2);
    const int Q0 = qblk * QB, q0w = Q0 + 32 * qg, tq = q0w + r;
    const size_t tokbase = (size_t)b * SEQ;
    const int gbh = ((MODE == 0 ? 0 : 8) + b) * 8 + hh;
    const bf16_t* Kg = KIMG + (size_t)gbh * SEQ * 128;
    const bf16_t* Vg = VT + (size_t)gbh * 32 * 8192;
    bf16x8 qf[NKS];
    { const bf16_t* qp = PROJ + (tokbase + tq) * NPROJ + (MODE == 0 ? PQ_SB + hh * 128 : PQ_DF + hh * 128 + role * 64) + 8 * h;
#pragma unroll
      for (int ks = 0; ks < NKS; ++ks) qf[ks] = *(const bf16x8*)(qp + 16 * ks); }
    f32x16 o[4];
#pragma unroll
    for (int d = 0; d < 4; ++d)
#pragma unroll
        for (int i = 0; i < 16; ++i) o[d][i] = 0.f;
    float R = 0.f, m_run = -1e30f, l_run = 0.f;
    const int kr0 = tid >> 4, kc = tid & 15, vr0 = tid >> 3, vc = tid & 7;
    const int kst = kr0 * KP + kc * 16, vst = KT_BYTES + vr0 * VP + vc * 16;
    const bf16_t* kgl = Kg + tid * 8;
    const bf16_t* vgl = Vg + tid * 8;
    u32x4 kreg[2], vreg[2];
#define ATT_LOAD(t) do { _Pragma("unroll") for (int i_ = 0; i_ < 2; ++i_) { \
        kreg[i_] = *(const u32x4*)(kgl + (size_t)(t) * 8192 + i_ * 4096); \
        vreg[i_] = *(const u32x4*)(vgl + (size_t)(t) * 8192 + i_ * 4096); } } while (0)
#define ATT_STORE(bo) do { _Pragma("unroll") for (int i_ = 0; i_ < 2; ++i_) { \
        *(LAS u32x4*)(lds + (bo) + kst + i_ * 32 * KP) = kreg[i_]; \
        *(LAS u32x4*)(lds + (bo) + vst + i_ * 64 * VP) = vreg[i_]; } } while (0)
    const int tl = (Q0 + QB - 1) >> 6;
    const int kfrag = r * KP + (role * 64 + 8 * h) * 2;
    const int vfrag = KT_BYTES + r * VP + (8 * h) * 2;
    volatile LAS int* flags = (volatile LAS int*)(lds + FLAG_OFF);
    __syncthreads();
    ATT_LOAD(tl); ATT_STORE(0);
    __syncthreads();
    int cur = 0, it = 0;
    bool wdone = false;
    for (int t = tl;; --t, ++it) {
        if (t > 0) ATT_LOAD(t - 1);
        const int k0 = 64 * t;
        const bool active = (MODE == 0) ? (!wdone && k0 <= q0w + 30) : (k0 <= q0w + 31);
        if (active) {
            const int bo = cur * BUF_BYTES;
            f32x16 s[2];
            bf16x8 vf[4][2][2];
            if (MODE == 1) {
                bf16x8 kf[2][NKS];
#pragma unroll
                for (int kb = 0; kb < 2; ++kb)
#pragma unroll
                    for (int ks = 0; ks < NKS; ++ks) kf[kb][ks] = *(const LAS bf16x8*)(lds + bo + kfrag + kb * 32 * KP + ks * 32);
                __builtin_amdgcn_sched_barrier(0);
#pragma unroll
                for (int kb = 0; kb < 2; ++kb) {
#pragma unroll
                    for (int i = 0; i < 16; ++i) s[kb][i] = 0.f;
#pragma unroll
                    for (int ks = 0; ks < NKS; ++ks) s[kb] = __builtin_amdgcn_mfma_f32_32x32x16_bf16(kf[kb][ks], qf[ks], s[kb], 0, 0, 0);
                }
                __builtin_amdgcn_sched_barrier(0);
#pragma unroll
                for (int d = 0; d < 2; ++d)
#pragma unroll
                    for (int kb = 0; kb < 2; ++kb)
#pragma unroll
                        for (int sp = 0; sp < 2; ++sp) vf[d][kb][sp] = *(const LAS bf16x8*)(lds + bo + vfrag + d * 32 * VP + (32 * kb + 16 * sp) * 2);
                __builtin_amdgcn_sched_barrier(0);
            } else {
#pragma unroll
                for (int kb = 0; kb < 2; ++kb) {
#pragma unroll
                    for (int i = 0; i < 16; ++i) s[kb][i] = 0.f;
#pragma unroll
                    for (int ks = 0; ks < NKS; ++ks) {
                        const bf16x8 a = *(const LAS bf16x8*)(lds + bo + kfrag + kb * 32 * KP + ks * 32);
                        s[kb] = __builtin_amdgcn_mfma_f32_32x32x16_bf16(a, qf[ks], s[kb], 0, 0, 0);
                    }
                }
            }
            bf16x8 pf[2][2];
            if (MODE == 0) {
                sb_block<true>(s[1], k0 + 32 + 4 * h, tq, h, R, pf[1]);
                if (__all(R >= R_DONE)) {
#pragma unroll
                    for (int sp = 0; sp < 2; ++sp)
#pragma unroll
                        for (int j = 0; j < 8; ++j) pf[0][sp][j] = 0;
                } else sb_block<true>(s[0], k0 + 4 * h, tq, h, R, pf[0]);
                wdone = __all(R >= R_DONE);
            } else {
                float mx = -1e30f;
                if (k0 + 63 > q0w) {
#pragma unroll
                    for (int kb = 0; kb < 2; ++kb) { const int kbase = k0 + 32 * kb + 4 * h;
#pragma unroll
                        for (int i = 0; i < 16; ++i) { const int key = kbase + 8 * (i >> 2) + (i & 3); const float v = (key <= tq) ? s[kb][i] : -1e30f; s[kb][i] = v; mx = fmaxf(mx, v); } }
                } else {
#pragma unroll
                    for (int kb = 0; kb < 2; ++kb)
#pragma unroll
                        for (int i = 0; i < 16; ++i) mx = fmaxf(mx, s[kb][i]);
                }
                mx = fmaxf(mx, __shfl_xor(mx, 32));
                const float m_new = fmaxf(m_run, mx), alpha = fast_exp2(m_run - m_new);
                m_run = m_new;
                float ls = 0.f;
#pragma unroll
                for (int kb = 0; kb < 2; ++kb) {
#pragma unroll
                    for (int i = 0; i < 16; ++i) { const float p = fast_exp2(s[kb][i] - m_new); s[kb][i] = p; ls += p; }
#pragma unroll
                    for (int sp = 0; sp < 2; ++sp) { u32x4 p; p.x = cvt_pk(s[kb][8 * sp], s[kb][8 * sp + 1]); p.y = cvt_pk(s[kb][8 * sp + 2], s[kb][8 * sp + 3]); p.z = cvt_pk(s[kb][8 * sp + 4], s[kb][8 * sp + 5]); p.w = cvt_pk(s[kb][8 * sp + 6], s[kb][8 * sp + 7]);
                        pf[kb][sp] = __builtin_bit_cast(bf16x8, p); }
                }
                l_run = l_run * alpha + ls;
                if (!__all(alpha == 1.f)) {
#pragma unroll
                    for (int d = 0; d < 4; ++d)
#pragma unroll
                        for (int i = 0; i < 16; ++i) o[d][i] *= alpha;
                }
            }
            if (MODE == 1) {
                __builtin_amdgcn_sched_barrier(0);
#pragma unroll
                for (int d = 2; d < 4; ++d)
#pragma unroll
                    for (int kb = 0; kb < 2; ++kb)
#pragma unroll
                        for (int sp = 0; sp < 2; ++sp) vf[d][kb][sp] = *(const LAS bf16x8*)(lds + bo + vfrag + d * 32 * VP + (32 * kb + 16 * sp) * 2);
                __builtin_amdgcn_sched_barrier(0);
            }
#pragma unroll
            for (int d = 0; d < 4; ++d)
#pragma unroll
                for (int kb = 0; kb < 2; ++kb)
#pragma unroll
                    for (int sp = 0; sp < 2; ++sp) {
                        const bf16x8 a = (MODE == 1) ? vf[d][kb][sp] : *(const LAS bf16x8*)(lds + bo + vfrag + d * 32 * VP + (32 * kb + 16 * sp) * 2);
                        o[d] = __builtin_amdgcn_mfma_f32_32x32x16_bf16(a, pf[kb][sp], o[d], 0, 0, 0);
                    }
        }
        if (t > 0) ATT_STORE((cur ^ 1) * BUF_BYTES);
        if (MODE == 0) { if (lane == 0) flags[(it & 1) * 8 + wid] = wdone ? 1 : 0; }
        __syncthreads();
        if (t == 0) break;
        if (MODE == 0) { int alld = 1;
#pragma unroll
            for (int w2 = 0; w2 < 8; ++w2) alld &= flags[(it & 1) * 8 + w2];
            if (alld) break; }
        cur ^= 1;
    }
#undef ATT_LOAD
#undef ATT_STORE
    const int erow = lane >> 4, ech = lane & 15;
    const size_t tok0 = tokbase + q0w;
    if (MODE == 0 || role == 0) {
    }
    u32x4 gw[8];
    if (MODE == 0 || role == 0) {
        const bf16_t* gp = PROJ + (tok0 + erow) * NPROJ + (MODE == 0 ? PG_SB : PG_DF) + hh * 128 + ech * 8;
#pragma unroll
        for (int i = 0; i < 8; ++i) gw[i] = *(const u32x4*)(gp + (size_t)(4 * i) * NPROJ);
    }
    LAS unsigned char* stg = lds + (MODE == 0 ? wid * 8704 : 69632 + qg * 8704);
    if (MODE == 0) {
#pragma unroll
        for (int d = 0; d < 4; ++d)
#pragma unroll
            for (int g = 0; g < 4; ++g) { u32x2 w; w.x = cvt_pk(o[d][4 * g], o[d][4 * g + 1]); w.y = cvt_pk(o[d][4 * g + 2], o[d][4 * g + 3]);
                *(LAS u32x2*)(stg + r * 272 + (32 * d + 8 * g + 4 * h) * 2) = w; }
    } else {
        const float lt = l_run + __shfl_xor(l_run, 32);
        const float inv = 1.f / lt;
        LAS float* xq = (LAS float*)lds + (qg * 32 + r) * XP + 4 * h;
        if (role == 1) {
            const float f = inv * lam;
#pragma unroll
            for (int d = 0; d < 4; ++d)
#pragma unroll
                for (int g = 0; g < 4; ++g) *(LAS f32x4*)(xq + 32 * d + 8 * g) = (f32x4){o[d][4 * g] * f, o[d][4 * g + 1] * f, o[d][4 * g + 2] * f, o[d][4 * g + 3] * f};
        }
        __syncthreads();
        if (role == 0) {
            float q = 0.f;
#pragma unroll
            for (int d = 0; d < 4; ++d)
#pragma unroll
                for (int g = 0; g < 4; ++g) { const f32x4 x2 = *(const LAS f32x4*)(xq + 32 * d + 8 * g);
#pragma unroll
                    for (int j = 0; j < 4; ++j) { const float v = o[d][4 * g + j] * inv - x2[j]; o[d][4 * g + j] = v; q += v * v; } }
            q += __shfl_xor(q, 32);
            const float rs = rsqrtf(q * (1.f / 128.f) + SUBLN_EPS) * (1.f - LAMBDA_INIT);
            const float* sg = subln_g + 4 * h;
#pragma unroll
            for (int d = 0; d < 4; ++d)
#pragma unroll
                for (int g = 0; g < 4; ++g) { const f32x4 sv = *(const f32x4*)(sg + 32 * d + 8 * g);
                    u32x2 w; w.x = cvt_pk(o[d][4 * g] * rs * sv[0], o[d][4 * g + 1] * rs * sv[1]); w.y = cvt_pk(o[d][4 * g + 2] * rs * sv[2], o[d][4 * g + 3] * rs * sv[3]);
                    *(LAS u32x2*)(stg + r * 272 + (32 * d + 8 * g + 4 * h) * 2) = w; }
        }
    }
    if (MODE == 0 || role == 0) {
        asm volatile("s_waitcnt lgkmcnt(0)" ::: "memory");
        bf16_t* op = MIXED + (tok0 + erow) * DM + (MODE == 0 ? 0 : 1024) + hh * 128 + ech * 8;
#pragma unroll
        for (int i = 0; i < 8; ++i) { const u32x4 ov = *(const LAS u32x4*)(stg + (4 * i + erow) * 272 + ech * 16); const u32x4 g4 = gw[i];
            u32x4 w; w.x = cvt_pk(bf_lo(ov.x) * bf_lo(g4.x), bf_hi(ov.x) * bf_hi(g4.x)); w.y = cvt_pk(bf_lo(ov.y) * bf_lo(g4.y), bf_hi(ov.y) * bf_hi(g4.y));
            w.z = cvt_pk(bf_lo(ov.z) * bf_lo(g4.z), bf_hi(ov.z) * bf_hi(g4.z)); w.w = cvt_pk(bf_lo(ov.w) * bf_lo(g4.w), bf_hi(ov.w) * bf_hi(g4.w));
            *(u32x4*)(op + (size_t)(4 * i) * DM) = w; }
    }
}

__device__ __forceinline__ void attn_unit_df(LAS unsigned char* lds, const bf16_t* __restrict__ PROJ, const bf16_t* __restrict__ KIMG, const bf16_t* __restrict__ VT, bf16_t* __restrict__ MIXED,
                                             int b, int hh, int qblk, float lam, const float* __restrict__ subln_g) {
    constexpr int VB0 = 2 * KT_BYTES;
    const int tid = opaque_tid(), lane = tid & 63, r = lane & 31, h = lane >> 5;
    const int wid = __builtin_amdgcn_readfirstlane(tid >> 6);
    const int qg = wid & 3, role = wid >> 2;
    const int Q0 = qblk * 128, q0w = Q0 + 32 * qg, tq = q0w + r;
    const size_t tokbase = (size_t)b * SEQ;
    const int gbh = (8 + b) * 8 + hh;
    const bf16_t* Kg = KIMG + (size_t)gbh * SEQ * 128;
    const bf16_t* Vg = VT + (size_t)gbh * 32 * 8192;
    bf16x8 qf[4];
    { const bf16_t* qp = PROJ + (tokbase + tq) * NPROJ + PQ_DF + hh * 128 + role * 64 + 8 * h;
#pragma unroll
      for (int ks = 0; ks < 4; ++ks) qf[ks] = *(const bf16x8*)(qp + 16 * ks); }
    f32x16 o[4];
#pragma unroll
    for (int d = 0; d < 4; ++d)
#pragma unroll
        for (int i = 0; i < 16; ++i) o[d][i] = 0.f;
    float m_run = -1e30f, l_run = 0.f, alpha = 1.f;
    const int kr0 = tid >> 4, kc = tid & 15, vr0 = tid >> 3, vc = tid & 7;
    const int kst = kr0 * KP + kc * 16, vst = vr0 * VP + vc * 16;
    const bf16_t* kgl = Kg + tid * 8;
    const bf16_t* vgl = Vg + tid * 8;
    u32x4 kreg[2], vreg[2];
#define DF_LOAD(t) do { _Pragma("unroll") for (int i_ = 0; i_ < 2; ++i_) { \
        kreg[i_] = *(const u32x4*)(kgl + (size_t)(t) * 8192 + i_ * 4096); \
        vreg[i_] = *(const u32x4*)(vgl + (size_t)(t) * 8192 + i_ * 4096); } } while (0)
#define DF_STORE(ko, vo) do { _Pragma("unroll") for (int i_ = 0; i_ < 2; ++i_) { \
        *(LAS u32x4*)(lds + (ko) + kst + i_ * 32 * KP) = kreg[i_]; \
        *(LAS u32x4*)(lds + (vo) + vst + i_ * 64 * VP) = vreg[i_]; } } while (0)
#define DF_VLOAD(vo) do { _Pragma("unroll") for (int d_ = 0; d_ < 4; ++d_) _Pragma("unroll") for (int kb_ = 0; kb_ < 2; ++kb_) _Pragma("unroll") for (int sp_ = 0; sp_ < 2; ++sp_) \
        vf[d_][kb_][sp_] = *(const LAS bf16x8*)(lds + (vo) + vfrag + d_ * 32 * VP + (32 * kb_ + 16 * sp_) * 2); } while (0)
#define DF_PV() do { _Pragma("unroll") for (int d_ = 0; d_ < 4; ++d_) _Pragma("unroll") for (int kb_ = 0; kb_ < 2; ++kb_) _Pragma("unroll") for (int sp_ = 0; sp_ < 2; ++sp_) \
        o[d_] = __builtin_amdgcn_mfma_f32_32x32x16_bf16(vf[d_][kb_][sp_], pf[kb_][sp_], o[d_], 0, 0, 0); } while (0)
#define DF_RESCALE() do { if (!__all(alpha == 1.f)) { _Pragma("unroll") for (int d_ = 0; d_ < 4; ++d_) _Pragma("unroll") for (int i_ = 0; i_ < 16; ++i_) o[d_][i_] *= alpha; } } while (0)
    const int tl = (Q0 + 127) >> 6, NT = tl + 1;
    const int kfrag = r * KP + (role * 64 + 8 * h) * 2;
    const int vfrag = r * VP + (8 * h) * 2;
    __syncthreads();
    DF_LOAD(tl); DF_STORE(0, VB0);
    __syncthreads();
    bool have_p = false;
    bf16x8 pf[2][2];
    for (int i = 0; i < NT; ++i) {
        const int t = tl - i, k0 = 64 * t;
        if (t > 0) DF_LOAD(t - 1);
        if (k0 <= q0w + 31) {
            const int ko = (i & 1) * KT_BYTES;
            bf16x8 kf[2][4];
#pragma unroll
            for (int kb = 0; kb < 2; ++kb)
#pragma unroll
                for (int ks = 0; ks < 4; ++ks) kf[kb][ks] = *(const LAS bf16x8*)(lds + ko + kfrag + kb * 32 * KP + ks * 32);
            f32x16 s[2];
#pragma unroll
            for (int kb = 0; kb < 2; ++kb) {
#pragma unroll
                for (int j = 0; j < 16; ++j) s[kb][j] = 0.f;
#pragma unroll
                for (int ks = 0; ks < 4; ++ks) s[kb] = __builtin_amdgcn_mfma_f32_32x32x16_bf16(kf[kb][ks], qf[ks], s[kb], 0, 0, 0);
            }
            if (!have_p) {
                float mx = -1e30f;
#pragma unroll
                for (int kb = 0; kb < 2; ++kb) { const int kbase = k0 + 32 * kb + 4 * h;
#pragma unroll
                    for (int j = 0; j < 16; ++j) { const int key = kbase + 8 * (j >> 2) + (j & 3); const float v = (key <= tq) ? s[kb][j] : -1e30f; s[kb][j] = v; mx = fmaxf(mx, v); } }
                mx = fmaxf(mx, __shfl_xor(mx, 32));
                m_run = mx; alpha = 1.f;
                float ls = 0.f;
#pragma unroll
                for (int kb = 0; kb < 2; ++kb) {
#pragma unroll
                    for (int j = 0; j < 16; ++j) { const float p = fast_exp2(s[kb][j] - mx); s[kb][j] = p; ls += p; }
#pragma unroll
                    for (int sp = 0; sp < 2; ++sp) { u32x4 p; p.x = cvt_pk(s[kb][8 * sp], s[kb][8 * sp + 1]); p.y = cvt_pk(s[kb][8 * sp + 2], s[kb][8 * sp + 3]); p.z = cvt_pk(s[kb][8 * sp + 4], s[kb][8 * sp + 5]); p.w = cvt_pk(s[kb][8 * sp + 6], s[kb][8 * sp + 7]);
                        pf[kb][sp] = __builtin_bit_cast(bf16x8, p); }
                }
                l_run = ls;
                have_p = true;
            } else {
                DF_RESCALE();
                const int vo = VB0 + ((i + 2) % 3) * VT_BYTES;
                bf16x8 vf[2][2][2];
                bf16x8 pn[2][2]; u32x4 pw[2][2];
                float mx = -1e30f, ls = 0.f, m_new = 0.f;
#define DF_VL(g) do { _Pragma("unroll") for (int kb_ = 0; kb_ < 2; ++kb_) _Pragma("unroll") for (int sp_ = 0; sp_ < 2; ++sp_) \
        vf[(g) & 1][kb_][sp_] = *(const LAS bf16x8*)(lds + vo + vfrag + (g) * 32 * VP + (32 * kb_ + 16 * sp_) * 2); } while (0)
#define DF_MF(k) o[(k) >> 2] = __builtin_amdgcn_mfma_f32_32x32x16_bf16(vf[((k) >> 2) & 1][((k) >> 1) & 1][(k) & 1], pf[((k) >> 1) & 1][(k) & 1], o[(k) >> 2], 0, 0, 0)
#define DF_S(e) s[(e) >> 4][(e) & 15]
                DF_VL(0); DF_VL(1);
                __builtin_amdgcn_sched_barrier(0);
                DF_MF(0);
                mx = fmaxf(fmaxf(mx, DF_S(0)), DF_S(1));
                mx = fmaxf(fmaxf(mx, DF_S(2)), DF_S(3));
                mx = fmaxf(fmaxf(mx, DF_S(4)), DF_S(5));
                mx = fmaxf(fmaxf(mx, DF_S(6)), DF_S(7));
                __builtin_amdgcn_sched_barrier(0);
                DF_MF(1);
                mx = fmaxf(fmaxf(mx, DF_S(8)), DF_S(9));
                mx = fmaxf(fmaxf(mx, DF_S(10)), DF_S(11));
                mx = fmaxf(fmaxf(mx, DF_S(12)), DF_S(13));
                mx = fmaxf(fmaxf(mx, DF_S(14)), DF_S(15));
                __builtin_amdgcn_sched_barrier(0);
                DF_MF(2);
                mx = fmaxf(fmaxf(mx, DF_S(16)), DF_S(17));
                mx = fmaxf(fmaxf(mx, DF_S(18)), DF_S(19));
                mx = fmaxf(fmaxf(mx, DF_S(20)), DF_S(21));
                mx = fmaxf(fmaxf(mx, DF_S(22)), DF_S(23));
                __builtin_amdgcn_sched_barrier(0);
                DF_MF(3);
                mx = fmaxf(fmaxf(mx, DF_S(24)), DF_S(25));
                mx = fmaxf(fmaxf(mx, DF_S(26)), DF_S(27));
                mx = fmaxf(fmaxf(mx, DF_S(28)), DF_S(29));
                mx = fmaxf(fmaxf(mx, DF_S(30)), DF_S(31));
                { auto rr = __builtin_amdgcn_permlane32_swap(__float_as_uint(mx), __float_as_uint(mx), false, false); mx = fmaxf(__uint_as_float(rr[0]), __uint_as_float(rr[1])); }
                { const bool grow = !__all(mx - m_run <= 8.f); m_new = grow ? fmaxf(m_run, mx) : m_run; alpha = fast_exp2(m_run - m_new); m_run = m_new; }
                __builtin_amdgcn_sched_barrier(0);
                DF_VL(2);
                DF_MF(4);
                { const float p = fast_exp2(DF_S(0) - m_new); DF_S(0) = p; ls += p; }
                { const float p = fast_exp2(DF_S(1) - m_new); DF_S(1) = p; ls += p; }
                pw[0][0][0] = cvt_pk(DF_S(0), DF_S(1));
                { const float p = fast_exp2(DF_S(2) - m_new); DF_S(2) = p; ls += p; }
                __builtin_amdgcn_sched_barrier(0);
                DF_MF(5);
                { const float p = fast_exp2(DF_S(3) - m_new); DF_S(3) = p; ls += p; }
                pw[0][0][1] = cvt_pk(DF_S(2), DF_S(3));
                { const float p = fast_exp2(DF_S(4) - m_new); DF_S(4) = p; ls += p; }
                { const float p = fast_exp2(DF_S(5) - m_new); DF_S(5) = p; ls += p; }
                pw[0][0][2] = cvt_pk(DF_S(4), DF_S(5));
                __builtin_amdgcn_sched_barrier(0);
                DF_MF(6);
                { const float p = fast_exp2(DF_S(6) - m_new); DF_S(6) = p; ls += p; }
                { const float p = fast_exp2(DF_S(7) - m_new); DF_S(7) = p; ls += p; }
                pw[0][0][3] = cvt_pk(DF_S(6), DF_S(7));
                { const float p = fast_exp2(DF_S(8) - m_new); DF_S(8) = p; ls += p; }
                __builtin_amdgcn_sched_barrier(0);
                DF_MF(7);
                { const float p = fast_exp2(DF_S(9) - m_new); DF_S(9) = p; ls += p; }
                pw[0][1][0] = cvt_pk(DF_S(8), DF_S(9));
                { const float p = fast_exp2(DF_S(10) - m_new); DF_S(10) = p; ls += p; }
                { const float p = fast_exp2(DF_S(11) - m_new); DF_S(11) = p; ls += p; }
                pw[0][1][1] = cvt_pk(DF_S(10), DF_S(11));
                __builtin_amdgcn_sched_barrier(0);
                DF_VL(3);
                DF_MF(8);
                { const float p = fast_exp2(DF_S(12) - m_new); DF_S(12) = p; ls += p; }
                { const float p = fast_exp2(DF_S(13) - m_new); DF_S(13) = p; ls += p; }
                pw[0][1][2] = cvt_pk(DF_S(12), DF_S(13));
                { const float p = fast_exp2(DF_S(14) - m_new); DF_S(14) = p; ls += p; }
                __builtin_amdgcn_sched_barrier(0);
                DF_MF(9);
                { const float p = fast_exp2(DF_S(15) - m_new); DF_S(15) = p; ls += p; }
                pw[0][1][3] = cvt_pk(DF_S(14), DF_S(15));
                { const float p = fast_exp2(DF_S(16) - m_new); DF_S(16) = p; ls += p; }
                { const float p = fast_exp2(DF_S(17) - m_new); DF_S(17) = p; ls += p; }
                pw[1][0][0] = cvt_pk(DF_S(16), DF_S(17));
                __builtin_amdgcn_sched_barrier(0);
                DF_MF(10);
                { const float p = fast_exp2(DF_S(18) - m_new); DF_S(18) = p; ls += p; }
                { const float p = fast_exp2(DF_S(19) - m_new); DF_S(19) = p; ls += p; }
                pw[1][0][1] = cvt_pk(DF_S(18), DF_S(19));
                { const float p = fast_exp2(DF_S(20) - m_new); DF_S(20) = p; ls += p; }
                __builtin_amdgcn_sched_barrier(0);
                DF_MF(11);
                { const float p = fast_exp2(DF_S(21) - m_new); DF_S(21) = p; ls += p; }
                pw[1][0][2] = cvt_pk(DF_S(20), DF_S(21));
                { const float p = fast_exp2(DF_S(22) - m_new); DF_S(22) = p; ls += p; }
                { const float p = fast_exp2(DF_S(23) - m_new); DF_S(23) = p; ls += p; }
                pw[1][0][3] = cvt_pk(DF_S(22), DF_S(23));
                __builtin_amdgcn_sched_barrier(0);
                DF_MF(12);
                { const float p = fast_exp2(DF_S(24) - m_new); DF_S(24) = p; ls += p; }
                { const float p = fast_exp2(DF_S(25) - m_new); DF_S(25) = p; ls += p; }
                pw[1][1][0] = cvt_pk(DF_S(24), DF_S(25));
                __builtin_amdgcn_sched_barrier(0);
                DF_MF(13);
                { const float p = fast_exp2(DF_S(26) - m_new); DF_S(26) = p; ls += p; }
                { const float p = fast_exp2(DF_S(27) - m_new); DF_S(27) = p; ls += p; }
                pw[1][1][1] = cvt_pk(DF_S(26), DF_S(27));
                __builtin_amdgcn_sched_barrier(0);
                DF_MF(14);
                { const float p = fast_exp2(DF_S(28) - m_new); DF_S(28) = p; ls += p; }
                { const float p = fast_exp2(DF_S(29) - m_new); DF_S(29) = p; ls += p; }
                pw[1][1][2] = cvt_pk(DF_S(28), DF_S(29));
                __builtin_amdgcn_sched_barrier(0);
                DF_MF(15);
                { const float p = fast_exp2(DF_S(30) - m_new); DF_S(30) = p; ls += p; }
                { const float p = fast_exp2(DF_S(31) - m_new); DF_S(31) = p; ls += p; }
                pw[1][1][3] = cvt_pk(DF_S(30), DF_S(31));
                __builtin_amdgcn_sched_barrier(0);
                l_run = l_run * alpha + ls;
#pragma unroll
                for (int kb = 0; kb < 2; ++kb)
#pragma unroll
                    for (int sp = 0; sp < 2; ++sp) pf[kb][sp] = __builtin_bit_cast(bf16x8, pw[kb][sp]);
#undef DF_VL
#undef DF_MF
#undef DF_S
            }
        }
        if (t > 0) DF_STORE(((i + 1) & 1) * KT_BYTES, VB0 + ((i + 1) % 3) * VT_BYTES);
        __syncthreads();
    }
    if (have_p) {
        DF_RESCALE();
        bf16x8 vf[4][2][2];
        DF_VLOAD(VB0 + ((NT - 1) % 3) * VT_BYTES);
        DF_PV();
    }
    __syncthreads();
#undef DF_LOAD
#undef DF_STORE
#undef DF_VLOAD
#undef DF_PV
#undef DF_RESCALE
    const int erow = lane >> 4, ech = lane & 15;
    const size_t tok0 = tokbase + q0w;
    u32x4 gw[8];
    if (role == 0) {
        const bf16_t* gp = PROJ + (tok0 + erow) * NPROJ + PG_DF + hh * 128 + ech * 8;
#pragma unroll
        for (int i = 0; i < 8; ++i) gw[i] = *(const u32x4*)(gp + (size_t)(4 * i) * NPROJ);
    }
    LAS unsigned char* stg = lds + 69632 + qg * 8704;
    {
        const float lt = l_run + __shfl_xor(l_run, 32);
        const float inv = 1.f / lt;
        LAS float* xq = (LAS float*)lds + (qg * 32 + r) * XP + 4 * h;
        if (role == 1) {
            const float f = inv * lam;
#pragma unroll
            for (int d = 0; d < 4; ++d)
#pragma unroll
                for (int g = 0; g < 4; ++g) *(LAS f32x4*)(xq + 32 * d + 8 * g) = (f32x4){o[d][4 * g] * f, o[d][4 * g + 1] * f, o[d][4 * g + 2] * f, o[d][4 * g + 3] * f};
        }
        __syncthreads();
        if (role == 0) {
            float q = 0.f;
#pragma unroll
            for (int d = 0; d < 4; ++d)
#pragma unroll
                for (int g = 0; g < 4; ++g) { const f32x4 x2 = *(const LAS f32x4*)(xq + 32 * d + 8 * g);
#pragma unroll
                    for (int j = 0; j < 4; ++j) { const float v = o[d][4 * g + j] * inv - x2[j]; o[d][4 * g + j] = v; q += v * v; } }
            q += __shfl_xor(q, 32);
            const float rs = rsqrtf(q * (1.f / 128.f) + SUBLN_EPS) * (1.f - LAMBDA_INIT);
            const float* sg = subln_g + 4 * h;
#pragma unroll
            for (int d = 0; d < 4; ++d)
#pragma unroll
                for (int g = 0; g < 4; ++g) { const f32x4 sv = *(const f32x4*)(sg + 32 * d + 8 * g);
                    u32x2 w; w.x = cvt_pk(o[d][4 * g] * rs * sv[0], o[d][4 * g + 1] * rs * sv[1]); w.y = cvt_pk(o[d][4 * g + 2] * rs * sv[2], o[d][4 * g + 3] * rs * sv[3]);
                    *(LAS u32x2*)(stg + r * 272 + (32 * d + 8 * g + 4 * h) * 2) = w; }
            asm volatile("s_waitcnt lgkmcnt(0)" ::: "memory");
            bf16_t* op = MIXED + (tok0 + erow) * DM + 1024 + hh * 128 + ech * 8;
#pragma unroll
            for (int i = 0; i < 8; ++i) { const u32x4 ov = *(const LAS u32x4*)(stg + (4 * i + erow) * 272 + ech * 16); const u32x4 g4 = gw[i];
                u32x4 w; w.x = cvt_pk(bf_lo(ov.x) * bf_lo(g4.x), bf_hi(ov.x) * bf_hi(g4.x)); w.y = cvt_pk(bf_lo(ov.y) * bf_lo(g4.y), bf_hi(ov.y) * bf_hi(g4.y));
                w.z = cvt_pk(bf_lo(ov.z) * bf_lo(g4.z), bf_hi(ov.z) * bf_hi(g4.z)); w.w = cvt_pk(bf_lo(ov.w) * bf_lo(g4.w), bf_hi(ov.w) * bf_hi(g4.w));
                *(u32x4*)(op + (size_t)(4 * i) * DM) = w; }
        }
    }
}
}
#define XB_TMO      128
#define XB_XCNT(j)  (256  + 64 * (j))
#define XB_XSUB(j)  (1280 + 64 * (j))
#define XB_XGEN(j)  (2304 + 64 * (j))
#define XB_TOP      3328
#define XB_TOPGEN   3392
#define XCD_BAR_WORDS 3456
#define XB_SPIN_CAP (1u << 18)

__device__ __forceinline__ unsigned xb_ld(unsigned* p)              { return __hip_atomic_load(p, __ATOMIC_RELAXED, __HIP_MEMORY_SCOPE_AGENT); }
__device__ __forceinline__ unsigned xb_add(unsigned* p, unsigned v) { return __hip_atomic_fetch_add(p, v, __ATOMIC_RELAXED, __HIP_MEMORY_SCOPE_AGENT); }
__device__ __forceinline__ unsigned xb_xcc_id() { return (unsigned)__builtin_amdgcn_s_getreg((3 << 11) | 20) & 0xFu; }
#define XB_SPIN(cond, bar) do { unsigned _sp = 0; while (cond) { __builtin_amdgcn_s_sleep(1); \
    if ((++_sp & 255u) == 0u) { if (xb_ld(&(bar)[XB_TMO])) break; if (_sp > XB_SPIN_CAP) { atomicAdd(&(bar)[XB_TMO], 1u); break; } } } } while (0)

struct XcdBarrier {
    unsigned* bar; unsigned x;
    volatile LAS unsigned* st;
};

__device__ __forceinline__ XcdBarrier xcd_barrier_post(unsigned* bar, volatile LAS unsigned* st) {
    XcdBarrier b; b.bar = bar; b.x = xb_xcc_id(); b.st = st;
    if (threadIdx.x == 0) (void)xb_add(&bar[XB_XCNT(b.x)], 1u);
    return b;
}
__device__ __forceinline__ void xcd_barrier_complete(unsigned* bar, unsigned x, unsigned& nloc, unsigned& nx) {
    const unsigned G = gridDim.x * gridDim.y * gridDim.z;
    unsigned sum, cnt, mine, sp = 0u;
    for (;;) {
        sum = 0u; cnt = 0u; mine = 0u;
#pragma unroll
        for (unsigned j = 0; j < 16; ++j) { const unsigned c = xb_ld(&bar[XB_XCNT(j)]); sum += c; cnt += (c > 0u) ? 1u : 0u; mine = (j == x) ? c : mine; }
        if (sum == G) break;
        __builtin_amdgcn_s_sleep(1);
        if ((++sp & 255u) == 0u) { if (xb_ld(&bar[XB_TMO])) break; if (sp > XB_SPIN_CAP) { atomicAdd(&bar[XB_TMO], 1u); break; } }
    }
    nloc = mine > 0u ? mine : 1u; nx = cnt > 0u ? cnt : 1u;
}

__device__ __forceinline__ void xcd_barrier(const XcdBarrier& b) {
    asm volatile("s_waitcnt vmcnt(0)" ::: "memory");
    __syncthreads();
    if (threadIdx.x == 0) {
        unsigned* bar = b.bar;
        __builtin_amdgcn_s_waitcnt(0);
        unsigned nloc = b.st[0], nx = b.st[1];
        if (nloc == 0u) { xcd_barrier_complete(bar, b.x, nloc, nx); b.st[0] = nloc; b.st[1] = nx; }
        const unsigned old = xb_add(&bar[XB_XSUB(b.x)], 1u);
        const unsigned gen = old / nloc;
        if (old + 1u == (gen + 1u) * nloc) {
            __builtin_amdgcn_fence(__ATOMIC_RELEASE, "agent");
            asm volatile("s_waitcnt vmcnt(0)" ::: "memory");
            const unsigned og = xb_add(&bar[XB_TOP], 1u);
            const unsigned tg = og / nx;
            if (og + 1u == (tg + 1u) * nx) xb_add(&bar[XB_TOPGEN], 1u);
            else XB_SPIN(xb_ld(&bar[XB_TOPGEN]) == tg, bar);
            __builtin_amdgcn_fence(__ATOMIC_ACQUIRE, "agent");
            xb_add(&bar[XB_XGEN(b.x)], 1u);
            asm volatile("s_waitcnt vmcnt(0)" ::: "memory");
        } else {
            XB_SPIN(xb_ld(&bar[XB_XGEN(b.x)]) == gen, bar);
            __builtin_amdgcn_fence(__ATOMIC_ACQUIRE, "agent");
            asm volatile("s_waitcnt vmcnt(0)" ::: "memory");
        }
    }
    __syncthreads();
}

__device__ __forceinline__ int win_dst_row(int c) {
    const int seg = c >> 10, w = c & 1023, d6 = w & 63;
    const int wp = d6 < 16 ? (w & ~63) + (d6 < 8 ? 2 * d6 : 2 * (d6 - 8) + 1) : w;
    switch (seg) { case 0: return w; case 1: return 1024 + w; case 2: return 6144 + w; case 3: return 2048 + w;
                   case 4: return 3072 + wp; case 5: return 4096 + wp; case 6: return 7168 + w; default: return 5120 + w; }
}
struct TItem { const float* W; bf16_t* WT; const float* ks; int K, N, win, item; };
__device__ __forceinline__ void tr_load(const TItem& t, float (&v)[32], int lane) {
    const int nblk = t.N / 32, kb = t.item / nblk, nb = t.item % nblk; const float* p = t.W + (size_t)(64 * kb + (lane >> 5)) * t.N + 32 * nb + (lane & 31);
#pragma unroll
    for (int i = 0; i < 32; ++i) v[i] = __builtin_nontemporal_load(&p[(size_t)(2 * i) * t.N]);
}
__device__ __forceinline__ void tr_write(const float (&v)[32], LAS float* scr, int lane) {
#pragma unroll
    for (int i = 0; i < 32; ++i) scr[(2 * i + (lane >> 5)) * 33 + (lane & 31)] = v[i];
}
__device__ __forceinline__ void tr_store(const TItem& t, LAS float* scr, int lane) {
    const int nblk = t.N / 32, kb = t.item / nblk, nb = t.item % nblk, k0 = 64 * kb, n0 = 32 * nb, c = lane & 7;
    f32x4 s0 = {1.f, 1.f, 1.f, 1.f}, s1 = {1.f, 1.f, 1.f, 1.f};
    if (t.ks) { s0 = *(const f32x4*)(t.ks + k0 + 8 * c); s1 = *(const f32x4*)(t.ks + k0 + 8 * c + 4); }
#pragma unroll
    for (int j = 0; j < 4; ++j) { const int n = (lane >> 3) + 8 * j; const LAS float* s = scr + (8 * c) * 33 + n;
        u32x4 o; o.x = cvt_pk(s[0 * 33] * s0[0], s[1 * 33] * s0[1]); o.y = cvt_pk(s[2 * 33] * s0[2], s[3 * 33] * s0[3]); o.z = cvt_pk(s[4 * 33] * s1[0], s[5 * 33] * s1[1]); o.w = cvt_pk(s[6 * 33] * s1[2], s[7 * 33] * s1[3]);
        const int dn = t.win ? win_dst_row(n0 + n) : (n0 + n);
        *(u32x4*)(t.WT + (size_t)dn * t.K + k0 + 8 * c) = o; }
}
__device__ __forceinline__ void rms_load(const float* __restrict__ xrow, f32x4 (&v)[8], int lane) {
    const f32x4* xr = (const f32x4*)xrow + lane;
#pragma unroll
    for (int j = 0; j < 8; ++j) v[j] = __builtin_nontemporal_load(&xr[64 * j]);
}
__device__ __forceinline__ void rms_finish(const f32x4 (&v)[8], const f32x4 (&gv)[8], bf16_t* __restrict__ orow, int lane) {
    float s = 0.f;
#pragma unroll
    for (int j = 0; j < 8; ++j) s += (v[j][0] * v[j][0] + v[j][1] * v[j][1]) + (v[j][2] * v[j][2] + v[j][3] * v[j][3]);
    const float rstd = rsqrtf(wave_sum(s) * (1.f / DM) + NORM_EPS);
    u32x2* o8 = (u32x2*)orow + lane;
#pragma unroll
    for (int j = 0; j < 8; ++j) { u32x2 w; w.x = cvt_pk(v[j][0] * rstd * gv[j][0], v[j][1] * rstd * gv[j][1]); w.y = cvt_pk(v[j][2] * rstd * gv[j][2], v[j][3] * rstd * gv[j][3]); o8[64 * j] = w; }
}

struct Args { const float* in[14]; float* out; unsigned char* ws; };

__global__ void __launch_bounds__(512, 2) fwd_megakernel(Args a) {
    extern __shared__ __attribute__((aligned(16))) unsigned char lds_raw[];
    LAS unsigned char* lds = (LAS unsigned char*)lds_raw;
    { cg::grid_group grid = cg::this_grid(); if (a.ws == nullptr) grid.sync(); }
    const int tid = threadIdx.x, lane = tid & 63, wave = __builtin_amdgcn_readfirstlane(tid >> 6);
    const int G = gridDim.x, bx = blockIdx.x;
    const int vcu = (G % 8 == 0) ? (bx % 8) * (G / 8) + bx / 8 : bx;
    unsigned char* ws = a.ws;
    float* ss2 = (float*)(ws + WS_CTL + CTL_SS2); float* ss3 = (float*)(ws + WS_CTL + CTL_SS3); float* lamp = (float*)(ws + WS_CTL + CTL_LAM); float* rope = (float*)(ws + WS_CTL + CTL_ROPE);
    bf16_t* WIN = (bf16_t*)(ws + WS_WIN); bf16_t* WOUT = (bf16_t*)(ws + WS_WOUT); bf16_t* WGATE = (bf16_t*)(ws + WS_WGATE); bf16_t* WPROJ = (bf16_t*)(ws + WS_WPROJ);
    bf16_t* PB = (bf16_t*)(ws + WS_PB); bf16_t* XN = (bf16_t*)(ws + WS_XN); bf16_t* MIXED = (bf16_t*)(ws + WS_MIXED); bf16_t* PROJ = (bf16_t*)(ws + WS_PROJ);
    bf16_t* VT = (bf16_t*)(ws + WS_VT); bf16_t* KIMG = (bf16_t*)(ws + WS_KIMG); bf16_t* HB = (bf16_t*)(ws + WS_HB); bf16_t* PLEB = (bf16_t*)(ws + WS_PLE); bf16_t* H2B = (bf16_t*)(ws + WS_H2B);
    const float* x = a.in[0]; float* out = a.out;
    volatile LAS unsigned* xst = (volatile LAS unsigned*)(lds + 131072);
    if (tid == 0) { xst[0] = 0u; xst[1] = 0u; }
    __syncthreads();
    const XcdBarrier xb = xcd_barrier_post((unsigned*)(ws + WS_CTL + CTL_BAR), xst);

    {
        const int gw = bx * 8 + wave, NGW = G * 8; const int gt = bx * 512 + tid, NGT = G * 512;
        for (int i = gt; i < 2 * NTOK; i += NGT) ss2[i] = 0.f;
        if (gt == 0) { float s1 = 0.f, s2 = 0.f; for (int i = 0; i < 64; ++i) { s1 += a.in[4][i] * a.in[5][i]; s2 += a.in[6][i] * a.in[7][i]; } lamp[0] = expf(s1) - expf(s2) + LAMBDA_INIT; }
        for (int i = gt; i < SEQ * 8; i += NGT) { const int pos = i >> 3, f = i & 7;
            const float invf = (float)exp2(-(double)f * 0.125 * 18.931568569324174);
            const float angf = (float)pos * invf;
            const double tw = 6.283185307179586476925; double ang = (double)angf; ang -= tw * rint(ang / tw);
            rope[2 * i] = (float)cos(ang); rope[2 * i + 1] = (float)sin(ang); }
        LAS float* scr = (LAS float*)(lds + wave * 16384);
        constexpr int I_IN = (DM / 64) * (8192 / 32), I_SQ = (DM / 64) * (DM / 32), I_PR = (PLE / 64) * (DM / 32), I_ALL = I_IN + 2 * I_SQ + I_PR;
#define P0_DECODE(T, it_) do { int rr_ = (it_); \
            if (rr_ < I_IN) { T = TItem{a.in[3], WIN, nullptr, DM, 8192, 1, rr_}; } \
            else if (rr_ < I_IN + I_SQ) { T = TItem{a.in[9], WOUT, nullptr, DM, DM, 0, rr_ - I_IN}; } \
            else if (rr_ < I_IN + 2 * I_SQ) { T = TItem{a.in[11], WGATE, a.in[10], DM, DM, 0, rr_ - I_IN - I_SQ}; } \
            else { T = TItem{a.in[12], WPROJ, nullptr, PLE, DM, 0, rr_ - I_IN - 2 * I_SQ}; } } while (0)
        {
            float tv[32]; TItem cur, nxt; int it = gw;
            if (it < I_ALL) { P0_DECODE(cur, it); tr_load(cur, tv, lane); }
            while (it < I_ALL) {
                tr_write(tv, scr, lane);
                const int itn = it + NGW;
                if (itn < I_ALL) { P0_DECODE(nxt, itn); tr_load(nxt, tv, lane); }
                asm volatile("s_waitcnt lgkmcnt(0)" ::: "memory");
                tr_store(cur, scr, lane);
                asm volatile("s_waitcnt lgkmcnt(0)" ::: "memory");
                cur = nxt; it = itn;
            }
        }
#undef P0_DECODE
        {
            f32x4 gv[8], va[8], vb[8];
            { const f32x4* gr = (const f32x4*)a.in[2] + lane;
#pragma unroll
              for (int j = 0; j < 8; ++j) gv[j] = gr[64 * j]; }
            int m = gw;
            if (m < NTOK) rms_load(x + (size_t)m * DM, va, lane);
            for (; m < NTOK; m += 2 * NGW) {
                const int m1 = m + NGW, m2 = m + 2 * NGW;
                if (m1 < NTOK) rms_load(x + (size_t)m1 * DM, vb, lane);
                rms_finish(va, gv, XN + (size_t)m * DM, lane);
                if (m2 < NTOK) rms_load(x + (size_t)m2 * DM, va, lane);
                if (m1 < NTOK) rms_finish(vb, gv, XN + (size_t)m1 * DM, lane);
            }
        }
        for (int i = gt; i < NTOK * PLE / 8; i += NGT) { const f32x4 v0 = __builtin_nontemporal_load(&((const f32x4*)a.in[1])[2 * i]), v1 = __builtin_nontemporal_load(&((const f32x4*)a.in[1])[2 * i + 1]);
            u32x4 w; w.x = cvt_pk(v0[0], v0[1]); w.y = cvt_pk(v0[2], v0[3]); w.z = cvt_pk(v1[0], v1[1]); w.w = cvt_pk(v1[2], v1[3]); ((u32x4*)PB)[i] = w; }
    }
    xcd_barrier(xb);
    {
        { pg8::Gemm g{XN, WIN, NTOK, NPROJ, DM}; pg8::StaticOrder S; S.init(NTOK, NPROJ, G, bx); pg8::EpiProj E{PROJ, rope, KIMG};
          pg8::gemm_phase<pg8::EpiProj, pg8::StaticOrder, true, true>(lds, g, S, E); }
        __syncthreads();
        { pg8::Gemm g{WIN + (size_t)NPROJ * DM, XN, 2048, NTOK, DM}; pg8::StaticOrder S; S.init(2048, NTOK, G, bx); pg8::EpiVt E{VT};
          pg8::gemm_phase<pg8::EpiVt, pg8::StaticOrder, true, true>(lds, g, S, E); }
    }
    xcd_barrier(xb);
    {
        const float lam = lamp[0];
        for (int su = vcu; su < 256; su += G) {
            const int grp = su >> 4, j = su & 15;
#pragma unroll 1
            for (int k = 0; k < 4; ++k) { const int bh = 4 * grp + k; const int qb = (k & 1) ? 15 - j : j;
                att::attn_unit_df(lds, PROJ, KIMG, VT, MIXED, bh >> 3, bh & 7, qb, lam, a.in[8]); }
        }
#pragma unroll 1
        for (int u = vcu; u < 512; u += G) att::attn_unit<0>(lds, PROJ, KIMG, VT, MIXED, (u >> 3) >> 3, (u >> 3) & 7, u & 7, lam, a.in[8]);
    }
    xcd_barrier(xb);
    {
        __syncthreads();
        { pg8::Gemm g{MIXED, WOUT, NTOK, DM, DM}; pg8::StaticOrder S; S.init(NTOK, DM, G, bx); pg8::EpiRes E{x, HB, ss2};
          pg8::gemm_phase<pg8::EpiRes, pg8::StaticOrder, true, true>(lds, g, S, E); }
        __syncthreads();
        { pg8::Gemm g{PB, WPROJ, NTOK, DM, PLE}; pg8::StaticOrder S; S.init(NTOK, DM, G, bx); pg8::EpiBf16 E{PLEB, DM};
          pg8::gemm_phase<pg8::EpiBf16, pg8::StaticOrder, true, true>(lds, g, S, E); }
    }
    xcd_barrier(xb);
    {
        pg8::Gemm g{HB, WGATE, NTOK, DM, DM}; pg8::StaticOrder S; S.init(NTOK, DM, G, bx); pg8::EpiGate E{HB, H2B, PLEB, ss2, ss3};
        pg8::gemm_phase<pg8::EpiGate, pg8::StaticOrder, true, true>(lds, g, S, E);
    }
    xcd_barrier(xb);
    {
        const int tid5 = opaque_tid(), lane = tid5 & 63, wave = __builtin_amdgcn_readfirstlane(tid5 >> 6);
        const int gw = bx * 8 + wave, NGW = G * 8; const f32x4* gr = (const f32x4*)a.in[13];
        f32x4 gv[8];
#pragma unroll
        for (int j = 0; j < 4; ++j) { gv[2 * j] = gr[2 * (lane + 64 * j)]; gv[2 * j + 1] = gr[2 * (lane + 64 * j) + 1]; }
#define P5_LOAD(H, S_, m_) do { const u32x4* hrow_ = (const u32x4*)(H2B + (size_t)(m_) * DM); S_ = ss3[m_]; _Pragma("unroll") for (int j_ = 0; j_ < 4; ++j_) H[j_] = __builtin_nontemporal_load(&hrow_[lane + 64 * j_]); } while (0)
#define P5_STORE(H, S_, m_) do { const float rstd_ = rsqrtf(S_ * (1.f / DM) + NORM_EPS); f32x4* orow_ = (f32x4*)(out + (size_t)(m_) * DM); \
            _Pragma("unroll") for (int j_ = 0; j_ < 4; ++j_) { const int c_ = lane + 64 * j_; const u32x4 hw_ = H[j_]; const f32x4 g0_ = gv[2 * j_], g1_ = gv[2 * j_ + 1]; \
                orow_[2 * c_] = (f32x4){bf_lo(hw_.x) * rstd_ * g0_[0], bf_hi(hw_.x) * rstd_ * g0_[1], bf_lo(hw_.y) * rstd_ * g0_[2], bf_hi(hw_.y) * rstd_ * g0_[3]}; \
                orow_[2 * c_ + 1] = (f32x4){bf_lo(hw_.z) * rstd_ * g1_[0], bf_hi(hw_.z) * rstd_ * g1_[1], bf_lo(hw_.w) * rstd_ * g1_[2], bf_hi(hw_.w) * rstd_ * g1_[3]}; } } while (0)
        u32x4 ha[4], hb4[4]; float sa = 0.f, sb = 0.f;
        int m = gw;
        if (m < NTOK) P5_LOAD(ha, sa, m);
        for (; m < NTOK; m += 2 * NGW) {
            const int m1 = m + NGW, m2 = m + 2 * NGW;
            if (m1 < NTOK) P5_LOAD(hb4, sb, m1);
            P5_STORE(ha, sa, m);
            if (m2 < NTOK) P5_LOAD(ha, sa, m2);
            if (m1 < NTOK) P5_STORE(hb4, sb, m1);
        }
#undef P5_LOAD
#undef P5_STORE
    }
}

extern "C" void kernel_launch(void* const* d_in, const int* in_sizes, int n_in, void* d_out, int out_size, void* d_ws, size_t ws_size, hipStream_t stream) {
    static int grid = 0;
    if (grid == 0) {
        if (n_in != 14 || out_size != NTOK * DM || ws_size < WS_END) { fprintf(stderr, "kernel_launch: unexpected shapes (n_in %d out %d ws %zu)\n", n_in, out_size, ws_size); grid = -1; return; }
        int dev = 0, cus = 0, per_cu = 0;
        (void)hipGetDevice(&dev); (void)hipDeviceGetAttribute(&cus, hipDeviceAttributeMultiprocessorCount, dev);
        (void)hipFuncSetAttribute((const void*)fwd_megakernel, hipFuncAttributeMaxDynamicSharedMemorySize, LDS_BYTES);
        (void)hipOccupancyMaxActiveBlocksPerMultiprocessor(&per_cu, (const void*)fwd_megakernel, 512, LDS_BYTES);
        if (per_cu < 1) { fprintf(stderr, "kernel_launch: occupancy query says %d blocks/CU\n", per_cu); per_cu = 1; }
        grid = cus * per_cu;
    }
    if (grid < 0) return;
    Args a{};
    for (int i = 0; i < 14; ++i) a.in[i] = (const float*)d_in[i];
    a.out = (float*)d_out; a.ws = (unsigned char*)d_ws;
    (void)hipMemsetAsync((unsigned char*)d_ws + WS_CTL + CTL_BAR, 0, CTL_BAR_BYTES, stream);
    void* args[] = {&a};
    hipError_t e = hipLaunchCooperativeKernel((void*)fwd_megakernel, dim3(grid), dim3(512), args, LDS_BYTES, stream);
    if (e != hipSuccess) fprintf(stderr, "cooperative launch failed: %s (grid %d)\n", hipGetErrorString(e), grid);
}
```

```cpp
#include <hip/hip_runtime.h>
#include <hip/hip_cooperative_groups.h>
#include <cstdio>
#include <cstdint>
namespace cg = cooperative_groups;
__device__ __forceinline__ int opaque_tid() { int t = (int)threadIdx.x; asm volatile("" : "+v"(t)); return t; }
namespace pg8 {
#define PG8_LAS __attribute__((address_space(3)))
typedef unsigned short bf16_t;
typedef short bf16x8 __attribute__((ext_vector_type(8)));
typedef float f32x4 __attribute__((ext_vector_type(4)));
typedef unsigned u32x4 __attribute__((ext_vector_type(4)));
constexpr int BM = 256, BK = 64, HALF = 128, HTB = HALF * BK * 2  , STAGE_BYTES = 8 * HTB, NXCD = 8, WGM = 8;

__host__ __device__ __forceinline__ int lds_byte(int r, int c) { const int st = (r >> 4) * 2 + (c >> 5), rr = r & 15, cc = c & 31, ob = rr * 64 + cc * 2; return st * 1024 + (ob ^ (((ob >> 9) & 1) << 5)); }
__host__ __device__ __forceinline__ void stage_rc(int b, int& R, int& C) { const int st = b / 1024, sb = b % 1024, swz = sb ^ (((sb >> 9) & 1) << 5); R = (st >> 1) * 16 + swz / 64; C = (st & 1) * 32 + (swz % 64) / 2; }
__host__ __device__ __forceinline__ int perm32(int rho) { const int n = rho >> 4, i = rho & 15; return 8 * (i >> 2) + 4 * n + (i & 3); }

struct Unit { int pm, pn; };
struct Gemm { const bf16_t* A; const bf16_t* Bt; int M, N, K; };

struct StaticOrder {
    int nM, nN, nwg, G, c;
    __host__ __device__ void init(int M, int N, int G_, int c_) { nM = M / BM; nN = N / BM; nwg = nM * nN; G = G_; c = c_; }
    __host__ __device__ bool next(int i, Unit& u) const {
        const long L = (long)i * G + c; if (L >= nwg) return false;
        int wgid = (int)L; { const int q = nwg / NXCD, r = nwg % NXCD, xcd = wgid % NXCD, off = wgid / NXCD; wgid = (xcd < r ? xcd * (q + 1) : r * (q + 1) + (xcd - r) * q) + off; }
        const int nig = WGM * nN, gid = wgid / nig, fm = gid * WGM, gsz = (nM - fm) < WGM ? (nM - fm) : WGM;
        u.pm = fm + ((wgid % nig) % gsz); u.pn = (wgid % nig) / gsz; return true;
    }
    __device__ __forceinline__ void a_ready(const Unit&) const {}
    __device__ __forceinline__ void done(const Unit&) const {}
};

__device__ __forceinline__ unsigned cvt_pk_bf16(float lo, float hi) { unsigned r; asm volatile("v_cvt_pk_bf16_f32 %0, %1, %2" : "=v"(r) : "v"(lo), "v"(hi)); return r; }
typedef float f32x2 __attribute__((ext_vector_type(2)));
template <class Epi, class Sched, bool ALIGN_EPI = false, bool SP2 = false>
__device__ __forceinline__ void gemm_phase(PG8_LAS unsigned char* lds, const Gemm g, const Sched& S, const Epi& E) {
    const int tid = opaque_tid(), wid = __builtin_amdgcn_readfirstlane(tid >> 6), lane = tid & 63, wr = wid >> 2, wc = wid & 3, fr = lane & 15, fq = lane >> 4;
    const int K = g.K, nt = K / BK;
    unsigned voffA[2], voffB[2];
#pragma unroll
    for (int i = 0; i < 2; ++i) { int R, C; stage_rc(tid * 16 + i * 8192, R, C); const int Rb = Epi::PERM ? ((R & ~31) + perm32(R & 31)) : R;
        voffA[i] = (unsigned)(R * K + C) * 2u; voffB[i] = (unsigned)(Rb * K + C) * 2u; }
    const size_t kstep = (size_t)(BK * 2);
    const size_t hstep = (size_t)HALF * K * 2;
    const size_t tstep = 2 * hstep;
    const unsigned ldsw = (unsigned)wid * 1024u;
    const int aoff = lds_byte(wr * 64 + fr, fq * 8), boff = lds_byte(wc * 32 + fr, fq * 8);
#define PG8_SA(b, h) (((b) * 2 + (h)) * HTB)
#define PG8_SB(b, h) ((4 + (b) * 2 + (h)) * HTB)
#define PG8_STAGE(bufoff, gbase, voff) do { _Pragma("unroll") for (int _i = 0; _i < 2; ++_i) \
        __builtin_amdgcn_global_load_lds((const unsigned*)((const char*)(gbase) + (voff)[_i]), (PG8_LAS unsigned*)(lds + (bufoff) + ldsw + _i * 8192), 16, 0, 0); } while (0)
#define PG8_LDA(dst, b, h) do { _Pragma("unroll") for (int m = 0; m < 4; ++m) _Pragma("unroll") for (int k = 0; k < 2; ++k) dst[m][k] = *(const PG8_LAS bf16x8*)(lds + PG8_SA(b, h) + aoff + m * 2048 + k * 1024); } while (0)
#define PG8_LDB(dst, b, h) do { _Pragma("unroll") for (int n = 0; n < 2; ++n) _Pragma("unroll") for (int k = 0; k < 2; ++k) dst[n][k] = *(const PG8_LAS bf16x8*)(lds + PG8_SB(b, h) + boff + n * 2048 + k * 1024); } while (0)
#define PG8_MMA(ai, bj, At, Bt) do { __builtin_amdgcn_s_setprio(1); _Pragma("unroll") for (int m = 0; m < 4; ++m) _Pragma("unroll") for (int n = 0; n < 2; ++n) _Pragma("unroll") for (int k = 0; k < 2; ++k) \
        acc[ai][bj][m][n] = __builtin_amdgcn_mfma_f32_16x16x32_bf16(Bt[n][k], At[m][k], acc[ai][bj][m][n], 0, 0, 0); __builtin_amdgcn_s_setprio(0); } while (0)
#define PG8_WAIT_V(n) asm volatile("s_waitcnt vmcnt(" #n ")" ::: "memory")
#define PG8_WAIT_L(n) asm volatile("s_waitcnt lgkmcnt(" #n ")" ::: "memory")
#define PG8_BAR __builtin_amdgcn_s_barrier()
#define PG8_SCHED __builtin_amdgcn_sched_barrier(0)
    Unit cur, nxt; int ui = 0;
    if (!S.next(0, cur)) return;
    f32x4 acc[2][2][4][2];
#pragma unroll
    for (int a = 0; a < 2; ++a)
#pragma unroll
        for (int b = 0; b < 2; ++b)
#pragma unroll
            for (int m = 0; m < 4; ++m)
#pragma unroll
                for (int n = 0; n < 2; ++n) acc[a][b][m][n] = (f32x4){0.f, 0.f, 0.f, 0.f};
    bf16x8 At[4][2], B0[2][2], B1[2][2];
    const char* cA = (const char*)g.A + (size_t)cur.pm * tstep; const char* cB = (const char*)g.Bt + (size_t)cur.pn * tstep;
    S.a_ready(cur);
    if constexpr (SP2) {
        PG8_STAGE(PG8_SB(0, 0), cB, voffB); PG8_STAGE(PG8_SB(0, 1), cB + hstep, voffB); PG8_STAGE(PG8_SA(0, 0), cA, voffA); PG8_STAGE(PG8_SA(0, 1), cA + hstep, voffA);
        if (wr == 1) PG8_BAR;
        PG8_WAIT_V(2); PG8_BAR;
        PG8_STAGE(PG8_SB(1, 0), cB + kstep, voffB); PG8_STAGE(PG8_SA(1, 0), cA + kstep, voffA); PG8_STAGE(PG8_SB(1, 1), cB + hstep + kstep, voffB);
        PG8_WAIT_V(6); PG8_BAR;
    } else {
        PG8_STAGE(PG8_SB(0, 0), cB, voffB); PG8_STAGE(PG8_SA(0, 0), cA, voffA); PG8_STAGE(PG8_SB(0, 1), cB + hstep, voffB); PG8_STAGE(PG8_SA(0, 1), cA + hstep, voffA);
        if (wr == 1) PG8_BAR;
        PG8_WAIT_V(4); PG8_BAR;
        PG8_STAGE(PG8_SB(1, 0), cB + kstep, voffB); PG8_STAGE(PG8_SA(1, 0), cA + kstep, voffA); PG8_STAGE(PG8_SB(1, 1), cB + hstep + kstep, voffB);
        PG8_WAIT_V(6); PG8_BAR;
    }
    for (;;) {
        const bool has_next = S.next(ui + 1, nxt);
        const char* nA = has_next ? (const char*)g.A + (size_t)nxt.pm * tstep : cA; const char* nB = has_next ? (const char*)g.Bt + (size_t)nxt.pn * tstep : cB;
        for (int t = 0; t < nt; t += 2) {
            const bool last = (t == nt - 2);
            const char* a1 = cA + (size_t)(t + 1) * kstep;
            const char* a2 = last ? nA : cA + (size_t)(t + 2) * kstep; const char* b2 = last ? nB : cB + (size_t)(t + 2) * kstep;
            const char* a3 = a2 + kstep; const char* b3 = b2 + kstep;
            if (last && has_next) S.a_ready(nxt);
            if constexpr (SP2) {
            PG8_LDB(B0, 0, 0); PG8_LDB(B1, 0, 1); PG8_SCHED; PG8_LDA(At, 0, 0); PG8_STAGE(PG8_SA(1, 1), a1 + hstep, voffA);
            PG8_WAIT_V(8); PG8_WAIT_L(0); PG8_BAR; PG8_MMA(0, 0, At, B0); PG8_MMA(0, 1, At, B1); PG8_BAR; PG8_SCHED;
            PG8_LDA(At, 0, 1); PG8_STAGE(PG8_SB(0, 0), b2, voffB); PG8_STAGE(PG8_SB(0, 1), b2 + hstep, voffB); PG8_STAGE(PG8_SA(0, 0), a2, voffA);
            PG8_WAIT_V(8); PG8_WAIT_L(0); PG8_BAR; PG8_MMA(1, 0, At, B0); PG8_MMA(1, 1, At, B1); PG8_BAR; PG8_SCHED;
            PG8_LDB(B0, 1, 0); PG8_LDB(B1, 1, 1); PG8_SCHED; PG8_LDA(At, 1, 0); PG8_STAGE(PG8_SA(0, 1), a2 + hstep, voffA);
            PG8_WAIT_V(8); PG8_WAIT_L(0); PG8_BAR; PG8_MMA(0, 0, At, B0); PG8_MMA(0, 1, At, B1); PG8_BAR; PG8_SCHED;
            PG8_LDA(At, 1, 1); PG8_STAGE(PG8_SB(1, 0), b3, voffB); PG8_STAGE(PG8_SB(1, 1), b3 + hstep, voffB); PG8_STAGE(PG8_SA(1, 0), a3, voffA);
            PG8_WAIT_V(8); PG8_WAIT_L(0); PG8_BAR; PG8_MMA(1, 0, At, B0); PG8_MMA(1, 1, At, B1); PG8_BAR; PG8_SCHED;
            } else {
            PG8_LDB(B0, 0, 0); PG8_SCHED; PG8_LDA(At, 0, 0); PG8_STAGE(PG8_SA(1, 1), a1 + hstep, voffA);
            PG8_WAIT_L(8); PG8_BAR; PG8_WAIT_L(0); PG8_MMA(0, 0, At, B0); PG8_BAR; PG8_SCHED;
            PG8_LDB(B1, 0, 1); PG8_STAGE(PG8_SB(0, 0), b2, voffB);
            PG8_BAR; PG8_WAIT_L(0); PG8_MMA(0, 1, At, B1); PG8_BAR;
            PG8_LDA(At, 0, 1); PG8_STAGE(PG8_SA(0, 0), a2, voffA);
            PG8_BAR; PG8_WAIT_L(0); PG8_MMA(1, 0, At, B0); PG8_BAR; PG8_SCHED;
            PG8_STAGE(PG8_SB(0, 1), b2 + hstep, voffB);
            PG8_WAIT_V(6); PG8_BAR; PG8_MMA(1, 1, At, B1); PG8_BAR;
            PG8_LDB(B0, 1, 0); PG8_SCHED; PG8_LDA(At, 1, 0); PG8_STAGE(PG8_SA(0, 1), a2 + hstep, voffA);
            PG8_WAIT_L(8); PG8_BAR; PG8_WAIT_L(0); PG8_MMA(0, 0, At, B0); PG8_BAR; PG8_SCHED;
            PG8_LDB(B1, 1, 1); PG8_STAGE(PG8_SB(1, 0), b3, voffB);
            PG8_BAR; PG8_WAIT_L(0); PG8_MMA(0, 1, At, B1); PG8_BAR;
            PG8_LDA(At, 1, 1); PG8_STAGE(PG8_SA(1, 0), a3, voffA);
            PG8_BAR; PG8_WAIT_L(0); PG8_MMA(1, 0, At, B0); PG8_BAR; PG8_SCHED;
            PG8_STAGE(PG8_SB(1, 1), b3 + hstep, voffB);
            PG8_WAIT_V(6); PG8_BAR; PG8_MMA(1, 1, At, B1); PG8_BAR;
            }
        }
        if constexpr (ALIGN_EPI) { if (wr == 0) PG8_BAR; }
        if constexpr (!Epi::AFTER_DRAIN) { E(acc, cur, wr, wc, fr, fq); S.done(cur); }
        if (!has_next) break;
#pragma unroll
        for (int a = 0; a < 2; ++a)
#pragma unroll
            for (int b = 0; b < 2; ++b)
#pragma unroll
                for (int m = 0; m < 4; ++m)
#pragma unroll
                    for (int n = 0; n < 2; ++n) acc[a][b][m][n] = (f32x4){0.f, 0.f, 0.f, 0.f};
        cur = nxt; cA = nA; cB = nB; ++ui;
        if constexpr (ALIGN_EPI) { if (wr == 1) PG8_BAR; }
    }
    PG8_WAIT_V(0);
    if constexpr (!ALIGN_EPI) { if (wr == 0) PG8_BAR; }
    PG8_BAR;
    if constexpr (Epi::AFTER_DRAIN) { E.fused(acc, cur, wr, wc, fr, fq, lds, wid, lane); S.done(cur); }
#undef PG8_SA
#undef PG8_SB
#undef PG8_STAGE
#undef PG8_LDA
#undef PG8_LDB
#undef PG8_MMA
#undef PG8_WAIT_V
#undef PG8_WAIT_L
#undef PG8_BAR
#undef PG8_SCHED
}
}
#define LAS __attribute__((address_space(3)))
typedef unsigned short bf16_t;
typedef short bf16x8 __attribute__((ext_vector_type(8)));
typedef float f32x4 __attribute__((ext_vector_type(4)));
typedef float f32x2 __attribute__((ext_vector_type(2)));
typedef float f32x16 __attribute__((ext_vector_type(16)));
typedef unsigned u32x4 __attribute__((ext_vector_type(4)));
typedef unsigned u32x2 __attribute__((ext_vector_type(2)));

constexpr int NTOK = 16384, DM = 2048, SEQ = 2048, NBATCH = 8, PLE = 256;
constexpr int NPROJ = 6144;
constexpr int PQ_SB = 0, PK_SB = 1024, PG_SB = 2048, PQ_DF = 3072, PK_DF = 4096, PG_DF = 5120;
constexpr float LOG2E = 1.4426950408889634f;
constexpr float SBQ_SCALE = 0.08838834764831845f * LOG2E;
constexpr float DFQ_SCALE = 0.125f * LOG2E;
constexpr float NORM_EPS = 1e-6f, SUBLN_EPS = 1e-5f;
constexpr float LAMBDA_INIT = 0.2f;

constexpr size_t MiB = 1u << 20;
constexpr size_t WS_CTL = 0;
constexpr size_t CTL_SS2 = 0, CTL_SS3 = 65536, CTL_LAM = 131072, CTL_ROPE = 262144, CTL_BAR = 524288, CTL_BAR_BYTES = 16384;
constexpr size_t WS_WIN = 2 * MiB, WS_WOUT = 34 * MiB, WS_WGATE = 42 * MiB, WS_WPROJ = 50 * MiB, WS_PB = 52 * MiB;
constexpr size_t WS_XN = 64 * MiB, WS_MIXED = 64 * MiB;
constexpr size_t WS_PROJ = 128 * MiB, WS_VT = 320 * MiB, WS_KIMG = 384 * MiB, WS_END = 448 * MiB;
constexpr size_t WS_HB = 128 * MiB, WS_PLE = 192 * MiB;
constexpr size_t WS_H2B = 64 * MiB;

constexpr int LDS_BYTES = 131072 + 1024;

typedef __bf16 bf16x2_t __attribute__((ext_vector_type(2)));
__device__ __forceinline__ unsigned cvt_pk(float lo, float hi) { f32x2 v = {lo, hi}; bf16x2_t b = __builtin_convertvector(v, bf16x2_t); return __builtin_bit_cast(unsigned, b); }
__device__ __forceinline__ float bf_lo(unsigned w) { return __uint_as_float(w << 16); }
__device__ __forceinline__ float bf_hi(unsigned w) { return __uint_as_float(w & 0xffff0000u); }
__device__ __forceinline__ float wave_sum(float v) {
#pragma unroll
    for (int o = 1; o < 64; o <<= 1) v += __shfl_xor(v, o);
    return v;
}
__device__ __forceinline__ float fast_exp2(float x) { return __builtin_amdgcn_exp2f(x); }
__device__ __forceinline__ float fast_log2(float x) { return __builtin_amdgcn_logf(x); }
__device__ __forceinline__ float silu_f(float x) { return x * __builtin_amdgcn_rcpf(1.f + fast_exp2(-x * LOG2E)); }
__device__ __forceinline__ float sigmoid_f(float x) { return __builtin_amdgcn_rcpf(1.f + fast_exp2(-x * LOG2E)); }

namespace pg8 {
struct EpiBf16 {
    static constexpr bool PERM = true, AFTER_DRAIN = false;
    bf16_t* O; int ldc;
    __device__ __forceinline__ void operator()(const f32x4 (&acc)[2][2][4][2], const Unit& u, int wr, int wc, int fr, int fq) const {
        const int row0 = u.pm * BM + wr * 64 + fr; const int col0 = u.pn * BM + wc * 32 + 8 * fq;
#pragma unroll
        for (int ai = 0; ai < 2; ++ai)
#pragma unroll
            for (int m = 0; m < 4; ++m) { bf16_t* rowp = O + (size_t)(row0 + ai * HALF + m * 16) * ldc + col0;
#pragma unroll
                for (int bj = 0; bj < 2; ++bj) { const f32x4 v0 = acc[ai][bj][m][0], v1 = acc[ai][bj][m][1];
                    u32x4 w; w.x = cvt_pk_bf16(v0[0], v0[1]); w.y = cvt_pk_bf16(v0[2], v0[3]); w.z = cvt_pk_bf16(v1[0], v1[1]); w.w = cvt_pk_bf16(v1[2], v1[3]);
                    *(u32x4*)(rowp + bj * HALF) = w; } }
    }
};
struct EpiProj {
    static constexpr bool PERM = true, AFTER_DRAIN = false;
    bf16_t* O; const float* rope; bf16_t* KI;
    __device__ __forceinline__ void operator()(const f32x4 (&acc)[2][2][4][2], const Unit& u, int wr, int wc, int fr, int fq) const {
        const int row0 = u.pm * BM + wr * 64 + fr; const int col0 = u.pn * BM + wc * 32 + 8 * fq;
        const int kind = u.pn >> 2;
        const bool dorope = (kind == 3 || kind == 4) && ((wc & 1) == 0) && (fq < 2);
        const float sc = kind == 0 ? SBQ_SCALE : (kind == 3 ? DFQ_SCALE : 1.f);
        const bool dosilu = (kind == 2 || kind == 5);
#pragma unroll
        for (int ai = 0; ai < 2; ++ai)
#pragma unroll
            for (int m = 0; m < 4; ++m) { const int row = row0 + ai * HALF + m * 16; bf16_t* rowp = O + (size_t)row * NPROJ + col0;
                if (kind == 1 || kind == 4) {
                    const int cw = col0 & 1023; rowp = KI + ((size_t)(((kind == 4 ? 8 : 0) + (row >> 11)) * 8 + (cw >> 7)) * SEQ + (row & (SEQ - 1))) * 128 + (cw & 127); }
                f32x4 cs0 = {1.f, 0.f, 1.f, 0.f}, cs1 = {1.f, 0.f, 1.f, 0.f};
                if (dorope) { const f32x4* rp = (const f32x4*)(rope + ((size_t)(row & (SEQ - 1)) * 8 + 4 * fq) * 2); cs0 = rp[0]; cs1 = rp[1]; }
#pragma unroll
                for (int bj = 0; bj < 2; ++bj) { f32x4 v0 = acc[ai][bj][m][0], v1 = acc[ai][bj][m][1];
                    if (dorope) {
                        f32x4 a, b;
                        a[0] = v0[0] * cs0[0] - v0[1] * cs0[1]; a[1] = v0[1] * cs0[0] + v0[0] * cs0[1];
                        a[2] = v0[2] * cs0[2] - v0[3] * cs0[3]; a[3] = v0[3] * cs0[2] + v0[2] * cs0[3];
                        b[0] = v1[0] * cs1[0] - v1[1] * cs1[1]; b[1] = v1[1] * cs1[0] + v1[0] * cs1[1];
                        b[2] = v1[2] * cs1[2] - v1[3] * cs1[3]; b[3] = v1[3] * cs1[2] + v1[2] * cs1[3];
                        v0 = a; v1 = b; }
                    if (dosilu) {
#pragma unroll
                        for (int j = 0; j < 4; ++j) { v0[j] = silu_f(v0[j]); v1[j] = silu_f(v1[j]); } }
                    v0 = v0 * sc; v1 = v1 * sc;
                    u32x4 w; w.x = cvt_pk_bf16(v0[0], v0[1]); w.y = cvt_pk_bf16(v0[2], v0[3]); w.z = cvt_pk_bf16(v1[0], v1[1]); w.w = cvt_pk_bf16(v1[2], v1[3]);
                    *(u32x4*)(rowp + ((kind == 1 || kind == 4) ? bj * SEQ * 128 : bj * HALF)) = w; } }
    }
};
struct EpiVt {
    static constexpr bool PERM = true, AFTER_DRAIN = false;
    bf16_t* O;
    __device__ __forceinline__ void operator()(const f32x4 (&acc)[2][2][4][2], const Unit& u, int wr, int wc, int fr, int fq) const {
        const int row0 = u.pm * BM + wr * 64 + fr; const int col0 = u.pn * BM + wc * 32 + 8 * fq;
        const int p0 = (fq & 1) ? 4 : 0, p1 = (fq & 1) ? 12 : 8;
#pragma unroll
        for (int ai = 0; ai < 2; ++ai)
#pragma unroll
            for (int m = 0; m < 4; ++m) { const int row = row0 + ai * HALF + m * 16; const int gh = row >> 7, d = row & 127;
#pragma unroll
                for (int bj = 0; bj < 2; ++bj) { const int col = col0 + bj * HALF; const int b = col >> 11, sq = col & (SEQ - 1);
                    bf16_t* tp = O + ((size_t)((((gh >> 3) * 8 + b) * 8 + (gh & 7)) * 32 + (sq >> 6)) * 128 + d) * 64 + (sq & 48);
                    const f32x4 v0 = acc[ai][bj][m][0], v1 = acc[ai][bj][m][1];
                    u32x2 w0, w1; w0.x = cvt_pk_bf16(v0[0], v0[1]); w0.y = cvt_pk_bf16(v0[2], v0[3]); w1.x = cvt_pk_bf16(v1[0], v1[1]); w1.y = cvt_pk_bf16(v1[2], v1[3]);
                    *(u32x2*)(tp + p0) = w0; *(u32x2*)(tp + p1) = w1; } }
    }
};
struct EpiRes {
    static constexpr bool PERM = true, AFTER_DRAIN = false;
    const float* x; bf16_t* hb; float* ss;
    __device__ __forceinline__ void operator()(const f32x4 (&acc)[2][2][4][2], const Unit& u, int wr, int wc, int fr, int fq) const {
        const int row0 = u.pm * BM + wr * 64 + fr; const int col0 = u.pn * BM + wc * 32 + 8 * fq;
#pragma unroll
        for (int ai = 0; ai < 2; ++ai)
#pragma unroll
            for (int m = 0; m < 4; ++m) { const int row = row0 + ai * HALF + m * 16; const size_t off = (size_t)row * DM + col0; float q = 0.f;
#pragma unroll
                for (int bj = 0; bj < 2; ++bj) { const size_t o2 = off + bj * HALF;
                    const f32x4 h0 = __builtin_nontemporal_load((const f32x4*)(x + o2)) + acc[ai][bj][m][0], h1 = __builtin_nontemporal_load((const f32x4*)(x + o2 + 4)) + acc[ai][bj][m][1];
                    u32x4 w; w.x = cvt_pk_bf16(h0[0], h0[1]); w.y = cvt_pk_bf16(h0[2], h0[3]); w.z = cvt_pk_bf16(h1[0], h1[1]); w.w = cvt_pk_bf16(h1[2], h1[3]);
                    *(u32x4*)(hb + o2) = w;
                    q += ((h0[0] * h0[0] + h0[1] * h0[1]) + (h0[2] * h0[2] + h0[3] * h0[3])) + ((h1[0] * h1[0] + h1[1] * h1[1]) + (h1[2] * h1[2] + h1[3] * h1[3])); }
                q += __shfl_xor(q, 16); q += __shfl_xor(q, 32);
                if (fq == 0) atomicAdd(ss + row, q); }
    }
};
struct EpiGate {
    static constexpr bool PERM = true, AFTER_DRAIN = false;
    const bf16_t* hb; bf16_t* h2b; const bf16_t* ple; const float* ss2; float* ss3;
    __device__ __forceinline__ void operator()(const f32x4 (&acc)[2][2][4][2], const Unit& u, int wr, int wc, int fr, int fq) const {
        const int row0 = u.pm * BM + wr * 64 + fr; const int col0 = u.pn * BM + wc * 32 + 8 * fq;
#pragma unroll
        for (int ai = 0; ai < 2; ++ai)
#pragma unroll
            for (int m = 0; m < 4; ++m) { const int row = row0 + ai * HALF + m * 16; const size_t off = (size_t)row * DM + col0; float q = 0.f;
                const float rstd = rsqrtf(ss2[row] * (1.f / DM) + NORM_EPS);
#pragma unroll
                for (int bj = 0; bj < 2; ++bj) { const size_t o2 = off + bj * HALF; const u32x4 hw = *(const u32x4*)(hb + o2); const u32x4 pw = *(const u32x4*)(ple + o2);
                    const f32x4 a0 = acc[ai][bj][m][0] * rstd, a1 = acc[ai][bj][m][1] * rstd; f32x4 g0, g1;
                    g0[0] = bf_lo(hw.x) + sigmoid_f(a0[0]) * bf_lo(pw.x); g0[1] = bf_hi(hw.x) + sigmoid_f(a0[1]) * bf_hi(pw.x);
                    g0[2] = bf_lo(hw.y) + sigmoid_f(a0[2]) * bf_lo(pw.y); g0[3] = bf_hi(hw.y) + sigmoid_f(a0[3]) * bf_hi(pw.y);
                    g1[0] = bf_lo(hw.z) + sigmoid_f(a1[0]) * bf_lo(pw.z); g1[1] = bf_hi(hw.z) + sigmoid_f(a1[1]) * bf_hi(pw.z);
                    g1[2] = bf_lo(hw.w) + sigmoid_f(a1[2]) * bf_lo(pw.w); g1[3] = bf_hi(hw.w) + sigmoid_f(a1[3]) * bf_hi(pw.w);
                    u32x4 w2; w2.x = cvt_pk_bf16(g0[0], g0[1]); w2.y = cvt_pk_bf16(g0[2], g0[3]); w2.z = cvt_pk_bf16(g1[0], g1[1]); w2.w = cvt_pk_bf16(g1[2], g1[3]);
                    *(u32x4*)(h2b + o2) = w2;
                    q += ((g0[0] * g0[0] + g0[1] * g0[1]) + (g0[2] * g0[2] + g0[3] * g0[3])) + ((g1[0] * g1[0] + g1[1] * g1[1]) + (g1[2] * g1[2] + g1[3] * g1[3])); }
                q += __shfl_xor(q, 16); q += __shfl_xor(q, 32);
                if (fq == 0) atomicAdd(ss3 + row, q); }
    }
};
}
namespace att {
constexpr int KP = 272, VP = 144, KT_BYTES = 64 * KP, VT_BYTES = 128 * VP, BUF_BYTES = KT_BYTES + VT_BYTES;
constexpr int FLAG_OFF = 2 * BUF_BYTES;
constexpr int XP = 132;
constexpr float R_DONE = 152.0f;

template <bool MASK>
__device__ __forceinline__ void sb_block(const f32x16& sv, int kbase, int tq, int h, float& R, bf16x8 (&pf)[2]) {
    float c[16], z[16];
#pragma unroll
    for (int i = 0; i < 16; ++i) {
        z[i] = (!MASK || (kbase + 8 * (i >> 2) + (i & 3) < tq)) ? sv[i] : -1e30f;
        c[i] = fmaxf(z[i], 0.f) + fast_log2(1.f + fast_exp2(-fabsf(z[i])));
    }
    float T[4], OT[4], pr[4], suf[4];
#pragma unroll
    for (int g = 0; g < 4; ++g) { c[4 * g + 2] += c[4 * g + 3]; c[4 * g + 1] += c[4 * g + 2]; c[4 * g] += c[4 * g + 1]; T[g] = c[4 * g]; }
#pragma unroll
    for (int g = 0; g < 4; ++g) { OT[g] = __shfl_xor(T[g], 32); pr[g] = T[g] + OT[g]; }
    suf[3] = 0.f; suf[2] = pr[3]; suf[1] = suf[2] + pr[2]; suf[0] = suf[1] + pr[1];
    float w[16];
#pragma unroll
    for (int g = 0; g < 4; ++g) { const float off = R + suf[g] + (h == 0 ? OT[g] : 0.f);
#pragma unroll
        for (int j = 0; j < 4; ++j) { const int i = 4 * g + j; w[i] = fast_exp2(z[i] - (off + c[i])); } }
    R += suf[0] + pr[0];
#pragma unroll
    for (int sp = 0; sp < 2; ++sp) { u32x4 p; p.x = cvt_pk(w[8 * sp], w[8 * sp + 1]); p.y = cvt_pk(w[8 * sp + 2], w[8 * sp + 3]); p.z = cvt_pk(w[8 * sp + 4], w[8 * sp + 5]); p.w = cvt_pk(w[8 * sp + 6], w[8 * sp + 7]);
        pf[sp] = __builtin_bit_cast(bf16x8, p); }
}

template <int MODE>
__device__ __forceinline__ void attn_unit(LAS unsigned char* lds, const bf16_t* __restrict__ PROJ, const bf16_t* __restrict__ KIMG, const bf16_t* __restrict__ VT, bf16_t* __restrict__ MIXED,
                                          int b, int hh, int qblk, float lam, const float* __restrict__ subln_g) {
    constexpr int QB = MODE == 0 ? 256 : 128;
    constexpr int NKS = MODE == 0 ? 8 : 4;
    const int tid = opaque_tid(), lane = tid & 63, r = lane & 31, h = lane >> 5;
    const int wid = __builtin_amdgcn_readfirstlane(tid >> 6);
    const int qg = MODE == 0 ? wid : (wid & 3), role = MODE == 0 ? 0 : (wid >> 2);
    const int Q0 = qblk * QB, q0w = Q0 + 32 * qg, tq = q0w + r;
    const size_t tokbase = (size_t)b * SEQ;
    const int gbh = ((MODE == 0 ? 0 : 8) + b) * 8 + hh;
    const bf16_t* Kg = KIMG + (size_t)gbh * SEQ * 128;
    const bf16_t* Vg = VT + (size_t)gbh * 32 * 8192;
    bf16x8 qf[NKS];
    { const bf16_t* qp = PROJ + (tokbase + tq) * NPROJ + (MODE == 0 ? PQ_SB + hh * 128 : PQ_DF + hh * 128 + role * 64) + 8 * h;
#pragma unroll
      for (int ks = 0; ks < NKS; ++ks) qf[ks] = *(const bf16x8*)(qp + 16 * ks); }
    f32x16 o[4];
#pragma unroll
    for (int d = 0; d < 4; ++d)
#pragma unroll
        for (int i = 0; i < 16; ++i) o[d][i] = 0.f;
    float R = 0.f, m_run = -1e30f, l_run = 0.f;
    const int kr0 = tid >> 4, kc = tid & 15, vr0 = tid >> 3, vc = tid & 7;
    const int kst = kr0 * KP + kc * 16, vst = KT_BYTES + vr0 * VP + vc * 16;
    const bf16_t* kgl = Kg + tid * 8;
    const bf16_t* vgl = Vg + tid * 8;
    u32x4 kreg[2], vreg[2];
#define ATT_LOAD(t) do { _Pragma("unroll") for (int i_ = 0; i_ < 2; ++i_) { \
        kreg[i_] = *(const u32x4*)(kgl + (size_t)(t) * 8192 + i_ * 4096); \
        vreg[i_] = *(const u32x4*)(vgl + (size_t)(t) * 8192 + i_ * 4096); } } while (0)
#define ATT_STORE(bo) do { _Pragma("unroll") for (int i_ = 0; i_ < 2; ++i_) { \
        *(LAS u32x4*)(lds + (bo) + kst + i_ * 32 * KP) = kreg[i_]; \
        *(LAS u32x4*)(lds + (bo) + vst + i_ * 64 * VP) = vreg[i_]; } } while (0)
    const int tl = (Q0 + QB - 1) >> 6;
    const int kfrag = r * KP + (role * 64 + 8 * h) * 2;
    const int vfrag = KT_BYTES + r * VP + (8 * h) * 2;
    volatile LAS int* flags = (volatile LAS int*)(lds + FLAG_OFF);
    __syncthreads();
    ATT_LOAD(tl); ATT_STORE(0);
    __syncthreads();
    int cur = 0, it = 0;
    bool wdone = false;
    for (int t = tl;; --t, ++it) {
        if (t > 0) ATT_LOAD(t - 1);
        const int k0 = 64 * t;
        const bool active = (MODE == 0) ? (!wdone && k0 <= q0w + 30) : (k0 <= q0w + 31);
        if (active) {
            const int bo = cur * BUF_BYTES;
            f32x16 s[2];
            bf16x8 vf[4][2][2];
            if (MODE == 1) {
                bf16x8 kf[2][NKS];
#pragma unroll
                for (int kb = 0; kb < 2; ++kb)
#pragma unroll
                    for (int ks = 0; ks < NKS; ++ks) kf[kb][ks] = *(const LAS bf16x8*)(lds + bo + kfrag + kb * 32 * KP + ks * 32);
                __builtin_amdgcn_sched_barrier(0);
#pragma unroll
                for (int kb = 0; kb < 2; ++kb) {
#pragma unroll
                    for (int i = 0; i < 16; ++i) s[kb][i] = 0.f;
#pragma unroll
                    for (int ks = 0; ks < NKS; ++ks) s[kb] = __builtin_amdgcn_mfma_f32_32x32x16_bf16(kf[kb][ks], qf[ks], s[kb], 0, 0, 0);
                }
                __builtin_amdgcn_sched_barrier(0);
#pragma unroll
                for (int d = 0; d < 2; ++d)
#pragma unroll
                    for (int kb = 0; kb < 2; ++kb)
#pragma unroll
                        for (int sp = 0; sp < 2; ++sp) vf[d][kb][sp] = *(const LAS bf16x8*)(lds + bo + vfrag + d * 32 * VP + (32 * kb + 16 * sp) * 2);
                __builtin_amdgcn_sched_barrier(0);
            } else {
#pragma unroll
                for (int kb = 0; kb < 2; ++kb) {
#pragma unroll
                    for (int i = 0; i < 16; ++i) s[kb][i] = 0.f;
#pragma unroll
                    for (int ks = 0; ks < NKS; ++ks) {
                        const bf16x8 a = *(const LAS bf16x8*)(lds + bo + kfrag + kb * 32 * KP + ks * 32);
                        s[kb] = __builtin_amdgcn_mfma_f32_32x32x16_bf16(a, qf[ks], s[kb], 0, 0, 0);
                    }
                }
            }
            bf16x8 pf[2][2];
            if (MODE == 0) {
                sb_block<true>(s[1], k0 + 32 + 4 * h, tq, h, R, pf[1]);
                if (__all(R >= R_DONE)) {
#pragma unroll
                    for (int sp = 0; sp < 2; ++sp)
#pragma unroll
                        for (int j = 0; j < 8; ++j) pf[0][sp][j] = 0;
                } else sb_block<true>(s[0], k0 + 4 * h, tq, h, R, pf[0]);
                wdone = __all(R >= R_DONE);
            } else {
                float mx = -1e30f;
                if (k0 + 63 > q0w) {
#pragma unroll
                    for (int kb = 0; kb < 2; ++kb) { const int kbase = k0 + 32 * kb + 4 * h;
#pragma unroll
                        for (int i = 0; i < 16; ++i) { const int key = kbase + 8 * (i >> 2) + (i & 3); const float v = (key <= tq) ? s[kb][i] : -1e30f; s[kb][i] = v; mx = fmaxf(mx, v); } }
                } else {
#pragma unroll
                    for (int kb = 0; kb < 2; ++kb)
#pragma unroll
                        for (int i = 0; i < 16; ++i) mx = fmaxf(mx, s[kb][i]);
                }
                mx = fmaxf(mx, __shfl_xor(mx, 32));
                const float m_new = fmaxf(m_run, mx), alpha = fast_exp2(m_run - m_new);
                m_run = m_new;
                float ls = 0.f;
#pragma unroll
                for (int kb = 0; kb < 2; ++kb) {
#pragma unroll
                    for (int i = 0; i < 16; ++i) { const float p = fast_exp2(s[kb][i] - m_new); s[kb][i] = p; ls += p; }
#pragma unroll
                    for (int sp = 0; sp < 2; ++sp) { u32x4 p; p.x = cvt_pk(s[kb][8 * sp], s[kb][8 * sp + 1]); p.y = cvt_pk(s[kb][8 * sp + 2], s[kb][8 * sp + 3]); p.z = cvt_pk(s[kb][8 * sp + 4], s[kb][8 * sp + 5]); p.w = cvt_pk(s[kb][8 * sp + 6], s[kb][8 * sp + 7]);
                        pf[kb][sp] = __builtin_bit_cast(bf16x8, p); }
                }
                l_run = l_run * alpha + ls;
                if (!__all(alpha == 1.f)) {
#pragma unroll
                    for (int d = 0; d < 4; ++d)
#pragma unroll
                        for (int i = 0; i < 16; ++i) o[d][i] *= alpha;
                }
            }
            if (MODE == 1) {
                __builtin_amdgcn_sched_barrier(0);
#pragma unroll
                for (int d = 2; d < 4; ++d)
#pragma unroll
                    for (int kb = 0; kb < 2; ++kb)
#pragma unroll
                        for (int sp = 0; sp < 2; ++sp) vf[d][kb][sp] = *(const LAS bf16x8*)(lds + bo + vfrag + d * 32 * VP + (32 * kb + 16 * sp) * 2);
                __builtin_amdgcn_sched_barrier(0);
            }
#pragma unroll
            for (int d = 0; d < 4; ++d)
#pragma unroll
                for (int kb = 0; kb < 2; ++kb)
#pragma unroll
                    for (int sp = 0; sp < 2; ++sp) {
                        const bf16x8 a = (MODE == 1) ? vf[d][kb][sp] : *(const LAS bf16x8*)(lds + bo + vfrag + d * 32 * VP + (32 * kb + 16 * sp) * 2);
                        o[d] = __builtin_amdgcn_mfma_f32_32x32x16_bf16(a, pf[kb][sp], o[d], 0, 0, 0);
                    }
        }
        if (t > 0) ATT_STORE((cur ^ 1) * BUF_BYTES);
        if (MODE == 0) { if (lane == 0) flags[(it & 1) * 8 + wid] = wdone ? 1 : 0; }
        __syncthreads();
        if (t == 0) break;
        if (MODE == 0) { int alld = 1;
#pragma unroll
            for (int w2 = 0; w2 < 8; ++w2) alld &= flags[(it & 1) * 8 + w2];
            if (alld) break; }
        cur ^= 1;
    }
#undef ATT_LOAD
#undef ATT_STORE
    const int erow = lane >> 4, ech = lane & 15;
    const size_t tok0 = tokbase + q0w;
    if (MODE == 0 || role == 0) {
    }
    u32x4 gw[8];
    if (MODE == 0 || role == 0) {
        const bf16_t* gp = PROJ + (tok0 + erow) * NPROJ + (MODE == 0 ? PG_SB : PG_DF) + hh * 128 + ech * 8;
#pragma unroll
        for (int i = 0; i < 8; ++i) gw[i] = *(const u32x4*)(gp + (size_t)(4 * i) * NPROJ);
    }
    LAS unsigned char* stg = lds + (MODE == 0 ? wid * 8704 : 69632 + qg * 8704);
    if (MODE == 0) {
#pragma unroll
        for (int d = 0; d < 4; ++d)
#pragma unroll
            for (int g = 0; g < 4; ++g) { u32x2 w; w.x = cvt_pk(o[d][4 * g], o[d][4 * g + 1]); w.y = cvt_pk(o[d][4 * g + 2], o[d][4 * g + 3]);
                *(LAS u32x2*)(stg + r * 272 + (32 * d + 8 * g + 4 * h) * 2) = w; }
    } else {
        const float lt = l_run + __shfl_xor(l_run, 32);
        const float inv = 1.f / lt;
        LAS float* xq = (LAS float*)lds + (qg * 32 + r) * XP + 4 * h;
        if (role == 1) {
            const float f = inv * lam;
#pragma unroll
            for (int d = 0; d < 4; ++d)
#pragma unroll
                for (int g = 0; g < 4; ++g) *(LAS f32x4*)(xq + 32 * d + 8 * g) = (f32x4){o[d][4 * g] * f, o[d][4 * g + 1] * f, o[d][4 * g + 2] * f, o[d][4 * g + 3] * f};
        }
        __syncthreads();
        if (role == 0) {
            float q = 0.f;
#pragma unroll
            for (int d = 0; d < 4; ++d)
#pragma unroll
                for (int g = 0; g < 4; ++g) { const f32x4 x2 = *(const LAS f32x4*)(xq + 32 * d + 8 * g);
#pragma unroll
                    for (int j = 0; j < 4; ++j) { const float v = o[d][4 * g + j] * inv - x2[j]; o[d][4 * g + j] = v; q += v * v; } }
            q += __shfl_xor(q, 32);
            const float rs = rsqrtf(q * (1.f / 128.f) + SUBLN_EPS) * (1.f - LAMBDA_INIT);
            const float* sg = subln_g + 4 * h;
#pragma unroll
            for (int d = 0; d < 4; ++d)
#pragma unroll
                for (int g = 0; g < 4; ++g) { const f32x4 sv = *(const f32x4*)(sg + 32 * d + 8 * g);
                    u32x2 w; w.x = cvt_pk(o[d][4 * g] * rs * sv[0], o[d][4 * g + 1] * rs * sv[1]); w.y = cvt_pk(o[d][4 * g + 2] * rs * sv[2], o[d][4 * g + 3] * rs * sv[3]);
                    *(LAS u32x2*)(stg + r * 272 + (32 * d + 8 * g + 4 * h) * 2) = w; }
        }
    }
    if (MODE == 0 || role == 0) {
        asm volatile("s_waitcnt lgkmcnt(0)" ::: "memory");
        bf16_t* op = MIXED + (tok0 + erow) * DM + (MODE == 0 ? 0 : 1024) + hh * 128 + ech * 8;
#pragma unroll
        for (int i = 0; i < 8; ++i) { const u32x4 ov = *(const LAS u32x4*)(stg + (4 * i + erow) * 272 + ech * 16); const u32x4 g4 = gw[i];
            u32x4 w; w.x = cvt_pk(bf_lo(ov.x) * bf_lo(g4.x), bf_hi(ov.x) * bf_hi(g4.x)); w.y = cvt_pk(bf_lo(ov.y) * bf_lo(g4.y), bf_hi(ov.y) * bf_hi(g4.y));
            w.z = cvt_pk(bf_lo(ov.z) * bf_lo(g4.z), bf_hi(ov.z) * bf_hi(g4.z)); w.w = cvt_pk(bf_lo(ov.w) * bf_lo(g4.w), bf_hi(ov.w) * bf_hi(g4.w));
            *(u32x4*)(op + (size_t)(4 * i) * DM) = w; }
    }
}

__device__ __forceinline__ void attn_unit_df(LAS unsigned char* lds, const bf16_t* __restrict__ PROJ, const bf16_t* __restrict__ KIMG, const bf16_t* __restrict__ VT, bf16_t* __restrict__ MIXED,
                                             int b, int hh, int qblk, float lam, const float* __restrict__ subln_g) {
    constexpr int VB0 = 2 * KT_BYTES;
    const int tid = opaque_tid(), lane = tid & 63, r = lane & 31, h = lane >> 5;
    const int wid = __builtin_amdgcn_readfirstlane(tid >> 6);
    const int qg = wid & 3, role = wid >> 2;
    const int Q0 = qblk * 128, q0w = Q0 + 32 * qg, tq = q0w + r;
    const size_t tokbase = (size_t)b * SEQ;
    const int gbh = (8 + b) * 8 + hh;
    const bf16_t* Kg = KIMG + (size_t)gbh * SEQ * 128;
    const bf16_t* Vg = VT + (size_t)gbh * 32 * 8192;
    bf16x8 qf[4];
    { const bf16_t* qp = PROJ + (tokbase + tq) * NPROJ + PQ_DF + hh * 128 + role * 64 + 8 * h;
#pragma unroll
      for (int ks = 0; ks < 4; ++ks) qf[ks] = *(const bf16x8*)(qp + 16 * ks); }
    f32x16 o[4];
#pragma unroll
    for (int d = 0; d < 4; ++d)
#pragma unroll
        for (int i = 0; i < 16; ++i) o[d][i] = 0.f;
    float m_run = -1e30f, l_run = 0.f, alpha = 1.f;
    f32x16 negm;
#pragma unroll
    for (int j = 0; j < 16; ++j) negm[j] = 0.f;
    const int kr0 = tid >> 4, kc = tid & 15, vr0 = tid >> 3, vc = tid & 7;
    const int kst = kr0 * KP + kc * 16, vst = vr0 * VP + vc * 16;
    const bf16_t* kgl = Kg + tid * 8;
    const bf16_t* vgl = Vg + tid * 8;
    u32x4 kreg[2], vreg[2];
#define DF_LOAD(t) do { _Pragma("unroll") for (int i_ = 0; i_ < 2; ++i_) { \
        kreg[i_] = *(const u32x4*)(kgl + (size_t)(t) * 8192 + i_ * 4096); \
        vreg[i_] = *(const u32x4*)(vgl + (size_t)(t) * 8192 + i_ * 4096); } } while (0)
#define DF_STORE(ko, vo) do { _Pragma("unroll") for (int i_ = 0; i_ < 2; ++i_) { \
        *(LAS u32x4*)(lds + (ko) + kst + i_ * 32 * KP) = kreg[i_]; \
        *(LAS u32x4*)(lds + (vo) + vst + i_ * 64 * VP) = vreg[i_]; } } while (0)
#define DF_VLOAD(vo) do { _Pragma("unroll") for (int d_ = 0; d_ < 4; ++d_) _Pragma("unroll") for (int kb_ = 0; kb_ < 2; ++kb_) _Pragma("unroll") for (int sp_ = 0; sp_ < 2; ++sp_) \
        vf[d_][kb_][sp_] = *(const LAS bf16x8*)(lds + (vo) + vfrag + d_ * 32 * VP + (32 * kb_ + 16 * sp_) * 2); } while (0)
#define DF_PV() do { _Pragma("unroll") for (int d_ = 0; d_ < 4; ++d_) _Pragma("unroll") for (int kb_ = 0; kb_ < 2; ++kb_) _Pragma("unroll") for (int sp_ = 0; sp_ < 2; ++sp_) \
        o[d_] = __builtin_amdgcn_mfma_f32_32x32x16_bf16(vf[d_][kb_][sp_], pf[kb_][sp_], o[d_], 0, 0, 0); } while (0)
#define DF_RESCALE() do { if (!__all(alpha == 1.f)) { _Pragma("unroll") for (int d_ = 0; d_ < 4; ++d_) _Pragma("unroll") for (int i_ = 0; i_ < 16; ++i_) o[d_][i_] *= alpha; } } while (0)
    const int tl = (Q0 + 127) >> 6, NT = tl + 1;
    const int kfrag = r * KP + (role * 64 + 8 * h) * 2;
    const int vfrag = r * VP + (8 * h) * 2;
    __syncthreads();
    DF_LOAD(tl); DF_STORE(0, VB0);
    __syncthreads();
    bool have_p = false;
    bf16x8 pf[2][2];
    for (int i = 0; i < NT; ++i) {
        const int t = tl - i, k0 = 64 * t;
        if (t > 0) DF_LOAD(t - 1);
        if (k0 <= q0w + 31) {
            const int ko = (i & 1) * KT_BYTES;
            bf16x8 kf[2][4];
#pragma unroll
            for (int kb = 0; kb < 2; ++kb)
#pragma unroll
                for (int ks = 0; ks < 4; ++ks) kf[kb][ks] = *(const LAS bf16x8*)(lds + ko + kfrag + kb * 32 * KP + ks * 32);
            f32x16 s[2];
#pragma unroll
            for (int kb = 0; kb < 2; ++kb) {
                s[kb] = __builtin_amdgcn_mfma_f32_32x32x16_bf16(kf[kb][0], qf[0], negm, 0, 0, 0);
#pragma unroll
                for (int ks = 1; ks < 4; ++ks) s[kb] = __builtin_amdgcn_mfma_f32_32x32x16_bf16(kf[kb][ks], qf[ks], s[kb], 0, 0, 0);
            }
            if (!have_p) {
                float mx = -1e30f;
#pragma unroll
                for (int kb = 0; kb < 2; ++kb) { const int kbase = k0 + 32 * kb + 4 * h;
#pragma unroll
                    for (int j = 0; j < 16; ++j) { const int key = kbase + 8 * (j >> 2) + (j & 3); const float v = (key <= tq) ? s[kb][j] : -1e30f; s[kb][j] = v; mx = fmaxf(mx, v); } }
                mx = fmaxf(mx, __shfl_xor(mx, 32));
                m_run = mx; alpha = 1.f;
                float ls = 0.f;
#pragma unroll
                for (int kb = 0; kb < 2; ++kb) {
#pragma unroll
                    for (int j = 0; j < 16; ++j) { const float p = fast_exp2(s[kb][j] - mx); s[kb][j] = p; ls += p; }
#pragma unroll
                    for (int sp = 0; sp < 2; ++sp) { u32x4 p; p.x = cvt_pk(s[kb][8 * sp], s[kb][8 * sp + 1]); p.y = cvt_pk(s[kb][8 * sp + 2], s[kb][8 * sp + 3]); p.z = cvt_pk(s[kb][8 * sp + 4], s[kb][8 * sp + 5]); p.w = cvt_pk(s[kb][8 * sp + 6], s[kb][8 * sp + 7]);
                        pf[kb][sp] = __builtin_bit_cast(bf16x8, p); }
                }
                l_run = ls;
#pragma unroll
                for (int j = 0; j < 16; ++j) negm[j] = -m_run;
                asm volatile("" : "+v"(negm));
                have_p = true;
            } else {
                DF_RESCALE();
                const int vo = VB0 + ((i + 2) % 3) * VT_BYTES;
                bf16x8 vf[2][2][2];
                u32x4 pw[2][2];
                float mx = -1e30f; f32x2 ls2 = {0.f, 0.f};
#define DF_VL(g) do { _Pragma("unroll") for (int kb_ = 0; kb_ < 2; ++kb_) _Pragma("unroll") for (int sp_ = 0; sp_ < 2; ++sp_) \
        vf[(g) & 1][kb_][sp_] = *(const LAS bf16x8*)(lds + vo + vfrag + (g) * 32 * VP + (32 * kb_ + 16 * sp_) * 2); } while (0)
#define DF_MF(k) o[(k) >> 2] = __builtin_amdgcn_mfma_f32_32x32x16_bf16(vf[((k) >> 2) & 1][((k) >> 1) & 1][(k) & 1], pf[((k) >> 1) & 1][(k) & 1], o[(k) >> 2], 0, 0, 0)
#define DF_S(e) s[(e) >> 4][(e) & 15]
                DF_VL(0); DF_VL(1);
                __builtin_amdgcn_sched_barrier(0);
                DF_MF(0);
                mx = fmaxf(fmaxf(mx, DF_S(0)), DF_S(1));
                mx = fmaxf(fmaxf(mx, DF_S(2)), DF_S(3));
                mx = fmaxf(fmaxf(mx, DF_S(4)), DF_S(5));
                mx = fmaxf(fmaxf(mx, DF_S(6)), DF_S(7));
                __builtin_amdgcn_sched_barrier(0);
                DF_MF(1);
                mx = fmaxf(fmaxf(mx, DF_S(8)), DF_S(9));
                mx = fmaxf(fmaxf(mx, DF_S(10)), DF_S(11));
                mx = fmaxf(fmaxf(mx, DF_S(12)), DF_S(13));
                mx = fmaxf(fmaxf(mx, DF_S(14)), DF_S(15));
                __builtin_amdgcn_sched_barrier(0);
                DF_MF(2);
                mx = fmaxf(fmaxf(mx, DF_S(16)), DF_S(17));
                mx = fmaxf(fmaxf(mx, DF_S(18)), DF_S(19));
                mx = fmaxf(fmaxf(mx, DF_S(20)), DF_S(21));
                mx = fmaxf(fmaxf(mx, DF_S(22)), DF_S(23));
                __builtin_amdgcn_sched_barrier(0);
                DF_MF(3);
                mx = fmaxf(fmaxf(mx, DF_S(24)), DF_S(25));
                mx = fmaxf(fmaxf(mx, DF_S(26)), DF_S(27));
                mx = fmaxf(fmaxf(mx, DF_S(28)), DF_S(29));
                mx = fmaxf(fmaxf(mx, DF_S(30)), DF_S(31));
                { auto rr = __builtin_amdgcn_permlane32_swap(__float_as_uint(mx), __float_as_uint(mx), false, false); mx = fmaxf(__uint_as_float(rr[0]), __uint_as_float(rr[1])); }
                alpha = 1.f;
                if (!__all(mx <= 8.f)) { const float dl = fmaxf(mx, 0.f); alpha = fast_exp2(-dl); m_run += dl;
#pragma unroll
                    for (int j = 0; j < 16; ++j) { s[0][j] -= dl; s[1][j] -= dl; negm[j] = -m_run; }
                    asm volatile("" : "+v"(negm)); }
                __builtin_amdgcn_sched_barrier(0);
                DF_VL(2);
                DF_MF(4);
                DF_S(0) = fast_exp2(DF_S(0));
                DF_S(1) = fast_exp2(DF_S(1));
                ls2 += (f32x2){DF_S(0), DF_S(1)}; pw[0][0][0] = cvt_pk(DF_S(0), DF_S(1));
                DF_S(2) = fast_exp2(DF_S(2));
                DF_S(3) = fast_exp2(DF_S(3));
                ls2 += (f32x2){DF_S(2), DF_S(3)}; pw[0][0][1] = cvt_pk(DF_S(2), DF_S(3));
                __builtin_amdgcn_sched_barrier(0);
                DF_MF(5);
                DF_S(4) = fast_exp2(DF_S(4));
                DF_S(5) = fast_exp2(DF_S(5));
                ls2 += (f32x2){DF_S(4), DF_S(5)}; pw[0][0][2] = cvt_pk(DF_S(4), DF_S(5));
                DF_S(6) = fast_exp2(DF_S(6));
                DF_S(7) = fast_exp2(DF_S(7));
                ls2 += (f32x2){DF_S(6), DF_S(7)}; pw[0][0][3] = cvt_pk(DF_S(6), DF_S(7));
                __builtin_amdgcn_sched_barrier(0);
                DF_MF(6);
                DF_S(8) = fast_exp2(DF_S(8));
                DF_S(9) = fast_exp2(DF_S(9));
                ls2 += (f32x2){DF_S(8), DF_S(9)}; pw[0][1][0] = cvt_pk(DF_S(8), DF_S(9));
                DF_S(10) = fast_exp2(DF_S(10));
                DF_S(11) = fast_exp2(DF_S(11));
                ls2 += (f32x2){DF_S(10), DF_S(11)}; pw[0][1][1] = cvt_pk(DF_S(10), DF_S(11));
                __builtin_amdgcn_sched_barrier(0);
                DF_MF(7);
                DF_S(12) = fast_exp2(DF_S(12));
                DF_S(13) = fast_exp2(DF_S(13));
                ls2 += (f32x2){DF_S(12), DF_S(13)}; pw[0][1][2] = cvt_pk(DF_S(12), DF_S(13));
                DF_S(14) = fast_exp2(DF_S(14));
                DF_S(15) = fast_exp2(DF_S(15));
                ls2 += (f32x2){DF_S(14), DF_S(15)}; pw[0][1][3] = cvt_pk(DF_S(14), DF_S(15));
                __builtin_amdgcn_sched_barrier(0);
                DF_VL(3);
                DF_MF(8);
                DF_S(16) = fast_exp2(DF_S(16));
                DF_S(17) = fast_exp2(DF_S(17));
                ls2 += (f32x2){DF_S(16), DF_S(17)}; pw[1][0][0] = cvt_pk(DF_S(16), DF_S(17));
                __builtin_amdgcn_sched_barrier(0);
                DF_MF(9);
                DF_S(18) = fast_exp2(DF_S(18));
                DF_S(19) = fast_exp2(DF_S(19));
                ls2 += (f32x2){DF_S(18), DF_S(19)}; pw[1][0][1] = cvt_pk(DF_S(18), DF_S(19));
                __builtin_amdgcn_sched_barrier(0);
                DF_MF(10);
                DF_S(20) = fast_exp2(DF_S(20));
                DF_S(21) = fast_exp2(DF_S(21));
                ls2 += (f32x2){DF_S(20), DF_S(21)}; pw[1][0][2] = cvt_pk(DF_S(20), DF_S(21));
                __builtin_amdgcn_sched_barrier(0);
                DF_MF(11);
                DF_S(22) = fast_exp2(DF_S(22));
                DF_S(23) = fast_exp2(DF_S(23));
                ls2 += (f32x2){DF_S(22), DF_S(23)}; pw[1][0][3] = cvt_pk(DF_S(22), DF_S(23));
                __builtin_amdgcn_sched_barrier(0);
                DF_MF(12);
                DF_S(24) = fast_exp2(DF_S(24));
                DF_S(25) = fast_exp2(DF_S(25));
                ls2 += (f32x2){DF_S(24), DF_S(25)}; pw[1][1][0] = cvt_pk(DF_S(24), DF_S(25));
                __builtin_amdgcn_sched_barrier(0);
                DF_MF(13);
                DF_S(26) = fast_exp2(DF_S(26));
                DF_S(27) = fast_exp2(DF_S(27));
                ls2 += (f32x2){DF_S(26), DF_S(27)}; pw[1][1][1] = cvt_pk(DF_S(26), DF_S(27));
                __builtin_amdgcn_sched_barrier(0);
                DF_MF(14);
                DF_S(28) = fast_exp2(DF_S(28));
                DF_S(29) = fast_exp2(DF_S(29));
                ls2 += (f32x2){DF_S(28), DF_S(29)}; pw[1][1][2] = cvt_pk(DF_S(28), DF_S(29));
                __builtin_amdgcn_sched_barrier(0);
                DF_MF(15);
                DF_S(30) = fast_exp2(DF_S(30));
                DF_S(31) = fast_exp2(DF_S(31));
                ls2 += (f32x2){DF_S(30), DF_S(31)}; pw[1][1][3] = cvt_pk(DF_S(30), DF_S(31));
                __builtin_amdgcn_sched_barrier(0);
                l_run = l_run * alpha + (ls2[0] + ls2[1]);
#pragma unroll
                for (int kb = 0; kb < 2; ++kb)
#pragma unroll
                    for (int sp = 0; sp < 2; ++sp) pf[kb][sp] = __builtin_bit_cast(bf16x8, pw[kb][sp]);
#undef DF_VL
#undef DF_MF
#undef DF_S
            }
        }
        if (t > 0) DF_STORE(((i + 1) & 1) * KT_BYTES, VB0 + ((i + 1) % 3) * VT_BYTES);
        __syncthreads();
    }
    if (have_p) {
        DF_RESCALE();
        bf16x8 vf[4][2][2];
        DF_VLOAD(VB0 + ((NT - 1) % 3) * VT_BYTES);
        DF_PV();
    }
    __syncthreads();
#undef DF_LOAD
#undef DF_STORE
#undef DF_VLOAD
#undef DF_PV
#undef DF_RESCALE
    const int erow = lane >> 4, ech = lane & 15;
    const size_t tok0 = tokbase + q0w;
    u32x4 gw[8];
    if (role == 0) {
        const bf16_t* gp = PROJ + (tok0 + erow) * NPROJ + PG_DF + hh * 128 + ech * 8;
#pragma unroll
        for (int i = 0; i < 8; ++i) gw[i] = *(const u32x4*)(gp + (size_t)(4 * i) * NPROJ);
    }
    LAS unsigned char* stg = lds + 69632 + qg * 8704;
    {
        const float lt = l_run + __shfl_xor(l_run, 32);
        const float inv = 1.f / lt;
        LAS float* xq = (LAS float*)lds + (qg * 32 + r) * XP + 4 * h;
        if (role == 1) {
            const float f = inv * lam;
#pragma unroll
            for (int d = 0; d < 4; ++d)
#pragma unroll
                for (int g = 0; g < 4; ++g) *(LAS f32x4*)(xq + 32 * d + 8 * g) = (f32x4){o[d][4 * g] * f, o[d][4 * g + 1] * f, o[d][4 * g + 2] * f, o[d][4 * g + 3] * f};
        }
        __syncthreads();
        if (role == 0) {
            float q = 0.f;
#pragma unroll
            for (int d = 0; d < 4; ++d)
#pragma unroll
                for (int g = 0; g < 4; ++g) { const f32x4 x2 = *(const LAS f32x4*)(xq + 32 * d + 8 * g);
#pragma unroll
                    for (int j = 0; j < 4; ++j) { const float v = o[d][4 * g + j] * inv - x2[j]; o[d][4 * g + j] = v; q += v * v; } }
            q += __shfl_xor(q, 32);
            const float rs = rsqrtf(q * (1.f / 128.f) + SUBLN_EPS) * (1.f - LAMBDA_INIT);
            const float* sg = subln_g + 4 * h;
#pragma unroll
            for (int d = 0; d < 4; ++d)
#pragma unroll
                for (int g = 0; g < 4; ++g) { const f32x4 sv = *(const f32x4*)(sg + 32 * d + 8 * g);
                    u32x2 w; w.x = cvt_pk(o[d][4 * g] * rs * sv[0], o[d][4 * g + 1] * rs * sv[1]); w.y = cvt_pk(o[d][4 * g + 2] * rs * sv[2], o[d][4 * g + 3] * rs * sv[3]);
                    *(LAS u32x2*)(stg + r * 272 + (32 * d + 8 * g + 4 * h) * 2) = w; }
            asm volatile("s_waitcnt lgkmcnt(0)" ::: "memory");
            bf16_t* op = MIXED + (tok0 + erow) * DM + 1024 + hh * 128 + ech * 8;
#pragma unroll
            for (int i = 0; i < 8; ++i) { const u32x4 ov = *(const LAS u32x4*)(stg + (4 * i + erow) * 272 + ech * 16); const u32x4 g4 = gw[i];
                u32x4 w; w.x = cvt_pk(bf_lo(ov.x) * bf_lo(g4.x), bf_hi(ov.x) * bf_hi(g4.x)); w.y = cvt_pk(bf_lo(ov.y) * bf_lo(g4.y), bf_hi(ov.y) * bf_hi(g4.y));
                w.z = cvt_pk(bf_lo(ov.z) * bf_lo(g4.z), bf_hi(ov.z) * bf_hi(g4.z)); w.w = cvt_pk(bf_lo(ov.w) * bf_lo(g4.w), bf_hi(ov.w) * bf_hi(g4.w));
                *(u32x4*)(op + (size_t)(4 * i) * DM) = w; }
        }
    }
}
}
#define XB_TMO      128
#define XB_XCNT(j)  (256  + 64 * (j))
#define XB_XSUB(j)  (1280 + 64 * (j))
#define XB_XGEN(j)  (2304 + 64 * (j))
#define XB_TOP      3328
#define XB_TOPGEN   3392
#define XCD_BAR_WORDS 3456
#define XB_SPIN_CAP (1u << 18)

__device__ __forceinline__ unsigned xb_ld(unsigned* p)              { return __hip_atomic_load(p, __ATOMIC_RELAXED, __HIP_MEMORY_SCOPE_AGENT); }
__device__ __forceinline__ unsigned xb_add(unsigned* p, unsigned v) { return __hip_atomic_fetch_add(p, v, __ATOMIC_RELAXED, __HIP_MEMORY_SCOPE_AGENT); }
__device__ __forceinline__ unsigned xb_xcc_id() { return (unsigned)__builtin_amdgcn_s_getreg((3 << 11) | 20) & 0xFu; }
#define XB_SPIN(cond, bar) do { unsigned _sp = 0; while (cond) { __builtin_amdgcn_s_sleep(1); \
    if ((++_sp & 255u) == 0u) { if (xb_ld(&(bar)[XB_TMO])) break; if (_sp > XB_SPIN_CAP) { atomicAdd(&(bar)[XB_TMO], 1u); break; } } } } while (0)

struct XcdBarrier {
    unsigned* bar; unsigned x;
    volatile LAS unsigned* st;
};

__device__ __forceinline__ XcdBarrier xcd_barrier_post(unsigned* bar, volatile LAS unsigned* st) {
    XcdBarrier b; b.bar = bar; b.x = xb_xcc_id(); b.st = st;
    if (threadIdx.x == 0) (void)xb_add(&bar[XB_XCNT(b.x)], 1u);
    return b;
}
__device__ __forceinline__ void xcd_barrier_complete(unsigned* bar, unsigned x, unsigned& nloc, unsigned& nx) {
    const unsigned G = gridDim.x * gridDim.y * gridDim.z;
    unsigned sum, cnt, mine, sp = 0u;
    for (;;) {
        sum = 0u; cnt = 0u; mine = 0u;
#pragma unroll
        for (unsigned j = 0; j < 16; ++j) { const unsigned c = xb_ld(&bar[XB_XCNT(j)]); sum += c; cnt += (c > 0u) ? 1u : 0u; mine = (j == x) ? c : mine; }
        if (sum == G) break;
        __builtin_amdgcn_s_sleep(1);
        if ((++sp & 255u) == 0u) { if (xb_ld(&bar[XB_TMO])) break; if (sp > XB_SPIN_CAP) { atomicAdd(&bar[XB_TMO], 1u); break; } }
    }
    nloc = mine > 0u ? mine : 1u; nx = cnt > 0u ? cnt : 1u;
}

__device__ __forceinline__ void xcd_barrier(const XcdBarrier& b) {
    asm volatile("s_waitcnt vmcnt(0)" ::: "memory");
    __syncthreads();
    if (threadIdx.x == 0) {
        unsigned* bar = b.bar;
        __builtin_amdgcn_s_waitcnt(0);
        unsigned nloc = b.st[0], nx = b.st[1];
        if (nloc == 0u) { xcd_barrier_complete(bar, b.x, nloc, nx); b.st[0] = nloc; b.st[1] = nx; }
        const unsigned old = xb_add(&bar[XB_XSUB(b.x)], 1u);
        const unsigned gen = old / nloc;
        if (old + 1u == (gen + 1u) * nloc) {
            __builtin_amdgcn_fence(__ATOMIC_RELEASE, "agent");
            asm volatile("s_waitcnt vmcnt(0)" ::: "memory");
            const unsigned og = xb_add(&bar[XB_TOP], 1u);
            const unsigned tg = og / nx;
            if (og + 1u == (tg + 1u) * nx) xb_add(&bar[XB_TOPGEN], 1u);
            else XB_SPIN(xb_ld(&bar[XB_TOPGEN]) == tg, bar);
            __builtin_amdgcn_fence(__ATOMIC_ACQUIRE, "agent");
            xb_add(&bar[XB_XGEN(b.x)], 1u);
            asm volatile("s_waitcnt vmcnt(0)" ::: "memory");
        } else {
            XB_SPIN(xb_ld(&bar[XB_XGEN(b.x)]) == gen, bar);
            __builtin_amdgcn_fence(__ATOMIC_ACQUIRE, "agent");
            asm volatile("s_waitcnt vmcnt(0)" ::: "memory");
        }
    }
    __syncthreads();
}

__device__ __forceinline__ int win_dst_row(int c) {
    const int seg = c >> 10, w = c & 1023, d6 = w & 63;
    const int wp = d6 < 16 ? (w & ~63) + (d6 < 8 ? 2 * d6 : 2 * (d6 - 8) + 1) : w;
    switch (seg) { case 0: return w; case 1: return 1024 + w; case 2: return 6144 + w; case 3: return 2048 + w;
                   case 4: return 3072 + wp; case 5: return 4096 + wp; case 6: return 7168 + w; default: return 5120 + w; }
}
struct TItem { const float* W; bf16_t* WT; const float* ks; int K, N, win, item; };
__device__ __forceinline__ void tr_load(const TItem& t, float (&v)[32], int lane) {
    const int nblk = t.N / 32, kb = t.item / nblk, nb = t.item % nblk; const float* p = t.W + (size_t)(64 * kb + (lane >> 5)) * t.N + 32 * nb + (lane & 31);
#pragma unroll
    for (int i = 0; i < 32; ++i) v[i] = __builtin_nontemporal_load(&p[(size_t)(2 * i) * t.N]);
}
__device__ __forceinline__ void tr_write(const float (&v)[32], LAS float* scr, int lane) {
#pragma unroll
    for (int i = 0; i < 32; ++i) scr[(2 * i + (lane >> 5)) * 33 + (lane & 31)] = v[i];
}
__device__ __forceinline__ void tr_store(const TItem& t, LAS float* scr, int lane) {
    const int nblk = t.N / 32, kb = t.item / nblk, nb = t.item % nblk, k0 = 64 * kb, n0 = 32 * nb, c = lane & 7;
    f32x4 s0 = {1.f, 1.f, 1.f, 1.f}, s1 = {1.f, 1.f, 1.f, 1.f};
    if (t.ks) { s0 = *(const f32x4*)(t.ks + k0 + 8 * c); s1 = *(const f32x4*)(t.ks + k0 + 8 * c + 4); }
#pragma unroll
    for (int j = 0; j < 4; ++j) { const int n = (lane >> 3) + 8 * j; const LAS float* s = scr + (8 * c) * 33 + n;
        u32x4 o; o.x = cvt_pk(s[0 * 33] * s0[0], s[1 * 33] * s0[1]); o.y = cvt_pk(s[2 * 33] * s0[2], s[3 * 33] * s0[3]); o.z = cvt_pk(s[4 * 33] * s1[0], s[5 * 33] * s1[1]); o.w = cvt_pk(s[6 * 33] * s1[2], s[7 * 33] * s1[3]);
        const int dn = t.win ? win_dst_row(n0 + n) : (n0 + n);
        *(u32x4*)(t.WT + (size_t)dn * t.K + k0 + 8 * c) = o; }
}
__device__ __forceinline__ void rms_load(const float* __restrict__ xrow, f32x4 (&v)[8], int lane) {
    const f32x4* xr = (const f32x4*)xrow + lane;
#pragma unroll
    for (int j = 0; j < 8; ++j) v[j] = __builtin_nontemporal_load(&xr[64 * j]);
}
__device__ __forceinline__ void rms_finish(const f32x4 (&v)[8], const f32x4 (&gv)[8], bf16_t* __restrict__ orow, int lane) {
    float s = 0.f;
#pragma unroll
    for (int j = 0; j < 8; ++j) s += (v[j][0] * v[j][0] + v[j][1] * v[j][1]) + (v[j][2] * v[j][2] + v[j][3] * v[j][3]);
    const float rstd = rsqrtf(wave_sum(s) * (1.f / DM) + NORM_EPS);
    u32x2* o8 = (u32x2*)orow + lane;
#pragma unroll
    for (int j = 0; j < 8; ++j) { u32x2 w; w.x = cvt_pk(v[j][0] * rstd * gv[j][0], v[j][1] * rstd * gv[j][1]); w.y = cvt_pk(v[j][2] * rstd * gv[j][2], v[j][3] * rstd * gv[j][3]); o8[64 * j] = w; }
}

struct Args { const float* in[14]; float* out; unsigned char* ws; };

__global__ void __launch_bounds__(512, 2) fwd_megakernel(Args a) {
    extern __shared__ __attribute__((aligned(16))) unsigned char lds_raw[];
    LAS unsigned char* lds = (LAS unsigned char*)lds_raw;
    { cg::grid_group grid = cg::this_grid(); if (a.ws == nullptr) grid.sync(); }
    const int tid = threadIdx.x, lane = tid & 63, wave = __builtin_amdgcn_readfirstlane(tid >> 6);
    const int G = gridDim.x, bx = blockIdx.x;
    const int vcu = (G % 8 == 0) ? (bx % 8) * (G / 8) + bx / 8 : bx;
    unsigned char* ws = a.ws;
    float* ss2 = (float*)(ws + WS_CTL + CTL_SS2); float* ss3 = (float*)(ws + WS_CTL + CTL_SS3); float* lamp = (float*)(ws + WS_CTL + CTL_LAM); float* rope = (float*)(ws + WS_CTL + CTL_ROPE);
    bf16_t* WIN = (bf16_t*)(ws + WS_WIN); bf16_t* WOUT = (bf16_t*)(ws + WS_WOUT); bf16_t* WGATE = (bf16_t*)(ws + WS_WGATE); bf16_t* WPROJ = (bf16_t*)(ws + WS_WPROJ);
    bf16_t* PB = (bf16_t*)(ws + WS_PB); bf16_t* XN = (bf16_t*)(ws + WS_XN); bf16_t* MIXED = (bf16_t*)(ws + WS_MIXED); bf16_t* PROJ = (bf16_t*)(ws + WS_PROJ);
    bf16_t* VT = (bf16_t*)(ws + WS_VT); bf16_t* KIMG = (bf16_t*)(ws + WS_KIMG); bf16_t* HB = (bf16_t*)(ws + WS_HB); bf16_t* PLEB = (bf16_t*)(ws + WS_PLE); bf16_t* H2B = (bf16_t*)(ws + WS_H2B);
    const float* x = a.in[0]; float* out = a.out;
    volatile LAS unsigned* xst = (volatile LAS unsigned*)(lds + 131072);
    if (tid == 0) { xst[0] = 0u; xst[1] = 0u; }
    __syncthreads();
    const XcdBarrier xb = xcd_barrier_post((unsigned*)(ws + WS_CTL + CTL_BAR), xst);

    {
        const int gw = bx * 8 + wave, NGW = G * 8; const int gt = bx * 512 + tid, NGT = G * 512;
        for (int i = gt; i < 2 * NTOK; i += NGT) ss2[i] = 0.f;
        if (gt == 0) { float s1 = 0.f, s2 = 0.f; for (int i = 0; i < 64; ++i) { s1 += a.in[4][i] * a.in[5][i]; s2 += a.in[6][i] * a.in[7][i]; } lamp[0] = expf(s1) - expf(s2) + LAMBDA_INIT; }
        for (int i = gt; i < SEQ * 8; i += NGT) { const int pos = i >> 3, f = i & 7;
            const float invf = (float)exp2(-(double)f * 0.125 * 18.931568569324174);
            const float angf = (float)pos * invf;
            const double tw = 6.283185307179586476925; double ang = (double)angf; ang -= tw * rint(ang / tw);
            rope[2 * i] = (float)cos(ang); rope[2 * i + 1] = (float)sin(ang); }
        LAS float* scr = (LAS float*)(lds + wave * 16384);
        constexpr int I_IN = (DM / 64) * (8192 / 32), I_SQ = (DM / 64) * (DM / 32), I_PR = (PLE / 64) * (DM / 32), I_ALL = I_IN + 2 * I_SQ + I_PR;
#define P0_DECODE(T, it_) do { int rr_ = (it_); \
            if (rr_ < I_IN) { T = TItem{a.in[3], WIN, nullptr, DM, 8192, 1, rr_}; } \
            else if (rr_ < I_IN + I_SQ) { T = TItem{a.in[9], WOUT, nullptr, DM, DM, 0, rr_ - I_IN}; } \
            else if (rr_ < I_IN + 2 * I_SQ) { T = TItem{a.in[11], WGATE, a.in[10], DM, DM, 0, rr_ - I_IN - I_SQ}; } \
            else { T = TItem{a.in[12], WPROJ, nullptr, PLE, DM, 0, rr_ - I_IN - 2 * I_SQ}; } } while (0)
        {
            float tv[32]; TItem cur, nxt; int it = gw;
            if (it < I_ALL) { P0_DECODE(cur, it); tr_load(cur, tv, lane); }
            while (it < I_ALL) {
                tr_write(tv, scr, lane);
                const int itn = it + NGW;
                if (itn < I_ALL) { P0_DECODE(nxt, itn); tr_load(nxt, tv, lane); }
                asm volatile("s_waitcnt lgkmcnt(0)" ::: "memory");
                tr_store(cur, scr, lane);
                asm volatile("s_waitcnt lgkmcnt(0)" ::: "memory");
                cur = nxt; it = itn;
            }
        }
#undef P0_DECODE
        {
            f32x4 gv[8], va[8], vb[8];
            { const f32x4* gr = (const f32x4*)a.in[2] + lane;
#pragma unroll
              for (int j = 0; j < 8; ++j) gv[j] = gr[64 * j]; }
            int m = gw;
            if (m < NTOK) rms_load(x + (size_t)m * DM, va, lane);
            for (; m < NTOK; m += 2 * NGW) {
                const int m1 = m + NGW, m2 = m + 2 * NGW;
                if (m1 < NTOK) rms_load(x + (size_t)m1 * DM, vb, lane);
                rms_finish(va, gv, XN + (size_t)m * DM, lane);
                if (m2 < NTOK) rms_load(x + (size_t)m2 * DM, va, lane);
                if (m1 < NTOK) rms_finish(vb, gv, XN + (size_t)m1 * DM, lane);
            }
        }
        for (int i = gt; i < NTOK * PLE / 8; i += NGT) { const f32x4 v0 = __builtin_nontemporal_load(&((const f32x4*)a.in[1])[2 * i]), v1 = __builtin_nontemporal_load(&((const f32x4*)a.in[1])[2 * i + 1]);
            u32x4 w; w.x = cvt_pk(v0[0], v0[1]); w.y = cvt_pk(v0[2], v0[3]); w.z = cvt_pk(v1[0], v1[1]); w.w = cvt_pk(v1[2], v1[3]); ((u32x4*)PB)[i] = w; }
    }
    xcd_barrier(xb);
    {
        { pg8::Gemm g{XN, WIN, NTOK, NPROJ, DM}; pg8::StaticOrder S; S.init(NTOK, NPROJ, G, bx); pg8::EpiProj E{PROJ, rope, KIMG};
          pg8::gemm_phase<pg8::EpiProj, pg8::StaticOrder, true, true>(lds, g, S, E); }
        __syncthreads();
        { pg8::Gemm g{WIN + (size_t)NPROJ * DM, XN, 2048, NTOK, DM}; pg8::StaticOrder S; S.init(2048, NTOK, G, bx); pg8::EpiVt E{VT};
          pg8::gemm_phase<pg8::EpiVt, pg8::StaticOrder, true, true>(lds, g, S, E); }
    }
    xcd_barrier(xb);
    {
        const float lam = lamp[0];
        for (int su = vcu; su < 256; su += G) {
            const int grp = su >> 4, j = su & 15;
#pragma unroll 1
            for (int k = 0; k < 4; ++k) { const int bh = 4 * grp + k; const int qb = (k & 1) ? 15 - j : j;
                att::attn_unit_df(lds, PROJ, KIMG, VT, MIXED, bh >> 3, bh & 7, qb, lam, a.in[8]); }
        }
#pragma unroll 1
        for (int u = vcu; u < 512; u += G) att::attn_unit<0>(lds, PROJ, KIMG, VT, MIXED, (u >> 3) >> 3, (u >> 3) & 7, u & 7, lam, a.in[8]);
    }
    xcd_barrier(xb);
    {
        __syncthreads();
        { pg8::Gemm g{MIXED, WOUT, NTOK, DM, DM}; pg8::StaticOrder S; S.init(NTOK, DM, G, bx); pg8::EpiRes E{x, HB, ss2};
          pg8::gemm_phase<pg8::EpiRes, pg8::StaticOrder, true, true>(lds, g, S, E); }
        __syncthreads();
        { pg8::Gemm g{PB, WPROJ, NTOK, DM, PLE}; pg8::StaticOrder S; S.init(NTOK, DM, G, bx); pg8::EpiBf16 E{PLEB, DM};
          pg8::gemm_phase<pg8::EpiBf16, pg8::StaticOrder, true, true>(lds, g, S, E); }
    }
    xcd_barrier(xb);
    {
        pg8::Gemm g{HB, WGATE, NTOK, DM, DM}; pg8::StaticOrder S; S.init(NTOK, DM, G, bx); pg8::EpiGate E{HB, H2B, PLEB, ss2, ss3};
        pg8::gemm_phase<pg8::EpiGate, pg8::StaticOrder, true, true>(lds, g, S, E);
    }
    xcd_barrier(xb);
    {
        const int tid5 = opaque_tid(), lane = tid5 & 63, wave = __builtin_amdgcn_readfirstlane(tid5 >> 6);
        const int gw = bx * 8 + wave, NGW = G * 8; const f32x4* gr = (const f32x4*)a.in[13];
        f32x4 gv[8];
#pragma unroll
        for (int j = 0; j < 4; ++j) { gv[2 * j] = gr[2 * (lane + 64 * j)]; gv[2 * j + 1] = gr[2 * (lane + 64 * j) + 1]; }
#define P5_LOAD(H, S_, m_) do { const u32x4* hrow_ = (const u32x4*)(H2B + (size_t)(m_) * DM); S_ = ss3[m_]; _Pragma("unroll") for (int j_ = 0; j_ < 4; ++j_) H[j_] = __builtin_nontemporal_load(&hrow_[lane + 64 * j_]); } while (0)
#define P5_STORE(H, S_, m_) do { const float rstd_ = rsqrtf(S_ * (1.f / DM) + NORM_EPS); f32x4* orow_ = (f32x4*)(out + (size_t)(m_) * DM); \
            _Pragma("unroll") for (int j_ = 0; j_ < 4; ++j_) { const int c_ = lane + 64 * j_; const u32x4 hw_ = H[j_]; const f32x4 g0_ = gv[2 * j_], g1_ = gv[2 * j_ + 1]; \
                orow_[2 * c_] = (f32x4){bf_lo(hw_.x) * rstd_ * g0_[0], bf_hi(hw_.x) * rstd_ * g0_[1], bf_lo(hw_.y) * rstd_ * g0_[2], bf_hi(hw_.y) * rstd_ * g0_[3]}; \
                orow_[2 * c_ + 1] = (f32x4){bf_lo(hw_.z) * rstd_ * g1_[0], bf_hi(hw_.z) * rstd_ * g1_[1], bf_lo(hw_.w) * rstd_ * g1_[2], bf_hi(hw_.w) * rstd_ * g1_[3]}; } } while (0)
        u32x4 ha[4], hb4[4]; float sa = 0.f, sb = 0.f;
        int m = gw;
        if (m < NTOK) P5_LOAD(ha, sa, m);
        for (; m < NTOK; m += 2 * NGW) {
            const int m1 = m + NGW, m2 = m + 2 * NGW;
            if (m1 < NTOK) P5_LOAD(hb4, sb, m1);
            P5_STORE(ha, sa, m);
            if (m2 < NTOK) P5_LOAD(ha, sa, m2);
            if (m1 < NTOK) P5_STORE(hb4, sb, m1);
        }
#undef P5_LOAD
#undef P5_STORE
    }
}

extern "C" void kernel_launch(void* const* d_in, const int* in_sizes, int n_in, void* d_out, int out_size, void* d_ws, size_t ws_size, hipStream_t stream) {
    static int grid = 0;
    if (grid == 0) {
        if (n_in != 14 || out_size != NTOK * DM || ws_size < WS_END) { fprintf(stderr, "kernel_launch: unexpected shapes (n_in %d out %d ws %zu)\n", n_in, out_size, ws_size); grid = -1; return; }
        int dev = 0, cus = 0, per_cu = 0;
        (void)hipGetDevice(&dev); (void)hipDeviceGetAttribute(&cus, hipDeviceAttributeMultiprocessorCount, dev);
        (void)hipFuncSetAttribute((const void*)fwd_megakernel, hipFuncAttributeMaxDynamicSharedMemorySize, LDS_BYTES);
        (void)hipOccupancyMaxActiveBlocksPerMultiprocessor(&per_cu, (const void*)fwd_megakernel, 512, LDS_BYTES);
        if (per_cu < 1) { fprintf(stderr, "kernel_launch: occupancy query says %d blocks/CU\n", per_cu); per_cu = 1; }
        grid = cus * per_cu;
    }
    if (grid < 0) return;
    Args a{};
    for (int i = 0; i < 14; ++i) a.in[i] = (const float*)d_in[i];
    a.out = (float*)d_out; a.ws = (unsigned char*)d_ws;
    (void)hipMemsetAsync((unsigned char*)d_ws + WS_CTL + CTL_BAR, 0, CTL_BAR_BYTES, stream);
    void* args[] = {&a};
    hipError_t e = hipLaunchCooperativeKernel((void*)fwd_megakernel, dim3(grid), dim3(512), args, LDS_BYTES, stream);
    if (e != hipSuccess) fprintf(stderr, "cooperative launch failed: %s (grid %d)\n", hipGetErrorString(e), grid);
}
```

```cpp
#include <hip/hip_runtime.h>
#include <hip/hip_cooperative_groups.h>
#include <cstdio>
#include <cstdint>
namespace cg = cooperative_groups;
__device__ __forceinline__ int opaque_tid() { int t = (int)threadIdx.x; asm volatile("" : "+v"(t)); return t; }
namespace pg8 {
#define PG8_LAS __attribute__((address_space(3)))
typedef unsigned short bf16_t;
typedef short bf16x8 __attribute__((ext_vector_type(8)));
typedef float f32x4 __attribute__((ext_vector_type(4)));
typedef unsigned u32x4 __attribute__((ext_vector_type(4)));
constexpr int BM = 256, BK = 64, HALF = 128, HTB = HALF * BK * 2  , STAGE_BYTES = 8 * HTB, NXCD = 8, WGM = 8;

__host__ __device__ __forceinline__ int lds_byte(int r, int c) { const int st = (r >> 4) * 2 + (c >> 5), rr = r & 15, cc = c & 31, ob = rr * 64 + cc * 2; return st * 1024 + (ob ^ (((ob >> 9) & 1) << 5)); }
__host__ __device__ __forceinline__ void stage_rc(int b, int& R, int& C) { const int st = b / 1024, sb = b % 1024, swz = sb ^ (((sb >> 9) & 1) << 5); R = (st >> 1) * 16 + swz / 64; C = (st & 1) * 32 + (swz % 64) / 2; }
__host__ __device__ __forceinline__ int perm32(int rho) { const int n = rho >> 4, i = rho & 15; return 8 * (i >> 2) + 4 * n + (i & 3); }

struct Unit { int pm, pn; };
struct Gemm { const bf16_t* A; const bf16_t* Bt; int M, N, K; };

struct StaticOrder {
    int nM, nN, nwg, G, c;
    __host__ __device__ void init(int M, int N, int G_, int c_) { nM = M / BM; nN = N / BM; nwg = nM * nN; G = G_; c = c_; }
    __host__ __device__ bool next(int i, Unit& u) const {
        const long L = (long)i * G + c; if (L >= nwg) return false;
        int wgid = (int)L; { const int q = nwg / NXCD, r = nwg % NXCD, xcd = wgid % NXCD, off = wgid / NXCD; wgid = (xcd < r ? xcd * (q + 1) : r * (q + 1) + (xcd - r) * q) + off; }
        const int nig = WGM * nN, gid = wgid / nig, fm = gid * WGM, gsz = (nM - fm) < WGM ? (nM - fm) : WGM;
        u.pm = fm + ((wgid % nig) % gsz); u.pn = (wgid % nig) / gsz; return true;
    }
    __device__ __forceinline__ void a_ready(const Unit&) const {}
    __device__ __forceinline__ void done(const Unit&) const {}
};

__device__ __forceinline__ unsigned cvt_pk_bf16(float lo, float hi) { unsigned r; asm volatile("v_cvt_pk_bf16_f32 %0, %1, %2" : "=v"(r) : "v"(lo), "v"(hi)); return r; }
typedef float f32x2 __attribute__((ext_vector_type(2)));
template <class Epi, class Sched, bool ALIGN_EPI = false, bool SP2 = false>
__device__ __forceinline__ void gemm_phase(PG8_LAS unsigned char* lds, const Gemm g, const Sched& S, const Epi& E) {
    const int tid = opaque_tid(), wid = __builtin_amdgcn_readfirstlane(tid >> 6), lane = tid & 63, wr = wid >> 2, wc = wid & 3, fr = lane & 15, fq = lane >> 4;
    const int K = g.K, nt = K / BK;
    unsigned voffA[2], voffB[2];
#pragma unroll
    for (int i = 0; i < 2; ++i) { int R, C; stage_rc(tid * 16 + i * 8192, R, C); const int Rb = Epi::PERM ? ((R & ~31) + perm32(R & 31)) : R;
        voffA[i] = (unsigned)(R * K + C) * 2u; voffB[i] = (unsigned)(Rb * K + C) * 2u; }
    const size_t kstep = (size_t)(BK * 2);
    const size_t hstep = (size_t)HALF * K * 2;
    const size_t tstep = 2 * hstep;
    const unsigned ldsw = (unsigned)wid * 1024u;
    const int aoff = lds_byte(wr * 64 + fr, fq * 8), boff = lds_byte(wc * 32 + fr, fq * 8);
#define PG8_SA(b, h) (((b) * 2 + (h)) * HTB)
#define PG8_SB(b, h) ((4 + (b) * 2 + (h)) * HTB)
#define PG8_STAGE(bufoff, gbase, voff) do { _Pragma("unroll") for (int _i = 0; _i < 2; ++_i) \
        __builtin_amdgcn_global_load_lds((const unsigned*)((const char*)(gbase) + (voff)[_i]), (PG8_LAS unsigned*)(lds + (bufoff) + ldsw + _i * 8192), 16, 0, 0); } while (0)
#define PG8_LDA(dst, b, h) do { _Pragma("unroll") for (int m = 0; m < 4; ++m) _Pragma("unroll") for (int k = 0; k < 2; ++k) dst[m][k] = *(const PG8_LAS bf16x8*)(lds + PG8_SA(b, h) + aoff + m * 2048 + k * 1024); } while (0)
#define PG8_LDB(dst, b, h) do { _Pragma("unroll") for (int n = 0; n < 2; ++n) _Pragma("unroll") for (int k = 0; k < 2; ++k) dst[n][k] = *(const PG8_LAS bf16x8*)(lds + PG8_SB(b, h) + boff + n * 2048 + k * 1024); } while (0)
#define PG8_MMA(ai, bj, At, Bt) do { __builtin_amdgcn_s_setprio(1); _Pragma("unroll") for (int m = 0; m < 4; ++m) _Pragma("unroll") for (int n = 0; n < 2; ++n) _Pragma("unroll") for (int k = 0; k < 2; ++k) \
        acc[ai][bj][m][n] = __builtin_amdgcn_mfma_f32_16x16x32_bf16(Bt[n][k], At[m][k], acc[ai][bj][m][n], 0, 0, 0); __builtin_amdgcn_s_setprio(0); } while (0)
#define PG8_WAIT_V(n) asm volatile("s_waitcnt vmcnt(" #n ")" ::: "memory")
#define PG8_WAIT_L(n) asm volatile("s_waitcnt lgkmcnt(" #n ")" ::: "memory")
#define PG8_BAR __builtin_amdgcn_s_barrier()
#define PG8_SCHED __builtin_amdgcn_sched_barrier(0)
    Unit cur, nxt; int ui = 0;
    if (!S.next(0, cur)) return;
    f32x4 acc[2][2][4][2];
#pragma unroll
    for (int a = 0; a < 2; ++a)
#pragma unroll
        for (int b = 0; b < 2; ++b)
#pragma unroll
            for (int m = 0; m < 4; ++m)
#pragma unroll
                for (int n = 0; n < 2; ++n) acc[a][b][m][n] = (f32x4){0.f, 0.f, 0.f, 0.f};
    bf16x8 At[4][2], B0[2][2], B1[2][2];
    const char* cA = (const char*)g.A + (size_t)cur.pm * tstep; const char* cB = (const char*)g.Bt + (size_t)cur.pn * tstep;
    S.a_ready(cur);
    if constexpr (SP2) {
        PG8_STAGE(PG8_SB(0, 0), cB, voffB); PG8_STAGE(PG8_SB(0, 1), cB + hstep, voffB); PG8_STAGE(PG8_SA(0, 0), cA, voffA); PG8_STAGE(PG8_SA(0, 1), cA + hstep, voffA);
        if (wr == 1) PG8_BAR;
        PG8_WAIT_V(2); PG8_BAR;
        PG8_STAGE(PG8_SB(1, 0), cB + kstep, voffB); PG8_STAGE(PG8_SA(1, 0), cA + kstep, voffA); PG8_STAGE(PG8_SB(1, 1), cB + hstep + kstep, voffB);
        PG8_WAIT_V(6); PG8_BAR;
    } else {
        PG8_STAGE(PG8_SB(0, 0), cB, voffB); PG8_STAGE(PG8_SA(0, 0), cA, voffA); PG8_STAGE(PG8_SB(0, 1), cB + hstep, voffB); PG8_STAGE(PG8_SA(0, 1), cA + hstep, voffA);
        if (wr == 1) PG8_BAR;
        PG8_WAIT_V(4); PG8_BAR;
        PG8_STAGE(PG8_SB(1, 0), cB + kstep, voffB); PG8_STAGE(PG8_SA(1, 0), cA + kstep, voffA); PG8_STAGE(PG8_SB(1, 1), cB + hstep + kstep, voffB);
        PG8_WAIT_V(6); PG8_BAR;
    }
    for (;;) {
        const bool has_next = S.next(ui + 1, nxt);
        const char* nA = has_next ? (const char*)g.A + (size_t)nxt.pm * tstep : cA; const char* nB = has_next ? (const char*)g.Bt + (size_t)nxt.pn * tstep : cB;
        for (int t = 0; t < nt; t += 2) {
            const bool last = (t == nt - 2);
            const char* a1 = cA + (size_t)(t + 1) * kstep;
            const char* a2 = last ? nA : cA + (size_t)(t + 2) * kstep; const char* b2 = last ? nB : cB + (size_t)(t + 2) * kstep;
            const char* a3 = a2 + kstep; const char* b3 = b2 + kstep;
            if (last && has_next) S.a_ready(nxt);
            if constexpr (SP2) {
            PG8_LDB(B0, 0, 0); PG8_LDB(B1, 0, 1); PG8_SCHED; PG8_LDA(At, 0, 0); PG8_STAGE(PG8_SA(1, 1), a1 + hstep, voffA);
            PG8_WAIT_V(8); PG8_WAIT_L(0); PG8_BAR; PG8_MMA(0, 0, At, B0); PG8_MMA(0, 1, At, B1); PG8_BAR; PG8_SCHED;
            PG8_LDA(At, 0, 1); PG8_STAGE(PG8_SB(0, 0), b2, voffB); PG8_STAGE(PG8_SB(0, 1), b2 + hstep, voffB); PG8_STAGE(PG8_SA(0, 0), a2, voffA);
            PG8_WAIT_V(8); PG8_WAIT_L(0); PG8_BAR; PG8_MMA(1, 0, At, B0); PG8_MMA(1, 1, At, B1); PG8_BAR; PG8_SCHED;
            PG8_LDB(B0, 1, 0); PG8_LDB(B1, 1, 1); PG8_SCHED; PG8_LDA(At, 1, 0); PG8_STAGE(PG8_SA(0, 1), a2 + hstep, voffA);
            PG8_WAIT_V(8); PG8_WAIT_L(0); PG8_BAR; PG8_MMA(0, 0, At, B0); PG8_MMA(0, 1, At, B1); PG8_BAR; PG8_SCHED;
            PG8_LDA(At, 1, 1); PG8_STAGE(PG8_SB(1, 0), b3, voffB); PG8_STAGE(PG8_SB(1, 1), b3 + hstep, voffB); PG8_STAGE(PG8_SA(1, 0), a3, voffA);
            PG8_WAIT_V(8); PG8_WAIT_L(0); PG8_BAR; PG8_MMA(1, 0, At, B0); PG8_MMA(1, 1, At, B1); PG8_BAR; PG8_SCHED;
            } else {
            PG8_LDB(B0, 0, 0); PG8_SCHED; PG8_LDA(At, 0, 0); PG8_STAGE(PG8_SA(1, 1), a1 + hstep, voffA);
            PG8_WAIT_L(8); PG8_BAR; PG8_WAIT_L(0); PG8_MMA(0, 0, At, B0); PG8_BAR; PG8_SCHED;
            PG8_LDB(B1, 0, 1); PG8_STAGE(PG8_SB(0, 0), b2, voffB);
            PG8_BAR; PG8_WAIT_L(0); PG8_MMA(0, 1, At, B1); PG8_BAR;
            PG8_LDA(At, 0, 1); PG8_STAGE(PG8_SA(0, 0), a2, voffA);
            PG8_BAR; PG8_WAIT_L(0); PG8_MMA(1, 0, At, B0); PG8_BAR; PG8_SCHED;
            PG8_STAGE(PG8_SB(0, 1), b2 + hstep, voffB);
            PG8_WAIT_V(6); PG8_BAR; PG8_MMA(1, 1, At, B1); PG8_BAR;
            PG8_LDB(B0, 1, 0); PG8_SCHED; PG8_LDA(At, 1, 0); PG8_STAGE(PG8_SA(0, 1), a2 + hstep, voffA);
            PG8_WAIT_L(8); PG8_BAR; PG8_WAIT_L(0); PG8_MMA(0, 0, At, B0); PG8_BAR; PG8_SCHED;
            PG8_LDB(B1, 1, 1); PG8_STAGE(PG8_SB(1, 0), b3, voffB);
            PG8_BAR; PG8_WAIT_L(0); PG8_MMA(0, 1, At, B1); PG8_BAR;
            PG8_LDA(At, 1, 1); PG8_STAGE(PG8_SA(1, 0), a3, voffA);
            PG8_BAR; PG8_WAIT_L(0); PG8_MMA(1, 0, At, B0); PG8_BAR; PG8_SCHED;
            PG8_STAGE(PG8_SB(1, 1), b3 + hstep, voffB);
            PG8_WAIT_V(6); PG8_BAR; PG8_MMA(1, 1, At, B1); PG8_BAR;
            }
        }
        if constexpr (ALIGN_EPI) { if (wr == 0) PG8_BAR; }
        if constexpr (!Epi::AFTER_DRAIN) { E(acc, cur, wr, wc, fr, fq); S.done(cur); }
        if (!has_next) break;
#pragma unroll
        for (int a = 0; a < 2; ++a)
#pragma unroll
            for (int b = 0; b < 2; ++b)
#pragma unroll
                for (int m = 0; m < 4; ++m)
#pragma unroll
                    for (int n = 0; n < 2; ++n) acc[a][b][m][n] = (f32x4){0.f, 0.f, 0.f, 0.f};
        cur = nxt; cA = nA; cB = nB; ++ui;
        if constexpr (ALIGN_EPI) { if (wr == 1) PG8_BAR; }
    }
    PG8_WAIT_V(0);
    if constexpr (!ALIGN_EPI) { if (wr == 0) PG8_BAR; }
    PG8_BAR;
    if constexpr (Epi::AFTER_DRAIN) { E.fused(acc, cur, wr, wc, fr, fq, lds, wid, lane); S.done(cur); }
#undef PG8_SA
#undef PG8_SB
#undef PG8_STAGE
#undef PG8_LDA
#undef PG8_LDB
#undef PG8_MMA
#undef PG8_WAIT_V
#undef PG8_WAIT_L
#undef PG8_BAR
#undef PG8_SCHED
}
}
#define LAS __attribute__((address_space(3)))
typedef unsigned short bf16_t;
typedef short bf16x8 __attribute__((ext_vector_type(8)));
typedef float f32x4 __attribute__((ext_vector_type(4)));
typedef float f32x2 __attribute__((ext_vector_type(2)));
typedef float f32x16 __attribute__((ext_vector_type(16)));
typedef unsigned u32x4 __attribute__((ext_vector_type(4)));
typedef unsigned u32x2 __attribute__((ext_vector_type(2)));

constexpr int NTOK = 16384, DM = 2048, SEQ = 2048, NBATCH = 8, PLE = 256;
constexpr int NPROJ = 6144;
constexpr int PQ_SB = 0, PK_SB = 1024, PG_SB = 2048, PQ_DF = 3072, PK_DF = 4096, PG_DF = 5120;
constexpr float LOG2E = 1.4426950408889634f;
constexpr float SBQ_SCALE = 0.08838834764831845f * LOG2E;
constexpr float DFQ_SCALE = 0.125f * LOG2E;
constexpr float NORM_EPS = 1e-6f, SUBLN_EPS = 1e-5f;
constexpr float LAMBDA_INIT = 0.2f;

constexpr size_t MiB = 1u << 20;
constexpr size_t WS_CTL = 0;
constexpr size_t CTL_SS2 = 0, CTL_SS3 = 65536, CTL_LAM = 131072, CTL_ROPE = 262144, CTL_BAR = 524288, CTL_BAR_BYTES = 16384;
constexpr size_t WS_WIN = 2 * MiB, WS_WOUT = 34 * MiB, WS_WGATE = 42 * MiB, WS_WPROJ = 50 * MiB, WS_PB = 52 * MiB;
constexpr size_t WS_XN = 64 * MiB, WS_MIXED = 64 * MiB;
constexpr size_t WS_PROJ = 128 * MiB, WS_VT = 320 * MiB, WS_KIMG = 384 * MiB, WS_END = 448 * MiB;
constexpr size_t WS_HB = 128 * MiB, WS_PLE = 192 * MiB;
constexpr size_t WS_H2B = 64 * MiB;

constexpr int LDS_BYTES = 131072 + 1024;

typedef __bf16 bf16x2_t __attribute__((ext_vector_type(2)));
__device__ __forceinline__ unsigned cvt_pk(float lo, float hi) { f32x2 v = {lo, hi}; bf16x2_t b = __builtin_convertvector(v, bf16x2_t); return __builtin_bit_cast(unsigned, b); }
__device__ __forceinline__ float bf_lo(unsigned w) { return __uint_as_float(w << 16); }
__device__ __forceinline__ float bf_hi(unsigned w) { return __uint_as_float(w & 0xffff0000u); }
__device__ __forceinline__ float wave_sum(float v) {
#pragma unroll
    for (int o = 1; o < 64; o <<= 1) v += __shfl_xor(v, o);
    return v;
}
__device__ __forceinline__ float fast_exp2(float x) { return __builtin_amdgcn_exp2f(x); }
__device__ __forceinline__ float fast_log2(float x) { return __builtin_amdgcn_logf(x); }
__device__ __forceinline__ float silu_f(float x) { return x * __builtin_amdgcn_rcpf(1.f + fast_exp2(-x * LOG2E)); }
__device__ __forceinline__ float sigmoid_f(float x) { return __builtin_amdgcn_rcpf(1.f + fast_exp2(-x * LOG2E)); }

namespace pg8 {
struct EpiBf16 {
    static constexpr bool PERM = true, AFTER_DRAIN = false;
    bf16_t* O; int ldc;
    __device__ __forceinline__ void operator()(const f32x4 (&acc)[2][2][4][2], const Unit& u, int wr, int wc, int fr, int fq) const {
        const int row0 = u.pm * BM + wr * 64 + fr; const int col0 = u.pn * BM + wc * 32 + 8 * fq;
#pragma unroll
        for (int ai = 0; ai < 2; ++ai)
#pragma unroll
            for (int m = 0; m < 4; ++m) { bf16_t* rowp = O + (size_t)(row0 + ai * HALF + m * 16) * ldc + col0;
#pragma unroll
                for (int bj = 0; bj < 2; ++bj) { const f32x4 v0 = acc[ai][bj][m][0], v1 = acc[ai][bj][m][1];
                    u32x4 w; w.x = cvt_pk_bf16(v0[0], v0[1]); w.y = cvt_pk_bf16(v0[2], v0[3]); w.z = cvt_pk_bf16(v1[0], v1[1]); w.w = cvt_pk_bf16(v1[2], v1[3]);
                    *(u32x4*)(rowp + bj * HALF) = w; } }
    }
};
struct EpiProj {
    static constexpr bool PERM = true, AFTER_DRAIN = false;
    bf16_t* O; const float* rope; bf16_t* KI;
    __device__ __forceinline__ void operator()(const f32x4 (&acc)[2][2][4][2], const Unit& u, int wr, int wc, int fr, int fq) const {
        const int row0 = u.pm * BM + wr * 64 + fr; const int col0 = u.pn * BM + wc * 32 + 8 * fq;
        const int kind = u.pn >> 2;
        const bool dorope = (kind == 3 || kind == 4) && ((wc & 1) == 0) && (fq < 2);
        const float sc = kind == 0 ? SBQ_SCALE : (kind == 3 ? DFQ_SCALE : 1.f);
        const bool dosilu = (kind == 2 || kind == 5);
#pragma unroll
        for (int ai = 0; ai < 2; ++ai)
#pragma unroll
            for (int m = 0; m < 4; ++m) { const int row = row0 + ai * HALF + m * 16; bf16_t* rowp = O + (size_t)row * NPROJ + col0;
                if (kind == 1 || kind == 4) {
                    const int cw = col0 & 1023; rowp = KI + ((size_t)(((kind == 4 ? 8 : 0) + (row >> 11)) * 8 + (cw >> 7)) * SEQ + (row & (SEQ - 1))) * 128 + (cw & 127); }
                f32x4 cs0 = {1.f, 0.f, 1.f, 0.f}, cs1 = {1.f, 0.f, 1.f, 0.f};
                if (dorope) { const f32x4* rp = (const f32x4*)(rope + ((size_t)(row & (SEQ - 1)) * 8 + 4 * fq) * 2); cs0 = rp[0]; cs1 = rp[1]; }
#pragma unroll
                for (int bj = 0; bj < 2; ++bj) { f32x4 v0 = acc[ai][bj][m][0], v1 = acc[ai][bj][m][1];
                    if (dorope) {
                        f32x4 a, b;
                        a[0] = v0[0] * cs0[0] - v0[1] * cs0[1]; a[1] = v0[1] * cs0[0] + v0[0] * cs0[1];
                        a[2] = v0[2] * cs0[2] - v0[3] * cs0[3]; a[3] = v0[3] * cs0[2] + v0[2] * cs0[3];
                        b[0] = v1[0] * cs1[0] - v1[1] * cs1[1]; b[1] = v1[1] * cs1[0] + v1[0] * cs1[1];
                        b[2] = v1[2] * cs1[2] - v1[3] * cs1[3]; b[3] = v1[3] * cs1[2] + v1[2] * cs1[3];
                        v0 = a; v1 = b; }
                    if (dosilu) {
#pragma unroll
                        for (int j = 0; j < 4; ++j) { v0[j] = silu_f(v0[j]); v1[j] = silu_f(v1[j]); } }
                    v0 = v0 * sc; v1 = v1 * sc;
                    u32x4 w; w.x = cvt_pk_bf16(v0[0], v0[1]); w.y = cvt_pk_bf16(v0[2], v0[3]); w.z = cvt_pk_bf16(v1[0], v1[1]); w.w = cvt_pk_bf16(v1[2], v1[3]);
                    *(u32x4*)(rowp + ((kind == 1 || kind == 4) ? bj * SEQ * 128 : bj * HALF)) = w; } }
    }
};
struct EpiVt {
    static constexpr bool PERM = true, AFTER_DRAIN = false;
    bf16_t* O;
    __device__ __forceinline__ void operator()(const f32x4 (&acc)[2][2][4][2], const Unit& u, int wr, int wc, int fr, int fq) const {
        const int row0 = u.pm * BM + wr * 64 + fr; const int col0 = u.pn * BM + wc * 32 + 8 * fq;
        const int p0 = (fq & 1) ? 4 : 0, p1 = (fq & 1) ? 12 : 8;
#pragma unroll
        for (int ai = 0; ai < 2; ++ai)
#pragma unroll
            for (int m = 0; m < 4; ++m) { const int row = row0 + ai * HALF + m * 16; const int gh = row >> 7, d = row & 127;
#pragma unroll
                for (int bj = 0; bj < 2; ++bj) { const int col = col0 + bj * HALF; const int b = col >> 11, sq = col & (SEQ - 1);
                    bf16_t* tp = O + ((size_t)((((gh >> 3) * 8 + b) * 8 + (gh & 7)) * 32 + (sq >> 6)) * 128 + d) * 64 + (sq & 48);
                    const f32x4 v0 = acc[ai][bj][m][0], v1 = acc[ai][bj][m][1];
                    u32x2 w0, w1; w0.x = cvt_pk_bf16(v0[0], v0[1]); w0.y = cvt_pk_bf16(v0[2], v0[3]); w1.x = cvt_pk_bf16(v1[0], v1[1]); w1.y = cvt_pk_bf16(v1[2], v1[3]);
                    *(u32x2*)(tp + p0) = w0; *(u32x2*)(tp + p1) = w1; } }
    }
};
struct EpiRes {
    static constexpr bool PERM = true, AFTER_DRAIN = false;
    const float* x; bf16_t* hb; float* ss;
    __device__ __forceinline__ void operator()(const f32x4 (&acc)[2][2][4][2], const Unit& u, int wr, int wc, int fr, int fq) const {
        const int row0 = u.pm * BM + wr * 64 + fr; const int col0 = u.pn * BM + wc * 32 + 8 * fq;
#pragma unroll
        for (int ai = 0; ai < 2; ++ai)
#pragma unroll
            for (int m = 0; m < 4; ++m) { const int row = row0 + ai * HALF + m * 16; const size_t off = (size_t)row * DM + col0; float q = 0.f;
#pragma unroll
                for (int bj = 0; bj < 2; ++bj) { const size_t o2 = off + bj * HALF;
                    const f32x4 h0 = __builtin_nontemporal_load((const f32x4*)(x + o2)) + acc[ai][bj][m][0], h1 = __builtin_nontemporal_load((const f32x4*)(x + o2 + 4)) + acc[ai][bj][m][1];
                    u32x4 w; w.x = cvt_pk_bf16(h0[0], h0[1]); w.y = cvt_pk_bf16(h0[2], h0[3]); w.z = cvt_pk_bf16(h1[0], h1[1]); w.w = cvt_pk_bf16(h1[2], h1[3]);
                    *(u32x4*)(hb + o2) = w;
                    q += ((h0[0] * h0[0] + h0[1] * h0[1]) + (h0[2] * h0[2] + h0[3] * h0[3])) + ((h1[0] * h1[0] + h1[1] * h1[1]) + (h1[2] * h1[2] + h1[3] * h1[3])); }
                q += __shfl_xor(q, 16); q += __shfl_xor(q, 32);
                if (fq == 0) atomicAdd(ss + row, q); }
    }
};
struct EpiGate {
    static constexpr bool PERM = true, AFTER_DRAIN = false;
    const bf16_t* hb; bf16_t* h2b; const bf16_t* ple; const float* ss2; float* ss3;
    __device__ __forceinline__ void operator()(const f32x4 (&acc)[2][2][4][2], const Unit& u, int wr, int wc, int fr, int fq) const {
        const int row0 = u.pm * BM + wr * 64 + fr; const int col0 = u.pn * BM + wc * 32 + 8 * fq;
#pragma unroll
        for (int ai = 0; ai < 2; ++ai)
#pragma unroll
            for (int m = 0; m < 4; ++m) { const int row = row0 + ai * HALF + m * 16; const size_t off = (size_t)row * DM + col0; float q = 0.f;
                const float rstd = rsqrtf(ss2[row] * (1.f / DM) + NORM_EPS);
#pragma unroll
                for (int bj = 0; bj < 2; ++bj) { const size_t o2 = off + bj * HALF; const u32x4 hw = *(const u32x4*)(hb + o2); const u32x4 pw = *(const u32x4*)(ple + o2);
                    const f32x4 a0 = acc[ai][bj][m][0] * rstd, a1 = acc[ai][bj][m][1] * rstd; f32x4 g0, g1;
                    g0[0] = bf_lo(hw.x) + sigmoid_f(a0[0]) * bf_lo(pw.x); g0[1] = bf_hi(hw.x) + sigmoid_f(a0[1]) * bf_hi(pw.x);
                    g0[2] = bf_lo(hw.y) + sigmoid_f(a0[2]) * bf_lo(pw.y); g0[3] = bf_hi(hw.y) + sigmoid_f(a0[3]) * bf_hi(pw.y);
                    g1[0] = bf_lo(hw.z) + sigmoid_f(a1[0]) * bf_lo(pw.z); g1[1] = bf_hi(hw.z) + sigmoid_f(a1[1]) * bf_hi(pw.z);
                    g1[2] = bf_lo(hw.w) + sigmoid_f(a1[2]) * bf_lo(pw.w); g1[3] = bf_hi(hw.w) + sigmoid_f(a1[3]) * bf_hi(pw.w);
                    u32x4 w2; w2.x = cvt_pk_bf16(g0[0], g0[1]); w2.y = cvt_pk_bf16(g0[2], g0[3]); w2.z = cvt_pk_bf16(g1[0], g1[1]); w2.w = cvt_pk_bf16(g1[2], g1[3]);
                    *(u32x4*)(h2b + o2) = w2;
                    q += ((g0[0] * g0[0] + g0[1] * g0[1]) + (g0[2] * g0[2] + g0[3] * g0[3])) + ((g1[0] * g1[0] + g1[1] * g1[1]) + (g1[2] * g1[2] + g1[3] * g1[3])); }
                q += __shfl_xor(q, 16); q += __shfl_xor(q, 32);
                if (fq == 0) atomicAdd(ss3 + row, q); }
    }
};
}
namespace att {
constexpr int KP = 272, VP = 144, KT_BYTES = 64 * KP, VT_BYTES = 128 * VP, BUF_BYTES = KT_BYTES + VT_BYTES;
constexpr int FLAG_OFF = 2 * BUF_BYTES;
constexpr int XP = 132;
constexpr float R_DONE = 152.0f;

template <bool MASK>
__device__ __forceinline__ void sb_block(const f32x16& sv, int kbase, int tq, int h, float& R, bf16x8 (&pf)[2]) {
    float c[16], z[16];
#pragma unroll
    for (int i = 0; i < 16; ++i) {
        z[i] = (!MASK || (kbase + 8 * (i >> 2) + (i & 3) < tq)) ? sv[i] : -1e30f;
        c[i] = fmaxf(z[i], 0.f) + fast_log2(1.f + fast_exp2(-fabsf(z[i])));
    }
    float T[4], OT[4], pr[4], suf[4];
#pragma unroll
    for (int g = 0; g < 4; ++g) { c[4 * g + 2] += c[4 * g + 3]; c[4 * g + 1] += c[4 * g + 2]; c[4 * g] += c[4 * g + 1]; T[g] = c[4 * g]; }
#pragma unroll
    for (int g = 0; g < 4; ++g) { OT[g] = __shfl_xor(T[g], 32); pr[g] = T[g] + OT[g]; }
    suf[3] = 0.f; suf[2] = pr[3]; suf[1] = suf[2] + pr[2]; suf[0] = suf[1] + pr[1];
    float w[16];
#pragma unroll
    for (int g = 0; g < 4; ++g) { const float off = R + suf[g] + (h == 0 ? OT[g] : 0.f);
#pragma unroll
        for (int j = 0; j < 4; ++j) { const int i = 4 * g + j; w[i] = fast_exp2(z[i] - (off + c[i])); } }
    R += suf[0] + pr[0];
#pragma unroll
    for (int sp = 0; sp < 2; ++sp) { u32x4 p; p.x = cvt_pk(w[8 * sp], w[8 * sp + 1]); p.y = cvt_pk(w[8 * sp + 2], w[8 * sp + 3]); p.z = cvt_pk(w[8 * sp + 4], w[8 * sp + 5]); p.w = cvt_pk(w[8 * sp + 6], w[8 * sp + 7]);
        pf[sp] = __builtin_bit_cast(bf16x8, p); }
}

template <int MODE>
__device__ __forceinline__ void attn_unit(LAS unsigned char* lds, const bf16_t* __restrict__ PROJ, const bf16_t* __restrict__ KIMG, const bf16_t* __restrict__ VT, bf16_t* __restrict__ MIXED,
                                          int b, int hh, int qblk, float lam, const float* __restrict__ subln_g) {
    constexpr int QB = MODE == 0 ? 256 : 128;
    constexpr int NKS = MODE == 0 ? 8 : 4;
    const int tid = opaque_tid(), lane = tid & 63, r = lane & 31, h = lane >> 5;
    const int wid = __builtin_amdgcn_readfirstlane(tid >> 6);
    const int qg = MODE == 0 ? wid : (wid & 3), role = MODE == 0 ? 0 : (wid >> 2);
    const int Q0 = qblk * QB, q0w = Q0 + 32 * qg, tq = q0w + r;
    const size_t tokbase = (size_t)b * SEQ;
    const int gbh = ((MODE == 0 ? 0 : 8) + b) * 8 + hh;
    const bf16_t* Kg = KIMG + (size_t)gbh * SEQ * 128;
    const bf16_t* Vg = VT + (size_t)gbh * 32 * 8192;
    bf16x8 qf[NKS];
    { const bf16_t* qp = PROJ + (tokbase + tq) * NPROJ + (MODE == 0 ? PQ_SB + hh * 128 : PQ_DF + hh * 128 + role * 64) + 8 * h;
#pragma unroll
      for (int ks = 0; ks < NKS; ++ks) qf[ks] = *(const bf16x8*)(qp + 16 * ks); }
    f32x16 o[4];
#pragma unroll
    for (int d = 0; d < 4; ++d)
#pragma unroll
        for (int i = 0; i < 16; ++i) o[d][i] = 0.f;
    float R = 0.f, m_run = -1e30f, l_run = 0.f;
    const int kr0 = tid >> 4, kc = tid & 15, vr0 = tid >> 3, vc = tid & 7;
    const int kst = kr0 * KP + kc * 16, vst = KT_BYTES + vr0 * VP + vc * 16;
    const bf16_t* kgl = Kg + tid * 8;
    const bf16_t* vgl = Vg + tid * 8;
    u32x4 kreg[2], vreg[2];
#define ATT_LOAD(t) do { _Pragma("unroll") for (int i_ = 0; i_ < 2; ++i_) { \
        kreg[i_] = *(const u32x4*)(kgl + (size_t)(t) * 8192 + i_ * 4096); \
        vreg[i_] = *(const u32x4*)(vgl + (size_t)(t) * 8192 + i_ * 4096); } } while (0)
#define ATT_STORE(bo) do { _Pragma("unroll") for (int i_ = 0; i_ < 2; ++i_) { \
        *(LAS u32x4*)(lds + (bo) + kst + i_ * 32 * KP) = kreg[i_]; \
        *(LAS u32x4*)(lds + (bo) + vst + i_ * 64 * VP) = vreg[i_]; } } while (0)
    const int tl = (Q0 + QB - 1) >> 6;
    const int kfrag = r * KP + (role * 64 + 8 * h) * 2;
    const int vfrag = KT_BYTES + r * VP + (8 * h) * 2;
    volatile LAS int* flags = (volatile LAS int*)(lds + FLAG_OFF);
    __syncthreads();
    ATT_LOAD(tl); ATT_STORE(0);
    __syncthreads();
    int cur = 0, it = 0;
    bool wdone = false;
    for (int t = tl;; --t, ++it) {
        if (t > 0) ATT_LOAD(t - 1);
        const int k0 = 64 * t;
        const bool active = (MODE == 0) ? (!wdone && k0 <= q0w + 30) : (k0 <= q0w + 31);
        if (active) {
            const int bo = cur * BUF_BYTES;
            f32x16 s[2];
            bf16x8 vf[4][2][2];
            if (MODE == 1) {
                bf16x8 kf[2][NKS];
#pragma unroll
                for (int kb = 0; kb < 2; ++kb)
#pragma unroll
                    for (int ks = 0; ks < NKS; ++ks) kf[kb][ks] = *(const LAS bf16x8*)(lds + bo + kfrag + kb * 32 * KP + ks * 32);
                __builtin_amdgcn_sched_barrier(0);
#pragma unroll
                for (int kb = 0; kb < 2; ++kb) {
#pragma unroll
                    for (int i = 0; i < 16; ++i) s[kb][i] = 0.f;
#pragma unroll
                    for (int ks = 0; ks < NKS; ++ks) s[kb] = __builtin_amdgcn_mfma_f32_32x32x16_bf16(kf[kb][ks], qf[ks], s[kb], 0, 0, 0);
                }
                __builtin_amdgcn_sched_barrier(0);
#pragma unroll
                for (int d = 0; d < 2; ++d)
#pragma unroll
                    for (int kb = 0; kb < 2; ++kb)
#pragma unroll
                        for (int sp = 0; sp < 2; ++sp) vf[d][kb][sp] = *(const LAS bf16x8*)(lds + bo + vfrag + d * 32 * VP + (32 * kb + 16 * sp) * 2);
                __builtin_amdgcn_sched_barrier(0);
            } else {
#pragma unroll
                for (int kb = 0; kb < 2; ++kb) {
#pragma unroll
                    for (int i = 0; i < 16; ++i) s[kb][i] = 0.f;
#pragma unroll
                    for (int ks = 0; ks < NKS; ++ks) {
                        const bf16x8 a = *(const LAS bf16x8*)(lds + bo + kfrag + kb * 32 * KP + ks * 32);
                        s[kb] = __builtin_amdgcn_mfma_f32_32x32x16_bf16(a, qf[ks], s[kb], 0, 0, 0);
                    }
                }
            }
            bf16x8 pf[2][2];
            if (MODE == 0) {
                sb_block<true>(s[1], k0 + 32 + 4 * h, tq, h, R, pf[1]);
                if (__all(R >= R_DONE)) {
#pragma unroll
                    for (int sp = 0; sp < 2; ++sp)
#pragma unroll
                        for (int j = 0; j < 8; ++j) pf[0][sp][j] = 0;
                } else sb_block<true>(s[0], k0 + 4 * h, tq, h, R, pf[0]);
                wdone = __all(R >= R_DONE);
            } else {
                float mx = -1e30f;
                if (k0 + 63 > q0w) {
#pragma unroll
                    for (int kb = 0; kb < 2; ++kb) { const int kbase = k0 + 32 * kb + 4 * h;
#pragma unroll
                        for (int i = 0; i < 16; ++i) { const int key = kbase + 8 * (i >> 2) + (i & 3); const float v = (key <= tq) ? s[kb][i] : -1e30f; s[kb][i] = v; mx = fmaxf(mx, v); } }
                } else {
#pragma unroll
                    for (int kb = 0; kb < 2; ++kb)
#pragma unroll
                        for (int i = 0; i < 16; ++i) mx = fmaxf(mx, s[kb][i]);
                }
                mx = fmaxf(mx, __shfl_xor(mx, 32));
                const float m_new = fmaxf(m_run, mx), alpha = fast_exp2(m_run - m_new);
                m_run = m_new;
                float ls = 0.f;
#pragma unroll
                for (int kb = 0; kb < 2; ++kb) {
#pragma unroll
                    for (int i = 0; i < 16; ++i) { const float p = fast_exp2(s[kb][i] - m_new); s[kb][i] = p; ls += p; }
#pragma unroll
                    for (int sp = 0; sp < 2; ++sp) { u32x4 p; p.x = cvt_pk(s[kb][8 * sp], s[kb][8 * sp + 1]); p.y = cvt_pk(s[kb][8 * sp + 2], s[kb][8 * sp + 3]); p.z = cvt_pk(s[kb][8 * sp + 4], s[kb][8 * sp + 5]); p.w = cvt_pk(s[kb][8 * sp + 6], s[kb][8 * sp + 7]);
                        pf[kb][sp] = __builtin_bit_cast(bf16x8, p); }
                }
                l_run = l_run * alpha + ls;
                if (!__all(alpha == 1.f)) {
#pragma unroll
                    for (int d = 0; d < 4; ++d)
#pragma unroll
                        for (int i = 0; i < 16; ++i) o[d][i] *= alpha;
                }
            }
            if (MODE == 1) {
                __builtin_amdgcn_sched_barrier(0);
#pragma unroll
                for (int d = 2; d < 4; ++d)
#pragma unroll
                    for (int kb = 0; kb < 2; ++kb)
#pragma unroll
                        for (int sp = 0; sp < 2; ++sp) vf[d][kb][sp] = *(const LAS bf16x8*)(lds + bo + vfrag + d * 32 * VP + (32 * kb + 16 * sp) * 2);
                __builtin_amdgcn_sched_barrier(0);
            }
#pragma unroll
            for (int d = 0; d < 4; ++d)
#pragma unroll
                for (int kb = 0; kb < 2; ++kb)
#pragma unroll
                    for (int sp = 0; sp < 2; ++sp) {
                        const bf16x8 a = (MODE == 1) ? vf[d][kb][sp] : *(const LAS bf16x8*)(lds + bo + vfrag + d * 32 * VP + (32 * kb + 16 * sp) * 2);
                        o[d] = __builtin_amdgcn_mfma_f32_32x32x16_bf16(a, pf[kb][sp], o[d], 0, 0, 0);
                    }
        }
        if (t > 0) ATT_STORE((cur ^ 1) * BUF_BYTES);
        if (MODE == 0) { if (lane == 0) flags[(it & 1) * 8 + wid] = wdone ? 1 : 0; }
        __syncthreads();
        if (t == 0) break;
        if (MODE == 0) { int alld = 1;
#pragma unroll
            for (int w2 = 0; w2 < 8; ++w2) alld &= flags[(it & 1) * 8 + w2];
            if (alld) break; }
        cur ^= 1;
    }
#undef ATT_LOAD
#undef ATT_STORE
    const int erow = lane >> 4, ech = lane & 15;
    const size_t tok0 = tokbase + q0w;
    if (MODE == 0 || role == 0) {
    }
    u32x4 gw[8];
    if (MODE == 0 || role == 0) {
        const bf16_t* gp = PROJ + (tok0 + erow) * NPROJ + (MODE == 0 ? PG_SB : PG_DF) + hh * 128 + ech * 8;
#pragma unroll
        for (int i = 0; i < 8; ++i) gw[i] = *(const u32x4*)(gp + (size_t)(4 * i) * NPROJ);
    }
    LAS unsigned char* stg = lds + (MODE == 0 ? wid * 8704 : 69632 + qg * 8704);
    if (MODE == 0) {
#pragma unroll
        for (int d = 0; d < 4; ++d)
#pragma unroll
            for (int g = 0; g < 4; ++g) { u32x2 w; w.x = cvt_pk(o[d][4 * g], o[d][4 * g + 1]); w.y = cvt_pk(o[d][4 * g + 2], o[d][4 * g + 3]);
                *(LAS u32x2*)(stg + r * 272 + (32 * d + 8 * g + 4 * h) * 2) = w; }
    } else {
        const float lt = l_run + __shfl_xor(l_run, 32);
        const float inv = 1.f / lt;
        LAS float* xq = (LAS float*)lds + (qg * 32 + r) * XP + 4 * h;
        if (role == 1) {
            const float f = inv * lam;
#pragma unroll
            for (int d = 0; d < 4; ++d)
#pragma unroll
                for (int g = 0; g < 4; ++g) *(LAS f32x4*)(xq + 32 * d + 8 * g) = (f32x4){o[d][4 * g] * f, o[d][4 * g + 1] * f, o[d][4 * g + 2] * f, o[d][4 * g + 3] * f};
        }
        __syncthreads();
        if (role == 0) {
            float q = 0.f;
#pragma unroll
            for (int d = 0; d < 4; ++d)
#pragma unroll
                for (int g = 0; g < 4; ++g) { const f32x4 x2 = *(const LAS f32x4*)(xq + 32 * d + 8 * g);
#pragma unroll
                    for (int j = 0; j < 4; ++j) { const float v = o[d][4 * g + j] * inv - x2[j]; o[d][4 * g + j] = v; q += v * v; } }
            q += __shfl_xor(q, 32);
            const float rs = rsqrtf(q * (1.f / 128.f) + SUBLN_EPS) * (1.f - LAMBDA_INIT);
            const float* sg = subln_g + 4 * h;
#pragma unroll
            for (int d = 0; d < 4; ++d)
#pragma unroll
                for (int g = 0; g < 4; ++g) { const f32x4 sv = *(const f32x4*)(sg + 32 * d + 8 * g);
                    u32x2 w; w.x = cvt_pk(o[d][4 * g] * rs * sv[0], o[d][4 * g + 1] * rs * sv[1]); w.y = cvt_pk(o[d][4 * g + 2] * rs * sv[2], o[d][4 * g + 3] * rs * sv[3]);
                    *(LAS u32x2*)(stg + r * 272 + (32 * d + 8 * g + 4 * h) * 2) = w; }
        }
    }
    if (MODE == 0 || role == 0) {
        asm volatile("s_waitcnt lgkmcnt(0)" ::: "memory");
        bf16_t* op = MIXED + (tok0 + erow) * DM + (MODE == 0 ? 0 : 1024) + hh * 128 + ech * 8;
#pragma unroll
        for (int i = 0; i < 8; ++i) { const u32x4 ov = *(const LAS u32x4*)(stg + (4 * i + erow) * 272 + ech * 16); const u32x4 g4 = gw[i];
            u32x4 w; w.x = cvt_pk(bf_lo(ov.x) * bf_lo(g4.x), bf_hi(ov.x) * bf_hi(g4.x)); w.y = cvt_pk(bf_lo(ov.y) * bf_lo(g4.y), bf_hi(ov.y) * bf_hi(g4.y));
            w.z = cvt_pk(bf_lo(ov.z) * bf_lo(g4.z), bf_hi(ov.z) * bf_hi(g4.z)); w.w = cvt_pk(bf_lo(ov.w) * bf_lo(g4.w), bf_hi(ov.w) * bf_hi(g4.w));
            *(u32x4*)(op + (size_t)(4 * i) * DM) = w; }
    }
}

__device__ __forceinline__ void attn_unit_df(LAS unsigned char* lds, const bf16_t* __restrict__ PROJ, const bf16_t* __restrict__ KIMG, const bf16_t* __restrict__ VT, bf16_t* __restrict__ MIXED,
                                             int b, int hh, int qblk, float lam, const float* __restrict__ subln_g) {
    constexpr int VB0 = 2 * KT_BYTES;
    const int tid = opaque_tid(), lane = tid & 63, r = lane & 31, h = lane >> 5;
    const int wid = __builtin_amdgcn_readfirstlane(tid >> 6);
    const int qg = wid & 3, role = wid >> 2;
    const int Q0 = qblk * 128, q0w = Q0 + 32 * qg, tq = q0w + r;
    const size_t tokbase = (size_t)b * SEQ;
    const int gbh = (8 + b) * 8 + hh;
    const bf16_t* Kg = KIMG + (size_t)gbh * SEQ * 128;
    const bf16_t* Vg = VT + (size_t)gbh * 32 * 8192;
    bf16x8 qf[4];
    { const bf16_t* qp = PROJ + (tokbase + tq) * NPROJ + PQ_DF + hh * 128 + role * 64 + 8 * h;
#pragma unroll
      for (int ks = 0; ks < 4; ++ks) qf[ks] = *(const bf16x8*)(qp + 16 * ks); }
    f32x16 o[4];
#pragma unroll
    for (int d = 0; d < 4; ++d)
#pragma unroll
        for (int i = 0; i < 16; ++i) o[d][i] = 0.f;
    float m_run = -1e30f, l_run = 0.f, alpha = 1.f;
    f32x16 negm;
#pragma unroll
    for (int j = 0; j < 16; ++j) negm[j] = 0.f;
    const int kr0 = tid >> 4, kc = tid & 15, vr0 = tid >> 3, vc = tid & 7;
    const int kst = kr0 * KP + kc * 16, vst = vr0 * VP + vc * 16;
    const bf16_t* kgl = Kg + tid * 8;
    const bf16_t* vgl = Vg + tid * 8;
    u32x4 kreg[2], vreg[2];
#define DF_LOAD(t) do { _Pragma("unroll") for (int i_ = 0; i_ < 2; ++i_) { \
        kreg[i_] = *(const u32x4*)(kgl + (size_t)(t) * 8192 + i_ * 4096); \
        vreg[i_] = *(const u32x4*)(vgl + (size_t)(t) * 8192 + i_ * 4096); } } while (0)
#define DF_STORE(ko, vo) do { _Pragma("unroll") for (int i_ = 0; i_ < 2; ++i_) { \
        *(LAS u32x4*)(lds + (ko) + kst + i_ * 32 * KP) = kreg[i_]; \
        *(LAS u32x4*)(lds + (vo) + vst + i_ * 64 * VP) = vreg[i_]; } } while (0)
#define DF_VLOAD(vo) do { _Pragma("unroll") for (int d_ = 0; d_ < 4; ++d_) _Pragma("unroll") for (int kb_ = 0; kb_ < 2; ++kb_) _Pragma("unroll") for (int sp_ = 0; sp_ < 2; ++sp_) \
        vf[d_][kb_][sp_] = *(const LAS bf16x8*)(lds + (vo) + vfrag + d_ * 32 * VP + (32 * kb_ + 16 * sp_) * 2); } while (0)
#define DF_PV() do { _Pragma("unroll") for (int d_ = 0; d_ < 4; ++d_) _Pragma("unroll") for (int kb_ = 0; kb_ < 2; ++kb_) _Pragma("unroll") for (int sp_ = 0; sp_ < 2; ++sp_) \
        o[d_] = __builtin_amdgcn_mfma_f32_32x32x16_bf16(vf[d_][kb_][sp_], pf[kb_][sp_], o[d_], 0, 0, 0); } while (0)
#define DF_RESCALE() do { if (!__all(alpha == 1.f)) { _Pragma("unroll") for (int d_ = 0; d_ < 4; ++d_) _Pragma("unroll") for (int i_ = 0; i_ < 16; ++i_) o[d_][i_] *= alpha; } } while (0)
    const int tl = (Q0 + 127) >> 6, NT = tl + 1;
    const int kfrag = r * KP + (role * 64 + 8 * h) * 2;
    const int vfrag = r * VP + (8 * h) * 2;
    __syncthreads();
    DF_LOAD(tl); DF_STORE(0, VB0);
    __syncthreads();
    bool have_p = false;
    bf16x8 pf[2][2];
    for (int i = 0; i < NT; ++i) {
        const int t = tl - i, k0 = 64 * t;
        if (t > 0) DF_LOAD(t - 1);
        if (k0 <= q0w + 31) {
            const int ko = (i & 1) * KT_BYTES;
            bf16x8 kf[2][4];
#pragma unroll
            for (int kb = 0; kb < 2; ++kb)
#pragma unroll
                for (int ks = 0; ks < 4; ++ks) kf[kb][ks] = *(const LAS bf16x8*)(lds + ko + kfrag + kb * 32 * KP + ks * 32);
            f32x16 s[2];
            bf16x8 vf[2][2][2];
            const int vo = VB0 + ((i + 2) % 3) * VT_BYTES;
#define DF_VL(g) do { _Pragma("unroll") for (int kb_ = 0; kb_ < 2; ++kb_) _Pragma("unroll") for (int sp_ = 0; sp_ < 2; ++sp_) \
        vf[(g) & 1][kb_][sp_] = *(const LAS bf16x8*)(lds + vo + vfrag + (g) * 32 * VP + (32 * kb_ + 16 * sp_) * 2); } while (0)
            if (have_p) { DF_VL(0); }
            __builtin_amdgcn_sched_barrier(0);
#pragma unroll
            for (int kb = 0; kb < 2; ++kb) {
                s[kb] = __builtin_amdgcn_mfma_f32_32x32x16_bf16(kf[kb][0], qf[0], negm, 0, 0, 0);
#pragma unroll
                for (int ks = 1; ks < 4; ++ks) s[kb] = __builtin_amdgcn_mfma_f32_32x32x16_bf16(kf[kb][ks], qf[ks], s[kb], 0, 0, 0);
            }
            if (!have_p) {
                float mx = -1e30f;
#pragma unroll
                for (int kb = 0; kb < 2; ++kb) { const int kbase = k0 + 32 * kb + 4 * h;
#pragma unroll
                    for (int j = 0; j < 16; ++j) { const int key = kbase + 8 * (j >> 2) + (j & 3); const float v = (key <= tq) ? s[kb][j] : -1e30f; s[kb][j] = v; mx = fmaxf(mx, v); } }
                mx = fmaxf(mx, __shfl_xor(mx, 32));
                m_run = mx; alpha = 1.f;
                float ls = 0.f;
#pragma unroll
                for (int kb = 0; kb < 2; ++kb) {
#pragma unroll
                    for (int j = 0; j < 16; ++j) { const float p = fast_exp2(s[kb][j] - mx); s[kb][j] = p; ls += p; }
#pragma unroll
                    for (int sp = 0; sp < 2; ++sp) { u32x4 p; p.x = cvt_pk(s[kb][8 * sp], s[kb][8 * sp + 1]); p.y = cvt_pk(s[kb][8 * sp + 2], s[kb][8 * sp + 3]); p.z = cvt_pk(s[kb][8 * sp + 4], s[kb][8 * sp + 5]); p.w = cvt_pk(s[kb][8 * sp + 6], s[kb][8 * sp + 7]);
                        pf[kb][sp] = __builtin_bit_cast(bf16x8, p); }
                }
                l_run = ls;
#pragma unroll
                for (int j = 0; j < 16; ++j) negm[j] = -m_run;
                asm volatile("" : "+v"(negm));
                have_p = true;
            } else {
                DF_RESCALE();
                u32x4 pw[2][2];
                float mx = -1e30f; f32x2 ls2 = {0.f, 0.f};
#define DF_MF(k) o[(k) >> 2] = __builtin_amdgcn_mfma_f32_32x32x16_bf16(vf[((k) >> 2) & 1][((k) >> 1) & 1][(k) & 1], pf[((k) >> 1) & 1][(k) & 1], o[(k) >> 2], 0, 0, 0)
#define DF_S(e) s[(e) >> 4][(e) & 15]
                DF_VL(1);
                __builtin_amdgcn_sched_barrier(0);
                DF_MF(0);
                mx = fmaxf(fmaxf(mx, DF_S(0)), DF_S(1));
                mx = fmaxf(fmaxf(mx, DF_S(2)), DF_S(3));
                mx = fmaxf(fmaxf(mx, DF_S(4)), DF_S(5));
                mx = fmaxf(fmaxf(mx, DF_S(6)), DF_S(7));
                __builtin_amdgcn_sched_barrier(0);
                DF_MF(1);
                mx = fmaxf(fmaxf(mx, DF_S(8)), DF_S(9));
                mx = fmaxf(fmaxf(mx, DF_S(10)), DF_S(11));
                mx = fmaxf(fmaxf(mx, DF_S(12)), DF_S(13));
                mx = fmaxf(fmaxf(mx, DF_S(14)), DF_S(15));
                __builtin_amdgcn_sched_barrier(0);
                DF_MF(2);
                mx = fmaxf(fmaxf(mx, DF_S(16)), DF_S(17));
                mx = fmaxf(fmaxf(mx, DF_S(18)), DF_S(19));
                mx = fmaxf(fmaxf(mx, DF_S(20)), DF_S(21));
                mx = fmaxf(fmaxf(mx, DF_S(22)), DF_S(23));
                __builtin_amdgcn_sched_barrier(0);
                DF_MF(3);
                mx = fmaxf(fmaxf(mx, DF_S(24)), DF_S(25));
                mx = fmaxf(fmaxf(mx, DF_S(26)), DF_S(27));
                mx = fmaxf(fmaxf(mx, DF_S(28)), DF_S(29));
                mx = fmaxf(fmaxf(mx, DF_S(30)), DF_S(31));
                { auto rr = __builtin_amdgcn_permlane32_swap(__float_as_uint(mx), __float_as_uint(mx), false, false); mx = fmaxf(__uint_as_float(rr[0]), __uint_as_float(rr[1])); }
                alpha = 1.f;
                if (!__all(mx <= 8.f)) { const float dl = fmaxf(mx, 0.f); alpha = fast_exp2(-dl); m_run += dl;
#pragma unroll
                    for (int j = 0; j < 16; ++j) { s[0][j] -= dl; s[1][j] -= dl; negm[j] = -m_run; }
                    asm volatile("" : "+v"(negm)); }
                __builtin_amdgcn_sched_barrier(0);
                DF_VL(2);
                DF_MF(4);
                DF_S(0) = fast_exp2(DF_S(0));
                DF_S(1) = fast_exp2(DF_S(1));
                ls2 += (f32x2){DF_S(0), DF_S(1)}; pw[0][0][0] = cvt_pk(DF_S(0), DF_S(1));
                DF_S(2) = fast_exp2(DF_S(2));
                DF_S(3) = fast_exp2(DF_S(3));
                ls2 += (f32x2){DF_S(2), DF_S(3)}; pw[0][0][1] = cvt_pk(DF_S(2), DF_S(3));
                __builtin_amdgcn_sched_barrier(0);
                DF_MF(5);
                DF_S(4) = fast_exp2(DF_S(4));
                DF_S(5) = fast_exp2(DF_S(5));
                ls2 += (f32x2){DF_S(4), DF_S(5)}; pw[0][0][2] = cvt_pk(DF_S(4), DF_S(5));
                DF_S(6) = fast_exp2(DF_S(6));
                DF_S(7) = fast_exp2(DF_S(7));
                ls2 += (f32x2){DF_S(6), DF_S(7)}; pw[0][0][3] = cvt_pk(DF_S(6), DF_S(7));
                __builtin_amdgcn_sched_barrier(0);
                DF_MF(6);
                DF_S(8) = fast_exp2(DF_S(8));
                DF_S(9) = fast_exp2(DF_S(9));
                ls2 += (f32x2){DF_S(8), DF_S(9)}; pw[0][1][0] = cvt_pk(DF_S(8), DF_S(9));
                DF_S(10) = fast_exp2(DF_S(10));
                DF_S(11) = fast_exp2(DF_S(11));
                ls2 += (f32x2){DF_S(10), DF_S(11)}; pw[0][1][1] = cvt_pk(DF_S(10), DF_S(11));
                __builtin_amdgcn_sched_barrier(0);
                DF_MF(7);
                DF_S(12) = fast_exp2(DF_S(12));
                DF_S(13) = fast_exp2(DF_S(13));
                ls2 += (f32x2){DF_S(12), DF_S(13)}; pw[0][1][2] = cvt_pk(DF_S(12), DF_S(13));
                DF_S(14) = fast_exp2(DF_S(14));
                DF_S(15) = fast_exp2(DF_S(15));
                ls2 += (f32x2){DF_S(14), DF_S(15)}; pw[0][1][3] = cvt_pk(DF_S(14), DF_S(15));
                __builtin_amdgcn_sched_barrier(0);
                DF_VL(3);
                DF_MF(8);
                DF_S(16) = fast_exp2(DF_S(16));
                DF_S(17) = fast_exp2(DF_S(17));
                ls2 += (f32x2){DF_S(16), DF_S(17)}; pw[1][0][0] = cvt_pk(DF_S(16), DF_S(17));
                __builtin_amdgcn_sched_barrier(0);
                DF_MF(9);
                DF_S(18) = fast_exp2(DF_S(18));
                DF_S(19) = fast_exp2(DF_S(19));
                ls2 += (f32x2){DF_S(18), DF_S(19)}; pw[1][0][1] = cvt_pk(DF_S(18), DF_S(19));
                __builtin_amdgcn_sched_barrier(0);
                DF_MF(10);
                DF_S(20) = fast_exp2(DF_S(20));
                DF_S(21) = fast_exp2(DF_S(21));
                ls2 += (f32x2){DF_S(20), DF_S(21)}; pw[1][0][2] = cvt_pk(DF_S(20), DF_S(21));
                __builtin_amdgcn_sched_barrier(0);
                DF_MF(11);
                DF_S(22) = fast_exp2(DF_S(22));
                DF_S(23) = fast_exp2(DF_S(23));
                ls2 += (f32x2){DF_S(22), DF_S(23)}; pw[1][0][3] = cvt_pk(DF_S(22), DF_S(23));
                __builtin_amdgcn_sched_barrier(0);
                DF_MF(12);
                DF_S(24) = fast_exp2(DF_S(24));
                DF_S(25) = fast_exp2(DF_S(25));
                ls2 += (f32x2){DF_S(24), DF_S(25)}; pw[1][1][0] = cvt_pk(DF_S(24), DF_S(25));
                __builtin_amdgcn_sched_barrier(0);
                DF_MF(13);
                DF_S(26) = fast_exp2(DF_S(26));
                DF_S(27) = fast_exp2(DF_S(27));
                ls2 += (f32x2){DF_S(26), DF_S(27)}; pw[1][1][1] = cvt_pk(DF_S(26), DF_S(27));
                __builtin_amdgcn_sched_barrier(0);
                DF_MF(14);
                DF_S(28) = fast_exp2(DF_S(28));
                DF_S(29) = fast_exp2(DF_S(29));
                ls2 += (f32x2){DF_S(28), DF_S(29)}; pw[1][1][2] = cvt_pk(DF_S(28), DF_S(29));
                __builtin_amdgcn_sched_barrier(0);
                DF_MF(15);
                DF_S(30) = fast_exp2(DF_S(30));
                DF_S(31) = fast_exp2(DF_S(31));
                ls2 += (f32x2){DF_S(30), DF_S(31)}; pw[1][1][3] = cvt_pk(DF_S(30), DF_S(31));
                __builtin_amdgcn_sched_barrier(0);
                l_run = l_run * alpha + (ls2[0] + ls2[1]);
#pragma unroll
                for (int kb = 0; kb < 2; ++kb)
#pragma unroll
                    for (int sp = 0; sp < 2; ++sp) pf[kb][sp] = __builtin_bit_cast(bf16x8, pw[kb][sp]);
#undef DF_VL
#undef DF_MF
#undef DF_S
            }
        }
        if (t > 0) DF_STORE(((i + 1) & 1) * KT_BYTES, VB0 + ((i + 1) % 3) * VT_BYTES);
        __syncthreads();
    }
    if (have_p) {
        DF_RESCALE();
        bf16x8 vf[4][2][2];
        DF_VLOAD(VB0 + ((NT - 1) % 3) * VT_BYTES);
        DF_PV();
    }
    __syncthreads();
#undef DF_LOAD
#undef DF_STORE
#undef DF_VLOAD
#undef DF_PV
#undef DF_RESCALE
    const int erow = lane >> 4, ech = lane & 15;
    const size_t tok0 = tokbase + q0w;
    u32x4 gw[8];
    if (role == 0) {
        const bf16_t* gp = PROJ + (tok0 + erow) * NPROJ + PG_DF + hh * 128 + ech * 8;
#pragma unroll
        for (int i = 0; i < 8; ++i) gw[i] = *(const u32x4*)(gp + (size_t)(4 * i) * NPROJ);
    }
    LAS unsigned char* stg = lds + 69632 + qg * 8704;
    {
        const float lt = l_run + __shfl_xor(l_run, 32);
        const float inv = 1.f / lt;
        LAS float* xq = (LAS float*)lds + (qg * 32 + r) * XP + 4 * h;
        if (role == 1) {
            const float f = inv * lam;
#pragma unroll
            for (int d = 0; d < 4; ++d)
#pragma unroll
                for (int g = 0; g < 4; ++g) *(LAS f32x4*)(xq + 32 * d + 8 * g) = (f32x4){o[d][4 * g] * f, o[d][4 * g + 1] * f, o[d][4 * g + 2] * f, o[d][4 * g + 3] * f};
        }
        __syncthreads();
        if (role == 0) {
            float q = 0.f;
#pragma unroll
            for (int d = 0; d < 4; ++d)
#pragma unroll
                for (int g = 0; g < 4; ++g) { const f32x4 x2 = *(const LAS f32x4*)(xq + 32 * d + 8 * g);
#pragma unroll
                    for (int j = 0; j < 4; ++j) { const float v = o[d][4 * g + j] * inv - x2[j]; o[d][4 * g + j] = v; q += v * v; } }
            q += __shfl_xor(q, 32);
            const float rs = rsqrtf(q * (1.f / 128.f) + SUBLN_EPS) * (1.f - LAMBDA_INIT);
            const float* sg = subln_g + 4 * h;
#pragma unroll
            for (int d = 0; d < 4; ++d)
#pragma unroll
                for (int g = 0; g < 4; ++g) { const f32x4 sv = *(const f32x4*)(sg + 32 * d + 8 * g);
                    u32x2 w; w.x = cvt_pk(o[d][4 * g] * rs * sv[0], o[d][4 * g + 1] * rs * sv[1]); w.y = cvt_pk(o[d][4 * g + 2] * rs * sv[2], o[d][4 * g + 3] * rs * sv[3]);
                    *(LAS u32x2*)(stg + r * 272 + (32 * d + 8 * g + 4 * h) * 2) = w; }
            asm volatile("s_waitcnt lgkmcnt(0)" ::: "memory");
            bf16_t* op = MIXED + (tok0 + erow) * DM + 1024 + hh * 128 + ech * 8;
#pragma unroll
            for (int i = 0; i < 8; ++i) { const u32x4 ov = *(const LAS u32x4*)(stg + (4 * i + erow) * 272 + ech * 16); const u32x4 g4 = gw[i];
                u32x4 w; w.x = cvt_pk(bf_lo(ov.x) * bf_lo(g4.x), bf_hi(ov.x) * bf_hi(g4.x)); w.y = cvt_pk(bf_lo(ov.y) * bf_lo(g4.y), bf_hi(ov.y) * bf_hi(g4.y));
                w.z = cvt_pk(bf_lo(ov.z) * bf_lo(g4.z), bf_hi(ov.z) * bf_hi(g4.z)); w.w = cvt_pk(bf_lo(ov.w) * bf_lo(g4.w), bf_hi(ov.w) * bf_hi(g4.w));
                *(u32x4*)(op + (size_t)(4 * i) * DM) = w; }
        }
    }
}
}
#define XB_TMO      128
#define XB_XCNT(j)  (256  + 64 * (j))
#define XB_XSUB(j)  (1280 + 64 * (j))
#define XB_XGEN(j)  (2304 + 64 * (j))
#define XB_TOP      3328
#define XB_TOPGEN   3392
#define XCD_BAR_WORDS 3456
#define XB_SPIN_CAP (1u << 18)

__device__ __forceinline__ unsigned xb_ld(unsigned* p)              { return __hip_atomic_load(p, __ATOMIC_RELAXED, __HIP_MEMORY_SCOPE_AGENT); }
__device__ __forceinline__ unsigned xb_add(unsigned* p, unsigned v) { return __hip_atomic_fetch_add(p, v, __ATOMIC_RELAXED, __HIP_MEMORY_SCOPE_AGENT); }
__device__ __forceinline__ unsigned xb_xcc_id() { return (unsigned)__builtin_amdgcn_s_getreg((3 << 11) | 20) & 0xFu; }
#define XB_SPIN(cond, bar) do { unsigned _sp = 0; while (cond) { __builtin_amdgcn_s_sleep(1); \
    if ((++_sp & 255u) == 0u) { if (xb_ld(&(bar)[XB_TMO])) break; if (_sp > XB_SPIN_CAP) { atomicAdd(&(bar)[XB_TMO], 1u); break; } } } } while (0)

struct XcdBarrier {
    unsigned* bar; unsigned x;
    volatile LAS unsigned* st;
};

__device__ __forceinline__ XcdBarrier xcd_barrier_post(unsigned* bar, volatile LAS unsigned* st) {
    XcdBarrier b; b.bar = bar; b.x = xb_xcc_id(); b.st = st;
    if (threadIdx.x == 0) (void)xb_add(&bar[XB_XCNT(b.x)], 1u);
    return b;
}
__device__ __forceinline__ void xcd_barrier_complete(unsigned* bar, unsigned x, unsigned& nloc, unsigned& nx) {
    const unsigned G = gridDim.x * gridDim.y * gridDim.z;
    unsigned sum, cnt, mine, sp = 0u;
    for (;;) {
        sum = 0u; cnt = 0u; mine = 0u;
#pragma unroll
        for (unsigned j = 0; j < 16; ++j) { const unsigned c = xb_ld(&bar[XB_XCNT(j)]); sum += c; cnt += (c > 0u) ? 1u : 0u; mine = (j == x) ? c : mine; }
        if (sum == G) break;
        __builtin_amdgcn_s_sleep(1);
        if ((++sp & 255u) == 0u) { if (xb_ld(&bar[XB_TMO])) break; if (sp > XB_SPIN_CAP) { atomicAdd(&bar[XB_TMO], 1u); break; } }
    }
    nloc = mine > 0u ? mine : 1u; nx = cnt > 0u ? cnt : 1u;
}

__device__ __forceinline__ void xcd_barrier(const XcdBarrier& b) {
    asm volatile("s_waitcnt vmcnt(0)" ::: "memory");
    __syncthreads();
    if (threadIdx.x == 0) {
        unsigned* bar = b.bar;
        __builtin_amdgcn_s_waitcnt(0);
        unsigned nloc = b.st[0], nx = b.st[1];
        if (nloc == 0u) { xcd_barrier_complete(bar, b.x, nloc, nx); b.st[0] = nloc; b.st[1] = nx; }
        const unsigned old = xb_add(&bar[XB_XSUB(b.x)], 1u);
        const unsigned gen = old / nloc;
        if (old + 1u == (gen + 1u) * nloc) {
            __builtin_amdgcn_fence(__ATOMIC_RELEASE, "agent");
            asm volatile("s_waitcnt vmcnt(0)" ::: "memory");
            const unsigned og = xb_add(&bar[XB_TOP], 1u);
            const unsigned tg = og / nx;
            if (og + 1u == (tg + 1u) * nx) xb_add(&bar[XB_TOPGEN], 1u);
            else XB_SPIN(xb_ld(&bar[XB_TOPGEN]) == tg, bar);
            __builtin_amdgcn_fence(__ATOMIC_ACQUIRE, "agent");
            xb_add(&bar[XB_XGEN(b.x)], 1u);
            asm volatile("s_waitcnt vmcnt(0)" ::: "memory");
        } else {
            XB_SPIN(xb_ld(&bar[XB_XGEN(b.x)]) == gen, bar);
            __builtin_amdgcn_fence(__ATOMIC_ACQUIRE, "agent");
            asm volatile("s_waitcnt vmcnt(0)" ::: "memory");
        }
    }
    __syncthreads();
}

__device__ __forceinline__ int win_dst_row(int c) {
    const int seg = c >> 10, w = c & 1023, d6 = w & 63;
    const int wp = d6 < 16 ? (w & ~63) + (d6 < 8 ? 2 * d6 : 2 * (d6 - 8) + 1) : w;
    switch (seg) { case 0: return w; case 1: return 1024 + w; case 2: return 6144 + w; case 3: return 2048 + w;
                   case 4: return 3072 + wp; case 5: return 4096 + wp; case 6: return 7168 + w; default: return 5120 + w; }
}
struct TItem { const float* W; bf16_t* WT; const float* ks; int K, N, win, item; };
__device__ __forceinline__ void tr_load(const TItem& t, float (&v)[32], int lane) {
    const int nblk = t.N / 32, kb = t.item / nblk, nb = t.item % nblk; const float* p = t.W + (size_t)(64 * kb + (lane >> 5)) * t.N + 32 * nb + (lane & 31);
#pragma unroll
    for (int i = 0; i < 32; ++i) v[i] = __builtin_nontemporal_load(&p[(size_t)(2 * i) * t.N]);
}
__device__ __forceinline__ void tr_write(const float (&v)[32], LAS float* scr, int lane) {
#pragma unroll
    for (int i = 0; i < 32; ++i) scr[(2 * i + (lane >> 5)) * 33 + (lane & 31)] = v[i];
}
__device__ __forceinline__ void tr_store(const TItem& t, LAS float* scr, int lane) {
    const int nblk = t.N / 32, kb = t.item / nblk, nb = t.item % nblk, k0 = 64 * kb, n0 = 32 * nb, c = lane & 7;
    f32x4 s0 = {1.f, 1.f, 1.f, 1.f}, s1 = {1.f, 1.f, 1.f, 1.f};
    if (t.ks) { s0 = *(const f32x4*)(t.ks + k0 + 8 * c); s1 = *(const f32x4*)(t.ks + k0 + 8 * c + 4); }
#pragma unroll
    for (int j = 0; j < 4; ++j) { const int n = (lane >> 3) + 8 * j; const LAS float* s = scr + (8 * c) * 33 + n;
        u32x4 o; o.x = cvt_pk(s[0 * 33] * s0[0], s[1 * 33] * s0[1]); o.y = cvt_pk(s[2 * 33] * s0[2], s[3 * 33] * s0[3]); o.z = cvt_pk(s[4 * 33] * s1[0], s[5 * 33] * s1[1]); o.w = cvt_pk(s[6 * 33] * s1[2], s[7 * 33] * s1[3]);
        const int dn = t.win ? win_dst_row(n0 + n) : (n0 + n);
        *(u32x4*)(t.WT + (size_t)dn * t.K + k0 + 8 * c) = o; }
}
__device__ __forceinline__ void rms_load(const float* __restrict__ xrow, f32x4 (&v)[8], int lane) {
    const f32x4* xr = (const f32x4*)xrow + lane;
#pragma unroll
    for (int j = 0; j < 8; ++j) v[j] = __builtin_nontemporal_load(&xr[64 * j]);
}
__device__ __forceinline__ void rms_finish(const f32x4 (&v)[8], const f32x4 (&gv)[8], bf16_t* __restrict__ orow, int lane) {
    float s = 0.f;
#pragma unroll
    for (int j = 0; j < 8; ++j) s += (v[j][0] * v[j][0] + v[j][1] * v[j][1]) + (v[j][2] * v[j][2] + v[j][3] * v[j][3]);
    const float rstd = rsqrtf(wave_sum(s) * (1.f / DM) + NORM_EPS);
    u32x2* o8 = (u32x2*)orow + lane;
#pragma unroll
    for (int j = 0; j < 8; ++j) { u32x2 w; w.x = cvt_pk(v[j][0] * rstd * gv[j][0], v[j][1] * rstd * gv[j][1]); w.y = cvt_pk(v[j][2] * rstd * gv[j][2], v[j][3] * rstd * gv[j][3]); o8[64 * j] = w; }
}

struct Args { const float* in[14]; float* out; unsigned char* ws; };

__global__ void __launch_bounds__(512, 2) fwd_megakernel(Args a) {
    extern __shared__ __attribute__((aligned(16))) unsigned char lds_raw[];
    LAS unsigned char* lds = (LAS unsigned char*)lds_raw;
    { cg::grid_group grid = cg::this_grid(); if (a.ws == nullptr) grid.sync(); }
    const int tid = threadIdx.x, lane = tid & 63, wave = __builtin_amdgcn_readfirstlane(tid >> 6);
    const int G = gridDim.x, bx = blockIdx.x;
    const int vcu = (G % 8 == 0) ? (bx % 8) * (G / 8) + bx / 8 : bx;
    unsigned char* ws = a.ws;
    float* ss2 = (float*)(ws + WS_CTL + CTL_SS2); float* ss3 = (float*)(ws + WS_CTL + CTL_SS3); float* lamp = (float*)(ws + WS_CTL + CTL_LAM); float* rope = (float*)(ws + WS_CTL + CTL_ROPE);
    bf16_t* WIN = (bf16_t*)(ws + WS_WIN); bf16_t* WOUT = (bf16_t*)(ws + WS_WOUT); bf16_t* WGATE = (bf16_t*)(ws + WS_WGATE); bf16_t* WPROJ = (bf16_t*)(ws + WS_WPROJ);
    bf16_t* PB = (bf16_t*)(ws + WS_PB); bf16_t* XN = (bf16_t*)(ws + WS_XN); bf16_t* MIXED = (bf16_t*)(ws + WS_MIXED); bf16_t* PROJ = (bf16_t*)(ws + WS_PROJ);
    bf16_t* VT = (bf16_t*)(ws + WS_VT); bf16_t* KIMG = (bf16_t*)(ws + WS_KIMG); bf16_t* HB = (bf16_t*)(ws + WS_HB); bf16_t* PLEB = (bf16_t*)(ws + WS_PLE); bf16_t* H2B = (bf16_t*)(ws + WS_H2B);
    const float* x = a.in[0]; float* out = a.out;
    volatile LAS unsigned* xst = (volatile LAS unsigned*)(lds + 131072);
    if (tid == 0) { xst[0] = 0u; xst[1] = 0u; }
    __syncthreads();
    const XcdBarrier xb = xcd_barrier_post((unsigned*)(ws + WS_CTL + CTL_BAR), xst);

    {
        const int gw = bx * 8 + wave, NGW = G * 8; const int gt = bx * 512 + tid, NGT = G * 512;
        for (int i = gt; i < 2 * NTOK; i += NGT) ss2[i] = 0.f;
        if (gt == 0) { float s1 = 0.f, s2 = 0.f; for (int i = 0; i < 64; ++i) { s1 += a.in[4][i] * a.in[5][i]; s2 += a.in[6][i] * a.in[7][i]; } lamp[0] = expf(s1) - expf(s2) + LAMBDA_INIT; }
        for (int i = gt; i < SEQ * 8; i += NGT) { const int pos = i >> 3, f = i & 7;
            const float invf = (float)exp2(-(double)f * 0.125 * 18.931568569324174);
            const float angf = (float)pos * invf;
            const double tw = 6.283185307179586476925; double ang = (double)angf; ang -= tw * rint(ang / tw);
            rope[2 * i] = (float)cos(ang); rope[2 * i + 1] = (float)sin(ang); }
        LAS float* scr = (LAS float*)(lds + wave * 16384);
        constexpr int I_IN = (DM / 64) * (8192 / 32), I_SQ = (DM / 64) * (DM / 32), I_PR = (PLE / 64) * (DM / 32), I_ALL = I_IN + 2 * I_SQ + I_PR;
#define P0_DECODE(T, it_) do { int rr_ = (it_); \
            if (rr_ < I_IN) { T = TItem{a.in[3], WIN, nullptr, DM, 8192, 1, rr_}; } \
            else if (rr_ < I_IN + I_SQ) { T = TItem{a.in[9], WOUT, nullptr, DM, DM, 0, rr_ - I_IN}; } \
            else if (rr_ < I_IN + 2 * I_SQ) { T = TItem{a.in[11], WGATE, a.in[10], DM, DM, 0, rr_ - I_IN - I_SQ}; } \
            else { T = TItem{a.in[12], WPROJ, nullptr, PLE, DM, 0, rr_ - I_IN - 2 * I_SQ}; } } while (0)
        {
            float tv[32]; TItem cur, nxt; int it = gw;
            if (it < I_ALL) { P0_DECODE(cur, it); tr_load(cur, tv, lane); }
            while (it < I_ALL) {
                tr_write(tv, scr, lane);
                const int itn = it + NGW;
                if (itn < I_ALL) { P0_DECODE(nxt, itn); tr_load(nxt, tv, lane); }
                asm volatile("s_waitcnt lgkmcnt(0)" ::: "memory");
                tr_store(cur, scr, lane);
                asm volatile("s_waitcnt lgkmcnt(0)" ::: "memory");
                cur = nxt; it = itn;
            }
        }
#undef P0_DECODE
        {
            f32x4 gv[8], va[8], vb[8];
            { const f32x4* gr = (const f32x4*)a.in[2] + lane;
#pragma unroll
              for (int j = 0; j < 8; ++j) gv[j] = gr[64 * j]; }
            int m = gw;
            if (m < NTOK) rms_load(x + (size_t)m * DM, va, lane);
            for (; m < NTOK; m += 2 * NGW) {
                const int m1 = m + NGW, m2 = m + 2 * NGW;
                if (m1 < NTOK) rms_load(x + (size_t)m1 * DM, vb, lane);
                rms_finish(va, gv, XN + (size_t)m * DM, lane);
                if (m2 < NTOK) rms_load(x + (size_t)m2 * DM, va, lane);
                if (m1 < NTOK) rms_finish(vb, gv, XN + (size_t)m1 * DM, lane);
            }
        }
        for (int i = gt; i < NTOK * PLE / 8; i += NGT) { const f32x4 v0 = __builtin_nontemporal_load(&((const f32x4*)a.in[1])[2 * i]), v1 = __builtin_nontemporal_load(&((const f32x4*)a.in[1])[2 * i + 1]);
            u32x4 w; w.x = cvt_pk(v0[0], v0[1]); w.y = cvt_pk(v0[2], v0[3]); w.z = cvt_pk(v1[0], v1[1]); w.w = cvt_pk(v1[2], v1[3]); ((u32x4*)PB)[i] = w; }
    }
    xcd_barrier(xb);
    {
        { pg8::Gemm g{XN, WIN, NTOK, NPROJ, DM}; pg8::StaticOrder S; S.init(NTOK, NPROJ, G, bx); pg8::EpiProj E{PROJ, rope, KIMG};
          pg8::gemm_phase<pg8::EpiProj, pg8::StaticOrder, true, true>(lds, g, S, E); }
        __syncthreads();
        { pg8::Gemm g{WIN + (size_t)NPROJ * DM, XN, 2048, NTOK, DM}; pg8::StaticOrder S; S.init(2048, NTOK, G, bx); pg8::EpiVt E{VT};
          pg8::gemm_phase<pg8::EpiVt, pg8::StaticOrder, true, true>(lds, g, S, E); }
    }
    xcd_barrier(xb);
    {
        const float lam = lamp[0];
        for (int su = vcu; su < 256; su += G) {
            const int grp = su >> 4, j = su & 15;
#pragma unroll 1
            for (int k = 0; k < 4; ++k) { const int bh = 4 * grp + k; const int qb = (k & 1) ? 15 - j : j;
                att::attn_unit_df(lds, PROJ, KIMG, VT, MIXED, bh >> 3, bh & 7, qb, lam, a.in[8]); }
        }
#pragma unroll 1
        for (int u = vcu; u < 512; u += G) att::attn_unit<0>(lds, PROJ, KIMG, VT, MIXED, (u >> 3) >> 3, (u >> 3) & 7, u & 7, lam, a.in[8]);
    }
    xcd_barrier(xb);
    {
        __syncthreads();
        { pg8::Gemm g{MIXED, WOUT, NTOK, DM, DM}; pg8::StaticOrder S; S.init(NTOK, DM, G, bx); pg8::EpiRes E{x, HB, ss2};
          pg8::gemm_phase<pg8::EpiRes, pg8::StaticOrder, true, true>(lds, g, S, E); }
        __syncthreads();
        { pg8::Gemm g{PB, WPROJ, NTOK, DM, PLE}; pg8::StaticOrder S; S.init(NTOK, DM, G, bx); pg8::EpiBf16 E{PLEB, DM};
          pg8::gemm_phase<pg8::EpiBf16, pg8::StaticOrder, true, true>(lds, g, S, E); }
    }
    xcd_barrier(xb);
    {
        pg8::Gemm g{HB, WGATE, NTOK, DM, DM}; pg8::StaticOrder S; S.init(NTOK, DM, G, bx); pg8::EpiGate E{HB, H2B, PLEB, ss2, ss3};
        pg8::gemm_phase<pg8::EpiGate, pg8::StaticOrder, true, true>(lds, g, S, E);
    }
    xcd_barrier(xb);
    {
        const int tid5 = opaque_tid(), lane = tid5 & 63, wave = __builtin_amdgcn_readfirstlane(tid5 >> 6);
        const int gw = bx * 8 + wave, NGW = G * 8; const f32x4* gr = (const f32x4*)a.in[13];
        f32x4 gv[8];
#pragma unroll
        for (int j = 0; j < 4; ++j) { gv[2 * j] = gr[2 * (lane + 64 * j)]; gv[2 * j + 1] = gr[2 * (lane + 64 * j) + 1]; }
#define P5_LOAD(H, S_, m_) do { const u32x4* hrow_ = (const u32x4*)(H2B + (size_t)(m_) * DM); S_ = ss3[m_]; _Pragma("unroll") for (int j_ = 0; j_ < 4; ++j_) H[j_] = __builtin_nontemporal_load(&hrow_[lane + 64 * j_]); } while (0)
#define P5_STORE(H, S_, m_) do { const float rstd_ = rsqrtf(S_ * (1.f / DM) + NORM_EPS); f32x4* orow_ = (f32x4*)(out + (size_t)(m_) * DM); \
            _Pragma("unroll") for (int j_ = 0; j_ < 4; ++j_) { const int c_ = lane + 64 * j_; const u32x4 hw_ = H[j_]; const f32x4 g0_ = gv[2 * j_], g1_ = gv[2 * j_ + 1]; \
                orow_[2 * c_] = (f32x4){bf_lo(hw_.x) * rstd_ * g0_[0], bf_hi(hw_.x) * rstd_ * g0_[1], bf_lo(hw_.y) * rstd_ * g0_[2], bf_hi(hw_.y) * rstd_ * g0_[3]}; \
                orow_[2 * c_ + 1] = (f32x4){bf_lo(hw_.z) * rstd_ * g1_[0], bf_hi(hw_.z) * rstd_ * g1_[1], bf_lo(hw_.w) * rstd_ * g1_[2], bf_hi(hw_.w) * rstd_ * g1_[3]}; } } while (0)
        u32x4 ha[4], hb4[4]; float sa = 0.f, sb = 0.f;
        int m = gw;
        if (m < NTOK) P5_LOAD(ha, sa, m);
        for (; m < NTOK; m += 2 * NGW) {
            const int m1 = m + NGW, m2 = m + 2 * NGW;
            if (m1 < NTOK) P5_LOAD(hb4, sb, m1);
            P5_STORE(ha, sa, m);
            if (m2 < NTOK) P5_LOAD(ha, sa, m2);
            if (m1 < NTOK) P5_STORE(hb4, sb, m1);
        }
#undef P5_LOAD
#undef P5_STORE
    }
}

extern "C" void kernel_launch(void* const* d_in, const int* in_sizes, int n_in, void* d_out, int out_size, void* d_ws, size_t ws_size, hipStream_t stream) {
    static int grid = 0;
    if (grid == 0) {
        if (n_in != 14 || out_size != NTOK * DM || ws_size < WS_END) { fprintf(stderr, "kernel_launch: unexpected shapes (n_in %d out %d ws %zu)\n", n_in, out_size, ws_size); grid = -1; return; }
        int dev = 0, cus = 0, per_cu = 0;
        (void)hipGetDevice(&dev); (void)hipDeviceGetAttribute(&cus, hipDeviceAttributeMultiprocessorCount, dev);
        (void)hipFuncSetAttribute((const void*)fwd_megakernel, hipFuncAttributeMaxDynamicSharedMemorySize, LDS_BYTES);
        (void)hipOccupancyMaxActiveBlocksPerMultiprocessor(&per_cu, (const void*)fwd_megakernel, 512, LDS_BYTES);
        if (per_cu < 1) { fprintf(stderr, "kernel_launch: occupancy query says %d blocks/CU\n", per_cu); per_cu = 1; }
        grid = cus * per_cu;
    }
    if (grid < 0) return;
    Args a{};
    for (int i = 0; i < 14; ++i) a.in[i] = (const float*)d_in[i];
    a.out = (float*)d_out; a.ws = (unsigned char*)d_ws;
    (void)hipMemsetAsync((unsigned char*)d_ws + WS_CTL + CTL_BAR, 0, CTL_BAR_BYTES, stream);
    void* args[] = {&a};
    hipError_t e = hipLaunchCooperativeKernel((void*)fwd_megakernel, dim3(grid), dim3(512), args, LDS_BYTES, stream);
    if (e != hipSuccess) fprintf(stderr, "cooperative launch failed: %s (grid %d)\n", hipGetErrorString(e), grid);
}
```

```cpp
#include <hip/hip_runtime.h>
#include <hip/hip_cooperative_groups.h>
#include <cstdio>
#include <cstdint>
namespace cg = cooperative_groups;
__device__ __forceinline__ int opaque_tid() { int t = (int)threadIdx.x; asm volatile("" : "+v"(t)); return t; }
namespace pg8 {
#define PG8_LAS __attribute__((address_space(3)))
typedef unsigned short bf16_t;
typedef short bf16x8 __attribute__((ext_vector_type(8)));
typedef float f32x4 __attribute__((ext_vector_type(4)));
typedef unsigned u32x4 __attribute__((ext_vector_type(4)));
constexpr int BM = 256, BK = 64, HALF = 128, HTB = HALF * BK * 2  , STAGE_BYTES = 8 * HTB, NXCD = 8, WGM = 8;

__host__ __device__ __forceinline__ int lds_byte(int r, int c) { const int st = (r >> 4) * 2 + (c >> 5), rr = r & 15, cc = c & 31, ob = rr * 64 + cc * 2; return st * 1024 + (ob ^ (((ob >> 9) & 1) << 5)); }
__host__ __device__ __forceinline__ void stage_rc(int b, int& R, int& C) { const int st = b / 1024, sb = b % 1024, swz = sb ^ (((sb >> 9) & 1) << 5); R = (st >> 1) * 16 + swz / 64; C = (st & 1) * 32 + (swz % 64) / 2; }
__host__ __device__ __forceinline__ int perm32(int rho) { const int n = rho >> 4, i = rho & 15; return 8 * (i >> 2) + 4 * n + (i & 3); }

struct Unit { int pm, pn; };
struct Gemm { const bf16_t* A; const bf16_t* Bt; int M, N, K; };

struct StaticOrder {
    int nM, nN, nwg, G, c;
    __host__ __device__ void init(int M, int N, int G_, int c_) { nM = M / BM; nN = N / BM; nwg = nM * nN; G = G_; c = c_; }
    __host__ __device__ bool next(int i, Unit& u) const {
        const long L = (long)i * G + c; if (L >= nwg) return false;
        int wgid = (int)L; { const int q = nwg / NXCD, r = nwg % NXCD, xcd = wgid % NXCD, off = wgid / NXCD; wgid = (xcd < r ? xcd * (q + 1) : r * (q + 1) + (xcd - r) * q) + off; }
        const int nig = WGM * nN, gid = wgid / nig, fm = gid * WGM, gsz = (nM - fm) < WGM ? (nM - fm) : WGM;
        u.pm = fm + ((wgid % nig) % gsz); u.pn = (wgid % nig) / gsz; return true;
    }
    __device__ __forceinline__ void a_ready(const Unit&) const {}
    __device__ __forceinline__ void done(const Unit&) const {}
};

__device__ __forceinline__ unsigned cvt_pk_bf16(float lo, float hi) { unsigned r; asm volatile("v_cvt_pk_bf16_f32 %0, %1, %2" : "=v"(r) : "v"(lo), "v"(hi)); return r; }
typedef float f32x2 __attribute__((ext_vector_type(2)));
template <class Epi, class Sched, bool ALIGN_EPI = false, bool SP2 = false>
__device__ __forceinline__ void gemm_phase(PG8_LAS unsigned char* lds, const Gemm g, const Sched& S, const Epi& E) {
    const int tid = opaque_tid(), wid = __builtin_amdgcn_readfirstlane(tid >> 6), lane = tid & 63, wr = wid >> 2, wc = wid & 3, fr = lane & 15, fq = lane >> 4;
    const int K = g.K, nt = K / BK;
    unsigned voffA[2], voffB[2];
#pragma unroll
    for (int i = 0; i < 2; ++i) { int R, C; stage_rc(tid * 16 + i * 8192, R, C); const int Rb = Epi::PERM ? ((R & ~31) + perm32(R & 31)) : R;
        voffA[i] = (unsigned)(R * K + C) * 2u; voffB[i] = (unsigned)(Rb * K + C) * 2u; }
    const size_t kstep = (size_t)(BK * 2);
    const size_t hstep = (size_t)HALF * K * 2;
    const size_t tstep = 2 * hstep;
    const unsigned ldsw = (unsigned)wid * 1024u;
    const int aoff = lds_byte(wr * 64 + fr, fq * 8), boff = lds_byte(wc * 32 + fr, fq * 8);
#define PG8_SA(b, h) (((b) * 2 + (h)) * HTB)
#define PG8_SB(b, h) ((4 + (b) * 2 + (h)) * HTB)
#define PG8_STAGE(bufoff, gbase, voff) do { _Pragma("unroll") for (int _i = 0; _i < 2; ++_i) \
        __builtin_amdgcn_global_load_lds((const unsigned*)((const char*)(gbase) + (voff)[_i]), (PG8_LAS unsigned*)(lds + (bufoff) + ldsw + _i * 8192), 16, 0, 0); } while (0)
#define PG8_LDA(dst, b, h) do { _Pragma("unroll") for (int m = 0; m < 4; ++m) _Pragma("unroll") for (int k = 0; k < 2; ++k) dst[m][k] = *(const PG8_LAS bf16x8*)(lds + PG8_SA(b, h) + aoff + m * 2048 + k * 1024); } while (0)
#define PG8_LDB(dst, b, h) do { _Pragma("unroll") for (int n = 0; n < 2; ++n) _Pragma("unroll") for (int k = 0; k < 2; ++k) dst[n][k] = *(const PG8_LAS bf16x8*)(lds + PG8_SB(b, h) + boff + n * 2048 + k * 1024); } while (0)
#define PG8_MMA(ai, bj, At, Bt) do { __builtin_amdgcn_s_setprio(1); _Pragma("unroll") for (int m = 0; m < 4; ++m) _Pragma("unroll") for (int n = 0; n < 2; ++n) _Pragma("unroll") for (int k = 0; k < 2; ++k) \
        acc[ai][bj][m][n] = __builtin_amdgcn_mfma_f32_16x16x32_bf16(Bt[n][k], At[m][k], acc[ai][bj][m][n], 0, 0, 0); __builtin_amdgcn_s_setprio(0); } while (0)
#define PG8_WAIT_V(n) asm volatile("s_waitcnt vmcnt(" #n ")" ::: "memory")
#define PG8_WAIT_L(n) asm volatile("s_waitcnt lgkmcnt(" #n ")" ::: "memory")
#define PG8_BAR __builtin_amdgcn_s_barrier()
#define PG8_SCHED __builtin_amdgcn_sched_barrier(0)
    Unit cur, nxt; int ui = 0;
    if (!S.next(0, cur)) return;
    f32x4 acc[2][2][4][2];
#pragma unroll
    for (int a = 0; a < 2; ++a)
#pragma unroll
        for (int b = 0; b < 2; ++b)
#pragma unroll
            for (int m = 0; m < 4; ++m)
#pragma unroll
                for (int n = 0; n < 2; ++n) acc[a][b][m][n] = (f32x4){0.f, 0.f, 0.f, 0.f};
    bf16x8 At[4][2], B0[2][2], B1[2][2];
    const char* cA = (const char*)g.A + (size_t)cur.pm * tstep; const char* cB = (const char*)g.Bt + (size_t)cur.pn * tstep;
    S.a_ready(cur);
    if constexpr (SP2) {
        PG8_STAGE(PG8_SB(0, 0), cB, voffB); PG8_STAGE(PG8_SB(0, 1), cB + hstep, voffB); PG8_STAGE(PG8_SA(0, 0), cA, voffA); PG8_STAGE(PG8_SA(0, 1), cA + hstep, voffA);
        if (wr == 1) PG8_BAR;
        PG8_WAIT_V(2); PG8_BAR;
        PG8_STAGE(PG8_SB(1, 0), cB + kstep, voffB); PG8_STAGE(PG8_SA(1, 0), cA + kstep, voffA); PG8_STAGE(PG8_SB(1, 1), cB + hstep + kstep, voffB);
        PG8_WAIT_V(6); PG8_BAR;
    } else {
        PG8_STAGE(PG8_SB(0, 0), cB, voffB); PG8_STAGE(PG8_SA(0, 0), cA, voffA); PG8_STAGE(PG8_SB(0, 1), cB + hstep, voffB); PG8_STAGE(PG8_SA(0, 1), cA + hstep, voffA);
        if (wr == 1) PG8_BAR;
        PG8_WAIT_V(4); PG8_BAR;
        PG8_STAGE(PG8_SB(1, 0), cB + kstep, voffB); PG8_STAGE(PG8_SA(1, 0), cA + kstep, voffA); PG8_STAGE(PG8_SB(1, 1), cB + hstep + kstep, voffB);
        PG8_WAIT_V(6); PG8_BAR;
    }
    for (;;) {
        const bool has_next = S.next(ui + 1, nxt);
        const char* nA = has_next ? (const char*)g.A + (size_t)nxt.pm * tstep : cA; const char* nB = has_next ? (const char*)g.Bt + (size_t)nxt.pn * tstep : cB;
        for (int t = 0; t < nt; t += 2) {
            const bool last = (t == nt - 2);
            const char* a1 = cA + (size_t)(t + 1) * kstep;
            const char* a2 = last ? nA : cA + (size_t)(t + 2) * kstep; const char* b2 = last ? nB : cB + (size_t)(t + 2) * kstep;
            const char* a3 = a2 + kstep; const char* b3 = b2 + kstep;
            if (last && has_next) S.a_ready(nxt);
            if constexpr (SP2) {
            PG8_LDB(B0, 0, 0); PG8_LDB(B1, 0, 1); PG8_SCHED; PG8_LDA(At, 0, 0); PG8_STAGE(PG8_SA(1, 1), a1 + hstep, voffA);
            PG8_WAIT_V(8); PG8_WAIT_L(0); PG8_BAR; PG8_MMA(0, 0, At, B0); PG8_MMA(0, 1, At, B1); PG8_BAR; PG8_SCHED;
            PG8_LDA(At, 0, 1); PG8_STAGE(PG8_SB(0, 0), b2, voffB); PG8_STAGE(PG8_SB(0, 1), b2 + hstep, voffB); PG8_STAGE(PG8_SA(0, 0), a2, voffA);
            PG8_WAIT_V(8); PG8_WAIT_L(0); PG8_BAR; PG8_MMA(1, 0, At, B0); PG8_MMA(1, 1, At, B1); PG8_BAR; PG8_SCHED;
            PG8_LDB(B0, 1, 0); PG8_LDB(B1, 1, 1); PG8_SCHED; PG8_LDA(At, 1, 0); PG8_STAGE(PG8_SA(0, 1), a2 + hstep, voffA);
            PG8_WAIT_V(8); PG8_WAIT_L(0); PG8_BAR; PG8_MMA(0, 0, At, B0); PG8_MMA(0, 1, At, B1); PG8_BAR; PG8_SCHED;
            PG8_LDA(At, 1, 1); PG8_STAGE(PG8_SB(1, 0), b3, voffB); PG8_STAGE(PG8_SB(1, 1), b3 + hstep, voffB); PG8_STAGE(PG8_SA(1, 0), a3, voffA);
            PG8_WAIT_V(8); PG8_WAIT_L(0); PG8_BAR; PG8_MMA(1, 0, At, B0); PG8_MMA(1, 1, At, B1); PG8_BAR; PG8_SCHED;
            } else {
            PG8_LDB(B0, 0, 0); PG8_SCHED; PG8_LDA(At, 0, 0); PG8_STAGE(PG8_SA(1, 1), a1 + hstep, voffA);
            PG8_WAIT_L(8); PG8_BAR; PG8_WAIT_L(0); PG8_MMA(0, 0, At, B0); PG8_BAR; PG8_SCHED;
            PG8_LDB(B1, 0, 1); PG8_STAGE(PG8_SB(0, 0), b2, voffB);
            PG8_BAR; PG8_WAIT_L(0); PG8_MMA(0, 1, At, B1); PG8_BAR;
            PG8_LDA(At, 0, 1); PG8_STAGE(PG8_SA(0, 0), a2, voffA);
            PG8_BAR; PG8_WAIT_L(0); PG8_MMA(1, 0, At, B0); PG8_BAR; PG8_SCHED;
            PG8_STAGE(PG8_SB(0, 1), b2 + hstep, voffB);
            PG8_WAIT_V(6); PG8_BAR; PG8_MMA(1, 1, At, B1); PG8_BAR;
            PG8_LDB(B0, 1, 0); PG8_SCHED; PG8_LDA(At, 1, 0); PG8_STAGE(PG8_SA(0, 1), a2 + hstep, voffA);
            PG8_WAIT_L(8); PG8_BAR; PG8_WAIT_L(0); PG8_MMA(0, 0, At, B0); PG8_BAR; PG8_SCHED;
            PG8_LDB(B1, 1, 1); PG8_STAGE(PG8_SB(1, 0), b3, voffB);
            PG8_BAR; PG8_WAIT_L(0); PG8_MMA(0, 1, At, B1); PG8_BAR;
            PG8_LDA(At, 1, 1); PG8_STAGE(PG8_SA(1, 0), a3, voffA);
            PG8_BAR; PG8_WAIT_L(0); PG8_MMA(1, 0, At, B0); PG8_BAR; PG8_SCHED;
            PG8_STAGE(PG8_SB(1, 1), b3 + hstep, voffB);
            PG8_WAIT_V(6); PG8_BAR; PG8_MMA(1, 1, At, B1); PG8_BAR;
            }
        }
        if constexpr (ALIGN_EPI) { if (wr == 0) PG8_BAR; }
        if constexpr (!Epi::AFTER_DRAIN) { E(acc, cur, wr, wc, fr, fq); S.done(cur); }
        if (!has_next) break;
#pragma unroll
        for (int a = 0; a < 2; ++a)
#pragma unroll
            for (int b = 0; b < 2; ++b)
#pragma unroll
                for (int m = 0; m < 4; ++m)
#pragma unroll
                    for (int n = 0; n < 2; ++n) acc[a][b][m][n] = (f32x4){0.f, 0.f, 0.f, 0.f};
        cur = nxt; cA = nA; cB = nB; ++ui;
        if constexpr (ALIGN_EPI) { if (wr == 1) PG8_BAR; }
    }
    PG8_WAIT_V(0);
    if constexpr (!ALIGN_EPI) { if (wr == 0) PG8_BAR; }
    PG8_BAR;
    if constexpr (Epi::AFTER_DRAIN) { E.fused(acc, cur, wr, wc, fr, fq, lds, wid, lane); S.done(cur); }
#undef PG8_SA
#undef PG8_SB
#undef PG8_STAGE
#undef PG8_LDA
#undef PG8_LDB
#undef PG8_MMA
#undef PG8_WAIT_V
#undef PG8_WAIT_L
#undef PG8_BAR
#undef PG8_SCHED
}
}
#define LAS __attribute__((address_space(3)))
typedef unsigned short bf16_t;
typedef short bf16x8 __attribute__((ext_vector_type(8)));
typedef float f32x4 __attribute__((ext_vector_type(4)));
typedef float f32x2 __attribute__((ext_vector_type(2)));
typedef float f32x16 __attribute__((ext_vector_type(16)));
typedef unsigned u32x4 __attribute__((ext_vector_type(4)));
typedef unsigned u32x2 __attribute__((ext_vector_type(2)));

constexpr int NTOK = 16384, DM = 2048, SEQ = 2048, NBATCH = 8, PLE = 256;
constexpr int NPROJ = 6144;
constexpr int PQ_SB = 0, PK_SB = 1024, PG_SB = 2048, PQ_DF = 3072, PK_DF = 4096, PG_DF = 5120;
constexpr float LOG2E = 1.4426950408889634f;
constexpr float SBQ_SCALE = 0.08838834764831845f * LOG2E;
constexpr float DFQ_SCALE = 0.125f * LOG2E;
constexpr float NORM_EPS = 1e-6f, SUBLN_EPS = 1e-5f;
constexpr float LAMBDA_INIT = 0.2f;

constexpr size_t MiB = 1u << 20;
constexpr size_t WS_CTL = 0;
constexpr size_t CTL_SS2 = 0, CTL_SS3 = 65536, CTL_LAM = 131072, CTL_ROPE = 262144, CTL_BAR = 524288, CTL_BAR_BYTES = 16384;
constexpr size_t WS_WIN = 2 * MiB, WS_WOUT = 34 * MiB, WS_WGATE = 42 * MiB, WS_WPROJ = 50 * MiB, WS_PB = 52 * MiB;
constexpr size_t WS_XN = 64 * MiB, WS_MIXED = 64 * MiB;
constexpr size_t WS_PROJ = 128 * MiB, WS_VT = 320 * MiB, WS_KIMG = 384 * MiB, WS_END = 448 * MiB;
constexpr size_t WS_HB = 128 * MiB, WS_PLE = 192 * MiB;
constexpr size_t WS_H2B = 64 * MiB;

constexpr int LDS_BYTES = 131072 + 1024;

typedef __bf16 bf16x2_t __attribute__((ext_vector_type(2)));
__device__ __forceinline__ unsigned cvt_pk(float lo, float hi) { f32x2 v = {lo, hi}; bf16x2_t b = __builtin_convertvector(v, bf16x2_t); return __builtin_bit_cast(unsigned, b); }
__device__ __forceinline__ float bf_lo(unsigned w) { return __uint_as_float(w << 16); }
__device__ __forceinline__ float bf_hi(unsigned w) { return __uint_as_float(w & 0xffff0000u); }
__device__ __forceinline__ float wave_sum(float v) {
#pragma unroll
    for (int o = 1; o < 64; o <<= 1) v += __shfl_xor(v, o);
    return v;
}
__device__ __forceinline__ float fast_exp2(float x) { return __builtin_amdgcn_exp2f(x); }
__device__ __forceinline__ float fast_log2(float x) { return __builtin_amdgcn_logf(x); }
__device__ __forceinline__ float silu_f(float x) { return x * __builtin_amdgcn_rcpf(1.f + fast_exp2(-x * LOG2E)); }
__device__ __forceinline__ float sigmoid_f(float x) { return __builtin_amdgcn_rcpf(1.f + fast_exp2(-x * LOG2E)); }

namespace pg8 {
struct EpiBf16 {
    static constexpr bool PERM = true, AFTER_DRAIN = false;
    bf16_t* O; int ldc;
    __device__ __forceinline__ void operator()(const f32x4 (&acc)[2][2][4][2], const Unit& u, int wr, int wc, int fr, int fq) const {
        const int row0 = u.pm * BM + wr * 64 + fr; const int col0 = u.pn * BM + wc * 32 + 8 * fq;
#pragma unroll
        for (int ai = 0; ai < 2; ++ai)
#pragma unroll
            for (int m = 0; m < 4; ++m) { bf16_t* rowp = O + (size_t)(row0 + ai * HALF + m * 16) * ldc + col0;
#pragma unroll
                for (int bj = 0; bj < 2; ++bj) { const f32x4 v0 = acc[ai][bj][m][0], v1 = acc[ai][bj][m][1];
                    u32x4 w; w.x = cvt_pk_bf16(v0[0], v0[1]); w.y = cvt_pk_bf16(v0[2], v0[3]); w.z = cvt_pk_bf16(v1[0], v1[1]); w.w = cvt_pk_bf16(v1[2], v1[3]);
                    *(u32x4*)(rowp + bj * HALF) = w; } }
    }
};
struct EpiProj {
    static constexpr bool PERM = true, AFTER_DRAIN = false;
    bf16_t* O; const float* rope; bf16_t* KI;
    __device__ __forceinline__ void operator()(const f32x4 (&acc)[2][2][4][2], const Unit& u, int wr, int wc, int fr, int fq) const {
        const int row0 = u.pm * BM + wr * 64 + fr; const int col0 = u.pn * BM + wc * 32 + 8 * fq;
        const int kind = u.pn >> 2;
        const bool dorope = (kind == 3 || kind == 4) && ((wc & 1) == 0) && (fq < 2);
        const float sc = kind == 0 ? SBQ_SCALE : (kind == 3 ? DFQ_SCALE : 1.f);
        const bool dosilu = (kind == 2 || kind == 5);
#pragma unroll
        for (int ai = 0; ai < 2; ++ai)
#pragma unroll
            for (int m = 0; m < 4; ++m) { const int row = row0 + ai * HALF + m * 16; bf16_t* rowp = O + (size_t)row * NPROJ + col0;
                if (kind == 1 || kind == 4) {
                    const int cw = col0 & 1023; rowp = KI + ((size_t)(((kind == 4 ? 8 : 0) + (row >> 11)) * 8 + (cw >> 7)) * SEQ + (row & (SEQ - 1))) * 128 + (cw & 127); }
                f32x4 cs0 = {1.f, 0.f, 1.f, 0.f}, cs1 = {1.f, 0.f, 1.f, 0.f};
                if (dorope) { const f32x4* rp = (const f32x4*)(rope + ((size_t)(row & (SEQ - 1)) * 8 + 4 * fq) * 2); cs0 = rp[0]; cs1 = rp[1]; }
#pragma unroll
                for (int bj = 0; bj < 2; ++bj) { f32x4 v0 = acc[ai][bj][m][0], v1 = acc[ai][bj][m][1];
                    if (dorope) {
                        f32x4 a, b;
                        a[0] = v0[0] * cs0[0] - v0[1] * cs0[1]; a[1] = v0[1] * cs0[0] + v0[0] * cs0[1];
                        a[2] = v0[2] * cs0[2] - v0[3] * cs0[3]; a[3] = v0[3] * cs0[2] + v0[2] * cs0[3];
                        b[0] = v1[0] * cs1[0] - v1[1] * cs1[1]; b[1] = v1[1] * cs1[0] + v1[0] * cs1[1];
                        b[2] = v1[2] * cs1[2] - v1[3] * cs1[3]; b[3] = v1[3] * cs1[2] + v1[2] * cs1[3];
                        v0 = a; v1 = b; }
                    if (dosilu) {
#pragma unroll
                        for (int j = 0; j < 4; ++j) { v0[j] = silu_f(v0[j]); v1[j] = silu_f(v1[j]); } }
                    v0 = v0 * sc; v1 = v1 * sc;
                    u32x4 w; w.x = cvt_pk_bf16(v0[0], v0[1]); w.y = cvt_pk_bf16(v0[2], v0[3]); w.z = cvt_pk_bf16(v1[0], v1[1]); w.w = cvt_pk_bf16(v1[2], v1[3]);
                    *(u32x4*)(rowp + ((kind == 1 || kind == 4) ? bj * SEQ * 128 : bj * HALF)) = w; } }
    }
};
struct EpiVt {
    static constexpr bool PERM = true, AFTER_DRAIN = false;
    bf16_t* O;
    __device__ __forceinline__ void operator()(const f32x4 (&acc)[2][2][4][2], const Unit& u, int wr, int wc, int fr, int fq) const {
        const int row0 = u.pm * BM + wr * 64 + fr; const int col0 = u.pn * BM + wc * 32 + 8 * fq;
        const int p0 = (fq & 1) ? 4 : 0, p1 = (fq & 1) ? 12 : 8;
#pragma unroll
        for (int ai = 0; ai < 2; ++ai)
#pragma unroll
            for (int m = 0; m < 4; ++m) { const int row = row0 + ai * HALF + m * 16; const int gh = row >> 7, d = row & 127;
#pragma unroll
                for (int bj = 0; bj < 2; ++bj) { const int col = col0 + bj * HALF; const int b = col >> 11, sq = col & (SEQ - 1);
                    bf16_t* tp = O + ((size_t)((((gh >> 3) * 8 + b) * 8 + (gh & 7)) * 32 + (sq >> 6)) * 128 + d) * 64 + (sq & 48);
                    const f32x4 v0 = acc[ai][bj][m][0], v1 = acc[ai][bj][m][1];
                    u32x2 w0, w1; w0.x = cvt_pk_bf16(v0[0], v0[1]); w0.y = cvt_pk_bf16(v0[2], v0[3]); w1.x = cvt_pk_bf16(v1[0], v1[1]); w1.y = cvt_pk_bf16(v1[2], v1[3]);
                    *(u32x2*)(tp + p0) = w0; *(u32x2*)(tp + p1) = w1; } }
    }
};
struct EpiRes {
    static constexpr bool PERM = true, AFTER_DRAIN = false;
    const float* x; bf16_t* hb; float* ss;
    __device__ __forceinline__ void operator()(const f32x4 (&acc)[2][2][4][2], const Unit& u, int wr, int wc, int fr, int fq) const {
        const int row0 = u.pm * BM + wr * 64 + fr; const int col0 = u.pn * BM + wc * 32 + 8 * fq;
#pragma unroll
        for (int ai = 0; ai < 2; ++ai)
#pragma unroll
            for (int m = 0; m < 4; ++m) { const int row = row0 + ai * HALF + m * 16; const size_t off = (size_t)row * DM + col0; float q = 0.f;
#pragma unroll
                for (int bj = 0; bj < 2; ++bj) { const size_t o2 = off + bj * HALF;
                    const f32x4 h0 = __builtin_nontemporal_load((const f32x4*)(x + o2)) + acc[ai][bj][m][0], h1 = __builtin_nontemporal_load((const f32x4*)(x + o2 + 4)) + acc[ai][bj][m][1];
                    u32x4 w; w.x = cvt_pk_bf16(h0[0], h0[1]); w.y = cvt_pk_bf16(h0[2], h0[3]); w.z = cvt_pk_bf16(h1[0], h1[1]); w.w = cvt_pk_bf16(h1[2], h1[3]);
                    *(u32x4*)(hb + o2) = w;
                    q += ((h0[0] * h0[0] + h0[1] * h0[1]) + (h0[2] * h0[2] + h0[3] * h0[3])) + ((h1[0] * h1[0] + h1[1] * h1[1]) + (h1[2] * h1[2] + h1[3] * h1[3])); }
                q += __shfl_xor(q, 16); q += __shfl_xor(q, 32);
                if (fq == 0) atomicAdd(ss + row, q); }
    }
};
struct EpiGate {
    static constexpr bool PERM = true, AFTER_DRAIN = false;
    const bf16_t* hb; bf16_t* h2b; const bf16_t* ple; const float* ss2; float* ss3;
    __device__ __forceinline__ void operator()(const f32x4 (&acc)[2][2][4][2], const Unit& u, int wr, int wc, int fr, int fq) const {
        const int row0 = u.pm * BM + wr * 64 + fr; const int col0 = u.pn * BM + wc * 32 + 8 * fq;
#pragma unroll
        for (int ai = 0; ai < 2; ++ai)
#pragma unroll
            for (int m = 0; m < 4; ++m) { const int row = row0 + ai * HALF + m * 16; const size_t off = (size_t)row * DM + col0; float q = 0.f;
                const float rstd = rsqrtf(ss2[row] * (1.f / DM) + NORM_EPS);
#pragma unroll
                for (int bj = 0; bj < 2; ++bj) { const size_t o2 = off + bj * HALF; const u32x4 hw = *(const u32x4*)(hb + o2); const u32x4 pw = *(const u32x4*)(ple + o2);
                    const f32x4 a0 = acc[ai][bj][m][0] * rstd, a1 = acc[ai][bj][m][1] * rstd; f32x4 g0, g1;
                    g0[0] = bf_lo(hw.x) + sigmoid_f(a0[0]) * bf_lo(pw.x); g0[1] = bf_hi(hw.x) + sigmoid_f(a0[1]) * bf_hi(pw.x);
                    g0[2] = bf_lo(hw.y) + sigmoid_f(a0[2]) * bf_lo(pw.y); g0[3] = bf_hi(hw.y) + sigmoid_f(a0[3]) * bf_hi(pw.y);
                    g1[0] = bf_lo(hw.z) + sigmoid_f(a1[0]) * bf_lo(pw.z); g1[1] = bf_hi(hw.z) + sigmoid_f(a1[1]) * bf_hi(pw.z);
                    g1[2] = bf_lo(hw.w) + sigmoid_f(a1[2]) * bf_lo(pw.w); g1[3] = bf_hi(hw.w) + sigmoid_f(a1[3]) * bf_hi(pw.w);
                    u32x4 w2; w2.x = cvt_pk_bf16(g0[0], g0[1]); w2.y = cvt_pk_bf16(g0[2], g0[3]); w2.z = cvt_pk_bf16(g1[0], g1[1]); w2.w = cvt_pk_bf16(g1[2], g1[3]);
                    *(u32x4*)(h2b + o2) = w2;
                    q += ((g0[0] * g0[0] + g0[1] * g0[1]) + (g0[2] * g0[2] + g0[3] * g0[3])) + ((g1[0] * g1[0] + g1[1] * g1[1]) + (g1[2] * g1[2] + g1[3] * g1[3])); }
                q += __shfl_xor(q, 16); q += __shfl_xor(q, 32);
                if (fq == 0) atomicAdd(ss3 + row, q); }
    }
};
}
namespace att {
constexpr int KP = 272, VP = 144, KT_BYTES = 64 * KP, VT_BYTES = 128 * VP, BUF_BYTES = KT_BYTES + VT_BYTES;
constexpr int FLAG_OFF = 2 * BUF_BYTES;
constexpr int XP = 132;
constexpr float R_DONE = 152.0f;

template <bool MASK>
__device__ __forceinline__ void sb_block(const f32x16& sv, int kbase, int tq, int h, float& R, bf16x8 (&pf)[2]) {
    f32x2 z[8], c[8];
#pragma unroll
    for (int p = 0; p < 8; ++p) {
        const int i = 2 * p;
        z[p].x = (!MASK || (kbase + 8 * (i >> 2) + (i & 3) < tq)) ? sv[i] : -1e30f;
        z[p].y = (!MASK || (kbase + 8 * ((i + 1) >> 2) + ((i + 1) & 3) < tq)) ? sv[i + 1] : -1e30f;
        f32x2 e; e.x = fast_exp2(-fabsf(z[p].x)); e.y = fast_exp2(-fabsf(z[p].y));
        e = e + 1.0f;
        f32x2 l; l.x = fast_log2(e.x); l.y = fast_log2(e.y);
        f32x2 m; m.x = fmaxf(z[p].x, 0.f); m.y = fmaxf(z[p].y, 0.f);
        c[p] = m + l;
    }
    float T[4], OT[4], pr[4], suf[4];
#pragma unroll
    for (int g = 0; g < 4; ++g) {
        const f32x2 lo = c[2 * g], hi = c[2 * g + 1];
        const f32x2 a = (f32x2){hi.x, lo.x} + (f32x2){hi.y, lo.y};
        const f32x2 b2 = (f32x2){lo.y, a.y} + (f32x2){a.x, a.x};
        c[2 * g] = (f32x2){b2.y, b2.x}; c[2 * g + 1] = (f32x2){a.x, hi.y};
        T[g] = b2.y;
    }
#pragma unroll
    for (int g = 0; g < 4; ++g) { OT[g] = __shfl_xor(T[g], 32); pr[g] = T[g] + OT[g]; }
    suf[3] = 0.f; suf[2] = pr[3]; suf[1] = suf[2] + pr[2]; suf[0] = suf[1] + pr[1];
    f32x2 w[8];
#pragma unroll
    for (int g = 0; g < 4; ++g) { const float off = R + suf[g] + (h == 0 ? OT[g] : 0.f);
#pragma unroll
        for (int q = 0; q < 2; ++q) { const int p = 2 * g + q; const f32x2 d = z[p] - (c[p] + off); w[p].x = fast_exp2(d.x); w[p].y = fast_exp2(d.y); } }
    R += suf[0] + pr[0];
#pragma unroll
    for (int sp = 0; sp < 2; ++sp) { u32x4 p; p.x = cvt_pk(w[4 * sp].x, w[4 * sp].y); p.y = cvt_pk(w[4 * sp + 1].x, w[4 * sp + 1].y); p.z = cvt_pk(w[4 * sp + 2].x, w[4 * sp + 2].y); p.w = cvt_pk(w[4 * sp + 3].x, w[4 * sp + 3].y);
        pf[sp] = __builtin_bit_cast(bf16x8, p); }
}

template <int MODE>
__device__ __forceinline__ void attn_unit(LAS unsigned char* lds, const bf16_t* __restrict__ PROJ, const bf16_t* __restrict__ KIMG, const bf16_t* __restrict__ VT, bf16_t* __restrict__ MIXED,
                                          int b, int hh, int qblk, float lam, const float* __restrict__ subln_g) {
    constexpr int QB = MODE == 0 ? 256 : 128;
    constexpr int NKS = MODE == 0 ? 8 : 4;
    const int tid = opaque_tid(), lane = tid & 63, r = lane & 31, h = lane >> 5;
    const int wid = __builtin_amdgcn_readfirstlane(tid >> 6);
    const int qg = MODE == 0 ? wid : (wid & 3), role = MODE == 0 ? 0 : (wid >> 2);
    const int Q0 = qblk * QB, q0w = Q0 + 32 * qg, tq = q0w + r;
    const size_t tokbase = (size_t)b * SEQ;
    const int gbh = ((MODE == 0 ? 0 : 8) + b) * 8 + hh;
    const bf16_t* Kg = KIMG + (size_t)gbh * SEQ * 128;
    const bf16_t* Vg = VT + (size_t)gbh * 32 * 8192;
    bf16x8 qf[NKS];
    { const bf16_t* qp = PROJ + (tokbase + tq) * NPROJ + (MODE == 0 ? PQ_SB + hh * 128 : PQ_DF + hh * 128 + role * 64) + 8 * h;
#pragma unroll
      for (int ks = 0; ks < NKS; ++ks) qf[ks] = *(const bf16x8*)(qp + 16 * ks); }
    f32x16 o[4];
#pragma unroll
    for (int d = 0; d < 4; ++d)
#pragma unroll
        for (int i = 0; i < 16; ++i) o[d][i] = 0.f;
    float R = 0.f, m_run = -1e30f, l_run = 0.f;
    const int kr0 = tid >> 4, kc = tid & 15, vr0 = tid >> 3, vc = tid & 7;
    const int kst = kr0 * KP + kc * 16, vst = KT_BYTES + vr0 * VP + vc * 16;
    const bf16_t* kgl = Kg + tid * 8;
    const bf16_t* vgl = Vg + tid * 8;
    u32x4 kreg[2], vreg[2];
#define ATT_LOAD(t) do { _Pragma("unroll") for (int i_ = 0; i_ < 2; ++i_) { \
        kreg[i_] = *(const u32x4*)(kgl + (size_t)(t) * 8192 + i_ * 4096); \
        vreg[i_] = *(const u32x4*)(vgl + (size_t)(t) * 8192 + i_ * 4096); } } while (0)
#define ATT_STORE(bo) do { _Pragma("unroll") for (int i_ = 0; i_ < 2; ++i_) { \
        *(LAS u32x4*)(lds + (bo) + kst + i_ * 32 * KP) = kreg[i_]; \
        *(LAS u32x4*)(lds + (bo) + vst + i_ * 64 * VP) = vreg[i_]; } } while (0)
    const int tl = (Q0 + QB - 1) >> 6;
    const int kfrag = r * KP + (role * 64 + 8 * h) * 2;
    const int vfrag = KT_BYTES + r * VP + (8 * h) * 2;
    volatile LAS int* flags = (volatile LAS int*)(lds + FLAG_OFF);
    __syncthreads();
    ATT_LOAD(tl); ATT_STORE(0);
    __syncthreads();
    int cur = 0, it = 0;
    bool wdone = false;
    for (int t = tl;; --t, ++it) {
        if (t > 0) ATT_LOAD(t - 1);
        const int k0 = 64 * t;
        const bool active = (MODE == 0) ? (!wdone && k0 <= q0w + 30) : (k0 <= q0w + 31);
        if (active) {
            const int bo = cur * BUF_BYTES;
            f32x16 s[2];
            bf16x8 vf[4][2][2];
            if (MODE == 1) {
                bf16x8 kf[2][NKS];
#pragma unroll
                for (int kb = 0; kb < 2; ++kb)
#pragma unroll
                    for (int ks = 0; ks < NKS; ++ks) kf[kb][ks] = *(const LAS bf16x8*)(lds + bo + kfrag + kb * 32 * KP + ks * 32);
                __builtin_amdgcn_sched_barrier(0);
#pragma unroll
                for (int kb = 0; kb < 2; ++kb) {
#pragma unroll
                    for (int i = 0; i < 16; ++i) s[kb][i] = 0.f;
#pragma unroll
                    for (int ks = 0; ks < NKS; ++ks) s[kb] = __builtin_amdgcn_mfma_f32_32x32x16_bf16(kf[kb][ks], qf[ks], s[kb], 0, 0, 0);
                }
                __builtin_amdgcn_sched_barrier(0);
#pragma unroll
                for (int d = 0; d < 2; ++d)
#pragma unroll
                    for (int kb = 0; kb < 2; ++kb)
#pragma unroll
                        for (int sp = 0; sp < 2; ++sp) vf[d][kb][sp] = *(const LAS bf16x8*)(lds + bo + vfrag + d * 32 * VP + (32 * kb + 16 * sp) * 2);
                __builtin_amdgcn_sched_barrier(0);
            } else {
#pragma unroll
                for (int kb = 0; kb < 2; ++kb) {
#pragma unroll
                    for (int i = 0; i < 16; ++i) s[kb][i] = 0.f;
#pragma unroll
                    for (int ks = 0; ks < NKS; ++ks) {
                        const bf16x8 a = *(const LAS bf16x8*)(lds + bo + kfrag + kb * 32 * KP + ks * 32);
                        s[kb] = __builtin_amdgcn_mfma_f32_32x32x16_bf16(a, qf[ks], s[kb], 0, 0, 0);
                    }
                }
            }
            bf16x8 pf[2][2];
            if (MODE == 0) {
                sb_block<true>(s[1], k0 + 32 + 4 * h, tq, h, R, pf[1]);
                if (__all(R >= R_DONE)) {
#pragma unroll
                    for (int sp = 0; sp < 2; ++sp)
#pragma unroll
                        for (int j = 0; j < 8; ++j) pf[0][sp][j] = 0;
                } else sb_block<true>(s[0], k0 + 4 * h, tq, h, R, pf[0]);
                wdone = __all(R >= R_DONE);
            } else {
                float mx = -1e30f;
                if (k0 + 63 > q0w) {
#pragma unroll
                    for (int kb = 0; kb < 2; ++kb) { const int kbase = k0 + 32 * kb + 4 * h;
#pragma unroll
                        for (int i = 0; i < 16; ++i) { const int key = kbase + 8 * (i >> 2) + (i & 3); const float v = (key <= tq) ? s[kb][i] : -1e30f; s[kb][i] = v; mx = fmaxf(mx, v); } }
                } else {
#pragma unroll
                    for (int kb = 0; kb < 2; ++kb)
#pragma unroll
                        for (int i = 0; i < 16; ++i) mx = fmaxf(mx, s[kb][i]);
                }
                mx = fmaxf(mx, __shfl_xor(mx, 32));
                const float m_new = fmaxf(m_run, mx), alpha = fast_exp2(m_run - m_new);
                m_run = m_new;
                float ls = 0.f;
#pragma unroll
                for (int kb = 0; kb < 2; ++kb) {
#pragma unroll
                    for (int i = 0; i < 16; ++i) { const float p = fast_exp2(s[kb][i] - m_new); s[kb][i] = p; ls += p; }
#pragma unroll
                    for (int sp = 0; sp < 2; ++sp) { u32x4 p; p.x = cvt_pk(s[kb][8 * sp], s[kb][8 * sp + 1]); p.y = cvt_pk(s[kb][8 * sp + 2], s[kb][8 * sp + 3]); p.z = cvt_pk(s[kb][8 * sp + 4], s[kb][8 * sp + 5]); p.w = cvt_pk(s[kb][8 * sp + 6], s[kb][8 * sp + 7]);
                        pf[kb][sp] = __builtin_bit_cast(bf16x8, p); }
                }
                l_run = l_run * alpha + ls;
                if (!__all(alpha == 1.f)) {
#pragma unroll
                    for (int d = 0; d < 4; ++d)
#pragma unroll
                        for (int i = 0; i < 16; ++i) o[d][i] *= alpha;
                }
            }
            if (MODE == 1) {
                __builtin_amdgcn_sched_barrier(0);
#pragma unroll
                for (int d = 2; d < 4; ++d)
#pragma unroll
                    for (int kb = 0; kb < 2; ++kb)
#pragma unroll
                        for (int sp = 0; sp < 2; ++sp) vf[d][kb][sp] = *(const LAS bf16x8*)(lds + bo + vfrag + d * 32 * VP + (32 * kb + 16 * sp) * 2);
                __builtin_amdgcn_sched_barrier(0);
            }
#pragma unroll
            for (int d = 0; d < 4; ++d)
#pragma unroll
                for (int kb = 0; kb < 2; ++kb)
#pragma unroll
                    for (int sp = 0; sp < 2; ++sp) {
                        const bf16x8 a = (MODE == 1) ? vf[d][kb][sp] : *(const LAS bf16x8*)(lds + bo + vfrag + d * 32 * VP + (32 * kb + 16 * sp) * 2);
                        o[d] = __builtin_amdgcn_mfma_f32_32x32x16_bf16(a, pf[kb][sp], o[d], 0, 0, 0);
                    }
        }
        if (t > 0) ATT_STORE((cur ^ 1) * BUF_BYTES);
        if (MODE == 0) { if (lane == 0) flags[(it & 1) * 8 + wid] = wdone ? 1 : 0; }
        __syncthreads();
        if (t == 0) break;
        if (MODE == 0) { int alld = 1;
#pragma unroll
            for (int w2 = 0; w2 < 8; ++w2) alld &= flags[(it & 1) * 8 + w2];
            if (alld) break; }
        cur ^= 1;
    }
#undef ATT_LOAD
#undef ATT_STORE
    const int erow = lane >> 4, ech = lane & 15;
    const size_t tok0 = tokbase + q0w;
    if (MODE == 0 || role == 0) {
    }
    u32x4 gw[8];
    if (MODE == 0 || role == 0) {
        const bf16_t* gp = PROJ + (tok0 + erow) * NPROJ + (MODE == 0 ? PG_SB : PG_DF) + hh * 128 + ech * 8;
#pragma unroll
        for (int i = 0; i < 8; ++i) gw[i] = *(const u32x4*)(gp + (size_t)(4 * i) * NPROJ);
    }
    LAS unsigned char* stg = lds + (MODE == 0 ? wid * 8704 : 69632 + qg * 8704);
    if (MODE == 0) {
#pragma unroll
        for (int d = 0; d < 4; ++d)
#pragma unroll
            for (int g = 0; g < 4; ++g) { u32x2 w; w.x = cvt_pk(o[d][4 * g], o[d][4 * g + 1]); w.y = cvt_pk(o[d][4 * g + 2], o[d][4 * g + 3]);
                *(LAS u32x2*)(stg + r * 272 + (32 * d + 8 * g + 4 * h) * 2) = w; }
    } else {
        const float lt = l_run + __shfl_xor(l_run, 32);
        const float inv = 1.f / lt;
        LAS float* xq = (LAS float*)lds + (qg * 32 + r) * XP + 4 * h;
        if (role == 1) {
            const float f = inv * lam;
#pragma unroll
            for (int d = 0; d < 4; ++d)
#pragma unroll
                for (int g = 0; g < 4; ++g) *(LAS f32x4*)(xq + 32 * d + 8 * g) = (f32x4){o[d][4 * g] * f, o[d][4 * g + 1] * f, o[d][4 * g + 2] * f, o[d][4 * g + 3] * f};
        }
        __syncthreads();
        if (role == 0) {
            float q = 0.f;
#pragma unroll
            for (int d = 0; d < 4; ++d)
#pragma unroll
                for (int g = 0; g < 4; ++g) { const f32x4 x2 = *(const LAS f32x4*)(xq + 32 * d + 8 * g);
#pragma unroll
                    for (int j = 0; j < 4; ++j) { const float v = o[d][4 * g + j] * inv - x2[j]; o[d][4 * g + j] = v; q += v * v; } }
            q += __shfl_xor(q, 32);
            const float rs = rsqrtf(q * (1.f / 128.f) + SUBLN_EPS) * (1.f - LAMBDA_INIT);
            const float* sg = subln_g + 4 * h;
#pragma unroll
            for (int d = 0; d < 4; ++d)
#pragma unroll
                for (int g = 0; g < 4; ++g) { const f32x4 sv = *(const f32x4*)(sg + 32 * d + 8 * g);
                    u32x2 w; w.x = cvt_pk(o[d][4 * g] * rs * sv[0], o[d][4 * g + 1] * rs * sv[1]); w.y = cvt_pk(o[d][4 * g + 2] * rs * sv[2], o[d][4 * g + 3] * rs * sv[3]);
                    *(LAS u32x2*)(stg + r * 272 + (32 * d + 8 * g + 4 * h) * 2) = w; }
        }
    }
    if (MODE == 0 || role == 0) {
        asm volatile("s_waitcnt lgkmcnt(0)" ::: "memory");
        bf16_t* op = MIXED + (tok0 + erow) * DM + (MODE == 0 ? 0 : 1024) + hh * 128 + ech * 8;
#pragma unroll
        for (int i = 0; i < 8; ++i) { const u32x4 ov = *(const LAS u32x4*)(stg + (4 * i + erow) * 272 + ech * 16); const u32x4 g4 = gw[i];
            u32x4 w; w.x = cvt_pk(bf_lo(ov.x) * bf_lo(g4.x), bf_hi(ov.x) * bf_hi(g4.x)); w.y = cvt_pk(bf_lo(ov.y) * bf_lo(g4.y), bf_hi(ov.y) * bf_hi(g4.y));
            w.z = cvt_pk(bf_lo(ov.z) * bf_lo(g4.z), bf_hi(ov.z) * bf_hi(g4.z)); w.w = cvt_pk(bf_lo(ov.w) * bf_lo(g4.w), bf_hi(ov.w) * bf_hi(g4.w));
            *(u32x4*)(op + (size_t)(4 * i) * DM) = w; }
    }
}

__device__ __forceinline__ void attn_unit_df(LAS unsigned char* lds, const bf16_t* __restrict__ PROJ, const bf16_t* __restrict__ KIMG, const bf16_t* __restrict__ VT, bf16_t* __restrict__ MIXED,
                                             int b, int hh, int qblk, float lam, const float* __restrict__ subln_g) {
    constexpr int VB0 = 2 * KT_BYTES;
    const int tid = opaque_tid(), lane = tid & 63, r = lane & 31, h = lane >> 5;
    const int wid = __builtin_amdgcn_readfirstlane(tid >> 6);
    const int qg = wid & 3, role = wid >> 2;
    const int Q0 = qblk * 128, q0w = Q0 + 32 * qg, tq = q0w + r;
    const size_t tokbase = (size_t)b * SEQ;
    const int gbh = (8 + b) * 8 + hh;
    const bf16_t* Kg = KIMG + (size_t)gbh * SEQ * 128;
    const bf16_t* Vg = VT + (size_t)gbh * 32 * 8192;
    bf16x8 qf[4];
    { const bf16_t* qp = PROJ + (tokbase + tq) * NPROJ + PQ_DF + hh * 128 + role * 64 + 8 * h;
#pragma unroll
      for (int ks = 0; ks < 4; ++ks) qf[ks] = *(const bf16x8*)(qp + 16 * ks); }
    f32x16 o[4];
#pragma unroll
    for (int d = 0; d < 4; ++d)
#pragma unroll
        for (int i = 0; i < 16; ++i) o[d][i] = 0.f;
    float m_run = -1e30f, l_run = 0.f, alpha = 1.f;
    f32x16 negm;
#pragma unroll
    for (int j = 0; j < 16; ++j) negm[j] = 0.f;
    const int kr0 = tid >> 4, kc = tid & 15, vr0 = tid >> 3, vc = tid & 7;
    const int kst = kr0 * KP + kc * 16, vst = vr0 * VP + vc * 16;
    const bf16_t* kgl = Kg + tid * 8;
    const bf16_t* vgl = Vg + tid * 8;
    u32x4 kreg[2], vreg[2];
#define DF_LOAD(t) do { _Pragma("unroll") for (int i_ = 0; i_ < 2; ++i_) { \
        kreg[i_] = *(const u32x4*)(kgl + (size_t)(t) * 8192 + i_ * 4096); \
        vreg[i_] = *(const u32x4*)(vgl + (size_t)(t) * 8192 + i_ * 4096); } } while (0)
#define DF_STORE(ko, vo) do { _Pragma("unroll") for (int i_ = 0; i_ < 2; ++i_) { \
        *(LAS u32x4*)(lds + (ko) + kst + i_ * 32 * KP) = kreg[i_]; \
        *(LAS u32x4*)(lds + (vo) + vst + i_ * 64 * VP) = vreg[i_]; } } while (0)
#define DF_VLOAD(vo) do { _Pragma("unroll") for (int d_ = 0; d_ < 4; ++d_) _Pragma("unroll") for (int kb_ = 0; kb_ < 2; ++kb_) _Pragma("unroll") for (int sp_ = 0; sp_ < 2; ++sp_) \
        vf[d_][kb_][sp_] = *(const LAS bf16x8*)(lds + (vo) + vfrag + d_ * 32 * VP + (32 * kb_ + 16 * sp_) * 2); } while (0)
#define DF_PV() do { _Pragma("unroll") for (int d_ = 0; d_ < 4; ++d_) _Pragma("unroll") for (int kb_ = 0; kb_ < 2; ++kb_) _Pragma("unroll") for (int sp_ = 0; sp_ < 2; ++sp_) \
        o[d_] = __builtin_amdgcn_mfma_f32_32x32x16_bf16(vf[d_][kb_][sp_], pf[kb_][sp_], o[d_], 0, 0, 0); } while (0)
#define DF_RESCALE() do { if (!__all(alpha == 1.f)) { _Pragma("unroll") for (int d_ = 0; d_ < 4; ++d_) _Pragma("unroll") for (int i_ = 0; i_ < 16; ++i_) o[d_][i_] *= alpha; } } while (0)
    const int tl = (Q0 + 127) >> 6, NT = tl + 1;
    const int kfrag = r * KP + (role * 64 + 8 * h) * 2;
    const int vfrag = r * VP + (8 * h) * 2;
    __syncthreads();
    DF_LOAD(tl); DF_STORE(0, VB0);
    __syncthreads();
    bool have_p = false;
    bf16x8 pf[2][2];
    for (int i = 0; i < NT; ++i) {
        const int t = tl - i, k0 = 64 * t;
        if (t > 0) DF_LOAD(t - 1);
        if (k0 <= q0w + 31) {
            const int ko = (i & 1) * KT_BYTES;
            bf16x8 kf[2][4];
#pragma unroll
            for (int kb = 0; kb < 2; ++kb)
#pragma unroll
                for (int ks = 0; ks < 4; ++ks) kf[kb][ks] = *(const LAS bf16x8*)(lds + ko + kfrag + kb * 32 * KP + ks * 32);
            f32x16 s[2];
            bf16x8 vf[2][2][2];
            const int vo = VB0 + ((i + 2) % 3) * VT_BYTES;
#define DF_VL(g) do { _Pragma("unroll") for (int kb_ = 0; kb_ < 2; ++kb_) _Pragma("unroll") for (int sp_ = 0; sp_ < 2; ++sp_) \
        vf[(g) & 1][kb_][sp_] = *(const LAS bf16x8*)(lds + vo + vfrag + (g) * 32 * VP + (32 * kb_ + 16 * sp_) * 2); } while (0)
            if (have_p) { DF_VL(0); }
            __builtin_amdgcn_sched_barrier(0);
#pragma unroll
            for (int kb = 0; kb < 2; ++kb) {
                s[kb] = __builtin_amdgcn_mfma_f32_32x32x16_bf16(kf[kb][0], qf[0], negm, 0, 0, 0);
#pragma unroll
                for (int ks = 1; ks < 4; ++ks) s[kb] = __builtin_amdgcn_mfma_f32_32x32x16_bf16(kf[kb][ks], qf[ks], s[kb], 0, 0, 0);
            }
            if (!have_p) {
                float mx = -1e30f;
#pragma unroll
                for (int kb = 0; kb < 2; ++kb) { const int kbase = k0 + 32 * kb + 4 * h;
#pragma unroll
                    for (int j = 0; j < 16; ++j) { const int key = kbase + 8 * (j >> 2) + (j & 3); const float v = (key <= tq) ? s[kb][j] : -1e30f; s[kb][j] = v; mx = fmaxf(mx, v); } }
                mx = fmaxf(mx, __shfl_xor(mx, 32));
                m_run = mx; alpha = 1.f;
                float ls = 0.f;
#pragma unroll
                for (int kb = 0; kb < 2; ++kb) {
#pragma unroll
                    for (int j = 0; j < 16; ++j) { const float p = fast_exp2(s[kb][j] - mx); s[kb][j] = p; ls += p; }
#pragma unroll
                    for (int sp = 0; sp < 2; ++sp) { u32x4 p; p.x = cvt_pk(s[kb][8 * sp], s[kb][8 * sp + 1]); p.y = cvt_pk(s[kb][8 * sp + 2], s[kb][8 * sp + 3]); p.z = cvt_pk(s[kb][8 * sp + 4], s[kb][8 * sp + 5]); p.w = cvt_pk(s[kb][8 * sp + 6], s[kb][8 * sp + 7]);
                        pf[kb][sp] = __builtin_bit_cast(bf16x8, p); }
                }
                l_run = ls;
#pragma unroll
                for (int j = 0; j < 16; ++j) negm[j] = -m_run;
                asm volatile("" : "+v"(negm));
                have_p = true;
            } else {
                DF_RESCALE();
                u32x4 pw[2][2];
                float mx = -1e30f; f32x2 ls2 = {0.f, 0.f};
#define DF_MF(k) o[(k) >> 2] = __builtin_amdgcn_mfma_f32_32x32x16_bf16(vf[((k) >> 2) & 1][((k) >> 1) & 1][(k) & 1], pf[((k) >> 1) & 1][(k) & 1], o[(k) >> 2], 0, 0, 0)
#define DF_S(e) s[(e) >> 4][(e) & 15]
                DF_VL(1);
                __builtin_amdgcn_sched_barrier(0);
                DF_MF(0);
                mx = fmaxf(fmaxf(mx, DF_S(0)), DF_S(1));
                mx = fmaxf(fmaxf(mx, DF_S(2)), DF_S(3));
                mx = fmaxf(fmaxf(mx, DF_S(4)), DF_S(5));
                mx = fmaxf(fmaxf(mx, DF_S(6)), DF_S(7));
                __builtin_amdgcn_sched_barrier(0);
                DF_MF(1);
                mx = fmaxf(fmaxf(mx, DF_S(8)), DF_S(9));
                mx = fmaxf(fmaxf(mx, DF_S(10)), DF_S(11));
                mx = fmaxf(fmaxf(mx, DF_S(12)), DF_S(13));
                mx = fmaxf(fmaxf(mx, DF_S(14)), DF_S(15));
                __builtin_amdgcn_sched_barrier(0);
                DF_MF(2);
                mx = fmaxf(fmaxf(mx, DF_S(16)), DF_S(17));
                mx = fmaxf(fmaxf(mx, DF_S(18)), DF_S(19));
                mx = fmaxf(fmaxf(mx, DF_S(20)), DF_S(21));
                mx = fmaxf(fmaxf(mx, DF_S(22)), DF_S(23));
                __builtin_amdgcn_sched_barrier(0);
                DF_MF(3);
                mx = fmaxf(fmaxf(mx, DF_S(24)), DF_S(25));
                mx = fmaxf(fmaxf(mx, DF_S(26)), DF_S(27));
                mx = fmaxf(fmaxf(mx, DF_S(28)), DF_S(29));
                mx = fmaxf(fmaxf(mx, DF_S(30)), DF_S(31));
                { auto rr = __builtin_amdgcn_permlane32_swap(__float_as_uint(mx), __float_as_uint(mx), false, false); mx = fmaxf(__uint_as_float(rr[0]), __uint_as_float(rr[1])); }
                alpha = 1.f;
                if (!__all(mx <= 8.f)) { const float dl = fmaxf(mx, 0.f); alpha = fast_exp2(-dl); m_run += dl;
#pragma unroll
                    for (int j = 0; j < 16; ++j) { s[0][j] -= dl; s[1][j] -= dl; negm[j] = -m_run; }
                    asm volatile("" : "+v"(negm)); }
                __builtin_amdgcn_sched_barrier(0);
                DF_VL(2);
                DF_MF(4);
                DF_S(0) = fast_exp2(DF_S(0));
                DF_S(1) = fast_exp2(DF_S(1));
                ls2 += (f32x2){DF_S(0), DF_S(1)}; pw[0][0][0] = cvt_pk(DF_S(0), DF_S(1));
                DF_S(2) = fast_exp2(DF_S(2));
                DF_S(3) = fast_exp2(DF_S(3));
                ls2 += (f32x2){DF_S(2), DF_S(3)}; pw[0][0][1] = cvt_pk(DF_S(2), DF_S(3));
                __builtin_amdgcn_sched_barrier(0);
                DF_MF(5);
                DF_S(4) = fast_exp2(DF_S(4));
                DF_S(5) = fast_exp2(DF_S(5));
                ls2 += (f32x2){DF_S(4), DF_S(5)}; pw[0][0][2] = cvt_pk(DF_S(4), DF_S(5));
                DF_S(6) = fast_exp2(DF_S(6));
                DF_S(7) = fast_exp2(DF_S(7));
                ls2 += (f32x2){DF_S(6), DF_S(7)}; pw[0][0][3] = cvt_pk(DF_S(6), DF_S(7));
                __builtin_amdgcn_sched_barrier(0);
                DF_MF(6);
                DF_S(8) = fast_exp2(DF_S(8));
                DF_S(9) = fast_exp2(DF_S(9));
                ls2 += (f32x2){DF_S(8), DF_S(9)}; pw[0][1][0] = cvt_pk(DF_S(8), DF_S(9));
                DF_S(10) = fast_exp2(DF_S(10));
                DF_S(11) = fast_exp2(DF_S(11));
                ls2 += (f32x2){DF_S(10), DF_S(11)}; pw[0][1][1] = cvt_pk(DF_S(10), DF_S(11));
                __builtin_amdgcn_sched_barrier(0);
                DF_MF(7);
                DF_S(12) = fast_exp2(DF_S(12));
                DF_S(13) = fast_exp2(DF_S(13));
                ls2 += (f32x2){DF_S(12), DF_S(13)}; pw[0][1][2] = cvt_pk(DF_S(12), DF_S(13));
                DF_S(14) = fast_exp2(DF_S(14));
                DF_S(15) = fast_exp2(DF_S(15));
                ls2 += (f32x2){DF_S(14), DF_S(15)}; pw[0][1][3] = cvt_pk(DF_S(14), DF_S(15));
                __builtin_amdgcn_sched_barrier(0);
                DF_VL(3);
                DF_MF(8);
                DF_S(16) = fast_exp2(DF_S(16));
                DF_S(17) = fast_exp2(DF_S(17));
                ls2 += (f32x2){DF_S(16), DF_S(17)}; pw[1][0][0] = cvt_pk(DF_S(16), DF_S(17));
                __builtin_amdgcn_sched_barrier(0);
                DF_MF(9);
                DF_S(18) = fast_exp2(DF_S(18));
                DF_S(19) = fast_exp2(DF_S(19));
                ls2 += (f32x2){DF_S(18), DF_S(19)}; pw[1][0][1] = cvt_pk(DF_S(18), DF_S(19));
                __builtin_amdgcn_sched_barrier(0);
                DF_MF(10);
                DF_S(20) = fast_exp2(DF_S(20));
                DF_S(21) = fast_exp2(DF_S(21));
                ls2 += (f32x2){DF_S(20), DF_S(21)}; pw[1][0][2] = cvt_pk(DF_S(20), DF_S(21));
                __builtin_amdgcn_sched_barrier(0);
                DF_MF(11);
                DF_S(22) = fast_exp2(DF_S(22));
                DF_S(23) = fast_exp2(DF_S(23));
                ls2 += (f32x2){DF_S(22), DF_S(23)}; pw[1][0][3] = cvt_pk(DF_S(22), DF_S(23));
                __builtin_amdgcn_sched_barrier(0);
                DF_MF(12);
                DF_S(24) = fast_exp2(DF_S(24));
                DF_S(25) = fast_exp2(DF_S(25));
                ls2 += (f32x2){DF_S(24), DF_S(25)}; pw[1][1][0] = cvt_pk(DF_S(24), DF_S(25));
                __builtin_amdgcn_sched_barrier(0);
                DF_MF(13);
                DF_S(26) = fast_exp2(DF_S(26));
                DF_S(27) = fast_exp2(DF_S(27));
                ls2 += (f32x2){DF_S(26), DF_S(27)}; pw[1][1][1] = cvt_pk(DF_S(26), DF_S(27));
                __builtin_amdgcn_sched_barrier(0);
                DF_MF(14);
                DF_S(28) = fast_exp2(DF_S(28));
                DF_S(29) = fast_exp2(DF_S(29));
                ls2 += (f32x2){DF_S(28), DF_S(29)}; pw[1][1][2] = cvt_pk(DF_S(28), DF_S(29));
                __builtin_amdgcn_sched_barrier(0);
                DF_MF(15);
                DF_S(30) = fast_exp2(DF_S(30));
                DF_S(31) = fast_exp2(DF_S(31));
                ls2 += (f32x2){DF_S(30), DF_S(31)}; pw[1][1][3] = cvt_pk(DF_S(30), DF_S(31));
                __builtin_amdgcn_sched_barrier(0);
                l_run = l_run * alpha + (ls2[0] + ls2[1]);
#pragma unroll
                for (int kb = 0; kb < 2; ++kb)
#pragma unroll
                    for (int sp = 0; sp < 2; ++sp) pf[kb][sp] = __builtin_bit_cast(bf16x8, pw[kb][sp]);
#undef DF_VL
#undef DF_MF
#undef DF_S
            }
        }
        if (t > 0) DF_STORE(((i + 1) & 1) * KT_BYTES, VB0 + ((i + 1) % 3) * VT_BYTES);
        __syncthreads();
    }
    if (have_p) {
        DF_RESCALE();
        bf16x8 vf[4][2][2];
        DF_VLOAD(VB0 + ((NT - 1) % 3) * VT_BYTES);
        DF_PV();
    }
    __syncthreads();
#undef DF_LOAD
#undef DF_STORE
#undef DF_VLOAD
#undef DF_PV
#undef DF_RESCALE
    const int erow = lane >> 4, ech = lane & 15;
    const size_t tok0 = tokbase + q0w;
    u32x4 gw[8];
    if (role == 0) {
        const bf16_t* gp = PROJ + (tok0 + erow) * NPROJ + PG_DF + hh * 128 + ech * 8;
#pragma unroll
        for (int i = 0; i < 8; ++i) gw[i] = *(const u32x4*)(gp + (size_t)(4 * i) * NPROJ);
    }
    LAS unsigned char* stg = lds + 69632 + qg * 8704;
    {
        const float lt = l_run + __shfl_xor(l_run, 32);
        const float inv = 1.f / lt;
        LAS float* xq = (LAS float*)lds + (qg * 32 + r) * XP + 4 * h;
        if (role == 1) {
            const float f = inv * lam;
#pragma unroll
            for (int d = 0; d < 4; ++d)
#pragma unroll
                for (int g = 0; g < 4; ++g) *(LAS f32x4*)(xq + 32 * d + 8 * g) = (f32x4){o[d][4 * g] * f, o[d][4 * g + 1] * f, o[d][4 * g + 2] * f, o[d][4 * g + 3] * f};
        }
        __syncthreads();
        if (role == 0) {
            float q = 0.f;
#pragma unroll
            for (int d = 0; d < 4; ++d)
#pragma unroll
                for (int g = 0; g < 4; ++g) { const f32x4 x2 = *(const LAS f32x4*)(xq + 32 * d + 8 * g);
#pragma unroll
                    for (int j = 0; j < 4; ++j) { const float v = o[d][4 * g + j] * inv - x2[j]; o[d][4 * g + j] = v; q += v * v; } }
            q += __shfl_xor(q, 32);
            const float rs = rsqrtf(q * (1.f / 128.f) + SUBLN_EPS) * (1.f - LAMBDA_INIT);
            const float* sg = subln_g + 4 * h;
#pragma unroll
            for (int d = 0; d < 4; ++d)
#pragma unroll
                for (int g = 0; g < 4; ++g) { const f32x4 sv = *(const f32x4*)(sg + 32 * d + 8 * g);
                    u32x2 w; w.x = cvt_pk(o[d][4 * g] * rs * sv[0], o[d][4 * g + 1] * rs * sv[1]); w.y = cvt_pk(o[d][4 * g + 2] * rs * sv[2], o[d][4 * g + 3] * rs * sv[3]);
                    *(LAS u32x2*)(stg + r * 272 + (32 * d + 8 * g + 4 * h) * 2) = w; }
            asm volatile("s_waitcnt lgkmcnt(0)" ::: "memory");
            bf16_t* op = MIXED + (tok0 + erow) * DM + 1024 + hh * 128 + ech * 8;
#pragma unroll
            for (int i = 0; i < 8; ++i) { const u32x4 ov = *(const LAS u32x4*)(stg + (4 * i + erow) * 272 + ech * 16); const u32x4 g4 = gw[i];
                u32x4 w; w.x = cvt_pk(bf_lo(ov.x) * bf_lo(g4.x), bf_hi(ov.x) * bf_hi(g4.x)); w.y = cvt_pk(bf_lo(ov.y) * bf_lo(g4.y), bf_hi(ov.y) * bf_hi(g4.y));
                w.z = cvt_pk(bf_lo(ov.z) * bf_lo(g4.z), bf_hi(ov.z) * bf_hi(g4.z)); w.w = cvt_pk(bf_lo(ov.w) * bf_lo(g4.w), bf_hi(ov.w) * bf_hi(g4.w));
                *(u32x4*)(op + (size_t)(4 * i) * DM) = w; }
        }
    }
}
}
#define XB_TMO      128
#define XB_XCNT(j)  (256  + 64 * (j))
#define XB_XSUB(j)  (1280 + 64 * (j))
#define XB_XGEN(j)  (2304 + 64 * (j))
#define XB_TOP      3328
#define XB_TOPGEN   3392
#define XCD_BAR_WORDS 3456
#define XB_SPIN_CAP (1u << 18)

__device__ __forceinline__ unsigned xb_ld(unsigned* p)              { return __hip_atomic_load(p, __ATOMIC_RELAXED, __HIP_MEMORY_SCOPE_AGENT); }
__device__ __forceinline__ unsigned xb_add(unsigned* p, unsigned v) { return __hip_atomic_fetch_add(p, v, __ATOMIC_RELAXED, __HIP_MEMORY_SCOPE_AGENT); }
__device__ __forceinline__ unsigned xb_xcc_id() { return (unsigned)__builtin_amdgcn_s_getreg((3 << 11) | 20) & 0xFu; }
#define XB_SPIN(cond, bar) do { unsigned _sp = 0; while (cond) { __builtin_amdgcn_s_sleep(1); \
    if ((++_sp & 255u) == 0u) { if (xb_ld(&(bar)[XB_TMO])) break; if (_sp > XB_SPIN_CAP) { atomicAdd(&(bar)[XB_TMO], 1u); break; } } } } while (0)

struct XcdBarrier {
    unsigned* bar; unsigned x;
    volatile LAS unsigned* st;
};

__device__ __forceinline__ XcdBarrier xcd_barrier_post(unsigned* bar, volatile LAS unsigned* st) {
    XcdBarrier b; b.bar = bar; b.x = xb_xcc_id(); b.st = st;
    if (threadIdx.x == 0) (void)xb_add(&bar[XB_XCNT(b.x)], 1u);
    return b;
}
__device__ __forceinline__ void xcd_barrier_complete(unsigned* bar, unsigned x, unsigned& nloc, unsigned& nx) {
    const unsigned G = gridDim.x * gridDim.y * gridDim.z;
    unsigned sum, cnt, mine, sp = 0u;
    for (;;) {
        sum = 0u; cnt = 0u; mine = 0u;
#pragma unroll
        for (unsigned j = 0; j < 16; ++j) { const unsigned c = xb_ld(&bar[XB_XCNT(j)]); sum += c; cnt += (c > 0u) ? 1u : 0u; mine = (j == x) ? c : mine; }
        if (sum == G) break;
        __builtin_amdgcn_s_sleep(1);
        if ((++sp & 255u) == 0u) { if (xb_ld(&bar[XB_TMO])) break; if (sp > XB_SPIN_CAP) { atomicAdd(&bar[XB_TMO], 1u); break; } }
    }
    nloc = mine > 0u ? mine : 1u; nx = cnt > 0u ? cnt : 1u;
}

__device__ __forceinline__ void xcd_barrier(const XcdBarrier& b) {
    asm volatile("s_waitcnt vmcnt(0)" ::: "memory");
    __syncthreads();
    if (threadIdx.x == 0) {
        unsigned* bar = b.bar;
        __builtin_amdgcn_s_waitcnt(0);
        unsigned nloc = b.st[0], nx = b.st[1];
        if (nloc == 0u) { xcd_barrier_complete(bar, b.x, nloc, nx); b.st[0] = nloc; b.st[1] = nx; }
        const unsigned old = xb_add(&bar[XB_XSUB(b.x)], 1u);
        const unsigned gen = old / nloc;
        if (old + 1u == (gen + 1u) * nloc) {
            __builtin_amdgcn_fence(__ATOMIC_RELEASE, "agent");
            asm volatile("s_waitcnt vmcnt(0)" ::: "memory");
            const unsigned og = xb_add(&bar[XB_TOP], 1u);
            const unsigned tg = og / nx;
            if (og + 1u == (tg + 1u) * nx) xb_add(&bar[XB_TOPGEN], 1u);
            else XB_SPIN(xb_ld(&bar[XB_TOPGEN]) == tg, bar);
            __builtin_amdgcn_fence(__ATOMIC_ACQUIRE, "agent");
            xb_add(&bar[XB_XGEN(b.x)], 1u);
            asm volatile("s_waitcnt vmcnt(0)" ::: "memory");
        } else {
            XB_SPIN(xb_ld(&bar[XB_XGEN(b.x)]) == gen, bar);
            __builtin_amdgcn_fence(__ATOMIC_ACQUIRE, "agent");
            asm volatile("s_waitcnt vmcnt(0)" ::: "memory");
        }
    }
    __syncthreads();
}

__device__ __forceinline__ int win_dst_row(int c) {
    const int seg = c >> 10, w = c & 1023, d6 = w & 63;
    const int wp = d6 < 16 ? (w & ~63) + (d6 < 8 ? 2 * d6 : 2 * (d6 - 8) + 1) : w;
    switch (seg) { case 0: return w; case 1: return 1024 + w; case 2: return 6144 + w; case 3: return 2048 + w;
                   case 4: return 3072 + wp; case 5: return 4096 + wp; case 6: return 7168 + w; default: return 5120 + w; }
}
struct TItem { const float* W; bf16_t* WT; const float* ks; int K, N, win, item; };
__device__ __forceinline__ void tr_load(const TItem& t, float (&v)[32], int lane) {
    const int nblk = t.N / 32, kb = t.item / nblk, nb = t.item % nblk; const float* p = t.W + (size_t)(64 * kb + (lane >> 5)) * t.N + 32 * nb + (lane & 31);
#pragma unroll
    for (int i = 0; i < 32; ++i) v[i] = __builtin_nontemporal_load(&p[(size_t)(2 * i) * t.N]);
}
__device__ __forceinline__ void tr_write(const float (&v)[32], LAS float* scr, int lane) {
#pragma unroll
    for (int i = 0; i < 32; ++i) scr[(2 * i + (lane >> 5)) * 33 + (lane & 31)] = v[i];
}
__device__ __forceinline__ void tr_store(const TItem& t, LAS float* scr, int lane) {
    const int nblk = t.N / 32, kb = t.item / nblk, nb = t.item % nblk, k0 = 64 * kb, n0 = 32 * nb, c = lane & 7;
    f32x4 s0 = {1.f, 1.f, 1.f, 1.f}, s1 = {1.f, 1.f, 1.f, 1.f};
    if (t.ks) { s0 = *(const f32x4*)(t.ks + k0 + 8 * c); s1 = *(const f32x4*)(t.ks + k0 + 8 * c + 4); }
#pragma unroll
    for (int j = 0; j < 4; ++j) { const int n = (lane >> 3) + 8 * j; const LAS float* s = scr + (8 * c) * 33 + n;
        u32x4 o; o.x = cvt_pk(s[0 * 33] * s0[0], s[1 * 33] * s0[1]); o.y = cvt_pk(s[2 * 33] * s0[2], s[3 * 33] * s0[3]); o.z = cvt_pk(s[4 * 33] * s1[0], s[5 * 33] * s1[1]); o.w = cvt_pk(s[6 * 33] * s1[2], s[7 * 33] * s1[3]);
        const int dn = t.win ? win_dst_row(n0 + n) : (n0 + n);
        *(u32x4*)(t.WT + (size_t)dn * t.K + k0 + 8 * c) = o; }
}
__device__ __forceinline__ void rms_load(const float* __restrict__ xrow, f32x4 (&v)[8], int lane) {
    const f32x4* xr = (const f32x4*)xrow + lane;
#pragma unroll
    for (int j = 0; j < 8; ++j) v[j] = __builtin_nontemporal_load(&xr[64 * j]);
}
__device__ __forceinline__ void rms_finish(const f32x4 (&v)[8], const f32x4 (&gv)[8], bf16_t* __restrict__ orow, int lane) {
    float s = 0.f;
#pragma unroll
    for (int j = 0; j < 8; ++j) s += (v[j][0] * v[j][0] + v[j][1] * v[j][1]) + (v[j][2] * v[j][2] + v[j][3] * v[j][3]);
    const float rstd = rsqrtf(wave_sum(s) * (1.f / DM) + NORM_EPS);
    u32x2* o8 = (u32x2*)orow + lane;
#pragma unroll
    for (int j = 0; j < 8; ++j) { u32x2 w; w.x = cvt_pk(v[j][0] * rstd * gv[j][0], v[j][1] * rstd * gv[j][1]); w.y = cvt_pk(v[j][2] * rstd * gv[j][2], v[j][3] * rstd * gv[j][3]); o8[64 * j] = w; }
}

struct Args { const float* in[14]; float* out; unsigned char* ws; };

__global__ void __launch_bounds__(512, 2) fwd_megakernel(Args a) {
    extern __shared__ __attribute__((aligned(16))) unsigned char lds_raw[];
    LAS unsigned char* lds = (LAS unsigned char*)lds_raw;
    { cg::grid_group grid = cg::this_grid(); if (a.ws == nullptr) grid.sync(); }
    const int tid = threadIdx.x, lane = tid & 63, wave = __builtin_amdgcn_readfirstlane(tid >> 6);
    const int G = gridDim.x, bx = blockIdx.x;
    const int vcu = (G % 8 == 0) ? (bx % 8) * (G / 8) + bx / 8 : bx;
    unsigned char* ws = a.ws;
    float* ss2 = (float*)(ws + WS_CTL + CTL_SS2); float* ss3 = (float*)(ws + WS_CTL + CTL_SS3); float* lamp = (float*)(ws + WS_CTL + CTL_LAM); float* rope = (float*)(ws + WS_CTL + CTL_ROPE);
    bf16_t* WIN = (bf16_t*)(ws + WS_WIN); bf16_t* WOUT = (bf16_t*)(ws + WS_WOUT); bf16_t* WGATE = (bf16_t*)(ws + WS_WGATE); bf16_t* WPROJ = (bf16_t*)(ws + WS_WPROJ);
    bf16_t* PB = (bf16_t*)(ws + WS_PB); bf16_t* XN = (bf16_t*)(ws + WS_XN); bf16_t* MIXED = (bf16_t*)(ws + WS_MIXED); bf16_t* PROJ = (bf16_t*)(ws + WS_PROJ);
    bf16_t* VT = (bf16_t*)(ws + WS_VT); bf16_t* KIMG = (bf16_t*)(ws + WS_KIMG); bf16_t* HB = (bf16_t*)(ws + WS_HB); bf16_t* PLEB = (bf16_t*)(ws + WS_PLE); bf16_t* H2B = (bf16_t*)(ws + WS_H2B);
    const float* x = a.in[0]; float* out = a.out;
    volatile LAS unsigned* xst = (volatile LAS unsigned*)(lds + 131072);
    if (tid == 0) { xst[0] = 0u; xst[1] = 0u; }
    __syncthreads();
    const XcdBarrier xb = xcd_barrier_post((unsigned*)(ws + WS_CTL + CTL_BAR), xst);

    {
        const int gw = bx * 8 + wave, NGW = G * 8; const int gt = bx * 512 + tid, NGT = G * 512;
        for (int i = gt; i < 2 * NTOK; i += NGT) ss2[i] = 0.f;
        if (gt == 0) { float s1 = 0.f, s2 = 0.f; for (int i = 0; i < 64; ++i) { s1 += a.in[4][i] * a.in[5][i]; s2 += a.in[6][i] * a.in[7][i]; } lamp[0] = expf(s1) - expf(s2) + LAMBDA_INIT; }
        for (int i = gt; i < SEQ * 8; i += NGT) { const int pos = i >> 3, f = i & 7;
            const float invf = (float)exp2(-(double)f * 0.125 * 18.931568569324174);
            const float angf = (float)pos * invf;
            const double tw = 6.283185307179586476925; double ang = (double)angf; ang -= tw * rint(ang / tw);
            rope[2 * i] = (float)cos(ang); rope[2 * i + 1] = (float)sin(ang); }
        LAS float* scr = (LAS float*)(lds + wave * 16384);
        constexpr int I_IN = (DM / 64) * (8192 / 32), I_SQ = (DM / 64) * (DM / 32), I_PR = (PLE / 64) * (DM / 32), I_ALL = I_IN + 2 * I_SQ + I_PR;
#define P0_DECODE(T, it_) do { int rr_ = (it_); \
            if (rr_ < I_IN) { T = TItem{a.in[3], WIN, nullptr, DM, 8192, 1, rr_}; } \
            else if (rr_ < I_IN + I_SQ) { T = TItem{a.in[9], WOUT, nullptr, DM, DM, 0, rr_ - I_IN}; } \
            else if (rr_ < I_IN + 2 * I_SQ) { T = TItem{a.in[11], WGATE, a.in[10], DM, DM, 0, rr_ - I_IN - I_SQ}; } \
            else { T = TItem{a.in[12], WPROJ, nullptr, PLE, DM, 0, rr_ - I_IN - 2 * I_SQ}; } } while (0)
        {
            float tv[32]; TItem cur, nxt; int it = gw;
            if (it < I_ALL) { P0_DECODE(cur, it); tr_load(cur, tv, lane); }
            while (it < I_ALL) {
                tr_write(tv, scr, lane);
                const int itn = it + NGW;
                if (itn < I_ALL) { P0_DECODE(nxt, itn); tr_load(nxt, tv, lane); }
                asm volatile("s_waitcnt lgkmcnt(0)" ::: "memory");
                tr_store(cur, scr, lane);
                asm volatile("s_waitcnt lgkmcnt(0)" ::: "memory");
                cur = nxt; it = itn;
            }
        }
#undef P0_DECODE
        {
            f32x4 gv[8], va[8], vb[8];
            { const f32x4* gr = (const f32x4*)a.in[2] + lane;
#pragma unroll
              for (int j = 0; j < 8; ++j) gv[j] = gr[64 * j]; }
            int m = gw;
            if (m < NTOK) rms_load(x + (size_t)m * DM, va, lane);
            for (; m < NTOK; m += 2 * NGW) {
                const int m1 = m + NGW, m2 = m + 2 * NGW;
                if (m1 < NTOK) rms_load(x + (size_t)m1 * DM, vb, lane);
                rms_finish(va, gv, XN + (size_t)m * DM, lane);
                if (m2 < NTOK) rms_load(x + (size_t)m2 * DM, va, lane);
                if (m1 < NTOK) rms_finish(vb, gv, XN + (size_t)m1 * DM, lane);
            }
        }
        for (int i = gt; i < NTOK * PLE / 8; i += NGT) { const f32x4 v0 = __builtin_nontemporal_load(&((const f32x4*)a.in[1])[2 * i]), v1 = __builtin_nontemporal_load(&((const f32x4*)a.in[1])[2 * i + 1]);
            u32x4 w; w.x = cvt_pk(v0[0], v0[1]); w.y = cvt_pk(v0[2], v0[3]); w.z = cvt_pk(v1[0], v1[1]); w.w = cvt_pk(v1[2], v1[3]); ((u32x4*)PB)[i] = w; }
    }
    xcd_barrier(xb);
    {
        { pg8::Gemm g{XN, WIN, NTOK, NPROJ, DM}; pg8::StaticOrder S; S.init(NTOK, NPROJ, G, bx); pg8::EpiProj E{PROJ, rope, KIMG};
          pg8::gemm_phase<pg8::EpiProj, pg8::StaticOrder, true, true>(lds, g, S, E); }
        __syncthreads();
        { pg8::Gemm g{WIN + (size_t)NPROJ * DM, XN, 2048, NTOK, DM}; pg8::StaticOrder S; S.init(2048, NTOK, G, bx); pg8::EpiVt E{VT};
          pg8::gemm_phase<pg8::EpiVt, pg8::StaticOrder, true, true>(lds, g, S, E); }
    }
    xcd_barrier(xb);
    {
        const float lam = lamp[0];
        for (int su = vcu; su < 256; su += G) {
            const int grp = su >> 4, j = su & 15;
#pragma unroll 1
            for (int k = 0; k < 4; ++k) { const int bh = 4 * grp + k; const int qb = (k & 1) ? 15 - j : j;
                att::attn_unit_df(lds, PROJ, KIMG, VT, MIXED, bh >> 3, bh & 7, qb, lam, a.in[8]); }
        }
#pragma unroll 1
        for (int u = vcu; u < 512; u += G) att::attn_unit<0>(lds, PROJ, KIMG, VT, MIXED, (u >> 3) >> 3, (u >> 3) & 7, u & 7, lam, a.in[8]);
    }
    xcd_barrier(xb);
    {
        __syncthreads();
        { pg8::Gemm g{MIXED, WOUT, NTOK, DM, DM}; pg8::StaticOrder S; S.init(NTOK, DM, G, bx); pg8::EpiRes E{x, HB, ss2};
          pg8::gemm_phase<pg8::EpiRes, pg8::StaticOrder, true, true>(lds, g, S, E); }
        __syncthreads();
        { pg8::Gemm g{PB, WPROJ, NTOK, DM, PLE}; pg8::StaticOrder S; S.init(NTOK, DM, G, bx); pg8::EpiBf16 E{PLEB, DM};
          pg8::gemm_phase<pg8::EpiBf16, pg8::StaticOrder, true, true>(lds, g, S, E); }
    }
    xcd_barrier(xb);
    {
        pg8::Gemm g{HB, WGATE, NTOK, DM, DM}; pg8::StaticOrder S; S.init(NTOK, DM, G, bx); pg8::EpiGate E{HB, H2B, PLEB, ss2, ss3};
        pg8::gemm_phase<pg8::EpiGate, pg8::StaticOrder, true, true>(lds, g, S, E);
    }
    xcd_barrier(xb);
    {
        const int tid5 = opaque_tid(), lane = tid5 & 63, wave = __builtin_amdgcn_readfirstlane(tid5 >> 6);
        const int gw = bx * 8 + wave, NGW = G * 8; const f32x4* gr = (const f32x4*)a.in[13];
        f32x4 gv[8];
#pragma unroll
        for (int j = 0; j < 4; ++j) { gv[2 * j] = gr[2 * (lane + 64 * j)]; gv[2 * j + 1] = gr[2 * (lane + 64 * j) + 1]; }
#define P5_LOAD(H, S_, m_) do { const u32x4* hrow_ = (const u32x4*)(H2B + (size_t)(m_) * DM); S_ = ss3[m_]; _Pragma("unroll") for (int j_ = 0; j_ < 4; ++j_) H[j_] = __builtin_nontemporal_load(&hrow_[lane + 64 * j_]); } while (0)
#define P5_STORE(H, S_, m_) do { const float rstd_ = rsqrtf(S_ * (1.f / DM) + NORM_EPS); f32x4* orow_ = (f32x4*)(out + (size_t)(m_) * DM); \
            _Pragma("unroll") for (int j_ = 0; j_ < 4; ++j_) { const int c_ = lane + 64 * j_; const u32x4 hw_ = H[j_]; const f32x4 g0_ = gv[2 * j_], g1_ = gv[2 * j_ + 1]; \
                orow_[2 * c_] = (f32x4){bf_lo(hw_.x) * rstd_ * g0_[0], bf_hi(hw_.x) * rstd_ * g0_[1], bf_lo(hw_.y) * rstd_ * g0_[2], bf_hi(hw_.y) * rstd_ * g0_[3]}; \
                orow_[2 * c_ + 1] = (f32x4){bf_lo(hw_.z) * rstd_ * g1_[0], bf_hi(hw_.z) * rstd_ * g1_[1], bf_lo(hw_.w) * rstd_ * g1_[2], bf_hi(hw_.w) * rstd_ * g1_[3]}; } } while (0)
        u32x4 ha[4], hb4[4]; float sa = 0.f, sb = 0.f;
        int m = gw;
        if (m < NTOK) P5_LOAD(ha, sa, m);
        for (; m < NTOK; m += 2 * NGW) {
            const int m1 = m + NGW, m2 = m + 2 * NGW;
            if (m1 < NTOK) P5_LOAD(hb4, sb, m1);
            P5_STORE(ha, sa, m);
            if (m2 < NTOK) P5_LOAD(ha, sa, m2);
            if (m1 < NTOK) P5_STORE(hb4, sb, m1);
        }
#undef P5_LOAD
#undef P5_STORE
    }
}

extern "C" void kernel_launch(void* const* d_in, const int* in_sizes, int n_in, void* d_out, int out_size, void* d_ws, size_t ws_size, hipStream_t stream) {
    static int grid = 0;
    if (grid == 0) {
        if (n_in != 14 || out_size != NTOK * DM || ws_size < WS_END) { fprintf(stderr, "kernel_launch: unexpected shapes (n_in %d out %d ws %zu)\n", n_in, out_size, ws_size); grid = -1; return; }
        int dev = 0, cus = 0, per_cu = 0;
        (void)hipGetDevice(&dev); (void)hipDeviceGetAttribute(&cus, hipDeviceAttributeMultiprocessorCount, dev);
        (void)hipFuncSetAttribute((const void*)fwd_megakernel, hipFuncAttributeMaxDynamicSharedMemorySize, LDS_BYTES);
        (void)hipOccupancyMaxActiveBlocksPerMultiprocessor(&per_cu, (const void*)fwd_megakernel, 512, LDS_BYTES);
        if (per_cu < 1) { fprintf(stderr, "kernel_launch: occupancy query says %d blocks/CU\n", per_cu); per_cu = 1; }
        grid = cus * per_cu;
    }
    if (grid < 0) return;
    Args a{};
    for (int i = 0; i < 14; ++i) a.in[i] = (const float*)d_in[i];
    a.out = (float*)d_out; a.ws = (unsigned char*)d_ws;
    (void)hipMemsetAsync((unsigned char*)d_ws + WS_CTL + CTL_BAR, 0, CTL_BAR_BYTES, stream);
    void* args[] = {&a};
    hipError_t e = hipLaunchCooperativeKernel((void*)fwd_megakernel, dim3(grid), dim3(512), args, LDS_BYTES, stream);
    if (e != hipSuccess) fprintf(stderr, "cooperative launch failed: %s (grid %d)\n", hipGetErrorString(e), grid);
}
```
